# Optimizing an MI355X kernel written in HIP

```python
import math
import jax, jax.numpy as jnp
from jax import lax
import numpy as np


D_MODEL = 2048
BATCH = 4
SEQ = 4096
DEPTH = 4

RWKV_HEADS = 16
RWKV_HEAD_DIM = 64
RWKV_DIM = RWKV_HEADS * RWKV_HEAD_DIM
DECAY_LORA = 64
AAA_LORA = 64
GATE_LORA = 160
RWKV_GN_EPS = 64e-5

SG_GROUPS = 4
SG_GROUP_DIM = 128
SG_DIM = SG_GROUPS * SG_GROUP_DIM
SG_CHUNK = 128

ATT_HEADS = 8
ATT_HEAD_DIM = 64
ATT_DIM = ATT_HEADS * ATT_HEAD_DIM
IDX_HEADS = 16
IDX_HEAD_DIM = 64
TOPK_MAX = 256
Q_BLOCK = 128

REL_BUCKETS = 32
REL_MAX_DIST = 128

N_BRANCH = 3
D_MIX = RWKV_DIM + SG_DIM + ATT_DIM
D_FF = 5632
LN_EPS = 1e-5
DEEPNORM_ALPHA = (2 * DEPTH) ** 0.25
DEEPNORM_BETA = (8 * DEPTH) ** -0.25

RWKV_SPLIT_POINTS = (RWKV_DIM, 2 * RWKV_DIM, 3 * RWKV_DIM,
                     3 * RWKV_DIM + DECAY_LORA, 3 * RWKV_DIM + DECAY_LORA + AAA_LORA)
RWKV_COLS = 3 * RWKV_DIM + DECAY_LORA + AAA_LORA + GATE_LORA
SG_COLS = 2 * SG_DIM
ATT_SPLIT_POINTS = (ATT_DIM, 2 * ATT_DIM, 3 * ATT_DIM,
                    3 * ATT_DIM + IDX_HEADS * IDX_HEAD_DIM,
                    3 * ATT_DIM + IDX_HEADS * IDX_HEAD_DIM + IDX_HEAD_DIM)
ATT_COLS = 3 * ATT_DIM + IDX_HEADS * IDX_HEAD_DIM + IDX_HEAD_DIM + IDX_HEADS
GATE_COLS = N_BRANCH * D_MODEL
GROUP_SPLIT_POINTS = (RWKV_COLS, RWKV_COLS + SG_COLS, RWKV_COLS + SG_COLS + ATT_COLS)
D_IN = RWKV_COLS + SG_COLS + ATT_COLS + GATE_COLS

kernel_name = "hybrid_rwkv7_sgu_dsa_macaron_deepnorm"


def layer_norm(x, g, b, eps=LN_EPS):
    xf = x.astype(jnp.float32)
    mu = jnp.mean(xf, axis=-1, keepdims=True)
    var = jnp.mean(jnp.square(xf - mu), axis=-1, keepdims=True)
    return ((xf - mu) * lax.rsqrt(var + eps) * g + b).astype(x.dtype)


def swiglu_ffn(x, w_in, w_out):
    gate, up = jnp.split(x @ w_in, 2, axis=-1)
    return (jax.nn.silu(gate) * up) @ w_out


def rel_bucket(dist):
    max_exact = REL_BUCKETS // 2
    d_f = jnp.maximum(dist, 1).astype(jnp.float32)
    large = max_exact + (jnp.log(d_f / max_exact) / math.log(REL_MAX_DIST / max_exact)
                         * (REL_BUCKETS - max_exact)).astype(jnp.int32)
    large = jnp.minimum(large, REL_BUCKETS - 1)
    return jnp.where(dist < max_exact, dist, large)


def rwkv7_time_mix(p, mu, w0, w2, a0, a2, g2, k_k, k_a, r_k, gn_g, gn_b):
    B, S, _ = p.shape
    H, N = RWKV_HEADS, RWKV_HEAD_DIM
    p_prev = jnp.pad(p, ((0, 0), (1, 0), (0, 0)))[:, :-1]
    p = p + (p_prev - p) * mu
    r, k, v, wd, ad, gd = jnp.split(p, RWKV_SPLIT_POINTS, axis=-1)
    wlog = -jax.nn.softplus(-(w0 + jnp.tanh(wd) @ w2)) - 0.5
    decay = jnp.exp(-jnp.exp(wlog.astype(jnp.float32)))
    a = jax.nn.sigmoid(a0 + ad @ a2)
    g = jax.nn.sigmoid(gd) @ g2

    def heads(t):
        return t.astype(jnp.float32).reshape(B, S, H, N)

    kk = heads(k * k_k)
    kk = kk / jnp.maximum(jnp.sqrt(jnp.sum(jnp.square(kk), axis=-1, keepdims=True)), 1e-12)
    k = k * (1 + (a - 1) * k_a)
    r_h, k_h, v_h, a_h, w_h = heads(r), heads(k), heads(v), heads(a), decay.reshape(B, S, H, N)
    xs = tuple(jnp.moveaxis(t, 1, 0) for t in (r_h, w_h, k_h, v_h, -kk, kk * a_h))

    def step(state, inp):
        r_t, w_t, k_t, v_t, aa_t, bb_t = inp
        sa = jnp.einsum('bhij,bhj->bhi', state, aa_t)
        state = (state * w_t[:, :, None, :] + sa[..., None] * bb_t[:, :, None, :]
                 + v_t[..., None] * k_t[:, :, None, :])
        return state, jnp.einsum('bhij,bhj->bhi', state, r_t)

    _, y = lax.scan(step, jnp.zeros((B, H, N, N), jnp.float32), xs)
    y = jnp.moveaxis(y, 0, 1)
    y_mu = jnp.mean(y, axis=-1, keepdims=True)
    y_var = jnp.mean(jnp.square(y - y_mu), axis=-1, keepdims=True)
    y = ((y - y_mu) * lax.rsqrt(y_var + RWKV_GN_EPS)).reshape(B, S, RWKV_DIM) * gn_g + gn_b
    bonus = jnp.sum(r_h * k_h * r_k, axis=-1, keepdims=True) * v_h
    y = y + bonus.reshape(B, S, RWKV_DIM)
    return (y * g).astype(p.dtype)


def spatial_gating(p, ln_g, ln_b, w_s, b_s):
    B, S, _ = p.shape
    z = jax.nn.gelu(p, approximate=False)
    u, v = z[..., :SG_DIM], z[..., SG_DIM:]
    v = layer_norm(v, ln_g, ln_b)
    v = v.reshape(B, S // SG_CHUNK, SG_CHUNK, SG_GROUPS, SG_GROUP_DIM)
    causal = jnp.tril(jnp.ones((SG_CHUNK, SG_CHUNK), dtype=bool))
    w = jnp.where(causal[None], w_s, jnp.zeros_like(w_s))
    mixed = jnp.einsum('gij,bcjgd->bcigd', w, v) + jnp.transpose(b_s)[:, :, None]
    return u * mixed.reshape(B, S, SG_DIM)


def dsa_attention(p, idx_ln_g, idx_ln_b, rel_bias):
    B, S, _ = p.shape
    top_k = min(TOPK_MAX, S // 4)
    nb = S // Q_BLOCK
    q, k, v, q_idx, k_idx, w_idx = jnp.split(p, ATT_SPLIT_POINTS, axis=-1)
    q = q.reshape(B, S, ATT_HEADS, ATT_HEAD_DIM)
    k = k.reshape(B, S, ATT_HEADS, ATT_HEAD_DIM)
    v = v.reshape(B, S, ATT_HEADS, ATT_HEAD_DIM)
    q_idx = q_idx.reshape(B, S, IDX_HEADS, IDX_HEAD_DIM)
    k_idx = layer_norm(k_idx, idx_ln_g, idx_ln_b)
    w_idx = w_idx * IDX_HEADS ** -0.5
    key_pos = jnp.arange(S, dtype=jnp.int32)

    def to_blocks(t):
        return jnp.moveaxis(t.reshape(B, nb, Q_BLOCK, *t.shape[2:]), 1, 0)

    def block(args):
        qb, qib, wb, start = args
        q_pos = start + jnp.arange(Q_BLOCK, dtype=jnp.int32)
        causal = key_pos[None, :] <= q_pos[:, None]
        dots = jnp.einsum('bqhd,bsd->bqhs', qib, k_idx) * IDX_HEAD_DIM ** -0.5
        score = jnp.einsum('bqh,bqhs->bqs', wb, jax.nn.relu(dots)).astype(jnp.float32)
        score = jnp.where(causal[None], score, -jnp.inf)
        _, sel = lax.top_k(score, top_k)
        k_sel = jax.vmap(lambda kb, ib: kb[ib])(k, sel)
        v_sel = jax.vmap(lambda vb, ib: vb[ib])(v, sel)
        dist = q_pos[None, :, None] - sel
        bias = rel_bias[rel_bucket(jnp.maximum(dist, 0))]
        logits = (jnp.einsum('bqhd,bqkhd->bqhk', qb, k_sel).astype(jnp.float32)
                  * ATT_HEAD_DIM ** -0.5 + jnp.swapaxes(bias, -1, -2))
        logits = jnp.where((dist >= 0)[:, :, None, :], logits, -jnp.inf)
        probs = jax.nn.softmax(logits, axis=-1).astype(v.dtype)
        return jnp.einsum('bqhk,bqkhd->bqhd', probs, v_sel)

    starts = jnp.arange(nb, dtype=jnp.int32) * Q_BLOCK
    out = lax.map(block, (to_blocks(q), to_blocks(q_idx), to_blocks(w_idx), starts))
    return jnp.moveaxis(out, 0, 1).reshape(B, S, ATT_DIM)


def hybrid_token_mixer(x, w_in, b_gate, rwkv_mu, rwkv_w0, rwkv_w2, rwkv_a0, rwkv_a2, rwkv_g2,
                       rwkv_k_k, rwkv_k_a, rwkv_r_k, rwkv_gn_g, rwkv_gn_b,
                       sg_ln_g, sg_ln_b, sg_w, sg_b, idx_ln_g, idx_ln_b, rel_bias,
                       w_branch, w_o):
    B, S, _ = x.shape
    p_rwkv, p_sg, p_att, p_gate = jnp.split(x @ w_in, GROUP_SPLIT_POINTS, axis=-1)
    y_rwkv = rwkv7_time_mix(p_rwkv, rwkv_mu, rwkv_w0, rwkv_w2, rwkv_a0, rwkv_a2, rwkv_g2,
                            rwkv_k_k, rwkv_k_a, rwkv_r_k, rwkv_gn_g, rwkv_gn_b)
    y_sg = spatial_gating(p_sg, sg_ln_g, sg_ln_b, sg_w, sg_b)
    y_att = dsa_attention(p_att, idx_ln_g, idx_ln_b, rel_bias)
    gates = jax.nn.sigmoid(p_gate + b_gate).reshape(B, S, N_BRANCH, D_MODEL)
    z_rwkv = y_rwkv @ w_branch[:RWKV_DIM]
    z_sg = y_sg @ w_branch[RWKV_DIM:RWKV_DIM + SG_DIM]
    z_att = y_att @ w_branch[RWKV_DIM + SG_DIM:]
    merged = gates[:, :, 0] * z_rwkv + gates[:, :, 1] * z_sg + gates[:, :, 2] * z_att
    return merged @ w_o


def setup_inputs(seed: int = 0) -> dict:
    key = jax.random.key(seed)
    keys = jax.random.split(key, 40)
    counter = [0]

    def nxt():
        counter[0] += 1
        return keys[counter[0] - 1]

    def normal(shape, scale):
        return scale * jax.random.normal(nxt(), shape, jnp.float32)

    def uniform(shape, lo, hi):
        return jax.random.uniform(nxt(), shape, jnp.float32, lo, hi)

    L = DEPTH
    return {
        'x': normal((BATCH, SEQ, D_MODEL), 1.0),
        'ffn1_w_in': normal((L, D_MODEL, 2 * D_FF), D_MODEL ** -0.5),
        'ffn1_w_out': normal((L, D_FF, D_MODEL), DEEPNORM_BETA * D_FF ** -0.5),
        'ln1_g': 1.0 + normal((L, D_MODEL), 0.02),
        'ln1_b': normal((L, D_MODEL), 0.02),
        'w_in': normal((L, D_MODEL, D_IN), D_MODEL ** -0.5),
        'b_gate': normal((L, GATE_COLS), 0.1),
        'rwkv_mu': uniform((L, RWKV_COLS), 0.2, 0.8),
        'rwkv_w0': uniform((L, RWKV_DIM), -6.0, 0.0),
        'rwkv_w2': normal((L, DECAY_LORA, RWKV_DIM), 0.1),
        'rwkv_a0': normal((L, RWKV_DIM), 0.1),
        'rwkv_a2': normal((L, AAA_LORA, RWKV_DIM), AAA_LORA ** -0.5),
        'rwkv_g2': normal((L, GATE_LORA, RWKV_DIM), GATE_LORA ** -0.5),
        'rwkv_k_k': 0.85 + normal((L, RWKV_DIM), 0.02),
        'rwkv_k_a': 1.0 + normal((L, RWKV_DIM), 0.02),
        'rwkv_r_k': normal((L, RWKV_HEADS, RWKV_HEAD_DIM), 0.1),
        'rwkv_gn_g': 1.0 + normal((L, RWKV_DIM), 0.02),
        'rwkv_gn_b': normal((L, RWKV_DIM), 0.02),
        'sg_ln_g': 1.0 + normal((L, SG_DIM), 0.02),
        'sg_ln_b': normal((L, SG_DIM), 0.02),
        'sg_w': normal((L, SG_GROUPS, SG_CHUNK, SG_CHUNK), SG_CHUNK ** -0.5),
        'sg_b': 1.0 + normal((L, SG_GROUPS, SG_CHUNK), 0.1),
        'idx_ln_g': 1.0 + normal((L, IDX_HEAD_DIM), 0.02),
        'idx_ln_b': normal((L, IDX_HEAD_DIM), 0.02),
        'rel_bias': normal((REL_BUCKETS, ATT_HEADS), 0.5),
        'w_branch': normal((L, D_MIX, D_MODEL), D_MIX ** -0.5),
        'w_o': normal((L, D_MODEL, D_MODEL), DEEPNORM_BETA * D_MODEL ** -0.5),
        'ln2_g': 1.0 + normal((L, D_MODEL), 0.02),
        'ln2_b': normal((L, D_MODEL), 0.02),
        'ffn2_w_in': normal((L, D_MODEL, 2 * D_FF), D_MODEL ** -0.5),
        'ffn2_w_out': normal((L, D_FF, D_MODEL), DEEPNORM_BETA * D_FF ** -0.5),
        'ln3_g': 1.0 + normal((L, D_MODEL), 0.02),
        'ln3_b': normal((L, D_MODEL), 0.02),
    }


def reference(x, ffn1_w_in, ffn1_w_out, ln1_g, ln1_b, w_in, b_gate, rwkv_mu, rwkv_w0, rwkv_w2,
              rwkv_a0, rwkv_a2, rwkv_g2, rwkv_k_k, rwkv_k_a, rwkv_r_k, rwkv_gn_g, rwkv_gn_b,
              sg_ln_g, sg_ln_b, sg_w, sg_b, idx_ln_g, idx_ln_b, rel_bias, w_branch, w_o,
              ln2_g, ln2_b, ffn2_w_in, ffn2_w_out, ln3_g, ln3_b):
    for l in range(DEPTH):
        x = layer_norm(DEEPNORM_ALPHA * x + 0.5 * swiglu_ffn(x, ffn1_w_in[l], ffn1_w_out[l]),
                       ln1_g[l], ln1_b[l])
        mix = hybrid_token_mixer(x, w_in[l], b_gate[l], rwkv_mu[l], rwkv_w0[l], rwkv_w2[l],
                                 rwkv_a0[l], rwkv_a2[l], rwkv_g2[l], rwkv_k_k[l], rwkv_k_a[l],
                                 rwkv_r_k[l], rwkv_gn_g[l], rwkv_gn_b[l], sg_ln_g[l], sg_ln_b[l],
                                 sg_w[l], sg_b[l], idx_ln_g[l], idx_ln_b[l], rel_bias,
                                 w_branch[l], w_o[l])
        x = layer_norm(DEEPNORM_ALPHA * x + mix, ln2_g[l], ln2_b[l])
        x = layer_norm(DEEPNORM_ALPHA * x + 0.5 * swiglu_ffn(x, ffn2_w_in[l], ffn2_w_out[l]),
                       ln3_g[l], ln3_b[l])
    return x
```

```cpp
#include <hip/hip_runtime.h>
#include <cstdio>
#include <cstdint>

#ifndef MK_PER_PHASE
#define MK_PER_PHASE 0
#endif
#ifndef PH_MASK
#define PH_MASK 0xFFFFFFFFu
#endif
#define PHON(k) (((PH_MASK) >> (k)) & 1u)
#ifndef RWKV_CHUNKED
#define RWKV_CHUNKED 1
#endif
#ifndef DBG_RWKV
#define DBG_RWKV 0
#endif
#ifndef DBG_LORA
#define DBG_LORA 0
#endif
#ifndef HETERO
#define HETERO 1
#endif
#ifndef SEQ_HILO
#define SEQ_HILO 0
#endif
#ifndef SGU_SPLIT
#define SGU_SPLIT 256
#endif
#ifndef REP_MASK
#define REP_MASK 0u
#endif

#define LAS __attribute__((address_space(3)))
#define DI __device__ __forceinline__
typedef unsigned short bf16_t;
typedef short bf16x8 __attribute__((ext_vector_type(8)));
typedef float f32x4 __attribute__((ext_vector_type(4)));
typedef float f32x2 __attribute__((ext_vector_type(2)));
typedef float f32x16 __attribute__((ext_vector_type(16)));
typedef unsigned u32x4 __attribute__((ext_vector_type(4)));
typedef unsigned u32x2 __attribute__((ext_vector_type(2)));
typedef __bf16 bf16x2_t __attribute__((ext_vector_type(2)));

constexpr int NB = 4, SEQ = 4096, M = NB * SEQ, D = 2048, FF = 5632, DEPTH = 4;
constexpr int RW = 1024;
constexpr int PCOLS = 13312;
constexpr int DIN = 13168;
constexpr int PC_R = 0, PC_K = 1024, PC_V = 2048, PC_SGU = 3072, PC_SGV = 3584, PC_AQ = 4096, PC_AK = 4608, PC_AV = 5120, PC_QI = 5632, PC_GATE = 6656, PC_LORA = 12800, PC_KI = 13088, PC_WI = 13152;
constexpr float ALPHA = 1.6817928305074290f;
constexpr float LN_EPS = 1e-5f;

constexpr size_t MiB = 1u << 20;
constexpr size_t OFF_CTL = 0, CTL_BYTES = 1 * MiB;
constexpr size_t OFF_BIAS = 1 * MiB;
constexpr size_t OFF_ST = OFF_BIAS + 786432;
constexpr size_t OFF_LW2 = OFF_BIAS + 65536, OFF_LA2 = OFF_LW2 + 131072, OFF_LG2 = OFF_LA2 + 131072;
constexpr int REC = 15360, RROW = 144, R_EL2 = 0, R_RL2 = 2304, R_A2 = 4608, R_A3 = 8704, R_FT = 9728, R_VT = 10240, R_GC = 12288, R_G = 12544, R_BON = 14592;
constexpr size_t OFF_W1A = 2 * MiB;
constexpr size_t OFF_W1B = OFF_W1A + 44 * MiB;
constexpr size_t OFF_WIN = OFF_W1B + 22 * MiB;
constexpr size_t OFF_WBR = OFF_WIN + 52 * MiB;
constexpr size_t OFF_WO  = OFF_WBR + 8 * MiB;
constexpr size_t OFF_W2A = OFF_WO + 8 * MiB;
constexpr size_t OFF_W2B = OFF_W2A + 44 * MiB;
constexpr size_t OFF_X   = OFF_W2B + 22 * MiB;
constexpr size_t OFF_T   = OFF_X + 128 * MiB;
constexpr size_t OFF_XB  = OFF_T + 128 * MiB;
constexpr size_t OFF_P   = OFF_XB + 64 * MiB;
constexpr size_t OFF_SCR = OFF_P + 416 * MiB;
constexpr size_t OFF_Y   = OFF_SCR + 416 * MiB;
constexpr size_t OFF_MG  = OFF_Y + 64 * MiB;
constexpr size_t OFF_BM  = OFF_MG + 64 * MiB;
constexpr size_t OFF_KI  = OFF_BM + 8 * MiB;
constexpr size_t OFF_VT  = OFF_KI + 2 * MiB;
constexpr size_t WS_END  = OFF_VT + 16 * MiB;

constexpr int LDS_BYTES = 147456;
constexpr int MISC_OFF = 131072 + 320;

DI unsigned f2bf(float f) { unsigned u = __builtin_bit_cast(unsigned, f); return (u + 0x7fffu + ((u >> 16) & 1u)) >> 16; }
DI float bf2f(unsigned short b) { return __builtin_bit_cast(float, ((unsigned)b) << 16); }
DI unsigned pk2(float lo, float hi) { f32x2 v = {lo, hi}; bf16x2_t b = __builtin_convertvector(v, bf16x2_t); return __builtin_bit_cast(unsigned, b); }
DI float bflo(unsigned w) { return __builtin_bit_cast(float, w << 16); }
DI float bfhi(unsigned w) { return __builtin_bit_cast(float, w & 0xffff0000u); }
template <int CTRL> DI float dpp_f(float x) { return __builtin_bit_cast(float, __builtin_amdgcn_update_dpp(0, __builtin_bit_cast(int, x), CTRL, 0xF, 0xF, true)); }
DI float row16_sum(float x) {
    x += dpp_f<0xB1>(x);
    x += dpp_f<0x4E>(x);
    x += dpp_f<0x141>(x);
    x += dpp_f<0x140>(x);
    return x;
}
DI int otid() { int t = threadIdx.x; asm volatile("" : "+v"(t)); return t; }
DI int obid() { int t = blockIdx.x; asm volatile("" : "+s"(t)); return t; }
DI float wave_sum(float x) {
    x = row16_sum(x);
    auto p = __builtin_amdgcn_permlane16_swap(__float_as_uint(x), __float_as_uint(x), false, false);
    x = __uint_as_float(p[0]) + __uint_as_float(p[1]);
    auto q = __builtin_amdgcn_permlane32_swap(__float_as_uint(x), __float_as_uint(x), false, false);
    return __uint_as_float(q[0]) + __uint_as_float(q[1]);
}
DI void wave_sum8(float (&x)[8]) {
#pragma unroll
    for (int i = 0; i < 8; ++i) x[i] += dpp_f<0xB1>(x[i]);
#pragma unroll
    for (int i = 0; i < 8; ++i) x[i] += dpp_f<0x4E>(x[i]);
#pragma unroll
    for (int i = 0; i < 8; ++i) x[i] += dpp_f<0x141>(x[i]);
#pragma unroll
    for (int i = 0; i < 8; ++i) x[i] += dpp_f<0x140>(x[i]);
#pragma unroll
    for (int i = 0; i < 8; ++i) { auto p = __builtin_amdgcn_permlane16_swap(__float_as_uint(x[i]), __float_as_uint(x[i]), false, false); x[i] = __uint_as_float(p[0]) + __uint_as_float(p[1]); }
#pragma unroll
    for (int i = 0; i < 8; ++i) { auto p = __builtin_amdgcn_permlane32_swap(__float_as_uint(x[i]), __float_as_uint(x[i]), false, false); x[i] = __uint_as_float(p[0]) + __uint_as_float(p[1]); }
}
DI float sigmoidf_(float x) { return 1.0f / (1.0f + __expf(-x)); }
DI float gelu_erf(float x) { return 0.5f * x * (1.0f + erff(x * 0.70710678118654752f)); }

namespace pg8 {
constexpr int BM = 256, BK = 64, HALF = 128, HTB = HALF * BK * 2, STAGE_BYTES = 8 * HTB, NXCD = 8, WGM = 8;
__host__ __device__ __forceinline__ int lds_byte(int r, int c) { const int st = (r >> 4) * 2 + (c >> 5), rr = r & 15, cc = c & 31, ob = rr * 64 + cc * 2; return st * 1024 + (ob ^ (((ob >> 9) & 1) << 5)); }
__host__ __device__ __forceinline__ void stage_rc(int b, int& R, int& C) { const int st = b / 1024, sb = b % 1024, swz = sb ^ (((sb >> 9) & 1) << 5); R = (st >> 1) * 16 + swz / 64; C = (st & 1) * 32 + (swz % 64) / 2; }
__host__ __device__ __forceinline__ int perm32(int rho) { const int n = rho >> 4, i = rho & 15; return 8 * (i >> 2) + 4 * n + (i & 3); }

struct Unit { int pm, pn, koff, nt, tag; };
struct Gemm { const bf16_t* A; const bf16_t* Bt; int lda, ldb; };

struct StaticOrder {
    int nM, nN, nwg, G, c, nt;
    __device__ void init(int M_, int N_, int K_, int G_, int c_) { nM = M_ / BM; nN = N_ / BM; nwg = nM * nN; G = G_; c = c_; nt = K_ / BK; }
    __device__ bool tile(int L, Unit& u) const {
        if (L >= nwg) return false;
        int wgid = L; { const int q = nwg / NXCD, r = nwg % NXCD, xcd = wgid % NXCD, off = wgid / NXCD; wgid = (xcd < r ? xcd * (q + 1) : r * (q + 1) + (xcd - r) * q) + off; }
        const int nig = WGM * nN, gid = wgid / nig, fm = gid * WGM, gsz = (nM - fm) < WGM ? (nM - fm) : WGM;
        u.pm = fm + ((wgid % nig) % gsz); u.pn = (wgid % nig) / gsz; return true;
    }
    __device__ bool next(int i, Unit& u) const { u.koff = 0; u.nt = nt; u.tag = 0; return tile(i * G + c, u); }
};
struct BranchOrder : StaticOrder {
    __device__ bool next(int i, Unit& u) const {
        const int ti = i / 3, br = i - 3 * ti;
        u.tag = br; u.koff = br == 0 ? 0 : (br == 1 ? 1024 : 1536); u.nt = br == 0 ? 16 : 8;
        return tile(ti * G + c, u);
    }
};

template <class Epi, class Sched>
__device__ __forceinline__ void gemm_phase(LAS unsigned char* lds, const Gemm g, const Sched& S, const Epi& E) {
    const int tid = otid(), wid = __builtin_amdgcn_readfirstlane(tid >> 6), lane = tid & 63, wr = wid >> 2, wc = wid & 3, fr = lane & 15, fq = lane >> 4;
    unsigned voffA[2], voffB[2];
#pragma unroll
    for (int i = 0; i < 2; ++i) { int R, C; stage_rc(tid * 16 + i * 8192, R, C); const int Rb = Epi::PERM ? ((R & ~31) + perm32(R & 31)) : R;
        voffA[i] = (unsigned)(R * g.lda + C) * 2u; voffB[i] = (unsigned)(Rb * g.ldb + C) * 2u; }
    const size_t kstep = (size_t)(BK * 2);
    const size_t hstepA = (size_t)HALF * g.lda * 2, hstepB = (size_t)HALF * g.ldb * 2;
    const size_t tstepA = 2 * hstepA, tstepB = 2 * hstepB;
    const unsigned ldsw = (unsigned)wid * 1024u;
    const int aoff = lds_byte(wr * 64 + fr, fq * 8), boff = lds_byte(wc * 32 + fr, fq * 8);
#define PG8_SA(b, h) (((b) * 2 + (h)) * HTB)
#define PG8_SB(b, h) ((4 + (b) * 2 + (h)) * HTB)
#define PG8_STAGE(bufoff, gbase, voff) do { _Pragma("unroll") for (int _i = 0; _i < 2; ++_i) \
        __builtin_amdgcn_global_load_lds((const unsigned*)((const char*)(gbase) + (voff)[_i]), (LAS unsigned*)(lds + (bufoff) + ldsw + _i * 8192), 16, 0, 0); } while (0)
#define PG8_LDA(dst, b, h) do { _Pragma("unroll") for (int m = 0; m < 4; ++m) _Pragma("unroll") for (int k = 0; k < 2; ++k) dst[m][k] = *(const LAS bf16x8*)(lds + PG8_SA(b, h) + aoff + m * 2048 + k * 1024); } while (0)
#define PG8_LDB(dst, b, h) do { _Pragma("unroll") for (int n = 0; n < 2; ++n) _Pragma("unroll") for (int k = 0; k < 2; ++k) dst[n][k] = *(const LAS bf16x8*)(lds + PG8_SB(b, h) + boff + n * 2048 + k * 1024); } while (0)
#define PG8_MMA(ai, bj, At, Bt) do { __builtin_amdgcn_s_setprio(1); _Pragma("unroll") for (int m = 0; m < 4; ++m) _Pragma("unroll") for (int n = 0; n < 2; ++n) _Pragma("unroll") for (int k = 0; k < 2; ++k) \
        acc[ai][bj][m][n] = __builtin_amdgcn_mfma_f32_16x16x32_bf16(Bt[n][k], At[m][k], acc[ai][bj][m][n], 0, 0, 0); __builtin_amdgcn_s_setprio(0); } while (0)
#define PG8_WAIT_V(n) asm volatile("s_waitcnt vmcnt(" #n ")" ::: "memory")
#define PG8_WAIT_L(n) asm volatile("s_waitcnt lgkmcnt(" #n ")" ::: "memory")
#define PG8_BAR __builtin_amdgcn_s_barrier()
#define PG8_SCHED __builtin_amdgcn_sched_barrier(0)
    Unit cur, nxt; int ui = 0;
    if (!S.next(0, cur)) return;
    f32x4 acc[2][2][4][2];
#pragma unroll
    for (int a = 0; a < 2; ++a)
#pragma unroll
        for (int b = 0; b < 2; ++b)
#pragma unroll
            for (int m = 0; m < 4; ++m)
#pragma unroll
                for (int n = 0; n < 2; ++n) acc[a][b][m][n] = (f32x4){0.f, 0.f, 0.f, 0.f};
    bf16x8 At[4][2], B0[2][2], B1[2][2];
    const char* cA = (const char*)g.A + (size_t)cur.pm * tstepA + (size_t)cur.koff * 2; const char* cB = (const char*)g.Bt + (size_t)cur.pn * tstepB + (size_t)cur.koff * 2;
    PG8_STAGE(PG8_SB(0, 0), cB, voffB); PG8_STAGE(PG8_SB(0, 1), cB + hstepB, voffB); PG8_STAGE(PG8_SA(0, 0), cA, voffA); PG8_STAGE(PG8_SA(0, 1), cA + hstepA, voffA);
    if (wr == 1) PG8_BAR;
    PG8_WAIT_V(2); PG8_BAR;
    PG8_STAGE(PG8_SB(1, 0), cB + kstep, voffB); PG8_STAGE(PG8_SA(1, 0), cA + kstep, voffA); PG8_STAGE(PG8_SB(1, 1), cB + hstepB + kstep, voffB);
    PG8_WAIT_V(6); PG8_BAR;
    for (;;) {
        const bool has_next = S.next(ui + 1, nxt);
        const char* nA = has_next ? (const char*)g.A + (size_t)nxt.pm * tstepA + (size_t)nxt.koff * 2 : cA; const char* nB = has_next ? (const char*)g.Bt + (size_t)nxt.pn * tstepB + (size_t)nxt.koff * 2 : cB;
        const int nt = cur.nt;
        for (int t = 0; t < nt; t += 2) {
            const bool last = (t == nt - 2);
            const char* a1 = cA + (size_t)(t + 1) * kstep;
            const char* a2 = last ? nA : cA + (size_t)(t + 2) * kstep; const char* b2 = last ? nB : cB + (size_t)(t + 2) * kstep;
            const char* a3 = a2 + kstep; const char* b3 = b2 + kstep;
            PG8_LDB(B0, 0, 0); PG8_LDB(B1, 0, 1); PG8_SCHED; PG8_LDA(At, 0, 0); PG8_STAGE(PG8_SA(1, 1), a1 + hstepA, voffA);
            PG8_WAIT_V(8); PG8_WAIT_L(0); PG8_BAR; PG8_MMA(0, 0, At, B0); PG8_MMA(0, 1, At, B1); PG8_BAR; PG8_SCHED;
            PG8_LDA(At, 0, 1); PG8_STAGE(PG8_SB(0, 0), b2, voffB); PG8_STAGE(PG8_SB(0, 1), b2 + hstepB, voffB); PG8_STAGE(PG8_SA(0, 0), a2, voffA);
            PG8_WAIT_V(8); PG8_WAIT_L(0); PG8_BAR; PG8_MMA(1, 0, At, B0); PG8_MMA(1, 1, At, B1); PG8_BAR; PG8_SCHED;
            PG8_LDB(B0, 1, 0); PG8_LDB(B1, 1, 1); PG8_SCHED; PG8_LDA(At, 1, 0); PG8_STAGE(PG8_SA(0, 1), a2 + hstepA, voffA);
            PG8_WAIT_V(8); PG8_WAIT_L(0); PG8_BAR; PG8_MMA(0, 0, At, B0); PG8_MMA(0, 1, At, B1); PG8_BAR; PG8_SCHED;
            PG8_LDA(At, 1, 1); PG8_STAGE(PG8_SB(1, 0), b3, voffB); PG8_STAGE(PG8_SB(1, 1), b3 + hstepB, voffB); PG8_STAGE(PG8_SA(1, 0), a3, voffA);
            PG8_WAIT_V(8); PG8_WAIT_L(0); PG8_BAR; PG8_MMA(1, 0, At, B0); PG8_MMA(1, 1, At, B1); PG8_BAR; PG8_SCHED;
        }
        if (wr == 0) PG8_BAR;
        E(acc, cur, wr, wc, fr, fq);
        if (!has_next) break;
#pragma unroll
        for (int a = 0; a < 2; ++a)
#pragma unroll
            for (int b = 0; b < 2; ++b)
#pragma unroll
                for (int m = 0; m < 4; ++m)
#pragma unroll
                    for (int n = 0; n < 2; ++n) acc[a][b][m][n] = (f32x4){0.f, 0.f, 0.f, 0.f};
        cur = nxt; cA = nA; cB = nB; ++ui;
        if (wr == 1) PG8_BAR;
    }
    PG8_WAIT_V(0);
    PG8_BAR;
#undef PG8_SA
#undef PG8_SB
#undef PG8_STAGE
#undef PG8_LDA
#undef PG8_LDB
#undef PG8_MMA
#undef PG8_WAIT_V
#undef PG8_WAIT_L
#undef PG8_BAR
#undef PG8_SCHED
}

struct EpiSwiglu {
    static constexpr bool PERM = true;
    bf16_t* O; int ldc;
    __device__ __forceinline__ void operator()(const f32x4 (&acc)[2][2][4][2], const Unit& u, int wr, int wc, int fr, int fq) const {
        const int row0 = u.pm * BM + wr * 64 + fr, col0 = u.pn * HALF + wc * 32 + 8 * fq;
#pragma unroll
        for (int ai = 0; ai < 2; ++ai)
#pragma unroll
            for (int m = 0; m < 4; ++m) {
                float hv[8];
#pragma unroll
                for (int n = 0; n < 2; ++n)
#pragma unroll
                    for (int j = 0; j < 4; ++j) { const float gv = acc[ai][0][m][n][j], uv = acc[ai][1][m][n][j]; hv[4 * n + j] = gv * __builtin_amdgcn_rcpf(1.0f + __expf(-gv)) * uv; }
                u32x4 w; w.x = pk2(hv[0], hv[1]); w.y = pk2(hv[2], hv[3]); w.z = pk2(hv[4], hv[5]); w.w = pk2(hv[6], hv[7]);
                *(u32x4*)(O + (size_t)(row0 + ai * HALF + m * 16) * ldc + col0) = w;
            }
    }
};
struct EpiRes {
    static constexpr bool PERM = false;
    const float* Xraw; const float* st; const float* g; const float* b; float* T; int ldc; float alpha, s;
    __device__ __forceinline__ void operator()(const f32x4 (&acc)[2][2][4][2], const Unit& u, int wr, int wc, int fr, int fq) const {
        const int row0 = u.pm * BM + wr * 64 + fr, col0 = u.pn * BM + wc * 32 + 4 * fq;
        f32x4 gv[2][2], bv[2][2];
        if (st) {
#pragma unroll
            for (int bj = 0; bj < 2; ++bj)
#pragma unroll
                for (int n = 0; n < 2; ++n) { gv[bj][n] = *(const f32x4*)(g + col0 + bj * HALF + n * 16); bv[bj][n] = *(const f32x4*)(b + col0 + bj * HALF + n * 16); } }
#pragma unroll
        for (int ai = 0; ai < 2; ++ai)
#pragma unroll
            for (int m = 0; m < 4; ++m) { const int row = row0 + ai * HALF + m * 16; const size_t off = (size_t)row * ldc + col0;
                f32x2 ms = {0.f, 1.f}; if (st) ms = *(const f32x2*)(st + 2 * (size_t)row);
#pragma unroll
                for (int bj = 0; bj < 2; ++bj)
#pragma unroll
                    for (int n = 0; n < 2; ++n) { f32x4 xv;
                        if (st) { const f32x4 tv = *(const f32x4*)(T + off + bj * HALF + n * 16); xv = (tv - ms[0]) * ms[1] * gv[bj][n] + bv[bj][n]; }
                        else xv = *(const f32x4*)(Xraw + off + bj * HALF + n * 16);
                        *(f32x4*)(T + off + bj * HALF + n * 16) = xv * alpha + acc[ai][bj][m][n] * s; } }
    }
};
struct EpiBf16 {
    static constexpr bool PERM = true;
    bf16_t* O; int ldc;
    __device__ __forceinline__ void operator()(const f32x4 (&acc)[2][2][4][2], const Unit& u, int wr, int wc, int fr, int fq) const {
        const int row0 = u.pm * BM + wr * 64 + fr, col0 = u.pn * BM + wc * 32 + 8 * fq;
#pragma unroll
        for (int ai = 0; ai < 2; ++ai)
#pragma unroll
            for (int m = 0; m < 4; ++m) { bf16_t* rowp = O + (size_t)(row0 + ai * HALF + m * 16) * ldc + col0;
#pragma unroll
                for (int bj = 0; bj < 2; ++bj) { const f32x4 v0 = acc[ai][bj][m][0], v1 = acc[ai][bj][m][1];
                    u32x4 w; w.x = pk2(v0[0], v0[1]); w.y = pk2(v0[2], v0[3]); w.z = pk2(v1[0], v1[1]); w.w = pk2(v1[2], v1[3]);
                    *(u32x4*)(rowp + bj * HALF) = w; } }
    }
};
struct EpiBranch {
    static constexpr bool PERM = false;
    const bf16_t* P; const float* bgate; float* TOT; bf16_t* MG;
    __device__ __forceinline__ void operator()(const f32x4 (&acc)[2][2][4][2], const Unit& u, int wr, int wc, int fr, int fq) const {
        const int row0 = u.pm * BM + wr * 64 + fr, col0 = u.pn * BM + wc * 32 + 4 * fq; const int br = u.tag;
#pragma unroll
        for (int ai = 0; ai < 2; ++ai)
#pragma unroll
            for (int m = 0; m < 4; ++m) { const size_t row = (size_t)(row0 + ai * HALF + m * 16);
#pragma unroll
                for (int bj = 0; bj < 2; ++bj)
#pragma unroll
                    for (int n = 0; n < 2; ++n) { const int col = col0 + bj * HALF + n * 16;
                        const u32x2 gw = *(const u32x2*)(P + row * PCOLS + PC_GATE + br * D + col); const f32x4 bg = *(const f32x4*)(bgate + br * D + col);
                        f32x4 gt; gt[0] = sigmoidf_(bflo(gw.x) + bg[0]); gt[1] = sigmoidf_(bfhi(gw.x) + bg[1]); gt[2] = sigmoidf_(bflo(gw.y) + bg[2]); gt[3] = sigmoidf_(bfhi(gw.y) + bg[3]);
                        f32x4 v = gt * acc[ai][bj][m][n];
                        float* tp = TOT + row * D + col;
                        if (br != 0) v += *(const f32x4*)tp;
                        if (br != 2) *(f32x4*)tp = v;
                        else { u32x2 o; o.x = pk2(v[0], v[1]); o.y = pk2(v[2], v[3]); *(u32x2*)(MG + row * D + col) = o; } } }
    }
};
}

#define XB_TMO      128
#define XB_XCNT(j)  (256  + 64 * (j))
#define XB_XSUB(j)  (1280 + 64 * (j))
#define XB_XGEN(j)  (2304 + 64 * (j))
#define XB_TOP      3328
#define XB_TOPGEN   3392
#define XCD_BAR_WORDS 3456
#define XB_SPIN_CAP (1u << 18)
__device__ __forceinline__ unsigned xb_ld(unsigned* p)              { return __hip_atomic_load(p, __ATOMIC_RELAXED, __HIP_MEMORY_SCOPE_AGENT); }
__device__ __forceinline__ unsigned xb_add(unsigned* p, unsigned v) { return __hip_atomic_fetch_add(p, v, __ATOMIC_RELAXED, __HIP_MEMORY_SCOPE_AGENT); }
__device__ __forceinline__ unsigned xb_xcc_id() { return (unsigned)__builtin_amdgcn_s_getreg((3 << 11) | 20) & 0xFu; }
#define XB_SPIN(cond, bar) do { unsigned _sp = 0; while (cond) { __builtin_amdgcn_s_sleep(1); \
    if ((++_sp & 255u) == 0u) { if (xb_ld(&(bar)[XB_TMO])) break; if (_sp > XB_SPIN_CAP) { atomicAdd(&(bar)[XB_TMO], 1u); break; } } } } while (0)
struct XcdBarrier { unsigned* bar; unsigned x; volatile LAS unsigned* st; };
__device__ __forceinline__ XcdBarrier xcd_barrier_post(unsigned* bar, volatile LAS unsigned* st) {
    XcdBarrier b; b.bar = bar; b.x = xb_xcc_id(); b.st = st;
    if (threadIdx.x == 0) (void)xb_add(&bar[XB_XCNT(b.x)], 1u);
    return b;
}
__device__ __forceinline__ void xcd_barrier_complete(unsigned* bar, unsigned x, unsigned& nloc, unsigned& nx) {
    const unsigned G = gridDim.x * gridDim.y * gridDim.z;
    unsigned sum, cnt, mine, sp = 0u;
    for (;;) {
        sum = 0u; cnt = 0u; mine = 0u;
#pragma unroll
        for (unsigned j = 0; j < 16; ++j) { const unsigned c = xb_ld(&bar[XB_XCNT(j)]); sum += c; cnt += (c > 0u) ? 1u : 0u; mine = (j == x) ? c : mine; }
        if (sum == G) break;
        __builtin_amdgcn_s_sleep(1);
        if ((++sp & 255u) == 0u) { if (xb_ld(&bar[XB_TMO])) break; if (sp > XB_SPIN_CAP) { atomicAdd(&bar[XB_TMO], 1u); break; } }
    }
    nloc = mine > 0u ? mine : 1u; nx = cnt > 0u ? cnt : 1u;
}
__device__ __forceinline__ void xcd_barrier(const XcdBarrier& b) {
    asm volatile("s_waitcnt vmcnt(0)" ::: "memory");
    __syncthreads();
    if (threadIdx.x == 0) {
        unsigned* bar = b.bar;
        __builtin_amdgcn_s_waitcnt(0);
        unsigned nloc = b.st[0], nx = b.st[1];
        if (nloc == 0u) { xcd_barrier_complete(bar, b.x, nloc, nx); b.st[0] = nloc; b.st[1] = nx; }
        const unsigned old = xb_add(&bar[XB_XSUB(b.x)], 1u);
        const unsigned gen = old / nloc;
        if (old + 1u == (gen + 1u) * nloc) {
            __builtin_amdgcn_fence(__ATOMIC_RELEASE, "agent");
            asm volatile("s_waitcnt vmcnt(0)" ::: "memory");
            const unsigned og = xb_add(&bar[XB_TOP], 1u);
            const unsigned tg = og / nx;
            if (og + 1u == (tg + 1u) * nx) xb_add(&bar[XB_TOPGEN], 1u);
            else XB_SPIN(xb_ld(&bar[XB_TOPGEN]) == tg, bar);
            __builtin_amdgcn_fence(__ATOMIC_ACQUIRE, "agent");
            xb_add(&bar[XB_XGEN(b.x)], 1u);
            asm volatile("s_waitcnt vmcnt(0)" ::: "memory");
        } else {
            XB_SPIN(xb_ld(&bar[XB_XGEN(b.x)]) == gen, bar);
            __builtin_amdgcn_fence(__ATOMIC_ACQUIRE, "agent");
            asm volatile("s_waitcnt vmcnt(0)" ::: "memory");
        }
    }
    __syncthreads();
}

struct Args { const float* in[33]; float* out; unsigned char* ws; int lo, hi; };
enum { I_X = 0, I_F1IN, I_F1OUT, I_LN1G, I_LN1B, I_WIN, I_BGATE, I_MU, I_W0, I_W2, I_A0, I_A2, I_G2, I_KK, I_KA, I_RK, I_GNG, I_GNB, I_SGLNG, I_SGLNB, I_SGW, I_SGB, I_ILNG, I_ILNB, I_RELB, I_WBR, I_WO, I_LN2G, I_LN2B, I_F2IN, I_F2OUT, I_LN3G, I_LN3B };

DI int pmap(int n) {
    if (n < 3072) return n;
    if (n < 3360) return PC_LORA + (n - 3072);
    if (n < 4384) return PC_SGU + (n - 3360);
    if (n < 5920) return PC_AQ + (n - 4384);
    if (n < 6944) return PC_QI + (n - 5920);
    if (n < 7008) return PC_KI + (n - 6944);
    if (n < 7024) return PC_WI + (n - 7008);
    return PC_GATE + (n - 7024);
}
template <int MODE> DI int rowmap(int n) {
    if (MODE == 0) return n;
    if (MODE == 1) { const int up = n >= FF ? 1 : 0, j = n - up * FF; return (j >> 7) * 256 + up * 128 + (j & 127); }
    return pmap(n);
}
template <int MODE> DI void transpose_item(const float* __restrict__ W, int K, int N, bf16_t* WT, float* scr, int item, int lane) {
    const int nblk = (N + 31) / 32, kb = item / nblk, nb = item % nblk, k0 = 64 * kb, n0 = 32 * nb;
    unsigned* st = (unsigned*)scr;
    const int c4 = lane & 7, rq = lane >> 3; const int ncol = n0 + 4 * c4; const bool okc = ncol < N;
    f32x4 va[4], vb[4];
#pragma unroll
    for (int i = 0; i < 4; ++i) { const int k = k0 + 2 * (rq + 8 * i);
        va[i] = okc ? *(const f32x4*)(W + (size_t)k * N + ncol) : (f32x4){0.f, 0.f, 0.f, 0.f}; vb[i] = okc ? *(const f32x4*)(W + (size_t)(k + 1) * N + ncol) : (f32x4){0.f, 0.f, 0.f, 0.f}; }
#pragma unroll
    for (int i = 0; i < 4; ++i) { const int rp = rq + 8 * i;
#pragma unroll
        for (int j = 0; j < 4; ++j) st[(4 * c4 + j) * 33 + rp] = pk2(va[i][j], vb[i][j]); }
    __builtin_amdgcn_s_waitcnt(0xc07f); asm volatile("" ::: "memory");
#pragma unroll
    for (int i = 0; i < 4; ++i) { const int id = lane + 64 * i, n = id >> 3, kc = id & 7; const unsigned* p = st + n * 33 + 4 * kc;
        u32x4 o; o.x = p[0]; o.y = p[1]; o.z = p[2]; o.w = p[3];
        if (n0 + n < N) *(u32x4*)(WT + (size_t)rowmap<MODE>(n0 + n) * K + k0 + 8 * kc) = o; }
    __builtin_amdgcn_s_waitcnt(0xc07f); asm volatile("" ::: "memory");
}
DI void convert_phase(const Args& a, int L, unsigned char* lds) {
    const int tidx_ = otid();
    const int wave = __builtin_amdgcn_readfirstlane(tidx_ >> 6), lane = tidx_ & 63;
    float* scr = (float*)(lds + wave * 16384);
    const int gw = blockIdx.x * 8 + wave, NGW = gridDim.x * 8;
    unsigned char* ws = a.ws;
    constexpr int I1 = (D / 64) * ((2 * FF) / 32), I2 = (FF / 64) * (D / 32), I3 = (D / 64) * ((DIN + 31) / 32), I4 = (D / 64) * (D / 32);
    constexpr int NIT = 2 * I1 + 2 * I2 + I3 + 2 * I4;
    for (int it = gw; it < NIT; it += NGW) {
        int r = it;
        if (r < I1) { transpose_item<1>(a.in[I_F1IN] + (size_t)L * D * 2 * FF, D, 2 * FF, (bf16_t*)(ws + OFF_W1A), scr, r, lane); continue; } r -= I1;
        if (r < I1) { transpose_item<1>(a.in[I_F2IN] + (size_t)L * D * 2 * FF, D, 2 * FF, (bf16_t*)(ws + OFF_W2A), scr, r, lane); continue; } r -= I1;
        if (r < I2) { transpose_item<0>(a.in[I_F1OUT] + (size_t)L * FF * D, FF, D, (bf16_t*)(ws + OFF_W1B), scr, r, lane); continue; } r -= I2;
        if (r < I2) { transpose_item<0>(a.in[I_F2OUT] + (size_t)L * FF * D, FF, D, (bf16_t*)(ws + OFF_W2B), scr, r, lane); continue; } r -= I2;
        if (r < I3) { transpose_item<2>(a.in[I_WIN] + (size_t)L * D * DIN, D, DIN, (bf16_t*)(ws + OFF_WIN), scr, r, lane); continue; } r -= I3;
        if (r < I4) { transpose_item<0>(a.in[I_WBR] + (size_t)L * D * D, D, D, (bf16_t*)(ws + OFF_WBR), scr, r, lane); continue; } r -= I4;
        transpose_item<0>(a.in[I_WO] + (size_t)L * D * D, D, D, (bf16_t*)(ws + OFF_WO), scr, r, lane);
    }
    { bf16_t* w2t = (bf16_t*)(ws + OFF_LW2); bf16_t* a2t = (bf16_t*)(ws + OFF_LA2); bf16_t* g2t = (bf16_t*)(ws + OFF_LG2);
      const float* w2 = a.in[I_W2] + (size_t)L * 64 * RW; const float* a2 = a.in[I_A2] + (size_t)L * 64 * RW; const float* g2 = a.in[I_G2] + (size_t)L * 160 * RW;
      for (int i = blockIdx.x * 512 + tidx_; i < RW * 288; i += gridDim.x * 512) { const int c = i / 288, jj = i - c * 288;
          if (jj < 64) w2t[c * 64 + jj] = (bf16_t)f2bf(w2[(size_t)jj * RW + c]);
          else if (jj < 128) a2t[c * 64 + jj - 64] = (bf16_t)f2bf(a2[(size_t)(jj - 64) * RW + c]);
          else g2t[c * 160 + jj - 128] = (bf16_t)f2bf(g2[(size_t)(jj - 128) * RW + c]); } }
    { u32x4* z = (u32x4*)(ws + OFF_WIN + (size_t)DIN * D * 2); const int n16 = (PCOLS - DIN) * D * 2 / 16;
      for (int i = blockIdx.x * 512 + tidx_; i < n16; i += gridDim.x * 512) z[i] = (u32x4){0u, 0u, 0u, 0u}; }
}
DI int rel_bucket_dev(int d) {
    if (d < 16) return d;
    const float df = (float)d;
    const int large = 16 + (int)(logf(df / 16.0f) / 2.0794415416798357f * 16.0f);
    return large < 31 ? large : 31;
}
DI void init_phase(const Args& a) {
    const int tidx_ = otid();
    const size_t n4 = (size_t)M * D / 4; const f32x4* x = (const f32x4*)a.in[I_X]; u32x2* XB = (u32x2*)(a.ws + OFF_XB);
    for (size_t i = (size_t)blockIdx.x * 512 + tidx_; i < n4; i += (size_t)gridDim.x * 512) { const f32x4 v = x[i]; u32x2 o; o.x = pk2(v[0], v[1]); o.y = pk2(v[2], v[3]); XB[i] = o; }
    if (blockIdx.x == 0) { float* bt = (float*)(a.ws + OFF_BIAS); for (int i = tidx_; i < 8 * 128; i += 512) { const int h = i >> 7, d = i & 127; bt[i] = a.in[I_RELB][rel_bucket_dev(d) * 8 + h]; } }
}
DI void ln_phase(const float* T, const float* g, const float* b, float* ST, bf16_t* XB, float* out) {
    const int tidx_ = otid();
    const int wave = __builtin_amdgcn_readfirstlane(tidx_ >> 6), lane = tidx_ & 63;
    for (int m = blockIdx.x * 8 + wave; m < M; m += gridDim.x * 8) {
        const f32x4* tr = (const f32x4*)(T + (size_t)m * D) + lane;
        f32x4 v[8]; float s = 0.f;
#pragma unroll
        for (int j = 0; j < 8; ++j) { v[j] = tr[64 * j]; s += (v[j][0] + v[j][1]) + (v[j][2] + v[j][3]); }
        const float mean = wave_sum(s) * (1.0f / D); float q = 0.f;
#pragma unroll
        for (int j = 0; j < 8; ++j) { v[j] = v[j] - mean; q += (v[j][0] * v[j][0] + v[j][1] * v[j][1]) + (v[j][2] * v[j][2] + v[j][3] * v[j][3]); }
        const float rstd = 1.0f / sqrtf(wave_sum(q) * (1.0f / D) + LN_EPS);
        if (lane == 0) *(f32x2*)(ST + 2 * (size_t)m) = (f32x2){mean, rstd};
        u32x2* bo = (u32x2*)(XB + (size_t)m * D) + lane;
#pragma unroll
        for (int j = 0; j < 8; ++j) { const f32x4 gv = ((const f32x4*)g)[lane + 64 * j], bv = ((const f32x4*)b)[lane + 64 * j];
            const f32x4 o = v[j] * rstd * gv + bv; u32x2 w; w.x = pk2(o[0], o[1]); w.y = pk2(o[2], o[3]); bo[64 * j] = w;
            if (out) ((f32x4*)(out + (size_t)m * D) + lane)[64 * j] = o; }
    }
}
DI void rwkv_prep_phase(const Args& a, int L, unsigned char* lds) {
    const int tidx_ = otid();
    const int tid = tidx_;
    const bf16_t* P = (const bf16_t*)(a.ws + OFF_P);
    float* Rr = (float*)(a.ws + OFF_SCR); float* Wr = Rr + (size_t)M * RW; float* Kr = Wr + (size_t)M * RW; float* Vr = Kr + (size_t)M * RW; float* Ar = Vr + (size_t)M * RW; float* Br = Ar + (size_t)M * RW;
    bf16_t* Gb = (bf16_t*)(a.ws + OFF_MG);
    const float* mu = a.in[I_MU] + (size_t)L * 3360; const float* w0 = a.in[I_W0] + L * RW; const float* w2 = a.in[I_W2] + (size_t)L * 64 * RW;
    const float* a0 = a.in[I_A0] + L * RW; const float* a2 = a.in[I_A2] + (size_t)L * 64 * RW; const float* g2 = a.in[I_G2] + (size_t)L * 160 * RW;
    const float* kkw = a.in[I_KK] + L * RW; const float* kaw = a.in[I_KA] + L * RW;
    float* xl = (float*)lds;
    for (int unit = blockIdx.x; unit < M / 32; unit += gridDim.x) {
        const int m0 = unit * 32;
        __syncthreads();
        for (int idx = tid; idx < 32 * 288; idx += 512) { const int tt = idx / 288, j = idx - tt * 288; const int m = m0 + tt;
            const float cur = bf2f(P[(size_t)m * PCOLS + PC_LORA + j]); const float prev = (m & (SEQ - 1)) == 0 ? 0.f : bf2f(P[(size_t)(m - 1) * PCOLS + PC_LORA + j]);
            float x = cur + (prev - cur) * mu[3072 + j];
            if (j < 64) x = tanhf(x); else if (j >= 128) x = sigmoidf_(x);
            xl[idx] = x; }
        __syncthreads();
#pragma unroll 1
        for (int half = 0; half < 2; ++half) { const int c = tid + 512 * half;
            const float w0c = w0[c], a0c = a0[c], kkc = kkw[c], kac = kaw[c], mur = mu[c], muk = mu[1024 + c], muv = mu[2048 + c];
#pragma unroll 1
            for (int sub = 0; sub < 4; ++sub) {
                float wl[8], al[8], gl[8];
#pragma unroll
                for (int t = 0; t < 8; ++t) { wl[t] = w0c; al[t] = a0c; gl[t] = 0.f; }
                const float* xb = xl + sub * 8 * 288;
#pragma unroll 2
                for (int j = 0; j < 64; j += 4) { const float u0 = w2[(size_t)(j + 0) * RW + c], u1 = w2[(size_t)(j + 1) * RW + c], u2 = w2[(size_t)(j + 2) * RW + c], u3 = w2[(size_t)(j + 3) * RW + c];
                    const float v0 = a2[(size_t)(j + 0) * RW + c], v1 = a2[(size_t)(j + 1) * RW + c], v2 = a2[(size_t)(j + 2) * RW + c], v3 = a2[(size_t)(j + 3) * RW + c];
#pragma unroll
                    for (int t = 0; t < 8; ++t) { const f32x4 xw = *(const f32x4*)(xb + t * 288 + j); const f32x4 xa = *(const f32x4*)(xb + t * 288 + 64 + j);
                        wl[t] += xw[0] * u0 + xw[1] * u1 + xw[2] * u2 + xw[3] * u3; al[t] += xa[0] * v0 + xa[1] * v1 + xa[2] * v2 + xa[3] * v3; } }
#pragma unroll 2
                for (int j = 0; j < 160; j += 4) { const float u0 = g2[(size_t)(j + 0) * RW + c], u1 = g2[(size_t)(j + 1) * RW + c], u2 = g2[(size_t)(j + 2) * RW + c], u3 = g2[(size_t)(j + 3) * RW + c];
#pragma unroll
                    for (int t = 0; t < 8; ++t) { const f32x4 xg = *(const f32x4*)(xb + t * 288 + 128 + j); gl[t] += xg[0] * u0 + xg[1] * u1 + xg[2] * u2 + xg[3] * u3; } }
#pragma unroll
                for (int t = 0; t < 8; ++t) { const int m = m0 + sub * 8 + t; const bool first = (m & (SEQ - 1)) == 0;
                    const bf16_t* pc = P + (size_t)m * PCOLS; const bf16_t* pp = pc - PCOLS;
                    const float rc = bf2f(pc[PC_R + c]), kc = bf2f(pc[PC_K + c]), vc = bf2f(pc[PC_V + c]);
                    const float rp = first ? 0.f : bf2f(pp[PC_R + c]), kp = first ? 0.f : bf2f(pp[PC_K + c]), vp = first ? 0.f : bf2f(pp[PC_V + c]);
                    const float r = rc + (rp - rc) * mur, k = kc + (kp - kc) * muk, v = vc + (vp - vc) * muv;
                    const float nx = -wl[t]; const float sp = nx > 20.f ? nx : log1pf(expf(nx));
                    const float decay = expf(-expf(-sp - 0.5f));
                    const float av = 1.0f / (1.0f + expf(-al[t]));
                    const float kk = k * kkc; const float ss = wave_sum(kk * kk); const float kkn = kk / fmaxf(sqrtf(ss), 1e-12f);
                    const float k2 = k * (1.0f + (av - 1.0f) * kac);
                    const size_t o = (size_t)m * RW + c;
                    Rr[o] = r; Wr[o] = decay; Kr[o] = k2; Vr[o] = v; Ar[o] = -kkn; Br[o] = kkn * av; Gb[o] = (bf16_t)f2bf(gl[t]); }
            }
        }
    }
}
DI void kidx_vt_phase(const Args& a, int L, unsigned char* lds) {
    const int tidx_ = otid();
    const int wave = __builtin_amdgcn_readfirstlane(tidx_ >> 6), lane = tidx_ & 63;
    const bf16_t* P = (const bf16_t*)(a.ws + OFF_P); bf16_t* KI = (bf16_t*)(a.ws + OFF_KI); bf16_t* VT = (bf16_t*)(a.ws + OFF_VT);
    const float g = a.in[I_ILNG][L * 64 + lane], b = a.in[I_ILNB][L * 64 + lane];
    for (int m = blockIdx.x * 8 + wave; m < M; m += gridDim.x * 8) {
        const float x = bf2f(P[(size_t)m * PCOLS + PC_KI + lane]);
        const float mean = wave_sum(x) * (1.0f / 64.0f); const float d = x - mean; const float var = wave_sum(d * d) * (1.0f / 64.0f);
        KI[(size_t)m * 64 + lane] = (bf16_t)f2bf(d * (1.0f / sqrtf(var + LN_EPS)) * g + b);
    }
    bf16_t* tile = (bf16_t*)(lds + wave * 16384);
    for (int u = blockIdx.x * 8 + wave; u < NB * 8 * 64; u += gridDim.x * 8) {
        const int tb = u & 63, h = (u >> 6) & 7, b_ = u >> 9; const int m = b_ * SEQ + tb * 64 + lane;
        const u32x4* src = (const u32x4*)(P + (size_t)m * PCOLS + PC_AV + h * 64);
#pragma unroll
        for (int q = 0; q < 8; ++q) { const u32x4 v = src[q]; const unsigned w[4] = {v.x, v.y, v.z, v.w};
#pragma unroll
            for (int e = 0; e < 4; ++e) { tile[(q * 8 + 2 * e) * 72 + lane] = (bf16_t)(w[e] & 0xffffu); tile[(q * 8 + 2 * e + 1) * 72 + lane] = (bf16_t)(w[e] >> 16); } }
        __builtin_amdgcn_s_waitcnt(0xc07f); asm volatile("" ::: "memory");
        bf16_t* dst = VT + ((size_t)(b_ * 8 + h) * 64 + lane) * SEQ + tb * 64;
#pragma unroll
        for (int q = 0; q < 8; ++q) *(u32x4*)(dst + q * 8) = *(const u32x4*)(tile + lane * 72 + q * 8);
        __builtin_amdgcn_s_waitcnt(0xc07f); asm volatile("" ::: "memory");
    }
}
DI void sgu_phase(const Args& a, int L, unsigned char* lds, int vb, int nvb, int u0 = 0, int u1 = NB * 32 * 4) {
    const int tidx_ = otid();
    const int tid = tidx_, wave = __builtin_amdgcn_readfirstlane(tid >> 6), lane = tid & 63, fr = lane & 15, fq = lane >> 4;
    const bf16_t* P = (const bf16_t*)(a.ws + OFF_P); bf16_t* Y = (bf16_t*)(a.ws + OFF_Y);
    const float* lng = a.in[I_SGLNG] + L * 512; const float* lnb = a.in[I_SGLNB] + L * 512;
    bf16_t* Wl = (bf16_t*)lds;
    bf16_t* Vl = (bf16_t*)(lds + 128 * 272);
    for (int unit = u0 + vb; unit < u1; unit += nvb) {
        const int g = unit & 3, ch = (unit >> 2) & 31, b_ = unit >> 7; const int m0 = b_ * SEQ + ch * 128;
        const float* sw = a.in[I_SGW] + ((size_t)(L * 4 + g) * 128) * 128; const float* sb = a.in[I_SGB] + (L * 4 + g) * 128;
        __syncthreads();
        for (int idx = tid; idx < 128 * 32; idx += 512) { const int i = idx >> 5, j4 = (idx & 31) * 4; const f32x4 w = *(const f32x4*)(sw + i * 128 + j4);
            u32x2 o; o.x = pk2(j4 + 0 <= i ? w[0] : 0.f, j4 + 1 <= i ? w[1] : 0.f); o.y = pk2(j4 + 2 <= i ? w[2] : 0.f, j4 + 3 <= i ? w[3] : 0.f);
            *(u32x2*)(Wl + i * 136 + j4) = o; }
        for (int tt = wave; tt < 128; tt += 8) { const int m = m0 + tt;
            const u32x4 pv = *(const u32x4*)(P + (size_t)m * PCOLS + PC_SGV + lane * 8);
            float z[8]; z[0] = gelu_erf(bflo(pv.x)); z[1] = gelu_erf(bfhi(pv.x)); z[2] = gelu_erf(bflo(pv.y)); z[3] = gelu_erf(bfhi(pv.y));
            z[4] = gelu_erf(bflo(pv.z)); z[5] = gelu_erf(bfhi(pv.z)); z[6] = gelu_erf(bflo(pv.w)); z[7] = gelu_erf(bfhi(pv.w));
            float s = 0.f;
#pragma unroll
            for (int e = 0; e < 8; ++e) s += z[e];
            const float mean = wave_sum(s) * (1.0f / 512.0f); float q = 0.f;
#pragma unroll
            for (int e = 0; e < 8; ++e) { z[e] -= mean; q += z[e] * z[e]; }
            const float rstd = 1.0f / sqrtf(wave_sum(q) * (1.0f / 512.0f) + LN_EPS);
            if ((lane >> 4) == g) {
#pragma unroll
                for (int e = 0; e < 8; ++e) { const int chn = lane * 8 + e; Vl[((lane & 15) * 8 + e) * 136 + tt] = (bf16_t)f2bf(z[e] * rstd * lng[chn] + lnb[chn]); } }
        }
        __syncthreads();
        f32x4 acc[8];
#pragma unroll
        for (int nt = 0; nt < 8; ++nt) acc[nt] = (f32x4){0.f, 0.f, 0.f, 0.f};
        const int ksmax = (16 * wave + 15) >> 5;
#pragma unroll
        for (int ks = 0; ks < 4; ++ks) if (ks <= ksmax) {
            const bf16x8 af = *(const bf16x8*)(Wl + (16 * wave + fr) * 136 + 32 * ks + 8 * fq);
#pragma unroll
            for (int nt = 0; nt < 8; ++nt) { const bf16x8 bfr = *(const bf16x8*)(Vl + (16 * nt + fr) * 136 + 32 * ks + 8 * fq);
                acc[nt] = __builtin_amdgcn_mfma_f32_16x16x32_bf16(af, bfr, acc[nt], 0, 0, 0); }
        }
#pragma unroll
        for (int r = 0; r < 4; ++r) { const int i = 16 * wave + 4 * fq + r; const float bs = sb[i]; const size_t m = (size_t)(m0 + i);
#pragma unroll
            for (int nt = 0; nt < 8; ++nt) { const int dcol = g * 128 + 16 * nt + fr; const float uu = gelu_erf(bf2f(P[m * PCOLS + PC_SGU + dcol]));
                Y[m * D + 1024 + dcol] = (bf16_t)f2bf(uu * (acc[nt][r] + bs)); } }
    }
}
DI void scan_load_chunk(unsigned char* bufp, const float* Rr, const float* Wr, const float* Kr, const float* Ar, const float* Br, const float* Vr, size_t base, int c, int rg, int lt) {
    const float* arrs[5] = {Rr, Wr, Kr, Ar, Br};
#pragma unroll
    for (int ar = 0; ar < 5; ++ar)
#pragma unroll
        for (int ps = 0; ps < 2; ++ps) { const int tt = ps * 16 + (lt >> 4), c4 = (lt & 15) * 4;
            const f32x4 v = *(const f32x4*)(arrs[ar] + base + (size_t)(c * 32 + tt) * RW + c4);
            *(f32x4*)(bufp + ar * 8192 + (tt * 64 + c4) * 4) = v; }
    if (lt < 128) { const int tt = lt >> 2, i4 = (lt & 3) * 4; const f32x4 v = *(const f32x4*)(Vr + base + (size_t)(c * 32 + tt) * RW + rg * 16 + i4);
        *(f32x4*)(bufp + 5 * 8192 + (tt * 16 + i4) * 4) = v; }
}
DI void scan_phase(const Args& a, unsigned char* lds) {
    const int tidx_ = otid();
    const int tid = tidx_;
    const float* Rr = (const float*)(a.ws + OFF_SCR); const float* Wr = Rr + (size_t)M * RW; const float* Kr = Wr + (size_t)M * RW; const float* Vr = Kr + (size_t)M * RW; const float* Ar = Vr + (size_t)M * RW; const float* Br = Ar + (size_t)M * RW;
    float* Yraw = (float*)(a.ws + OFF_X);
    constexpr int BUFB = 5 * 8192 + 2048;
    constexpr int NCH = SEQ / 32;
    for (int unit = blockIdx.x; unit < 256; unit += gridDim.x) {
        const int rg = unit & 3, h = (unit >> 2) & 15, b_ = unit >> 6;
        const size_t base = (size_t)b_ * SEQ * RW + h * 64;
        __syncthreads();
        const bool loader = tid >= 256; const int lt = tid - 256;
        if (loader) scan_load_chunk(lds, Rr, Wr, Kr, Ar, Br, Vr, base, 0, rg, lt);
        __syncthreads();
        float S0 = 0.f, S1 = 0.f, S2 = 0.f, S3 = 0.f;
        const int i = tid >> 4, c4 = tid & 15;
#pragma unroll 1
        for (int c = 0; c < NCH; ++c) {
            if (loader) {
                if (c > 0 && lt < 128) { const int tt = lt >> 2, i4 = (lt & 3) * 4; const f32x4 y = *(const f32x4*)(lds + 2 * BUFB + ((c - 1) & 1) * 2048 + (tt * 16 + i4) * 4);
                    *(f32x4*)(Yraw + base + (size_t)((c - 1) * 32 + tt) * RW + rg * 16 + i4) = y; }
                if (c + 1 < NCH) scan_load_chunk(lds + ((c + 1) & 1) * BUFB, Rr, Wr, Kr, Ar, Br, Vr, base, c + 1, rg, lt);
            } else {
                const unsigned char* bufp = lds + (c & 1) * BUFB; float* yb = (float*)(lds + 2 * BUFB + (c & 1) * 2048);
#pragma unroll 4
                for (int s = 0; s < 32; ++s) {
                    const f32x4 r4 = *(const f32x4*)(bufp + 0 * 8192 + (s * 64 + c4 * 4) * 4);
                    const f32x4 w4 = *(const f32x4*)(bufp + 1 * 8192 + (s * 64 + c4 * 4) * 4);
                    const f32x4 k4 = *(const f32x4*)(bufp + 2 * 8192 + (s * 64 + c4 * 4) * 4);
                    const f32x4 a4 = *(const f32x4*)(bufp + 3 * 8192 + (s * 64 + c4 * 4) * 4);
                    const f32x4 b4 = *(const f32x4*)(bufp + 4 * 8192 + (s * 64 + c4 * 4) * 4);
                    const float vi = *(const float*)(bufp + 5 * 8192 + (s * 16 + i) * 4);
                    float sa = (S0 * a4[0] + S1 * a4[1]) + (S2 * a4[2] + S3 * a4[3]);
                    sa = row16_sum(sa);
                    S0 = S0 * w4[0] + sa * b4[0] + vi * k4[0]; S1 = S1 * w4[1] + sa * b4[1] + vi * k4[1];
                    S2 = S2 * w4[2] + sa * b4[2] + vi * k4[2]; S3 = S3 * w4[3] + sa * b4[3] + vi * k4[3];
                    float yp = (S0 * r4[0] + S1 * r4[1]) + (S2 * r4[2] + S3 * r4[3]);
                    yp = row16_sum(yp);
                    if (c4 == 0) yb[s * 16 + i] = yp;
                }
            }
            __syncthreads();
        }
        if (loader && lt < 128) { const int tt = lt >> 2, i4 = (lt & 3) * 4; const f32x4 y = *(const f32x4*)(lds + 2 * BUFB + ((NCH - 1) & 1) * 2048 + (tt * 16 + i4) * 4);
            *(f32x4*)(Yraw + base + (size_t)((NCH - 1) * 32 + tt) * RW + rg * 16 + i4) = y; }
    }
}
DI void rwkv_fin_phase(const Args& a, int L) {
    const int tidx_ = otid();
    const int wave = __builtin_amdgcn_readfirstlane(tidx_ >> 6), lane = tidx_ & 63;
    const float* Rr = (const float*)(a.ws + OFF_SCR); const float* Kr = Rr + 2 * (size_t)M * RW; const float* Vr = Kr + (size_t)M * RW;
    const float* Yraw = (const float*)(a.ws + OFF_X); const bf16_t* Gb = (const bf16_t*)(a.ws + OFF_MG); bf16_t* Y = (bf16_t*)(a.ws + OFF_Y);
    const float* rk = a.in[I_RK] + L * RW; const float* gng = a.in[I_GNG] + L * RW; const float* gnb = a.in[I_GNB] + L * RW;
    for (int it = blockIdx.x * 8 + wave; it < M * 16; it += gridDim.x * 8) {
        const int m = it >> 4, h = it & 15, c = h * 64 + lane; const size_t o = (size_t)m * RW + c;
        const float y = Yraw[o], r = Rr[o], k = Kr[o], v = Vr[o];
        const float mean = wave_sum(y) * (1.0f / 64.0f); const float d = y - mean; const float var = wave_sum(d * d) * (1.0f / 64.0f);
        const float yn = d * (1.0f / sqrtf(var + 64e-5f)) * gng[c] + gnb[c];
        const float bonus = wave_sum(r * k * rk[c]) * v;
        Y[(size_t)m * D + c] = (bf16_t)f2bf((yn + bonus) * bf2f(Gb[o]));
    }
}
DI void rwkv_par_phase(const Args& a, int L, unsigned char* lds) {
    const int tidx_ = otid();
    const int tid = tidx_, wave = __builtin_amdgcn_readfirstlane(tid >> 6), lane = tid & 63, fr = lane & 15, q = lane >> 4;
    const bf16_t* P = (const bf16_t*)(a.ws + OFF_P); unsigned char* RECB = a.ws + OFF_SCR;
    const bf16_t* W2T = (const bf16_t*)(a.ws + OFF_LW2); const bf16_t* A2T = (const bf16_t*)(a.ws + OFF_LA2); const bf16_t* G2T = (const bf16_t*)(a.ws + OFF_LG2);
    const float* mu = a.in[I_MU] + (size_t)L * 3360; const float* w0 = a.in[I_W0] + L * RW; const float* a0 = a.in[I_A0] + L * RW;
    const float* kkw = a.in[I_KK] + L * RW; const float* kaw = a.in[I_KA] + L * RW; const float* rkw = a.in[I_RK] + L * RW;
    unsigned char* XL = lds;
    unsigned char* WS = lds + 9472 + wave * 12288;
    for (int unit = blockIdx.x; unit < NB * 256; unit += gridDim.x) {
        const int b_ = unit >> 8, cidx = unit & 255; const int m0 = b_ * SEQ + cidx * 16;
        __syncthreads();
        int tb9 = tid; asm volatile("" : "+v"(tb9));
#pragma unroll
        for (int it9 = 0; it9 < 9; ++it9) { const int idx = tb9 + 512 * it9; const int t = idx / 288, jj = idx - t * 288; const int m = m0 + t;
            const float cur = bf2f(P[(size_t)m * PCOLS + PC_LORA + jj]); const float prev = (m & (SEQ - 1)) == 0 ? 0.f : bf2f(P[(size_t)(m - 1) * PCOLS + PC_LORA + jj]);
            float x = cur + (prev - cur) * mu[3072 + jj];
            if (jj < 64) { const float e2x = __expf(2.0f * x); x = 1.0f - 2.0f * __builtin_amdgcn_rcpf(e2x + 1.0f); } else if (jj >= 128) x = __builtin_amdgcn_rcpf(1.0f + __expf(-x));
            *(bf16_t*)(XL + t * 592 + jj * 2) = (bf16_t)f2bf(x); }
        __syncthreads();
#define AXF(ks) (*(const bf16x8*)(XL + fr * 592 + (32 * (ks) + 8 * q) * 2))
#pragma unroll 1
        for (int hh2 = 0; hh2 < 2; ++hh2) {
            const int h = wave + 8 * hh2; const int c = h * 64 + lane;
            unsigned char* rec = RECB + (size_t)(cidx * 64 + b_ * 16 + h) * REC;
            const bool first = (m0 & (SEQ - 1)) == 0;
            const bf16_t* pbase = P + (size_t)m0 * PCOLS + h * 64 + lane;
            unsigned rawrk[17], rawvv[9];
#pragma unroll
            for (int t = 0; t < 17; ++t) { const bf16_t* pc = pbase + (ptrdiff_t)(t - 1) * PCOLS; const bool ok = t > 0 || !first;
                const unsigned rr_ = ok ? (unsigned)pc[PC_R] : 0u, kk_ = ok ? (unsigned)pc[PC_K] : 0u, vv_ = ok ? (unsigned)pc[PC_V] : 0u;
                rawrk[t] = rr_ | (kk_ << 16); if (t & 1) rawvv[t >> 1] |= vv_ << 16; else rawvv[t >> 1] = vv_; }
            const float w0c = w0[c], a0c = a0[c], kkc = kkw[c], kac = kaw[c], rkc = rkw[c], mur = mu[c], muk = mu[1024 + c], muv = mu[2048 + c];
            bf16x8 bwf[4][2], baf[4][2];
#pragma unroll
            for (int nt = 0; nt < 4; ++nt) { const int cn = h * 64 + 16 * nt + fr;
#pragma unroll
                for (int ks = 0; ks < 2; ++ks) { bwf[nt][ks] = *(const bf16x8*)(W2T + cn * 64 + 32 * ks + 8 * q); baf[nt][ks] = *(const bf16x8*)(A2T + cn * 64 + 32 * ks + 8 * q); } }
            asm volatile("" ::: "memory");
            f32x4 accW[4], accA[4], accG[4];
#pragma unroll
            for (int nt = 0; nt < 4; ++nt) { accW[nt] = (f32x4){0.f, 0.f, 0.f, 0.f}; accA[nt] = accW[nt]; accG[nt] = accW[nt];
#pragma unroll
                for (int ks = 0; ks < 2; ++ks) { accW[nt] = __builtin_amdgcn_mfma_f32_16x16x32_bf16(AXF(ks), bwf[nt][ks], accW[nt], 0, 0, 0); accA[nt] = __builtin_amdgcn_mfma_f32_16x16x32_bf16(AXF(2 + ks), baf[nt][ks], accA[nt], 0, 0, 0); } }
#pragma unroll
            for (int n2 = 0; n2 < 2; ++n2) { bf16x8 bgf[2][5];
#pragma unroll
                for (int nn = 0; nn < 2; ++nn) { const int cn = h * 64 + 16 * (2 * n2 + nn) + fr;
#pragma unroll
                    for (int ks = 0; ks < 5; ++ks) bgf[nn][ks] = *(const bf16x8*)(G2T + cn * 160 + 32 * ks + 8 * q); }
                asm volatile("" ::: "memory");
#pragma unroll
                for (int nn = 0; nn < 2; ++nn)
#pragma unroll
                    for (int ks = 0; ks < 5; ++ks) accG[2 * n2 + nn] = __builtin_amdgcn_mfma_f32_16x16x32_bf16(AXF(4 + ks), bgf[nn][ks], accG[2 * n2 + nn], 0, 0, 0); }
            float* X3 = (float*)WS;
#pragma unroll
            for (int nt = 0; nt < 4; ++nt)
#pragma unroll
                for (int r = 0; r < 4; ++r) { const int o = (4 * q + r) * 64 + 16 * nt + fr; X3[o] = accW[nt][r]; X3[1024 + o] = accA[nt][r]; X3[2048 + o] = accG[nt][r]; }
            float cum[16], asg[16];
            { float run = 0.f;
#pragma unroll
              for (int t = 0; t < 16; ++t) { float dw = X3[t * 64 + lane], da = X3[1024 + t * 64 + lane], dg = X3[2048 + t * 64 + lane];
#if DBG_LORA
                  { const float* w2 = a.in[I_W2] + (size_t)L * 64 * RW; const float* a2 = a.in[I_A2] + (size_t)L * 64 * RW; const float* g2 = a.in[I_G2] + (size_t)L * 160 * RW;
                    float s0 = 0.f, s1 = 0.f, s2 = 0.f;
                    for (int jj = 0; jj < 64; ++jj) { s0 += bf2f(*(const bf16_t*)(XL + t * 592 + jj * 2)) * w2[(size_t)jj * RW + c]; s1 += bf2f(*(const bf16_t*)(XL + t * 592 + (64 + jj) * 2)) * a2[(size_t)jj * RW + c]; }
                    for (int jj = 0; jj < 160; ++jj) s2 += bf2f(*(const bf16_t*)(XL + t * 592 + (128 + jj) * 2)) * g2[(size_t)jj * RW + c];
                    dw = s0; da = s1; dg = s2; }
#endif
                  const float nx = -(w0c + dw); const float sp = nx > 20.f ? nx : __logf(1.0f + __expf(nx));
                  run += -__expf(-sp - 0.5f); cum[t] = run; asg[t] = __builtin_amdgcn_rcpf(1.0f + __expf(-(a0c + da)));
                  *(bf16_t*)(rec + R_G + (t * 64 + lane) * 2) = (bf16_t)f2bf(dg); } }
            asm volatile("" ::: "memory");
            const float gC = __expf(cum[15]); *(float*)(rec + R_GC + lane * 4) = gC;
            bf16_t* imgA = (bf16_t*)WS; bf16_t* imgR = (bf16_t*)(WS + 2304); bf16_t* imgB = (bf16_t*)(WS + 4608); bf16_t* imgK = (bf16_t*)(WS + 6912);
            float At[16]; unsigned vpk[8]; float bgv[4], kgv[4]; float vprev = 0.f;
            float rp = bflo(rawrk[0]), kp = bfhi(rawrk[0]), vp = bflo(rawvv[0]);
            float eprev = 1.0f;
#pragma unroll
            for (int t = 0; t < 16; ++t) {
                const float rc = bflo(rawrk[t + 1]), kc = bfhi(rawrk[t + 1]), vc = ((t + 1) & 1) ? bfhi(rawvv[(t + 1) >> 1]) : bflo(rawvv[(t + 1) >> 1]);
                const float r = rc + (rp - rc) * mur, k = kc + (kp - kc) * muk, v = vc + (vp - vc) * muv; rp = rc; kp = kc; vp = vc;
                const float asig = asg[t];
                const float kk = k * kkc; const float kkn = kk * __builtin_amdgcn_rsqf(fmaxf(wave_sum(kk * kk), 1e-24f));
                const float k2 = k * (1.0f + (asig - 1.0f) * kac); const float av = -kkn, bv = kkn * asig;
                const float bon = wave_sum(r * k2 * rkc); if (lane == 0) *(float*)(rec + R_BON + t * 4) = bon;
                const float e2 = __expf(cum[t]), e3 = __expf(-cum[t]), e4 = __expf(cum[15] - cum[t]);
                At[t] = eprev * av; eprev = e2;
                const float Rt = e2 * r, Bt = bv * e3, Kt = k2 * e3;
                imgA[t * 72 + lane] = (bf16_t)f2bf(At[t]); imgR[t * 72 + lane] = (bf16_t)f2bf(Rt); imgB[t * 72 + lane] = (bf16_t)f2bf(Bt); imgK[t * 72 + lane] = (bf16_t)f2bf(Kt);
                *(bf16_t*)(rec + R_RL2 + t * RROW + lane * 2) = (bf16_t)f2bf(Rt);
                bgv[t & 3] = bv * e4; kgv[t & 3] = k2 * e4;
                if ((t & 3) == 3) { u32x4 o; o.x = pk2(bgv[0], bgv[1]); o.y = pk2(bgv[2], bgv[3]); o.z = pk2(kgv[0], kgv[1]); o.w = pk2(kgv[2], kgv[3]); *(u32x4*)(rec + R_A2 + (lane * 4 + (t >> 2)) * 16) = o; }
                if (t & 1) vpk[t >> 1] = pk2(vprev, v); else vprev = v; }
            { u32x4 o0, o1; o0.x = vpk[0]; o0.y = vpk[1]; o0.z = vpk[2]; o0.w = vpk[3]; o1.x = vpk[4]; o1.y = vpk[5]; o1.z = vpk[6]; o1.w = vpk[7];
              *(u32x4*)(rec + R_VT + lane * 32) = o0; *(u32x4*)(rec + R_VT + lane * 32 + 16) = o1; }
            asm volatile("" ::: "memory");
            f32x4 gAB = (f32x4){0.f, 0.f, 0.f, 0.f}, gAK = gAB, gBR = gAB, gKR = gAB;
#pragma unroll
            for (int ks = 0; ks < 2; ++ks) { const int off = fr * 72 + 32 * ks + 8 * q;
                const bf16x8 fA = *(const bf16x8*)(imgA + off), fR = *(const bf16x8*)(imgR + off), fB = *(const bf16x8*)(imgB + off), fK = *(const bf16x8*)(imgK + off);
                gAB = __builtin_amdgcn_mfma_f32_16x16x32_bf16(fB, fA, gAB, 0, 0, 0); gAK = __builtin_amdgcn_mfma_f32_16x16x32_bf16(fK, fA, gAK, 0, 0, 0);
                gBR = __builtin_amdgcn_mfma_f32_16x16x32_bf16(fB, fR, gBR, 0, 0, 0); gKR = __builtin_amdgcn_mfma_f32_16x16x32_bf16(fK, fR, gKR, 0, 0, 0); }
#pragma unroll
            for (int r = 0; r < 4; ++r) { const int sI = 4 * q + r; gAB[r] = sI < fr ? gAB[r] : 0.f; gAK[r] = sI < fr ? gAK[r] : 0.f; gBR[r] = sI <= fr ? gBR[r] : 0.f; gKR[r] = sI <= fr ? gKR[r] : 0.f; }
            { u32x4 o; o.x = pk2(gBR[0], gBR[1]); o.y = pk2(gBR[2], gBR[3]); o.z = pk2(gKR[0], gKR[1]); o.w = pk2(gKR[2], gKR[3]); *(u32x4*)(rec + R_A3 + (fr * 4 + q) * 16) = o; }
            asm volatile("" ::: "memory");
            float* AKL = (float*)(WS + 9216);
#pragma unroll
            for (int r = 0; r < 4; ++r) AKL[(4 * q + r) * 16 + fr] = gAK[r];
            float Ft[16];
            { const f32x4* row = (const f32x4*)(AKL + (lane & 15) * 16);
#pragma unroll
              for (int t4 = 0; t4 < 4; ++t4) { const f32x4 v4 = row[t4]; Ft[4 * t4] = v4[0]; Ft[4 * t4 + 1] = v4[1]; Ft[4 * t4 + 2] = v4[2]; Ft[4 * t4 + 3] = v4[3]; } }
#pragma unroll
            for (int t = 1; t < 16; ++t) { float e = At[t], f = Ft[t];
#pragma unroll
                for (int s2 = 0; s2 < t; ++s2) { const float gsel = gAB[s2 & 3];
                    const float sc = __int_as_float(__builtin_amdgcn_readlane(__float_as_int(gsel), t + 16 * (s2 >> 2))); e += At[s2] * sc; f += Ft[s2] * sc; }
                At[t] = e; Ft[t] = f; }
#pragma unroll
            for (int t = 0; t < 16; ++t) *(bf16_t*)(rec + R_EL2 + t * RROW + lane * 2) = (bf16_t)f2bf(At[t]);
            asm volatile("" ::: "memory");
            float* FL = (float*)(WS + 10240);
            if (lane < 16) {
#pragma unroll
                for (int t4 = 0; t4 < 4; ++t4) *(f32x4*)(FL + lane * 16 + 4 * t4) = (f32x4){Ft[4 * t4], Ft[4 * t4 + 1], Ft[4 * t4 + 2], Ft[4 * t4 + 3]}; }
            { const float f0 = FL[(4 * q + 0) * 16 + fr], f1 = FL[(4 * q + 1) * 16 + fr], f2 = FL[(4 * q + 2) * 16 + fr], f3 = FL[(4 * q + 3) * 16 + fr];
              u32x2 o; o.x = pk2(f0, f1); o.y = pk2(f2, f3); *(u32x2*)(rec + R_FT + (fr * 4 + q) * 8) = o; }
            asm volatile("" ::: "memory");
        }
    }
#undef AXF
}
DI bf16x8 mk8(u32x2 lo, u32x2 hi) { u32x4 w; w.x = lo.x; w.y = lo.y; w.z = hi.x; w.w = hi.y; return __builtin_bit_cast(bf16x8, w); }
struct SeqOps { u32x2 e[2][2], r[2][2]; u32x4 a2[4]; u32x4 a3; u32x2 ft, vt; f32x4 gc[4]; };
DI void seq_ops_load(SeqOps& f, const LAS unsigned char* rec, int fr, int q, int i0) {
#pragma unroll
    for (int ks = 0; ks < 2; ++ks) { f.e[ks][0] = *(const LAS u32x2*)(rec + R_EL2 + fr * RROW + (32 * ks + 4 * q) * 2); f.e[ks][1] = *(const LAS u32x2*)(rec + R_EL2 + fr * RROW + (32 * ks + 16 + 4 * q) * 2);
        f.r[ks][0] = *(const LAS u32x2*)(rec + R_RL2 + fr * RROW + (32 * ks + 4 * q) * 2); f.r[ks][1] = *(const LAS u32x2*)(rec + R_RL2 + fr * RROW + (32 * ks + 16 + 4 * q) * 2); }
#pragma unroll
    for (int jt = 0; jt < 4; ++jt) { f.a2[jt] = *(const LAS u32x4*)(rec + R_A2 + ((16 * jt + fr) * 4 + q) * 16); f.gc[jt] = *(const LAS f32x4*)(rec + R_GC + (16 * jt + 4 * q) * 4); }
    f.a3 = *(const LAS u32x4*)(rec + R_A3 + (fr * 4 + q) * 16); f.ft = *(const LAS u32x2*)(rec + R_FT + (fr * 4 + q) * 8); f.vt = *(const LAS u32x2*)(rec + R_VT + ((i0 + fr) * 16 + 4 * q) * 2);
}
DI void rwkv_seq_phase(const Args& a, unsigned char* lds, float* yout, const float* gng, const float* gnb, bf16_t* yfin) {
    const int tidx_ = otid();
    const int tid = tidx_, wave = __builtin_amdgcn_readfirstlane(tid >> 6), lane = tid & 63, fr = lane & 15, q = lane >> 4;
    constexpr int NR = 8, DEPTH_ = 6, NCHK = 256;
    LAS unsigned char* ring = (LAS unsigned char*)lds;
    LAS float* ybuf = (LAS float*)(ring + NR * REC);
    for (int bh = blockIdx.x; bh < NB * 16; bh += gridDim.x) {
        const unsigned char* rec0 = a.ws + OFF_SCR + (size_t)bh * REC;
        const int hd = bh & 15;
        asm volatile("s_waitcnt vmcnt(0) lgkmcnt(0)" ::: "memory"); __builtin_amdgcn_s_barrier();
        if (wave >= 4) {
            const int lw = wave - 4;
            const float gg = yfin ? gng[hd * 64 + lane] : 0.f, gb = yfin ? gnb[hd * 64 + lane] : 0.f;
            bf16_t* Yo = yfin + ((size_t)(bh >> 4) * SEQ) * D + hd * 64 + lane;
#define SEQ_ISSUE(cc) do { const unsigned char* g_ = rec0 + (size_t)(cc) * 64 * REC; LAS unsigned char* l_ = ring + ((cc) & (NR - 1)) * REC; \
            _Pragma("unroll") for (int i_ = 0; i_ < 4; ++i_) { int pc_ = i_ * 4 + lw; if (pc_ >= 15) pc_ = lw; \
                __builtin_amdgcn_global_load_lds((const unsigned*)(g_ + pc_ * 1024 + lane * 16), (LAS unsigned*)(l_ + pc_ * 1024), 16, 0, 0); } } while (0)
#define SEQ_FINALIZE(cf) do { const LAS unsigned char* rc_ = ring + ((cf) & (NR - 1)) * REC; const LAS float* yb_ = ybuf + ((cf) & 1) * 1024; \
            const u32x2 vv_ = *(const LAS u32x2*)(rc_ + R_VT + (lane * 16 + 4 * lw) * 2); \
            float y_[4], rd_[8]; \
            _Pragma("unroll") for (int tt_ = 0; tt_ < 4; ++tt_) { y_[tt_] = yb_[(4 * lw + tt_) * 64 + lane]; rd_[tt_] = y_[tt_]; rd_[4 + tt_] = y_[tt_] * y_[tt_]; } \
            wave_sum8(rd_);        \
            _Pragma("unroll") for (int tt_ = 0; tt_ < 4; ++tt_) { const int t_ = 4 * lw + tt_; \
                const float mean_ = rd_[tt_] * (1.0f / 64.0f); const float var_ = fmaxf(rd_[4 + tt_] * (1.0f / 64.0f) - mean_ * mean_, 0.f); \
                const float yn_ = (y_[tt_] - mean_) * __builtin_amdgcn_rsqf(var_ + 64e-5f) * gg + gb; \
                const float bon_ = *(const LAS float*)(rc_ + R_BON + t_ * 4); const float g_ = bf2f(*(const LAS bf16_t*)(rc_ + R_G + (t_ * 64 + lane) * 2)); \
                const unsigned vw_ = (tt_ & 2) ? vv_.y : vv_.x; const float v_ = (tt_ & 1) ? bfhi(vw_) : bflo(vw_); \
                Yo[(size_t)(16 * (cf) + t_) * D] = (bf16_t)f2bf((yn_ + bon_ * v_) * g_); } } while (0)
#pragma unroll 1
            for (int cc = 0; cc < DEPTH_; ++cc) SEQ_ISSUE(cc);
            asm volatile("s_waitcnt vmcnt(16)" ::: "memory");
            __builtin_amdgcn_s_barrier();
#pragma unroll 1
            for (int c = 0; c < NCHK; ++c) {
                if (yfin && c > 0) SEQ_FINALIZE(c - 1);
                if (c + DEPTH_ < NCHK) { SEQ_ISSUE(c + DEPTH_); asm volatile("s_waitcnt vmcnt(16)" ::: "memory"); }
                else asm volatile("s_waitcnt vmcnt(0)" ::: "memory");
                asm volatile("s_waitcnt lgkmcnt(0)" ::: "memory");
                __builtin_amdgcn_s_barrier();
            }
            if (yfin) SEQ_FINALIZE(NCHK - 1);
#undef SEQ_ISSUE
#undef SEQ_FINALIZE
        } else {
            const int i0 = wave * 16;
            float* Yp = yout + (size_t)(bh >> 4) * SEQ * RW + hd * 64 + i0 + fr;
            f32x4 S[4];
#pragma unroll
            for (int jt = 0; jt < 4; ++jt) S[jt] = (f32x4){0.f, 0.f, 0.f, 0.f};
            __builtin_amdgcn_s_barrier();
            SeqOps cur, nxt; seq_ops_load(cur, ring, fr, q, i0);
#pragma unroll 1
            for (int c = 0; c < NCHK; ++c) {
                if (c + 1 < NCHK) seq_ops_load(nxt, ring + ((c + 1) & (NR - 1)) * REC, fr, q, i0); else nxt = cur;
                bf16x8 sh[2];
#pragma unroll
                for (int ks = 0; ks < 2; ++ks) { u32x4 hw; hw.x = pk2(S[2 * ks][0], S[2 * ks][1]); hw.y = pk2(S[2 * ks][2], S[2 * ks][3]); hw.z = pk2(S[2 * ks + 1][0], S[2 * ks + 1][1]); hw.w = pk2(S[2 * ks + 1][2], S[2 * ks + 1][3]); sh[ks] = __builtin_bit_cast(bf16x8, hw); }
                const u32x2 z2 = {0u, 0u}; const f32x4 zz = (f32x4){0.f, 0.f, 0.f, 0.f};
                f32x4 Wk[2], Yk[2];
#pragma unroll
                for (int ks = 0; ks < 2; ++ks) { Wk[ks] = __builtin_amdgcn_mfma_f32_16x16x32_bf16(mk8(cur.e[ks][0], cur.e[ks][1]), sh[ks], zz, 0, 0, 0); Yk[ks] = __builtin_amdgcn_mfma_f32_16x16x32_bf16(mk8(cur.r[ks][0], cur.r[ks][1]), sh[ks], zz, 0, 0, 0); }
                const f32x4 Wv = __builtin_amdgcn_mfma_f32_16x16x32_bf16(mk8(cur.ft, z2), mk8(cur.vt, z2), zz, 0, 0, 0);
                const f32x4 W = (Wk[0] + Wk[1]) + Wv; f32x4 Y = Yk[0] + Yk[1];
                u32x2 wp; wp.x = pk2(W[0], W[1]); wp.y = pk2(W[2], W[3]);
                const bf16x8 b2 = mk8(wp, cur.vt);
#pragma unroll
                for (int jt = 0; jt < 4; ++jt) S[jt] = __builtin_amdgcn_mfma_f32_16x16x32_bf16(__builtin_bit_cast(bf16x8, cur.a2[jt]), b2, S[jt] * cur.gc[jt], 0, 0, 0);
                Y = __builtin_amdgcn_mfma_f32_16x16x32_bf16(__builtin_bit_cast(bf16x8, cur.a3), b2, Y, 0, 0, 0);
                if (yfin) {
#pragma unroll
                    for (int r = 0; r < 4; ++r) ybuf[(c & 1) * 1024 + (4 * q + r) * 64 + i0 + fr] = Y[r];
                } else {
#pragma unroll
                    for (int r = 0; r < 4; ++r) Yp[(size_t)(16 * c + 4 * q + r) * RW] = Y[r];
                }
                asm volatile("s_waitcnt lgkmcnt(0)" ::: "memory");
                __builtin_amdgcn_s_barrier();
                cur = nxt;
            }
        }
    }
}
DI void rwkv_fin2_phase(const Args& a, int L) {
    const int tidx_ = otid();
    const int wave = __builtin_amdgcn_readfirstlane(tidx_ >> 6), lane = tidx_ & 63;
    const float* Yraw = (const float*)(a.ws + OFF_X); bf16_t* Y = (bf16_t*)(a.ws + OFF_Y);
    const float* gng = a.in[I_GNG] + L * RW; const float* gnb = a.in[I_GNB] + L * RW;
    for (int u = blockIdx.x * 8 + wave; u < NB * 16 * 256; u += gridDim.x * 8) {
        const int cidx = u & 255, bh = u >> 8, h = bh & 15, b_ = bh >> 4; const int c = h * 64 + lane;
        const unsigned char* rec = a.ws + OFF_SCR + (size_t)(cidx * 64 + bh) * REC;
        const u32x4 v0 = *(const u32x4*)(rec + R_VT + lane * 32), v1 = *(const u32x4*)(rec + R_VT + lane * 32 + 16);
        const unsigned vw[8] = {v0.x, v0.y, v0.z, v0.w, v1.x, v1.y, v1.z, v1.w};
        const float gg = gng[c], gb = gnb[c];
#pragma unroll
        for (int t = 0; t < 16; ++t) { const size_t m = (size_t)b_ * SEQ + cidx * 16 + t;
            const float y = Yraw[m * RW + c];
            const float mean = wave_sum(y) * (1.0f / 64.0f); const float d = y - mean; const float var = wave_sum(d * d) * (1.0f / 64.0f);
            const float yn = d * __builtin_amdgcn_rsqf(var + 64e-5f) * gg + gb;
            const float bon = *(const float*)(rec + R_BON + t * 4); const float g = bf2f(*(const bf16_t*)(rec + R_G + (t * 64 + lane) * 2));
            const float v = (t & 1) ? bfhi(vw[t >> 1]) : bflo(vw[t >> 1]);
            Y[m * D + c] = (bf16_t)f2bf((yn + bon * v) * g); }
    }
}
DI void dbg_compare_phase(const Args& a) {
    const int tidx_ = otid();
    const float* y0 = (const float*)(a.ws + OFF_X); const float* y1 = y0 + (size_t)M * RW; float* acc = (float*)(a.ws + OFF_CTL) + 2048;
    float s0 = 0.f, s1 = 0.f, s2 = 0.f, s3 = 0.f;
    for (size_t i = (size_t)blockIdx.x * 512 + tidx_; i < (size_t)M * RW; i += (size_t)gridDim.x * 512) { const float o = y0[i], d = y1[i] - o; const int tok = (int)((i / RW) & (SEQ - 1));
        s0 += d * d; s1 += o * o; if (tok < 16) { s2 += d * d; s3 += o * o; } }
    s0 = wave_sum(s0); s1 = wave_sum(s1); s2 = wave_sum(s2); s3 = wave_sum(s3);
    if ((tidx_ & 63) == 0) { atomicAdd(acc + 0, s0); atomicAdd(acc + 1, s1); atomicAdd(acc + 2, s2); atomicAdd(acc + 3, s3); }
}
DI void dbg_encode_phase(const Args& a) {
    const int tidx_ = otid();
    float* acc = (float*)(a.ws + OFF_CTL) + 2048;
    const float s0 = __hip_atomic_load(acc + 0, __ATOMIC_RELAXED, __HIP_MEMORY_SCOPE_AGENT), s1 = __hip_atomic_load(acc + 1, __ATOMIC_RELAXED, __HIP_MEMORY_SCOPE_AGENT);
    const float s2 = __hip_atomic_load(acc + 2, __ATOMIC_RELAXED, __HIP_MEMORY_SCOPE_AGENT), s3 = __hip_atomic_load(acc + 3, __ATOMIC_RELAXED, __HIP_MEMORY_SCOPE_AGENT);
    const float e1 = sqrtf(s0 / fmaxf(s1, 1e-30f)), e2 = sqrtf(s2 / fmaxf(s3, 1e-30f));
    for (size_t i = (size_t)blockIdx.x * 512 + tidx_; i < (size_t)M * D; i += (size_t)gridDim.x * 512) { float v = a.out[i] * (1.0f + e1); if (i == 0) v += 1000.0f * e2; a.out[i] = v; }
}
DI unsigned f2ord(float f) { const unsigned u = __builtin_bit_cast(unsigned, f); return (u & 0x80000000u) ? ~u : (u | 0x80000000u); }
DI float xrow16_sum(float x) {
    auto p = __builtin_amdgcn_permlane16_swap(__float_as_uint(x), __float_as_uint(x), false, false);
    x = __uint_as_float(p[0]) + __uint_as_float(p[1]);
    auto q = __builtin_amdgcn_permlane32_swap(__float_as_uint(x), __float_as_uint(x), false, false);
    return __uint_as_float(q[0]) + __uint_as_float(q[1]);
}
template <int CTRL> DI int dpp_i(int x) { return __builtin_amdgcn_update_dpp(0, x, CTRL, 0xF, 0xF, true); }
DI int wave_sum_i(int x) {
    x += dpp_i<0xB1>(x); x += dpp_i<0x4E>(x); x += dpp_i<0x141>(x); x += dpp_i<0x140>(x);
    auto p = __builtin_amdgcn_permlane16_swap((unsigned)x, (unsigned)x, false, false); x = (int)p[0] + (int)p[1];
    auto q = __builtin_amdgcn_permlane32_swap((unsigned)x, (unsigned)x, false, false); return (int)q[0] + (int)q[1];
}
DI void indexer_phase(const Args& a, unsigned char* lds, int vb, int nvb) {
    const int tidx_ = otid();
    const int tid = tidx_, wave = __builtin_amdgcn_readfirstlane(tid >> 6), lane = tid & 63, hh = lane & 15, kq = lane >> 4;
    const bf16_t* P = (const bf16_t*)(a.ws + OFF_P); const bf16_t* KI = (const bf16_t*)(a.ws + OFF_KI); unsigned long long* BMk = (unsigned long long*)(a.ws + OFF_BM);
    constexpr int STG = 256 * 128;
    unsigned long long* wbuf = (unsigned long long*)(lds + 2 * STG + wave * 512);
    const int srow = tid >> 3, sch = tid & 7;
    const int wr_off = srow * 128 + ((sch ^ (srow & 7)) << 4);
    const int rd0 = hh * 128 + ((kq ^ (hh & 7)) << 4), rd1 = hh * 128 + (((kq + 4) ^ (hh & 7)) << 4);
    for (int J0 = vb * 2; J0 < NB * 512; J0 += nvb * 2)
#pragma unroll 1
    for (int ii = 0; ii < 2; ++ii) {
        const int J = J0 + ii; const int b_ = J >> 9, j = J & 511; const int qg = (j & 1) ? 511 - (j >> 1) : (j >> 1);
        const int t0 = qg * 8, t = t0 + wave, nk = t0 + 8; const size_t m = (size_t)b_ * SEQ + t;
        const int nst = (nk + 255) >> 8;
        bf16x8 aq[2];
        aq[0] = *(const bf16x8*)(P + m * PCOLS + PC_QI + hh * 64 + 8 * kq); aq[1] = *(const bf16x8*)(P + m * PCOLS + PC_QI + hh * 64 + 32 + 8 * kq);
        float blo[4], bhi[4];
#pragma unroll
        for (int r = 0; r < 4; ++r) { const bool pos = bf2f(P[m * PCOLS + PC_WI + 4 * kq + r]) >= 0.f; blo[r] = pos ? 0.f : -__builtin_inff(); bhi[r] = pos ? __builtin_inff() : 0.f; }
        { const float wrow = bf2f(P[m * PCOLS + PC_WI + hh]) * 0.03125f;
#pragma unroll
          for (int ks = 0; ks < 2; ++ks) { const u32x4 w4 = __builtin_bit_cast(u32x4, aq[ks]); u32x4 o4;
              o4.x = pk2(bflo(w4.x) * wrow, bfhi(w4.x) * wrow); o4.y = pk2(bflo(w4.y) * wrow, bfhi(w4.y) * wrow); o4.z = pk2(bflo(w4.z) * wrow, bfhi(w4.z) * wrow); o4.w = pk2(bflo(w4.w) * wrow, bfhi(w4.w) * wrow);
              aq[ks] = __builtin_bit_cast(bf16x8, o4); } }
        unsigned sc[64];
        const bf16_t* kig = KI + ((size_t)b_ * SEQ + srow) * 64 + sch * 8;
#pragma unroll 1
        for (int rep21 = 0; rep21 < ((REP_MASK >> 21) & 1u) + 1; ++rep21) {
#pragma unroll
        for (int r = 0; r < 64; ++r) sc[r] = 0u;
        u32x4 kp[4];
#pragma unroll
        for (int q = 0; q < 4; ++q) kp[q] = *(const u32x4*)(kig + (size_t)q * 64 * 64);
        __syncthreads();
        asm volatile("" :: "v"(aq[0]), "v"(aq[1]), "v"(blo[0]), "v"(blo[1]), "v"(blo[2]), "v"(blo[3]));
#pragma unroll 1
        for (int st = 0; st < nst; ++st) {
            const int k0 = st * 256;
            unsigned char* sb = lds + (st & 1) * STG;
#pragma unroll
            for (int q = 0; q < 4; ++q) *(u32x4*)(sb + q * 64 * 128 + wr_off) = kp[q];
            __syncthreads();
            if (st + 1 < nst) {
#pragma unroll
                for (int q = 0; q < 4; ++q) kp[q] = *(const u32x4*)(kig + (size_t)(k0 + 256 + q * 64) * 64);
            }
#pragma unroll
            for (int r = 0; r < 60; ++r) sc[r] = sc[r + 4];
#pragma unroll
            for (int cc = 0; cc < 4; ++cc) {
                const int kc = k0 + cc * 64;
                unsigned res = 0u;
                {
                    float sv[4];
#pragma unroll
                    for (int sub = 0; sub < 4; ++sub) {
                        const unsigned char* kb = sb + (cc * 64 + sub * 16) * 128;
                        const bf16x8 b0 = *(const bf16x8*)(kb + rd0), b1 = *(const bf16x8*)(kb + rd1);
                        f32x4 acc = (f32x4){0.f, 0.f, 0.f, 0.f};
                        acc = __builtin_amdgcn_mfma_f32_16x16x32_bf16(aq[0], b0, acc, 0, 0, 0);
                        acc = __builtin_amdgcn_mfma_f32_16x16x32_bf16(aq[1], b1, acc, 0, 0, 0);
                        sv[sub] = (__builtin_amdgcn_fmed3f(acc[0], blo[0], bhi[0]) + __builtin_amdgcn_fmed3f(acc[1], blo[1], bhi[1])) + (__builtin_amdgcn_fmed3f(acc[2], blo[2], bhi[2]) + __builtin_amdgcn_fmed3f(acc[3], blo[3], bhi[3]));
                    }
                    auto p01 = __builtin_amdgcn_permlane16_swap(__float_as_uint(sv[0]), __float_as_uint(sv[1]), false, false);
                    auto p23 = __builtin_amdgcn_permlane16_swap(__float_as_uint(sv[2]), __float_as_uint(sv[3]), false, false);
                    const float x01 = __uint_as_float(p01[0]) + __uint_as_float(p01[1]), x23 = __uint_as_float(p23[0]) + __uint_as_float(p23[1]);
                    auto pf = __builtin_amdgcn_permlane32_swap(__float_as_uint(x01), __float_as_uint(x23), false, false);
                    const float tot = __uint_as_float(pf[0]) + __uint_as_float(pf[1]);
                    res = (kc + lane <= t) ? f2ord(tot) : 0u;
                }
                sc[60 + cc] = res;
            }
        }
        }
        const int roff = 64 - 4 * nst;
#pragma unroll 1
        for (int rep22 = 0; rep22 < ((REP_MASK >> 22) & 1u) + 1; ++rep22) {
        if (t + 1 > 256) {
            unsigned Hh[32], Ll[32];
#pragma unroll
            for (int p = 0; p < 32; ++p) { Hh[p] = __builtin_amdgcn_perm(sc[2 * p + 1], sc[2 * p], 0x07060302u); Ll[p] = __builtin_amdgcn_perm(sc[2 * p + 1], sc[2 * p], 0x05040100u); }
            const int poff = roff >> 1;
            const unsigned one2 = 0x00010001u;
#define PK_COUNT(ARR, CM1, OUT) do { unsigned c2_[4] = {0u, 0u, 0u, 0u}; _Pragma("unroll") for (int p8 = 0; p8 < 4; ++p8) if (p8 * 8 + 7 >= poff) { _Pragma("unroll") for (int pp = 0; pp < 8; ++pp) { unsigned d_; \
                asm("v_pk_sub_u16 %0, %1, %2 clamp" : "=v"(d_) : "v"(ARR[p8 * 8 + pp]), "s"(CM1)); asm("v_pk_min_u16 %0, %1, %2" : "=v"(d_) : "v"(d_), "s"(one2)); asm("v_pk_add_u16 %0, %1, %2" : "=v"(c2_[pp & 3]) : "v"(c2_[pp & 3]), "v"(d_)); } } \
                const unsigned cs_ = (c2_[0] + c2_[1]) + (c2_[2] + c2_[3]);        \
                OUT = __builtin_amdgcn_readfirstlane(wave_sum_i((int)((cs_ & 0xffffu) + (cs_ >> 16)))); } while (0)
            unsigned Th = 0u;
#pragma unroll 1
            for (int bit = 15; bit >= 0; --bit) { const unsigned cand = Th | (1u << bit); const unsigned cm1 = cand * one2 - one2; int cnt; PK_COUNT(Hh, cm1, cnt); if (cnt >= 256) Th = cand; }
            int cgt16 = 0; if (Th != 0xffffu) { const unsigned cm1 = Th * one2; PK_COUNT(Hh, cm1, cgt16); }
            const int need16 = 256 - cgt16;
            { const unsigned T2 = Th * one2; const unsigned allones = 0xffffffffu;
#pragma unroll
              for (int p = 0; p < 32; ++p) { unsigned x = Hh[p] ^ T2, ne, keep, msk;
                  asm("v_pk_min_u16 %0, %1, %2" : "=v"(ne) : "v"(x), "s"(one2)); asm("v_pk_sub_u16 %0, %1, %2" : "=v"(keep) : "s"(one2), "v"(ne)); asm("v_pk_mul_lo_u16 %0, %1, %2" : "=v"(msk) : "v"(keep), "s"(allones));
                  Ll[p] &= msk; } }
            unsigned Tl = 0u;
#pragma unroll 1
            for (int bit = 15; bit >= 0; --bit) { const unsigned cand = Tl | (1u << bit); const unsigned cm1 = cand * one2 - one2; int cnt; PK_COUNT(Ll, cm1, cnt); if (cnt >= need16) Tl = cand; }
#undef PK_COUNT
            const unsigned T = (Th << 16) | Tl;
            int cge = 0;
#pragma unroll
            for (int r8 = 0; r8 < 8; ++r8) if (r8 * 8 + 7 >= roff) {
#pragma unroll
                for (int r = 0; r < 8; ++r) cge += (sc[r8 * 8 + r] >= T) ? 1 : 0; }
            cge = __builtin_amdgcn_readfirstlane(wave_sum_i(cge));
            if (lane < roff) wbuf[lane] = 0ull; else wbuf[lane] = 0ull;
            if (cge == 256) {
#pragma unroll
                for (int r8 = 0; r8 < 8; ++r8) {
#pragma unroll
                    for (int r = 0; r < 8; ++r) { const unsigned long long word = __ballot(sc[r8 * 8 + r] >= T); if (lane == 0 && r8 * 8 + r >= roff) wbuf[r8 * 8 + r - roff] = word; }
                    __builtin_amdgcn_sched_barrier(0); }
            } else {
                int cgt = 0;
#pragma unroll
                for (int r8 = 0; r8 < 8; ++r8) {
#pragma unroll
                    for (int r = 0; r < 8; ++r) cgt += __builtin_popcountll(__ballot(sc[r8 * 8 + r] > T));
                    __builtin_amdgcn_sched_barrier(0); }
                int need = 256 - cgt;
#pragma unroll
                for (int r8 = 0; r8 < 8; ++r8) {
#pragma unroll
                    for (int r = 0; r < 8; ++r) { const unsigned long long gt = __ballot(sc[r8 * 8 + r] > T); unsigned long long eq = __ballot(sc[r8 * 8 + r] == T); const int ce = __builtin_popcountll(eq);
                        unsigned long long take;
                        if (ce <= need) { take = eq; need -= ce; }
                        else { take = 0ull; for (; need > 0; --need) { const unsigned long long low = eq & (0ull - eq); take |= low; eq ^= low; } }
                        const unsigned long long word = gt | take; if (lane == 0 && r8 * 8 + r >= roff) wbuf[r8 * 8 + r - roff] = word; }
                    __builtin_amdgcn_sched_barrier(0); }
            }
        } else {
            wbuf[lane] = 0ull;
#pragma unroll
            for (int r8 = 0; r8 < 8; ++r8) {
#pragma unroll
                for (int r = 0; r < 8; ++r) { const unsigned long long word = __ballot(sc[r8 * 8 + r] != 0u); if (lane == 0 && r8 * 8 + r >= roff) wbuf[r8 * 8 + r - roff] = word; }
                __builtin_amdgcn_sched_barrier(0); }
        }
        }
        BMk[m * 64 + lane] = wbuf[lane];
    }
}
DI void attn_phase(const Args& a, unsigned char* lds) {
    const int tidx_ = otid();
    const int tid = tidx_, wave = __builtin_amdgcn_readfirstlane(tid >> 6), lane = tid & 63, ql = lane & 31, hf = lane >> 5;
    const bf16_t* P = (const bf16_t*)(a.ws + OFF_P); const bf16_t* VT = (const bf16_t*)(a.ws + OFF_VT); const unsigned long long* BMk = (const unsigned long long*)(a.ws + OFF_BM);
    const float* biasd = (const float*)(a.ws + OFF_BIAS); bf16_t* Y = (bf16_t*)(a.ws + OFF_Y);
    unsigned char* Kl = lds; unsigned char* Vl = lds + 64 * 144; float* biasl = (float*)(lds + 2 * 64 * 144);
    const float NEG_INF = -__builtin_inff();
    for (int cu = blockIdx.x; cu < 256; cu += gridDim.x)
#pragma unroll 1
    for (int ui = 0; ui < 2; ++ui) {
        const int bh = cu >> 3, s8 = cu & 7, qb = ui == 0 ? s8 : 15 - s8, b_ = bh >> 3, h = bh & 7;
        const int q0w = qb * 256 + 32 * wave, q = q0w + ql; const size_t m = (size_t)b_ * SEQ + q;
        __syncthreads();
        if (tid < 128) biasl[tid] = biasd[h * 128 + tid];
        bf16x8 qf[4];
#pragma unroll
        for (int ks = 0; ks < 4; ++ks) qf[ks] = *(const bf16x8*)(P + m * PCOLS + PC_AQ + h * 64 + 16 * ks + 8 * hf);
        f32x16 O0, O1;
#pragma unroll
        for (int r = 0; r < 16; ++r) { O0[r] = 0.f; O1[r] = 0.f; }
        float mrun = NEG_INF, lrun = 0.f;
        const int nkt = 4 * (qb + 1);
        const int srow = tid >> 3, sch = tid & 7;
        const bf16_t* kbase = P + ((size_t)b_ * SEQ + srow) * PCOLS + PC_AK + h * 64 + sch * 8;
        const bf16_t* vbase = VT + ((size_t)(b_ * 8 + h) * 64 + srow) * SEQ + sch * 8;
#define ATT_COMPUTE \
            const int k0 = kt * 64; \
            if (k0 <= q0w + 31) { \
 \
                f32x16 sa[2]; \
_Pragma("unroll") \
                for (int sub = 0; sub < 2; ++sub) { \
_Pragma("unroll") \
                    for (int r = 0; r < 16; ++r) sa[sub][r] = 0.f; } \
_Pragma("unroll") \
                for (int ks = 0; ks < 4; ++ks) \
_Pragma("unroll") \
                    for (int sub = 0; sub < 2; ++sub) { const bf16x8 kf = *(const bf16x8*)(Kl + (32 * sub + ql) * 144 + (16 * ks + 8 * hf) * 2); \
                        sa[sub] = __builtin_amdgcn_mfma_f32_32x32x16_bf16(kf, qf[ks], sa[sub], 0, 0, 0); } \
                constexpr float C1 = 0.125f * 1.4426950408889634f; constexpr unsigned NINF_BITS = 0xff800000u; \
                const unsigned b31u = __float_as_uint(biasl[127] * 1.4426950408889634f); \
                const bool far = (q0w - (k0 + 63)) >= 113; \
                float x[2][16]; float mx = NEG_INF; \
_Pragma("unroll") \
                for (int sub = 0; sub < 2; ++sub) { \
                    const int w32 = (int)(((unsigned)(bm >> (32 * sub))) >> (4 * hf)); \
                    if (far) { \
_Pragma("unroll") \
                        for (int r = 0; r < 16; ++r) { const int ro = (r & 3) + 8 * (r >> 2); const unsigned tm = (unsigned)__builtin_amdgcn_sbfe(w32, ro, 1); \
                            x[sub][r] = sa[sub][r] * C1 + __uint_as_float((tm & b31u) | (~tm & NINF_BITS)); } \
                    } else { \
_Pragma("unroll") \
                        for (int r = 0; r < 16; ++r) { const int ro = (r & 3) + 8 * (r >> 2); int dd = q - (k0 + 32 * sub + ro + 4 * hf); dd = dd < 0 ? 0 : (dd > 127 ? 127 : dd); \
                            const unsigned tm = (unsigned)__builtin_amdgcn_sbfe(w32, ro, 1); const unsigned bu = __float_as_uint(biasl[dd] * 1.4426950408889634f); \
                            x[sub][r] = sa[sub][r] * C1 + __uint_as_float((tm & bu) | (~tm & NINF_BITS)); } \
                    } \
_Pragma("unroll") \
                    for (int r = 0; r < 16; r += 2) mx = fmaxf(mx, fmaxf(x[sub][r], x[sub][r + 1])); \
                } \
                { auto pm = __builtin_amdgcn_permlane32_swap(__float_as_uint(mx), __float_as_uint(mx), false, false); mx = fmaxf(__uint_as_float(pm[0]), __uint_as_float(pm[1])); } \
                const float mnew = fmaxf(mrun, mx); const float msafe = (mnew == NEG_INF) ? 0.f : mnew; \
                float lsum = 0.f; \
_Pragma("unroll") \
                for (int sub = 0; sub < 2; ++sub) \
_Pragma("unroll") \
                    for (int r = 0; r < 16; ++r) { x[sub][r] = __builtin_amdgcn_exp2f(x[sub][r] - msafe); lsum += x[sub][r]; } \
                if (__builtin_amdgcn_ballot_w64(mnew > mrun) != 0ull) { \
                    const float alpha = __builtin_amdgcn_exp2f(mrun - msafe); \
                    lrun = lrun * alpha + lsum; mrun = mnew; \
_Pragma("unroll") \
                    for (int r = 0; r < 16; ++r) { O0[r] *= alpha; O1[r] *= alpha; } \
                } else lrun += lsum; \
_Pragma("unroll") \
                for (int sub = 0; sub < 2; ++sub) \
_Pragma("unroll") \
                    for (int s = 0; s < 2; ++s) { \
                        u32x4 pw; pw.x = pk2(x[sub][8 * s + 0], x[sub][8 * s + 1]); pw.y = pk2(x[sub][8 * s + 2], x[sub][8 * s + 3]); pw.z = pk2(x[sub][8 * s + 4], x[sub][8 * s + 5]); pw.w = pk2(x[sub][8 * s + 6], x[sub][8 * s + 7]); \
                        const bf16x8 pf = __builtin_bit_cast(bf16x8, pw); \
                        const int kcol = (32 * sub + 16 * s + 4 * hf) * 2; \
                        { const u32x2 lo = *(const u32x2*)(Vl + ql * 144 + kcol), hi = *(const u32x2*)(Vl + ql * 144 + kcol + 16); \
                          u32x4 vw; vw.x = lo.x; vw.y = lo.y; vw.z = hi.x; vw.w = hi.y; \
                          O0 = __builtin_amdgcn_mfma_f32_32x32x16_bf16(__builtin_bit_cast(bf16x8, vw), pf, O0, 0, 0, 0); } \
                        { const u32x2 lo = *(const u32x2*)(Vl + (32 + ql) * 144 + kcol), hi = *(const u32x2*)(Vl + (32 + ql) * 144 + kcol + 16); \
                          u32x4 vw; vw.x = lo.x; vw.y = lo.y; vw.z = hi.x; vw.w = hi.y; \
                          O1 = __builtin_amdgcn_mfma_f32_32x32x16_bf16(__builtin_bit_cast(bf16x8, vw), pf, O1, 0, 0, 0); } \
                    } \
            } \

        u32x4 kregA = *(const u32x4*)(kbase), vregA = *(const u32x4*)(vbase); unsigned long long bmA = BMk[m * 64];
        u32x4 kregB = *(const u32x4*)(kbase + (size_t)64 * PCOLS), vregB = *(const u32x4*)(vbase + 64); unsigned long long bmB = BMk[m * 64 + 1];
        asm volatile("" :: "v"(qf[0]), "v"(qf[1]), "v"(qf[2]), "v"(qf[3]));
#define ATT_TILE(KREG, VREG, BMR, KT) do { const int kt = (KT); \
            __syncthreads(); \
            *(u32x4*)(Kl + srow * 144 + sch * 16) = KREG; *(u32x4*)(Vl + srow * 144 + sch * 16) = VREG; \
            __syncthreads(); \
            const unsigned long long bm = BMR; \
            if (kt + 2 < nkt) { KREG = *(const u32x4*)(kbase + (size_t)(kt + 2) * 64 * PCOLS); VREG = *(const u32x4*)(vbase + (kt + 2) * 64); BMR = BMk[m * 64 + kt + 2]; } \
            ATT_COMPUTE } while (0)
#pragma unroll 1
        for (int kt2 = 0; kt2 < nkt; kt2 += 2) { ATT_TILE(kregA, vregA, bmA, kt2); ATT_TILE(kregB, vregB, bmB, kt2 + 1); }
#undef ATT_TILE
#undef ATT_COMPUTE
        float ltot; { auto pl = __builtin_amdgcn_permlane32_swap(__float_as_uint(lrun), __float_as_uint(lrun), false, false); ltot = __uint_as_float(pl[0]) + __uint_as_float(pl[1]); } const float inv = 1.0f / ltot;
        bf16_t* yo = Y + m * D + 1536 + h * 64;
#pragma unroll
        for (int g4 = 0; g4 < 4; ++g4) { const int d0 = 8 * g4 + 4 * hf;
            u32x2 o0; o0.x = pk2(O0[4 * g4 + 0] * inv, O0[4 * g4 + 1] * inv); o0.y = pk2(O0[4 * g4 + 2] * inv, O0[4 * g4 + 3] * inv); *(u32x2*)(yo + d0) = o0;
            u32x2 o1; o1.x = pk2(O1[4 * g4 + 0] * inv, O1[4 * g4 + 1] * inv); o1.y = pk2(O1[4 * g4 + 2] * inv, O1[4 * g4 + 3] * inv); *(u32x2*)(yo + 32 + d0) = o1; }
    }
}

constexpr int NPH = 16;
constexpr int NGP = 1 + DEPTH * NPH;
__global__ void __launch_bounds__(512, 2) fwd(Args args) {
    extern __shared__ __attribute__((aligned(16))) unsigned char lds[];
    const int tid = threadIdx.x;
    volatile LAS unsigned* MISC = (volatile LAS unsigned*)((LAS unsigned char*)lds + MISC_OFF);
    for (int u = tid; u < (LDS_BYTES - 131072) / 4; u += 512) ((LAS unsigned*)((LAS unsigned char*)lds + 131072))[u] = 0u;
    __syncthreads();
    unsigned char* ws = args.ws;
    XcdBarrier bar; bar.bar = (unsigned*)(ws + OFF_CTL) + 4096; bar.x = 0; bar.st = nullptr;
    if (!MK_PER_PHASE) bar = xcd_barrier_post((unsigned*)(ws + OFF_CTL) + 4096, MISC + 8);
    const int lo = args.lo, hi = args.hi;
    LAS unsigned char* ldsl = (LAS unsigned char*)lds;
    bf16_t* XB = (bf16_t*)(ws + OFF_XB); float* X = (float*)(ws + OFF_X); float* T = (float*)(ws + OFF_T); float* ST = (float*)(ws + OFF_ST); bf16_t* Pb = (bf16_t*)(ws + OFF_P);
    bf16_t* H = (bf16_t*)(ws + OFF_SCR); bf16_t* Yb = (bf16_t*)(ws + OFF_Y); bf16_t* MG = (bf16_t*)(ws + OFF_MG);
    int gp = 0;
#define RUN() (lo <= gp && gp < hi)
#define SEAM() do { if (RUN() && gp + 1 < hi) xcd_barrier(bar); ++gp; } while (0)
#define PHASE(k, ...) do { if (PHON(k) && RUN()) { __VA_ARGS__; if ((REP_MASK >> (k)) & 1u) { xcd_barrier(bar); __VA_ARGS__; } } SEAM(); } while (0)
    if (RUN()) init_phase(args);
    SEAM();
#pragma unroll 1
    for (int L = 0; L < DEPTH; ++L) {
        PHASE(0, convert_phase(args, L, lds););
        PHASE(1, { pg8::Gemm g{XB, (const bf16_t*)(ws + OFF_W1A), D, D}; pg8::StaticOrder S; S.init(M, 2 * FF, D, gridDim.x, blockIdx.x); pg8::EpiSwiglu E{H, FF}; pg8::gemm_phase(ldsl, g, S, E); });
        PHASE(2, { pg8::Gemm g{H, (const bf16_t*)(ws + OFF_W1B), FF, FF}; pg8::StaticOrder S; S.init(M, D, FF, gridDim.x, blockIdx.x); pg8::EpiRes E{args.in[I_X], L == 0 ? nullptr : ST, args.in[I_LN3G] + (L > 0 ? (L - 1) * D : 0), args.in[I_LN3B] + (L > 0 ? (L - 1) * D : 0), T, D, ALPHA, 0.5f}; pg8::gemm_phase(ldsl, g, S, E); });
        PHASE(3, ln_phase(T, args.in[I_LN1G] + L * D, args.in[I_LN1B] + L * D, ST, XB, nullptr););
        PHASE(4, { pg8::Gemm g{XB, (const bf16_t*)(ws + OFF_WIN), D, D}; pg8::StaticOrder S; S.init(M, PCOLS, D, gridDim.x, blockIdx.x); pg8::EpiBf16 E{Pb, PCOLS}; pg8::gemm_phase(ldsl, g, S, E); });
        PHASE(5, { kidx_vt_phase(args, L, lds); if (RWKV_CHUNKED && !DBG_RWKV) rwkv_par_phase(args, L, lds); else rwkv_prep_phase(args, L, lds); });
        if (!HETERO) PHASE(6, { sgu_phase(args, L, lds, blockIdx.x, gridDim.x); }); else ++gp;
        PHASE(7, { if (DBG_RWKV) { scan_phase(args, lds); xcd_barrier(bar); rwkv_par_phase(args, L, lds); xcd_barrier(bar); rwkv_seq_phase(args, lds, X + (size_t)M * RW, nullptr, nullptr, nullptr); xcd_barrier(bar); dbg_compare_phase(args); }
                   else if (HETERO) { if ((int)blockIdx.x < 64) { rwkv_seq_phase(args, lds, X, args.in[I_GNG] + L * RW, args.in[I_GNB] + L * RW, Yb); if (REP_MASK & (1u << 20)) rwkv_seq_phase(args, lds, X, args.in[I_GNG] + L * RW, args.in[I_GNB] + L * RW, Yb); sgu_phase(args, L, lds, blockIdx.x, 64, 0, SGU_SPLIT); } else { indexer_phase(args, lds, blockIdx.x - 64, gridDim.x - 64); if (REP_MASK & (1u << 16)) indexer_phase(args, lds, blockIdx.x - 64, gridDim.x - 64); sgu_phase(args, L, lds, blockIdx.x - 64, gridDim.x - 64, SGU_SPLIT, NB * 32 * 4); } }
                   else if (RWKV_CHUNKED) rwkv_seq_phase(args, lds, X, nullptr, nullptr, nullptr); else scan_phase(args, lds); });
        if (!HETERO) PHASE(8, { indexer_phase(args, lds, blockIdx.x, gridDim.x); if (RWKV_CHUNKED) rwkv_fin2_phase(args, L); else rwkv_fin_phase(args, L); }); else ++gp;
        PHASE(9, { attn_phase(args, lds); });
        PHASE(10, { pg8::Gemm g{Yb, (const bf16_t*)(ws + OFF_WBR), D, D}; pg8::BranchOrder S; S.init(M, D, D, gridDim.x, blockIdx.x); pg8::EpiBranch E{Pb, args.in[I_BGATE] + (size_t)L * 3 * D, (float*)(ws + OFF_SCR), MG}; pg8::gemm_phase(ldsl, g, S, E); });
        PHASE(11, { pg8::Gemm g{MG, (const bf16_t*)(ws + OFF_WO), D, D}; pg8::StaticOrder S; S.init(M, D, D, gridDim.x, blockIdx.x); pg8::EpiRes E{nullptr, ST, args.in[I_LN1G] + L * D, args.in[I_LN1B] + L * D, T, D, ALPHA, 1.0f}; pg8::gemm_phase(ldsl, g, S, E); });
        PHASE(12, ln_phase(T, args.in[I_LN2G] + L * D, args.in[I_LN2B] + L * D, ST, XB, nullptr););
        PHASE(13, { pg8::Gemm g{XB, (const bf16_t*)(ws + OFF_W2A), D, D}; pg8::StaticOrder S; S.init(M, 2 * FF, D, gridDim.x, blockIdx.x); pg8::EpiSwiglu E{H, FF}; pg8::gemm_phase(ldsl, g, S, E); });
        PHASE(14, { pg8::Gemm g{H, (const bf16_t*)(ws + OFF_W2B), FF, FF}; pg8::StaticOrder S; S.init(M, D, FF, gridDim.x, blockIdx.x); pg8::EpiRes E{nullptr, ST, args.in[I_LN2G] + L * D, args.in[I_LN2B] + L * D, T, D, ALPHA, 0.5f}; pg8::gemm_phase(ldsl, g, S, E); });
        PHASE(15, ln_phase(T, args.in[I_LN3G] + L * D, args.in[I_LN3B] + L * D, ST, XB, L == DEPTH - 1 ? args.out : nullptr););
    }
    if (DBG_RWKV) { xcd_barrier(bar); dbg_encode_phase(args); }
#undef RUN
#undef SEAM
#undef PHASE
}

extern "C" void kernel_launch(void* const* d_in, const int* in_sizes, int n_in, void* d_out, int out_size, void* d_ws, size_t ws_size, hipStream_t stream) {
    static int grid = 0;
    if (grid == 0) {
        if (n_in != 33 || out_size != M * D || ws_size < WS_END) { fprintf(stderr, "kernel_launch: unexpected shapes (n_in %d out %d ws %zu, need %zu)\n", n_in, out_size, ws_size, (size_t)WS_END); grid = -1; return; }
        int dev = 0, cus = 0;
        if (hipGetDevice(&dev) != hipSuccess || hipDeviceGetAttribute(&cus, hipDeviceAttributeMultiprocessorCount, dev) != hipSuccess) { grid = -1; return; }
        if (hipFuncSetAttribute((const void*)fwd, hipFuncAttributeMaxDynamicSharedMemorySize, LDS_BYTES) != hipSuccess) { fprintf(stderr, "kernel_launch: hipFuncSetAttribute failed\n"); grid = -1; return; }
        int per_cu = 0; (void)hipOccupancyMaxActiveBlocksPerMultiprocessor(&per_cu, (const void*)fwd, 512, LDS_BYTES); (void)hipGetLastError();
        grid = cus;
    }
    if (grid < 0) return;
    (void)hipMemsetAsync((char*)d_ws + OFF_CTL, 0, CTL_BYTES, stream);
    Args a{};
    for (int i = 0; i < 33; ++i) a.in[i] = (const float*)d_in[i];
    a.out = (float*)d_out; a.ws = (unsigned char*)d_ws;
#if MK_PER_PHASE
    for (int p = 0; p < NGP; ++p) { a.lo = p; a.hi = p + 1; hipLaunchKernelGGL(fwd, dim3(grid), dim3(512), LDS_BYTES, stream, a); }
#else
    a.lo = 0; a.hi = NGP;
    hipLaunchKernelGGL(fwd, dim3(grid), dim3(512), LDS_BYTES, stream, a);
#endif
}
```

```cpp
#include <hip/hip_runtime.h>
#include <cstdio>
#include <cstdint>

#ifndef MK_PER_PHASE
#define MK_PER_PHASE 0
#endif
#ifndef PH_MASK
#define PH_MASK 0xFFFFFFFFu
#endif
#define PHON(k) (((PH_MASK) >> (k)) & 1u)
#ifndef RWKV_CHUNKED
#define RWKV_CHUNKED 1
#endif
#ifndef DBG_RWKV
#define DBG_RWKV 0
#endif
#ifndef DBG_LORA
#define DBG_LORA 0
#endif
#ifndef HETERO
#define HETERO 1
#endif
#ifndef SEQ_HILO
#define SEQ_HILO 0
#endif
#ifndef SGU_SPLIT
#define SGU_SPLIT 256
#endif
#ifndef REP_MASK
#define REP_MASK 0u
#endif

#define LAS __attribute__((address_space(3)))
#define DI __device__ __forceinline__
typedef unsigned short bf16_t;
typedef short bf16x8 __attribute__((ext_vector_type(8)));
typedef float f32x4 __attribute__((ext_vector_type(4)));
typedef float f32x2 __attribute__((ext_vector_type(2)));
typedef float f32x16 __attribute__((ext_vector_type(16)));
typedef unsigned u32x4 __attribute__((ext_vector_type(4)));
typedef unsigned u32x2 __attribute__((ext_vector_type(2)));
typedef __bf16 bf16x2_t __attribute__((ext_vector_type(2)));

constexpr int NB = 4, SEQ = 4096, M = NB * SEQ, D = 2048, FF = 5632, DEPTH = 4;
constexpr int RW = 1024;
constexpr int PCOLS = 13312;
constexpr int DIN = 13168;
constexpr int PC_R = 0, PC_K = 1024, PC_V = 2048, PC_SGU = 3072, PC_SGV = 3584, PC_AQ = 4096, PC_AK = 4608, PC_AV = 5120, PC_QI = 5632, PC_GATE = 6656, PC_LORA = 12800, PC_KI = 13088, PC_WI = 13152;
constexpr float ALPHA = 1.6817928305074290f;
constexpr float LN_EPS = 1e-5f;

constexpr size_t MiB = 1u << 20;
constexpr size_t OFF_CTL = 0, CTL_BYTES = 1 * MiB;
constexpr size_t OFF_BIAS = 1 * MiB;
constexpr size_t OFF_ST = OFF_BIAS + 786432;
constexpr size_t OFF_LW2 = OFF_BIAS + 65536, OFF_LA2 = OFF_LW2 + 131072, OFF_LG2 = OFF_LA2 + 131072;
constexpr int REC = 15360, RROW = 144, R_EL2 = 0, R_RL2 = 2304, R_A2 = 4608, R_A3 = 8704, R_FT = 9728, R_VT = 10240, R_GC = 12288, R_G = 12544, R_BON = 14592;
constexpr size_t OFF_W1A = 2 * MiB;
constexpr size_t OFF_W1B = OFF_W1A + 44 * MiB;
constexpr size_t OFF_WIN = OFF_W1B + 22 * MiB;
constexpr size_t OFF_WBR = OFF_WIN + 52 * MiB;
constexpr size_t OFF_WO  = OFF_WBR + 8 * MiB;
constexpr size_t OFF_W2A = OFF_WO + 8 * MiB;
constexpr size_t OFF_W2B = OFF_W2A + 44 * MiB;
constexpr size_t OFF_X   = OFF_W2B + 22 * MiB;
constexpr size_t OFF_T   = OFF_X + 128 * MiB;
constexpr size_t OFF_XB  = OFF_T + 128 * MiB;
constexpr size_t OFF_P   = OFF_XB + 64 * MiB;
constexpr size_t OFF_SCR = OFF_P + 416 * MiB;
constexpr size_t OFF_Y   = OFF_SCR + 416 * MiB;
constexpr size_t OFF_MG  = OFF_Y + 64 * MiB;
constexpr size_t OFF_BM  = OFF_MG + 64 * MiB;
constexpr size_t OFF_KI  = OFF_BM + 8 * MiB;
constexpr size_t OFF_VT  = OFF_KI + 2 * MiB;
constexpr size_t WS_END  = OFF_VT + 16 * MiB;

constexpr int LDS_BYTES = 147456;
constexpr int MISC_OFF = 131072 + 320;

DI unsigned f2bf(float f) { unsigned u = __builtin_bit_cast(unsigned, f); return (u + 0x7fffu + ((u >> 16) & 1u)) >> 16; }
DI float bf2f(unsigned short b) { return __builtin_bit_cast(float, ((unsigned)b) << 16); }
DI unsigned pk2(float lo, float hi) { f32x2 v = {lo, hi}; bf16x2_t b = __builtin_convertvector(v, bf16x2_t); return __builtin_bit_cast(unsigned, b); }
DI float bflo(unsigned w) { return __builtin_bit_cast(float, w << 16); }
DI float bfhi(unsigned w) { return __builtin_bit_cast(float, w & 0xffff0000u); }
template <int CTRL> DI float dpp_f(float x) { return __builtin_bit_cast(float, __builtin_amdgcn_update_dpp(0, __builtin_bit_cast(int, x), CTRL, 0xF, 0xF, true)); }
DI float row16_sum(float x) {
    x += dpp_f<0xB1>(x);
    x += dpp_f<0x4E>(x);
    x += dpp_f<0x141>(x);
    x += dpp_f<0x140>(x);
    return x;
}
DI int otid() { int t = threadIdx.x; asm volatile("" : "+v"(t)); return t; }
DI int obid() { int t = blockIdx.x; asm volatile("" : "+s"(t)); return t; }
DI float wave_sum(float x) {
    x = row16_sum(x);
    auto p = __builtin_amdgcn_permlane16_swap(__float_as_uint(x), __float_as_uint(x), false, false);
    x = __uint_as_float(p[0]) + __uint_as_float(p[1]);
    auto q = __builtin_amdgcn_permlane32_swap(__float_as_uint(x), __float_as_uint(x), false, false);
    return __uint_as_float(q[0]) + __uint_as_float(q[1]);
}
DI void wave_sum8(float (&x)[8]) {
#pragma unroll
    for (int i = 0; i < 8; ++i) x[i] += dpp_f<0xB1>(x[i]);
#pragma unroll
    for (int i = 0; i < 8; ++i) x[i] += dpp_f<0x4E>(x[i]);
#pragma unroll
    for (int i = 0; i < 8; ++i) x[i] += dpp_f<0x141>(x[i]);
#pragma unroll
    for (int i = 0; i < 8; ++i) x[i] += dpp_f<0x140>(x[i]);
#pragma unroll
    for (int i = 0; i < 8; ++i) { auto p = __builtin_amdgcn_permlane16_swap(__float_as_uint(x[i]), __float_as_uint(x[i]), false, false); x[i] = __uint_as_float(p[0]) + __uint_as_float(p[1]); }
#pragma unroll
    for (int i = 0; i < 8; ++i) { auto p = __builtin_amdgcn_permlane32_swap(__float_as_uint(x[i]), __float_as_uint(x[i]), false, false); x[i] = __uint_as_float(p[0]) + __uint_as_float(p[1]); }
}
DI float sigmoidf_(float x) { return 1.0f / (1.0f + __expf(-x)); }
DI float gelu_erf(float x) { return 0.5f * x * (1.0f + erff(x * 0.70710678118654752f)); }

namespace pg8 {
constexpr int BM = 256, BK = 64, HALF = 128, HTB = HALF * BK * 2, STAGE_BYTES = 8 * HTB, NXCD = 8, WGM = 8;
__host__ __device__ __forceinline__ int lds_byte(int r, int c) { const int st = (r >> 4) * 2 + (c >> 5), rr = r & 15, cc = c & 31, ob = rr * 64 + cc * 2; return st * 1024 + (ob ^ (((ob >> 9) & 1) << 5)); }
__host__ __device__ __forceinline__ void stage_rc(int b, int& R, int& C) { const int st = b / 1024, sb = b % 1024, swz = sb ^ (((sb >> 9) & 1) << 5); R = (st >> 1) * 16 + swz / 64; C = (st & 1) * 32 + (swz % 64) / 2; }
__host__ __device__ __forceinline__ int perm32(int rho) { const int n = rho >> 4, i = rho & 15; return 8 * (i >> 2) + 4 * n + (i & 3); }

struct Unit { int pm, pn, koff, nt, tag; };
struct Gemm { const bf16_t* A; const bf16_t* Bt; int lda, ldb; };

struct StaticOrder {
    int nM, nN, nwg, G, c, nt;
    __device__ void init(int M_, int N_, int K_, int G_, int c_) { nM = M_ / BM; nN = N_ / BM; nwg = nM * nN; G = G_; c = c_; nt = K_ / BK; }
    __device__ bool tile(int L, Unit& u) const {
        if (L >= nwg) return false;
        int wgid = L; { const int q = nwg / NXCD, r = nwg % NXCD, xcd = wgid % NXCD, off = wgid / NXCD; wgid = (xcd < r ? xcd * (q + 1) : r * (q + 1) + (xcd - r) * q) + off; }
        const int nig = WGM * nN, gid = wgid / nig, fm = gid * WGM, gsz = (nM - fm) < WGM ? (nM - fm) : WGM;
        u.pm = fm + ((wgid % nig) % gsz); u.pn = (wgid % nig) / gsz; return true;
    }
    __device__ bool next(int i, Unit& u) const { u.koff = 0; u.nt = nt; u.tag = 0; return tile(i * G + c, u); }
};
struct BranchOrder : StaticOrder {
    __device__ bool next(int i, Unit& u) const {
        const int ti = i / 3, br = i - 3 * ti;
        u.tag = br; u.koff = br == 0 ? 0 : (br == 1 ? 1024 : 1536); u.nt = br == 0 ? 16 : 8;
        return tile(ti * G + c, u);
    }
};

template <class Epi, class Sched>
__device__ __forceinline__ void gemm_phase(LAS unsigned char* lds, const Gemm g, const Sched& S, const Epi& E) {
    const int tid = otid(), wid = __builtin_amdgcn_readfirstlane(tid >> 6), lane = tid & 63, wr = wid >> 2, wc = wid & 3, fr = lane & 15, fq = lane >> 4;
    unsigned voffA[2], voffB[2];
#pragma unroll
    for (int i = 0; i < 2; ++i) { int R, C; stage_rc(tid * 16 + i * 8192, R, C); const int Rb = Epi::PERM ? ((R & ~31) + perm32(R & 31)) : R;
        voffA[i] = (unsigned)(R * g.lda + C) * 2u; voffB[i] = (unsigned)(Rb * g.ldb + C) * 2u; }
    const size_t kstep = (size_t)(BK * 2);
    const size_t hstepA = (size_t)HALF * g.lda * 2, hstepB = (size_t)HALF * g.ldb * 2;
    const size_t tstepA = 2 * hstepA, tstepB = 2 * hstepB;
    const unsigned ldsw = (unsigned)wid * 1024u;
    const int aoff = lds_byte(wr * 64 + fr, fq * 8), boff = lds_byte(wc * 32 + fr, fq * 8);
#define PG8_SA(b, h) (((b) * 2 + (h)) * HTB)
#define PG8_SB(b, h) ((4 + (b) * 2 + (h)) * HTB)
#define PG8_STAGE(bufoff, gbase, voff) do { _Pragma("unroll") for (int _i = 0; _i < 2; ++_i) \
        __builtin_amdgcn_global_load_lds((const unsigned*)((const char*)(gbase) + (voff)[_i]), (LAS unsigned*)(lds + (bufoff) + ldsw + _i * 8192), 16, 0, 0); } while (0)
#define PG8_LDA(dst, b, h) do { _Pragma("unroll") for (int m = 0; m < 4; ++m) _Pragma("unroll") for (int k = 0; k < 2; ++k) dst[m][k] = *(const LAS bf16x8*)(lds + PG8_SA(b, h) + aoff + m * 2048 + k * 1024); } while (0)
#define PG8_LDB(dst, b, h) do { _Pragma("unroll") for (int n = 0; n < 2; ++n) _Pragma("unroll") for (int k = 0; k < 2; ++k) dst[n][k] = *(const LAS bf16x8*)(lds + PG8_SB(b, h) + boff + n * 2048 + k * 1024); } while (0)
#define PG8_MMA(ai, bj, At, Bt) do { __builtin_amdgcn_s_setprio(1); _Pragma("unroll") for (int m = 0; m < 4; ++m) _Pragma("unroll") for (int n = 0; n < 2; ++n) _Pragma("unroll") for (int k = 0; k < 2; ++k) \
        acc[ai][bj][m][n] = __builtin_amdgcn_mfma_f32_16x16x32_bf16(Bt[n][k], At[m][k], acc[ai][bj][m][n], 0, 0, 0); __builtin_amdgcn_s_setprio(0); } while (0)
#define PG8_WAIT_V(n) asm volatile("s_waitcnt vmcnt(" #n ")" ::: "memory")
#define PG8_WAIT_L(n) asm volatile("s_waitcnt lgkmcnt(" #n ")" ::: "memory")
#define PG8_BAR __builtin_amdgcn_s_barrier()
#define PG8_SCHED __builtin_amdgcn_sched_barrier(0)
    Unit cur, nxt; int ui = 0;
    if (!S.next(0, cur)) return;
    f32x4 acc[2][2][4][2];
#pragma unroll
    for (int a = 0; a < 2; ++a)
#pragma unroll
        for (int b = 0; b < 2; ++b)
#pragma unroll
            for (int m = 0; m < 4; ++m)
#pragma unroll
                for (int n = 0; n < 2; ++n) acc[a][b][m][n] = (f32x4){0.f, 0.f, 0.f, 0.f};
    bf16x8 At[4][2], B0[2][2], B1[2][2];
    const char* cA = (const char*)g.A + (size_t)cur.pm * tstepA + (size_t)cur.koff * 2; const char* cB = (const char*)g.Bt + (size_t)cur.pn * tstepB + (size_t)cur.koff * 2;
    PG8_STAGE(PG8_SB(0, 0), cB, voffB); PG8_STAGE(PG8_SB(0, 1), cB + hstepB, voffB); PG8_STAGE(PG8_SA(0, 0), cA, voffA); PG8_STAGE(PG8_SA(0, 1), cA + hstepA, voffA);
    if (wr == 1) PG8_BAR;
    PG8_WAIT_V(2); PG8_BAR;
    PG8_STAGE(PG8_SB(1, 0), cB + kstep, voffB); PG8_STAGE(PG8_SA(1, 0), cA + kstep, voffA); PG8_STAGE(PG8_SB(1, 1), cB + hstepB + kstep, voffB);
    PG8_WAIT_V(6); PG8_BAR;
    for (;;) {
        const bool has_next = S.next(ui + 1, nxt);
        const char* nA = has_next ? (const char*)g.A + (size_t)nxt.pm * tstepA + (size_t)nxt.koff * 2 : cA; const char* nB = has_next ? (const char*)g.Bt + (size_t)nxt.pn * tstepB + (size_t)nxt.koff * 2 : cB;
        const int nt = cur.nt;
        for (int t = 0; t < nt; t += 2) {
            const bool last = (t == nt - 2);
            const char* a1 = cA + (size_t)(t + 1) * kstep;
            const char* a2 = last ? nA : cA + (size_t)(t + 2) * kstep; const char* b2 = last ? nB : cB + (size_t)(t + 2) * kstep;
            const char* a3 = a2 + kstep; const char* b3 = b2 + kstep;
            PG8_LDB(B0, 0, 0); PG8_LDB(B1, 0, 1); PG8_SCHED; PG8_LDA(At, 0, 0); PG8_STAGE(PG8_SA(1, 1), a1 + hstepA, voffA);
            PG8_WAIT_V(8); PG8_WAIT_L(0); PG8_BAR; PG8_MMA(0, 0, At, B0); PG8_MMA(0, 1, At, B1); PG8_BAR; PG8_SCHED;
            PG8_LDA(At, 0, 1); PG8_STAGE(PG8_SB(0, 0), b2, voffB); PG8_STAGE(PG8_SB(0, 1), b2 + hstepB, voffB); PG8_STAGE(PG8_SA(0, 0), a2, voffA);
            PG8_WAIT_V(8); PG8_WAIT_L(0); PG8_BAR; PG8_MMA(1, 0, At, B0); PG8_MMA(1, 1, At, B1); PG8_BAR; PG8_SCHED;
            PG8_LDB(B0, 1, 0); PG8_LDB(B1, 1, 1); PG8_SCHED; PG8_LDA(At, 1, 0); PG8_STAGE(PG8_SA(0, 1), a2 + hstepA, voffA);
            PG8_WAIT_V(8); PG8_WAIT_L(0); PG8_BAR; PG8_MMA(0, 0, At, B0); PG8_MMA(0, 1, At, B1); PG8_BAR; PG8_SCHED;
            PG8_LDA(At, 1, 1); PG8_STAGE(PG8_SB(1, 0), b3, voffB); PG8_STAGE(PG8_SB(1, 1), b3 + hstepB, voffB); PG8_STAGE(PG8_SA(1, 0), a3, voffA);
            PG8_WAIT_V(8); PG8_WAIT_L(0); PG8_BAR; PG8_MMA(1, 0, At, B0); PG8_MMA(1, 1, At, B1); PG8_BAR; PG8_SCHED;
        }
        if (wr == 0) PG8_BAR;
        E(acc, cur, wr, wc, fr, fq);
        if (!has_next) break;
#pragma unroll
        for (int a = 0; a < 2; ++a)
#pragma unroll
            for (int b = 0; b < 2; ++b)
#pragma unroll
                for (int m = 0; m < 4; ++m)
#pragma unroll
                    for (int n = 0; n < 2; ++n) acc[a][b][m][n] = (f32x4){0.f, 0.f, 0.f, 0.f};
        cur = nxt; cA = nA; cB = nB; ++ui;
        if (wr == 1) PG8_BAR;
    }
    PG8_WAIT_V(0);
    PG8_BAR;
#undef PG8_SA
#undef PG8_SB
#undef PG8_STAGE
#undef PG8_LDA
#undef PG8_LDB
#undef PG8_MMA
#undef PG8_WAIT_V
#undef PG8_WAIT_L
#undef PG8_BAR
#undef PG8_SCHED
}

struct EpiSwiglu {
    static constexpr bool PERM = true;
    bf16_t* O; int ldc;
    __device__ __forceinline__ void operator()(const f32x4 (&acc)[2][2][4][2], const Unit& u, int wr, int wc, int fr, int fq) const {
        const int row0 = u.pm * BM + wr * 64 + fr, col0 = u.pn * HALF + wc * 32 + 8 * fq;
#pragma unroll
        for (int ai = 0; ai < 2; ++ai)
#pragma unroll
            for (int m = 0; m < 4; ++m) {
                float hv[8];
#pragma unroll
                for (int n = 0; n < 2; ++n)
#pragma unroll
                    for (int j = 0; j < 4; ++j) { const float gv = acc[ai][0][m][n][j], uv = acc[ai][1][m][n][j]; hv[4 * n + j] = gv * __builtin_amdgcn_rcpf(1.0f + __expf(-gv)) * uv; }
                u32x4 w; w.x = pk2(hv[0], hv[1]); w.y = pk2(hv[2], hv[3]); w.z = pk2(hv[4], hv[5]); w.w = pk2(hv[6], hv[7]);
                *(u32x4*)(O + (size_t)(row0 + ai * HALF + m * 16) * ldc + col0) = w;
            }
    }
};
struct EpiRes {
    static constexpr bool PERM = false;
    const float* Xraw; const float* st; const float* g; const float* b; float* T; int ldc; float alpha, s;
    __device__ __forceinline__ void operator()(const f32x4 (&acc)[2][2][4][2], const Unit& u, int wr, int wc, int fr, int fq) const {
        const int row0 = u.pm * BM + wr * 64 + fr, col0 = u.pn * BM + wc * 32 + 4 * fq;
        f32x4 gv[2][2], bv[2][2];
        if (st) {
#pragma unroll
            for (int bj = 0; bj < 2; ++bj)
#pragma unroll
                for (int n = 0; n < 2; ++n) { gv[bj][n] = *(const f32x4*)(g + col0 + bj * HALF + n * 16); bv[bj][n] = *(const f32x4*)(b + col0 + bj * HALF + n * 16); } }
        const float* src = st ? T : Xraw;
#pragma unroll
        for (int ai = 0; ai < 2; ++ai)
#pragma unroll
            for (int m2 = 0; m2 < 2; ++m2) {
                f32x4 tv[2][2][2]; f32x2 ms[2];
#pragma unroll
                for (int mm = 0; mm < 2; ++mm) { const int row = row0 + ai * HALF + (2 * m2 + mm) * 16; const size_t off = (size_t)row * ldc + col0;
                    ms[mm] = (f32x2){0.f, 1.f}; if (st) ms[mm] = *(const f32x2*)(st + 2 * (size_t)row);
#pragma unroll
                    for (int bj = 0; bj < 2; ++bj)
#pragma unroll
                        for (int n = 0; n < 2; ++n) tv[mm][bj][n] = *(const f32x4*)(src + off + bj * HALF + n * 16); }
                asm volatile("" ::: "memory");
#pragma unroll
                for (int mm = 0; mm < 2; ++mm) { const int m = 2 * m2 + mm; const size_t off = (size_t)(row0 + ai * HALF + m * 16) * ldc + col0;
#pragma unroll
                    for (int bj = 0; bj < 2; ++bj)
#pragma unroll
                        for (int n = 0; n < 2; ++n) { f32x4 xv = tv[mm][bj][n]; if (st) xv = (xv - ms[mm][0]) * ms[mm][1] * gv[bj][n] + bv[bj][n];
                            *(f32x4*)(T + off + bj * HALF + n * 16) = xv * alpha + acc[ai][bj][m][n] * s; } }
            }
    }
};
struct EpiBf16 {
    static constexpr bool PERM = true;
    bf16_t* O; int ldc;
    __device__ __forceinline__ void operator()(const f32x4 (&acc)[2][2][4][2], const Unit& u, int wr, int wc, int fr, int fq) const {
        const int row0 = u.pm * BM + wr * 64 + fr, col0 = u.pn * BM + wc * 32 + 8 * fq;
#pragma unroll
        for (int ai = 0; ai < 2; ++ai)
#pragma unroll
            for (int m = 0; m < 4; ++m) { bf16_t* rowp = O + (size_t)(row0 + ai * HALF + m * 16) * ldc + col0;
#pragma unroll
                for (int bj = 0; bj < 2; ++bj) { const f32x4 v0 = acc[ai][bj][m][0], v1 = acc[ai][bj][m][1];
                    u32x4 w; w.x = pk2(v0[0], v0[1]); w.y = pk2(v0[2], v0[3]); w.z = pk2(v1[0], v1[1]); w.w = pk2(v1[2], v1[3]);
                    *(u32x4*)(rowp + bj * HALF) = w; } }
    }
};
struct EpiBranch {
    static constexpr bool PERM = false;
    const bf16_t* P; const float* bgate; float* TOT; bf16_t* MG;
    __device__ __forceinline__ void operator()(const f32x4 (&acc)[2][2][4][2], const Unit& u, int wr, int wc, int fr, int fq) const {
        const int row0 = u.pm * BM + wr * 64 + fr, col0 = u.pn * BM + wc * 32 + 4 * fq; const int br = u.tag;
        f32x4 bg[2][2];
#pragma unroll
        for (int bj = 0; bj < 2; ++bj)
#pragma unroll
            for (int n = 0; n < 2; ++n) bg[bj][n] = *(const f32x4*)(bgate + br * D + col0 + bj * HALF + n * 16);
#pragma unroll
        for (int ai = 0; ai < 2; ++ai)
#pragma unroll
            for (int m2 = 0; m2 < 2; ++m2) {
                u32x2 gw[2][2][2]; f32x4 tt[2][2][2];
#pragma unroll
                for (int mm = 0; mm < 2; ++mm) { const size_t row = (size_t)(row0 + ai * HALF + (2 * m2 + mm) * 16);
#pragma unroll
                    for (int bj = 0; bj < 2; ++bj)
#pragma unroll
                        for (int n = 0; n < 2; ++n) { const int col = col0 + bj * HALF + n * 16; gw[mm][bj][n] = *(const u32x2*)(P + row * PCOLS + PC_GATE + br * D + col);
                            tt[mm][bj][n] = (f32x4){0.f, 0.f, 0.f, 0.f}; if (br != 0) tt[mm][bj][n] = *(const f32x4*)(TOT + row * D + col); } }
                asm volatile("" ::: "memory");
#pragma unroll
                for (int mm = 0; mm < 2; ++mm) { const int m = 2 * m2 + mm; const size_t row = (size_t)(row0 + ai * HALF + m * 16);
#pragma unroll
                    for (int bj = 0; bj < 2; ++bj)
#pragma unroll
                        for (int n = 0; n < 2; ++n) { const int col = col0 + bj * HALF + n * 16; const u32x2 w2 = gw[mm][bj][n]; const f32x4 b4 = bg[bj][n];
                            f32x4 gt; gt[0] = sigmoidf_(bflo(w2.x) + b4[0]); gt[1] = sigmoidf_(bfhi(w2.x) + b4[1]); gt[2] = sigmoidf_(bflo(w2.y) + b4[2]); gt[3] = sigmoidf_(bfhi(w2.y) + b4[3]);
                            const f32x4 v = gt * acc[ai][bj][m][n] + tt[mm][bj][n];
                            if (br != 2) *(f32x4*)(TOT + row * D + col) = v;
                            else { u32x2 o; o.x = pk2(v[0], v[1]); o.y = pk2(v[2], v[3]); *(u32x2*)(MG + row * D + col) = o; } } }
            }
    }
};
}

#define XB_TMO      128
#define XB_XCNT(j)  (256  + 64 * (j))
#define XB_XSUB(j)  (1280 + 64 * (j))
#define XB_XGEN(j)  (2304 + 64 * (j))
#define XB_TOP      3328
#define XB_TOPGEN   3392
#define XCD_BAR_WORDS 3456
#define XB_SPIN_CAP (1u << 18)
__device__ __forceinline__ unsigned xb_ld(unsigned* p)              { return __hip_atomic_load(p, __ATOMIC_RELAXED, __HIP_MEMORY_SCOPE_AGENT); }
__device__ __forceinline__ unsigned xb_add(unsigned* p, unsigned v) { return __hip_atomic_fetch_add(p, v, __ATOMIC_RELAXED, __HIP_MEMORY_SCOPE_AGENT); }
__device__ __forceinline__ unsigned xb_xcc_id() { return (unsigned)__builtin_amdgcn_s_getreg((3 << 11) | 20) & 0xFu; }
#define XB_SPIN(cond, bar) do { unsigned _sp = 0; while (cond) { __builtin_amdgcn_s_sleep(1); \
    if ((++_sp & 255u) == 0u) { if (xb_ld(&(bar)[XB_TMO])) break; if (_sp > XB_SPIN_CAP) { atomicAdd(&(bar)[XB_TMO], 1u); break; } } } } while (0)
struct XcdBarrier { unsigned* bar; unsigned x; volatile LAS unsigned* st; };
__device__ __forceinline__ XcdBarrier xcd_barrier_post(unsigned* bar, volatile LAS unsigned* st) {
    XcdBarrier b; b.bar = bar; b.x = xb_xcc_id(); b.st = st;
    if (threadIdx.x == 0) (void)xb_add(&bar[XB_XCNT(b.x)], 1u);
    return b;
}
__device__ __forceinline__ void xcd_barrier_complete(unsigned* bar, unsigned x, unsigned& nloc, unsigned& nx) {
    const unsigned G = gridDim.x * gridDim.y * gridDim.z;
    unsigned sum, cnt, mine, sp = 0u;
    for (;;) {
        sum = 0u; cnt = 0u; mine = 0u;
#pragma unroll
        for (unsigned j = 0; j < 16; ++j) { const unsigned c = xb_ld(&bar[XB_XCNT(j)]); sum += c; cnt += (c > 0u) ? 1u : 0u; mine = (j == x) ? c : mine; }
        if (sum == G) break;
        __builtin_amdgcn_s_sleep(1);
        if ((++sp & 255u) == 0u) { if (xb_ld(&bar[XB_TMO])) break; if (sp > XB_SPIN_CAP) { atomicAdd(&bar[XB_TMO], 1u); break; } }
    }
    nloc = mine > 0u ? mine : 1u; nx = cnt > 0u ? cnt : 1u;
}
__device__ __forceinline__ void xcd_barrier(const XcdBarrier& b) {
    asm volatile("s_waitcnt vmcnt(0)" ::: "memory");
    __syncthreads();
    if (threadIdx.x == 0) {
        unsigned* bar = b.bar;
        __builtin_amdgcn_s_waitcnt(0);
        unsigned nloc = b.st[0], nx = b.st[1];
        if (nloc == 0u) { xcd_barrier_complete(bar, b.x, nloc, nx); b.st[0] = nloc; b.st[1] = nx; }
        const unsigned old = xb_add(&bar[XB_XSUB(b.x)], 1u);
        const unsigned gen = old / nloc;
        if (old + 1u == (gen + 1u) * nloc) {
            __builtin_amdgcn_fence(__ATOMIC_RELEASE, "agent");
            asm volatile("s_waitcnt vmcnt(0)" ::: "memory");
            const unsigned og = xb_add(&bar[XB_TOP], 1u);
            const unsigned tg = og / nx;
            if (og + 1u == (tg + 1u) * nx) xb_add(&bar[XB_TOPGEN], 1u);
            else XB_SPIN(xb_ld(&bar[XB_TOPGEN]) == tg, bar);
            __builtin_amdgcn_fence(__ATOMIC_ACQUIRE, "agent");
            xb_add(&bar[XB_XGEN(b.x)], 1u);
            asm volatile("s_waitcnt vmcnt(0)" ::: "memory");
        } else {
            XB_SPIN(xb_ld(&bar[XB_XGEN(b.x)]) == gen, bar);
            __builtin_amdgcn_fence(__ATOMIC_ACQUIRE, "agent");
            asm volatile("s_waitcnt vmcnt(0)" ::: "memory");
        }
    }
    __syncthreads();
}

struct Args { const float* in[33]; float* out; unsigned char* ws; int lo, hi; };
enum { I_X = 0, I_F1IN, I_F1OUT, I_LN1G, I_LN1B, I_WIN, I_BGATE, I_MU, I_W0, I_W2, I_A0, I_A2, I_G2, I_KK, I_KA, I_RK, I_GNG, I_GNB, I_SGLNG, I_SGLNB, I_SGW, I_SGB, I_ILNG, I_ILNB, I_RELB, I_WBR, I_WO, I_LN2G, I_LN2B, I_F2IN, I_F2OUT, I_LN3G, I_LN3B };

DI int pmap(int n) {
    if (n < 3072) return n;
    if (n < 3360) return PC_LORA + (n - 3072);
    if (n < 4384) return PC_SGU + (n - 3360);
    if (n < 5920) return PC_AQ + (n - 4384);
    if (n < 6944) return PC_QI + (n - 5920);
    if (n < 7008) return PC_KI + (n - 6944);
    if (n < 7024) return PC_WI + (n - 7008);
    return PC_GATE + (n - 7024);
}
template <int MODE> DI int rowmap(int n) {
    if (MODE == 0) return n;
    if (MODE == 1) { const int up = n >= FF ? 1 : 0, j = n - up * FF; return (j >> 7) * 256 + up * 128 + (j & 127); }
    return pmap(n);
}
struct CvtItem { const float* W; bf16_t* WT; int K, N, mode, item; };
DI void cvt_load(const CvtItem& d, int lane, f32x4 (&va)[4], f32x4 (&vb)[4]) {
    const int nblk = (d.N + 31) / 32, kb = d.item / nblk, nb = d.item % nblk, k0 = 64 * kb, n0 = 32 * nb;
    const int c4 = lane & 7, rq = lane >> 3; const int ncol = n0 + 4 * c4; const bool okc = ncol < d.N;
#pragma unroll
    for (int i = 0; i < 4; ++i) { const int k = k0 + 2 * (rq + 8 * i);
        va[i] = okc ? *(const f32x4*)(d.W + (size_t)k * d.N + ncol) : (f32x4){0.f, 0.f, 0.f, 0.f}; vb[i] = okc ? *(const f32x4*)(d.W + (size_t)(k + 1) * d.N + ncol) : (f32x4){0.f, 0.f, 0.f, 0.f}; }
}
DI void cvt_finish(const CvtItem& d, int lane, const f32x4 (&va)[4], const f32x4 (&vb)[4], float* scr) {
    const int nblk = (d.N + 31) / 32, kb = d.item / nblk, nb = d.item % nblk, k0 = 64 * kb, n0 = 32 * nb;
    unsigned* st = (unsigned*)scr; const int c4 = lane & 7, rq = lane >> 3;
#pragma unroll
    for (int i = 0; i < 4; ++i) { const int rp = rq + 8 * i;
#pragma unroll
        for (int j = 0; j < 4; ++j) st[(4 * c4 + j) * 33 + rp] = pk2(va[i][j], vb[i][j]); }
    __builtin_amdgcn_s_waitcnt(0xc07f); asm volatile("" ::: "memory");
#pragma unroll
    for (int i = 0; i < 4; ++i) { const int id = lane + 64 * i, n = id >> 3, kc = id & 7; const unsigned* p = st + n * 33 + 4 * kc;
        u32x4 o; o.x = p[0]; o.y = p[1]; o.z = p[2]; o.w = p[3];
        const int ns = n0 + n; const int nd = d.mode == 0 ? ns : (d.mode == 1 ? rowmap<1>(ns) : pmap(ns));
        if (ns < d.N) *(u32x4*)(d.WT + (size_t)nd * d.K + k0 + 8 * kc) = o; }
    __builtin_amdgcn_s_waitcnt(0xc07f); asm volatile("" ::: "memory");
}
DI void convert_phase(const Args& a, int L, unsigned char* lds) {
    const int tidx_ = otid();
    const int wave = __builtin_amdgcn_readfirstlane(tidx_ >> 6), lane = tidx_ & 63;
    float* scr = (float*)(lds + wave * 16384);
    const int gw = blockIdx.x * 8 + wave, NGW = gridDim.x * 8;
    unsigned char* ws = a.ws;
    constexpr int I1 = (D / 64) * ((2 * FF) / 32), I2 = (FF / 64) * (D / 32), I3 = (D / 64) * ((DIN + 31) / 32), I4 = (D / 64) * (D / 32);
    constexpr int NIT = 2 * I1 + 2 * I2 + I3 + 2 * I4;
    auto decode = [&](int it) -> CvtItem {
        int r = it;
        if (r < I1) return CvtItem{a.in[I_F1IN] + (size_t)L * D * 2 * FF, (bf16_t*)(ws + OFF_W1A), D, 2 * FF, 1, r}; r -= I1;
        if (r < I1) return CvtItem{a.in[I_F2IN] + (size_t)L * D * 2 * FF, (bf16_t*)(ws + OFF_W2A), D, 2 * FF, 1, r}; r -= I1;
        if (r < I2) return CvtItem{a.in[I_F1OUT] + (size_t)L * FF * D, (bf16_t*)(ws + OFF_W1B), FF, D, 0, r}; r -= I2;
        if (r < I2) return CvtItem{a.in[I_F2OUT] + (size_t)L * FF * D, (bf16_t*)(ws + OFF_W2B), FF, D, 0, r}; r -= I2;
        if (r < I3) return CvtItem{a.in[I_WIN] + (size_t)L * D * DIN, (bf16_t*)(ws + OFF_WIN), D, DIN, 2, r}; r -= I3;
        if (r < I4) return CvtItem{a.in[I_WBR] + (size_t)L * D * D, (bf16_t*)(ws + OFF_WBR), D, D, 0, r}; r -= I4;
        return CvtItem{a.in[I_WO] + (size_t)L * D * D, (bf16_t*)(ws + OFF_WO), D, D, 0, r};
    };
#pragma unroll 1
    for (int it = gw; it < NIT; it += 2 * NGW) {
        const bool two = it + NGW < NIT;
        const CvtItem d0 = decode(it), d1 = decode(two ? it + NGW : it);
        f32x4 a0[4], b0[4], a1[4], b1[4];
        cvt_load(d0, lane, a0, b0); if (two) cvt_load(d1, lane, a1, b1);
        asm volatile("" ::: "memory");
        cvt_finish(d0, lane, a0, b0, scr); if (two) cvt_finish(d1, lane, a1, b1, scr + 2048);
    }
    { bf16_t* w2t = (bf16_t*)(ws + OFF_LW2); bf16_t* a2t = (bf16_t*)(ws + OFF_LA2); bf16_t* g2t = (bf16_t*)(ws + OFF_LG2);
      const float* w2 = a.in[I_W2] + (size_t)L * 64 * RW; const float* a2 = a.in[I_A2] + (size_t)L * 64 * RW; const float* g2 = a.in[I_G2] + (size_t)L * 160 * RW;
      for (int i = blockIdx.x * 512 + tidx_; i < RW * 288; i += gridDim.x * 512) { const int c = i / 288, jj = i - c * 288;
          if (jj < 64) w2t[c * 64 + jj] = (bf16_t)f2bf(w2[(size_t)jj * RW + c]);
          else if (jj < 128) a2t[c * 64 + jj - 64] = (bf16_t)f2bf(a2[(size_t)(jj - 64) * RW + c]);
          else g2t[c * 160 + jj - 128] = (bf16_t)f2bf(g2[(size_t)(jj - 128) * RW + c]); } }
    { u32x4* z = (u32x4*)(ws + OFF_WIN + (size_t)DIN * D * 2); const int n16 = (PCOLS - DIN) * D * 2 / 16;
      for (int i = blockIdx.x * 512 + tidx_; i < n16; i += gridDim.x * 512) z[i] = (u32x4){0u, 0u, 0u, 0u}; }
}
DI int rel_bucket_dev(int d) {
    if (d < 16) return d;
    const float df = (float)d;
    const int large = 16 + (int)(logf(df / 16.0f) / 2.0794415416798357f * 16.0f);
    return large < 31 ? large : 31;
}
DI void init_phase(const Args& a) {
    const int tidx_ = otid();
    const size_t n4 = (size_t)M * D / 4; const f32x4* x = (const f32x4*)a.in[I_X]; u32x2* XB = (u32x2*)(a.ws + OFF_XB);
    for (size_t i = (size_t)blockIdx.x * 512 + tidx_; i < n4; i += (size_t)gridDim.x * 512) { const f32x4 v = x[i]; u32x2 o; o.x = pk2(v[0], v[1]); o.y = pk2(v[2], v[3]); XB[i] = o; }
    if (blockIdx.x == 0) { float* bt = (float*)(a.ws + OFF_BIAS); for (int i = tidx_; i < 8 * 128; i += 512) { const int h = i >> 7, d = i & 127; bt[i] = a.in[I_RELB][rel_bucket_dev(d) * 8 + h]; } }
}
DI void ln_phase(const float* T, const float* g, const float* b, float* ST, bf16_t* XB, float* out) {
    const int tidx_ = otid();
    const int wave = __builtin_amdgcn_readfirstlane(tidx_ >> 6), lane = tidx_ & 63;
    const int stride = gridDim.x * 8;
    f32x4 gvs[8], bvs[8];
#pragma unroll
    for (int j = 0; j < 8; ++j) { gvs[j] = ((const f32x4*)g)[lane + 64 * j]; bvs[j] = ((const f32x4*)b)[lane + 64 * j]; }
    int m = blockIdx.x * 8 + wave;
    f32x4 nx[8];
    if (m < M) {
#pragma unroll
        for (int j = 0; j < 8; ++j) nx[j] = ((const f32x4*)(T + (size_t)m * D) + lane)[64 * j]; }
#pragma unroll 1
    for (; m < M; m += stride) {
        f32x4 v[8]; float s = 0.f;
#pragma unroll
        for (int j = 0; j < 8; ++j) { v[j] = nx[j]; s += (v[j][0] + v[j][1]) + (v[j][2] + v[j][3]); }
        if (m + stride < M) {
#pragma unroll
            for (int j = 0; j < 8; ++j) nx[j] = ((const f32x4*)(T + (size_t)(m + stride) * D) + lane)[64 * j]; }
        const float mean = wave_sum(s) * (1.0f / D); float q = 0.f;
#pragma unroll
        for (int j = 0; j < 8; ++j) { v[j] = v[j] - mean; q += (v[j][0] * v[j][0] + v[j][1] * v[j][1]) + (v[j][2] * v[j][2] + v[j][3] * v[j][3]); }
        const float rstd = __builtin_amdgcn_rsqf(wave_sum(q) * (1.0f / D) + LN_EPS);
        if (lane == 0) *(f32x2*)(ST + 2 * (size_t)m) = (f32x2){mean, rstd};
        u32x2* bo = (u32x2*)(XB + (size_t)m * D) + lane;
#pragma unroll
        for (int j = 0; j < 8; ++j) {
            const f32x4 o = v[j] * rstd * gvs[j] + bvs[j]; u32x2 w; w.x = pk2(o[0], o[1]); w.y = pk2(o[2], o[3]); bo[64 * j] = w;
            if (out) ((f32x4*)(out + (size_t)m * D) + lane)[64 * j] = o; }
    }
}
DI void rwkv_prep_phase(const Args& a, int L, unsigned char* lds) {
    const int tidx_ = otid();
    const int tid = tidx_;
    const bf16_t* P = (const bf16_t*)(a.ws + OFF_P);
    float* Rr = (float*)(a.ws + OFF_SCR); float* Wr = Rr + (size_t)M * RW; float* Kr = Wr + (size_t)M * RW; float* Vr = Kr + (size_t)M * RW; float* Ar = Vr + (size_t)M * RW; float* Br = Ar + (size_t)M * RW;
    bf16_t* Gb = (bf16_t*)(a.ws + OFF_MG);
    const float* mu = a.in[I_MU] + (size_t)L * 3360; const float* w0 = a.in[I_W0] + L * RW; const float* w2 = a.in[I_W2] + (size_t)L * 64 * RW;
    const float* a0 = a.in[I_A0] + L * RW; const float* a2 = a.in[I_A2] + (size_t)L * 64 * RW; const float* g2 = a.in[I_G2] + (size_t)L * 160 * RW;
    const float* kkw = a.in[I_KK] + L * RW; const float* kaw = a.in[I_KA] + L * RW;
    float* xl = (float*)lds;
    for (int unit = blockIdx.x; unit < M / 32; unit += gridDim.x) {
        const int m0 = unit * 32;
        __syncthreads();
        for (int idx = tid; idx < 32 * 288; idx += 512) { const int tt = idx / 288, j = idx - tt * 288; const int m = m0 + tt;
            const float cur = bf2f(P[(size_t)m * PCOLS + PC_LORA + j]); const float prev = (m & (SEQ - 1)) == 0 ? 0.f : bf2f(P[(size_t)(m - 1) * PCOLS + PC_LORA + j]);
            float x = cur + (prev - cur) * mu[3072 + j];
            if (j < 64) x = tanhf(x); else if (j >= 128) x = sigmoidf_(x);
            xl[idx] = x; }
        __syncthreads();
#pragma unroll 1
        for (int half = 0; half < 2; ++half) { const int c = tid + 512 * half;
            const float w0c = w0[c], a0c = a0[c], kkc = kkw[c], kac = kaw[c], mur = mu[c], muk = mu[1024 + c], muv = mu[2048 + c];
#pragma unroll 1
            for (int sub = 0; sub < 4; ++sub) {
                float wl[8], al[8], gl[8];
#pragma unroll
                for (int t = 0; t < 8; ++t) { wl[t] = w0c; al[t] = a0c; gl[t] = 0.f; }
                const float* xb = xl + sub * 8 * 288;
#pragma unroll 2
                for (int j = 0; j < 64; j += 4) { const float u0 = w2[(size_t)(j + 0) * RW + c], u1 = w2[(size_t)(j + 1) * RW + c], u2 = w2[(size_t)(j + 2) * RW + c], u3 = w2[(size_t)(j + 3) * RW + c];
                    const float v0 = a2[(size_t)(j + 0) * RW + c], v1 = a2[(size_t)(j + 1) * RW + c], v2 = a2[(size_t)(j + 2) * RW + c], v3 = a2[(size_t)(j + 3) * RW + c];
#pragma unroll
                    for (int t = 0; t < 8; ++t) { const f32x4 xw = *(const f32x4*)(xb + t * 288 + j); const f32x4 xa = *(const f32x4*)(xb + t * 288 + 64 + j);
                        wl[t] += xw[0] * u0 + xw[1] * u1 + xw[2] * u2 + xw[3] * u3; al[t] += xa[0] * v0 + xa[1] * v1 + xa[2] * v2 + xa[3] * v3; } }
#pragma unroll 2
                for (int j = 0; j < 160; j += 4) { const float u0 = g2[(size_t)(j + 0) * RW + c], u1 = g2[(size_t)(j + 1) * RW + c], u2 = g2[(size_t)(j + 2) * RW + c], u3 = g2[(size_t)(j + 3) * RW + c];
#pragma unroll
                    for (int t = 0; t < 8; ++t) { const f32x4 xg = *(const f32x4*)(xb + t * 288 + 128 + j); gl[t] += xg[0] * u0 + xg[1] * u1 + xg[2] * u2 + xg[3] * u3; } }
#pragma unroll
                for (int t = 0; t < 8; ++t) { const int m = m0 + sub * 8 + t; const bool first = (m & (SEQ - 1)) == 0;
                    const bf16_t* pc = P + (size_t)m * PCOLS; const bf16_t* pp = pc - PCOLS;
                    const float rc = bf2f(pc[PC_R + c]), kc = bf2f(pc[PC_K + c]), vc = bf2f(pc[PC_V + c]);
                    const float rp = first ? 0.f : bf2f(pp[PC_R + c]), kp = first ? 0.f : bf2f(pp[PC_K + c]), vp = first ? 0.f : bf2f(pp[PC_V + c]);
                    const float r = rc + (rp - rc) * mur, k = kc + (kp - kc) * muk, v = vc + (vp - vc) * muv;
                    const float nx = -wl[t]; const float sp = nx > 20.f ? nx : log1pf(expf(nx));
                    const float decay = expf(-expf(-sp - 0.5f));
                    const float av = 1.0f / (1.0f + expf(-al[t]));
                    const float kk = k * kkc; const float ss = wave_sum(kk * kk); const float kkn = kk / fmaxf(sqrtf(ss), 1e-12f);
                    const float k2 = k * (1.0f + (av - 1.0f) * kac);
                    const size_t o = (size_t)m * RW + c;
                    Rr[o] = r; Wr[o] = decay; Kr[o] = k2; Vr[o] = v; Ar[o] = -kkn; Br[o] = kkn * av; Gb[o] = (bf16_t)f2bf(gl[t]); }
            }
        }
    }
}
DI void kidx_vt_phase(const Args& a, int L, unsigned char* lds) {
    const int tidx_ = otid();
    const int wave = __builtin_amdgcn_readfirstlane(tidx_ >> 6), lane = tidx_ & 63;
    const bf16_t* P = (const bf16_t*)(a.ws + OFF_P); bf16_t* KI = (bf16_t*)(a.ws + OFF_KI); bf16_t* VT = (bf16_t*)(a.ws + OFF_VT);
    const float g = a.in[I_ILNG][L * 64 + lane], b = a.in[I_ILNB][L * 64 + lane];
    for (int m0 = blockIdx.x * 8 + wave; m0 < M; m0 += gridDim.x * 8 * 8) {
        bf16_t raw[8];
#pragma unroll
        for (int i = 0; i < 8; ++i) { const int m = m0 + i * gridDim.x * 8; raw[i] = m < M ? P[(size_t)m * PCOLS + PC_KI + lane] : (bf16_t)0; }
#pragma unroll
        for (int i = 0; i < 8; ++i) { const int m = m0 + i * gridDim.x * 8; if (m < M) { const float x = bf2f(raw[i]);
            const float mean = wave_sum(x) * (1.0f / 64.0f); const float d = x - mean; const float var = wave_sum(d * d) * (1.0f / 64.0f);
            KI[(size_t)m * 64 + lane] = (bf16_t)f2bf(d * __builtin_amdgcn_rsqf(var + LN_EPS) * g + b); } }
    }
    bf16_t* tile = (bf16_t*)(lds + wave * 16384);
    for (int u = blockIdx.x * 8 + wave; u < NB * 8 * 64; u += gridDim.x * 8) {
        const int tb = u & 63, h = (u >> 6) & 7, b_ = u >> 9; const int m = b_ * SEQ + tb * 64 + lane;
        const u32x4* src = (const u32x4*)(P + (size_t)m * PCOLS + PC_AV + h * 64);
#pragma unroll
        for (int q = 0; q < 8; ++q) { const u32x4 v = src[q]; const unsigned w[4] = {v.x, v.y, v.z, v.w};
#pragma unroll
            for (int e = 0; e < 4; ++e) { tile[(q * 8 + 2 * e) * 72 + lane] = (bf16_t)(w[e] & 0xffffu); tile[(q * 8 + 2 * e + 1) * 72 + lane] = (bf16_t)(w[e] >> 16); } }
        __builtin_amdgcn_s_waitcnt(0xc07f); asm volatile("" ::: "memory");
        bf16_t* dst = VT + ((size_t)(b_ * 8 + h) * 64 + lane) * SEQ + tb * 64;
#pragma unroll
        for (int q = 0; q < 8; ++q) *(u32x4*)(dst + q * 8) = *(const u32x4*)(tile + lane * 72 + q * 8);
        __builtin_amdgcn_s_waitcnt(0xc07f); asm volatile("" ::: "memory");
    }
}
DI void sgu_phase(const Args& a, int L, unsigned char* lds, int vb, int nvb, int u0 = 0, int u1 = NB * 32 * 4) {
    const int tidx_ = otid();
    const int tid = tidx_, wave = __builtin_amdgcn_readfirstlane(tid >> 6), lane = tid & 63, fr = lane & 15, fq = lane >> 4;
    const bf16_t* P = (const bf16_t*)(a.ws + OFF_P); bf16_t* Y = (bf16_t*)(a.ws + OFF_Y);
    const float* lng = a.in[I_SGLNG] + L * 512; const float* lnb = a.in[I_SGLNB] + L * 512;
    bf16_t* Wl = (bf16_t*)lds;
    bf16_t* Vl = (bf16_t*)(lds + 128 * 272);
    for (int unit = u0 + vb; unit < u1; unit += nvb) {
        const int g = unit & 3, ch = (unit >> 2) & 31, b_ = unit >> 7; const int m0 = b_ * SEQ + ch * 128;
        const float* sw = a.in[I_SGW] + ((size_t)(L * 4 + g) * 128) * 128; const float* sb = a.in[I_SGB] + (L * 4 + g) * 128;
        __syncthreads();
        for (int idx = tid; idx < 128 * 32; idx += 512) { const int i = idx >> 5, j4 = (idx & 31) * 4; const f32x4 w = *(const f32x4*)(sw + i * 128 + j4);
            u32x2 o; o.x = pk2(j4 + 0 <= i ? w[0] : 0.f, j4 + 1 <= i ? w[1] : 0.f); o.y = pk2(j4 + 2 <= i ? w[2] : 0.f, j4 + 3 <= i ? w[3] : 0.f);
            *(u32x2*)(Wl + i * 136 + j4) = o; }
        float lgv[8], lbv[8];
#pragma unroll
        for (int e = 0; e < 8; ++e) { lgv[e] = lng[lane * 8 + e]; lbv[e] = lnb[lane * 8 + e]; }
        u32x4 pvs[16];
#pragma unroll
        for (int i = 0; i < 16; ++i) pvs[i] = *(const u32x4*)(P + (size_t)(m0 + wave + 8 * i) * PCOLS + PC_SGV + lane * 8);
#pragma unroll
        for (int i = 0; i < 16; ++i) { const int tt = wave + 8 * i;
            const u32x4 pv = pvs[i];
            float z[8]; z[0] = gelu_erf(bflo(pv.x)); z[1] = gelu_erf(bfhi(pv.x)); z[2] = gelu_erf(bflo(pv.y)); z[3] = gelu_erf(bfhi(pv.y));
            z[4] = gelu_erf(bflo(pv.z)); z[5] = gelu_erf(bfhi(pv.z)); z[6] = gelu_erf(bflo(pv.w)); z[7] = gelu_erf(bfhi(pv.w));
            float s = 0.f;
#pragma unroll
            for (int e = 0; e < 8; ++e) s += z[e];
            const float mean = wave_sum(s) * (1.0f / 512.0f); float q = 0.f;
#pragma unroll
            for (int e = 0; e < 8; ++e) { z[e] -= mean; q += z[e] * z[e]; }
            const float rstd = __builtin_amdgcn_rsqf(wave_sum(q) * (1.0f / 512.0f) + LN_EPS);
            if ((lane >> 4) == g) {
#pragma unroll
                for (int e = 0; e < 8; ++e) Vl[((lane & 15) * 8 + e) * 136 + tt] = (bf16_t)f2bf(z[e] * rstd * lgv[e] + lbv[e]); }
        }
        __syncthreads();
        f32x4 acc[8];
#pragma unroll
        for (int nt = 0; nt < 8; ++nt) acc[nt] = (f32x4){0.f, 0.f, 0.f, 0.f};
        const int ksmax = (16 * wave + 15) >> 5;
#pragma unroll
        for (int ks = 0; ks < 4; ++ks) if (ks <= ksmax) {
            const bf16x8 af = *(const bf16x8*)(Wl + (16 * wave + fr) * 136 + 32 * ks + 8 * fq);
#pragma unroll
            for (int nt = 0; nt < 8; ++nt) { const bf16x8 bfr = *(const bf16x8*)(Vl + (16 * nt + fr) * 136 + 32 * ks + 8 * fq);
                acc[nt] = __builtin_amdgcn_mfma_f32_16x16x32_bf16(af, bfr, acc[nt], 0, 0, 0); }
        }
        bf16_t ur[4][8];
#pragma unroll
        for (int r = 0; r < 4; ++r)
#pragma unroll
            for (int nt = 0; nt < 8; ++nt) ur[r][nt] = P[(size_t)(m0 + 16 * wave + 4 * fq + r) * PCOLS + PC_SGU + g * 128 + 16 * nt + fr];
        float bsv[4];
#pragma unroll
        for (int r = 0; r < 4; ++r) bsv[r] = sb[16 * wave + 4 * fq + r];
        asm volatile("" ::: "memory");
#pragma unroll
        for (int r = 0; r < 4; ++r) { const int i = 16 * wave + 4 * fq + r; const float bs = bsv[r]; const size_t m = (size_t)(m0 + i);
#pragma unroll
            for (int nt = 0; nt < 8; ++nt) { const int dcol = g * 128 + 16 * nt + fr; const float uu = gelu_erf(bf2f(ur[r][nt]));
                Y[m * D + 1024 + dcol] = (bf16_t)f2bf(uu * (acc[nt][r] + bs)); } }
    }
}
DI void scan_load_chunk(unsigned char* bufp, const float* Rr, const float* Wr, const float* Kr, const float* Ar, const float* Br, const float* Vr, size_t base, int c, int rg, int lt) {
    const float* arrs[5] = {Rr, Wr, Kr, Ar, Br};
#pragma unroll
    for (int ar = 0; ar < 5; ++ar)
#pragma unroll
        for (int ps = 0; ps < 2; ++ps) { const int tt = ps * 16 + (lt >> 4), c4 = (lt & 15) * 4;
            const f32x4 v = *(const f32x4*)(arrs[ar] + base + (size_t)(c * 32 + tt) * RW + c4);
            *(f32x4*)(bufp + ar * 8192 + (tt * 64 + c4) * 4) = v; }
    if (lt < 128) { const int tt = lt >> 2, i4 = (lt & 3) * 4; const f32x4 v = *(const f32x4*)(Vr + base + (size_t)(c * 32 + tt) * RW + rg * 16 + i4);
        *(f32x4*)(bufp + 5 * 8192 + (tt * 16 + i4) * 4) = v; }
}
DI void scan_phase(const Args& a, unsigned char* lds) {
    const int tidx_ = otid();
    const int tid = tidx_;
    const float* Rr = (const float*)(a.ws + OFF_SCR); const float* Wr = Rr + (size_t)M * RW; const float* Kr = Wr + (size_t)M * RW; const float* Vr = Kr + (size_t)M * RW; const float* Ar = Vr + (size_t)M * RW; const float* Br = Ar + (size_t)M * RW;
    float* Yraw = (float*)(a.ws + OFF_X);
    constexpr int BUFB = 5 * 8192 + 2048;
    constexpr int NCH = SEQ / 32;
    for (int unit = blockIdx.x; unit < 256; unit += gridDim.x) {
        const int rg = unit & 3, h = (unit >> 2) & 15, b_ = unit >> 6;
        const size_t base = (size_t)b_ * SEQ * RW + h * 64;
        __syncthreads();
        const bool loader = tid >= 256; const int lt = tid - 256;
        if (loader) scan_load_chunk(lds, Rr, Wr, Kr, Ar, Br, Vr, base, 0, rg, lt);
        __syncthreads();
        float S0 = 0.f, S1 = 0.f, S2 = 0.f, S3 = 0.f;
        const int i = tid >> 4, c4 = tid & 15;
#pragma unroll 1
        for (int c = 0; c < NCH; ++c) {
            if (loader) {
                if (c > 0 && lt < 128) { const int tt = lt >> 2, i4 = (lt & 3) * 4; const f32x4 y = *(const f32x4*)(lds + 2 * BUFB + ((c - 1) & 1) * 2048 + (tt * 16 + i4) * 4);
                    *(f32x4*)(Yraw + base + (size_t)((c - 1) * 32 + tt) * RW + rg * 16 + i4) = y; }
                if (c + 1 < NCH) scan_load_chunk(lds + ((c + 1) & 1) * BUFB, Rr, Wr, Kr, Ar, Br, Vr, base, c + 1, rg, lt);
            } else {
                const unsigned char* bufp = lds + (c & 1) * BUFB; float* yb = (float*)(lds + 2 * BUFB + (c & 1) * 2048);
#pragma unroll 4
                for (int s = 0; s < 32; ++s) {
                    const f32x4 r4 = *(const f32x4*)(bufp + 0 * 8192 + (s * 64 + c4 * 4) * 4);
                    const f32x4 w4 = *(const f32x4*)(bufp + 1 * 8192 + (s * 64 + c4 * 4) * 4);
                    const f32x4 k4 = *(const f32x4*)(bufp + 2 * 8192 + (s * 64 + c4 * 4) * 4);
                    const f32x4 a4 = *(const f32x4*)(bufp + 3 * 8192 + (s * 64 + c4 * 4) * 4);
                    const f32x4 b4 = *(const f32x4*)(bufp + 4 * 8192 + (s * 64 + c4 * 4) * 4);
                    const float vi = *(const float*)(bufp + 5 * 8192 + (s * 16 + i) * 4);
                    float sa = (S0 * a4[0] + S1 * a4[1]) + (S2 * a4[2] + S3 * a4[3]);
                    sa = row16_sum(sa);
                    S0 = S0 * w4[0] + sa * b4[0] + vi * k4[0]; S1 = S1 * w4[1] + sa * b4[1] + vi * k4[1];
                    S2 = S2 * w4[2] + sa * b4[2] + vi * k4[2]; S3 = S3 * w4[3] + sa * b4[3] + vi * k4[3];
                    float yp = (S0 * r4[0] + S1 * r4[1]) + (S2 * r4[2] + S3 * r4[3]);
                    yp = row16_sum(yp);
                    if (c4 == 0) yb[s * 16 + i] = yp;
                }
            }
            __syncthreads();
        }
        if (loader && lt < 128) { const int tt = lt >> 2, i4 = (lt & 3) * 4; const f32x4 y = *(const f32x4*)(lds + 2 * BUFB + ((NCH - 1) & 1) * 2048 + (tt * 16 + i4) * 4);
            *(f32x4*)(Yraw + base + (size_t)((NCH - 1) * 32 + tt) * RW + rg * 16 + i4) = y; }
    }
}
DI void rwkv_fin_phase(const Args& a, int L) {
    const int tidx_ = otid();
    const int wave = __builtin_amdgcn_readfirstlane(tidx_ >> 6), lane = tidx_ & 63;
    const float* Rr = (const float*)(a.ws + OFF_SCR); const float* Kr = Rr + 2 * (size_t)M * RW; const float* Vr = Kr + (size_t)M * RW;
    const float* Yraw = (const float*)(a.ws + OFF_X); const bf16_t* Gb = (const bf16_t*)(a.ws + OFF_MG); bf16_t* Y = (bf16_t*)(a.ws + OFF_Y);
    const float* rk = a.in[I_RK] + L * RW; const float* gng = a.in[I_GNG] + L * RW; const float* gnb = a.in[I_GNB] + L * RW;
    for (int it = blockIdx.x * 8 + wave; it < M * 16; it += gridDim.x * 8) {
        const int m = it >> 4, h = it & 15, c = h * 64 + lane; const size_t o = (size_t)m * RW + c;
        const float y = Yraw[o], r = Rr[o], k = Kr[o], v = Vr[o];
        const float mean = wave_sum(y) * (1.0f / 64.0f); const float d = y - mean; const float var = wave_sum(d * d) * (1.0f / 64.0f);
        const float yn = d * (1.0f / sqrtf(var + 64e-5f)) * gng[c] + gnb[c];
        const float bonus = wave_sum(r * k * rk[c]) * v;
        Y[(size_t)m * D + c] = (bf16_t)f2bf((yn + bonus) * bf2f(Gb[o]));
    }
}
DI void rwkv_par_phase(const Args& a, int L, unsigned char* lds) {
    const int tidx_ = otid();
    const int tid = tidx_, wave = __builtin_amdgcn_readfirstlane(tid >> 6), lane = tid & 63, fr = lane & 15, q = lane >> 4;
    const bf16_t* P = (const bf16_t*)(a.ws + OFF_P); unsigned char* RECB = a.ws + OFF_SCR;
    const bf16_t* W2T = (const bf16_t*)(a.ws + OFF_LW2); const bf16_t* A2T = (const bf16_t*)(a.ws + OFF_LA2); const bf16_t* G2T = (const bf16_t*)(a.ws + OFF_LG2);
    const float* mu = a.in[I_MU] + (size_t)L * 3360; const float* w0 = a.in[I_W0] + L * RW; const float* a0 = a.in[I_A0] + L * RW;
    const float* kkw = a.in[I_KK] + L * RW; const float* kaw = a.in[I_KA] + L * RW; const float* rkw = a.in[I_RK] + L * RW;
    unsigned char* XL = lds;
    unsigned char* WS = lds + 9472 + wave * 12288;
    for (int unit = blockIdx.x; unit < NB * 256; unit += gridDim.x) {
        const int b_ = unit >> 8, cidx = unit & 255; const int m0 = b_ * SEQ + cidx * 16;
        __syncthreads();
        int tb9 = tid; asm volatile("" : "+v"(tb9));
#pragma unroll
        for (int it9 = 0; it9 < 9; ++it9) { const int idx = tb9 + 512 * it9; const int t = idx / 288, jj = idx - t * 288; const int m = m0 + t;
            const float cur = bf2f(P[(size_t)m * PCOLS + PC_LORA + jj]); const float prev = (m & (SEQ - 1)) == 0 ? 0.f : bf2f(P[(size_t)(m - 1) * PCOLS + PC_LORA + jj]);
            float x = cur + (prev - cur) * mu[3072 + jj];
            if (jj < 64) { const float e2x = __expf(2.0f * x); x = 1.0f - 2.0f * __builtin_amdgcn_rcpf(e2x + 1.0f); } else if (jj >= 128) x = __builtin_amdgcn_rcpf(1.0f + __expf(-x));
            *(bf16_t*)(XL + t * 592 + jj * 2) = (bf16_t)f2bf(x); }
        __syncthreads();
#define AXF(ks) (*(const bf16x8*)(XL + fr * 592 + (32 * (ks) + 8 * q) * 2))
#pragma unroll 1
        for (int hh2 = 0; hh2 < 2; ++hh2) {
            const int h = wave + 8 * hh2; const int c = h * 64 + lane;
            unsigned char* rec = RECB + (size_t)(cidx * 64 + b_ * 16 + h) * REC;
            const bool first = (m0 & (SEQ - 1)) == 0;
            const bf16_t* pbase = P + (size_t)m0 * PCOLS + h * 64 + lane;
            unsigned rawrk[17], rawvv[9];
#pragma unroll
            for (int t = 0; t < 17; ++t) { const bf16_t* pc = pbase + (ptrdiff_t)(t - 1) * PCOLS; const bool ok = t > 0 || !first;
                const unsigned rr_ = ok ? (unsigned)pc[PC_R] : 0u, kk_ = ok ? (unsigned)pc[PC_K] : 0u, vv_ = ok ? (unsigned)pc[PC_V] : 0u;
                rawrk[t] = rr_ | (kk_ << 16); if (t & 1) rawvv[t >> 1] |= vv_ << 16; else rawvv[t >> 1] = vv_; }
            const float w0c = w0[c], a0c = a0[c], kkc = kkw[c], kac = kaw[c], rkc = rkw[c], mur = mu[c], muk = mu[1024 + c], muv = mu[2048 + c];
            bf16x8 bwf[4][2], baf[4][2];
#pragma unroll
            for (int nt = 0; nt < 4; ++nt) { const int cn = h * 64 + 16 * nt + fr;
#pragma unroll
                for (int ks = 0; ks < 2; ++ks) { bwf[nt][ks] = *(const bf16x8*)(W2T + cn * 64 + 32 * ks + 8 * q); baf[nt][ks] = *(const bf16x8*)(A2T + cn * 64 + 32 * ks + 8 * q); } }
            asm volatile("" ::: "memory");
            f32x4 accW[4], accA[4], accG[4];
#pragma unroll
            for (int nt = 0; nt < 4; ++nt) { accW[nt] = (f32x4){0.f, 0.f, 0.f, 0.f}; accA[nt] = accW[nt]; accG[nt] = accW[nt];
#pragma unroll
                for (int ks = 0; ks < 2; ++ks) { accW[nt] = __builtin_amdgcn_mfma_f32_16x16x32_bf16(AXF(ks), bwf[nt][ks], accW[nt], 0, 0, 0); accA[nt] = __builtin_amdgcn_mfma_f32_16x16x32_bf16(AXF(2 + ks), baf[nt][ks], accA[nt], 0, 0, 0); } }
#pragma unroll
            for (int n2 = 0; n2 < 2; ++n2) { bf16x8 bgf[2][5];
#pragma unroll
                for (int nn = 0; nn < 2; ++nn) { const int cn = h * 64 + 16 * (2 * n2 + nn) + fr;
#pragma unroll
                    for (int ks = 0; ks < 5; ++ks) bgf[nn][ks] = *(const bf16x8*)(G2T + cn * 160 + 32 * ks + 8 * q); }
                asm volatile("" ::: "memory");
#pragma unroll
                for (int nn = 0; nn < 2; ++nn)
#pragma unroll
                    for (int ks = 0; ks < 5; ++ks) accG[2 * n2 + nn] = __builtin_amdgcn_mfma_f32_16x16x32_bf16(AXF(4 + ks), bgf[nn][ks], accG[2 * n2 + nn], 0, 0, 0); }
            float* X3 = (float*)WS;
#pragma unroll
            for (int nt = 0; nt < 4; ++nt)
#pragma unroll
                for (int r = 0; r < 4; ++r) { const int o = (4 * q + r) * 64 + 16 * nt + fr; X3[o] = accW[nt][r]; X3[1024 + o] = accA[nt][r]; X3[2048 + o] = accG[nt][r]; }
            float cum[16], asg[16];
            { float run = 0.f;
#pragma unroll
              for (int t = 0; t < 16; ++t) { float dw = X3[t * 64 + lane], da = X3[1024 + t * 64 + lane], dg = X3[2048 + t * 64 + lane];
#if DBG_LORA
                  { const float* w2 = a.in[I_W2] + (size_t)L * 64 * RW; const float* a2 = a.in[I_A2] + (size_t)L * 64 * RW; const float* g2 = a.in[I_G2] + (size_t)L * 160 * RW;
                    float s0 = 0.f, s1 = 0.f, s2 = 0.f;
                    for (int jj = 0; jj < 64; ++jj) { s0 += bf2f(*(const bf16_t*)(XL + t * 592 + jj * 2)) * w2[(size_t)jj * RW + c]; s1 += bf2f(*(const bf16_t*)(XL + t * 592 + (64 + jj) * 2)) * a2[(size_t)jj * RW + c]; }
                    for (int jj = 0; jj < 160; ++jj) s2 += bf2f(*(const bf16_t*)(XL + t * 592 + (128 + jj) * 2)) * g2[(size_t)jj * RW + c];
                    dw = s0; da = s1; dg = s2; }
#endif
                  const float nx = -(w0c + dw); const float sp = nx > 20.f ? nx : __logf(1.0f + __expf(nx));
                  run += -__expf(-sp - 0.5f); cum[t] = run; asg[t] = __builtin_amdgcn_rcpf(1.0f + __expf(-(a0c + da)));
                  *(bf16_t*)(rec + R_G + (t * 64 + lane) * 2) = (bf16_t)f2bf(dg); } }
            asm volatile("" ::: "memory");
            const float gC = __expf(cum[15]); *(float*)(rec + R_GC + lane * 4) = gC;
            bf16_t* imgA = (bf16_t*)WS; bf16_t* imgR = (bf16_t*)(WS + 2304); bf16_t* imgB = (bf16_t*)(WS + 4608); bf16_t* imgK = (bf16_t*)(WS + 6912);
            float At[16]; unsigned vpk[8]; float bgv[4], kgv[4]; float vprev = 0.f;
            float rp = bflo(rawrk[0]), kp = bfhi(rawrk[0]), vp = bflo(rawvv[0]);
            float eprev = 1.0f;
#pragma unroll
            for (int t = 0; t < 16; ++t) {
                const float rc = bflo(rawrk[t + 1]), kc = bfhi(rawrk[t + 1]), vc = ((t + 1) & 1) ? bfhi(rawvv[(t + 1) >> 1]) : bflo(rawvv[(t + 1) >> 1]);
                const float r = rc + (rp - rc) * mur, k = kc + (kp - kc) * muk, v = vc + (vp - vc) * muv; rp = rc; kp = kc; vp = vc;
                const float asig = asg[t];
                const float kk = k * kkc; const float kkn = kk * __builtin_amdgcn_rsqf(fmaxf(wave_sum(kk * kk), 1e-24f));
                const float k2 = k * (1.0f + (asig - 1.0f) * kac); const float av = -kkn, bv = kkn * asig;
                const float bon = wave_sum(r * k2 * rkc); if (lane == 0) *(float*)(rec + R_BON + t * 4) = bon;
                const float e2 = __expf(cum[t]), e3 = __expf(-cum[t]), e4 = __expf(cum[15] - cum[t]);
                At[t] = eprev * av; eprev = e2;
                const float Rt = e2 * r, Bt = bv * e3, Kt = k2 * e3;
                imgA[t * 72 + lane] = (bf16_t)f2bf(At[t]); imgR[t * 72 + lane] = (bf16_t)f2bf(Rt); imgB[t * 72 + lane] = (bf16_t)f2bf(Bt); imgK[t * 72 + lane] = (bf16_t)f2bf(Kt);
                *(bf16_t*)(rec + R_RL2 + t * RROW + lane * 2) = (bf16_t)f2bf(Rt);
                bgv[t & 3] = bv * e4; kgv[t & 3] = k2 * e4;
                if ((t & 3) == 3) { u32x4 o; o.x = pk2(bgv[0], bgv[1]); o.y = pk2(bgv[2], bgv[3]); o.z = pk2(kgv[0], kgv[1]); o.w = pk2(kgv[2], kgv[3]); *(u32x4*)(rec + R_A2 + (lane * 4 + (t >> 2)) * 16) = o; }
                if (t & 1) vpk[t >> 1] = pk2(vprev, v); else vprev = v; }
            { u32x4 o0, o1; o0.x = vpk[0]; o0.y = vpk[1]; o0.z = vpk[2]; o0.w = vpk[3]; o1.x = vpk[4]; o1.y = vpk[5]; o1.z = vpk[6]; o1.w = vpk[7];
              *(u32x4*)(rec + R_VT + lane * 32) = o0; *(u32x4*)(rec + R_VT + lane * 32 + 16) = o1; }
            asm volatile("" ::: "memory");
            f32x4 gAB = (f32x4){0.f, 0.f, 0.f, 0.f}, gAK = gAB, gBR = gAB, gKR = gAB;
#pragma unroll
            for (int ks = 0; ks < 2; ++ks) { const int off = fr * 72 + 32 * ks + 8 * q;
                const bf16x8 fA = *(const bf16x8*)(imgA + off), fR = *(const bf16x8*)(imgR + off), fB = *(const bf16x8*)(imgB + off), fK = *(const bf16x8*)(imgK + off);
                gAB = __builtin_amdgcn_mfma_f32_16x16x32_bf16(fB, fA, gAB, 0, 0, 0); gAK = __builtin_amdgcn_mfma_f32_16x16x32_bf16(fK, fA, gAK, 0, 0, 0);
                gBR = __builtin_amdgcn_mfma_f32_16x16x32_bf16(fB, fR, gBR, 0, 0, 0); gKR = __builtin_amdgcn_mfma_f32_16x16x32_bf16(fK, fR, gKR, 0, 0, 0); }
#pragma unroll
            for (int r = 0; r < 4; ++r) { const int sI = 4 * q + r; gAB[r] = sI < fr ? gAB[r] : 0.f; gAK[r] = sI < fr ? gAK[r] : 0.f; gBR[r] = sI <= fr ? gBR[r] : 0.f; gKR[r] = sI <= fr ? gKR[r] : 0.f; }
            { u32x4 o; o.x = pk2(gBR[0], gBR[1]); o.y = pk2(gBR[2], gBR[3]); o.z = pk2(gKR[0], gKR[1]); o.w = pk2(gKR[2], gKR[3]); *(u32x4*)(rec + R_A3 + (fr * 4 + q) * 16) = o; }
            asm volatile("" ::: "memory");
            float* AKL = (float*)(WS + 9216);
#pragma unroll
            for (int r = 0; r < 4; ++r) AKL[(4 * q + r) * 16 + fr] = gAK[r];
            float Ft[16];
            { const f32x4* row = (const f32x4*)(AKL + (lane & 15) * 16);
#pragma unroll
              for (int t4 = 0; t4 < 4; ++t4) { const f32x4 v4 = row[t4]; Ft[4 * t4] = v4[0]; Ft[4 * t4 + 1] = v4[1]; Ft[4 * t4 + 2] = v4[2]; Ft[4 * t4 + 3] = v4[3]; } }
#pragma unroll
            for (int t = 1; t < 16; ++t) { float e = At[t], f = Ft[t];
#pragma unroll
                for (int s2 = 0; s2 < t; ++s2) { const float gsel = gAB[s2 & 3];
                    const float sc = __int_as_float(__builtin_amdgcn_readlane(__float_as_int(gsel), t + 16 * (s2 >> 2))); e += At[s2] * sc; f += Ft[s2] * sc; }
                At[t] = e; Ft[t] = f; }
#pragma unroll
            for (int t = 0; t < 16; ++t) *(bf16_t*)(rec + R_EL2 + t * RROW + lane * 2) = (bf16_t)f2bf(At[t]);
            asm volatile("" ::: "memory");
            float* FL = (float*)(WS + 10240);
            if (lane < 16) {
#pragma unroll
                for (int t4 = 0; t4 < 4; ++t4) *(f32x4*)(FL + lane * 16 + 4 * t4) = (f32x4){Ft[4 * t4], Ft[4 * t4 + 1], Ft[4 * t4 + 2], Ft[4 * t4 + 3]}; }
            { const float f0 = FL[(4 * q + 0) * 16 + fr], f1 = FL[(4 * q + 1) * 16 + fr], f2 = FL[(4 * q + 2) * 16 + fr], f3 = FL[(4 * q + 3) * 16 + fr];
              u32x2 o; o.x = pk2(f0, f1); o.y = pk2(f2, f3); *(u32x2*)(rec + R_FT + (fr * 4 + q) * 8) = o; }
            asm volatile("" ::: "memory");
        }
    }
#undef AXF
}
DI bf16x8 mk8(u32x2 lo, u32x2 hi) { u32x4 w; w.x = lo.x; w.y = lo.y; w.z = hi.x; w.w = hi.y; return __builtin_bit_cast(bf16x8, w); }
struct SeqOps { u32x2 e[2][2], r[2][2]; u32x4 a2[4]; u32x4 a3; u32x2 ft, vt; f32x4 gc[4]; };
DI void seq_ops_load(SeqOps& f, const LAS unsigned char* rec, int fr, int q, int i0) {
#pragma unroll
    for (int ks = 0; ks < 2; ++ks) { f.e[ks][0] = *(const LAS u32x2*)(rec + R_EL2 + fr * RROW + (32 * ks + 4 * q) * 2); f.e[ks][1] = *(const LAS u32x2*)(rec + R_EL2 + fr * RROW + (32 * ks + 16 + 4 * q) * 2);
        f.r[ks][0] = *(const LAS u32x2*)(rec + R_RL2 + fr * RROW + (32 * ks + 4 * q) * 2); f.r[ks][1] = *(const LAS u32x2*)(rec + R_RL2 + fr * RROW + (32 * ks + 16 + 4 * q) * 2); }
#pragma unroll
    for (int jt = 0; jt < 4; ++jt) { f.a2[jt] = *(const LAS u32x4*)(rec + R_A2 + ((16 * jt + fr) * 4 + q) * 16); f.gc[jt] = *(const LAS f32x4*)(rec + R_GC + (16 * jt + 4 * q) * 4); }
    f.a3 = *(const LAS u32x4*)(rec + R_A3 + (fr * 4 + q) * 16); f.ft = *(const LAS u32x2*)(rec + R_FT + (fr * 4 + q) * 8); f.vt = *(const LAS u32x2*)(rec + R_VT + ((i0 + fr) * 16 + 4 * q) * 2);
}
DI void rwkv_seq_phase(const Args& a, unsigned char* lds, float* yout, const float* gng, const float* gnb, bf16_t* yfin) {
    const int tidx_ = otid();
    const int tid = tidx_, wave = __builtin_amdgcn_readfirstlane(tid >> 6), lane = tid & 63, fr = lane & 15, q = lane >> 4;
    constexpr int NR = 8, DEPTH_ = 6, NCHK = 256;
    LAS unsigned char* ring = (LAS unsigned char*)lds;
    LAS float* ybuf = (LAS float*)(ring + NR * REC);
    for (int bh = blockIdx.x; bh < NB * 16; bh += gridDim.x) {
        const unsigned char* rec0 = a.ws + OFF_SCR + (size_t)bh * REC;
        const int hd = bh & 15;
        asm volatile("s_waitcnt vmcnt(0) lgkmcnt(0)" ::: "memory"); __builtin_amdgcn_s_barrier();
        if (wave >= 4) {
            const int lw = wave - 4;
            const float gg = yfin ? gng[hd * 64 + lane] : 0.f, gb = yfin ? gnb[hd * 64 + lane] : 0.f;
            bf16_t* Yo = yfin + ((size_t)(bh >> 4) * SEQ) * D + hd * 64 + lane;
#define SEQ_ISSUE(cc) do { const unsigned char* g_ = rec0 + (size_t)(cc) * 64 * REC; LAS unsigned char* l_ = ring + ((cc) & (NR - 1)) * REC; \
            _Pragma("unroll") for (int i_ = 0; i_ < 4; ++i_) { int pc_ = i_ * 4 + lw; if (pc_ >= 15) pc_ = lw; \
                __builtin_amdgcn_global_load_lds((const unsigned*)(g_ + pc_ * 1024 + lane * 16), (LAS unsigned*)(l_ + pc_ * 1024), 16, 0, 0); } } while (0)
#define SEQ_FINALIZE(cf) do { const LAS unsigned char* rc_ = ring + ((cf) & (NR - 1)) * REC; const LAS float* yb_ = ybuf + ((cf) & 1) * 1024; \
            const u32x2 vv_ = *(const LAS u32x2*)(rc_ + R_VT + (lane * 16 + 4 * lw) * 2); \
            float y_[4], rd_[8]; \
            _Pragma("unroll") for (int tt_ = 0; tt_ < 4; ++tt_) { y_[tt_] = yb_[(4 * lw + tt_) * 64 + lane]; rd_[tt_] = y_[tt_]; rd_[4 + tt_] = y_[tt_] * y_[tt_]; } \
            wave_sum8(rd_);        \
            _Pragma("unroll") for (int tt_ = 0; tt_ < 4; ++tt_) { const int t_ = 4 * lw + tt_; \
                const float mean_ = rd_[tt_] * (1.0f / 64.0f); const float var_ = fmaxf(rd_[4 + tt_] * (1.0f / 64.0f) - mean_ * mean_, 0.f); \
                const float yn_ = (y_[tt_] - mean_) * __builtin_amdgcn_rsqf(var_ + 64e-5f) * gg + gb; \
                const float bon_ = *(const LAS float*)(rc_ + R_BON + t_ * 4); const float g_ = bf2f(*(const LAS bf16_t*)(rc_ + R_G + (t_ * 64 + lane) * 2)); \
                const unsigned vw_ = (tt_ & 2) ? vv_.y : vv_.x; const float v_ = (tt_ & 1) ? bfhi(vw_) : bflo(vw_); \
                Yo[(size_t)(16 * (cf) + t_) * D] = (bf16_t)f2bf((yn_ + bon_ * v_) * g_); } } while (0)
#pragma unroll 1
            for (int cc = 0; cc < DEPTH_; ++cc) SEQ_ISSUE(cc);
            asm volatile("s_waitcnt vmcnt(16)" ::: "memory");
            __builtin_amdgcn_s_barrier();
#pragma unroll 1
            for (int c = 0; c < NCHK; ++c) {
                if (yfin && c > 0) SEQ_FINALIZE(c - 1);
                if (c + DEPTH_ < NCHK) { SEQ_ISSUE(c + DEPTH_); asm volatile("s_waitcnt vmcnt(16)" ::: "memory"); }
                else asm volatile("s_waitcnt vmcnt(0)" ::: "memory");
                asm volatile("s_waitcnt lgkmcnt(0)" ::: "memory");
                __builtin_amdgcn_s_barrier();
            }
            if (yfin) SEQ_FINALIZE(NCHK - 1);
#undef SEQ_ISSUE
#undef SEQ_FINALIZE
        } else {
            const int i0 = wave * 16;
            float* Yp = yout + (size_t)(bh >> 4) * SEQ * RW + hd * 64 + i0 + fr;
            f32x4 S[4];
#pragma unroll
            for (int jt = 0; jt < 4; ++jt) S[jt] = (f32x4){0.f, 0.f, 0.f, 0.f};
            __builtin_amdgcn_s_barrier();
            SeqOps cur, nxt; seq_ops_load(cur, ring, fr, q, i0);
#pragma unroll 1
            for (int c = 0; c < NCHK; ++c) {
                if (c + 1 < NCHK) seq_ops_load(nxt, ring + ((c + 1) & (NR - 1)) * REC, fr, q, i0); else nxt = cur;
                bf16x8 sh[2];
#pragma unroll
                for (int ks = 0; ks < 2; ++ks) { u32x4 hw; hw.x = pk2(S[2 * ks][0], S[2 * ks][1]); hw.y = pk2(S[2 * ks][2], S[2 * ks][3]); hw.z = pk2(S[2 * ks + 1][0], S[2 * ks + 1][1]); hw.w = pk2(S[2 * ks + 1][2], S[2 * ks + 1][3]); sh[ks] = __builtin_bit_cast(bf16x8, hw); }
                const u32x2 z2 = {0u, 0u}; const f32x4 zz = (f32x4){0.f, 0.f, 0.f, 0.f};
                f32x4 Wk[2], Yk[2];
#pragma unroll
                for (int ks = 0; ks < 2; ++ks) { Wk[ks] = __builtin_amdgcn_mfma_f32_16x16x32_bf16(mk8(cur.e[ks][0], cur.e[ks][1]), sh[ks], zz, 0, 0, 0); Yk[ks] = __builtin_amdgcn_mfma_f32_16x16x32_bf16(mk8(cur.r[ks][0], cur.r[ks][1]), sh[ks], zz, 0, 0, 0); }
                const f32x4 Wv = __builtin_amdgcn_mfma_f32_16x16x32_bf16(mk8(cur.ft, z2), mk8(cur.vt, z2), zz, 0, 0, 0);
                const f32x4 W = (Wk[0] + Wk[1]) + Wv; f32x4 Y = Yk[0] + Yk[1];
                u32x2 wp; wp.x = pk2(W[0], W[1]); wp.y = pk2(W[2], W[3]);
                const bf16x8 b2 = mk8(wp, cur.vt);
#pragma unroll
                for (int jt = 0; jt < 4; ++jt) S[jt] = __builtin_amdgcn_mfma_f32_16x16x32_bf16(__builtin_bit_cast(bf16x8, cur.a2[jt]), b2, S[jt] * cur.gc[jt], 0, 0, 0);
                Y = __builtin_amdgcn_mfma_f32_16x16x32_bf16(__builtin_bit_cast(bf16x8, cur.a3), b2, Y, 0, 0, 0);
                if (yfin) {
#pragma unroll
                    for (int r = 0; r < 4; ++r) ybuf[(c & 1) * 1024 + (4 * q + r) * 64 + i0 + fr] = Y[r];
                } else {
#pragma unroll
                    for (int r = 0; r < 4; ++r) Yp[(size_t)(16 * c + 4 * q + r) * RW] = Y[r];
                }
                asm volatile("s_waitcnt lgkmcnt(0)" ::: "memory");
                __builtin_amdgcn_s_barrier();
                cur = nxt;
            }
        }
    }
}
DI void rwkv_fin2_phase(const Args& a, int L) {
    const int tidx_ = otid();
    const int wave = __builtin_amdgcn_readfirstlane(tidx_ >> 6), lane = tidx_ & 63;
    const float* Yraw = (const float*)(a.ws + OFF_X); bf16_t* Y = (bf16_t*)(a.ws + OFF_Y);
    const float* gng = a.in[I_GNG] + L * RW; const float* gnb = a.in[I_GNB] + L * RW;
    for (int u = blockIdx.x * 8 + wave; u < NB * 16 * 256; u += gridDim.x * 8) {
        const int cidx = u & 255, bh = u >> 8, h = bh & 15, b_ = bh >> 4; const int c = h * 64 + lane;
        const unsigned char* rec = a.ws + OFF_SCR + (size_t)(cidx * 64 + bh) * REC;
        const u32x4 v0 = *(const u32x4*)(rec + R_VT + lane * 32), v1 = *(const u32x4*)(rec + R_VT + lane * 32 + 16);
        const unsigned vw[8] = {v0.x, v0.y, v0.z, v0.w, v1.x, v1.y, v1.z, v1.w};
        const float gg = gng[c], gb = gnb[c];
#pragma unroll
        for (int t = 0; t < 16; ++t) { const size_t m = (size_t)b_ * SEQ + cidx * 16 + t;
            const float y = Yraw[m * RW + c];
            const float mean = wave_sum(y) * (1.0f / 64.0f); const float d = y - mean; const float var = wave_sum(d * d) * (1.0f / 64.0f);
            const float yn = d * __builtin_amdgcn_rsqf(var + 64e-5f) * gg + gb;
            const float bon = *(const float*)(rec + R_BON + t * 4); const float g = bf2f(*(const bf16_t*)(rec + R_G + (t * 64 + lane) * 2));
            const float v = (t & 1) ? bfhi(vw[t >> 1]) : bflo(vw[t >> 1]);
            Y[m * D + c] = (bf16_t)f2bf((yn + bon * v) * g); }
    }
}
DI void dbg_compare_phase(const Args& a) {
    const int tidx_ = otid();
    const float* y0 = (const float*)(a.ws + OFF_X); const float* y1 = y0 + (size_t)M * RW; float* acc = (float*)(a.ws + OFF_CTL) + 2048;
    float s0 = 0.f, s1 = 0.f, s2 = 0.f, s3 = 0.f;
    for (size_t i = (size_t)blockIdx.x * 512 + tidx_; i < (size_t)M * RW; i += (size_t)gridDim.x * 512) { const float o = y0[i], d = y1[i] - o; const int tok = (int)((i / RW) & (SEQ - 1));
        s0 += d * d; s1 += o * o; if (tok < 16) { s2 += d * d; s3 += o * o; } }
    s0 = wave_sum(s0); s1 = wave_sum(s1); s2 = wave_sum(s2); s3 = wave_sum(s3);
    if ((tidx_ & 63) == 0) { atomicAdd(acc + 0, s0); atomicAdd(acc + 1, s1); atomicAdd(acc + 2, s2); atomicAdd(acc + 3, s3); }
}
DI void dbg_encode_phase(const Args& a) {
    const int tidx_ = otid();
    float* acc = (float*)(a.ws + OFF_CTL) + 2048;
    const float s0 = __hip_atomic_load(acc + 0, __ATOMIC_RELAXED, __HIP_MEMORY_SCOPE_AGENT), s1 = __hip_atomic_load(acc + 1, __ATOMIC_RELAXED, __HIP_MEMORY_SCOPE_AGENT);
    const float s2 = __hip_atomic_load(acc + 2, __ATOMIC_RELAXED, __HIP_MEMORY_SCOPE_AGENT), s3 = __hip_atomic_load(acc + 3, __ATOMIC_RELAXED, __HIP_MEMORY_SCOPE_AGENT);
    const float e1 = sqrtf(s0 / fmaxf(s1, 1e-30f)), e2 = sqrtf(s2 / fmaxf(s3, 1e-30f));
    for (size_t i = (size_t)blockIdx.x * 512 + tidx_; i < (size_t)M * D; i += (size_t)gridDim.x * 512) { float v = a.out[i] * (1.0f + e1); if (i == 0) v += 1000.0f * e2; a.out[i] = v; }
}
DI unsigned f2ord(float f) { const unsigned u = __builtin_bit_cast(unsigned, f); return (u & 0x80000000u) ? ~u : (u | 0x80000000u); }
DI float xrow16_sum(float x) {
    auto p = __builtin_amdgcn_permlane16_swap(__float_as_uint(x), __float_as_uint(x), false, false);
    x = __uint_as_float(p[0]) + __uint_as_float(p[1]);
    auto q = __builtin_amdgcn_permlane32_swap(__float_as_uint(x), __float_as_uint(x), false, false);
    return __uint_as_float(q[0]) + __uint_as_float(q[1]);
}
template <int CTRL> DI int dpp_i(int x) { return __builtin_amdgcn_update_dpp(0, x, CTRL, 0xF, 0xF, true); }
DI int wave_sum_i(int x) {
    x += dpp_i<0xB1>(x); x += dpp_i<0x4E>(x); x += dpp_i<0x141>(x); x += dpp_i<0x140>(x);
    auto p = __builtin_amdgcn_permlane16_swap((unsigned)x, (unsigned)x, false, false); x = (int)p[0] + (int)p[1];
    auto q = __builtin_amdgcn_permlane32_swap((unsigned)x, (unsigned)x, false, false); return (int)q[0] + (int)q[1];
}
DI void indexer_phase(const Args& a, unsigned char* lds, int vb, int nvb) {
    const int tidx_ = otid();
    const int tid = tidx_, wave = __builtin_amdgcn_readfirstlane(tid >> 6), lane = tid & 63, hh = lane & 15, kq = lane >> 4;
    const bf16_t* P = (const bf16_t*)(a.ws + OFF_P); const bf16_t* KI = (const bf16_t*)(a.ws + OFF_KI); unsigned long long* BMk = (unsigned long long*)(a.ws + OFF_BM);
    constexpr int STG = 256 * 128;
    unsigned long long* wbuf = (unsigned long long*)(lds + 2 * STG + wave * 512);
    const int srow = tid >> 3, sch = tid & 7;
    const int wr_off = srow * 128 + ((sch ^ (srow & 7)) << 4);
    const int rd0 = hh * 128 + ((kq ^ (hh & 7)) << 4), rd1 = hh * 128 + (((kq + 4) ^ (hh & 7)) << 4);
    for (int J0 = vb * 2; J0 < NB * 512; J0 += nvb * 2)
#pragma unroll 1
    for (int ii = 0; ii < 2; ++ii) {
        const int J = J0 + ii; const int b_ = J >> 9, j = J & 511; const int qg = (j & 1) ? 511 - (j >> 1) : (j >> 1);
        const int t0 = qg * 8, t = t0 + wave, nk = t0 + 8; const size_t m = (size_t)b_ * SEQ + t;
        const int nst = (nk + 255) >> 8;
        bf16x8 aq[2];
        aq[0] = *(const bf16x8*)(P + m * PCOLS + PC_QI + hh * 64 + 8 * kq); aq[1] = *(const bf16x8*)(P + m * PCOLS + PC_QI + hh * 64 + 32 + 8 * kq);
        float blo[4], bhi[4];
#pragma unroll
        for (int r = 0; r < 4; ++r) { const bool pos = bf2f(P[m * PCOLS + PC_WI + 4 * kq + r]) >= 0.f; blo[r] = pos ? 0.f : -__builtin_inff(); bhi[r] = pos ? __builtin_inff() : 0.f; }
        { const float wrow = bf2f(P[m * PCOLS + PC_WI + hh]) * 0.03125f;
#pragma unroll
          for (int ks = 0; ks < 2; ++ks) { const u32x4 w4 = __builtin_bit_cast(u32x4, aq[ks]); u32x4 o4;
              o4.x = pk2(bflo(w4.x) * wrow, bfhi(w4.x) * wrow); o4.y = pk2(bflo(w4.y) * wrow, bfhi(w4.y) * wrow); o4.z = pk2(bflo(w4.z) * wrow, bfhi(w4.z) * wrow); o4.w = pk2(bflo(w4.w) * wrow, bfhi(w4.w) * wrow);
              aq[ks] = __builtin_bit_cast(bf16x8, o4); } }
        unsigned sc[64];
        const bf16_t* kig = KI + ((size_t)b_ * SEQ + srow) * 64 + sch * 8;
#pragma unroll 1
        for (int rep21 = 0; rep21 < ((REP_MASK >> 21) & 1u) + 1; ++rep21) {
#pragma unroll
        for (int r = 0; r < 64; ++r) sc[r] = 0u;
        u32x4 kp[4];
#pragma unroll
        for (int q = 0; q < 4; ++q) kp[q] = *(const u32x4*)(kig + (size_t)q * 64 * 64);
        __syncthreads();
        asm volatile("" :: "v"(aq[0]), "v"(aq[1]), "v"(blo[0]), "v"(blo[1]), "v"(blo[2]), "v"(blo[3]));
#pragma unroll 1
        for (int st = 0; st < nst; ++st) {
            const int k0 = st * 256;
            unsigned char* sb = lds + (st & 1) * STG;
#pragma unroll
            for (int q = 0; q < 4; ++q) *(u32x4*)(sb + q * 64 * 128 + wr_off) = kp[q];
            __syncthreads();
            if (st + 1 < nst) {
#pragma unroll
                for (int q = 0; q < 4; ++q) kp[q] = *(const u32x4*)(kig + (size_t)(k0 + 256 + q * 64) * 64);
            }
#pragma unroll
            for (int r = 0; r < 60; ++r) sc[r] = sc[r + 4];
#pragma unroll
            for (int cc = 0; cc < 4; ++cc) {
                const int kc = k0 + cc * 64;
                unsigned res = 0u;
                {
                    float sv[4];
#pragma unroll
                    for (int sub = 0; sub < 4; ++sub) {
                        const unsigned char* kb = sb + (cc * 64 + sub * 16) * 128;
                        const bf16x8 b0 = *(const bf16x8*)(kb + rd0), b1 = *(const bf16x8*)(kb + rd1);
                        f32x4 acc = (f32x4){0.f, 0.f, 0.f, 0.f};
                        acc = __builtin_amdgcn_mfma_f32_16x16x32_bf16(aq[0], b0, acc, 0, 0, 0);
                        acc = __builtin_amdgcn_mfma_f32_16x16x32_bf16(aq[1], b1, acc, 0, 0, 0);
                        sv[sub] = (__builtin_amdgcn_fmed3f(acc[0], blo[0], bhi[0]) + __builtin_amdgcn_fmed3f(acc[1], blo[1], bhi[1])) + (__builtin_amdgcn_fmed3f(acc[2], blo[2], bhi[2]) + __builtin_amdgcn_fmed3f(acc[3], blo[3], bhi[3]));
                    }
                    auto p01 = __builtin_amdgcn_permlane16_swap(__float_as_uint(sv[0]), __float_as_uint(sv[1]), false, false);
                    auto p23 = __builtin_amdgcn_permlane16_swap(__float_as_uint(sv[2]), __float_as_uint(sv[3]), false, false);
                    const float x01 = __uint_as_float(p01[0]) + __uint_as_float(p01[1]), x23 = __uint_as_float(p23[0]) + __uint_as_float(p23[1]);
                    auto pf = __builtin_amdgcn_permlane32_swap(__float_as_uint(x01), __float_as_uint(x23), false, false);
                    const float tot = __uint_as_float(pf[0]) + __uint_as_float(pf[1]);
                    res = (kc + lane <= t) ? f2ord(tot) : 0u;
                }
                sc[60 + cc] = res;
            }
        }
        }
        const int roff = 64 - 4 * nst;
#pragma unroll 1
        for (int rep22 = 0; rep22 < ((REP_MASK >> 22) & 1u) + 1; ++rep22) {
        if (t + 1 > 256) {
            unsigned Hh[32], Ll[32];
#pragma unroll
            for (int p = 0; p < 32; ++p) { Hh[p] = __builtin_amdgcn_perm(sc[2 * p + 1], sc[2 * p], 0x07060302u); Ll[p] = __builtin_amdgcn_perm(sc[2 * p + 1], sc[2 * p], 0x05040100u); }
            const int poff = roff >> 1;
            const unsigned one2 = 0x00010001u;
#define PK_COUNT(ARR, CM1, OUT) do { unsigned c2_[4] = {0u, 0u, 0u, 0u}; _Pragma("unroll") for (int p8 = 0; p8 < 4; ++p8) if (p8 * 8 + 7 >= poff) { _Pragma("unroll") for (int pp = 0; pp < 8; ++pp) { unsigned d_; \
                asm("v_pk_sub_u16 %0, %1, %2 clamp" : "=v"(d_) : "v"(ARR[p8 * 8 + pp]), "s"(CM1)); asm("v_pk_min_u16 %0, %1, %2" : "=v"(d_) : "v"(d_), "s"(one2)); asm("v_pk_add_u16 %0, %1, %2" : "=v"(c2_[pp & 3]) : "v"(c2_[pp & 3]), "v"(d_)); } } \
                const unsigned cs_ = (c2_[0] + c2_[1]) + (c2_[2] + c2_[3]);        \
                OUT = __builtin_amdgcn_readfirstlane(wave_sum_i((int)((cs_ & 0xffffu) + (cs_ >> 16)))); } while (0)
            unsigned Th = 0u;
#pragma unroll 1
            for (int bit = 15; bit >= 0; --bit) { const unsigned cand = Th | (1u << bit); const unsigned cm1 = cand * one2 - one2; int cnt; PK_COUNT(Hh, cm1, cnt); if (cnt >= 256) Th = cand; }
            int cgt16 = 0; if (Th != 0xffffu) { const unsigned cm1 = Th * one2; PK_COUNT(Hh, cm1, cgt16); }
            const int need16 = 256 - cgt16;
            { const unsigned T2 = Th * one2; const unsigned allones = 0xffffffffu;
#pragma unroll
              for (int p = 0; p < 32; ++p) { unsigned x = Hh[p] ^ T2, ne, keep, msk;
                  asm("v_pk_min_u16 %0, %1, %2" : "=v"(ne) : "v"(x), "s"(one2)); asm("v_pk_sub_u16 %0, %1, %2" : "=v"(keep) : "s"(one2), "v"(ne)); asm("v_pk_mul_lo_u16 %0, %1, %2" : "=v"(msk) : "v"(keep), "s"(allones));
                  Ll[p] &= msk; } }
            unsigned Tl = 0u;
#pragma unroll 1
            for (int bit = 15; bit >= 0; --bit) { const unsigned cand = Tl | (1u << bit); const unsigned cm1 = cand * one2 - one2; int cnt; PK_COUNT(Ll, cm1, cnt); if (cnt >= need16) Tl = cand; }
#undef PK_COUNT
            const unsigned T = (Th << 16) | Tl;
            int cge = 0;
#pragma unroll
            for (int r8 = 0; r8 < 8; ++r8) if (r8 * 8 + 7 >= roff) {
#pragma unroll
                for (int r = 0; r < 8; ++r) cge += (sc[r8 * 8 + r] >= T) ? 1 : 0; }
            cge = __builtin_amdgcn_readfirstlane(wave_sum_i(cge));
            if (lane < roff) wbuf[lane] = 0ull; else wbuf[lane] = 0ull;
            if (cge == 256) {
#pragma unroll
                for (int r8 = 0; r8 < 8; ++r8) {
#pragma unroll
                    for (int r = 0; r < 8; ++r) { const unsigned long long word = __ballot(sc[r8 * 8 + r] >= T); if (lane == 0 && r8 * 8 + r >= roff) wbuf[r8 * 8 + r - roff] = word; }
                    __builtin_amdgcn_sched_barrier(0); }
            } else {
                int cgt = 0;
#pragma unroll
                for (int r8 = 0; r8 < 8; ++r8) {
#pragma unroll
                    for (int r = 0; r < 8; ++r) cgt += __builtin_popcountll(__ballot(sc[r8 * 8 + r] > T));
                    __builtin_amdgcn_sched_barrier(0); }
                int need = 256 - cgt;
#pragma unroll
                for (int r8 = 0; r8 < 8; ++r8) {
#pragma unroll
                    for (int r = 0; r < 8; ++r) { const unsigned long long gt = __ballot(sc[r8 * 8 + r] > T); unsigned long long eq = __ballot(sc[r8 * 8 + r] == T); const int ce = __builtin_popcountll(eq);
                        unsigned long long take;
                        if (ce <= need) { take = eq; need -= ce; }
                        else { take = 0ull; for (; need > 0; --need) { const unsigned long long low = eq & (0ull - eq); take |= low; eq ^= low; } }
                        const unsigned long long word = gt | take; if (lane == 0 && r8 * 8 + r >= roff) wbuf[r8 * 8 + r - roff] = word; }
                    __builtin_amdgcn_sched_barrier(0); }
            }
        } else {
            wbuf[lane] = 0ull;
#pragma unroll
            for (int r8 = 0; r8 < 8; ++r8) {
#pragma unroll
                for (int r = 0; r < 8; ++r) { const unsigned long long word = __ballot(sc[r8 * 8 + r] != 0u); if (lane == 0 && r8 * 8 + r >= roff) wbuf[r8 * 8 + r - roff] = word; }
                __builtin_amdgcn_sched_barrier(0); }
        }
        }
        BMk[m * 64 + lane] = wbuf[lane];
    }
}
DI void attn_phase(const Args& a, unsigned char* lds) {
    const int tidx_ = otid();
    const int tid = tidx_, wave = __builtin_amdgcn_readfirstlane(tid >> 6), lane = tid & 63, ql = lane & 31, hf = lane >> 5;
    const bf16_t* P = (const bf16_t*)(a.ws + OFF_P); const bf16_t* VT = (const bf16_t*)(a.ws + OFF_VT); const unsigned long long* BMk = (const unsigned long long*)(a.ws + OFF_BM);
    const float* biasd = (const float*)(a.ws + OFF_BIAS); bf16_t* Y = (bf16_t*)(a.ws + OFF_Y);
    unsigned char* Kl = lds; unsigned char* Vl = lds + 64 * 144; float* biasl = (float*)(lds + 2 * 64 * 144);
    const float NEG_INF = -__builtin_inff();
    for (int cu = blockIdx.x; cu < 256; cu += gridDim.x)
#pragma unroll 1
    for (int ui = 0; ui < 2; ++ui) {
        const int bh = cu >> 3, s8 = cu & 7, qb = ui == 0 ? s8 : 15 - s8, b_ = bh >> 3, h = bh & 7;
        const int q0w = qb * 256 + 32 * wave, q = q0w + ql; const size_t m = (size_t)b_ * SEQ + q;
        __syncthreads();
        if (tid < 128) biasl[tid] = biasd[h * 128 + tid];
        bf16x8 qf[4];
#pragma unroll
        for (int ks = 0; ks < 4; ++ks) qf[ks] = *(const bf16x8*)(P + m * PCOLS + PC_AQ + h * 64 + 16 * ks + 8 * hf);
        f32x16 O0, O1;
#pragma unroll
        for (int r = 0; r < 16; ++r) { O0[r] = 0.f; O1[r] = 0.f; }
        float mrun = NEG_INF, lrun = 0.f;
        const int nkt = 4 * (qb + 1);
        const int srow = tid >> 3, sch = tid & 7;
        const bf16_t* kbase = P + ((size_t)b_ * SEQ + srow) * PCOLS + PC_AK + h * 64 + sch * 8;
        const bf16_t* vbase = VT + ((size_t)(b_ * 8 + h) * 64 + srow) * SEQ + sch * 8;
#define ATT_COMPUTE \
            const int k0 = kt * 64; \
            if (k0 <= q0w + 31) { \
 \
                f32x16 sa[2]; \
_Pragma("unroll") \
                for (int sub = 0; sub < 2; ++sub) { \
_Pragma("unroll") \
                    for (int r = 0; r < 16; ++r) sa[sub][r] = 0.f; } \
_Pragma("unroll") \
                for (int ks = 0; ks < 4; ++ks) \
_Pragma("unroll") \
                    for (int sub = 0; sub < 2; ++sub) { const bf16x8 kf = *(const bf16x8*)(Kl + (32 * sub + ql) * 144 + (16 * ks + 8 * hf) * 2); \
                        sa[sub] = __builtin_amdgcn_mfma_f32_32x32x16_bf16(kf, qf[ks], sa[sub], 0, 0, 0); } \
                constexpr float C1 = 0.125f * 1.4426950408889634f; constexpr unsigned NINF_BITS = 0xff800000u; \
                const unsigned b31u = __float_as_uint(biasl[127] * 1.4426950408889634f); \
                const bool far = (q0w - (k0 + 63)) >= 113; \
                float x[2][16]; float mx = NEG_INF; \
_Pragma("unroll") \
                for (int sub = 0; sub < 2; ++sub) { \
                    const int w32 = (int)(((unsigned)(bm >> (32 * sub))) >> (4 * hf)); \
                    if (far) { \
_Pragma("unroll") \
                        for (int r = 0; r < 16; ++r) { const int ro = (r & 3) + 8 * (r >> 2); const unsigned tm = (unsigned)__builtin_amdgcn_sbfe(w32, ro, 1); \
                            x[sub][r] = sa[sub][r] * C1 + __uint_as_float((tm & b31u) | (~tm & NINF_BITS)); } \
                    } else { \
_Pragma("unroll") \
                        for (int r = 0; r < 16; ++r) { const int ro = (r & 3) + 8 * (r >> 2); int dd = q - (k0 + 32 * sub + ro + 4 * hf); dd = dd < 0 ? 0 : (dd > 127 ? 127 : dd); \
                            const unsigned tm = (unsigned)__builtin_amdgcn_sbfe(w32, ro, 1); const unsigned bu = __float_as_uint(biasl[dd] * 1.4426950408889634f); \
                            x[sub][r] = sa[sub][r] * C1 + __uint_as_float((tm & bu) | (~tm & NINF_BITS)); } \
                    } \
_Pragma("unroll") \
                    for (int r = 0; r < 16; r += 2) mx = fmaxf(mx, fmaxf(x[sub][r], x[sub][r + 1])); \
                } \
                { auto pm = __builtin_amdgcn_permlane32_swap(__float_as_uint(mx), __float_as_uint(mx), false, false); mx = fmaxf(__uint_as_float(pm[0]), __uint_as_float(pm[1])); } \
                const float mnew = fmaxf(mrun, mx); const float msafe = (mnew == NEG_INF) ? 0.f : mnew; \
                float lsum = 0.f; \
_Pragma("unroll") \
                for (int sub = 0; sub < 2; ++sub) \
_Pragma("unroll") \
                    for (int r = 0; r < 16; ++r) { x[sub][r] = __builtin_amdgcn_exp2f(x[sub][r] - msafe); lsum += x[sub][r]; } \
                if (__builtin_amdgcn_ballot_w64(mnew > mrun) != 0ull) { \
                    const float alpha = __builtin_amdgcn_exp2f(mrun - msafe); \
                    lrun = lrun * alpha + lsum; mrun = mnew; \
_Pragma("unroll") \
                    for (int r = 0; r < 16; ++r) { O0[r] *= alpha; O1[r] *= alpha; } \
                } else lrun += lsum; \
_Pragma("unroll") \
                for (int sub = 0; sub < 2; ++sub) \
_Pragma("unroll") \
                    for (int s = 0; s < 2; ++s) { \
                        u32x4 pw; pw.x = pk2(x[sub][8 * s + 0], x[sub][8 * s + 1]); pw.y = pk2(x[sub][8 * s + 2], x[sub][8 * s + 3]); pw.z = pk2(x[sub][8 * s + 4], x[sub][8 * s + 5]); pw.w = pk2(x[sub][8 * s + 6], x[sub][8 * s + 7]); \
                        const bf16x8 pf = __builtin_bit_cast(bf16x8, pw); \
                        const int kcol = (32 * sub + 16 * s + 4 * hf) * 2; \
                        { const u32x2 lo = *(const u32x2*)(Vl + ql * 144 + kcol), hi = *(const u32x2*)(Vl + ql * 144 + kcol + 16); \
                          u32x4 vw; vw.x = lo.x; vw.y = lo.y; vw.z = hi.x; vw.w = hi.y; \
                          O0 = __builtin_amdgcn_mfma_f32_32x32x16_bf16(__builtin_bit_cast(bf16x8, vw), pf, O0, 0, 0, 0); } \
                        { const u32x2 lo = *(const u32x2*)(Vl + (32 + ql) * 144 + kcol), hi = *(const u32x2*)(Vl + (32 + ql) * 144 + kcol + 16); \
                          u32x4 vw; vw.x = lo.x; vw.y = lo.y; vw.z = hi.x; vw.w = hi.y; \
                          O1 = __builtin_amdgcn_mfma_f32_32x32x16_bf16(__builtin_bit_cast(bf16x8, vw), pf, O1, 0, 0, 0); } \
                    } \
            } \

        u32x4 kregA = *(const u32x4*)(kbase), vregA = *(const u32x4*)(vbase); unsigned long long bmA = BMk[m * 64];
        u32x4 kregB = *(const u32x4*)(kbase + (size_t)64 * PCOLS), vregB = *(const u32x4*)(vbase + 64); unsigned long long bmB = BMk[m * 64 + 1];
        asm volatile("" :: "v"(qf[0]), "v"(qf[1]), "v"(qf[2]), "v"(qf[3]));
#define ATT_TILE(KREG, VREG, BMR, KT) do { const int kt = (KT); \
            __syncthreads(); \
            *(u32x4*)(Kl + srow * 144 + sch * 16) = KREG; *(u32x4*)(Vl + srow * 144 + sch * 16) = VREG; \
            __syncthreads(); \
            const unsigned long long bm = BMR; \
            if (kt + 2 < nkt) { KREG = *(const u32x4*)(kbase + (size_t)(kt + 2) * 64 * PCOLS); VREG = *(const u32x4*)(vbase + (kt + 2) * 64); BMR = BMk[m * 64 + kt + 2]; } \
            ATT_COMPUTE } while (0)
#pragma unroll 1
        for (int kt2 = 0; kt2 < nkt; kt2 += 2) { ATT_TILE(kregA, vregA, bmA, kt2); ATT_TILE(kregB, vregB, bmB, kt2 + 1); }
#undef ATT_TILE
#undef ATT_COMPUTE
        float ltot; { auto pl = __builtin_amdgcn_permlane32_swap(__float_as_uint(lrun), __float_as_uint(lrun), false, false); ltot = __uint_as_float(pl[0]) + __uint_as_float(pl[1]); } const float inv = 1.0f / ltot;
        bf16_t* yo = Y + m * D + 1536 + h * 64;
#pragma unroll
        for (int g4 = 0; g4 < 4; ++g4) { const int d0 = 8 * g4 + 4 * hf;
            u32x2 o0; o0.x = pk2(O0[4 * g4 + 0] * inv, O0[4 * g4 + 1] * inv); o0.y = pk2(O0[4 * g4 + 2] * inv, O0[4 * g4 + 3] * inv); *(u32x2*)(yo + d0) = o0;
            u32x2 o1; o1.x = pk2(O1[4 * g4 + 0] * inv, O1[4 * g4 + 1] * inv); o1.y = pk2(O1[4 * g4 + 2] * inv, O1[4 * g4 + 3] * inv); *(u32x2*)(yo + 32 + d0) = o1; }
    }
}

constexpr int NPH = 16;
constexpr int NGP = 1 + DEPTH * NPH;
__global__ void __launch_bounds__(512, 2) fwd(Args args) {
    extern __shared__ __attribute__((aligned(16))) unsigned char lds[];
    const int tid = threadIdx.x;
    volatile LAS unsigned* MISC = (volatile LAS unsigned*)((LAS unsigned char*)lds + MISC_OFF);
    for (int u = tid; u < (LDS_BYTES - 131072) / 4; u += 512) ((LAS unsigned*)((LAS unsigned char*)lds + 131072))[u] = 0u;
    __syncthreads();
    unsigned char* ws = args.ws;
    XcdBarrier bar; bar.bar = (unsigned*)(ws + OFF_CTL) + 4096; bar.x = 0; bar.st = nullptr;
    if (!MK_PER_PHASE) bar = xcd_barrier_post((unsigned*)(ws + OFF_CTL) + 4096, MISC + 8);
    const int lo = args.lo, hi = args.hi;
    LAS unsigned char* ldsl = (LAS unsigned char*)lds;
    bf16_t* XB = (bf16_t*)(ws + OFF_XB); float* X = (float*)(ws + OFF_X); float* T = (float*)(ws + OFF_T); float* ST = (float*)(ws + OFF_ST); bf16_t* Pb = (bf16_t*)(ws + OFF_P);
    bf16_t* H = (bf16_t*)(ws + OFF_SCR); bf16_t* Yb = (bf16_t*)(ws + OFF_Y); bf16_t* MG = (bf16_t*)(ws + OFF_MG);
    int gp = 0;
#define RUN() (lo <= gp && gp < hi)
#define SEAM() do { if (RUN() && gp + 1 < hi) xcd_barrier(bar); ++gp; } while (0)
#define PHASE(k, ...) do { if (PHON(k) && RUN()) { __VA_ARGS__; if ((REP_MASK >> (k)) & 1u) { xcd_barrier(bar); __VA_ARGS__; } } SEAM(); } while (0)
    if (RUN()) init_phase(args);
    SEAM();
#pragma unroll 1
    for (int L = 0; L < DEPTH; ++L) {
        PHASE(0, convert_phase(args, L, lds););
        PHASE(1, { pg8::Gemm g{XB, (const bf16_t*)(ws + OFF_W1A), D, D}; pg8::StaticOrder S; S.init(M, 2 * FF, D, gridDim.x, blockIdx.x); pg8::EpiSwiglu E{H, FF}; pg8::gemm_phase(ldsl, g, S, E); });
        PHASE(2, { pg8::Gemm g{H, (const bf16_t*)(ws + OFF_W1B), FF, FF}; pg8::StaticOrder S; S.init(M, D, FF, gridDim.x, blockIdx.x); pg8::EpiRes E{args.in[I_X], L == 0 ? nullptr : ST, args.in[I_LN3G] + (L > 0 ? (L - 1) * D : 0), args.in[I_LN3B] + (L > 0 ? (L - 1) * D : 0), T, D, ALPHA, 0.5f}; pg8::gemm_phase(ldsl, g, S, E); });
        PHASE(3, ln_phase(T, args.in[I_LN1G] + L * D, args.in[I_LN1B] + L * D, ST, XB, nullptr););
        PHASE(4, { pg8::Gemm g{XB, (const bf16_t*)(ws + OFF_WIN), D, D}; pg8::StaticOrder S; S.init(M, PCOLS, D, gridDim.x, blockIdx.x); pg8::EpiBf16 E{Pb, PCOLS}; pg8::gemm_phase(ldsl, g, S, E); });
        PHASE(5, { kidx_vt_phase(args, L, lds); if (RWKV_CHUNKED && !DBG_RWKV) rwkv_par_phase(args, L, lds); else rwkv_prep_phase(args, L, lds); });
        if (!HETERO) PHASE(6, { sgu_phase(args, L, lds, blockIdx.x, gridDim.x); }); else ++gp;
        PHASE(7, { if (DBG_RWKV) { scan_phase(args, lds); xcd_barrier(bar); rwkv_par_phase(args, L, lds); xcd_barrier(bar); rwkv_seq_phase(args, lds, X + (size_t)M * RW, nullptr, nullptr, nullptr); xcd_barrier(bar); dbg_compare_phase(args); }
                   else if (HETERO) { if ((int)blockIdx.x < 64) { rwkv_seq_phase(args, lds, X, args.in[I_GNG] + L * RW, args.in[I_GNB] + L * RW, Yb); if (REP_MASK & (1u << 20)) rwkv_seq_phase(args, lds, X, args.in[I_GNG] + L * RW, args.in[I_GNB] + L * RW, Yb); sgu_phase(args, L, lds, blockIdx.x, 64, 0, SGU_SPLIT); } else { indexer_phase(args, lds, blockIdx.x - 64, gridDim.x - 64); if (REP_MASK & (1u << 16)) indexer_phase(args, lds, blockIdx.x - 64, gridDim.x - 64); sgu_phase(args, L, lds, blockIdx.x - 64, gridDim.x - 64, SGU_SPLIT, NB * 32 * 4); } }
                   else if (RWKV_CHUNKED) rwkv_seq_phase(args, lds, X, nullptr, nullptr, nullptr); else scan_phase(args, lds); });
        if (!HETERO) PHASE(8, { indexer_phase(args, lds, blockIdx.x, gridDim.x); if (RWKV_CHUNKED) rwkv_fin2_phase(args, L); else rwkv_fin_phase(args, L); }); else ++gp;
        PHASE(9, { attn_phase(args, lds); });
        PHASE(10, { pg8::Gemm g{Yb, (const bf16_t*)(ws + OFF_WBR), D, D}; pg8::BranchOrder S; S.init(M, D, D, gridDim.x, blockIdx.x); pg8::EpiBranch E{Pb, args.in[I_BGATE] + (size_t)L * 3 * D, (float*)(ws + OFF_SCR), MG}; pg8::gemm_phase(ldsl, g, S, E); });
        PHASE(11, { pg8::Gemm g{MG, (const bf16_t*)(ws + OFF_WO), D, D}; pg8::StaticOrder S; S.init(M, D, D, gridDim.x, blockIdx.x); pg8::EpiRes E{nullptr, ST, args.in[I_LN1G] + L * D, args.in[I_LN1B] + L * D, T, D, ALPHA, 1.0f}; pg8::gemm_phase(ldsl, g, S, E); });
        PHASE(12, ln_phase(T, args.in[I_LN2G] + L * D, args.in[I_LN2B] + L * D, ST, XB, nullptr););
        PHASE(13, { pg8::Gemm g{XB, (const bf16_t*)(ws + OFF_W2A), D, D}; pg8::StaticOrder S; S.init(M, 2 * FF, D, gridDim.x, blockIdx.x); pg8::EpiSwiglu E{H, FF}; pg8::gemm_phase(ldsl, g, S, E); });
        PHASE(14, { pg8::Gemm g{H, (const bf16_t*)(ws + OFF_W2B), FF, FF}; pg8::StaticOrder S; S.init(M, D, FF, gridDim.x, blockIdx.x); pg8::EpiRes E{nullptr, ST, args.in[I_LN2G] + L * D, args.in[I_LN2B] + L * D, T, D, ALPHA, 0.5f}; pg8::gemm_phase(ldsl, g, S, E); });
        PHASE(15, ln_phase(T, args.in[I_LN3G] + L * D, args.in[I_LN3B] + L * D, ST, XB, L == DEPTH - 1 ? args.out : nullptr););
    }
    if (DBG_RWKV) { xcd_barrier(bar); dbg_encode_phase(args); }
#undef RUN
#undef SEAM
#undef PHASE
}

extern "C" void kernel_launch(void* const* d_in, const int* in_sizes, int n_in, void* d_out, int out_size, void* d_ws, size_t ws_size, hipStream_t stream) {
    static int grid = 0;
    if (grid == 0) {
        if (n_in != 33 || out_size != M * D || ws_size < WS_END) { fprintf(stderr, "kernel_launch: unexpected shapes (n_in %d out %d ws %zu, need %zu)\n", n_in, out_size, ws_size, (size_t)WS_END); grid = -1; return; }
        int dev = 0, cus = 0;
        if (hipGetDevice(&dev) != hipSuccess || hipDeviceGetAttribute(&cus, hipDeviceAttributeMultiprocessorCount, dev) != hipSuccess) { grid = -1; return; }
        if (hipFuncSetAttribute((const void*)fwd, hipFuncAttributeMaxDynamicSharedMemorySize, LDS_BYTES) != hipSuccess) { fprintf(stderr, "kernel_launch: hipFuncSetAttribute failed\n"); grid = -1; return; }
        int per_cu = 0; (void)hipOccupancyMaxActiveBlocksPerMultiprocessor(&per_cu, (const void*)fwd, 512, LDS_BYTES); (void)hipGetLastError();
        grid = cus;
    }
    if (grid < 0) return;
    (void)hipMemsetAsync((char*)d_ws + OFF_CTL, 0, CTL_BYTES, stream);
    Args a{};
    for (int i = 0; i < 33; ++i) a.in[i] = (const float*)d_in[i];
    a.out = (float*)d_out; a.ws = (unsigned char*)d_ws;
#if MK_PER_PHASE
    for (int p = 0; p < NGP; ++p) { a.lo = p; a.hi = p + 1; hipLaunchKernelGGL(fwd, dim3(grid), dim3(512), LDS_BYTES, stream, a); }
#else
    a.lo = 0; a.hi = NGP;
    hipLaunchKernelGGL(fwd, dim3(grid), dim3(512), LDS_BYTES, stream, a);
#endif
}
```

```cpp
#include <hip/hip_runtime.h>
#include <cstdio>
#include <cstdint>

#ifndef MK_PER_PHASE
#define MK_PER_PHASE 0
#endif
#ifndef PH_MASK
#define PH_MASK 0xFFFFFFFFu
#endif
#define PHON(k) (((PH_MASK) >> (k)) & 1u)
#ifndef RWKV_CHUNKED
#define RWKV_CHUNKED 1
#endif
#ifndef DBG_RWKV
#define DBG_RWKV 0
#endif
#ifndef DBG_LORA
#define DBG_LORA 0
#endif
#ifndef HETERO
#define HETERO 1
#endif
#ifndef SEQ_HILO
#define SEQ_HILO 0
#endif
#ifndef SGU_SPLIT
#define SGU_SPLIT 256
#endif
#ifndef REP_MASK
#define REP_MASK 0u
#endif

#define LAS __attribute__((address_space(3)))
#define DI __device__ __forceinline__
typedef unsigned short bf16_t;
typedef short bf16x8 __attribute__((ext_vector_type(8)));
typedef float f32x4 __attribute__((ext_vector_type(4)));
typedef float f32x2 __attribute__((ext_vector_type(2)));
typedef float f32x16 __attribute__((ext_vector_type(16)));
typedef unsigned u32x4 __attribute__((ext_vector_type(4)));
typedef unsigned u32x2 __attribute__((ext_vector_type(2)));
typedef __bf16 bf16x2_t __attribute__((ext_vector_type(2)));

constexpr int NB = 4, SEQ = 4096, M = NB * SEQ, D = 2048, FF = 5632, DEPTH = 4;
constexpr int RW = 1024;
constexpr int NP = 13312;
constexpr int PCOLS = 7168;
constexpr int DIN = 13168;
constexpr int GN_GATE = 6656, GN_LORA = 12800, GN_KI = 13088, GN_WI = 13152;
constexpr int PC_R = 0, PC_K = 1024, PC_V = 2048, PC_SGU = 3072, PC_SGV = 3584, PC_AQ = 4096, PC_AK = 4608, PC_AV = 5120, PC_QI = 5632, PC_LORA = 6656, PC_KI = 6944, PC_WI = 7008;
constexpr float ALPHA = 1.6817928305074290f;
constexpr float LN_EPS = 1e-5f;

constexpr size_t MiB = 1u << 20;
constexpr size_t OFF_CTL = 0, CTL_BYTES = 1 * MiB;
constexpr size_t OFF_BIAS = 1 * MiB;
constexpr size_t OFF_ST = OFF_BIAS + 786432;
constexpr size_t OFF_LW2 = OFF_BIAS + 65536, OFF_LA2 = OFF_LW2 + 131072, OFF_LG2 = OFF_LA2 + 131072;
constexpr int REC = 15360, RROW = 144, R_EL2 = 0, R_RL2 = 2304, R_A2 = 4608, R_A3 = 8704, R_FT = 9728, R_VT = 10240, R_GC = 12288, R_G = 12544, R_BON = 14592;
constexpr size_t OFF_W1A = 2 * MiB;
constexpr size_t OFF_W1B = OFF_W1A + 44 * MiB;
constexpr size_t OFF_WIN = OFF_W1B + 22 * MiB;
constexpr size_t OFF_WBR = OFF_WIN + 52 * MiB;
constexpr size_t OFF_WO  = OFF_WBR + 8 * MiB;
constexpr size_t OFF_W2A = OFF_WO + 8 * MiB;
constexpr size_t OFF_W2B = OFF_W2A + 44 * MiB;
constexpr size_t OFF_X   = OFF_W2B + 22 * MiB;
constexpr size_t OFF_T   = OFF_X + 128 * MiB;
constexpr size_t OFF_XB  = OFF_T + 128 * MiB;
constexpr size_t OFF_P   = OFF_XB + 64 * MiB;
constexpr size_t OFF_GATES = OFF_P + 224 * MiB;
constexpr size_t OFF_SCR = OFF_GATES + 192 * MiB;
constexpr size_t OFF_Y   = OFF_SCR + 416 * MiB;
constexpr size_t OFF_MG  = OFF_Y + 64 * MiB;
constexpr size_t OFF_BM  = OFF_MG + 64 * MiB;
constexpr size_t OFF_KI  = OFF_BM + 8 * MiB;
constexpr size_t OFF_VT  = OFF_KI + 2 * MiB;
constexpr size_t WS_END  = OFF_VT + 16 * MiB;

constexpr int LDS_BYTES = 147456;
constexpr int MISC_OFF = 131072 + 320;

DI unsigned f2bf(float f) { unsigned u = __builtin_bit_cast(unsigned, f); return (u + 0x7fffu + ((u >> 16) & 1u)) >> 16; }
DI float bf2f(unsigned short b) { return __builtin_bit_cast(float, ((unsigned)b) << 16); }
DI unsigned pk2(float lo, float hi) { f32x2 v = {lo, hi}; bf16x2_t b = __builtin_convertvector(v, bf16x2_t); return __builtin_bit_cast(unsigned, b); }
DI float bflo(unsigned w) { return __builtin_bit_cast(float, w << 16); }
DI float bfhi(unsigned w) { return __builtin_bit_cast(float, w & 0xffff0000u); }
template <int CTRL> DI float dpp_f(float x) { return __builtin_bit_cast(float, __builtin_amdgcn_update_dpp(0, __builtin_bit_cast(int, x), CTRL, 0xF, 0xF, true)); }
DI float row16_sum(float x) {
    x += dpp_f<0xB1>(x);
    x += dpp_f<0x4E>(x);
    x += dpp_f<0x141>(x);
    x += dpp_f<0x140>(x);
    return x;
}
DI int otid() { int t = threadIdx.x; asm volatile("" : "+v"(t)); return t; }
DI int obid() { int t = blockIdx.x; asm volatile("" : "+s"(t)); return t; }
DI float wave_sum(float x) {
    x = row16_sum(x);
    auto p = __builtin_amdgcn_permlane16_swap(__float_as_uint(x), __float_as_uint(x), false, false);
    x = __uint_as_float(p[0]) + __uint_as_float(p[1]);
    auto q = __builtin_amdgcn_permlane32_swap(__float_as_uint(x), __float_as_uint(x), false, false);
    return __uint_as_float(q[0]) + __uint_as_float(q[1]);
}
DI void wave_sum8(float (&x)[8]) {
#pragma unroll
    for (int i = 0; i < 8; ++i) x[i] += dpp_f<0xB1>(x[i]);
#pragma unroll
    for (int i = 0; i < 8; ++i) x[i] += dpp_f<0x4E>(x[i]);
#pragma unroll
    for (int i = 0; i < 8; ++i) x[i] += dpp_f<0x141>(x[i]);
#pragma unroll
    for (int i = 0; i < 8; ++i) x[i] += dpp_f<0x140>(x[i]);
#pragma unroll
    for (int i = 0; i < 8; ++i) { auto p = __builtin_amdgcn_permlane16_swap(__float_as_uint(x[i]), __float_as_uint(x[i]), false, false); x[i] = __uint_as_float(p[0]) + __uint_as_float(p[1]); }
#pragma unroll
    for (int i = 0; i < 8; ++i) { auto p = __builtin_amdgcn_permlane32_swap(__float_as_uint(x[i]), __float_as_uint(x[i]), false, false); x[i] = __uint_as_float(p[0]) + __uint_as_float(p[1]); }
}
DI float sigmoidf_(float x) { return 1.0f / (1.0f + __expf(-x)); }
DI float gelu_erf(float x) { return 0.5f * x * (1.0f + erff(x * 0.70710678118654752f)); }

namespace pg8 {
constexpr int BM = 256, BK = 64, HALF = 128, HTB = HALF * BK * 2, STAGE_BYTES = 8 * HTB, NXCD = 8, WGM = 8;
__host__ __device__ __forceinline__ int lds_byte(int r, int c) { const int st = (r >> 4) * 2 + (c >> 5), rr = r & 15, cc = c & 31, ob = rr * 64 + cc * 2; return st * 1024 + (ob ^ (((ob >> 9) & 1) << 5)); }
__host__ __device__ __forceinline__ void stage_rc(int b, int& R, int& C) { const int st = b / 1024, sb = b % 1024, swz = sb ^ (((sb >> 9) & 1) << 5); R = (st >> 1) * 16 + swz / 64; C = (st & 1) * 32 + (swz % 64) / 2; }
__host__ __device__ __forceinline__ int perm32(int rho) { const int n = rho >> 4, i = rho & 15; return 8 * (i >> 2) + 4 * n + (i & 3); }

struct Unit { int pm, pn, koff, nt, tag; };
struct Gemm { const bf16_t* A; const bf16_t* Bt; int lda, ldb; };

struct StaticOrder {
    int nM, nN, nwg, G, c, nt;
    __device__ void init(int M_, int N_, int K_, int G_, int c_) { nM = M_ / BM; nN = N_ / BM; nwg = nM * nN; G = G_; c = c_; nt = K_ / BK; }
    __device__ bool tile(int L, Unit& u) const {
        if (L >= nwg) return false;
        int wgid = L; { const int q = nwg / NXCD, r = nwg % NXCD, xcd = wgid % NXCD, off = wgid / NXCD; wgid = (xcd < r ? xcd * (q + 1) : r * (q + 1) + (xcd - r) * q) + off; }
        const int nig = WGM * nN, gid = wgid / nig, fm = gid * WGM, gsz = (nM - fm) < WGM ? (nM - fm) : WGM;
        u.pm = fm + ((wgid % nig) % gsz); u.pn = (wgid % nig) / gsz; return true;
    }
    __device__ bool next(int i, Unit& u) const { u.koff = 0; u.nt = nt; u.tag = 0; return tile(i * G + c, u); }
};
struct BranchOrder : StaticOrder {
    __device__ bool next(int i, Unit& u) const {
        const int ti = i / 3, br = i - 3 * ti;
        u.tag = br; u.koff = br == 0 ? 0 : (br == 1 ? 1024 : 1536); u.nt = br == 0 ? 16 : 8;
        return tile(ti * G + c, u);
    }
};

template <class Epi, class Sched>
__device__ __forceinline__ void gemm_phase(LAS unsigned char* lds, const Gemm g, const Sched& S, const Epi& E) {
    const int tid = otid(), wid = __builtin_amdgcn_readfirstlane(tid >> 6), lane = tid & 63, wr = wid >> 2, wc = wid & 3, fr = lane & 15, fq = lane >> 4;
    unsigned voffA[2], voffB[2];
#pragma unroll
    for (int i = 0; i < 2; ++i) { int R, C; stage_rc(tid * 16 + i * 8192, R, C); const int Rb = Epi::PERM ? ((R & ~31) + perm32(R & 31)) : R;
        voffA[i] = (unsigned)(R * g.lda + C) * 2u; voffB[i] = (unsigned)(Rb * g.ldb + C) * 2u; }
    const size_t kstep = (size_t)(BK * 2);
    const size_t hstepA = (size_t)HALF * g.lda * 2, hstepB = (size_t)HALF * g.ldb * 2;
    const size_t tstepA = 2 * hstepA, tstepB = 2 * hstepB;
    const unsigned ldsw = (unsigned)wid * 1024u;
    const int aoff = lds_byte(wr * 64 + fr, fq * 8), boff = lds_byte(wc * 32 + fr, fq * 8);
#define PG8_SA(b, h) (((b) * 2 + (h)) * HTB)
#define PG8_SB(b, h) ((4 + (b) * 2 + (h)) * HTB)
#define PG8_STAGE(bufoff, gbase, voff) do { _Pragma("unroll") for (int _i = 0; _i < 2; ++_i) \
        __builtin_amdgcn_global_load_lds((const unsigned*)((const char*)(gbase) + (voff)[_i]), (LAS unsigned*)(lds + (bufoff) + ldsw + _i * 8192), 16, 0, 0); } while (0)
#define PG8_LDA(dst, b, h) do { _Pragma("unroll") for (int m = 0; m < 4; ++m) _Pragma("unroll") for (int k = 0; k < 2; ++k) dst[m][k] = *(const LAS bf16x8*)(lds + PG8_SA(b, h) + aoff + m * 2048 + k * 1024); } while (0)
#define PG8_LDB(dst, b, h) do { _Pragma("unroll") for (int n = 0; n < 2; ++n) _Pragma("unroll") for (int k = 0; k < 2; ++k) dst[n][k] = *(const LAS bf16x8*)(lds + PG8_SB(b, h) + boff + n * 2048 + k * 1024); } while (0)
#define PG8_MMA(ai, bj, At, Bt) do { __builtin_amdgcn_s_setprio(1); _Pragma("unroll") for (int m = 0; m < 4; ++m) _Pragma("unroll") for (int n = 0; n < 2; ++n) _Pragma("unroll") for (int k = 0; k < 2; ++k) \
        acc[ai][bj][m][n] = __builtin_amdgcn_mfma_f32_16x16x32_bf16(Bt[n][k], At[m][k], acc[ai][bj][m][n], 0, 0, 0); __builtin_amdgcn_s_setprio(0); } while (0)
#define PG8_WAIT_V(n) asm volatile("s_waitcnt vmcnt(" #n ")" ::: "memory")
#define PG8_WAIT_L(n) asm volatile("s_waitcnt lgkmcnt(" #n ")" ::: "memory")
#define PG8_BAR __builtin_amdgcn_s_barrier()
#define PG8_SCHED __builtin_amdgcn_sched_barrier(0)
    Unit cur, nxt; int ui = 0;
    if (!S.next(0, cur)) return;
    f32x4 acc[2][2][4][2];
#pragma unroll
    for (int a = 0; a < 2; ++a)
#pragma unroll
        for (int b = 0; b < 2; ++b)
#pragma unroll
            for (int m = 0; m < 4; ++m)
#pragma unroll
                for (int n = 0; n < 2; ++n) acc[a][b][m][n] = (f32x4){0.f, 0.f, 0.f, 0.f};
    bf16x8 At[4][2], B0[2][2], B1[2][2];
    const char* cA = (const char*)g.A + (size_t)cur.pm * tstepA + (size_t)cur.koff * 2; const char* cB = (const char*)g.Bt + (size_t)cur.pn * tstepB + (size_t)cur.koff * 2;
    PG8_STAGE(PG8_SB(0, 0), cB, voffB); PG8_STAGE(PG8_SB(0, 1), cB + hstepB, voffB); PG8_STAGE(PG8_SA(0, 0), cA, voffA); PG8_STAGE(PG8_SA(0, 1), cA + hstepA, voffA);
    if (wr == 1) PG8_BAR;
    PG8_WAIT_V(2); PG8_BAR;
    PG8_STAGE(PG8_SB(1, 0), cB + kstep, voffB); PG8_STAGE(PG8_SA(1, 0), cA + kstep, voffA); PG8_STAGE(PG8_SB(1, 1), cB + hstepB + kstep, voffB);
    PG8_WAIT_V(6); PG8_BAR;
    for (;;) {
        const bool has_next = S.next(ui + 1, nxt);
        const char* nA = has_next ? (const char*)g.A + (size_t)nxt.pm * tstepA + (size_t)nxt.koff * 2 : cA; const char* nB = has_next ? (const char*)g.Bt + (size_t)nxt.pn * tstepB + (size_t)nxt.koff * 2 : cB;
        const int nt = cur.nt;
        for (int t = 0; t < nt; t += 2) {
            const bool last = (t == nt - 2);
            const char* a1 = cA + (size_t)(t + 1) * kstep;
            const char* a2 = last ? nA : cA + (size_t)(t + 2) * kstep; const char* b2 = last ? nB : cB + (size_t)(t + 2) * kstep;
            const char* a3 = a2 + kstep; const char* b3 = b2 + kstep;
            PG8_LDB(B0, 0, 0); PG8_LDB(B1, 0, 1); PG8_SCHED; PG8_LDA(At, 0, 0); PG8_STAGE(PG8_SA(1, 1), a1 + hstepA, voffA);
            PG8_WAIT_V(8); PG8_WAIT_L(0); PG8_BAR; PG8_MMA(0, 0, At, B0); PG8_MMA(0, 1, At, B1); PG8_BAR; PG8_SCHED;
            PG8_LDA(At, 0, 1); PG8_STAGE(PG8_SB(0, 0), b2, voffB); PG8_STAGE(PG8_SB(0, 1), b2 + hstepB, voffB); PG8_STAGE(PG8_SA(0, 0), a2, voffA);
            PG8_WAIT_V(8); PG8_WAIT_L(0); PG8_BAR; PG8_MMA(1, 0, At, B0); PG8_MMA(1, 1, At, B1); PG8_BAR; PG8_SCHED;
            PG8_LDB(B0, 1, 0); PG8_LDB(B1, 1, 1); PG8_SCHED; PG8_LDA(At, 1, 0); PG8_STAGE(PG8_SA(0, 1), a2 + hstepA, voffA);
            PG8_WAIT_V(8); PG8_WAIT_L(0); PG8_BAR; PG8_MMA(0, 0, At, B0); PG8_MMA(0, 1, At, B1); PG8_BAR; PG8_SCHED;
            PG8_LDA(At, 1, 1); PG8_STAGE(PG8_SB(1, 0), b3, voffB); PG8_STAGE(PG8_SB(1, 1), b3 + hstepB, voffB); PG8_STAGE(PG8_SA(1, 0), a3, voffA);
            PG8_WAIT_V(8); PG8_WAIT_L(0); PG8_BAR; PG8_MMA(1, 0, At, B0); PG8_MMA(1, 1, At, B1); PG8_BAR; PG8_SCHED;
        }
        if (wr == 0) PG8_BAR;
        E(acc, cur, wr, wc, fr, fq);
        if (!has_next) break;
#pragma unroll
        for (int a = 0; a < 2; ++a)
#pragma unroll
            for (int b = 0; b < 2; ++b)
#pragma unroll
                for (int m = 0; m < 4; ++m)
#pragma unroll
                    for (int n = 0; n < 2; ++n) acc[a][b][m][n] = (f32x4){0.f, 0.f, 0.f, 0.f};
        cur = nxt; cA = nA; cB = nB; ++ui;
        if (wr == 1) PG8_BAR;
    }
    PG8_WAIT_V(0);
    PG8_BAR;
#undef PG8_SA
#undef PG8_SB
#undef PG8_STAGE
#undef PG8_LDA
#undef PG8_LDB
#undef PG8_MMA
#undef PG8_WAIT_V
#undef PG8_WAIT_L
#undef PG8_BAR
#undef PG8_SCHED
}

struct EpiSwiglu {
    static constexpr bool PERM = true;
    bf16_t* O; int ldc;
    __device__ __forceinline__ void operator()(const f32x4 (&acc)[2][2][4][2], const Unit& u, int wr, int wc, int fr, int fq) const {
        const int row0 = u.pm * BM + wr * 64 + fr, col0 = u.pn * HALF + wc * 32 + 8 * fq;
#pragma unroll
        for (int ai = 0; ai < 2; ++ai)
#pragma unroll
            for (int m = 0; m < 4; ++m) {
                float hv[8];
#pragma unroll
                for (int n = 0; n < 2; ++n)
#pragma unroll
                    for (int j = 0; j < 4; ++j) { const float gv = acc[ai][0][m][n][j], uv = acc[ai][1][m][n][j]; hv[4 * n + j] = gv * __builtin_amdgcn_rcpf(1.0f + __expf(-gv)) * uv; }
                u32x4 w; w.x = pk2(hv[0], hv[1]); w.y = pk2(hv[2], hv[3]); w.z = pk2(hv[4], hv[5]); w.w = pk2(hv[6], hv[7]);
                *(u32x4*)(O + (size_t)(row0 + ai * HALF + m * 16) * ldc + col0) = w;
            }
    }
};
struct EpiRes {
    static constexpr bool PERM = false;
    const float* Xraw; const float* st; const float* g; const float* b; float* T; int ldc; float alpha, s;
    __device__ __forceinline__ void operator()(const f32x4 (&acc)[2][2][4][2], const Unit& u, int wr, int wc, int fr, int fq) const {
        const int row0 = u.pm * BM + wr * 64 + fr, col0 = u.pn * BM + wc * 32 + 4 * fq;
        f32x4 gv[2][2], bv[2][2];
        if (st) {
#pragma unroll
            for (int bj = 0; bj < 2; ++bj)
#pragma unroll
                for (int n = 0; n < 2; ++n) { gv[bj][n] = *(const f32x4*)(g + col0 + bj * HALF + n * 16); bv[bj][n] = *(const f32x4*)(b + col0 + bj * HALF + n * 16); } }
        const float* src = st ? T : Xraw;
#pragma unroll
        for (int ai = 0; ai < 2; ++ai)
#pragma unroll
            for (int m2 = 0; m2 < 2; ++m2) {
                f32x4 tv[2][2][2]; f32x2 ms[2];
#pragma unroll
                for (int mm = 0; mm < 2; ++mm) { const int row = row0 + ai * HALF + (2 * m2 + mm) * 16; const size_t off = (size_t)row * ldc + col0;
                    ms[mm] = (f32x2){0.f, 1.f}; if (st) ms[mm] = *(const f32x2*)(st + 2 * (size_t)row);
#pragma unroll
                    for (int bj = 0; bj < 2; ++bj)
#pragma unroll
                        for (int n = 0; n < 2; ++n) tv[mm][bj][n] = *(const f32x4*)(src + off + bj * HALF + n * 16); }
                asm volatile("" ::: "memory");
#pragma unroll
                for (int mm = 0; mm < 2; ++mm) { const int m = 2 * m2 + mm; const size_t off = (size_t)(row0 + ai * HALF + m * 16) * ldc + col0;
#pragma unroll
                    for (int bj = 0; bj < 2; ++bj)
#pragma unroll
                        for (int n = 0; n < 2; ++n) { f32x4 xv = tv[mm][bj][n]; if (st) xv = (xv - ms[mm][0]) * ms[mm][1] * gv[bj][n] + bv[bj][n];
                            *(f32x4*)(T + off + bj * HALF + n * 16) = xv * alpha + acc[ai][bj][m][n] * s; } }
            }
    }
};
__device__ __forceinline__ int frag_off(int wr, int wc, int fr, int fq, int ai, int m, int bj) { return (((((wr * 4 + wc) * 2 + ai) * 4 + m) * 2 + bj) * 64 + fq * 16 + fr) * 8; }
struct EpiBf16 {
    static constexpr bool PERM = true;
    bf16_t* O; int ldc; bf16_t* G;
    __device__ __forceinline__ void operator()(const f32x4 (&acc)[2][2][4][2], const Unit& u, int wr, int wc, int fr, int fq) const {
        const bool gate = u.pn >= GN_GATE / BM && u.pn < GN_LORA / BM;
        const int gt = u.pn - GN_GATE / BM;
        bf16_t* gbase = G + ((size_t)((gt >> 3) * (M / BM) + u.pm) * 8 + (gt & 7)) * 65536;
        const int pcol = (u.pn >= GN_LORA / BM ? PC_LORA + (u.pn - GN_LORA / BM) * BM : u.pn * BM) + wc * 32 + 8 * fq;
        const int row0 = u.pm * BM + wr * 64 + fr;
        int lbase = ((wr * 4 + wc) * 1024 + fq * 16 + fr) * 8; asm volatile("" : "+v"(lbase));
#pragma unroll
        for (int ai = 0; ai < 2; ++ai)
#pragma unroll
            for (int m = 0; m < 4; ++m) { bf16_t* rowp = O + (size_t)(row0 + ai * HALF + m * 16) * ldc + pcol;
#pragma unroll
                for (int bj = 0; bj < 2; ++bj) { const f32x4 v0 = acc[ai][bj][m][0], v1 = acc[ai][bj][m][1];
                    u32x4 w; w.x = pk2(v0[0], v0[1]); w.y = pk2(v0[2], v0[3]); w.z = pk2(v1[0], v1[1]); w.w = pk2(v1[2], v1[3]);
                    if (gate) *(u32x4*)(gbase + lbase + (((ai * 4 + m) * 2 + bj) * 512)) = w; else *(u32x4*)(rowp + bj * HALF) = w; } }
    }
};
struct EpiBranch {
    static constexpr bool PERM = true;
    const bf16_t* G; const float* bgate; bf16_t* TOT; bf16_t* MG;
    __device__ __forceinline__ void operator()(const f32x4 (&acc)[2][2][4][2], const Unit& u, int wr, int wc, int fr, int fq) const {
        const int row0 = u.pm * BM + wr * 64 + fr, col0 = u.pn * BM + wc * 32 + 8 * fq; const int br = u.tag;
        int lbase = ((wr * 4 + wc) * 1024 + fq * 16 + fr) * 8; asm volatile("" : "+v"(lbase));
        u32x2 bgp[2][2];
#pragma unroll
        for (int bj = 0; bj < 2; ++bj)
#pragma unroll
            for (int n = 0; n < 2; ++n) { const f32x4 t = *(const f32x4*)(bgate + br * D + col0 + bj * HALF + 4 * n); bgp[bj][n].x = pk2(t[0], t[1]); bgp[bj][n].y = pk2(t[2], t[3]); }
        const bf16_t* gbase = G + ((size_t)(br * (M / BM) + u.pm) * 8 + u.pn) * 65536;
        bf16_t* tbase = TOT + (size_t)(u.pm * 8 + u.pn) * 65536;
#pragma unroll
        for (int a2 = 0; a2 < 4; ++a2) { const int ai = a2 >> 1, mb = (a2 & 1) * 2;
            u32x4 gw[2][2], tt[2][2];
#pragma unroll
            for (int mm = 0; mm < 2; ++mm)
#pragma unroll
                for (int bj = 0; bj < 2; ++bj) { const int fo = lbase + (((ai * 4 + mb + mm) * 2 + bj) * 512); gw[mm][bj] = *(const u32x4*)(gbase + fo);
                    tt[mm][bj] = (u32x4){0u, 0u, 0u, 0u}; if (br != 0) tt[mm][bj] = *(const u32x4*)(tbase + fo); }
            asm volatile("" ::: "memory");
#pragma unroll
            for (int mm = 0; mm < 2; ++mm) { const int m = mb + mm; const size_t row = (size_t)(row0 + ai * HALF + m * 16);
#pragma unroll
                for (int bj = 0; bj < 2; ++bj) { const u32x4 w4 = gw[mm][bj], t4 = tt[mm][bj];
                    const unsigned ww[4] = {w4.x, w4.y, w4.z, w4.w}, tw[4] = {t4.x, t4.y, t4.z, t4.w}; unsigned ow[4];
#pragma unroll
                    for (int n = 0; n < 2; ++n) { const f32x4 b4 = (f32x4){bflo(bgp[bj][n].x), bfhi(bgp[bj][n].x), bflo(bgp[bj][n].y), bfhi(bgp[bj][n].y)}; const f32x4 av = acc[ai][bj][m][n];
                        const float g0 = sigmoidf_(bflo(ww[2 * n]) + b4[0]), g1 = sigmoidf_(bfhi(ww[2 * n]) + b4[1]), g2 = sigmoidf_(bflo(ww[2 * n + 1]) + b4[2]), g3 = sigmoidf_(bfhi(ww[2 * n + 1]) + b4[3]);
                        ow[2 * n] = pk2(g0 * av[0] + bflo(tw[2 * n]), g1 * av[1] + bfhi(tw[2 * n])); ow[2 * n + 1] = pk2(g2 * av[2] + bflo(tw[2 * n + 1]), g3 * av[3] + bfhi(tw[2 * n + 1])); }
                    u32x4 o; o.x = ow[0]; o.y = ow[1]; o.z = ow[2]; o.w = ow[3];
                    if (br == 2) *(u32x4*)(MG + row * D + col0 + bj * HALF) = o; else *(u32x4*)(tbase + lbase + (((ai * 4 + m) * 2 + bj) * 512)) = o; } }
        }
    }
};
}

#define XB_TMO      128
#define XB_XCNT(j)  (256  + 64 * (j))
#define XB_XSUB(j)  (1280 + 64 * (j))
#define XB_XGEN(j)  (2304 + 64 * (j))
#define XB_TOP      3328
#define XB_TOPGEN   3392
#define XCD_BAR_WORDS 3456
#define XB_SPIN_CAP (1u << 18)
__device__ __forceinline__ unsigned xb_ld(unsigned* p)              { return __hip_atomic_load(p, __ATOMIC_RELAXED, __HIP_MEMORY_SCOPE_AGENT); }
__device__ __forceinline__ unsigned xb_add(unsigned* p, unsigned v) { return __hip_atomic_fetch_add(p, v, __ATOMIC_RELAXED, __HIP_MEMORY_SCOPE_AGENT); }
__device__ __forceinline__ unsigned xb_xcc_id() { return (unsigned)__builtin_amdgcn_s_getreg((3 << 11) | 20) & 0xFu; }
#define XB_SPIN(cond, bar) do { unsigned _sp = 0; while (cond) { __builtin_amdgcn_s_sleep(1); \
    if ((++_sp & 255u) == 0u) { if (xb_ld(&(bar)[XB_TMO])) break; if (_sp > XB_SPIN_CAP) { atomicAdd(&(bar)[XB_TMO], 1u); break; } } } } while (0)
struct XcdBarrier { unsigned* bar; unsigned x; volatile LAS unsigned* st; };
__device__ __forceinline__ XcdBarrier xcd_barrier_post(unsigned* bar, volatile LAS unsigned* st) {
    XcdBarrier b; b.bar = bar; b.x = xb_xcc_id(); b.st = st;
    if (threadIdx.x == 0) (void)xb_add(&bar[XB_XCNT(b.x)], 1u);
    return b;
}
__device__ __forceinline__ void xcd_barrier_complete(unsigned* bar, unsigned x, unsigned& nloc, unsigned& nx) {
    const unsigned G = gridDim.x * gridDim.y * gridDim.z;
    unsigned sum, cnt, mine, sp = 0u;
    for (;;) {
        sum = 0u; cnt = 0u; mine = 0u;
#pragma unroll
        for (unsigned j = 0; j < 16; ++j) { const unsigned c = xb_ld(&bar[XB_XCNT(j)]); sum += c; cnt += (c > 0u) ? 1u : 0u; mine = (j == x) ? c : mine; }
        if (sum == G) break;
        __builtin_amdgcn_s_sleep(1);
        if ((++sp & 255u) == 0u) { if (xb_ld(&bar[XB_TMO])) break; if (sp > XB_SPIN_CAP) { atomicAdd(&bar[XB_TMO], 1u); break; } }
    }
    nloc = mine > 0u ? mine : 1u; nx = cnt > 0u ? cnt : 1u;
}
__device__ __forceinline__ void xcd_barrier(const XcdBarrier& b) {
    asm volatile("s_waitcnt vmcnt(0)" ::: "memory");
    __syncthreads();
    if (threadIdx.x == 0) {
        unsigned* bar = b.bar;
        __builtin_amdgcn_s_waitcnt(0);
        unsigned nloc = b.st[0], nx = b.st[1];
        if (nloc == 0u) { xcd_barrier_complete(bar, b.x, nloc, nx); b.st[0] = nloc; b.st[1] = nx; }
        const unsigned old = xb_add(&bar[XB_XSUB(b.x)], 1u);
        const unsigned gen = old / nloc;
        if (old + 1u == (gen + 1u) * nloc) {
            __builtin_amdgcn_fence(__ATOMIC_RELEASE, "agent");
            asm volatile("s_waitcnt vmcnt(0)" ::: "memory");
            const unsigned og = xb_add(&bar[XB_TOP], 1u);
            const unsigned tg = og / nx;
            if (og + 1u == (tg + 1u) * nx) xb_add(&bar[XB_TOPGEN], 1u);
            else XB_SPIN(xb_ld(&bar[XB_TOPGEN]) == tg, bar);
            __builtin_amdgcn_fence(__ATOMIC_ACQUIRE, "agent");
            xb_add(&bar[XB_XGEN(b.x)], 1u);
            asm volatile("s_waitcnt vmcnt(0)" ::: "memory");
        } else {
            XB_SPIN(xb_ld(&bar[XB_XGEN(b.x)]) == gen, bar);
            __builtin_amdgcn_fence(__ATOMIC_ACQUIRE, "agent");
            asm volatile("s_waitcnt vmcnt(0)" ::: "memory");
        }
    }
    __syncthreads();
}

struct Args { const float* in[33]; float* out; unsigned char* ws; int lo, hi; };
enum { I_X = 0, I_F1IN, I_F1OUT, I_LN1G, I_LN1B, I_WIN, I_BGATE, I_MU, I_W0, I_W2, I_A0, I_A2, I_G2, I_KK, I_KA, I_RK, I_GNG, I_GNB, I_SGLNG, I_SGLNB, I_SGW, I_SGB, I_ILNG, I_ILNB, I_RELB, I_WBR, I_WO, I_LN2G, I_LN2B, I_F2IN, I_F2OUT, I_LN3G, I_LN3B };

DI int pmap(int n) {
    if (n < 3072) return n;
    if (n < 3360) return GN_LORA + (n - 3072);
    if (n < 4384) return PC_SGU + (n - 3360);
    if (n < 5920) return PC_AQ + (n - 4384);
    if (n < 6944) return PC_QI + (n - 5920);
    if (n < 7008) return GN_KI + (n - 6944);
    if (n < 7024) return GN_WI + (n - 7008);
    return GN_GATE + (n - 7024);
}
template <int MODE> DI int rowmap(int n) {
    if (MODE == 0) return n;
    if (MODE == 1) { const int up = n >= FF ? 1 : 0, j = n - up * FF; return (j >> 7) * 256 + up * 128 + (j & 127); }
    return pmap(n);
}
struct CvtItem { const float* W; bf16_t* WT; int K, N, mode, item; };
DI void cvt_load(const CvtItem& d, int lane, f32x4 (&va)[4], f32x4 (&vb)[4]) {
    const int nblk = (d.N + 31) / 32, kb = d.item / nblk, nb = d.item % nblk, k0 = 64 * kb, n0 = 32 * nb;
    const int c4 = lane & 7, rq = lane >> 3; const int ncol = n0 + 4 * c4; const bool okc = ncol < d.N;
#pragma unroll
    for (int i = 0; i < 4; ++i) { const int k = k0 + 2 * (rq + 8 * i);
        va[i] = okc ? *(const f32x4*)(d.W + (size_t)k * d.N + ncol) : (f32x4){0.f, 0.f, 0.f, 0.f}; vb[i] = okc ? *(const f32x4*)(d.W + (size_t)(k + 1) * d.N + ncol) : (f32x4){0.f, 0.f, 0.f, 0.f}; }
}
DI void cvt_finish(const CvtItem& d, int lane, const f32x4 (&va)[4], const f32x4 (&vb)[4], float* scr) {
    const int nblk = (d.N + 31) / 32, kb = d.item / nblk, nb = d.item % nblk, k0 = 64 * kb, n0 = 32 * nb;
    unsigned* st = (unsigned*)scr; const int c4 = lane & 7, rq = lane >> 3;
#pragma unroll
    for (int i = 0; i < 4; ++i) { const int rp = rq + 8 * i;
#pragma unroll
        for (int j = 0; j < 4; ++j) st[(4 * c4 + j) * 33 + rp] = pk2(va[i][j], vb[i][j]); }
    __builtin_amdgcn_s_waitcnt(0xc07f); asm volatile("" ::: "memory");
#pragma unroll
    for (int i = 0; i < 4; ++i) { const int id = lane + 64 * i, n = id >> 3, kc = id & 7; const unsigned* p = st + n * 33 + 4 * kc;
        u32x4 o; o.x = p[0]; o.y = p[1]; o.z = p[2]; o.w = p[3];
        const int ns = n0 + n; const int nd = d.mode == 0 ? ns : (d.mode == 1 ? rowmap<1>(ns) : pmap(ns));
        if (ns < d.N) *(u32x4*)(d.WT + (size_t)nd * d.K + k0 + 8 * kc) = o; }
    __builtin_amdgcn_s_waitcnt(0xc07f); asm volatile("" ::: "memory");
}
DI void convert_phase(const Args& a, int L, unsigned char* lds) {
    const int tidx_ = otid();
    const int wave = __builtin_amdgcn_readfirstlane(tidx_ >> 6), lane = tidx_ & 63;
    float* scr = (float*)(lds + wave * 16384);
    const int gw = blockIdx.x * 8 + wave, NGW = gridDim.x * 8;
    unsigned char* ws = a.ws;
    constexpr int I1 = (D / 64) * ((2 * FF) / 32), I2 = (FF / 64) * (D / 32), I3 = (D / 64) * ((DIN + 31) / 32), I4 = (D / 64) * (D / 32);
    constexpr int NIT = 2 * I1 + 2 * I2 + I3 + 2 * I4;
    auto decode = [&](int it) -> CvtItem {
        int r = it;
        if (r < I1) return CvtItem{a.in[I_F1IN] + (size_t)L * D * 2 * FF, (bf16_t*)(ws + OFF_W1A), D, 2 * FF, 1, r}; r -= I1;
        if (r < I1) return CvtItem{a.in[I_F2IN] + (size_t)L * D * 2 * FF, (bf16_t*)(ws + OFF_W2A), D, 2 * FF, 1, r}; r -= I1;
        if (r < I2) return CvtItem{a.in[I_F1OUT] + (size_t)L * FF * D, (bf16_t*)(ws + OFF_W1B), FF, D, 0, r}; r -= I2;
        if (r < I2) return CvtItem{a.in[I_F2OUT] + (size_t)L * FF * D, (bf16_t*)(ws + OFF_W2B), FF, D, 0, r}; r -= I2;
        if (r < I3) return CvtItem{a.in[I_WIN] + (size_t)L * D * DIN, (bf16_t*)(ws + OFF_WIN), D, DIN, 2, r}; r -= I3;
        if (r < I4) return CvtItem{a.in[I_WBR] + (size_t)L * D * D, (bf16_t*)(ws + OFF_WBR), D, D, 0, r}; r -= I4;
        return CvtItem{a.in[I_WO] + (size_t)L * D * D, (bf16_t*)(ws + OFF_WO), D, D, 0, r};
    };
#pragma unroll 1
    for (int it = gw; it < NIT; it += 2 * NGW) {
        const bool two = it + NGW < NIT;
        const CvtItem d0 = decode(it), d1 = decode(two ? it + NGW : it);
        f32x4 a0[4], b0[4], a1[4], b1[4];
        cvt_load(d0, lane, a0, b0); if (two) cvt_load(d1, lane, a1, b1);
        asm volatile("" ::: "memory");
        cvt_finish(d0, lane, a0, b0, scr); if (two) cvt_finish(d1, lane, a1, b1, scr + 2048);
    }
    { bf16_t* w2t = (bf16_t*)(ws + OFF_LW2); bf16_t* a2t = (bf16_t*)(ws + OFF_LA2); bf16_t* g2t = (bf16_t*)(ws + OFF_LG2);
      const float* w2 = a.in[I_W2] + (size_t)L * 64 * RW; const float* a2 = a.in[I_A2] + (size_t)L * 64 * RW; const float* g2 = a.in[I_G2] + (size_t)L * 160 * RW;
      for (int i = blockIdx.x * 512 + tidx_; i < RW * 288; i += gridDim.x * 512) { const int c = i / 288, jj = i - c * 288;
          if (jj < 64) w2t[c * 64 + jj] = (bf16_t)f2bf(w2[(size_t)jj * RW + c]);
          else if (jj < 128) a2t[c * 64 + jj - 64] = (bf16_t)f2bf(a2[(size_t)(jj - 64) * RW + c]);
          else g2t[c * 160 + jj - 128] = (bf16_t)f2bf(g2[(size_t)(jj - 128) * RW + c]); } }
    { u32x4* z = (u32x4*)(ws + OFF_WIN + (size_t)DIN * D * 2); const int n16 = (NP - DIN) * D * 2 / 16;
      for (int i = blockIdx.x * 512 + tidx_; i < n16; i += gridDim.x * 512) z[i] = (u32x4){0u, 0u, 0u, 0u}; }
}
DI int rel_bucket_dev(int d) {
    if (d < 16) return d;
    const float df = (float)d;
    const int large = 16 + (int)(logf(df / 16.0f) / 2.0794415416798357f * 16.0f);
    return large < 31 ? large : 31;
}
DI void init_phase(const Args& a) {
    const int tidx_ = otid();
    const size_t n4 = (size_t)M * D / 4; const f32x4* x = (const f32x4*)a.in[I_X]; u32x2* XB = (u32x2*)(a.ws + OFF_XB);
    for (size_t i = (size_t)blockIdx.x * 512 + tidx_; i < n4; i += (size_t)gridDim.x * 512) { const f32x4 v = x[i]; u32x2 o; o.x = pk2(v[0], v[1]); o.y = pk2(v[2], v[3]); XB[i] = o; }
    if (blockIdx.x == 0) { float* bt = (float*)(a.ws + OFF_BIAS); for (int i = tidx_; i < 8 * 128; i += 512) { const int h = i >> 7, d = i & 127; bt[i] = a.in[I_RELB][rel_bucket_dev(d) * 8 + h]; } }
}
DI void ln_phase(const float* T, const float* g, const float* b, float* ST, bf16_t* XB, float* out) {
    const int tidx_ = otid();
    const int wave = __builtin_amdgcn_readfirstlane(tidx_ >> 6), lane = tidx_ & 63;
    const int stride = gridDim.x * 8;
    f32x4 gvs[8], bvs[8];
#pragma unroll
    for (int j = 0; j < 8; ++j) { gvs[j] = ((const f32x4*)g)[lane + 64 * j]; bvs[j] = ((const f32x4*)b)[lane + 64 * j]; }
    int m = blockIdx.x * 8 + wave;
    f32x4 nx[8];
    if (m < M) {
#pragma unroll
        for (int j = 0; j < 8; ++j) nx[j] = ((const f32x4*)(T + (size_t)m * D) + lane)[64 * j]; }
#pragma unroll 1
    for (; m < M; m += stride) {
        f32x4 v[8]; float s = 0.f;
#pragma unroll
        for (int j = 0; j < 8; ++j) { v[j] = nx[j]; s += (v[j][0] + v[j][1]) + (v[j][2] + v[j][3]); }
        if (m + stride < M) {
#pragma unroll
            for (int j = 0; j < 8; ++j) nx[j] = ((const f32x4*)(T + (size_t)(m + stride) * D) + lane)[64 * j]; }
        const float mean = wave_sum(s) * (1.0f / D); float q = 0.f;
#pragma unroll
        for (int j = 0; j < 8; ++j) { v[j] = v[j] - mean; q += (v[j][0] * v[j][0] + v[j][1] * v[j][1]) + (v[j][2] * v[j][2] + v[j][3] * v[j][3]); }
        const float rstd = __builtin_amdgcn_rsqf(wave_sum(q) * (1.0f / D) + LN_EPS);
        if (lane == 0) *(f32x2*)(ST + 2 * (size_t)m) = (f32x2){mean, rstd};
        u32x2* bo = (u32x2*)(XB + (size_t)m * D) + lane;
#pragma unroll
        for (int j = 0; j < 8; ++j) {
            const f32x4 o = v[j] * rstd * gvs[j] + bvs[j]; u32x2 w; w.x = pk2(o[0], o[1]); w.y = pk2(o[2], o[3]); bo[64 * j] = w;
            if (out) ((f32x4*)(out + (size_t)m * D) + lane)[64 * j] = o; }
    }
}
DI void rwkv_prep_phase(const Args& a, int L, unsigned char* lds) {
    const int tidx_ = otid();
    const int tid = tidx_;
    const bf16_t* P = (const bf16_t*)(a.ws + OFF_P);
    float* Rr = (float*)(a.ws + OFF_SCR); float* Wr = Rr + (size_t)M * RW; float* Kr = Wr + (size_t)M * RW; float* Vr = Kr + (size_t)M * RW; float* Ar = Vr + (size_t)M * RW; float* Br = Ar + (size_t)M * RW;
    bf16_t* Gb = (bf16_t*)(a.ws + OFF_MG);
    const float* mu = a.in[I_MU] + (size_t)L * 3360; const float* w0 = a.in[I_W0] + L * RW; const float* w2 = a.in[I_W2] + (size_t)L * 64 * RW;
    const float* a0 = a.in[I_A0] + L * RW; const float* a2 = a.in[I_A2] + (size_t)L * 64 * RW; const float* g2 = a.in[I_G2] + (size_t)L * 160 * RW;
    const float* kkw = a.in[I_KK] + L * RW; const float* kaw = a.in[I_KA] + L * RW;
    float* xl = (float*)lds;
    for (int unit = blockIdx.x; unit < M / 32; unit += gridDim.x) {
        const int m0 = unit * 32;
        __syncthreads();
        for (int idx = tid; idx < 32 * 288; idx += 512) { const int tt = idx / 288, j = idx - tt * 288; const int m = m0 + tt;
            const float cur = bf2f(P[(size_t)m * PCOLS + PC_LORA + j]); const float prev = (m & (SEQ - 1)) == 0 ? 0.f : bf2f(P[(size_t)(m - 1) * PCOLS + PC_LORA + j]);
            float x = cur + (prev - cur) * mu[3072 + j];
            if (j < 64) x = tanhf(x); else if (j >= 128) x = sigmoidf_(x);
            xl[idx] = x; }
        __syncthreads();
#pragma unroll 1
        for (int half = 0; half < 2; ++half) { const int c = tid + 512 * half;
            const float w0c = w0[c], a0c = a0[c], kkc = kkw[c], kac = kaw[c], mur = mu[c], muk = mu[1024 + c], muv = mu[2048 + c];
#pragma unroll 1
            for (int sub = 0; sub < 4; ++sub) {
                float wl[8], al[8], gl[8];
#pragma unroll
                for (int t = 0; t < 8; ++t) { wl[t] = w0c; al[t] = a0c; gl[t] = 0.f; }
                const float* xb = xl + sub * 8 * 288;
#pragma unroll 2
                for (int j = 0; j < 64; j += 4) { const float u0 = w2[(size_t)(j + 0) * RW + c], u1 = w2[(size_t)(j + 1) * RW + c], u2 = w2[(size_t)(j + 2) * RW + c], u3 = w2[(size_t)(j + 3) * RW + c];
                    const float v0 = a2[(size_t)(j + 0) * RW + c], v1 = a2[(size_t)(j + 1) * RW + c], v2 = a2[(size_t)(j + 2) * RW + c], v3 = a2[(size_t)(j + 3) * RW + c];
#pragma unroll
                    for (int t = 0; t < 8; ++t) { const f32x4 xw = *(const f32x4*)(xb + t * 288 + j); const f32x4 xa = *(const f32x4*)(xb + t * 288 + 64 + j);
                        wl[t] += xw[0] * u0 + xw[1] * u1 + xw[2] * u2 + xw[3] * u3; al[t] += xa[0] * v0 + xa[1] * v1 + xa[2] * v2 + xa[3] * v3; } }
#pragma unroll 2
                for (int j = 0; j < 160; j += 4) { const float u0 = g2[(size_t)(j + 0) * RW + c], u1 = g2[(size_t)(j + 1) * RW + c], u2 = g2[(size_t)(j + 2) * RW + c], u3 = g2[(size_t)(j + 3) * RW + c];
#pragma unroll
                    for (int t = 0; t < 8; ++t) { const f32x4 xg = *(const f32x4*)(xb + t * 288 + 128 + j); gl[t] += xg[0] * u0 + xg[1] * u1 + xg[2] * u2 + xg[3] * u3; } }
#pragma unroll
                for (int t = 0; t < 8; ++t) { const int m = m0 + sub * 8 + t; const bool first = (m & (SEQ - 1)) == 0;
                    const bf16_t* pc = P + (size_t)m * PCOLS; const bf16_t* pp = pc - PCOLS;
                    const float rc = bf2f(pc[PC_R + c]), kc = bf2f(pc[PC_K + c]), vc = bf2f(pc[PC_V + c]);
                    const float rp = first ? 0.f : bf2f(pp[PC_R + c]), kp = first ? 0.f : bf2f(pp[PC_K + c]), vp = first ? 0.f : bf2f(pp[PC_V + c]);
                    const float r = rc + (rp - rc) * mur, k = kc + (kp - kc) * muk, v = vc + (vp - vc) * muv;
                    const float nx = -wl[t]; const float sp = nx > 20.f ? nx : log1pf(expf(nx));
                    const float decay = expf(-expf(-sp - 0.5f));
                    const float av = 1.0f / (1.0f + expf(-al[t]));
                    const float kk = k * kkc; const float ss = wave_sum(kk * kk); const float kkn = kk / fmaxf(sqrtf(ss), 1e-12f);
                    const float k2 = k * (1.0f + (av - 1.0f) * kac);
                    const size_t o = (size_t)m * RW + c;
                    Rr[o] = r; Wr[o] = decay; Kr[o] = k2; Vr[o] = v; Ar[o] = -kkn; Br[o] = kkn * av; Gb[o] = (bf16_t)f2bf(gl[t]); }
            }
        }
    }
}
DI void kidx_vt_phase(const Args& a, int L, unsigned char* lds) {
    const int tidx_ = otid();
    const int wave = __builtin_amdgcn_readfirstlane(tidx_ >> 6), lane = tidx_ & 63;
    const bf16_t* P = (const bf16_t*)(a.ws + OFF_P); bf16_t* KI = (bf16_t*)(a.ws + OFF_KI); bf16_t* VT = (bf16_t*)(a.ws + OFF_VT);
    const float g = a.in[I_ILNG][L * 64 + lane], b = a.in[I_ILNB][L * 64 + lane];
    for (int m0 = blockIdx.x * 8 + wave; m0 < M; m0 += gridDim.x * 8 * 8) {
        bf16_t raw[8];
#pragma unroll
        for (int i = 0; i < 8; ++i) { const int m = m0 + i * gridDim.x * 8; raw[i] = m < M ? P[(size_t)m * PCOLS + PC_KI + lane] : (bf16_t)0; }
#pragma unroll
        for (int i = 0; i < 8; ++i) { const int m = m0 + i * gridDim.x * 8; if (m < M) { const float x = bf2f(raw[i]);
            const float mean = wave_sum(x) * (1.0f / 64.0f); const float d = x - mean; const float var = wave_sum(d * d) * (1.0f / 64.0f);
            KI[(size_t)m * 64 + lane] = (bf16_t)f2bf(d * __builtin_amdgcn_rsqf(var + LN_EPS) * g + b); } }
    }
    bf16_t* tile = (bf16_t*)(lds + wave * 16384);
    for (int u = blockIdx.x * 8 + wave; u < NB * 8 * 64; u += gridDim.x * 8) {
        const int tb = u & 63, h = (u >> 6) & 7, b_ = u >> 9; const int m = b_ * SEQ + tb * 64 + lane;
        const u32x4* src = (const u32x4*)(P + (size_t)m * PCOLS + PC_AV + h * 64);
#pragma unroll
        for (int q = 0; q < 8; ++q) { const u32x4 v = src[q]; const unsigned w[4] = {v.x, v.y, v.z, v.w};
#pragma unroll
            for (int e = 0; e < 4; ++e) { tile[(q * 8 + 2 * e) * 72 + lane] = (bf16_t)(w[e] & 0xffffu); tile[(q * 8 + 2 * e + 1) * 72 + lane] = (bf16_t)(w[e] >> 16); } }
        __builtin_amdgcn_s_waitcnt(0xc07f); asm volatile("" ::: "memory");
        bf16_t* dst = VT + ((size_t)(b_ * 8 + h) * 64 + lane) * SEQ + tb * 64;
#pragma unroll
        for (int q = 0; q < 8; ++q) *(u32x4*)(dst + q * 8) = *(const u32x4*)(tile + lane * 72 + q * 8);
        __builtin_amdgcn_s_waitcnt(0xc07f); asm volatile("" ::: "memory");
    }
}
DI void sgu_phase(const Args& a, int L, unsigned char* lds, int vb, int nvb, int u0 = 0, int u1 = NB * 32 * 4) {
    const int tidx_ = otid();
    const int tid = tidx_, wave = __builtin_amdgcn_readfirstlane(tid >> 6), lane = tid & 63, fr = lane & 15, fq = lane >> 4;
    const bf16_t* P = (const bf16_t*)(a.ws + OFF_P); bf16_t* Y = (bf16_t*)(a.ws + OFF_Y);
    const float* lng = a.in[I_SGLNG] + L * 512; const float* lnb = a.in[I_SGLNB] + L * 512;
    bf16_t* Wl = (bf16_t*)lds;
    bf16_t* Vl = (bf16_t*)(lds + 128 * 272);
    for (int unit = u0 + vb; unit < u1; unit += nvb) {
        const int g = unit & 3, ch = (unit >> 2) & 31, b_ = unit >> 7; const int m0 = b_ * SEQ + ch * 128;
        const float* sw = a.in[I_SGW] + ((size_t)(L * 4 + g) * 128) * 128; const float* sb = a.in[I_SGB] + (L * 4 + g) * 128;
        __syncthreads();
#pragma unroll
        for (int it8 = 0; it8 < 8; ++it8) { const int idx = tid + 512 * it8; const int i = idx >> 5, j4 = (idx & 31) * 4; const f32x4 w = *(const f32x4*)(sw + i * 128 + j4);
            u32x2 o; o.x = pk2(j4 + 0 <= i ? w[0] : 0.f, j4 + 1 <= i ? w[1] : 0.f); o.y = pk2(j4 + 2 <= i ? w[2] : 0.f, j4 + 3 <= i ? w[3] : 0.f);
            *(u32x2*)(Wl + i * 136 + j4) = o; }
        float lgv[8], lbv[8];
#pragma unroll
        for (int e = 0; e < 8; ++e) { lgv[e] = lng[lane * 8 + e]; lbv[e] = lnb[lane * 8 + e]; }
        u32x4 pvs[16];
#pragma unroll
        for (int i = 0; i < 16; ++i) pvs[i] = *(const u32x4*)(P + (size_t)(m0 + wave + 8 * i) * PCOLS + PC_SGV + lane * 8);
#pragma unroll
        for (int i = 0; i < 16; ++i) { const int tt = wave + 8 * i;
            const u32x4 pv = pvs[i];
            float z[8]; z[0] = gelu_erf(bflo(pv.x)); z[1] = gelu_erf(bfhi(pv.x)); z[2] = gelu_erf(bflo(pv.y)); z[3] = gelu_erf(bfhi(pv.y));
            z[4] = gelu_erf(bflo(pv.z)); z[5] = gelu_erf(bfhi(pv.z)); z[6] = gelu_erf(bflo(pv.w)); z[7] = gelu_erf(bfhi(pv.w));
            float s = 0.f;
#pragma unroll
            for (int e = 0; e < 8; ++e) s += z[e];
            const float mean = wave_sum(s) * (1.0f / 512.0f); float q = 0.f;
#pragma unroll
            for (int e = 0; e < 8; ++e) { z[e] -= mean; q += z[e] * z[e]; }
            const float rstd = __builtin_amdgcn_rsqf(wave_sum(q) * (1.0f / 512.0f) + LN_EPS);
            if ((lane >> 4) == g) {
#pragma unroll
                for (int e = 0; e < 8; ++e) Vl[((lane & 15) * 8 + e) * 136 + tt] = (bf16_t)f2bf(z[e] * rstd * lgv[e] + lbv[e]); }
        }
        __syncthreads();
        f32x4 acc[8];
#pragma unroll
        for (int nt = 0; nt < 8; ++nt) acc[nt] = (f32x4){0.f, 0.f, 0.f, 0.f};
        const int ksmax = (16 * wave + 15) >> 5;
#pragma unroll
        for (int ks = 0; ks < 4; ++ks) if (ks <= ksmax) {
            const bf16x8 af = *(const bf16x8*)(Wl + (16 * wave + fr) * 136 + 32 * ks + 8 * fq);
#pragma unroll
            for (int nt = 0; nt < 8; ++nt) { const bf16x8 bfr = *(const bf16x8*)(Vl + (16 * nt + fr) * 136 + 32 * ks + 8 * fq);
                acc[nt] = __builtin_amdgcn_mfma_f32_16x16x32_bf16(af, bfr, acc[nt], 0, 0, 0); }
        }
        bf16_t ur[4][8];
#pragma unroll
        for (int r = 0; r < 4; ++r)
#pragma unroll
            for (int nt = 0; nt < 8; ++nt) ur[r][nt] = P[(size_t)(m0 + 16 * wave + 4 * fq + r) * PCOLS + PC_SGU + g * 128 + 16 * nt + fr];
        float bsv[4];
#pragma unroll
        for (int r = 0; r < 4; ++r) bsv[r] = sb[16 * wave + 4 * fq + r];
        asm volatile("" ::: "memory");
#pragma unroll
        for (int r = 0; r < 4; ++r) { const int i = 16 * wave + 4 * fq + r; const float bs = bsv[r]; const size_t m = (size_t)(m0 + i);
#pragma unroll
            for (int nt = 0; nt < 8; ++nt) { const int dcol = g * 128 + 16 * nt + fr; const float uu = gelu_erf(bf2f(ur[r][nt]));
                Y[m * D + 1024 + dcol] = (bf16_t)f2bf(uu * (acc[nt][r] + bs)); } }
    }
}
DI void scan_load_chunk(unsigned char* bufp, const float* Rr, const float* Wr, const float* Kr, const float* Ar, const float* Br, const float* Vr, size_t base, int c, int rg, int lt) {
    const float* arrs[5] = {Rr, Wr, Kr, Ar, Br};
#pragma unroll
    for (int ar = 0; ar < 5; ++ar)
#pragma unroll
        for (int ps = 0; ps < 2; ++ps) { const int tt = ps * 16 + (lt >> 4), c4 = (lt & 15) * 4;
            const f32x4 v = *(const f32x4*)(arrs[ar] + base + (size_t)(c * 32 + tt) * RW + c4);
            *(f32x4*)(bufp + ar * 8192 + (tt * 64 + c4) * 4) = v; }
    if (lt < 128) { const int tt = lt >> 2, i4 = (lt & 3) * 4; const f32x4 v = *(const f32x4*)(Vr + base + (size_t)(c * 32 + tt) * RW + rg * 16 + i4);
        *(f32x4*)(bufp + 5 * 8192 + (tt * 16 + i4) * 4) = v; }
}
DI void scan_phase(const Args& a, unsigned char* lds) {
    const int tidx_ = otid();
    const int tid = tidx_;
    const float* Rr = (const float*)(a.ws + OFF_SCR); const float* Wr = Rr + (size_t)M * RW; const float* Kr = Wr + (size_t)M * RW; const float* Vr = Kr + (size_t)M * RW; const float* Ar = Vr + (size_t)M * RW; const float* Br = Ar + (size_t)M * RW;
    float* Yraw = (float*)(a.ws + OFF_X);
    constexpr int BUFB = 5 * 8192 + 2048;
    constexpr int NCH = SEQ / 32;
    for (int unit = blockIdx.x; unit < 256; unit += gridDim.x) {
        const int rg = unit & 3, h = (unit >> 2) & 15, b_ = unit >> 6;
        const size_t base = (size_t)b_ * SEQ * RW + h * 64;
        __syncthreads();
        const bool loader = tid >= 256; const int lt = tid - 256;
        if (loader) scan_load_chunk(lds, Rr, Wr, Kr, Ar, Br, Vr, base, 0, rg, lt);
        __syncthreads();
        float S0 = 0.f, S1 = 0.f, S2 = 0.f, S3 = 0.f;
        const int i = tid >> 4, c4 = tid & 15;
#pragma unroll 1
        for (int c = 0; c < NCH; ++c) {
            if (loader) {
                if (c > 0 && lt < 128) { const int tt = lt >> 2, i4 = (lt & 3) * 4; const f32x4 y = *(const f32x4*)(lds + 2 * BUFB + ((c - 1) & 1) * 2048 + (tt * 16 + i4) * 4);
                    *(f32x4*)(Yraw + base + (size_t)((c - 1) * 32 + tt) * RW + rg * 16 + i4) = y; }
                if (c + 1 < NCH) scan_load_chunk(lds + ((c + 1) & 1) * BUFB, Rr, Wr, Kr, Ar, Br, Vr, base, c + 1, rg, lt);
            } else {
                const unsigned char* bufp = lds + (c & 1) * BUFB; float* yb = (float*)(lds + 2 * BUFB + (c & 1) * 2048);
#pragma unroll 4
                for (int s = 0; s < 32; ++s) {
                    const f32x4 r4 = *(const f32x4*)(bufp + 0 * 8192 + (s * 64 + c4 * 4) * 4);
                    const f32x4 w4 = *(const f32x4*)(bufp + 1 * 8192 + (s * 64 + c4 * 4) * 4);
                    const f32x4 k4 = *(const f32x4*)(bufp + 2 * 8192 + (s * 64 + c4 * 4) * 4);
                    const f32x4 a4 = *(const f32x4*)(bufp + 3 * 8192 + (s * 64 + c4 * 4) * 4);
                    const f32x4 b4 = *(const f32x4*)(bufp + 4 * 8192 + (s * 64 + c4 * 4) * 4);
                    const float vi = *(const float*)(bufp + 5 * 8192 + (s * 16 + i) * 4);
                    float sa = (S0 * a4[0] + S1 * a4[1]) + (S2 * a4[2] + S3 * a4[3]);
                    sa = row16_sum(sa);
                    S0 = S0 * w4[0] + sa * b4[0] + vi * k4[0]; S1 = S1 * w4[1] + sa * b4[1] + vi * k4[1];
                    S2 = S2 * w4[2] + sa * b4[2] + vi * k4[2]; S3 = S3 * w4[3] + sa * b4[3] + vi * k4[3];
                    float yp = (S0 * r4[0] + S1 * r4[1]) + (S2 * r4[2] + S3 * r4[3]);
                    yp = row16_sum(yp);
                    if (c4 == 0) yb[s * 16 + i] = yp;
                }
            }
            __syncthreads();
        }
        if (loader && lt < 128) { const int tt = lt >> 2, i4 = (lt & 3) * 4; const f32x4 y = *(const f32x4*)(lds + 2 * BUFB + ((NCH - 1) & 1) * 2048 + (tt * 16 + i4) * 4);
            *(f32x4*)(Yraw + base + (size_t)((NCH - 1) * 32 + tt) * RW + rg * 16 + i4) = y; }
    }
}
DI void rwkv_fin_phase(const Args& a, int L) {
    const int tidx_ = otid();
    const int wave = __builtin_amdgcn_readfirstlane(tidx_ >> 6), lane = tidx_ & 63;
    const float* Rr = (const float*)(a.ws + OFF_SCR); const float* Kr = Rr + 2 * (size_t)M * RW; const float* Vr = Kr + (size_t)M * RW;
    const float* Yraw = (const float*)(a.ws + OFF_X); const bf16_t* Gb = (const bf16_t*)(a.ws + OFF_MG); bf16_t* Y = (bf16_t*)(a.ws + OFF_Y);
    const float* rk = a.in[I_RK] + L * RW; const float* gng = a.in[I_GNG] + L * RW; const float* gnb = a.in[I_GNB] + L * RW;
    for (int it = blockIdx.x * 8 + wave; it < M * 16; it += gridDim.x * 8) {
        const int m = it >> 4, h = it & 15, c = h * 64 + lane; const size_t o = (size_t)m * RW + c;
        const float y = Yraw[o], r = Rr[o], k = Kr[o], v = Vr[o];
        const float mean = wave_sum(y) * (1.0f / 64.0f); const float d = y - mean; const float var = wave_sum(d * d) * (1.0f / 64.0f);
        const float yn = d * (1.0f / sqrtf(var + 64e-5f)) * gng[c] + gnb[c];
        const float bonus = wave_sum(r * k * rk[c]) * v;
        Y[(size_t)m * D + c] = (bf16_t)f2bf((yn + bonus) * bf2f(Gb[o]));
    }
}
DI void rwkv_par_phase(const Args& a, int L, unsigned char* lds) {
    const int tidx_ = otid();
    const int tid = tidx_, wave = __builtin_amdgcn_readfirstlane(tid >> 6), lane = tid & 63, fr = lane & 15, q = lane >> 4;
    const bf16_t* P = (const bf16_t*)(a.ws + OFF_P); unsigned char* RECB = a.ws + OFF_SCR;
    const bf16_t* W2T = (const bf16_t*)(a.ws + OFF_LW2); const bf16_t* A2T = (const bf16_t*)(a.ws + OFF_LA2); const bf16_t* G2T = (const bf16_t*)(a.ws + OFF_LG2);
    const float* mu = a.in[I_MU] + (size_t)L * 3360; const float* w0 = a.in[I_W0] + L * RW; const float* a0 = a.in[I_A0] + L * RW;
    const float* kkw = a.in[I_KK] + L * RW; const float* kaw = a.in[I_KA] + L * RW; const float* rkw = a.in[I_RK] + L * RW;
    unsigned char* XL = lds;
    unsigned char* WS = lds + 9472 + wave * 12288;
    for (int unit = blockIdx.x; unit < NB * 256; unit += gridDim.x) {
        const int b_ = unit >> 8, cidx = unit & 255; const int m0 = b_ * SEQ + cidx * 16;
        __syncthreads();
        int tb9 = tid; asm volatile("" : "+v"(tb9));
#pragma unroll
        for (int it9 = 0; it9 < 9; ++it9) { const int idx = tb9 + 512 * it9; const int t = idx / 288, jj = idx - t * 288; const int m = m0 + t;
            const float cur = bf2f(P[(size_t)m * PCOLS + PC_LORA + jj]); const float prev = (m & (SEQ - 1)) == 0 ? 0.f : bf2f(P[(size_t)(m - 1) * PCOLS + PC_LORA + jj]);
            float x = cur + (prev - cur) * mu[3072 + jj];
            if (jj < 64) { const float e2x = __expf(2.0f * x); x = 1.0f - 2.0f * __builtin_amdgcn_rcpf(e2x + 1.0f); } else if (jj >= 128) x = __builtin_amdgcn_rcpf(1.0f + __expf(-x));
            *(bf16_t*)(XL + t * 592 + jj * 2) = (bf16_t)f2bf(x); }
        __syncthreads();
#define AXF(ks) (*(const bf16x8*)(XL + fr * 592 + (32 * (ks) + 8 * q) * 2))
#pragma unroll 1
        for (int hh2 = 0; hh2 < 2; ++hh2) {
            const int h = wave + 8 * hh2; const int c = h * 64 + lane;
            unsigned char* rec = RECB + (size_t)(cidx * 64 + b_ * 16 + h) * REC;
            const bool first = (m0 & (SEQ - 1)) == 0;
            const bf16_t* pbase = P + (size_t)m0 * PCOLS + h * 64 + lane;
            unsigned rawrk[17], rawvv[9];
#pragma unroll
            for (int t = 0; t < 17; ++t) { const bf16_t* pc = pbase + (ptrdiff_t)(t - 1) * PCOLS; const bool ok = t > 0 || !first;
                const unsigned rr_ = ok ? (unsigned)pc[PC_R] : 0u, kk_ = ok ? (unsigned)pc[PC_K] : 0u, vv_ = ok ? (unsigned)pc[PC_V] : 0u;
                rawrk[t] = rr_ | (kk_ << 16); if (t & 1) rawvv[t >> 1] |= vv_ << 16; else rawvv[t >> 1] = vv_; }
            const float w0c = w0[c], a0c = a0[c], kkc = kkw[c], kac = kaw[c], rkc = rkw[c], mur = mu[c], muk = mu[1024 + c], muv = mu[2048 + c];
            bf16x8 bwf[4][2], baf[4][2];
#pragma unroll
            for (int nt = 0; nt < 4; ++nt) { const int cn = h * 64 + 16 * nt + fr;
#pragma unroll
                for (int ks = 0; ks < 2; ++ks) { bwf[nt][ks] = *(const bf16x8*)(W2T + cn * 64 + 32 * ks + 8 * q); baf[nt][ks] = *(const bf16x8*)(A2T + cn * 64 + 32 * ks + 8 * q); } }
            asm volatile("" ::: "memory");
            f32x4 accW[4], accA[4], accG[4];
#pragma unroll
            for (int nt = 0; nt < 4; ++nt) { accW[nt] = (f32x4){0.f, 0.f, 0.f, 0.f}; accA[nt] = accW[nt]; accG[nt] = accW[nt];
#pragma unroll
                for (int ks = 0; ks < 2; ++ks) { accW[nt] = __builtin_amdgcn_mfma_f32_16x16x32_bf16(AXF(ks), bwf[nt][ks], accW[nt], 0, 0, 0); accA[nt] = __builtin_amdgcn_mfma_f32_16x16x32_bf16(AXF(2 + ks), baf[nt][ks], accA[nt], 0, 0, 0); } }
#pragma unroll
            for (int n2 = 0; n2 < 2; ++n2) { bf16x8 bgf[2][5];
#pragma unroll
                for (int nn = 0; nn < 2; ++nn) { const int cn = h * 64 + 16 * (2 * n2 + nn) + fr;
#pragma unroll
                    for (int ks = 0; ks < 5; ++ks) bgf[nn][ks] = *(const bf16x8*)(G2T + cn * 160 + 32 * ks + 8 * q); }
                asm volatile("" ::: "memory");
#pragma unroll
                for (int nn = 0; nn < 2; ++nn)
#pragma unroll
                    for (int ks = 0; ks < 5; ++ks) accG[2 * n2 + nn] = __builtin_amdgcn_mfma_f32_16x16x32_bf16(AXF(4 + ks), bgf[nn][ks], accG[2 * n2 + nn], 0, 0, 0); }
            float* X3 = (float*)WS;
#pragma unroll
            for (int nt = 0; nt < 4; ++nt)
#pragma unroll
                for (int r = 0; r < 4; ++r) { const int o = (4 * q + r) * 64 + 16 * nt + fr; X3[o] = accW[nt][r]; X3[1024 + o] = accA[nt][r]; X3[2048 + o] = accG[nt][r]; }
            float cum[16], asg[16];
            { float run = 0.f;
#pragma unroll
              for (int t = 0; t < 16; ++t) { float dw = X3[t * 64 + lane], da = X3[1024 + t * 64 + lane], dg = X3[2048 + t * 64 + lane];
#if DBG_LORA
                  { const float* w2 = a.in[I_W2] + (size_t)L * 64 * RW; const float* a2 = a.in[I_A2] + (size_t)L * 64 * RW; const float* g2 = a.in[I_G2] + (size_t)L * 160 * RW;
                    float s0 = 0.f, s1 = 0.f, s2 = 0.f;
                    for (int jj = 0; jj < 64; ++jj) { s0 += bf2f(*(const bf16_t*)(XL + t * 592 + jj * 2)) * w2[(size_t)jj * RW + c]; s1 += bf2f(*(const bf16_t*)(XL + t * 592 + (64 + jj) * 2)) * a2[(size_t)jj * RW + c]; }
                    for (int jj = 0; jj < 160; ++jj) s2 += bf2f(*(const bf16_t*)(XL + t * 592 + (128 + jj) * 2)) * g2[(size_t)jj * RW + c];
                    dw = s0; da = s1; dg = s2; }
#endif
                  const float nx = -(w0c + dw); const float sp = nx > 20.f ? nx : __logf(1.0f + __expf(nx));
                  run += -__expf(-sp - 0.5f); cum[t] = run; asg[t] = __builtin_amdgcn_rcpf(1.0f + __expf(-(a0c + da)));
                  *(bf16_t*)(rec + R_G + (t * 64 + lane) * 2) = (bf16_t)f2bf(dg); } }
            asm volatile("" ::: "memory");
            const float gC = __expf(cum[15]); *(float*)(rec + R_GC + lane * 4) = gC;
            bf16_t* imgA = (bf16_t*)WS; bf16_t* imgR = (bf16_t*)(WS + 2304); bf16_t* imgB = (bf16_t*)(WS + 4608); bf16_t* imgK = (bf16_t*)(WS + 6912);
            float At[16]; unsigned vpk[8]; float bgv[4], kgv[4]; float vprev = 0.f;
            float rp = bflo(rawrk[0]), kp = bfhi(rawrk[0]), vp = bflo(rawvv[0]);
            float eprev = 1.0f;
#pragma unroll
            for (int t = 0; t < 16; ++t) {
                const float rc = bflo(rawrk[t + 1]), kc = bfhi(rawrk[t + 1]), vc = ((t + 1) & 1) ? bfhi(rawvv[(t + 1) >> 1]) : bflo(rawvv[(t + 1) >> 1]);
                const float r = rc + (rp - rc) * mur, k = kc + (kp - kc) * muk, v = vc + (vp - vc) * muv; rp = rc; kp = kc; vp = vc;
                const float asig = asg[t];
                const float kk = k * kkc; const float kkn = kk * __builtin_amdgcn_rsqf(fmaxf(wave_sum(kk * kk), 1e-24f));
                const float k2 = k * (1.0f + (asig - 1.0f) * kac); const float av = -kkn, bv = kkn * asig;
                const float bon = wave_sum(r * k2 * rkc); if (lane == 0) *(float*)(rec + R_BON + t * 4) = bon;
                const float e2 = __expf(cum[t]), e3 = __expf(-cum[t]), e4 = __expf(cum[15] - cum[t]);
                At[t] = eprev * av; eprev = e2;
                const float Rt = e2 * r, Bt = bv * e3, Kt = k2 * e3;
                imgA[t * 72 + lane] = (bf16_t)f2bf(At[t]); imgR[t * 72 + lane] = (bf16_t)f2bf(Rt); imgB[t * 72 + lane] = (bf16_t)f2bf(Bt); imgK[t * 72 + lane] = (bf16_t)f2bf(Kt);
                *(bf16_t*)(rec + R_RL2 + t * RROW + lane * 2) = (bf16_t)f2bf(Rt);
                bgv[t & 3] = bv * e4; kgv[t & 3] = k2 * e4;
                if ((t & 3) == 3) { u32x4 o; o.x = pk2(bgv[0], bgv[1]); o.y = pk2(bgv[2], bgv[3]); o.z = pk2(kgv[0], kgv[1]); o.w = pk2(kgv[2], kgv[3]); *(u32x4*)(rec + R_A2 + (lane * 4 + (t >> 2)) * 16) = o; }
                if (t & 1) vpk[t >> 1] = pk2(vprev, v); else vprev = v; }
            { u32x4 o0, o1; o0.x = vpk[0]; o0.y = vpk[1]; o0.z = vpk[2]; o0.w = vpk[3]; o1.x = vpk[4]; o1.y = vpk[5]; o1.z = vpk[6]; o1.w = vpk[7];
              *(u32x4*)(rec + R_VT + lane * 32) = o0; *(u32x4*)(rec + R_VT + lane * 32 + 16) = o1; }
            asm volatile("" ::: "memory");
            f32x4 gAB = (f32x4){0.f, 0.f, 0.f, 0.f}, gAK = gAB, gBR = gAB, gKR = gAB;
#pragma unroll
            for (int ks = 0; ks < 2; ++ks) { const int off = fr * 72 + 32 * ks + 8 * q;
                const bf16x8 fA = *(const bf16x8*)(imgA + off), fR = *(const bf16x8*)(imgR + off), fB = *(const bf16x8*)(imgB + off), fK = *(const bf16x8*)(imgK + off);
                gAB = __builtin_amdgcn_mfma_f32_16x16x32_bf16(fB, fA, gAB, 0, 0, 0); gAK = __builtin_amdgcn_mfma_f32_16x16x32_bf16(fK, fA, gAK, 0, 0, 0);
                gBR = __builtin_amdgcn_mfma_f32_16x16x32_bf16(fB, fR, gBR, 0, 0, 0); gKR = __builtin_amdgcn_mfma_f32_16x16x32_bf16(fK, fR, gKR, 0, 0, 0); }
#pragma unroll
            for (int r = 0; r < 4; ++r) { const int sI = 4 * q + r; gAB[r] = sI < fr ? gAB[r] : 0.f; gAK[r] = sI < fr ? gAK[r] : 0.f; gBR[r] = sI <= fr ? gBR[r] : 0.f; gKR[r] = sI <= fr ? gKR[r] : 0.f; }
            { u32x4 o; o.x = pk2(gBR[0], gBR[1]); o.y = pk2(gBR[2], gBR[3]); o.z = pk2(gKR[0], gKR[1]); o.w = pk2(gKR[2], gKR[3]); *(u32x4*)(rec + R_A3 + (fr * 4 + q) * 16) = o; }
            asm volatile("" ::: "memory");
            float* AKL = (float*)(WS + 9216);
#pragma unroll
            for (int r = 0; r < 4; ++r) AKL[(4 * q + r) * 16 + fr] = gAK[r];
            float Ft[16];
            { const f32x4* row = (const f32x4*)(AKL + (lane & 15) * 16);
#pragma unroll
              for (int t4 = 0; t4 < 4; ++t4) { const f32x4 v4 = row[t4]; Ft[4 * t4] = v4[0]; Ft[4 * t4 + 1] = v4[1]; Ft[4 * t4 + 2] = v4[2]; Ft[4 * t4 + 3] = v4[3]; } }
#pragma unroll
            for (int t = 1; t < 16; ++t) { float e = At[t], f = Ft[t];
#pragma unroll
                for (int s2 = 0; s2 < t; ++s2) { const float gsel = gAB[s2 & 3];
                    const float sc = __int_as_float(__builtin_amdgcn_readlane(__float_as_int(gsel), t + 16 * (s2 >> 2))); e += At[s2] * sc; f += Ft[s2] * sc; }
                At[t] = e; Ft[t] = f; }
#pragma unroll
            for (int t = 0; t < 16; ++t) *(bf16_t*)(rec + R_EL2 + t * RROW + lane * 2) = (bf16_t)f2bf(At[t]);
            asm volatile("" ::: "memory");
            float* FL = (float*)(WS + 10240);
            if (lane < 16) {
#pragma unroll
                for (int t4 = 0; t4 < 4; ++t4) *(f32x4*)(FL + lane * 16 + 4 * t4) = (f32x4){Ft[4 * t4], Ft[4 * t4 + 1], Ft[4 * t4 + 2], Ft[4 * t4 + 3]}; }
            { const float f0 = FL[(4 * q + 0) * 16 + fr], f1 = FL[(4 * q + 1) * 16 + fr], f2 = FL[(4 * q + 2) * 16 + fr], f3 = FL[(4 * q + 3) * 16 + fr];
              u32x2 o; o.x = pk2(f0, f1); o.y = pk2(f2, f3); *(u32x2*)(rec + R_FT + (fr * 4 + q) * 8) = o; }
            asm volatile("" ::: "memory");
        }
    }
#undef AXF
}
DI bf16x8 mk8(u32x2 lo, u32x2 hi) { u32x4 w; w.x = lo.x; w.y = lo.y; w.z = hi.x; w.w = hi.y; return __builtin_bit_cast(bf16x8, w); }
struct SeqOps { u32x2 e[2][2], r[2][2]; u32x4 a2[4]; u32x4 a3; u32x2 ft, vt; f32x4 gc[4]; };
DI void seq_ops_load(SeqOps& f, const LAS unsigned char* rec, int fr, int q, int i0) {
#pragma unroll
    for (int ks = 0; ks < 2; ++ks) { f.e[ks][0] = *(const LAS u32x2*)(rec + R_EL2 + fr * RROW + (32 * ks + 4 * q) * 2); f.e[ks][1] = *(const LAS u32x2*)(rec + R_EL2 + fr * RROW + (32 * ks + 16 + 4 * q) * 2);
        f.r[ks][0] = *(const LAS u32x2*)(rec + R_RL2 + fr * RROW + (32 * ks + 4 * q) * 2); f.r[ks][1] = *(const LAS u32x2*)(rec + R_RL2 + fr * RROW + (32 * ks + 16 + 4 * q) * 2); }
#pragma unroll
    for (int jt = 0; jt < 4; ++jt) { f.a2[jt] = *(const LAS u32x4*)(rec + R_A2 + ((16 * jt + fr) * 4 + q) * 16); f.gc[jt] = *(const LAS f32x4*)(rec + R_GC + (16 * jt + 4 * q) * 4); }
    f.a3 = *(const LAS u32x4*)(rec + R_A3 + (fr * 4 + q) * 16); f.ft = *(const LAS u32x2*)(rec + R_FT + (fr * 4 + q) * 8); f.vt = *(const LAS u32x2*)(rec + R_VT + ((i0 + fr) * 16 + 4 * q) * 2);
}
DI void rwkv_seq_phase(const Args& a, unsigned char* lds, float* yout, const float* gng, const float* gnb, bf16_t* yfin) {
    const int tidx_ = otid();
    const int tid = tidx_, wave = __builtin_amdgcn_readfirstlane(tid >> 6), lane = tid & 63, fr = lane & 15, q = lane >> 4;
    constexpr int NR = 8, DEPTH_ = 6, NCHK = 256;
    LAS unsigned char* ring = (LAS unsigned char*)lds;
    LAS float* ybuf = (LAS float*)(ring + NR * REC);
    for (int bh = blockIdx.x; bh < NB * 16; bh += gridDim.x) {
        const unsigned char* rec0 = a.ws + OFF_SCR + (size_t)bh * REC;
        const int hd = bh & 15;
        asm volatile("s_waitcnt vmcnt(0) lgkmcnt(0)" ::: "memory"); __builtin_amdgcn_s_barrier();
        if (wave >= 4) {
            const int lw = wave - 4;
            const float gg = yfin ? gng[hd * 64 + lane] : 0.f, gb = yfin ? gnb[hd * 64 + lane] : 0.f;
            bf16_t* Yo = yfin + ((size_t)(bh >> 4) * SEQ) * D + hd * 64 + lane;
#define SEQ_ISSUE(cc) do { const unsigned char* g_ = rec0 + (size_t)(cc) * 64 * REC; LAS unsigned char* l_ = ring + ((cc) & (NR - 1)) * REC; \
            _Pragma("unroll") for (int i_ = 0; i_ < 4; ++i_) { int pc_ = i_ * 4 + lw; if (pc_ >= 15) pc_ = lw; \
                __builtin_amdgcn_global_load_lds((const unsigned*)(g_ + pc_ * 1024 + lane * 16), (LAS unsigned*)(l_ + pc_ * 1024), 16, 0, 0); } } while (0)
#define SEQ_FINALIZE(cf) do { const LAS unsigned char* rc_ = ring + ((cf) & (NR - 1)) * REC; const LAS float* yb_ = ybuf + ((cf) & 1) * 1024; \
            const u32x2 vv_ = *(const LAS u32x2*)(rc_ + R_VT + (lane * 16 + 4 * lw) * 2); \
            float y_[4], rd_[8]; \
            _Pragma("unroll") for (int tt_ = 0; tt_ < 4; ++tt_) { y_[tt_] = yb_[(4 * lw + tt_) * 64 + lane]; rd_[tt_] = y_[tt_]; rd_[4 + tt_] = y_[tt_] * y_[tt_]; } \
            wave_sum8(rd_);        \
            _Pragma("unroll") for (int tt_ = 0; tt_ < 4; ++tt_) { const int t_ = 4 * lw + tt_; \
                const float mean_ = rd_[tt_] * (1.0f / 64.0f); const float var_ = fmaxf(rd_[4 + tt_] * (1.0f / 64.0f) - mean_ * mean_, 0.f); \
                const float yn_ = (y_[tt_] - mean_) * __builtin_amdgcn_rsqf(var_ + 64e-5f) * gg + gb; \
                const float bon_ = *(const LAS float*)(rc_ + R_BON + t_ * 4); const float g_ = bf2f(*(const LAS bf16_t*)(rc_ + R_G + (t_ * 64 + lane) * 2)); \
                const unsigned vw_ = (tt_ & 2) ? vv_.y : vv_.x; const float v_ = (tt_ & 1) ? bfhi(vw_) : bflo(vw_); \
                Yo[(size_t)(16 * (cf) + t_) * D] = (bf16_t)f2bf((yn_ + bon_ * v_) * g_); } } while (0)
#pragma unroll 1
            for (int cc = 0; cc < DEPTH_; ++cc) SEQ_ISSUE(cc);
            asm volatile("s_waitcnt vmcnt(16)" ::: "memory");
            __builtin_amdgcn_s_barrier();
#pragma unroll 1
            for (int c = 0; c < NCHK; ++c) {
                if (yfin && c > 0) SEQ_FINALIZE(c - 1);
                if (c + DEPTH_ < NCHK) { SEQ_ISSUE(c + DEPTH_); asm volatile("s_waitcnt vmcnt(16)" ::: "memory"); }
                else asm volatile("s_waitcnt vmcnt(0)" ::: "memory");
                asm volatile("s_waitcnt lgkmcnt(0)" ::: "memory");
                __builtin_amdgcn_s_barrier();
            }
            if (yfin) SEQ_FINALIZE(NCHK - 1);
#undef SEQ_ISSUE
#undef SEQ_FINALIZE
        } else {
            const int i0 = wave * 16;
            float* Yp = yout + (size_t)(bh >> 4) * SEQ * RW + hd * 64 + i0 + fr;
            f32x4 S[4];
#pragma unroll
            for (int jt = 0; jt < 4; ++jt) S[jt] = (f32x4){0.f, 0.f, 0.f, 0.f};
            __builtin_amdgcn_s_barrier();
            SeqOps cur, nxt; seq_ops_load(cur, ring, fr, q, i0);
#pragma unroll 1
            for (int c = 0; c < NCHK; ++c) {
                if (c + 1 < NCHK) seq_ops_load(nxt, ring + ((c + 1) & (NR - 1)) * REC, fr, q, i0); else nxt = cur;
                bf16x8 sh[2];
#pragma unroll
                for (int ks = 0; ks < 2; ++ks) { u32x4 hw; hw.x = pk2(S[2 * ks][0], S[2 * ks][1]); hw.y = pk2(S[2 * ks][2], S[2 * ks][3]); hw.z = pk2(S[2 * ks + 1][0], S[2 * ks + 1][1]); hw.w = pk2(S[2 * ks + 1][2], S[2 * ks + 1][3]); sh[ks] = __builtin_bit_cast(bf16x8, hw); }
                const u32x2 z2 = {0u, 0u}; const f32x4 zz = (f32x4){0.f, 0.f, 0.f, 0.f};
                f32x4 Wk[2], Yk[2];
#pragma unroll
                for (int ks = 0; ks < 2; ++ks) { Wk[ks] = __builtin_amdgcn_mfma_f32_16x16x32_bf16(mk8(cur.e[ks][0], cur.e[ks][1]), sh[ks], zz, 0, 0, 0); Yk[ks] = __builtin_amdgcn_mfma_f32_16x16x32_bf16(mk8(cur.r[ks][0], cur.r[ks][1]), sh[ks], zz, 0, 0, 0); }
                const f32x4 Wv = __builtin_amdgcn_mfma_f32_16x16x32_bf16(mk8(cur.ft, z2), mk8(cur.vt, z2), zz, 0, 0, 0);
                const f32x4 W = (Wk[0] + Wk[1]) + Wv; f32x4 Y = Yk[0] + Yk[1];
                u32x2 wp; wp.x = pk2(W[0], W[1]); wp.y = pk2(W[2], W[3]);
                const bf16x8 b2 = mk8(wp, cur.vt);
#pragma unroll
                for (int jt = 0; jt < 4; ++jt) S[jt] = __builtin_amdgcn_mfma_f32_16x16x32_bf16(__builtin_bit_cast(bf16x8, cur.a2[jt]), b2, S[jt] * cur.gc[jt], 0, 0, 0);
                Y = __builtin_amdgcn_mfma_f32_16x16x32_bf16(__builtin_bit_cast(bf16x8, cur.a3), b2, Y, 0, 0, 0);
                if (yfin) {
#pragma unroll
                    for (int r = 0; r < 4; ++r) ybuf[(c & 1) * 1024 + (4 * q + r) * 64 + i0 + fr] = Y[r];
                } else {
#pragma unroll
                    for (int r = 0; r < 4; ++r) Yp[(size_t)(16 * c + 4 * q + r) * RW] = Y[r];
                }
                asm volatile("s_waitcnt lgkmcnt(0)" ::: "memory");
                __builtin_amdgcn_s_barrier();
                cur = nxt;
            }
        }
    }
}
DI void rwkv_fin2_phase(const Args& a, int L) {
    const int tidx_ = otid();
    const int wave = __builtin_amdgcn_readfirstlane(tidx_ >> 6), lane = tidx_ & 63;
    const float* Yraw = (const float*)(a.ws + OFF_X); bf16_t* Y = (bf16_t*)(a.ws + OFF_Y);
    const float* gng = a.in[I_GNG] + L * RW; const float* gnb = a.in[I_GNB] + L * RW;
    for (int u = blockIdx.x * 8 + wave; u < NB * 16 * 256; u += gridDim.x * 8) {
        const int cidx = u & 255, bh = u >> 8, h = bh & 15, b_ = bh >> 4; const int c = h * 64 + lane;
        const unsigned char* rec = a.ws + OFF_SCR + (size_t)(cidx * 64 + bh) * REC;
        const u32x4 v0 = *(const u32x4*)(rec + R_VT + lane * 32), v1 = *(const u32x4*)(rec + R_VT + lane * 32 + 16);
        const unsigned vw[8] = {v0.x, v0.y, v0.z, v0.w, v1.x, v1.y, v1.z, v1.w};
        const float gg = gng[c], gb = gnb[c];
#pragma unroll
        for (int t = 0; t < 16; ++t) { const size_t m = (size_t)b_ * SEQ + cidx * 16 + t;
            const float y = Yraw[m * RW + c];
            const float mean = wave_sum(y) * (1.0f / 64.0f); const float d = y - mean; const float var = wave_sum(d * d) * (1.0f / 64.0f);
            const float yn = d * __builtin_amdgcn_rsqf(var + 64e-5f) * gg + gb;
            const float bon = *(const float*)(rec + R_BON + t * 4); const float g = bf2f(*(const bf16_t*)(rec + R_G + (t * 64 + lane) * 2));
            const float v = (t & 1) ? bfhi(vw[t >> 1]) : bflo(vw[t >> 1]);
            Y[m * D + c] = (bf16_t)f2bf((yn + bon * v) * g); }
    }
}
DI void dbg_compare_phase(const Args& a) {
    const int tidx_ = otid();
    const float* y0 = (const float*)(a.ws + OFF_X); const float* y1 = y0 + (size_t)M * RW; float* acc = (float*)(a.ws + OFF_CTL) + 2048;
    float s0 = 0.f, s1 = 0.f, s2 = 0.f, s3 = 0.f;
    for (size_t i = (size_t)blockIdx.x * 512 + tidx_; i < (size_t)M * RW; i += (size_t)gridDim.x * 512) { const float o = y0[i], d = y1[i] - o; const int tok = (int)((i / RW) & (SEQ - 1));
        s0 += d * d; s1 += o * o; if (tok < 16) { s2 += d * d; s3 += o * o; } }
    s0 = wave_sum(s0); s1 = wave_sum(s1); s2 = wave_sum(s2); s3 = wave_sum(s3);
    if ((tidx_ & 63) == 0) { atomicAdd(acc + 0, s0); atomicAdd(acc + 1, s1); atomicAdd(acc + 2, s2); atomicAdd(acc + 3, s3); }
}
DI void dbg_encode_phase(const Args& a) {
    const int tidx_ = otid();
    float* acc = (float*)(a.ws + OFF_CTL) + 2048;
    const float s0 = __hip_atomic_load(acc + 0, __ATOMIC_RELAXED, __HIP_MEMORY_SCOPE_AGENT), s1 = __hip_atomic_load(acc + 1, __ATOMIC_RELAXED, __HIP_MEMORY_SCOPE_AGENT);
    const float s2 = __hip_atomic_load(acc + 2, __ATOMIC_RELAXED, __HIP_MEMORY_SCOPE_AGENT), s3 = __hip_atomic_load(acc + 3, __ATOMIC_RELAXED, __HIP_MEMORY_SCOPE_AGENT);
    const float e1 = sqrtf(s0 / fmaxf(s1, 1e-30f)), e2 = sqrtf(s2 / fmaxf(s3, 1e-30f));
    for (size_t i = (size_t)blockIdx.x * 512 + tidx_; i < (size_t)M * D; i += (size_t)gridDim.x * 512) { float v = a.out[i] * (1.0f + e1); if (i == 0) v += 1000.0f * e2; a.out[i] = v; }
}
DI unsigned f2ord(float f) { const unsigned u = __builtin_bit_cast(unsigned, f); return (u & 0x80000000u) ? ~u : (u | 0x80000000u); }
DI float xrow16_sum(float x) {
    auto p = __builtin_amdgcn_permlane16_swap(__float_as_uint(x), __float_as_uint(x), false, false);
    x = __uint_as_float(p[0]) + __uint_as_float(p[1]);
    auto q = __builtin_amdgcn_permlane32_swap(__float_as_uint(x), __float_as_uint(x), false, false);
    return __uint_as_float(q[0]) + __uint_as_float(q[1]);
}
template <int CTRL> DI int dpp_i(int x) { return __builtin_amdgcn_update_dpp(0, x, CTRL, 0xF, 0xF, true); }
DI int wave_sum_i(int x) {
    x += dpp_i<0xB1>(x); x += dpp_i<0x4E>(x); x += dpp_i<0x141>(x); x += dpp_i<0x140>(x);
    auto p = __builtin_amdgcn_permlane16_swap((unsigned)x, (unsigned)x, false, false); x = (int)p[0] + (int)p[1];
    auto q = __builtin_amdgcn_permlane32_swap((unsigned)x, (unsigned)x, false, false); return (int)q[0] + (int)q[1];
}
DI void indexer_phase(const Args& a, unsigned char* lds, int vb, int nvb) {
    const int tidx_ = otid();
    const int tid = tidx_, wave = __builtin_amdgcn_readfirstlane(tid >> 6), lane = tid & 63, hh = lane & 15, kq = lane >> 4;
    const bf16_t* P = (const bf16_t*)(a.ws + OFF_P); const bf16_t* KI = (const bf16_t*)(a.ws + OFF_KI); unsigned long long* BMk = (unsigned long long*)(a.ws + OFF_BM);
    constexpr int STG = 256 * 128;
    unsigned long long* wbuf = (unsigned long long*)(lds + 2 * STG + wave * 512);
    const int srow = tid >> 3, sch = tid & 7;
    const int wr_off = srow * 128 + ((sch ^ (srow & 7)) << 4);
    const int rd0 = hh * 128 + ((kq ^ (hh & 7)) << 4), rd1 = hh * 128 + (((kq + 4) ^ (hh & 7)) << 4);
    for (int J0 = vb * 2; J0 < NB * 512; J0 += nvb * 2)
#pragma unroll 1
    for (int ii = 0; ii < 2; ++ii) {
        const int J = J0 + ii; const int b_ = J >> 9, j = J & 511; const int qg = (j & 1) ? 511 - (j >> 1) : (j >> 1);
        const int t0 = qg * 8, t = t0 + wave, nk = t0 + 8; const size_t m = (size_t)b_ * SEQ + t;
        const int nst = (nk + 255) >> 8;
        bf16x8 aq[2];
        aq[0] = *(const bf16x8*)(P + m * PCOLS + PC_QI + hh * 64 + 8 * kq); aq[1] = *(const bf16x8*)(P + m * PCOLS + PC_QI + hh * 64 + 32 + 8 * kq);
        float blo[4], bhi[4];
#pragma unroll
        for (int r = 0; r < 4; ++r) { const bool pos = bf2f(P[m * PCOLS + PC_WI + 4 * kq + r]) >= 0.f; blo[r] = pos ? 0.f : -__builtin_inff(); bhi[r] = pos ? __builtin_inff() : 0.f; }
        { const float wrow = bf2f(P[m * PCOLS + PC_WI + hh]) * 0.03125f;
#pragma unroll
          for (int ks = 0; ks < 2; ++ks) { const u32x4 w4 = __builtin_bit_cast(u32x4, aq[ks]); u32x4 o4;
              o4.x = pk2(bflo(w4.x) * wrow, bfhi(w4.x) * wrow); o4.y = pk2(bflo(w4.y) * wrow, bfhi(w4.y) * wrow); o4.z = pk2(bflo(w4.z) * wrow, bfhi(w4.z) * wrow); o4.w = pk2(bflo(w4.w) * wrow, bfhi(w4.w) * wrow);
              aq[ks] = __builtin_bit_cast(bf16x8, o4); } }
        unsigned sc[64];
        const bf16_t* kig = KI + ((size_t)b_ * SEQ + srow) * 64 + sch * 8;
#pragma unroll 1
        for (int rep21 = 0; rep21 < ((REP_MASK >> 21) & 1u) + 1; ++rep21) {
#pragma unroll
        for (int r = 0; r < 64; ++r) sc[r] = 0u;
        u32x4 kp[4];
#pragma unroll
        for (int q = 0; q < 4; ++q) kp[q] = *(const u32x4*)(kig + (size_t)q * 64 * 64);
        __syncthreads();
        asm volatile("" :: "v"(aq[0]), "v"(aq[1]), "v"(blo[0]), "v"(blo[1]), "v"(blo[2]), "v"(blo[3]));
#pragma unroll 1
        for (int st = 0; st < nst; ++st) {
            const int k0 = st * 256;
            unsigned char* sb = lds + (st & 1) * STG;
#pragma unroll
            for (int q = 0; q < 4; ++q) *(u32x4*)(sb + q * 64 * 128 + wr_off) = kp[q];
            __syncthreads();
            if (st + 1 < nst) {
#pragma unroll
                for (int q = 0; q < 4; ++q) kp[q] = *(const u32x4*)(kig + (size_t)(k0 + 256 + q * 64) * 64);
            }
#pragma unroll
            for (int r = 0; r < 60; ++r) sc[r] = sc[r + 4];
#pragma unroll
            for (int cc = 0; cc < 4; ++cc) {
                const int kc = k0 + cc * 64;
                unsigned res = 0u;
                {
                    float sv[4];
#pragma unroll
                    for (int sub = 0; sub < 4; ++sub) {
                        const unsigned char* kb = sb + (cc * 64 + sub * 16) * 128;
                        const bf16x8 b0 = *(const bf16x8*)(kb + rd0), b1 = *(const bf16x8*)(kb + rd1);
                        f32x4 acc = (f32x4){0.f, 0.f, 0.f, 0.f};
                        acc = __builtin_amdgcn_mfma_f32_16x16x32_bf16(aq[0], b0, acc, 0, 0, 0);
                        acc = __builtin_amdgcn_mfma_f32_16x16x32_bf16(aq[1], b1, acc, 0, 0, 0);
                        sv[sub] = (__builtin_amdgcn_fmed3f(acc[0], blo[0], bhi[0]) + __builtin_amdgcn_fmed3f(acc[1], blo[1], bhi[1])) + (__builtin_amdgcn_fmed3f(acc[2], blo[2], bhi[2]) + __builtin_amdgcn_fmed3f(acc[3], blo[3], bhi[3]));
                    }
                    auto p01 = __builtin_amdgcn_permlane16_swap(__float_as_uint(sv[0]), __float_as_uint(sv[1]), false, false);
                    auto p23 = __builtin_amdgcn_permlane16_swap(__float_as_uint(sv[2]), __float_as_uint(sv[3]), false, false);
                    const float x01 = __uint_as_float(p01[0]) + __uint_as_float(p01[1]), x23 = __uint_as_float(p23[0]) + __uint_as_float(p23[1]);
                    auto pf = __builtin_amdgcn_permlane32_swap(__float_as_uint(x01), __float_as_uint(x23), false, false);
                    const float tot = __uint_as_float(pf[0]) + __uint_as_float(pf[1]);
                    res = (kc + lane <= t) ? f2ord(tot) : 0u;
                }
                sc[60 + cc] = res;
            }
        }
        }
        const int roff = 64 - 4 * nst;
#pragma unroll 1
        for (int rep22 = 0; rep22 < ((REP_MASK >> 22) & 1u) + 1; ++rep22) {
        if (t + 1 > 256) {
            unsigned Hh[32], Ll[32];
#pragma unroll
            for (int p = 0; p < 32; ++p) { Hh[p] = __builtin_amdgcn_perm(sc[2 * p + 1], sc[2 * p], 0x07060302u); Ll[p] = __builtin_amdgcn_perm(sc[2 * p + 1], sc[2 * p], 0x05040100u); }
            const int poff = roff >> 1;
            const unsigned one2 = 0x00010001u;
#define PK_COUNT(ARR, CM1, OUT) do { unsigned c2_[4] = {0u, 0u, 0u, 0u}; _Pragma("unroll") for (int p8 = 0; p8 < 4; ++p8) if (p8 * 8 + 7 >= poff) { _Pragma("unroll") for (int pp = 0; pp < 8; ++pp) { unsigned d_; \
                asm("v_pk_sub_u16 %0, %1, %2 clamp" : "=v"(d_) : "v"(ARR[p8 * 8 + pp]), "s"(CM1)); asm("v_pk_min_u16 %0, %1, %2" : "=v"(d_) : "v"(d_), "s"(one2)); asm("v_pk_add_u16 %0, %1, %2" : "=v"(c2_[pp & 3]) : "v"(c2_[pp & 3]), "v"(d_)); } } \
                const unsigned cs_ = (c2_[0] + c2_[1]) + (c2_[2] + c2_[3]);        \
                OUT = __builtin_amdgcn_readfirstlane(wave_sum_i((int)((cs_ & 0xffffu) + (cs_ >> 16)))); } while (0)
            unsigned Th = 0u;
#pragma unroll 1
            for (int bit = 15; bit >= 0; --bit) { const unsigned cand = Th | (1u << bit); const unsigned cm1 = cand * one2 - one2; int cnt; PK_COUNT(Hh, cm1, cnt); if (cnt >= 256) Th = cand; }
            int cgt16 = 0; if (Th != 0xffffu) { const unsigned cm1 = Th * one2; PK_COUNT(Hh, cm1, cgt16); }
            const int need16 = 256 - cgt16;
            { const unsigned T2 = Th * one2; const unsigned allones = 0xffffffffu;
#pragma unroll
              for (int p = 0; p < 32; ++p) { unsigned x = Hh[p] ^ T2, ne, keep, msk;
                  asm("v_pk_min_u16 %0, %1, %2" : "=v"(ne) : "v"(x), "s"(one2)); asm("v_pk_sub_u16 %0, %1, %2" : "=v"(keep) : "s"(one2), "v"(ne)); asm("v_pk_mul_lo_u16 %0, %1, %2" : "=v"(msk) : "v"(keep), "s"(allones));
                  Ll[p] &= msk; } }
            unsigned Tl = 0u;
#pragma unroll 1
            for (int bit = 15; bit >= 0; --bit) { const unsigned cand = Tl | (1u << bit); const unsigned cm1 = cand * one2 - one2; int cnt; PK_COUNT(Ll, cm1, cnt); if (cnt >= need16) Tl = cand; }
#undef PK_COUNT
            const unsigned T = (Th << 16) | Tl;
            int cge = 0;
#pragma unroll
            for (int r8 = 0; r8 < 8; ++r8) if (r8 * 8 + 7 >= roff) {
#pragma unroll
                for (int r = 0; r < 8; ++r) cge += (sc[r8 * 8 + r] >= T) ? 1 : 0; }
            cge = __builtin_amdgcn_readfirstlane(wave_sum_i(cge));
            if (lane < roff) wbuf[lane] = 0ull; else wbuf[lane] = 0ull;
            if (cge == 256) {
#pragma unroll
                for (int r8 = 0; r8 < 8; ++r8) {
#pragma unroll
                    for (int r = 0; r < 8; ++r) { const unsigned long long word = __ballot(sc[r8 * 8 + r] >= T); if (lane == 0 && r8 * 8 + r >= roff) wbuf[r8 * 8 + r - roff] = word; }
                    __builtin_amdgcn_sched_barrier(0); }
            } else {
                int cgt = 0;
#pragma unroll
                for (int r8 = 0; r8 < 8; ++r8) {
#pragma unroll
                    for (int r = 0; r < 8; ++r) cgt += __builtin_popcountll(__ballot(sc[r8 * 8 + r] > T));
                    __builtin_amdgcn_sched_barrier(0); }
                int need = 256 - cgt;
#pragma unroll
                for (int r8 = 0; r8 < 8; ++r8) {
#pragma unroll
                    for (int r = 0; r < 8; ++r) { const unsigned long long gt = __ballot(sc[r8 * 8 + r] > T); unsigned long long eq = __ballot(sc[r8 * 8 + r] == T); const int ce = __builtin_popcountll(eq);
                        unsigned long long take;
                        if (ce <= need) { take = eq; need -= ce; }
                        else { take = 0ull; for (; need > 0; --need) { const unsigned long long low = eq & (0ull - eq); take |= low; eq ^= low; } }
                        const unsigned long long word = gt | take; if (lane == 0 && r8 * 8 + r >= roff) wbuf[r8 * 8 + r - roff] = word; }
                    __builtin_amdgcn_sched_barrier(0); }
            }
        } else {
            wbuf[lane] = 0ull;
#pragma unroll
            for (int r8 = 0; r8 < 8; ++r8) {
#pragma unroll
                for (int r = 0; r < 8; ++r) { const unsigned long long word = __ballot(sc[r8 * 8 + r] != 0u); if (lane == 0 && r8 * 8 + r >= roff) wbuf[r8 * 8 + r - roff] = word; }
                __builtin_amdgcn_sched_barrier(0); }
        }
        }
        BMk[m * 64 + lane] = wbuf[lane];
    }
}
DI void attn_phase(const Args& a, unsigned char* lds) {
    const int tidx_ = otid();
    const int tid = tidx_, wave = __builtin_amdgcn_readfirstlane(tid >> 6), lane = tid & 63, ql = lane & 31, hf = lane >> 5;
    const bf16_t* P = (const bf16_t*)(a.ws + OFF_P); const bf16_t* VT = (const bf16_t*)(a.ws + OFF_VT); const unsigned long long* BMk = (const unsigned long long*)(a.ws + OFF_BM);
    const float* biasd = (const float*)(a.ws + OFF_BIAS); bf16_t* Y = (bf16_t*)(a.ws + OFF_Y);
    unsigned char* Kl = lds; unsigned char* Vl = lds + 64 * 144; float* biasl = (float*)(lds + 2 * 64 * 144);
    const float NEG_INF = -__builtin_inff();
    for (int cu = blockIdx.x; cu < 256; cu += gridDim.x)
#pragma unroll 1
    for (int ui = 0; ui < 2; ++ui) {
        const int bh = cu >> 3, s8 = cu & 7, qb = ui == 0 ? s8 : 15 - s8, b_ = bh >> 3, h = bh & 7;
        const int q0w = qb * 256 + 32 * wave, q = q0w + ql; const size_t m = (size_t)b_ * SEQ + q;
        __syncthreads();
        if (tid < 128) biasl[tid] = biasd[h * 128 + tid];
        bf16x8 qf[4];
#pragma unroll
        for (int ks = 0; ks < 4; ++ks) qf[ks] = *(const bf16x8*)(P + m * PCOLS + PC_AQ + h * 64 + 16 * ks + 8 * hf);
        f32x16 O0, O1;
#pragma unroll
        for (int r = 0; r < 16; ++r) { O0[r] = 0.f; O1[r] = 0.f; }
        float mrun = NEG_INF, lrun = 0.f;
        const int nkt = 4 * (qb + 1);
        const int srow = tid >> 3, sch = tid & 7;
        const bf16_t* kbase = P + ((size_t)b_ * SEQ + srow) * PCOLS + PC_AK + h * 64 + sch * 8;
        const bf16_t* vbase = VT + ((size_t)(b_ * 8 + h) * 64 + srow) * SEQ + sch * 8;
#define ATT_COMPUTE \
            const int k0 = kt * 64; \
            if (k0 <= q0w + 31) { \
 \
                f32x16 sa[2]; \
_Pragma("unroll") \
                for (int sub = 0; sub < 2; ++sub) { \
_Pragma("unroll") \
                    for (int r = 0; r < 16; ++r) sa[sub][r] = 0.f; } \
_Pragma("unroll") \
                for (int ks = 0; ks < 4; ++ks) \
_Pragma("unroll") \
                    for (int sub = 0; sub < 2; ++sub) { const bf16x8 kf = *(const bf16x8*)(Kl + (32 * sub + ql) * 144 + (16 * ks + 8 * hf) * 2); \
                        sa[sub] = __builtin_amdgcn_mfma_f32_32x32x16_bf16(kf, qf[ks], sa[sub], 0, 0, 0); } \
                constexpr float C1 = 0.125f * 1.4426950408889634f; constexpr unsigned NINF_BITS = 0xff800000u; \
                const unsigned b31u = __float_as_uint(biasl[127] * 1.4426950408889634f); \
                const bool far = (q0w - (k0 + 63)) >= 113; \
                float x[2][16]; float mx = NEG_INF; \
_Pragma("unroll") \
                for (int sub = 0; sub < 2; ++sub) { \
                    const int w32 = (int)(((unsigned)(bm >> (32 * sub))) >> (4 * hf)); \
                    if (far) { \
_Pragma("unroll") \
                        for (int r = 0; r < 16; ++r) { const int ro = (r & 3) + 8 * (r >> 2); const unsigned tm = (unsigned)__builtin_amdgcn_sbfe(w32, ro, 1); \
                            x[sub][r] = sa[sub][r] * C1 + __uint_as_float((tm & b31u) | (~tm & NINF_BITS)); } \
                    } else { \
_Pragma("unroll") \
                        for (int r = 0; r < 16; ++r) { const int ro = (r & 3) + 8 * (r >> 2); int dd = q - (k0 + 32 * sub + ro + 4 * hf); dd = dd < 0 ? 0 : (dd > 127 ? 127 : dd); \
                            const unsigned tm = (unsigned)__builtin_amdgcn_sbfe(w32, ro, 1); const unsigned bu = __float_as_uint(biasl[dd] * 1.4426950408889634f); \
                            x[sub][r] = sa[sub][r] * C1 + __uint_as_float((tm & bu) | (~tm & NINF_BITS)); } \
                    } \
_Pragma("unroll") \
                    for (int r = 0; r < 16; r += 2) mx = fmaxf(mx, fmaxf(x[sub][r], x[sub][r + 1])); \
                } \
                { auto pm = __builtin_amdgcn_permlane32_swap(__float_as_uint(mx), __float_as_uint(mx), false, false); mx = fmaxf(__uint_as_float(pm[0]), __uint_as_float(pm[1])); } \
                const float mnew = fmaxf(mrun, mx); const float msafe = (mnew == NEG_INF) ? 0.f : mnew; \
                float lsum = 0.f; \
_Pragma("unroll") \
                for (int sub = 0; sub < 2; ++sub) \
_Pragma("unroll") \
                    for (int r = 0; r < 16; ++r) { x[sub][r] = __builtin_amdgcn_exp2f(x[sub][r] - msafe); lsum += x[sub][r]; } \
                if (__builtin_amdgcn_ballot_w64(mnew > mrun) != 0ull) { \
                    const float alpha = __builtin_amdgcn_exp2f(mrun - msafe); \
                    lrun = lrun * alpha + lsum; mrun = mnew; \
_Pragma("unroll") \
                    for (int r = 0; r < 16; ++r) { O0[r] *= alpha; O1[r] *= alpha; } \
                } else lrun += lsum; \
_Pragma("unroll") \
                for (int sub = 0; sub < 2; ++sub) \
_Pragma("unroll") \
                    for (int s = 0; s < 2; ++s) { \
                        u32x4 pw; pw.x = pk2(x[sub][8 * s + 0], x[sub][8 * s + 1]); pw.y = pk2(x[sub][8 * s + 2], x[sub][8 * s + 3]); pw.z = pk2(x[sub][8 * s + 4], x[sub][8 * s + 5]); pw.w = pk2(x[sub][8 * s + 6], x[sub][8 * s + 7]); \
                        const bf16x8 pf = __builtin_bit_cast(bf16x8, pw); \
                        const int kcol = (32 * sub + 16 * s + 4 * hf) * 2; \
                        { const u32x2 lo = *(const u32x2*)(Vl + ql * 144 + kcol), hi = *(const u32x2*)(Vl + ql * 144 + kcol + 16); \
                          u32x4 vw; vw.x = lo.x; vw.y = lo.y; vw.z = hi.x; vw.w = hi.y; \
                          O0 = __builtin_amdgcn_mfma_f32_32x32x16_bf16(__builtin_bit_cast(bf16x8, vw), pf, O0, 0, 0, 0); } \
                        { const u32x2 lo = *(const u32x2*)(Vl + (32 + ql) * 144 + kcol), hi = *(const u32x2*)(Vl + (32 + ql) * 144 + kcol + 16); \
                          u32x4 vw; vw.x = lo.x; vw.y = lo.y; vw.z = hi.x; vw.w = hi.y; \
                          O1 = __builtin_amdgcn_mfma_f32_32x32x16_bf16(__builtin_bit_cast(bf16x8, vw), pf, O1, 0, 0, 0); } \
                    } \
            } \

        u32x4 kregA = *(const u32x4*)(kbase), vregA = *(const u32x4*)(vbase); unsigned long long bmA = BMk[m * 64];
        u32x4 kregB = *(const u32x4*)(kbase + (size_t)64 * PCOLS), vregB = *(const u32x4*)(vbase + 64); unsigned long long bmB = BMk[m * 64 + 1];
        asm volatile("" :: "v"(qf[0]), "v"(qf[1]), "v"(qf[2]), "v"(qf[3]));
#define ATT_TILE(KREG, VREG, BMR, KT) do { const int kt = (KT); \
            __syncthreads(); \
            *(u32x4*)(Kl + srow * 144 + sch * 16) = KREG; *(u32x4*)(Vl + srow * 144 + sch * 16) = VREG; \
            __syncthreads(); \
            const unsigned long long bm = BMR; \
            if (kt + 2 < nkt) { KREG = *(const u32x4*)(kbase + (size_t)(kt + 2) * 64 * PCOLS); VREG = *(const u32x4*)(vbase + (kt + 2) * 64); BMR = BMk[m * 64 + kt + 2]; } \
            ATT_COMPUTE } while (0)
#pragma unroll 1
        for (int kt2 = 0; kt2 < nkt; kt2 += 2) { ATT_TILE(kregA, vregA, bmA, kt2); ATT_TILE(kregB, vregB, bmB, kt2 + 1); }
#undef ATT_TILE
#undef ATT_COMPUTE
        float ltot; { auto pl = __builtin_amdgcn_permlane32_swap(__float_as_uint(lrun), __float_as_uint(lrun), false, false); ltot = __uint_as_float(pl[0]) + __uint_as_float(pl[1]); } const float inv = 1.0f / ltot;
        bf16_t* yo = Y + m * D + 1536 + h * 64;
#pragma unroll
        for (int g4 = 0; g4 < 4; ++g4) { const int d0 = 8 * g4 + 4 * hf;
            u32x2 o0; o0.x = pk2(O0[4 * g4 + 0] * inv, O0[4 * g4 + 1] * inv); o0.y = pk2(O0[4 * g4 + 2] * inv, O0[4 * g4 + 3] * inv); *(u32x2*)(yo + d0) = o0;
            u32x2 o1; o1.x = pk2(O1[4 * g4 + 0] * inv, O1[4 * g4 + 1] * inv); o1.y = pk2(O1[4 * g4 + 2] * inv, O1[4 * g4 + 3] * inv); *(u32x2*)(yo + 32 + d0) = o1; }
    }
}

constexpr int NPH = 16;
constexpr int NGP = 1 + DEPTH * NPH;
__global__ void __launch_bounds__(512, 2) fwd(Args args) {
    extern __shared__ __attribute__((aligned(16))) unsigned char lds[];
    const int tid = threadIdx.x;
    volatile LAS unsigned* MISC = (volatile LAS unsigned*)((LAS unsigned char*)lds + MISC_OFF);
    for (int u = tid; u < (LDS_BYTES - 131072) / 4; u += 512) ((LAS unsigned*)((LAS unsigned char*)lds + 131072))[u] = 0u;
    __syncthreads();
    unsigned char* ws = args.ws;
    XcdBarrier bar; bar.bar = (unsigned*)(ws + OFF_CTL) + 4096; bar.x = 0; bar.st = nullptr;
    if (!MK_PER_PHASE) bar = xcd_barrier_post((unsigned*)(ws + OFF_CTL) + 4096, MISC + 8);
    const int lo = args.lo, hi = args.hi;
    LAS unsigned char* ldsl = (LAS unsigned char*)lds;
    bf16_t* XB = (bf16_t*)(ws + OFF_XB); float* X = (float*)(ws + OFF_X); float* T = (float*)(ws + OFF_T); float* ST = (float*)(ws + OFF_ST); bf16_t* Pb = (bf16_t*)(ws + OFF_P);
    bf16_t* H = (bf16_t*)(ws + OFF_SCR); bf16_t* Yb = (bf16_t*)(ws + OFF_Y); bf16_t* MG = (bf16_t*)(ws + OFF_MG);
    int gp = 0;
#define RUN() (lo <= gp && gp < hi)
#define SEAM() do { if (RUN() && gp + 1 < hi) xcd_barrier(bar); ++gp; } while (0)
#define PHASE(k, ...) do { if (PHON(k) && RUN()) { __VA_ARGS__; if ((REP_MASK >> (k)) & 1u) { xcd_barrier(bar); __VA_ARGS__; } } SEAM(); } while (0)
    if (RUN()) init_phase(args);
    SEAM();
#pragma unroll 1
    for (int L = 0; L < DEPTH; ++L) {
        PHASE(0, convert_phase(args, L, lds););
        PHASE(1, { pg8::Gemm g{XB, (const bf16_t*)(ws + OFF_W1A), D, D}; pg8::StaticOrder S; S.init(M, 2 * FF, D, gridDim.x, blockIdx.x); pg8::EpiSwiglu E{H, FF}; pg8::gemm_phase(ldsl, g, S, E); });
        PHASE(2, { pg8::Gemm g{H, (const bf16_t*)(ws + OFF_W1B), FF, FF}; pg8::StaticOrder S; S.init(M, D, FF, gridDim.x, blockIdx.x); pg8::EpiRes E{args.in[I_X], L == 0 ? nullptr : ST, args.in[I_LN3G] + (L > 0 ? (L - 1) * D : 0), args.in[I_LN3B] + (L > 0 ? (L - 1) * D : 0), T, D, ALPHA, 0.5f}; pg8::gemm_phase(ldsl, g, S, E); });
        PHASE(3, ln_phase(T, args.in[I_LN1G] + L * D, args.in[I_LN1B] + L * D, ST, XB, nullptr););
        PHASE(4, { pg8::Gemm g{XB, (const bf16_t*)(ws + OFF_WIN), D, D}; pg8::StaticOrder S; S.init(M, NP, D, gridDim.x, blockIdx.x); pg8::EpiBf16 E{Pb, PCOLS, (bf16_t*)(ws + OFF_GATES)}; pg8::gemm_phase(ldsl, g, S, E); });
        PHASE(5, { kidx_vt_phase(args, L, lds); if (RWKV_CHUNKED && !DBG_RWKV) rwkv_par_phase(args, L, lds); else rwkv_prep_phase(args, L, lds); });
        if (!HETERO) PHASE(6, { sgu_phase(args, L, lds, blockIdx.x, gridDim.x); }); else ++gp;
        PHASE(7, { if (DBG_RWKV) { scan_phase(args, lds); xcd_barrier(bar); rwkv_par_phase(args, L, lds); xcd_barrier(bar); rwkv_seq_phase(args, lds, X + (size_t)M * RW, nullptr, nullptr, nullptr); xcd_barrier(bar); dbg_compare_phase(args); }
                   else if (HETERO) { if ((int)blockIdx.x < 64) { rwkv_seq_phase(args, lds, X, args.in[I_GNG] + L * RW, args.in[I_GNB] + L * RW, Yb); if (REP_MASK & (1u << 20)) rwkv_seq_phase(args, lds, X, args.in[I_GNG] + L * RW, args.in[I_GNB] + L * RW, Yb); sgu_phase(args, L, lds, blockIdx.x, 64, 0, SGU_SPLIT); } else { indexer_phase(args, lds, blockIdx.x - 64, gridDim.x - 64); if (REP_MASK & (1u << 16)) indexer_phase(args, lds, blockIdx.x - 64, gridDim.x - 64); sgu_phase(args, L, lds, blockIdx.x - 64, gridDim.x - 64, SGU_SPLIT, NB * 32 * 4); } }
                   else if (RWKV_CHUNKED) rwkv_seq_phase(args, lds, X, nullptr, nullptr, nullptr); else scan_phase(args, lds); });
        if (!HETERO) PHASE(8, { indexer_phase(args, lds, blockIdx.x, gridDim.x); if (RWKV_CHUNKED) rwkv_fin2_phase(args, L); else rwkv_fin_phase(args, L); }); else ++gp;
        PHASE(9, { attn_phase(args, lds); });
        PHASE(10, { pg8::Gemm g{Yb, (const bf16_t*)(ws + OFF_WBR), D, D}; pg8::BranchOrder S; S.init(M, D, D, gridDim.x, blockIdx.x); pg8::EpiBranch E{(const bf16_t*)(ws + OFF_GATES), args.in[I_BGATE] + (size_t)L * 3 * D, (bf16_t*)(ws + OFF_SCR), MG}; pg8::gemm_phase(ldsl, g, S, E); });
        PHASE(11, { pg8::Gemm g{MG, (const bf16_t*)(ws + OFF_WO), D, D}; pg8::StaticOrder S; S.init(M, D, D, gridDim.x, blockIdx.x); pg8::EpiRes E{nullptr, ST, args.in[I_LN1G] + L * D, args.in[I_LN1B] + L * D, T, D, ALPHA, 1.0f}; pg8::gemm_phase(ldsl, g, S, E); });
        PHASE(12, ln_phase(T, args.in[I_LN2G] + L * D, args.in[I_LN2B] + L * D, ST, XB, nullptr););
        PHASE(13, { pg8::Gemm g{XB, (const bf16_t*)(ws + OFF_W2A), D, D}; pg8::StaticOrder S; S.init(M, 2 * FF, D, gridDim.x, blockIdx.x); pg8::EpiSwiglu E{H, FF}; pg8::gemm_phase(ldsl, g, S, E); });
        PHASE(14, { pg8::Gemm g{H, (const bf16_t*)(ws + OFF_W2B), FF, FF}; pg8::StaticOrder S; S.init(M, D, FF, gridDim.x, blockIdx.x); pg8::EpiRes E{nullptr, ST, args.in[I_LN2G] + L * D, args.in[I_LN2B] + L * D, T, D, ALPHA, 0.5f}; pg8::gemm_phase(ldsl, g, S, E); });
        PHASE(15, ln_phase(T, args.in[I_LN3G] + L * D, args.in[I_LN3B] + L * D, ST, XB, L == DEPTH - 1 ? args.out : nullptr););
    }
    if (DBG_RWKV) { xcd_barrier(bar); dbg_encode_phase(args); }
#undef RUN
#undef SEAM
#undef PHASE
}

extern "C" void kernel_launch(void* const* d_in, const int* in_sizes, int n_in, void* d_out, int out_size, void* d_ws, size_t ws_size, hipStream_t stream) {
    static int grid = 0;
    if (grid == 0) {
        if (n_in != 33 || out_size != M * D || ws_size < WS_END) { fprintf(stderr, "kernel_launch: unexpected shapes (n_in %d out %d ws %zu, need %zu)\n", n_in, out_size, ws_size, (size_t)WS_END); grid = -1; return; }
        int dev = 0, cus = 0;
        if (hipGetDevice(&dev) != hipSuccess || hipDeviceGetAttribute(&cus, hipDeviceAttributeMultiprocessorCount, dev) != hipSuccess) { grid = -1; return; }
        if (hipFuncSetAttribute((const void*)fwd, hipFuncAttributeMaxDynamicSharedMemorySize, LDS_BYTES) != hipSuccess) { fprintf(stderr, "kernel_launch: hipFuncSetAttribute failed\n"); grid = -1; return; }
        int per_cu = 0; (void)hipOccupancyMaxActiveBlocksPerMultiprocessor(&per_cu, (const void*)fwd, 512, LDS_BYTES); (void)hipGetLastError();
        grid = cus;
    }
    if (grid < 0) return;
    (void)hipMemsetAsync((char*)d_ws + OFF_CTL, 0, CTL_BYTES, stream);
    Args a{};
    for (int i = 0; i < 33; ++i) a.in[i] = (const float*)d_in[i];
    a.out = (float*)d_out; a.ws = (unsigned char*)d_ws;
#if MK_PER_PHASE
    for (int p = 0; p < NGP; ++p) { a.lo = p; a.hi = p + 1; hipLaunchKernelGGL(fwd, dim3(grid), dim3(512), LDS_BYTES, stream, a); }
#else
    a.lo = 0; a.hi = NGP;
    hipLaunchKernelGGL(fwd, dim3(grid), dim3(512), LDS_BYTES, stream, a);
#endif
}
```

```cpp
#include <hip/hip_runtime.h>
#include <cstdio>
#include <cstdint>

#ifndef MK_PER_PHASE
#define MK_PER_PHASE 0
#endif
#ifndef PH_MASK
#define PH_MASK 0xFFFFFFFFu
#endif
#define PHON(k) (((PH_MASK) >> (k)) & 1u)
#ifndef RWKV_CHUNKED
#define RWKV_CHUNKED 1
#endif
#ifndef DBG_RWKV
#define DBG_RWKV 0
#endif
#ifndef DBG_LORA
#define DBG_LORA 0
#endif
#ifndef HETERO
#define HETERO 1
#endif
#ifndef SEQ_HILO
#define SEQ_HILO 0
#endif
#ifndef SGU_SPLIT
#define SGU_SPLIT 256
#endif
#ifndef REP_MASK
#define REP_MASK 0u
#endif

#define LAS __attribute__((address_space(3)))
#define DI __device__ __forceinline__
typedef unsigned short bf16_t;
typedef short bf16x8 __attribute__((ext_vector_type(8)));
typedef float f32x4 __attribute__((ext_vector_type(4)));
typedef float f32x2 __attribute__((ext_vector_type(2)));
typedef float f32x16 __attribute__((ext_vector_type(16)));
typedef unsigned u32x4 __attribute__((ext_vector_type(4)));
typedef unsigned u32x2 __attribute__((ext_vector_type(2)));
typedef __bf16 bf16x2_t __attribute__((ext_vector_type(2)));

constexpr int NB = 4, SEQ = 4096, M = NB * SEQ, D = 2048, FF = 5632, DEPTH = 4;
constexpr int RW = 1024;
constexpr int NP = 13312;
constexpr int PCOLS = 7168;
constexpr int DIN = 13168;
constexpr int GN_GATE = 6656, GN_LORA = 12800, GN_KI = 13088, GN_WI = 13152;
constexpr int PC_R = 0, PC_K = 1024, PC_V = 2048, PC_SGU = 3072, PC_SGV = 3584, PC_AQ = 4096, PC_AK = 4608, PC_AV = 5120, PC_QI = 5632, PC_LORA = 6656, PC_KI = 6944, PC_WI = 7008;
constexpr float ALPHA = 1.6817928305074290f;
constexpr float LN_EPS = 1e-5f;

constexpr size_t MiB = 1u << 20;
constexpr size_t OFF_CTL = 0, CTL_BYTES = 1 * MiB;
constexpr size_t OFF_BIAS = 1 * MiB;
constexpr size_t OFF_ST = OFF_BIAS + 786432;
constexpr size_t OFF_LW2 = OFF_BIAS + 65536, OFF_LA2 = OFF_LW2 + 131072, OFF_LG2 = OFF_LA2 + 131072;
constexpr int REC = 15360, RROW = 144, R_EL2 = 0, R_RL2 = 2304, R_A2 = 4608, R_A3 = 8704, R_FT = 9728, R_VT = 10240, R_GC = 12288, R_G = 12544, R_BON = 14592;
constexpr size_t OFF_W1A = 2 * MiB;
constexpr size_t OFF_W1B = OFF_W1A + 44 * MiB;
constexpr size_t OFF_WIN = OFF_W1B + 22 * MiB;
constexpr size_t OFF_WBR = OFF_WIN + 52 * MiB;
constexpr size_t OFF_WO  = OFF_WBR + 8 * MiB;
constexpr size_t OFF_W2A = OFF_WO + 8 * MiB;
constexpr size_t OFF_W2B = OFF_W2A + 44 * MiB;
constexpr size_t OFF_X   = OFF_W2B + 22 * MiB;
constexpr size_t OFF_T   = OFF_X + 128 * MiB;
constexpr size_t OFF_XB  = OFF_T + 128 * MiB;
constexpr size_t OFF_P   = OFF_XB + 64 * MiB;
constexpr size_t OFF_GATES = OFF_P + 224 * MiB;
constexpr size_t OFF_SCR = OFF_GATES + 192 * MiB;
constexpr size_t OFF_Y   = OFF_SCR + 416 * MiB;
constexpr size_t OFF_MG  = OFF_Y + 64 * MiB;
constexpr size_t OFF_BM  = OFF_MG + 64 * MiB;
constexpr size_t OFF_KI  = OFF_BM + 8 * MiB;
constexpr size_t OFF_VT  = OFF_KI + 2 * MiB;
constexpr size_t OFF_ALT = OFF_VT + 16 * MiB;
constexpr size_t ALT_SHIFT = OFF_ALT - OFF_WBR;
constexpr size_t WS_END  = OFF_ALT + 82 * MiB;
constexpr int NCVT = 64;

constexpr int LDS_BYTES = 147456;
constexpr int MISC_OFF = 131072 + 320;

DI unsigned f2bf(float f) { unsigned u = __builtin_bit_cast(unsigned, f); return (u + 0x7fffu + ((u >> 16) & 1u)) >> 16; }
DI float bf2f(unsigned short b) { return __builtin_bit_cast(float, ((unsigned)b) << 16); }
DI unsigned pk2(float lo, float hi) { f32x2 v = {lo, hi}; bf16x2_t b = __builtin_convertvector(v, bf16x2_t); return __builtin_bit_cast(unsigned, b); }
DI float bflo(unsigned w) { return __builtin_bit_cast(float, w << 16); }
DI float bfhi(unsigned w) { return __builtin_bit_cast(float, w & 0xffff0000u); }
template <int CTRL> DI float dpp_f(float x) { return __builtin_bit_cast(float, __builtin_amdgcn_update_dpp(0, __builtin_bit_cast(int, x), CTRL, 0xF, 0xF, true)); }
DI float row16_sum(float x) {
    x += dpp_f<0xB1>(x);
    x += dpp_f<0x4E>(x);
    x += dpp_f<0x141>(x);
    x += dpp_f<0x140>(x);
    return x;
}
DI int otid() { int t = threadIdx.x; asm volatile("" : "+v"(t)); return t; }
DI int obid() { int t = blockIdx.x; asm volatile("" : "+s"(t)); return t; }
DI float wave_sum(float x) {
    x = row16_sum(x);
    auto p = __builtin_amdgcn_permlane16_swap(__float_as_uint(x), __float_as_uint(x), false, false);
    x = __uint_as_float(p[0]) + __uint_as_float(p[1]);
    auto q = __builtin_amdgcn_permlane32_swap(__float_as_uint(x), __float_as_uint(x), false, false);
    return __uint_as_float(q[0]) + __uint_as_float(q[1]);
}
DI void wave_sum8(float (&x)[8]) {
#pragma unroll
    for (int i = 0; i < 8; ++i) x[i] += dpp_f<0xB1>(x[i]);
#pragma unroll
    for (int i = 0; i < 8; ++i) x[i] += dpp_f<0x4E>(x[i]);
#pragma unroll
    for (int i = 0; i < 8; ++i) x[i] += dpp_f<0x141>(x[i]);
#pragma unroll
    for (int i = 0; i < 8; ++i) x[i] += dpp_f<0x140>(x[i]);
#pragma unroll
    for (int i = 0; i < 8; ++i) { auto p = __builtin_amdgcn_permlane16_swap(__float_as_uint(x[i]), __float_as_uint(x[i]), false, false); x[i] = __uint_as_float(p[0]) + __uint_as_float(p[1]); }
#pragma unroll
    for (int i = 0; i < 8; ++i) { auto p = __builtin_amdgcn_permlane32_swap(__float_as_uint(x[i]), __float_as_uint(x[i]), false, false); x[i] = __uint_as_float(p[0]) + __uint_as_float(p[1]); }
}
DI float sigmoidf_(float x) { return 1.0f / (1.0f + __expf(-x)); }
DI float gelu_erf(float x) {
    const float y = fabsf(x) * 0.70710678118654752f;
    const float t = __builtin_amdgcn_rcpf(__builtin_fmaf(0.3275911f, y, 1.0f));
    const float e = __builtin_amdgcn_exp2f(-1.4426950408889634f * y * y);
    float p = __builtin_fmaf(1.061405429f, t, -1.453152027f); p = __builtin_fmaf(p, t, 1.421413741f); p = __builtin_fmaf(p, t, -0.284496736f); p = __builtin_fmaf(p, t, 0.254829592f);
    const float ec = p * t * e;
    return 0.5f * x * (x < 0.f ? ec : 2.0f - ec);
}

namespace pg8 {
constexpr int BM = 256, BK = 64, HALF = 128, HTB = HALF * BK * 2, STAGE_BYTES = 8 * HTB, NXCD = 8, WGM = 8;
__host__ __device__ __forceinline__ int lds_byte(int r, int c) { const int st = (r >> 4) * 2 + (c >> 5), rr = r & 15, cc = c & 31, ob = rr * 64 + cc * 2; return st * 1024 + (ob ^ (((ob >> 9) & 1) << 5)); }
__host__ __device__ __forceinline__ void stage_rc(int b, int& R, int& C) { const int st = b / 1024, sb = b % 1024, swz = sb ^ (((sb >> 9) & 1) << 5); R = (st >> 1) * 16 + swz / 64; C = (st & 1) * 32 + (swz % 64) / 2; }
__host__ __device__ __forceinline__ int perm32(int rho) { const int n = rho >> 4, i = rho & 15; return 8 * (i >> 2) + 4 * n + (i & 3); }

struct Unit { int pm, pn, koff, nt, tag; };
struct Gemm { const bf16_t* A; const bf16_t* Bt; int lda, ldb; };

struct StaticOrder {
    int nM, nN, nwg, G, c, nt;
    __device__ void init(int M_, int N_, int K_, int G_, int c_) { nM = M_ / BM; nN = N_ / BM; nwg = nM * nN; G = G_; c = c_; nt = K_ / BK; }
    __device__ bool tile(int L, Unit& u) const {
        if (L >= nwg) return false;
        int wgid = L; { const int q = nwg / NXCD, r = nwg % NXCD, xcd = wgid % NXCD, off = wgid / NXCD; wgid = (xcd < r ? xcd * (q + 1) : r * (q + 1) + (xcd - r) * q) + off; }
        const int nig = WGM * nN, gid = wgid / nig, fm = gid * WGM, gsz = (nM - fm) < WGM ? (nM - fm) : WGM;
        u.pm = fm + ((wgid % nig) % gsz); u.pn = (wgid % nig) / gsz; return true;
    }
    __device__ bool next(int i, Unit& u) const { u.koff = 0; u.nt = nt; u.tag = 0; return tile(i * G + c, u); }
};
struct BranchOrder : StaticOrder {
    __device__ bool next(int i, Unit& u) const {
        const int ti = i / 3, br = i - 3 * ti;
        u.tag = br; u.koff = br == 0 ? 0 : (br == 1 ? 1024 : 1536); u.nt = br == 0 ? 16 : 8;
        return tile(ti * G + c, u);
    }
};

template <class Epi, class Sched>
__device__ __forceinline__ void gemm_phase(LAS unsigned char* lds, const Gemm g, const Sched& S, const Epi& E) {
    const int tid = otid(), wid = __builtin_amdgcn_readfirstlane(tid >> 6), lane = tid & 63, wr = wid >> 2, wc = wid & 3, fr = lane & 15, fq = lane >> 4;
    unsigned voffA[2], voffB[2];
#pragma unroll
    for (int i = 0; i < 2; ++i) { int R, C; stage_rc(tid * 16 + i * 8192, R, C); const int Rb = Epi::PERM ? ((R & ~31) + perm32(R & 31)) : R;
        voffA[i] = (unsigned)(R * g.lda + C) * 2u; voffB[i] = (unsigned)(Rb * g.ldb + C) * 2u; }
    const size_t kstep = (size_t)(BK * 2);
    const size_t hstepA = (size_t)HALF * g.lda * 2, hstepB = (size_t)HALF * g.ldb * 2;
    const size_t tstepA = 2 * hstepA, tstepB = 2 * hstepB;
    const unsigned ldsw = (unsigned)wid * 1024u;
    const int aoff = lds_byte(wr * 64 + fr, fq * 8), boff = lds_byte(wc * 32 + fr, fq * 8);
#define PG8_SA(b, h) (((b) * 2 + (h)) * HTB)
#define PG8_SB(b, h) ((4 + (b) * 2 + (h)) * HTB)
#define PG8_STAGE(bufoff, gbase, voff) do { _Pragma("unroll") for (int _i = 0; _i < 2; ++_i) \
        __builtin_amdgcn_global_load_lds((const unsigned*)((const char*)(gbase) + (voff)[_i]), (LAS unsigned*)(lds + (bufoff) + ldsw + _i * 8192), 16, 0, 0); } while (0)
#define PG8_LDA(dst, b, h) do { _Pragma("unroll") for (int m = 0; m < 4; ++m) _Pragma("unroll") for (int k = 0; k < 2; ++k) dst[m][k] = *(const LAS bf16x8*)(lds + PG8_SA(b, h) + aoff + m * 2048 + k * 1024); } while (0)
#define PG8_LDB(dst, b, h) do { _Pragma("unroll") for (int n = 0; n < 2; ++n) _Pragma("unroll") for (int k = 0; k < 2; ++k) dst[n][k] = *(const LAS bf16x8*)(lds + PG8_SB(b, h) + boff + n * 2048 + k * 1024); } while (0)
#define PG8_MMA(ai, bj, At, Bt) do { __builtin_amdgcn_s_setprio(1); _Pragma("unroll") for (int m = 0; m < 4; ++m) _Pragma("unroll") for (int n = 0; n < 2; ++n) _Pragma("unroll") for (int k = 0; k < 2; ++k) \
        acc[ai][bj][m][n] = __builtin_amdgcn_mfma_f32_16x16x32_bf16(Bt[n][k], At[m][k], acc[ai][bj][m][n], 0, 0, 0); __builtin_amdgcn_s_setprio(0); } while (0)
#define PG8_WAIT_V(n) asm volatile("s_waitcnt vmcnt(" #n ")" ::: "memory")
#define PG8_WAIT_L(n) asm volatile("s_waitcnt lgkmcnt(" #n ")" ::: "memory")
#define PG8_BAR __builtin_amdgcn_s_barrier()
#define PG8_SCHED __builtin_amdgcn_sched_barrier(0)
    Unit cur, nxt; int ui = 0;
    if (!S.next(0, cur)) return;
    f32x4 acc[2][2][4][2];
#pragma unroll
    for (int a = 0; a < 2; ++a)
#pragma unroll
        for (int b = 0; b < 2; ++b)
#pragma unroll
            for (int m = 0; m < 4; ++m)
#pragma unroll
                for (int n = 0; n < 2; ++n) acc[a][b][m][n] = (f32x4){0.f, 0.f, 0.f, 0.f};
    bf16x8 At[4][2], B0[2][2], B1[2][2];
    const char* cA = (const char*)g.A + (size_t)cur.pm * tstepA + (size_t)cur.koff * 2; const char* cB = (const char*)g.Bt + (size_t)cur.pn * tstepB + (size_t)cur.koff * 2;
    PG8_STAGE(PG8_SB(0, 0), cB, voffB); PG8_STAGE(PG8_SB(0, 1), cB + hstepB, voffB); PG8_STAGE(PG8_SA(0, 0), cA, voffA); PG8_STAGE(PG8_SA(0, 1), cA + hstepA, voffA);
    if (wr == 1) PG8_BAR;
    PG8_WAIT_V(2); PG8_BAR;
    PG8_STAGE(PG8_SB(1, 0), cB + kstep, voffB); PG8_STAGE(PG8_SA(1, 0), cA + kstep, voffA); PG8_STAGE(PG8_SB(1, 1), cB + hstepB + kstep, voffB);
    PG8_WAIT_V(6); PG8_BAR;
    for (;;) {
        const bool has_next = S.next(ui + 1, nxt);
        const char* nA = has_next ? (const char*)g.A + (size_t)nxt.pm * tstepA + (size_t)nxt.koff * 2 : cA; const char* nB = has_next ? (const char*)g.Bt + (size_t)nxt.pn * tstepB + (size_t)nxt.koff * 2 : cB;
        const int nt = cur.nt;
        for (int t = 0; t < nt; t += 2) {
            const bool last = (t == nt - 2);
            const char* a1 = cA + (size_t)(t + 1) * kstep;
            const char* a2 = last ? nA : cA + (size_t)(t + 2) * kstep; const char* b2 = last ? nB : cB + (size_t)(t + 2) * kstep;
            const char* a3 = a2 + kstep; const char* b3 = b2 + kstep;
            PG8_LDB(B0, 0, 0); PG8_LDB(B1, 0, 1); PG8_SCHED; PG8_LDA(At, 0, 0); PG8_STAGE(PG8_SA(1, 1), a1 + hstepA, voffA);
            PG8_WAIT_V(8); PG8_WAIT_L(0); PG8_BAR; PG8_MMA(0, 0, At, B0); PG8_MMA(0, 1, At, B1); PG8_BAR; PG8_SCHED;
            PG8_LDA(At, 0, 1); PG8_STAGE(PG8_SB(0, 0), b2, voffB); PG8_STAGE(PG8_SB(0, 1), b2 + hstepB, voffB); PG8_STAGE(PG8_SA(0, 0), a2, voffA);
            PG8_WAIT_V(8); PG8_WAIT_L(0); PG8_BAR; PG8_MMA(1, 0, At, B0); PG8_MMA(1, 1, At, B1); PG8_BAR; PG8_SCHED;
            PG8_LDB(B0, 1, 0); PG8_LDB(B1, 1, 1); PG8_SCHED; PG8_LDA(At, 1, 0); PG8_STAGE(PG8_SA(0, 1), a2 + hstepA, voffA);
            PG8_WAIT_V(8); PG8_WAIT_L(0); PG8_BAR; PG8_MMA(0, 0, At, B0); PG8_MMA(0, 1, At, B1); PG8_BAR; PG8_SCHED;
            PG8_LDA(At, 1, 1); PG8_STAGE(PG8_SB(1, 0), b3, voffB); PG8_STAGE(PG8_SB(1, 1), b3 + hstepB, voffB); PG8_STAGE(PG8_SA(1, 0), a3, voffA);
            PG8_WAIT_V(8); PG8_WAIT_L(0); PG8_BAR; PG8_MMA(1, 0, At, B0); PG8_MMA(1, 1, At, B1); PG8_BAR; PG8_SCHED;
        }
        if (wr == 0) PG8_BAR;
        E(acc, cur, wr, wc, fr, fq);
        if (!has_next) break;
#pragma unroll
        for (int a = 0; a < 2; ++a)
#pragma unroll
            for (int b = 0; b < 2; ++b)
#pragma unroll
                for (int m = 0; m < 4; ++m)
#pragma unroll
                    for (int n = 0; n < 2; ++n) acc[a][b][m][n] = (f32x4){0.f, 0.f, 0.f, 0.f};
        cur = nxt; cA = nA; cB = nB; ++ui;
        if (wr == 1) PG8_BAR;
    }
    PG8_WAIT_V(0);
    PG8_BAR;
#undef PG8_SA
#undef PG8_SB
#undef PG8_STAGE
#undef PG8_LDA
#undef PG8_LDB
#undef PG8_MMA
#undef PG8_WAIT_V
#undef PG8_WAIT_L
#undef PG8_BAR
#undef PG8_SCHED
}

struct EpiSwiglu {
    static constexpr bool PERM = true;
    bf16_t* O; int ldc;
    __device__ __forceinline__ void operator()(const f32x4 (&acc)[2][2][4][2], const Unit& u, int wr, int wc, int fr, int fq) const {
        const int row0 = u.pm * BM + wr * 64 + fr, col0 = u.pn * HALF + wc * 32 + 8 * fq;
#pragma unroll
        for (int ai = 0; ai < 2; ++ai)
#pragma unroll
            for (int m = 0; m < 4; ++m) {
                float hv[8];
#pragma unroll
                for (int n = 0; n < 2; ++n)
#pragma unroll
                    for (int j = 0; j < 4; ++j) { const float gv = acc[ai][0][m][n][j], uv = acc[ai][1][m][n][j]; hv[4 * n + j] = gv * __builtin_amdgcn_rcpf(1.0f + __expf(-gv)) * uv; }
                u32x4 w; w.x = pk2(hv[0], hv[1]); w.y = pk2(hv[2], hv[3]); w.z = pk2(hv[4], hv[5]); w.w = pk2(hv[6], hv[7]);
                *(u32x4*)(O + (size_t)(row0 + ai * HALF + m * 16) * ldc + col0) = w;
            }
    }
};
struct EpiRes {
    static constexpr bool PERM = false;
    const float* Xraw; const float* st; const float* g; const float* b; float* T; int ldc; float alpha, s;
    __device__ __forceinline__ void operator()(const f32x4 (&acc)[2][2][4][2], const Unit& u, int wr, int wc, int fr, int fq) const {
        const int row0 = u.pm * BM + wr * 64 + fr, col0 = u.pn * BM + wc * 32 + 4 * fq;
        f32x4 gv[2][2], bv[2][2];
        if (st) {
#pragma unroll
            for (int bj = 0; bj < 2; ++bj)
#pragma unroll
                for (int n = 0; n < 2; ++n) { gv[bj][n] = *(const f32x4*)(g + col0 + bj * HALF + n * 16); bv[bj][n] = *(const f32x4*)(b + col0 + bj * HALF + n * 16); } }
        const float* src = st ? T : Xraw;
#pragma unroll
        for (int ai = 0; ai < 2; ++ai)
#pragma unroll
            for (int m2 = 0; m2 < 2; ++m2) {
                f32x4 tv[2][2][2]; f32x2 ms[2];
#pragma unroll
                for (int mm = 0; mm < 2; ++mm) { const int row = row0 + ai * HALF + (2 * m2 + mm) * 16; const size_t off = (size_t)row * ldc + col0;
                    ms[mm] = (f32x2){0.f, 1.f}; if (st) ms[mm] = *(const f32x2*)(st + 2 * (size_t)row);
#pragma unroll
                    for (int bj = 0; bj < 2; ++bj)
#pragma unroll
                        for (int n = 0; n < 2; ++n) tv[mm][bj][n] = *(const f32x4*)(src + off + bj * HALF + n * 16); }
                asm volatile("" ::: "memory");
#pragma unroll
                for (int mm = 0; mm < 2; ++mm) { const int m = 2 * m2 + mm; const size_t off = (size_t)(row0 + ai * HALF + m * 16) * ldc + col0;
#pragma unroll
                    for (int bj = 0; bj < 2; ++bj)
#pragma unroll
                        for (int n = 0; n < 2; ++n) { f32x4 xv = tv[mm][bj][n]; if (st) xv = (xv - ms[mm][0]) * ms[mm][1] * gv[bj][n] + bv[bj][n];
                            *(f32x4*)(T + off + bj * HALF + n * 16) = xv * alpha + acc[ai][bj][m][n] * s; } }
            }
    }
};
__device__ __forceinline__ int frag_off(int wr, int wc, int fr, int fq, int ai, int m, int bj) { return (((((wr * 4 + wc) * 2 + ai) * 4 + m) * 2 + bj) * 64 + fq * 16 + fr) * 8; }
struct EpiBf16 {
    static constexpr bool PERM = true;
    bf16_t* O; int ldc; bf16_t* G;
    __device__ __forceinline__ void operator()(const f32x4 (&acc)[2][2][4][2], const Unit& u, int wr, int wc, int fr, int fq) const {
        const bool gate = u.pn >= GN_GATE / BM && u.pn < GN_LORA / BM;
        const int gt = u.pn - GN_GATE / BM;
        bf16_t* gbase = G + ((size_t)((gt >> 3) * (M / BM) + u.pm) * 8 + (gt & 7)) * 65536;
        const int pcol = (u.pn >= GN_LORA / BM ? PC_LORA + (u.pn - GN_LORA / BM) * BM : u.pn * BM) + wc * 32 + 8 * fq;
        const int row0 = u.pm * BM + wr * 64 + fr;
        int lbase = ((wr * 4 + wc) * 1024 + fq * 16 + fr) * 8; asm volatile("" : "+v"(lbase));
#pragma unroll
        for (int ai = 0; ai < 2; ++ai)
#pragma unroll
            for (int m = 0; m < 4; ++m) { bf16_t* rowp = O + (size_t)(row0 + ai * HALF + m * 16) * ldc + pcol;
#pragma unroll
                for (int bj = 0; bj < 2; ++bj) { const f32x4 v0 = acc[ai][bj][m][0], v1 = acc[ai][bj][m][1];
                    u32x4 w; w.x = pk2(v0[0], v0[1]); w.y = pk2(v0[2], v0[3]); w.z = pk2(v1[0], v1[1]); w.w = pk2(v1[2], v1[3]);
                    if (gate) *(u32x4*)(gbase + lbase + (((ai * 4 + m) * 2 + bj) * 512)) = w; else *(u32x4*)(rowp + bj * HALF) = w; } }
    }
};
struct EpiBranch {
    static constexpr bool PERM = true;
    const bf16_t* G; const float* bgate; bf16_t* TOT; bf16_t* MG;
    __device__ __forceinline__ void operator()(const f32x4 (&acc)[2][2][4][2], const Unit& u, int wr, int wc, int fr, int fq) const {
        const int row0 = u.pm * BM + wr * 64 + fr, col0 = u.pn * BM + wc * 32 + 8 * fq; const int br = u.tag;
        int lbase = ((wr * 4 + wc) * 1024 + fq * 16 + fr) * 8; asm volatile("" : "+v"(lbase));
        u32x2 bgp[2][2];
#pragma unroll
        for (int bj = 0; bj < 2; ++bj)
#pragma unroll
            for (int n = 0; n < 2; ++n) { const f32x4 t = *(const f32x4*)(bgate + br * D + col0 + bj * HALF + 4 * n); bgp[bj][n].x = pk2(t[0], t[1]); bgp[bj][n].y = pk2(t[2], t[3]); }
        const bf16_t* gbase = G + ((size_t)(br * (M / BM) + u.pm) * 8 + u.pn) * 65536;
        bf16_t* tbase = TOT + (size_t)(u.pm * 8 + u.pn) * 65536;
#pragma unroll
        for (int a2 = 0; a2 < 4; ++a2) { const int ai = a2 >> 1, mb = (a2 & 1) * 2;
            u32x4 gw[2][2], tt[2][2];
#pragma unroll
            for (int mm = 0; mm < 2; ++mm)
#pragma unroll
                for (int bj = 0; bj < 2; ++bj) { const int fo = lbase + (((ai * 4 + mb + mm) * 2 + bj) * 512); gw[mm][bj] = *(const u32x4*)(gbase + fo);
                    tt[mm][bj] = (u32x4){0u, 0u, 0u, 0u}; if (br != 0) tt[mm][bj] = *(const u32x4*)(tbase + fo); }
            asm volatile("" ::: "memory");
#pragma unroll
            for (int mm = 0; mm < 2; ++mm) { const int m = mb + mm; const size_t row = (size_t)(row0 + ai * HALF + m * 16);
#pragma unroll
                for (int bj = 0; bj < 2; ++bj) { const u32x4 w4 = gw[mm][bj], t4 = tt[mm][bj];
                    const unsigned ww[4] = {w4.x, w4.y, w4.z, w4.w}, tw[4] = {t4.x, t4.y, t4.z, t4.w}; unsigned ow[4];
#pragma unroll
                    for (int n = 0; n < 2; ++n) { const f32x4 b4 = (f32x4){bflo(bgp[bj][n].x), bfhi(bgp[bj][n].x), bflo(bgp[bj][n].y), bfhi(bgp[bj][n].y)}; const f32x4 av = acc[ai][bj][m][n];
                        const float g0 = sigmoidf_(bflo(ww[2 * n]) + b4[0]), g1 = sigmoidf_(bfhi(ww[2 * n]) + b4[1]), g2 = sigmoidf_(bflo(ww[2 * n + 1]) + b4[2]), g3 = sigmoidf_(bfhi(ww[2 * n + 1]) + b4[3]);
                        ow[2 * n] = pk2(g0 * av[0] + bflo(tw[2 * n]), g1 * av[1] + bfhi(tw[2 * n])); ow[2 * n + 1] = pk2(g2 * av[2] + bflo(tw[2 * n + 1]), g3 * av[3] + bfhi(tw[2 * n + 1])); }
                    u32x4 o; o.x = ow[0]; o.y = ow[1]; o.z = ow[2]; o.w = ow[3];
                    if (br == 2) *(u32x4*)(MG + row * D + col0 + bj * HALF) = o; else *(u32x4*)(tbase + lbase + (((ai * 4 + m) * 2 + bj) * 512)) = o; } }
        }
    }
};
}

#define XB_TMO      128
#define XB_XCNT(j)  (256  + 64 * (j))
#define XB_XSUB(j)  (1280 + 64 * (j))
#define XB_XGEN(j)  (2304 + 64 * (j))
#define XB_TOP      3328
#define XB_TOPGEN   3392
#define XCD_BAR_WORDS 3456
#define XB_SPIN_CAP (1u << 18)
__device__ __forceinline__ unsigned xb_ld(unsigned* p)              { return __hip_atomic_load(p, __ATOMIC_RELAXED, __HIP_MEMORY_SCOPE_AGENT); }
__device__ __forceinline__ unsigned xb_add(unsigned* p, unsigned v) { return __hip_atomic_fetch_add(p, v, __ATOMIC_RELAXED, __HIP_MEMORY_SCOPE_AGENT); }
__device__ __forceinline__ unsigned xb_xcc_id() { return (unsigned)__builtin_amdgcn_s_getreg((3 << 11) | 20) & 0xFu; }
#define XB_SPIN(cond, bar) do { unsigned _sp = 0; while (cond) { __builtin_amdgcn_s_sleep(1); \
    if ((++_sp & 255u) == 0u) { if (xb_ld(&(bar)[XB_TMO])) break; if (_sp > XB_SPIN_CAP) { atomicAdd(&(bar)[XB_TMO], 1u); break; } } } } while (0)
struct XcdBarrier { unsigned* bar; unsigned x; volatile LAS unsigned* st; };
__device__ __forceinline__ XcdBarrier xcd_barrier_post(unsigned* bar, volatile LAS unsigned* st) {
    XcdBarrier b; b.bar = bar; b.x = xb_xcc_id(); b.st = st;
    if (threadIdx.x == 0) (void)xb_add(&bar[XB_XCNT(b.x)], 1u);
    return b;
}
__device__ __forceinline__ void xcd_barrier_complete(unsigned* bar, unsigned x, unsigned& nloc, unsigned& nx) {
    const unsigned G = gridDim.x * gridDim.y * gridDim.z;
    unsigned sum, cnt, mine, sp = 0u;
    for (;;) {
        sum = 0u; cnt = 0u; mine = 0u;
#pragma unroll
        for (unsigned j = 0; j < 16; ++j) { const unsigned c = xb_ld(&bar[XB_XCNT(j)]); sum += c; cnt += (c > 0u) ? 1u : 0u; mine = (j == x) ? c : mine; }
        if (sum == G) break;
        __builtin_amdgcn_s_sleep(1);
        if ((++sp & 255u) == 0u) { if (xb_ld(&bar[XB_TMO])) break; if (sp > XB_SPIN_CAP) { atomicAdd(&bar[XB_TMO], 1u); break; } }
    }
    nloc = mine > 0u ? mine : 1u; nx = cnt > 0u ? cnt : 1u;
}
__device__ __forceinline__ void xcd_barrier(const XcdBarrier& b) {
    asm volatile("s_waitcnt vmcnt(0)" ::: "memory");
    __syncthreads();
    if (threadIdx.x == 0) {
        unsigned* bar = b.bar;
        __builtin_amdgcn_s_waitcnt(0);
        unsigned nloc = b.st[0], nx = b.st[1];
        if (nloc == 0u) { xcd_barrier_complete(bar, b.x, nloc, nx); b.st[0] = nloc; b.st[1] = nx; }
        const unsigned old = xb_add(&bar[XB_XSUB(b.x)], 1u);
        const unsigned gen = old / nloc;
        if (old + 1u == (gen + 1u) * nloc) {
            __builtin_amdgcn_fence(__ATOMIC_RELEASE, "agent");
            asm volatile("s_waitcnt vmcnt(0)" ::: "memory");
            const unsigned og = xb_add(&bar[XB_TOP], 1u);
            const unsigned tg = og / nx;
            if (og + 1u == (tg + 1u) * nx) xb_add(&bar[XB_TOPGEN], 1u);
            else XB_SPIN(xb_ld(&bar[XB_TOPGEN]) == tg, bar);
            __builtin_amdgcn_fence(__ATOMIC_ACQUIRE, "agent");
            xb_add(&bar[XB_XGEN(b.x)], 1u);
            asm volatile("s_waitcnt vmcnt(0)" ::: "memory");
        } else {
            XB_SPIN(xb_ld(&bar[XB_XGEN(b.x)]) == gen, bar);
            __builtin_amdgcn_fence(__ATOMIC_ACQUIRE, "agent");
            asm volatile("s_waitcnt vmcnt(0)" ::: "memory");
        }
    }
    __syncthreads();
}

struct Args { const float* in[33]; float* out; unsigned char* ws; int lo, hi; };
enum { I_X = 0, I_F1IN, I_F1OUT, I_LN1G, I_LN1B, I_WIN, I_BGATE, I_MU, I_W0, I_W2, I_A0, I_A2, I_G2, I_KK, I_KA, I_RK, I_GNG, I_GNB, I_SGLNG, I_SGLNB, I_SGW, I_SGB, I_ILNG, I_ILNB, I_RELB, I_WBR, I_WO, I_LN2G, I_LN2B, I_F2IN, I_F2OUT, I_LN3G, I_LN3B };

DI int pmap(int n) {
    int off = 0;
    off = n >= 3072 ? GN_LORA - 3072 : off; off = n >= 3360 ? PC_SGU - 3360 : off; off = n >= 4384 ? PC_AQ - 4384 : off; off = n >= 5920 ? PC_QI - 5920 : off;
    off = n >= 6944 ? GN_KI - 6944 : off; off = n >= 7008 ? GN_WI - 7008 : off; off = n >= 7024 ? GN_GATE - 7024 : off;
    return n + off;
}
template <int MODE> DI int rowmap(int n) {
    if (MODE == 0) return n;
    if (MODE == 1) { const int up = n >= FF ? 1 : 0, j = n - up * FF; return (j >> 7) * 256 + up * 128 + (j & 127); }
    return pmap(n);
}
struct CvtItem { const float* W; bf16_t* WT; int K, N, mode, item; };
DI void cvt_load(const CvtItem& d, int lane, f32x4 (&va)[4], f32x4 (&vb)[4]) {
    const int nblk = (d.N + 31) / 32, kb = d.item / nblk, nb = d.item % nblk, k0 = 64 * kb, n0 = 32 * nb;
    const int c4 = lane & 7, rq = lane >> 3; const int ncol = n0 + 4 * c4; const int ncl = ncol < d.N ? ncol : 0;
#pragma unroll
    for (int i = 0; i < 4; ++i) { const int k = k0 + 2 * (rq + 8 * i);
        va[i] = *(const f32x4*)(d.W + (size_t)k * d.N + ncl); vb[i] = *(const f32x4*)(d.W + (size_t)(k + 1) * d.N + ncl); }
}
DI void cvt_finish(const CvtItem& d, int lane, const f32x4 (&va)[4], const f32x4 (&vb)[4], float* scr) {
    const int nblk = (d.N + 31) / 32, kb = d.item / nblk, nb = d.item % nblk, k0 = 64 * kb, n0 = 32 * nb;
    unsigned* st = (unsigned*)scr; const int c4 = lane & 7, rq = lane >> 3;
#pragma unroll
    for (int i = 0; i < 4; ++i) { const int rp = rq + 8 * i;
#pragma unroll
        for (int j = 0; j < 4; ++j) st[(4 * c4 + j) * 33 + rp] = pk2(va[i][j], vb[i][j]); }
    __builtin_amdgcn_s_waitcnt(0xc07f); asm volatile("" ::: "memory");
#pragma unroll
    for (int i = 0; i < 4; ++i) { const int id = lane + 64 * i, n = id >> 3, kc = id & 7; const unsigned* p = st + n * 33 + 4 * kc;
        u32x4 o; o.x = p[0]; o.y = p[1]; o.z = p[2]; o.w = p[3];
        const int ns = n0 + n; const int nd1 = rowmap<1>(ns), nd2 = pmap(ns); const int nd = d.mode == 0 ? ns : (d.mode == 1 ? nd1 : nd2);
        if (ns < d.N) *(u32x4*)(d.WT + (size_t)nd * d.K + k0 + 8 * kc) = o; }
    __builtin_amdgcn_s_waitcnt(0xc07f); asm volatile("" ::: "memory");
}
DI void convert_phase(const Args& a, int L, unsigned char* lds, int vb, int nvb) {
    const int tidx_ = otid();
    const int wave = __builtin_amdgcn_readfirstlane(tidx_ >> 6), lane = tidx_ & 63;
    float* scr = (float*)(lds + wave * 16384);
    const int gw = vb * 8 + wave, NGW = nvb * 8;
    unsigned char* ws = a.ws; const size_t alt = (L & 1) ? ALT_SHIFT : 0;
    constexpr int I1 = (D / 64) * ((2 * FF) / 32), I2 = (FF / 64) * (D / 32), I3 = (D / 64) * ((DIN + 31) / 32), I4 = (D / 64) * (D / 32);
    constexpr int NIT = 2 * I1 + 2 * I2 + I3 + 2 * I4;
    auto decode = [&](int it) -> CvtItem {
        int r = it;
        if (r < I1) return CvtItem{a.in[I_F1IN] + (size_t)L * D * 2 * FF, (bf16_t*)(ws + OFF_W1A), D, 2 * FF, 1, r}; r -= I1;
        if (r < I1) return CvtItem{a.in[I_F2IN] + (size_t)L * D * 2 * FF, (bf16_t*)(ws + OFF_W2A + alt), D, 2 * FF, 1, r}; r -= I1;
        if (r < I2) return CvtItem{a.in[I_F1OUT] + (size_t)L * FF * D, (bf16_t*)(ws + OFF_W1B), FF, D, 0, r}; r -= I2;
        if (r < I2) return CvtItem{a.in[I_F2OUT] + (size_t)L * FF * D, (bf16_t*)(ws + OFF_W2B + alt), FF, D, 0, r}; r -= I2;
        if (r < I3) return CvtItem{a.in[I_WIN] + (size_t)L * D * DIN, (bf16_t*)(ws + OFF_WIN), D, DIN, 2, r}; r -= I3;
        if (r < I4) return CvtItem{a.in[I_WBR] + (size_t)L * D * D, (bf16_t*)(ws + OFF_WBR + alt), D, D, 0, r}; r -= I4;
        return CvtItem{a.in[I_WO] + (size_t)L * D * D, (bf16_t*)(ws + OFF_WO + alt), D, D, 0, r};
    };
    auto clampi = [&](int x) { return x < NIT ? x : gw; };
    {
        int it = gw;
        CvtItem dA0 = decode(clampi(it)), dA1 = decode(clampi(it + NGW));
        f32x4 a0[4], b0[4], a1[4], b1[4], a2[4], b2[4], a3[4], b3[4];
        cvt_load(dA0, lane, a0, b0); cvt_load(dA1, lane, a1, b1);
#pragma unroll 1
        for (; it < NIT; it += 4 * NGW) {
            const CvtItem dB0 = decode(clampi(it + 2 * NGW)), dB1 = decode(clampi(it + 3 * NGW));
            cvt_load(dB0, lane, a2, b2); cvt_load(dB1, lane, a3, b3);
            asm volatile("" ::: "memory");
            cvt_finish(dA0, lane, a0, b0, scr); cvt_finish(dA1, lane, a1, b1, scr + 2048);
            asm volatile("" ::: "memory");
            dA0 = decode(clampi(it + 4 * NGW)); dA1 = decode(clampi(it + 5 * NGW));
            cvt_load(dA0, lane, a0, b0); cvt_load(dA1, lane, a1, b1);
            asm volatile("" ::: "memory");
            cvt_finish(dB0, lane, a2, b2, scr); cvt_finish(dB1, lane, a3, b3, scr + 2048);
            asm volatile("" ::: "memory");
        }
    }
    { bf16_t* w2t = (bf16_t*)(ws + OFF_LW2); bf16_t* a2t = (bf16_t*)(ws + OFF_LA2); bf16_t* g2t = (bf16_t*)(ws + OFF_LG2);
      const float* w2 = a.in[I_W2] + (size_t)L * 64 * RW; const float* a2 = a.in[I_A2] + (size_t)L * 64 * RW; const float* g2 = a.in[I_G2] + (size_t)L * 160 * RW;
      for (int i = vb * 512 + tidx_; i < RW * 288; i += nvb * 512) { const int c = i / 288, jj = i - c * 288;
          if (jj < 64) w2t[c * 64 + jj] = (bf16_t)f2bf(w2[(size_t)jj * RW + c]);
          else if (jj < 128) a2t[c * 64 + jj - 64] = (bf16_t)f2bf(a2[(size_t)(jj - 64) * RW + c]);
          else g2t[c * 160 + jj - 128] = (bf16_t)f2bf(g2[(size_t)(jj - 128) * RW + c]); } }
    { u32x4* z = (u32x4*)(ws + OFF_WIN + (size_t)DIN * D * 2); const int n16 = (NP - DIN) * D * 2 / 16;
      u32x4 zq = (u32x4){0u, 0u, 0u, 0u}; asm volatile("" : "+v"(zq));
      for (int i = vb * 512 + tidx_; i < n16; i += nvb * 512) z[i] = zq; }
}
DI int rel_bucket_dev(int d) {
    if (d < 16) return d;
    const float df = (float)d;
    const int large = 16 + (int)(logf(df / 16.0f) / 2.0794415416798357f * 16.0f);
    return large < 31 ? large : 31;
}
DI void init_phase(const Args& a) {
    const int tidx_ = otid();
    const size_t n4 = (size_t)M * D / 4; const f32x4* x = (const f32x4*)a.in[I_X]; u32x2* XB = (u32x2*)(a.ws + OFF_XB);
    for (size_t i = (size_t)blockIdx.x * 512 + tidx_; i < n4; i += (size_t)gridDim.x * 512) { const f32x4 v = x[i]; u32x2 o; o.x = pk2(v[0], v[1]); o.y = pk2(v[2], v[3]); XB[i] = o; }
    if (blockIdx.x == 0) { float* bt = (float*)(a.ws + OFF_BIAS); for (int i = tidx_; i < 8 * 128; i += 512) { const int h = i >> 7, d = i & 127; bt[i] = a.in[I_RELB][rel_bucket_dev(d) * 8 + h]; } }
}
DI void ln_phase(const float* T, const float* g, const float* b, float* ST, bf16_t* XB, float* out) {
    const int tidx_ = otid();
    const int wave = __builtin_amdgcn_readfirstlane(tidx_ >> 6), lane = tidx_ & 63;
    const int stride = gridDim.x * 8;
    f32x4 gvs[8], bvs[8];
#pragma unroll
    for (int j = 0; j < 8; ++j) { gvs[j] = ((const f32x4*)g)[lane + 64 * j]; bvs[j] = ((const f32x4*)b)[lane + 64 * j]; }
    int m = blockIdx.x * 8 + wave;
    f32x4 nx[8];
    if (m < M) {
#pragma unroll
        for (int j = 0; j < 8; ++j) nx[j] = ((const f32x4*)(T + (size_t)m * D) + lane)[64 * j]; }
#pragma unroll 1
    for (; m < M; m += stride) {
        f32x4 v[8]; float s = 0.f;
#pragma unroll
        for (int j = 0; j < 8; ++j) { v[j] = nx[j]; s += (v[j][0] + v[j][1]) + (v[j][2] + v[j][3]); }
        if (m + stride < M) {
#pragma unroll
            for (int j = 0; j < 8; ++j) nx[j] = ((const f32x4*)(T + (size_t)(m + stride) * D) + lane)[64 * j]; }
        const float mean = wave_sum(s) * (1.0f / D); float q = 0.f;
#pragma unroll
        for (int j = 0; j < 8; ++j) { v[j] = v[j] - mean; q += (v[j][0] * v[j][0] + v[j][1] * v[j][1]) + (v[j][2] * v[j][2] + v[j][3] * v[j][3]); }
        const float rstd = __builtin_amdgcn_rsqf(wave_sum(q) * (1.0f / D) + LN_EPS);
        if (lane == 0) *(f32x2*)(ST + 2 * (size_t)m) = (f32x2){mean, rstd};
        u32x2* bo = (u32x2*)(XB + (size_t)m * D) + lane;
#pragma unroll
        for (int j = 0; j < 8; ++j) {
            const f32x4 o = v[j] * rstd * gvs[j] + bvs[j]; u32x2 w; w.x = pk2(o[0], o[1]); w.y = pk2(o[2], o[3]); bo[64 * j] = w;
            if (out) ((f32x4*)(out + (size_t)m * D) + lane)[64 * j] = o; }
    }
}
DI void rwkv_prep_phase(const Args& a, int L, unsigned char* lds) {
    const int tidx_ = otid();
    const int tid = tidx_;
    const bf16_t* P = (const bf16_t*)(a.ws + OFF_P);
    float* Rr = (float*)(a.ws + OFF_SCR); float* Wr = Rr + (size_t)M * RW; float* Kr = Wr + (size_t)M * RW; float* Vr = Kr + (size_t)M * RW; float* Ar = Vr + (size_t)M * RW; float* Br = Ar + (size_t)M * RW;
    bf16_t* Gb = (bf16_t*)(a.ws + OFF_MG);
    const float* mu = a.in[I_MU] + (size_t)L * 3360; const float* w0 = a.in[I_W0] + L * RW; const float* w2 = a.in[I_W2] + (size_t)L * 64 * RW;
    const float* a0 = a.in[I_A0] + L * RW; const float* a2 = a.in[I_A2] + (size_t)L * 64 * RW; const float* g2 = a.in[I_G2] + (size_t)L * 160 * RW;
    const float* kkw = a.in[I_KK] + L * RW; const float* kaw = a.in[I_KA] + L * RW;
    float* xl = (float*)lds;
    for (int unit = blockIdx.x; unit < M / 32; unit += gridDim.x) {
        const int m0 = unit * 32;
        __syncthreads();
        for (int idx = tid; idx < 32 * 288; idx += 512) { const int tt = idx / 288, j = idx - tt * 288; const int m = m0 + tt;
            const float cur = bf2f(P[(size_t)m * PCOLS + PC_LORA + j]); const float prev = (m & (SEQ - 1)) == 0 ? 0.f : bf2f(P[(size_t)(m - 1) * PCOLS + PC_LORA + j]);
            float x = cur + (prev - cur) * mu[3072 + j];
            if (j < 64) x = tanhf(x); else if (j >= 128) x = sigmoidf_(x);
            xl[idx] = x; }
        __syncthreads();
#pragma unroll 1
        for (int half = 0; half < 2; ++half) { const int c = tid + 512 * half;
            const float w0c = w0[c], a0c = a0[c], kkc = kkw[c], kac = kaw[c], mur = mu[c], muk = mu[1024 + c], muv = mu[2048 + c];
#pragma unroll 1
            for (int sub = 0; sub < 4; ++sub) {
                float wl[8], al[8], gl[8];
#pragma unroll
                for (int t = 0; t < 8; ++t) { wl[t] = w0c; al[t] = a0c; gl[t] = 0.f; }
                const float* xb = xl + sub * 8 * 288;
#pragma unroll 2
                for (int j = 0; j < 64; j += 4) { const float u0 = w2[(size_t)(j + 0) * RW + c], u1 = w2[(size_t)(j + 1) * RW + c], u2 = w2[(size_t)(j + 2) * RW + c], u3 = w2[(size_t)(j + 3) * RW + c];
                    const float v0 = a2[(size_t)(j + 0) * RW + c], v1 = a2[(size_t)(j + 1) * RW + c], v2 = a2[(size_t)(j + 2) * RW + c], v3 = a2[(size_t)(j + 3) * RW + c];
#pragma unroll
                    for (int t = 0; t < 8; ++t) { const f32x4 xw = *(const f32x4*)(xb + t * 288 + j); const f32x4 xa = *(const f32x4*)(xb + t * 288 + 64 + j);
                        wl[t] += xw[0] * u0 + xw[1] * u1 + xw[2] * u2 + xw[3] * u3; al[t] += xa[0] * v0 + xa[1] * v1 + xa[2] * v2 + xa[3] * v3; } }
#pragma unroll 2
                for (int j = 0; j < 160; j += 4) { const float u0 = g2[(size_t)(j + 0) * RW + c], u1 = g2[(size_t)(j + 1) * RW + c], u2 = g2[(size_t)(j + 2) * RW + c], u3 = g2[(size_t)(j + 3) * RW + c];
#pragma unroll
                    for (int t = 0; t < 8; ++t) { const f32x4 xg = *(const f32x4*)(xb + t * 288 + 128 + j); gl[t] += xg[0] * u0 + xg[1] * u1 + xg[2] * u2 + xg[3] * u3; } }
#pragma unroll
                for (int t = 0; t < 8; ++t) { const int m = m0 + sub * 8 + t; const bool first = (m & (SEQ - 1)) == 0;
                    const bf16_t* pc = P + (size_t)m * PCOLS; const bf16_t* pp = pc - PCOLS;
                    const float rc = bf2f(pc[PC_R + c]), kc = bf2f(pc[PC_K + c]), vc = bf2f(pc[PC_V + c]);
                    const float rp = first ? 0.f : bf2f(pp[PC_R + c]), kp = first ? 0.f : bf2f(pp[PC_K + c]), vp = first ? 0.f : bf2f(pp[PC_V + c]);
                    const float r = rc + (rp - rc) * mur, k = kc + (kp - kc) * muk, v = vc + (vp - vc) * muv;
                    const float nx = -wl[t]; const float sp = nx > 20.f ? nx : log1pf(expf(nx));
                    const float decay = expf(-expf(-sp - 0.5f));
                    const float av = 1.0f / (1.0f + expf(-al[t]));
                    const float kk = k * kkc; const float ss = wave_sum(kk * kk); const float kkn = kk / fmaxf(sqrtf(ss), 1e-12f);
                    const float k2 = k * (1.0f + (av - 1.0f) * kac);
                    const size_t o = (size_t)m * RW + c;
                    Rr[o] = r; Wr[o] = decay; Kr[o] = k2; Vr[o] = v; Ar[o] = -kkn; Br[o] = kkn * av; Gb[o] = (bf16_t)f2bf(gl[t]); }
            }
        }
    }
}
struct WorkQ { unsigned* ctr; int pend, par, stride; };
constexpr int WQ_SLOT = 147456 - 16;
DI int wq_next(WorkQ& q, int cur, unsigned char* lds, int tid) {
    if (!q.ctr) return cur + q.stride;
    LAS int* slot = (LAS int*)(lds + WQ_SLOT);
    if (tid == 0) slot[q.par] = q.pend;
    __syncthreads();
    const int v = __builtin_amdgcn_readfirstlane(slot[q.par]);
    q.par ^= 1;
    if (tid == 0) q.pend = (int)__hip_atomic_fetch_add(q.ctr, 1u, __ATOMIC_RELAXED, __HIP_MEMORY_SCOPE_AGENT);
    return v;
}
DI int wq_first(WorkQ& q, unsigned char* lds, int tid) {
    q.par = 0; q.pend = 0;
    if (tid == 0) q.pend = (int)__hip_atomic_fetch_add(q.ctr, 1u, __ATOMIC_RELAXED, __HIP_MEMORY_SCOPE_AGENT);
    return wq_next(q, 0, lds, tid);
}
DI void kidx_vt_phase(const Args& a, int L, unsigned char* lds) {
    const int tidx_ = otid();
    const int wave = __builtin_amdgcn_readfirstlane(tidx_ >> 6), lane = tidx_ & 63;
    const bf16_t* P = (const bf16_t*)(a.ws + OFF_P); bf16_t* KI = (bf16_t*)(a.ws + OFF_KI); bf16_t* VT = (bf16_t*)(a.ws + OFF_VT);
    const float g = a.in[I_ILNG][L * 64 + lane], b = a.in[I_ILNB][L * 64 + lane];
    for (int m0 = blockIdx.x * 8 + wave; m0 < M; m0 += gridDim.x * 8 * 8) {
        bf16_t raw[8];
#pragma unroll
        for (int i = 0; i < 8; ++i) { const int m = m0 + i * gridDim.x * 8; raw[i] = m < M ? P[(size_t)m * PCOLS + PC_KI + lane] : (bf16_t)0; }
#pragma unroll
        for (int i = 0; i < 8; ++i) { const int m = m0 + i * gridDim.x * 8; if (m < M) { const float x = bf2f(raw[i]);
            const float mean = wave_sum(x) * (1.0f / 64.0f); const float d = x - mean; const float var = wave_sum(d * d) * (1.0f / 64.0f);
            KI[(size_t)m * 64 + lane] = (bf16_t)f2bf(d * __builtin_amdgcn_rsqf(var + LN_EPS) * g + b); } }
    }
    bf16_t* tile = (bf16_t*)(lds + wave * 16384);
    for (int u = blockIdx.x * 8 + wave; u < NB * 8 * 64; u += gridDim.x * 8) {
        const int tb = u & 63, h = (u >> 6) & 7, b_ = u >> 9; const int m = b_ * SEQ + tb * 64 + lane;
        const u32x4* src = (const u32x4*)(P + (size_t)m * PCOLS + PC_AV + h * 64);
#pragma unroll
        for (int q = 0; q < 8; ++q) { const u32x4 v = src[q]; const unsigned w[4] = {v.x, v.y, v.z, v.w};
#pragma unroll
            for (int e = 0; e < 4; ++e) { tile[(q * 8 + 2 * e) * 72 + lane] = (bf16_t)(w[e] & 0xffffu); tile[(q * 8 + 2 * e + 1) * 72 + lane] = (bf16_t)(w[e] >> 16); } }
        __builtin_amdgcn_s_waitcnt(0xc07f); asm volatile("" ::: "memory");
        bf16_t* dst = VT + ((size_t)(b_ * 8 + h) * 64 + lane) * SEQ + tb * 64;
#pragma unroll
        for (int q = 0; q < 8; ++q) *(u32x4*)(dst + q * 8) = *(const u32x4*)(tile + lane * 72 + q * 8);
        __builtin_amdgcn_s_waitcnt(0xc07f); asm volatile("" ::: "memory");
    }
}
DI void sgu_phase(const Args& a, int L, unsigned char* lds, WorkQ& wq, int& item, int ibase) {
    const int tidx_ = otid();
    const int tid = tidx_, wave = __builtin_amdgcn_readfirstlane(tid >> 6), lane = tid & 63, fr = lane & 15, fq = lane >> 4;
    const bf16_t* P = (const bf16_t*)(a.ws + OFF_P); bf16_t* Y = (bf16_t*)(a.ws + OFF_Y);
    const float* lng = a.in[I_SGLNG] + L * 512; const float* lnb = a.in[I_SGLNB] + L * 512;
    bf16_t* Wl = (bf16_t*)lds;
    bf16_t* Vl = (bf16_t*)(lds + 128 * 272);
    for (; item < ibase + NB * 32 * 4; item = wq_next(wq, item, lds, tid)) {
        const int unit = item - ibase;
        const int g = unit & 3, ch = (unit >> 2) & 31, b_ = unit >> 7; const int m0 = b_ * SEQ + ch * 128;
        const float* sw = a.in[I_SGW] + ((size_t)(L * 4 + g) * 128) * 128; const float* sb = a.in[I_SGB] + (L * 4 + g) * 128;
        __syncthreads();
#pragma unroll
        for (int it8 = 0; it8 < 8; ++it8) { const int idx = tid + 512 * it8; const int i = idx >> 5, j4 = (idx & 31) * 4; const f32x4 w = *(const f32x4*)(sw + i * 128 + j4);
            u32x2 o; o.x = pk2(j4 + 0 <= i ? w[0] : 0.f, j4 + 1 <= i ? w[1] : 0.f); o.y = pk2(j4 + 2 <= i ? w[2] : 0.f, j4 + 3 <= i ? w[3] : 0.f);
            *(u32x2*)(Wl + i * 136 + j4) = o; }
        float lgv[8], lbv[8];
#pragma unroll
        for (int e = 0; e < 8; ++e) { lgv[e] = lng[lane * 8 + e]; lbv[e] = lnb[lane * 8 + e]; }
#pragma unroll 1
        for (int ib = 0; ib < 2; ++ib) {
        u32x4 pvs[8];
#pragma unroll
        for (int i = 0; i < 8; ++i) pvs[i] = *(const u32x4*)(P + (size_t)(m0 + wave + 8 * (8 * ib + i)) * PCOLS + PC_SGV + lane * 8);
#pragma unroll
        for (int i = 0; i < 8; ++i) { const int tt = wave + 8 * (8 * ib + i);
            const u32x4 pv = pvs[i];
            float z[8]; z[0] = gelu_erf(bflo(pv.x)); z[1] = gelu_erf(bfhi(pv.x)); z[2] = gelu_erf(bflo(pv.y)); z[3] = gelu_erf(bfhi(pv.y));
            z[4] = gelu_erf(bflo(pv.z)); z[5] = gelu_erf(bfhi(pv.z)); z[6] = gelu_erf(bflo(pv.w)); z[7] = gelu_erf(bfhi(pv.w));
            float s = 0.f;
#pragma unroll
            for (int e = 0; e < 8; ++e) s += z[e];
            const float mean = wave_sum(s) * (1.0f / 512.0f); float q = 0.f;
#pragma unroll
            for (int e = 0; e < 8; ++e) { z[e] -= mean; q += z[e] * z[e]; }
            const float rstd = __builtin_amdgcn_rsqf(wave_sum(q) * (1.0f / 512.0f) + LN_EPS);
            if ((lane >> 4) == g) {
#pragma unroll
                for (int e = 0; e < 8; ++e) Vl[((lane & 15) * 8 + e) * 136 + tt] = (bf16_t)f2bf(z[e] * rstd * lgv[e] + lbv[e]); }
        }
        }
        __syncthreads();
        f32x4 acc[8];
#pragma unroll
        for (int nt = 0; nt < 8; ++nt) acc[nt] = (f32x4){0.f, 0.f, 0.f, 0.f};
        const int ksmax = (16 * wave + 15) >> 5;
#pragma unroll
        for (int ks = 0; ks < 4; ++ks) if (ks <= ksmax) {
            const bf16x8 af = *(const bf16x8*)(Wl + (16 * wave + fr) * 136 + 32 * ks + 8 * fq);
#pragma unroll
            for (int nt = 0; nt < 8; ++nt) { const bf16x8 bfr = *(const bf16x8*)(Vl + (16 * nt + fr) * 136 + 32 * ks + 8 * fq);
                acc[nt] = __builtin_amdgcn_mfma_f32_16x16x32_bf16(af, bfr, acc[nt], 0, 0, 0); }
        }
        bf16_t ur[4][8];
#pragma unroll
        for (int r = 0; r < 4; ++r)
#pragma unroll
            for (int nt = 0; nt < 8; ++nt) ur[r][nt] = P[(size_t)(m0 + 16 * wave + 4 * fq + r) * PCOLS + PC_SGU + g * 128 + 16 * nt + fr];
        float bsv[4];
#pragma unroll
        for (int r = 0; r < 4; ++r) bsv[r] = sb[16 * wave + 4 * fq + r];
        asm volatile("" ::: "memory");
#pragma unroll
        for (int r = 0; r < 4; ++r) { const int i = 16 * wave + 4 * fq + r; const float bs = bsv[r]; const size_t m = (size_t)(m0 + i);
#pragma unroll
            for (int nt = 0; nt < 8; ++nt) { const int dcol = g * 128 + 16 * nt + fr; const float uu = gelu_erf(bf2f(ur[r][nt]));
                Y[m * D + 1024 + dcol] = (bf16_t)f2bf(uu * (acc[nt][r] + bs)); } }
    }
}
DI void scan_load_chunk(unsigned char* bufp, const float* Rr, const float* Wr, const float* Kr, const float* Ar, const float* Br, const float* Vr, size_t base, int c, int rg, int lt) {
    const float* arrs[5] = {Rr, Wr, Kr, Ar, Br};
#pragma unroll
    for (int ar = 0; ar < 5; ++ar)
#pragma unroll
        for (int ps = 0; ps < 2; ++ps) { const int tt = ps * 16 + (lt >> 4), c4 = (lt & 15) * 4;
            const f32x4 v = *(const f32x4*)(arrs[ar] + base + (size_t)(c * 32 + tt) * RW + c4);
            *(f32x4*)(bufp + ar * 8192 + (tt * 64 + c4) * 4) = v; }
    if (lt < 128) { const int tt = lt >> 2, i4 = (lt & 3) * 4; const f32x4 v = *(const f32x4*)(Vr + base + (size_t)(c * 32 + tt) * RW + rg * 16 + i4);
        *(f32x4*)(bufp + 5 * 8192 + (tt * 16 + i4) * 4) = v; }
}
DI void scan_phase(const Args& a, unsigned char* lds) {
    const int tidx_ = otid();
    const int tid = tidx_;
    const float* Rr = (const float*)(a.ws + OFF_SCR); const float* Wr = Rr + (size_t)M * RW; const float* Kr = Wr + (size_t)M * RW; const float* Vr = Kr + (size_t)M * RW; const float* Ar = Vr + (size_t)M * RW; const float* Br = Ar + (size_t)M * RW;
    float* Yraw = (float*)(a.ws + OFF_X);
    constexpr int BUFB = 5 * 8192 + 2048;
    constexpr int NCH = SEQ / 32;
    for (int unit = blockIdx.x; unit < 256; unit += gridDim.x) {
        const int rg = unit & 3, h = (unit >> 2) & 15, b_ = unit >> 6;
        const size_t base = (size_t)b_ * SEQ * RW + h * 64;
        __syncthreads();
        const bool loader = tid >= 256; const int lt = tid - 256;
        if (loader) scan_load_chunk(lds, Rr, Wr, Kr, Ar, Br, Vr, base, 0, rg, lt);
        __syncthreads();
        float S0 = 0.f, S1 = 0.f, S2 = 0.f, S3 = 0.f;
        const int i = tid >> 4, c4 = tid & 15;
#pragma unroll 1
        for (int c = 0; c < NCH; ++c) {
            if (loader) {
                if (c > 0 && lt < 128) { const int tt = lt >> 2, i4 = (lt & 3) * 4; const f32x4 y = *(const f32x4*)(lds + 2 * BUFB + ((c - 1) & 1) * 2048 + (tt * 16 + i4) * 4);
                    *(f32x4*)(Yraw + base + (size_t)((c - 1) * 32 + tt) * RW + rg * 16 + i4) = y; }
                if (c + 1 < NCH) scan_load_chunk(lds + ((c + 1) & 1) * BUFB, Rr, Wr, Kr, Ar, Br, Vr, base, c + 1, rg, lt);
            } else {
                const unsigned char* bufp = lds + (c & 1) * BUFB; float* yb = (float*)(lds + 2 * BUFB + (c & 1) * 2048);
#pragma unroll 4
                for (int s = 0; s < 32; ++s) {
                    const f32x4 r4 = *(const f32x4*)(bufp + 0 * 8192 + (s * 64 + c4 * 4) * 4);
                    const f32x4 w4 = *(const f32x4*)(bufp + 1 * 8192 + (s * 64 + c4 * 4) * 4);
                    const f32x4 k4 = *(const f32x4*)(bufp + 2 * 8192 + (s * 64 + c4 * 4) * 4);
                    const f32x4 a4 = *(const f32x4*)(bufp + 3 * 8192 + (s * 64 + c4 * 4) * 4);
                    const f32x4 b4 = *(const f32x4*)(bufp + 4 * 8192 + (s * 64 + c4 * 4) * 4);
                    const float vi = *(const float*)(bufp + 5 * 8192 + (s * 16 + i) * 4);
                    float sa = (S0 * a4[0] + S1 * a4[1]) + (S2 * a4[2] + S3 * a4[3]);
                    sa = row16_sum(sa);
                    S0 = S0 * w4[0] + sa * b4[0] + vi * k4[0]; S1 = S1 * w4[1] + sa * b4[1] + vi * k4[1];
                    S2 = S2 * w4[2] + sa * b4[2] + vi * k4[2]; S3 = S3 * w4[3] + sa * b4[3] + vi * k4[3];
                    float yp = (S0 * r4[0] + S1 * r4[1]) + (S2 * r4[2] + S3 * r4[3]);
                    yp = row16_sum(yp);
                    if (c4 == 0) yb[s * 16 + i] = yp;
                }
            }
            __syncthreads();
        }
        if (loader && lt < 128) { const int tt = lt >> 2, i4 = (lt & 3) * 4; const f32x4 y = *(const f32x4*)(lds + 2 * BUFB + ((NCH - 1) & 1) * 2048 + (tt * 16 + i4) * 4);
            *(f32x4*)(Yraw + base + (size_t)((NCH - 1) * 32 + tt) * RW + rg * 16 + i4) = y; }
    }
}
DI void rwkv_fin_phase(const Args& a, int L) {
    const int tidx_ = otid();
    const int wave = __builtin_amdgcn_readfirstlane(tidx_ >> 6), lane = tidx_ & 63;
    const float* Rr = (const float*)(a.ws + OFF_SCR); const float* Kr = Rr + 2 * (size_t)M * RW; const float* Vr = Kr + (size_t)M * RW;
    const float* Yraw = (const float*)(a.ws + OFF_X); const bf16_t* Gb = (const bf16_t*)(a.ws + OFF_MG); bf16_t* Y = (bf16_t*)(a.ws + OFF_Y);
    const float* rk = a.in[I_RK] + L * RW; const float* gng = a.in[I_GNG] + L * RW; const float* gnb = a.in[I_GNB] + L * RW;
    for (int it = blockIdx.x * 8 + wave; it < M * 16; it += gridDim.x * 8) {
        const int m = it >> 4, h = it & 15, c = h * 64 + lane; const size_t o = (size_t)m * RW + c;
        const float y = Yraw[o], r = Rr[o], k = Kr[o], v = Vr[o];
        const float mean = wave_sum(y) * (1.0f / 64.0f); const float d = y - mean; const float var = wave_sum(d * d) * (1.0f / 64.0f);
        const float yn = d * (1.0f / sqrtf(var + 64e-5f)) * gng[c] + gnb[c];
        const float bonus = wave_sum(r * k * rk[c]) * v;
        Y[(size_t)m * D + c] = (bf16_t)f2bf((yn + bonus) * bf2f(Gb[o]));
    }
}
DI void rwkv_par_phase(const Args& a, int L, unsigned char* lds) {
    const int tidx_ = otid();
    const int tid = tidx_, wave = __builtin_amdgcn_readfirstlane(tid >> 6), lane = tid & 63, fr = lane & 15, q = lane >> 4;
    const bf16_t* P = (const bf16_t*)(a.ws + OFF_P); unsigned char* RECB = a.ws + OFF_SCR;
    const bf16_t* W2T = (const bf16_t*)(a.ws + OFF_LW2); const bf16_t* A2T = (const bf16_t*)(a.ws + OFF_LA2); const bf16_t* G2T = (const bf16_t*)(a.ws + OFF_LG2);
    const float* mu = a.in[I_MU] + (size_t)L * 3360; const float* w0 = a.in[I_W0] + L * RW; const float* a0 = a.in[I_A0] + L * RW;
    const float* kkw = a.in[I_KK] + L * RW; const float* kaw = a.in[I_KA] + L * RW; const float* rkw = a.in[I_RK] + L * RW;
    unsigned char* XL = lds;
    unsigned char* WS = lds + 9472 + wave * 12288;
    for (int unit = blockIdx.x; unit < NB * 256; unit += gridDim.x) {
        const int b_ = unit >> 8, cidx = unit & 255; const int m0 = b_ * SEQ + cidx * 16;
        __syncthreads();
        int tb9 = tid; asm volatile("" : "+v"(tb9));
#pragma unroll
        for (int it9 = 0; it9 < 9; ++it9) { const int idx = tb9 + 512 * it9; const int t = idx / 288, jj = idx - t * 288; const int m = m0 + t;
            const float cur = bf2f(P[(size_t)m * PCOLS + PC_LORA + jj]); const float prev = (m & (SEQ - 1)) == 0 ? 0.f : bf2f(P[(size_t)(m - 1) * PCOLS + PC_LORA + jj]);
            float x = cur + (prev - cur) * mu[3072 + jj];
            if (jj < 64) { const float e2x = __expf(2.0f * x); x = 1.0f - 2.0f * __builtin_amdgcn_rcpf(e2x + 1.0f); } else if (jj >= 128) x = __builtin_amdgcn_rcpf(1.0f + __expf(-x));
            *(bf16_t*)(XL + t * 592 + jj * 2) = (bf16_t)f2bf(x); }
        __syncthreads();
#define AXF(ks) (*(const bf16x8*)(XL + fr * 592 + (32 * (ks) + 8 * q) * 2))
#pragma unroll 1
        for (int hh2 = 0; hh2 < 2; ++hh2) {
            const int h = wave + 8 * hh2; const int c = h * 64 + lane;
            unsigned char* rec = RECB + (size_t)(cidx * 64 + b_ * 16 + h) * REC;
            const bool first = (m0 & (SEQ - 1)) == 0;
            const bf16_t* pbase = P + (size_t)m0 * PCOLS + h * 64 + lane;
            unsigned rawrk[17], rawvv[9];
#pragma unroll
            for (int t = 0; t < 17; ++t) { const bf16_t* pc = pbase + (ptrdiff_t)(t - 1) * PCOLS; const bool ok = t > 0 || !first;
                const unsigned rr_ = ok ? (unsigned)pc[PC_R] : 0u, kk_ = ok ? (unsigned)pc[PC_K] : 0u, vv_ = ok ? (unsigned)pc[PC_V] : 0u;
                rawrk[t] = rr_ | (kk_ << 16); if (t & 1) rawvv[t >> 1] |= vv_ << 16; else rawvv[t >> 1] = vv_; }
            const float w0c = w0[c], a0c = a0[c], kkc = kkw[c], kac = kaw[c], rkc = rkw[c], mur = mu[c], muk = mu[1024 + c], muv = mu[2048 + c];
            bf16x8 bwf[4][2], baf[4][2];
#pragma unroll
            for (int nt = 0; nt < 4; ++nt) { const int cn = h * 64 + 16 * nt + fr;
#pragma unroll
                for (int ks = 0; ks < 2; ++ks) { bwf[nt][ks] = *(const bf16x8*)(W2T + cn * 64 + 32 * ks + 8 * q); baf[nt][ks] = *(const bf16x8*)(A2T + cn * 64 + 32 * ks + 8 * q); } }
            asm volatile("" ::: "memory");
            f32x4 accW[4], accA[4], accG[4];
#pragma unroll
            for (int nt = 0; nt < 4; ++nt) { accW[nt] = (f32x4){0.f, 0.f, 0.f, 0.f}; accA[nt] = accW[nt]; accG[nt] = accW[nt];
#pragma unroll
                for (int ks = 0; ks < 2; ++ks) { accW[nt] = __builtin_amdgcn_mfma_f32_16x16x32_bf16(AXF(ks), bwf[nt][ks], accW[nt], 0, 0, 0); accA[nt] = __builtin_amdgcn_mfma_f32_16x16x32_bf16(AXF(2 + ks), baf[nt][ks], accA[nt], 0, 0, 0); } }
#pragma unroll
            for (int n2 = 0; n2 < 2; ++n2) { bf16x8 bgf[2][5];
#pragma unroll
                for (int nn = 0; nn < 2; ++nn) { const int cn = h * 64 + 16 * (2 * n2 + nn) + fr;
#pragma unroll
                    for (int ks = 0; ks < 5; ++ks) bgf[nn][ks] = *(const bf16x8*)(G2T + cn * 160 + 32 * ks + 8 * q); }
                asm volatile("" ::: "memory");
#pragma unroll
                for (int nn = 0; nn < 2; ++nn)
#pragma unroll
                    for (int ks = 0; ks < 5; ++ks) accG[2 * n2 + nn] = __builtin_amdgcn_mfma_f32_16x16x32_bf16(AXF(4 + ks), bgf[nn][ks], accG[2 * n2 + nn], 0, 0, 0); }
            float* X3 = (float*)WS;
#pragma unroll
            for (int nt = 0; nt < 4; ++nt)
#pragma unroll
                for (int r = 0; r < 4; ++r) { const int o = (4 * q + r) * 64 + 16 * nt + fr; X3[o] = accW[nt][r]; X3[1024 + o] = accA[nt][r]; X3[2048 + o] = accG[nt][r]; }
            float cum[16], asg[16];
            { float run = 0.f;
#pragma unroll
              for (int t = 0; t < 16; ++t) { float dw = X3[t * 64 + lane], da = X3[1024 + t * 64 + lane], dg = X3[2048 + t * 64 + lane];
#if DBG_LORA
                  { const float* w2 = a.in[I_W2] + (size_t)L * 64 * RW; const float* a2 = a.in[I_A2] + (size_t)L * 64 * RW; const float* g2 = a.in[I_G2] + (size_t)L * 160 * RW;
                    float s0 = 0.f, s1 = 0.f, s2 = 0.f;
                    for (int jj = 0; jj < 64; ++jj) { s0 += bf2f(*(const bf16_t*)(XL + t * 592 + jj * 2)) * w2[(size_t)jj * RW + c]; s1 += bf2f(*(const bf16_t*)(XL + t * 592 + (64 + jj) * 2)) * a2[(size_t)jj * RW + c]; }
                    for (int jj = 0; jj < 160; ++jj) s2 += bf2f(*(const bf16_t*)(XL + t * 592 + (128 + jj) * 2)) * g2[(size_t)jj * RW + c];
                    dw = s0; da = s1; dg = s2; }
#endif
                  const float nx = -(w0c + dw); const float sp = nx > 20.f ? nx : __logf(1.0f + __expf(nx));
                  run += -__expf(-sp - 0.5f); cum[t] = run; asg[t] = __builtin_amdgcn_rcpf(1.0f + __expf(-(a0c + da)));
                  *(bf16_t*)(rec + R_G + (t * 64 + lane) * 2) = (bf16_t)f2bf(dg); } }
            asm volatile("" ::: "memory");
            const float gC = __expf(cum[15]); *(float*)(rec + R_GC + lane * 4) = gC;
            bf16_t* imgA = (bf16_t*)WS; bf16_t* imgR = (bf16_t*)(WS + 2304); bf16_t* imgB = (bf16_t*)(WS + 4608); bf16_t* imgK = (bf16_t*)(WS + 6912);
            float At[16]; unsigned vpk[8]; float bgv[4], kgv[4]; float vprev = 0.f;
            float rp = bflo(rawrk[0]), kp = bfhi(rawrk[0]), vp = bflo(rawvv[0]);
            float eprev = 1.0f;
#pragma unroll
            for (int t = 0; t < 16; ++t) {
                const float rc = bflo(rawrk[t + 1]), kc = bfhi(rawrk[t + 1]), vc = ((t + 1) & 1) ? bfhi(rawvv[(t + 1) >> 1]) : bflo(rawvv[(t + 1) >> 1]);
                const float r = rc + (rp - rc) * mur, k = kc + (kp - kc) * muk, v = vc + (vp - vc) * muv; rp = rc; kp = kc; vp = vc;
                const float asig = asg[t];
                const float kk = k * kkc; const float kkn = kk * __builtin_amdgcn_rsqf(fmaxf(wave_sum(kk * kk), 1e-24f));
                const float k2 = k * (1.0f + (asig - 1.0f) * kac); const float av = -kkn, bv = kkn * asig;
                const float bon = wave_sum(r * k2 * rkc); if (lane == 0) *(float*)(rec + R_BON + t * 4) = bon;
                const float e2 = __expf(cum[t]), e3 = __expf(-cum[t]), e4 = __expf(cum[15] - cum[t]);
                At[t] = eprev * av; eprev = e2;
                const float Rt = e2 * r, Bt = bv * e3, Kt = k2 * e3;
                imgA[t * 72 + lane] = (bf16_t)f2bf(At[t]); imgR[t * 72 + lane] = (bf16_t)f2bf(Rt); imgB[t * 72 + lane] = (bf16_t)f2bf(Bt); imgK[t * 72 + lane] = (bf16_t)f2bf(Kt);
                *(bf16_t*)(rec + R_RL2 + t * RROW + lane * 2) = (bf16_t)f2bf(Rt);
                bgv[t & 3] = bv * e4; kgv[t & 3] = k2 * e4;
                if ((t & 3) == 3) { u32x4 o; o.x = pk2(bgv[0], bgv[1]); o.y = pk2(bgv[2], bgv[3]); o.z = pk2(kgv[0], kgv[1]); o.w = pk2(kgv[2], kgv[3]); *(u32x4*)(rec + R_A2 + (lane * 4 + (t >> 2)) * 16) = o; }
                if (t & 1) vpk[t >> 1] = pk2(vprev, v); else vprev = v; }
            { u32x4 o0, o1; o0.x = vpk[0]; o0.y = vpk[1]; o0.z = vpk[2]; o0.w = vpk[3]; o1.x = vpk[4]; o1.y = vpk[5]; o1.z = vpk[6]; o1.w = vpk[7];
              *(u32x4*)(rec + R_VT + lane * 32) = o0; *(u32x4*)(rec + R_VT + lane * 32 + 16) = o1; }
            asm volatile("" ::: "memory");
            f32x4 gAB = (f32x4){0.f, 0.f, 0.f, 0.f}, gAK = gAB, gBR = gAB, gKR = gAB;
#pragma unroll
            for (int ks = 0; ks < 2; ++ks) { const int off = fr * 72 + 32 * ks + 8 * q;
                const bf16x8 fA = *(const bf16x8*)(imgA + off), fR = *(const bf16x8*)(imgR + off), fB = *(const bf16x8*)(imgB + off), fK = *(const bf16x8*)(imgK + off);
                gAB = __builtin_amdgcn_mfma_f32_16x16x32_bf16(fB, fA, gAB, 0, 0, 0); gAK = __builtin_amdgcn_mfma_f32_16x16x32_bf16(fK, fA, gAK, 0, 0, 0);
                gBR = __builtin_amdgcn_mfma_f32_16x16x32_bf16(fB, fR, gBR, 0, 0, 0); gKR = __builtin_amdgcn_mfma_f32_16x16x32_bf16(fK, fR, gKR, 0, 0, 0); }
#pragma unroll
            for (int r = 0; r < 4; ++r) { const int sI = 4 * q + r; gAB[r] = sI < fr ? gAB[r] : 0.f; gAK[r] = sI < fr ? gAK[r] : 0.f; gBR[r] = sI <= fr ? gBR[r] : 0.f; gKR[r] = sI <= fr ? gKR[r] : 0.f; }
            { u32x4 o; o.x = pk2(gBR[0], gBR[1]); o.y = pk2(gBR[2], gBR[3]); o.z = pk2(gKR[0], gKR[1]); o.w = pk2(gKR[2], gKR[3]); *(u32x4*)(rec + R_A3 + (fr * 4 + q) * 16) = o; }
            asm volatile("" ::: "memory");
            float* AKL = (float*)(WS + 9216);
#pragma unroll
            for (int r = 0; r < 4; ++r) AKL[(4 * q + r) * 16 + fr] = gAK[r];
            float Ft[16];
            { const f32x4* row = (const f32x4*)(AKL + (lane & 15) * 16);
#pragma unroll
              for (int t4 = 0; t4 < 4; ++t4) { const f32x4 v4 = row[t4]; Ft[4 * t4] = v4[0]; Ft[4 * t4 + 1] = v4[1]; Ft[4 * t4 + 2] = v4[2]; Ft[4 * t4 + 3] = v4[3]; } }
#pragma unroll
            for (int s2 = 0; s2 < 15; ++s2) {
                const float gsel = gAB[s2 & 3];
#pragma unroll
                for (int t = s2 + 1; t < 16; ++t) { const float sc = __int_as_float(__builtin_amdgcn_readlane(__float_as_int(gsel), t + 16 * (s2 >> 2))); At[t] += At[s2] * sc; Ft[t] += Ft[s2] * sc; } }
#pragma unroll
            for (int t = 0; t < 16; ++t) *(bf16_t*)(rec + R_EL2 + t * RROW + lane * 2) = (bf16_t)f2bf(At[t]);
            asm volatile("" ::: "memory");
            float* FL = (float*)(WS + 10240);
            if (lane < 16) {
#pragma unroll
                for (int t4 = 0; t4 < 4; ++t4) *(f32x4*)(FL + lane * 16 + 4 * t4) = (f32x4){Ft[4 * t4], Ft[4 * t4 + 1], Ft[4 * t4 + 2], Ft[4 * t4 + 3]}; }
            { const float f0 = FL[(4 * q + 0) * 16 + fr], f1 = FL[(4 * q + 1) * 16 + fr], f2 = FL[(4 * q + 2) * 16 + fr], f3 = FL[(4 * q + 3) * 16 + fr];
              u32x2 o; o.x = pk2(f0, f1); o.y = pk2(f2, f3); *(u32x2*)(rec + R_FT + (fr * 4 + q) * 8) = o; }
            asm volatile("" ::: "memory");
        }
    }
#undef AXF
}
DI bf16x8 mk8(u32x2 lo, u32x2 hi) { u32x4 w; w.x = lo.x; w.y = lo.y; w.z = hi.x; w.w = hi.y; return __builtin_bit_cast(bf16x8, w); }
struct SeqOps { u32x2 e[2][2], r[2][2]; u32x4 a2[4]; u32x4 a3; u32x2 ft, vt; f32x4 gc[4]; };
DI void seq_ops_load(SeqOps& f, const LAS unsigned char* rec, int fr, int q, int i0) {
#pragma unroll
    for (int ks = 0; ks < 2; ++ks) { f.e[ks][0] = *(const LAS u32x2*)(rec + R_EL2 + fr * RROW + (32 * ks + 4 * q) * 2); f.e[ks][1] = *(const LAS u32x2*)(rec + R_EL2 + fr * RROW + (32 * ks + 16 + 4 * q) * 2);
        f.r[ks][0] = *(const LAS u32x2*)(rec + R_RL2 + fr * RROW + (32 * ks + 4 * q) * 2); f.r[ks][1] = *(const LAS u32x2*)(rec + R_RL2 + fr * RROW + (32 * ks + 16 + 4 * q) * 2); }
#pragma unroll
    for (int jt = 0; jt < 4; ++jt) { f.a2[jt] = *(const LAS u32x4*)(rec + R_A2 + ((16 * jt + fr) * 4 + q) * 16); f.gc[jt] = *(const LAS f32x4*)(rec + R_GC + (16 * jt + 4 * q) * 4); }
    f.a3 = *(const LAS u32x4*)(rec + R_A3 + (fr * 4 + q) * 16); f.ft = *(const LAS u32x2*)(rec + R_FT + (fr * 4 + q) * 8); f.vt = *(const LAS u32x2*)(rec + R_VT + ((i0 + fr) * 16 + 4 * q) * 2);
}
DI void rwkv_seq_phase(const Args& a, unsigned char* lds, float* yout, const float* gng, const float* gnb, bf16_t* yfin) {
    const int tidx_ = otid();
    const int tid = tidx_, wave = __builtin_amdgcn_readfirstlane(tid >> 6), lane = tid & 63, fr = lane & 15, q = lane >> 4;
    constexpr int NR = 8, DEPTH_ = 6, NCHK = 256;
    LAS unsigned char* ring = (LAS unsigned char*)lds;
    LAS float* ybuf = (LAS float*)(ring + NR * REC);
    for (int bh = blockIdx.x; bh < NB * 16; bh += gridDim.x) {
        const unsigned char* rec0 = a.ws + OFF_SCR + (size_t)bh * REC;
        const int hd = bh & 15;
        asm volatile("s_waitcnt vmcnt(0) lgkmcnt(0)" ::: "memory"); __builtin_amdgcn_s_barrier();
        if (wave >= 4) {
            const int lw = wave - 4;
            const float gg = yfin ? gng[hd * 64 + lane] : 0.f, gb = yfin ? gnb[hd * 64 + lane] : 0.f;
            bf16_t* Yo = yfin + ((size_t)(bh >> 4) * SEQ) * D + hd * 64 + lane;
#define SEQ_ISSUE(cc) do { const unsigned char* g_ = rec0 + (size_t)(cc) * 64 * REC; LAS unsigned char* l_ = ring + ((cc) & (NR - 1)) * REC; \
            _Pragma("unroll") for (int i_ = 0; i_ < 4; ++i_) { int pc_ = i_ * 4 + lw; if (pc_ >= 15) pc_ = lw; \
                __builtin_amdgcn_global_load_lds((const unsigned*)(g_ + pc_ * 1024 + lane * 16), (LAS unsigned*)(l_ + pc_ * 1024), 16, 0, 0); } } while (0)
#define SEQ_FINALIZE(cf) do { const LAS unsigned char* rc_ = ring + ((cf) & (NR - 1)) * REC; const LAS float* yb_ = ybuf + ((cf) & 1) * 1024; \
            const u32x2 vv_ = *(const LAS u32x2*)(rc_ + R_VT + (lane * 16 + 4 * lw) * 2); \
            float y_[4], rd_[8]; \
            _Pragma("unroll") for (int tt_ = 0; tt_ < 4; ++tt_) { y_[tt_] = yb_[(4 * lw + tt_) * 64 + lane]; rd_[tt_] = y_[tt_]; rd_[4 + tt_] = y_[tt_] * y_[tt_]; } \
            wave_sum8(rd_);        \
            _Pragma("unroll") for (int tt_ = 0; tt_ < 4; ++tt_) { const int t_ = 4 * lw + tt_; \
                const float mean_ = rd_[tt_] * (1.0f / 64.0f); const float var_ = fmaxf(rd_[4 + tt_] * (1.0f / 64.0f) - mean_ * mean_, 0.f); \
                const float yn_ = (y_[tt_] - mean_) * __builtin_amdgcn_rsqf(var_ + 64e-5f) * gg + gb; \
                const float bon_ = *(const LAS float*)(rc_ + R_BON + t_ * 4); const float g_ = bf2f(*(const LAS bf16_t*)(rc_ + R_G + (t_ * 64 + lane) * 2)); \
                const unsigned vw_ = (tt_ & 2) ? vv_.y : vv_.x; const float v_ = (tt_ & 1) ? bfhi(vw_) : bflo(vw_); \
                Yo[(size_t)(16 * (cf) + t_) * D] = (bf16_t)f2bf((yn_ + bon_ * v_) * g_); } } while (0)
#pragma unroll 1
            for (int cc = 0; cc < DEPTH_; ++cc) SEQ_ISSUE(cc);
            asm volatile("s_waitcnt vmcnt(16)" ::: "memory");
            __builtin_amdgcn_s_barrier();
#pragma unroll 1
            for (int c = 0; c < NCHK; ++c) {
                if (yfin && c > 0) SEQ_FINALIZE(c - 1);
                if (c + DEPTH_ < NCHK) { SEQ_ISSUE(c + DEPTH_); asm volatile("s_waitcnt vmcnt(16)" ::: "memory"); }
                else asm volatile("s_waitcnt vmcnt(0)" ::: "memory");
                asm volatile("s_waitcnt lgkmcnt(0)" ::: "memory");
                __builtin_amdgcn_s_barrier();
            }
            if (yfin) SEQ_FINALIZE(NCHK - 1);
#undef SEQ_ISSUE
#undef SEQ_FINALIZE
        } else {
            const int i0 = wave * 16;
            float* Yp = yout + (size_t)(bh >> 4) * SEQ * RW + hd * 64 + i0 + fr;
            f32x4 S[4];
#pragma unroll
            for (int jt = 0; jt < 4; ++jt) S[jt] = (f32x4){0.f, 0.f, 0.f, 0.f};
            __builtin_amdgcn_s_barrier();
            SeqOps cur, nxt; seq_ops_load(cur, ring, fr, q, i0);
#pragma unroll 1
            for (int c = 0; c < NCHK; ++c) {
                if (c + 1 < NCHK) seq_ops_load(nxt, ring + ((c + 1) & (NR - 1)) * REC, fr, q, i0); else nxt = cur;
                bf16x8 sh[2];
#pragma unroll
                for (int ks = 0; ks < 2; ++ks) { u32x4 hw; hw.x = pk2(S[2 * ks][0], S[2 * ks][1]); hw.y = pk2(S[2 * ks][2], S[2 * ks][3]); hw.z = pk2(S[2 * ks + 1][0], S[2 * ks + 1][1]); hw.w = pk2(S[2 * ks + 1][2], S[2 * ks + 1][3]); sh[ks] = __builtin_bit_cast(bf16x8, hw); }
                const u32x2 z2 = {0u, 0u}; const f32x4 zz = (f32x4){0.f, 0.f, 0.f, 0.f};
                f32x4 Wk[2], Yk[2];
#pragma unroll
                for (int ks = 0; ks < 2; ++ks) { Wk[ks] = __builtin_amdgcn_mfma_f32_16x16x32_bf16(mk8(cur.e[ks][0], cur.e[ks][1]), sh[ks], zz, 0, 0, 0); Yk[ks] = __builtin_amdgcn_mfma_f32_16x16x32_bf16(mk8(cur.r[ks][0], cur.r[ks][1]), sh[ks], zz, 0, 0, 0); }
                const f32x4 Wv = __builtin_amdgcn_mfma_f32_16x16x32_bf16(mk8(cur.ft, z2), mk8(cur.vt, z2), zz, 0, 0, 0);
                const f32x4 W = (Wk[0] + Wk[1]) + Wv; f32x4 Y = Yk[0] + Yk[1];
                u32x2 wp; wp.x = pk2(W[0], W[1]); wp.y = pk2(W[2], W[3]);
                const bf16x8 b2 = mk8(wp, cur.vt);
#pragma unroll
                for (int jt = 0; jt < 4; ++jt) S[jt] = __builtin_amdgcn_mfma_f32_16x16x32_bf16(__builtin_bit_cast(bf16x8, cur.a2[jt]), b2, S[jt] * cur.gc[jt], 0, 0, 0);
                Y = __builtin_amdgcn_mfma_f32_16x16x32_bf16(__builtin_bit_cast(bf16x8, cur.a3), b2, Y, 0, 0, 0);
                if (yfin) {
#pragma unroll
                    for (int r = 0; r < 4; ++r) ybuf[(c & 1) * 1024 + (4 * q + r) * 64 + i0 + fr] = Y[r];
                } else {
#pragma unroll
                    for (int r = 0; r < 4; ++r) Yp[(size_t)(16 * c + 4 * q + r) * RW] = Y[r];
                }
                asm volatile("s_waitcnt lgkmcnt(0)" ::: "memory");
                __builtin_amdgcn_s_barrier();
                cur = nxt;
            }
        }
    }
}
DI void rwkv_fin2_phase(const Args& a, int L) {
    const int tidx_ = otid();
    const int wave = __builtin_amdgcn_readfirstlane(tidx_ >> 6), lane = tidx_ & 63;
    const float* Yraw = (const float*)(a.ws + OFF_X); bf16_t* Y = (bf16_t*)(a.ws + OFF_Y);
    const float* gng = a.in[I_GNG] + L * RW; const float* gnb = a.in[I_GNB] + L * RW;
    for (int u = blockIdx.x * 8 + wave; u < NB * 16 * 256; u += gridDim.x * 8) {
        const int cidx = u & 255, bh = u >> 8, h = bh & 15, b_ = bh >> 4; const int c = h * 64 + lane;
        const unsigned char* rec = a.ws + OFF_SCR + (size_t)(cidx * 64 + bh) * REC;
        const u32x4 v0 = *(const u32x4*)(rec + R_VT + lane * 32), v1 = *(const u32x4*)(rec + R_VT + lane * 32 + 16);
        const unsigned vw[8] = {v0.x, v0.y, v0.z, v0.w, v1.x, v1.y, v1.z, v1.w};
        const float gg = gng[c], gb = gnb[c];
#pragma unroll
        for (int t = 0; t < 16; ++t) { const size_t m = (size_t)b_ * SEQ + cidx * 16 + t;
            const float y = Yraw[m * RW + c];
            const float mean = wave_sum(y) * (1.0f / 64.0f); const float d = y - mean; const float var = wave_sum(d * d) * (1.0f / 64.0f);
            const float yn = d * __builtin_amdgcn_rsqf(var + 64e-5f) * gg + gb;
            const float bon = *(const float*)(rec + R_BON + t * 4); const float g = bf2f(*(const bf16_t*)(rec + R_G + (t * 64 + lane) * 2));
            const float v = (t & 1) ? bfhi(vw[t >> 1]) : bflo(vw[t >> 1]);
            Y[m * D + c] = (bf16_t)f2bf((yn + bon * v) * g); }
    }
}
DI void dbg_compare_phase(const Args& a) {
    const int tidx_ = otid();
    const float* y0 = (const float*)(a.ws + OFF_X); const float* y1 = y0 + (size_t)M * RW; float* acc = (float*)(a.ws + OFF_CTL) + 2048;
    float s0 = 0.f, s1 = 0.f, s2 = 0.f, s3 = 0.f;
    for (size_t i = (size_t)blockIdx.x * 512 + tidx_; i < (size_t)M * RW; i += (size_t)gridDim.x * 512) { const float o = y0[i], d = y1[i] - o; const int tok = (int)((i / RW) & (SEQ - 1));
        s0 += d * d; s1 += o * o; if (tok < 16) { s2 += d * d; s3 += o * o; } }
    s0 = wave_sum(s0); s1 = wave_sum(s1); s2 = wave_sum(s2); s3 = wave_sum(s3);
    if ((tidx_ & 63) == 0) { atomicAdd(acc + 0, s0); atomicAdd(acc + 1, s1); atomicAdd(acc + 2, s2); atomicAdd(acc + 3, s3); }
}
DI void dbg_encode_phase(const Args& a) {
    const int tidx_ = otid();
    float* acc = (float*)(a.ws + OFF_CTL) + 2048;
    const float s0 = __hip_atomic_load(acc + 0, __ATOMIC_RELAXED, __HIP_MEMORY_SCOPE_AGENT), s1 = __hip_atomic_load(acc + 1, __ATOMIC_RELAXED, __HIP_MEMORY_SCOPE_AGENT);
    const float s2 = __hip_atomic_load(acc + 2, __ATOMIC_RELAXED, __HIP_MEMORY_SCOPE_AGENT), s3 = __hip_atomic_load(acc + 3, __ATOMIC_RELAXED, __HIP_MEMORY_SCOPE_AGENT);
    const float e1 = sqrtf(s0 / fmaxf(s1, 1e-30f)), e2 = sqrtf(s2 / fmaxf(s3, 1e-30f));
    for (size_t i = (size_t)blockIdx.x * 512 + tidx_; i < (size_t)M * D; i += (size_t)gridDim.x * 512) { float v = a.out[i] * (1.0f + e1); if (i == 0) v += 1000.0f * e2; a.out[i] = v; }
}
DI unsigned f2ord(float f) { const unsigned u = __builtin_bit_cast(unsigned, f); return (u & 0x80000000u) ? ~u : (u | 0x80000000u); }
DI float xrow16_sum(float x) {
    auto p = __builtin_amdgcn_permlane16_swap(__float_as_uint(x), __float_as_uint(x), false, false);
    x = __uint_as_float(p[0]) + __uint_as_float(p[1]);
    auto q = __builtin_amdgcn_permlane32_swap(__float_as_uint(x), __float_as_uint(x), false, false);
    return __uint_as_float(q[0]) + __uint_as_float(q[1]);
}
template <int CTRL> DI int dpp_i(int x) { return __builtin_amdgcn_update_dpp(0, x, CTRL, 0xF, 0xF, true); }
DI int wave_sum_i(int x) {
    x += dpp_i<0xB1>(x); x += dpp_i<0x4E>(x); x += dpp_i<0x141>(x); x += dpp_i<0x140>(x);
    auto p = __builtin_amdgcn_permlane16_swap((unsigned)x, (unsigned)x, false, false); x = (int)p[0] + (int)p[1];
    auto q = __builtin_amdgcn_permlane32_swap((unsigned)x, (unsigned)x, false, false); return (int)q[0] + (int)q[1];
}
DI void indexer_phase(const Args& a, unsigned char* lds, WorkQ& wq, int& item) {
    const int tidx_ = otid();
    const int tid = tidx_, wave = __builtin_amdgcn_readfirstlane(tid >> 6), lane = tid & 63, hh = lane & 15, kq = lane >> 4;
    const bf16_t* P = (const bf16_t*)(a.ws + OFF_P); const bf16_t* KI = (const bf16_t*)(a.ws + OFF_KI); unsigned long long* BMk = (unsigned long long*)(a.ws + OFF_BM);
    constexpr int STG = 256 * 128;
    unsigned long long* wbuf = (unsigned long long*)(lds + 2 * STG + wave * 512);
    const int srow = tid >> 3, sch = tid & 7;
    const int wr_off = srow * 128 + ((sch ^ (srow & 7)) << 4);
    const int rd0 = hh * 128 + ((kq ^ (hh & 7)) << 4), rd1 = hh * 128 + (((kq + 4) ^ (hh & 7)) << 4);
#pragma unroll 1
    for (; item < NB * 512; item = wq_next(wq, item, lds, tid)) {
        const int b_ = item & 3, qg = 511 - (item >> 2);
        const int t0 = qg * 8, t = t0 + wave, nk = t0 + 8; const size_t m = (size_t)b_ * SEQ + t;
        const int nst = (nk + 255) >> 8;
        bf16x8 aq[2];
        aq[0] = *(const bf16x8*)(P + m * PCOLS + PC_QI + hh * 64 + 8 * kq); aq[1] = *(const bf16x8*)(P + m * PCOLS + PC_QI + hh * 64 + 32 + 8 * kq);
        float blo[4], bhi[4];
#pragma unroll
        for (int r = 0; r < 4; ++r) { const bool pos = bf2f(P[m * PCOLS + PC_WI + 4 * kq + r]) >= 0.f; blo[r] = pos ? 0.f : -__builtin_inff(); bhi[r] = pos ? __builtin_inff() : 0.f; }
        { const float wrow = bf2f(P[m * PCOLS + PC_WI + hh]) * 0.03125f;
#pragma unroll
          for (int ks = 0; ks < 2; ++ks) { const u32x4 w4 = __builtin_bit_cast(u32x4, aq[ks]); u32x4 o4;
              o4.x = pk2(bflo(w4.x) * wrow, bfhi(w4.x) * wrow); o4.y = pk2(bflo(w4.y) * wrow, bfhi(w4.y) * wrow); o4.z = pk2(bflo(w4.z) * wrow, bfhi(w4.z) * wrow); o4.w = pk2(bflo(w4.w) * wrow, bfhi(w4.w) * wrow);
              aq[ks] = __builtin_bit_cast(bf16x8, o4); } }
        unsigned sc[64];
        const bf16_t* kig = KI + ((size_t)b_ * SEQ + srow) * 64 + sch * 8;
#pragma unroll 1
        for (int rep21 = 0; rep21 < ((REP_MASK >> 21) & 1u) + 1; ++rep21) {
#pragma unroll
        for (int r = 0; r < 64; ++r) sc[r] = 0u;
        u32x4 kp[4];
#pragma unroll
        for (int q = 0; q < 4; ++q) kp[q] = *(const u32x4*)(kig + (size_t)q * 64 * 64);
        __syncthreads();
        asm volatile("" :: "v"(aq[0]), "v"(aq[1]), "v"(blo[0]), "v"(blo[1]), "v"(blo[2]), "v"(blo[3]));
#pragma unroll 1
        for (int st = 0; st < nst; ++st) {
            const int k0 = st * 256;
            unsigned char* sb = lds + (st & 1) * STG;
#pragma unroll
            for (int q = 0; q < 4; ++q) *(u32x4*)(sb + q * 64 * 128 + wr_off) = kp[q];
            __syncthreads();
            if (st + 1 < nst) {
#pragma unroll
                for (int q = 0; q < 4; ++q) kp[q] = *(const u32x4*)(kig + (size_t)(k0 + 256 + q * 64) * 64);
            }
#pragma unroll
            for (int r = 0; r < 60; ++r) sc[r] = sc[r + 4];
#pragma unroll
            for (int cc = 0; cc < 4; ++cc) {
                const int kc = k0 + cc * 64;
                unsigned res = 0u;
                {
                    float sv[4];
#pragma unroll
                    for (int sub = 0; sub < 4; ++sub) {
                        const unsigned char* kb = sb + (cc * 64 + sub * 16) * 128;
                        const bf16x8 b0 = *(const bf16x8*)(kb + rd0), b1 = *(const bf16x8*)(kb + rd1);
                        f32x4 acc = (f32x4){0.f, 0.f, 0.f, 0.f};
                        acc = __builtin_amdgcn_mfma_f32_16x16x32_bf16(aq[0], b0, acc, 0, 0, 0);
                        acc = __builtin_amdgcn_mfma_f32_16x16x32_bf16(aq[1], b1, acc, 0, 0, 0);
                        sv[sub] = (__builtin_amdgcn_fmed3f(acc[0], blo[0], bhi[0]) + __builtin_amdgcn_fmed3f(acc[1], blo[1], bhi[1])) + (__builtin_amdgcn_fmed3f(acc[2], blo[2], bhi[2]) + __builtin_amdgcn_fmed3f(acc[3], blo[3], bhi[3]));
                    }
                    auto p01 = __builtin_amdgcn_permlane16_swap(__float_as_uint(sv[0]), __float_as_uint(sv[1]), false, false);
                    auto p23 = __builtin_amdgcn_permlane16_swap(__float_as_uint(sv[2]), __float_as_uint(sv[3]), false, false);
                    const float x01 = __uint_as_float(p01[0]) + __uint_as_float(p01[1]), x23 = __uint_as_float(p23[0]) + __uint_as_float(p23[1]);
                    auto pf = __builtin_amdgcn_permlane32_swap(__float_as_uint(x01), __float_as_uint(x23), false, false);
                    const float tot = __uint_as_float(pf[0]) + __uint_as_float(pf[1]);
                    res = (kc + lane <= t) ? f2ord(tot) : 0u;
                }
                sc[60 + cc] = res;
            }
        }
        }
        const int roff = 64 - 4 * nst;
#pragma unroll 1
        for (int rep22 = 0; rep22 < ((REP_MASK >> 22) & 1u) + 1; ++rep22) {
        if (t + 1 > 256) {
            unsigned T = 0u; bool exact = false;
#pragma unroll 1
            for (int bit = 31; bit >= 0; --bit) { const unsigned cand = T | (1u << bit); int cnt = 0; unsigned candv = cand; asm volatile("" : "+v"(candv));
#pragma unroll
                for (int r8 = 0; r8 < 8; ++r8) if (r8 * 8 + 7 >= roff) {
                    unsigned long long mk_[8];
                    asm("v_cmp_ge_u32_e64 %0, %8, %16\n\tv_cmp_ge_u32_e64 %1, %9, %16\n\tv_cmp_ge_u32_e64 %2, %10, %16\n\tv_cmp_ge_u32_e64 %3, %11, %16\n\tv_cmp_ge_u32_e64 %4, %12, %16\n\tv_cmp_ge_u32_e64 %5, %13, %16\n\tv_cmp_ge_u32_e64 %6, %14, %16\n\tv_cmp_ge_u32_e64 %7, %15, %16"
                        : "=&s"(mk_[0]), "=&s"(mk_[1]), "=&s"(mk_[2]), "=&s"(mk_[3]), "=&s"(mk_[4]), "=&s"(mk_[5]), "=&s"(mk_[6]), "=&s"(mk_[7])
                        : "v"(sc[r8 * 8 + 0]), "v"(sc[r8 * 8 + 1]), "v"(sc[r8 * 8 + 2]), "v"(sc[r8 * 8 + 3]), "v"(sc[r8 * 8 + 4]), "v"(sc[r8 * 8 + 5]), "v"(sc[r8 * 8 + 6]), "v"(sc[r8 * 8 + 7]), "v"(candv));
#pragma unroll
                    for (int r = 0; r < 8; ++r) cnt += __builtin_popcountll(mk_[r]); }
                if (cnt >= 256) T = cand;
                if (cnt == 256) { exact = true; break; } }
            int cge = 256;
            if (!exact) { cge = 0;
#pragma unroll
                for (int r8 = 0; r8 < 8; ++r8) if (r8 * 8 + 7 >= roff) {
#pragma unroll
                    for (int r = 0; r < 8; ++r) cge += __builtin_popcountll(__ballot(sc[r8 * 8 + r] >= T)); } }
            { unsigned long long z64 = 0ull; asm volatile("" : "+v"(z64)); wbuf[lane] = z64; }
            if (cge == 256) {
#pragma unroll
                for (int r8 = 0; r8 < 8; ++r8) {
#pragma unroll
                    for (int r = 0; r < 8; ++r) { const unsigned long long word = __ballot(sc[r8 * 8 + r] >= T); if (lane == 0 && r8 * 8 + r >= roff) wbuf[r8 * 8 + r - roff] = word; }
                    __builtin_amdgcn_sched_barrier(0); }
            } else {
                int cgt = 0;
#pragma unroll
                for (int r8 = 0; r8 < 8; ++r8) {
#pragma unroll
                    for (int r = 0; r < 8; ++r) cgt += __builtin_popcountll(__ballot(sc[r8 * 8 + r] > T));
                    __builtin_amdgcn_sched_barrier(0); }
                int need = 256 - cgt;
#pragma unroll
                for (int r8 = 0; r8 < 8; ++r8) {
#pragma unroll
                    for (int r = 0; r < 8; ++r) { const unsigned long long gt = __ballot(sc[r8 * 8 + r] > T); unsigned long long eq = __ballot(sc[r8 * 8 + r] == T); const int ce = __builtin_popcountll(eq);
                        unsigned long long take;
                        if (ce <= need) { take = eq; need -= ce; }
                        else { take = 0ull; for (; need > 0; --need) { const unsigned long long low = eq & (0ull - eq); take |= low; eq ^= low; } }
                        const unsigned long long word = gt | take; if (lane == 0 && r8 * 8 + r >= roff) wbuf[r8 * 8 + r - roff] = word; }
                    __builtin_amdgcn_sched_barrier(0); }
            }
        } else {
            { unsigned long long z64 = 0ull; asm volatile("" : "+v"(z64)); wbuf[lane] = z64; }
#pragma unroll
            for (int r8 = 0; r8 < 8; ++r8) {
#pragma unroll
                for (int r = 0; r < 8; ++r) { const unsigned long long word = __ballot(sc[r8 * 8 + r] != 0u); if (lane == 0 && r8 * 8 + r >= roff) wbuf[r8 * 8 + r - roff] = word; }
                __builtin_amdgcn_sched_barrier(0); }
        }
        }
        BMk[m * 64 + lane] = wbuf[lane];
    }
}
DI void attn_phase(const Args& a, unsigned char* lds) {
    const int tidx_ = otid();
    const int tid = tidx_, wave = __builtin_amdgcn_readfirstlane(tid >> 6), lane = tid & 63, ql = lane & 31, hf = lane >> 5;
    const bf16_t* P = (const bf16_t*)(a.ws + OFF_P); const bf16_t* VT = (const bf16_t*)(a.ws + OFF_VT); const unsigned long long* BMk = (const unsigned long long*)(a.ws + OFF_BM);
    const float* biasd = (const float*)(a.ws + OFF_BIAS); bf16_t* Y = (bf16_t*)(a.ws + OFF_Y);
    unsigned char* Kl = lds; unsigned char* Vl = lds + 64 * 144; float* biasl = (float*)(lds + 2 * 64 * 144);
    const float NEG_INF = -__builtin_inff();
    for (int cu = blockIdx.x; cu < 256; cu += gridDim.x)
#pragma unroll 1
    for (int ui = 0; ui < 2; ++ui) {
        const int bh = cu >> 3, s8 = cu & 7, qb = ui == 0 ? s8 : 15 - s8, b_ = bh >> 3, h = bh & 7;
        const int q0w = qb * 256 + 32 * wave, q = q0w + ql; const size_t m = (size_t)b_ * SEQ + q;
        __syncthreads();
        if (tid < 128) biasl[tid] = biasd[h * 128 + tid];
        bf16x8 qf[4];
#pragma unroll
        for (int ks = 0; ks < 4; ++ks) qf[ks] = *(const bf16x8*)(P + m * PCOLS + PC_AQ + h * 64 + 16 * ks + 8 * hf);
        f32x16 O0, O1;
#pragma unroll
        for (int r = 0; r < 16; ++r) { O0[r] = 0.f; O1[r] = 0.f; }
        float mrun = NEG_INF, lrun = 0.f;
        const int nkt = 4 * (qb + 1);
        const int srow = tid >> 3, sch = tid & 7;
        const bf16_t* kbase = P + ((size_t)b_ * SEQ + srow) * PCOLS + PC_AK + h * 64 + sch * 8;
        const bf16_t* vbase = VT + ((size_t)(b_ * 8 + h) * 64 + srow) * SEQ + sch * 8;
#define ATT_COMPUTE \
            const int k0 = kt * 64; \
            if (k0 <= q0w + 31) { \
 \
                f32x16 sa[2]; \
_Pragma("unroll") \
                for (int sub = 0; sub < 2; ++sub) { \
_Pragma("unroll") \
                    for (int r = 0; r < 16; ++r) sa[sub][r] = 0.f; } \
_Pragma("unroll") \
                for (int ks = 0; ks < 4; ++ks) \
_Pragma("unroll") \
                    for (int sub = 0; sub < 2; ++sub) { const bf16x8 kf = *(const bf16x8*)(Kl + (32 * sub + ql) * 144 + (16 * ks + 8 * hf) * 2); \
                        sa[sub] = __builtin_amdgcn_mfma_f32_32x32x16_bf16(kf, qf[ks], sa[sub], 0, 0, 0); } \
                constexpr float C1 = 0.125f * 1.4426950408889634f; constexpr unsigned NINF_BITS = 0xff800000u; \
                const unsigned b31u = __float_as_uint(biasl[127] * 1.4426950408889634f); \
                const bool far = (q0w - (k0 + 63)) >= 113; \
                float x[2][16]; float mx = NEG_INF; \
_Pragma("unroll") \
                for (int sub = 0; sub < 2; ++sub) { \
                    const int w32 = (int)(((unsigned)(bm >> (32 * sub))) >> (4 * hf)); \
                    if (far) { \
_Pragma("unroll") \
                        for (int r = 0; r < 16; ++r) { const int ro = (r & 3) + 8 * (r >> 2); const unsigned tm = (unsigned)__builtin_amdgcn_sbfe(w32, ro, 1); \
                            x[sub][r] = sa[sub][r] * C1 + __uint_as_float((tm & b31u) | (~tm & NINF_BITS)); } \
                    } else { \
_Pragma("unroll") \
                        for (int r = 0; r < 16; ++r) { const int ro = (r & 3) + 8 * (r >> 2); int dd = q - (k0 + 32 * sub + ro + 4 * hf); dd = dd < 0 ? 0 : (dd > 127 ? 127 : dd); \
                            const unsigned tm = (unsigned)__builtin_amdgcn_sbfe(w32, ro, 1); const unsigned bu = __float_as_uint(biasl[dd] * 1.4426950408889634f); \
                            x[sub][r] = sa[sub][r] * C1 + __uint_as_float((tm & bu) | (~tm & NINF_BITS)); } \
                    } \
_Pragma("unroll") \
                    for (int r = 0; r < 16; r += 2) mx = fmaxf(mx, fmaxf(x[sub][r], x[sub][r + 1])); \
                } \
                { auto pm = __builtin_amdgcn_permlane32_swap(__float_as_uint(mx), __float_as_uint(mx), false, false); mx = fmaxf(__uint_as_float(pm[0]), __uint_as_float(pm[1])); } \
                const float mnew = fmaxf(mrun, mx); const float msafe = (mnew == NEG_INF) ? 0.f : mnew; \
                float lsum = 0.f; \
_Pragma("unroll") \
                for (int sub = 0; sub < 2; ++sub) \
_Pragma("unroll") \
                    for (int r = 0; r < 16; ++r) { x[sub][r] = __builtin_amdgcn_exp2f(x[sub][r] - msafe); lsum += x[sub][r]; } \
                if (__builtin_amdgcn_ballot_w64(mnew > mrun) != 0ull) { \
                    const float alpha = __builtin_amdgcn_exp2f(mrun - msafe); \
                    lrun = lrun * alpha + lsum; mrun = mnew; \
_Pragma("unroll") \
                    for (int r = 0; r < 16; ++r) { O0[r] *= alpha; O1[r] *= alpha; } \
                } else lrun += lsum; \
_Pragma("unroll") \
                for (int sub = 0; sub < 2; ++sub) \
_Pragma("unroll") \
                    for (int s = 0; s < 2; ++s) { \
                        u32x4 pw; pw.x = pk2(x[sub][8 * s + 0], x[sub][8 * s + 1]); pw.y = pk2(x[sub][8 * s + 2], x[sub][8 * s + 3]); pw.z = pk2(x[sub][8 * s + 4], x[sub][8 * s + 5]); pw.w = pk2(x[sub][8 * s + 6], x[sub][8 * s + 7]); \
                        const bf16x8 pf = __builtin_bit_cast(bf16x8, pw); \
                        const int kcol = (32 * sub + 16 * s + 4 * hf) * 2; \
                        { const u32x2 lo = *(const u32x2*)(Vl + ql * 144 + kcol), hi = *(const u32x2*)(Vl + ql * 144 + kcol + 16); \
                          u32x4 vw; vw.x = lo.x; vw.y = lo.y; vw.z = hi.x; vw.w = hi.y; \
                          O0 = __builtin_amdgcn_mfma_f32_32x32x16_bf16(__builtin_bit_cast(bf16x8, vw), pf, O0, 0, 0, 0); } \
                        { const u32x2 lo = *(const u32x2*)(Vl + (32 + ql) * 144 + kcol), hi = *(const u32x2*)(Vl + (32 + ql) * 144 + kcol + 16); \
                          u32x4 vw; vw.x = lo.x; vw.y = lo.y; vw.z = hi.x; vw.w = hi.y; \
                          O1 = __builtin_amdgcn_mfma_f32_32x32x16_bf16(__builtin_bit_cast(bf16x8, vw), pf, O1, 0, 0, 0); } \
                    } \
            } \

        u32x4 kregA = *(const u32x4*)(kbase), vregA = *(const u32x4*)(vbase); unsigned long long bmA = BMk[m * 64];
        u32x4 kregB = *(const u32x4*)(kbase + (size_t)64 * PCOLS), vregB = *(const u32x4*)(vbase + 64); unsigned long long bmB = BMk[m * 64 + 1];
        asm volatile("" :: "v"(qf[0]), "v"(qf[1]), "v"(qf[2]), "v"(qf[3]));
#define ATT_TILE(KREG, VREG, BMR, KT) do { const int kt = (KT); \
            __syncthreads(); \
            *(u32x4*)(Kl + srow * 144 + sch * 16) = KREG; *(u32x4*)(Vl + srow * 144 + sch * 16) = VREG; \
            __syncthreads(); \
            const unsigned long long bm = BMR; \
            if (kt + 2 < nkt) { KREG = *(const u32x4*)(kbase + (size_t)(kt + 2) * 64 * PCOLS); VREG = *(const u32x4*)(vbase + (kt + 2) * 64); BMR = BMk[m * 64 + kt + 2]; } \
            ATT_COMPUTE } while (0)
#pragma unroll 1
        for (int kt2 = 0; kt2 < nkt; kt2 += 2) { ATT_TILE(kregA, vregA, bmA, kt2); ATT_TILE(kregB, vregB, bmB, kt2 + 1); }
#undef ATT_TILE
#undef ATT_COMPUTE
        float ltot; { auto pl = __builtin_amdgcn_permlane32_swap(__float_as_uint(lrun), __float_as_uint(lrun), false, false); ltot = __uint_as_float(pl[0]) + __uint_as_float(pl[1]); } const float inv = 1.0f / ltot;
        bf16_t* yo = Y + m * D + 1536 + h * 64;
#pragma unroll
        for (int g4 = 0; g4 < 4; ++g4) { const int d0 = 8 * g4 + 4 * hf;
            u32x2 o0; o0.x = pk2(O0[4 * g4 + 0] * inv, O0[4 * g4 + 1] * inv); o0.y = pk2(O0[4 * g4 + 2] * inv, O0[4 * g4 + 3] * inv); *(u32x2*)(yo + d0) = o0;
            u32x2 o1; o1.x = pk2(O1[4 * g4 + 0] * inv, O1[4 * g4 + 1] * inv); o1.y = pk2(O1[4 * g4 + 2] * inv, O1[4 * g4 + 3] * inv); *(u32x2*)(yo + 32 + d0) = o1; }
    }
}

constexpr int NPH = 16;
constexpr int NGP = 1 + DEPTH * NPH;
__global__ void __launch_bounds__(512, 2) fwd(Args args) {
    extern __shared__ __attribute__((aligned(16))) unsigned char lds[];
    const int tid = threadIdx.x;
    volatile LAS unsigned* MISC = (volatile LAS unsigned*)((LAS unsigned char*)lds + MISC_OFF);
    for (int u = tid; u < (LDS_BYTES - 131072) / 4; u += 512) ((LAS unsigned*)((LAS unsigned char*)lds + 131072))[u] = 0u;
    __syncthreads();
    unsigned char* ws = args.ws;
    XcdBarrier bar; bar.bar = (unsigned*)(ws + OFF_CTL) + 4096; bar.x = 0; bar.st = nullptr;
    if (!MK_PER_PHASE) bar = xcd_barrier_post((unsigned*)(ws + OFF_CTL) + 4096, MISC + 8);
    const int lo = args.lo, hi = args.hi;
    LAS unsigned char* ldsl = (LAS unsigned char*)lds;
    bf16_t* XB = (bf16_t*)(ws + OFF_XB); float* X = (float*)(ws + OFF_X); float* T = (float*)(ws + OFF_T); float* ST = (float*)(ws + OFF_ST); bf16_t* Pb = (bf16_t*)(ws + OFF_P);
    bf16_t* H = (bf16_t*)(ws + OFF_SCR); bf16_t* Yb = (bf16_t*)(ws + OFF_Y); bf16_t* MG = (bf16_t*)(ws + OFF_MG);
    int gp = 0;
#define RUN() (lo <= gp && gp < hi)
#define SEAM() do { if (RUN() && gp + 1 < hi) xcd_barrier(bar); ++gp; } while (0)
#define PHASE(k, ...) do { if (PHON(k) && RUN()) { __VA_ARGS__; if ((REP_MASK >> (k)) & 1u) { xcd_barrier(bar); __VA_ARGS__; } } SEAM(); } while (0)
    if (RUN()) init_phase(args);
    SEAM();
    int p7n = 0;
#pragma unroll 1
    for (int L = 0; L < DEPTH; ++L) {
        const size_t walt = (L & 1) ? ALT_SHIFT : 0;
        if (L == 0 || !HETERO) PHASE(0, convert_phase(args, L, lds, blockIdx.x, gridDim.x);); else ++gp;
        PHASE(1, { pg8::Gemm g{XB, (const bf16_t*)(ws + OFF_W1A), D, D}; pg8::StaticOrder S; S.init(M, 2 * FF, D, gridDim.x, blockIdx.x); pg8::EpiSwiglu E{H, FF}; pg8::gemm_phase(ldsl, g, S, E); });
        PHASE(2, { pg8::Gemm g{H, (const bf16_t*)(ws + OFF_W1B), FF, FF}; pg8::StaticOrder S; S.init(M, D, FF, gridDim.x, blockIdx.x); pg8::EpiRes E{args.in[I_X], L == 0 ? nullptr : ST, args.in[I_LN3G] + (L > 0 ? (L - 1) * D : 0), args.in[I_LN3B] + (L > 0 ? (L - 1) * D : 0), T, D, ALPHA, 0.5f}; pg8::gemm_phase(ldsl, g, S, E); });
        PHASE(3, ln_phase(T, args.in[I_LN1G] + L * D, args.in[I_LN1B] + L * D, ST, XB, nullptr););
        PHASE(4, { pg8::Gemm g{XB, (const bf16_t*)(ws + OFF_WIN), D, D}; pg8::StaticOrder S; S.init(M, NP, D, gridDim.x, blockIdx.x); pg8::EpiBf16 E{Pb, PCOLS, (bf16_t*)(ws + OFF_GATES)}; pg8::gemm_phase(ldsl, g, S, E); });
        PHASE(5, { kidx_vt_phase(args, L, lds); if (REP_MASK & (1u << 23)) kidx_vt_phase(args, L, lds); if (RWKV_CHUNKED && !DBG_RWKV) { rwkv_par_phase(args, L, lds); if (REP_MASK & (1u << 24)) rwkv_par_phase(args, L, lds); } else rwkv_prep_phase(args, L, lds); });
        if (!HETERO) PHASE(6, { WorkQ wq{nullptr, 0, 0, (int)gridDim.x}; int item = blockIdx.x; sgu_phase(args, L, lds, wq, item, 0); }); else ++gp;
        PHASE(7, { if (DBG_RWKV) { scan_phase(args, lds); xcd_barrier(bar); rwkv_par_phase(args, L, lds); xcd_barrier(bar); rwkv_seq_phase(args, lds, X + (size_t)M * RW, nullptr, nullptr, nullptr); xcd_barrier(bar); dbg_compare_phase(args); }
                   else if (HETERO) {
                       if ((int)blockIdx.x < 64) { rwkv_seq_phase(args, lds, X, args.in[I_GNG] + L * RW, args.in[I_GNB] + L * RW, Yb); if (REP_MASK & (1u << 20)) rwkv_seq_phase(args, lds, X, args.in[I_GNG] + L * RW, args.in[I_GNB] + L * RW, Yb); }
                       else if ((int)blockIdx.x < 64 + NCVT && L + 1 < DEPTH) { convert_phase(args, L + 1, lds, blockIdx.x - 64, NCVT); __syncthreads(); }
                       WorkQ wq{(unsigned*)(ws + OFF_CTL + 524288) + (p7n++) * 64, 0, 0, 0}; int item = wq_first(wq, lds, otid());
                       indexer_phase(args, lds, wq, item); sgu_phase(args, L, lds, wq, item, NB * 512); }
                   else if (RWKV_CHUNKED) rwkv_seq_phase(args, lds, X, nullptr, nullptr, nullptr); else scan_phase(args, lds); });
        if (!HETERO) PHASE(8, { WorkQ wq{nullptr, 0, 0, (int)gridDim.x}; int item = blockIdx.x; indexer_phase(args, lds, wq, item); if (RWKV_CHUNKED) rwkv_fin2_phase(args, L); else rwkv_fin_phase(args, L); }); else ++gp;
        PHASE(9, { attn_phase(args, lds); });
        PHASE(10, { pg8::Gemm g{Yb, (const bf16_t*)(ws + OFF_WBR + walt), D, D}; pg8::BranchOrder S; S.init(M, D, D, gridDim.x, blockIdx.x); pg8::EpiBranch E{(const bf16_t*)(ws + OFF_GATES), args.in[I_BGATE] + (size_t)L * 3 * D, (bf16_t*)(ws + OFF_SCR), MG}; pg8::gemm_phase(ldsl, g, S, E); });
        PHASE(11, { pg8::Gemm g{MG, (const bf16_t*)(ws + OFF_WO + walt), D, D}; pg8::StaticOrder S; S.init(M, D, D, gridDim.x, blockIdx.x); pg8::EpiRes E{nullptr, ST, args.in[I_LN1G] + L * D, args.in[I_LN1B] + L * D, T, D, ALPHA, 1.0f}; pg8::gemm_phase(ldsl, g, S, E); });
        PHASE(12, ln_phase(T, args.in[I_LN2G] + L * D, args.in[I_LN2B] + L * D, ST, XB, nullptr););
        PHASE(13, { pg8::Gemm g{XB, (const bf16_t*)(ws + OFF_W2A + walt), D, D}; pg8::StaticOrder S; S.init(M, 2 * FF, D, gridDim.x, blockIdx.x); pg8::EpiSwiglu E{H, FF}; pg8::gemm_phase(ldsl, g, S, E); });
        PHASE(14, { pg8::Gemm g{H, (const bf16_t*)(ws + OFF_W2B + walt), FF, FF}; pg8::StaticOrder S; S.init(M, D, FF, gridDim.x, blockIdx.x); pg8::EpiRes E{nullptr, ST, args.in[I_LN2G] + L * D, args.in[I_LN2B] + L * D, T, D, ALPHA, 0.5f}; pg8::gemm_phase(ldsl, g, S, E); });
        PHASE(15, ln_phase(T, args.in[I_LN3G] + L * D, args.in[I_LN3B] + L * D, ST, XB, L == DEPTH - 1 ? args.out : nullptr););
        if (REP_MASK & (1u << 25)) { for (int xb = 0; xb < 10; ++xb) xcd_barrier(bar); }
    }
    if (DBG_RWKV) { xcd_barrier(bar); dbg_encode_phase(args); }
#undef RUN
#undef SEAM
#undef PHASE
}

extern "C" void kernel_launch(void* const* d_in, const int* in_sizes, int n_in, void* d_out, int out_size, void* d_ws, size_t ws_size, hipStream_t stream) {
    static int grid = 0;
    if (grid == 0) {
        if (n_in != 33 || out_size != M * D || ws_size < WS_END) { fprintf(stderr, "kernel_launch: unexpected shapes (n_in %d out %d ws %zu, need %zu)\n", n_in, out_size, ws_size, (size_t)WS_END); grid = -1; return; }
        int dev = 0, cus = 0;
        if (hipGetDevice(&dev) != hipSuccess || hipDeviceGetAttribute(&cus, hipDeviceAttributeMultiprocessorCount, dev) != hipSuccess) { grid = -1; return; }
        if (hipFuncSetAttribute((const void*)fwd, hipFuncAttributeMaxDynamicSharedMemorySize, LDS_BYTES) != hipSuccess) { fprintf(stderr, "kernel_launch: hipFuncSetAttribute failed\n"); grid = -1; return; }
        int per_cu = 0; (void)hipOccupancyMaxActiveBlocksPerMultiprocessor(&per_cu, (const void*)fwd, 512, LDS_BYTES); (void)hipGetLastError();
        grid = cus;
    }
    if (grid < 0) return;
    (void)hipMemsetAsync((char*)d_ws + OFF_CTL, 0, CTL_BYTES, stream);
    Args a{};
    for (int i = 0; i < 33; ++i) a.in[i] = (const float*)d_in[i];
    a.out = (float*)d_out; a.ws = (unsigned char*)d_ws;
#if MK_PER_PHASE
    for (int p = 0; p < NGP; ++p) { a.lo = p; a.hi = p + 1; hipLaunchKernelGGL(fwd, dim3(grid), dim3(512), LDS_BYTES, stream, a); }
#else
    a.lo = 0; a.hi = NGP;
    hipLaunchKernelGGL(fwd, dim3(grid), dim3(512), LDS_BYTES, stream, a);
#endif
}
```

```cpp
#include <hip/hip_runtime.h>
#include <cstdio>
#include <cstdint>

#ifndef MK_PER_PHASE
#define MK_PER_PHASE 0
#endif
#ifndef PH_MASK
#define PH_MASK 0xFFFFFFFFu
#endif
#define PHON(k) (((PH_MASK) >> (k)) & 1u)
#ifndef RWKV_CHUNKED
#define RWKV_CHUNKED 1
#endif
#ifndef DBG_RWKV
#define DBG_RWKV 0
#endif
#ifndef DBG_LORA
#define DBG_LORA 0
#endif
#ifndef HETERO
#define HETERO 1
#endif
#ifndef SEQ_HILO
#define SEQ_HILO 0
#endif
#ifndef SGU_SPLIT
#define SGU_SPLIT 256
#endif
#ifndef REP_MASK
#define REP_MASK 0u
#endif

#define LAS __attribute__((address_space(3)))
#define DI __device__ __forceinline__
typedef unsigned short bf16_t;
typedef short bf16x8 __attribute__((ext_vector_type(8)));
typedef float f32x4 __attribute__((ext_vector_type(4)));
typedef float f32x2 __attribute__((ext_vector_type(2)));
typedef float f32x16 __attribute__((ext_vector_type(16)));
typedef unsigned u32x4 __attribute__((ext_vector_type(4)));
typedef unsigned u32x2 __attribute__((ext_vector_type(2)));
typedef __bf16 bf16x2_t __attribute__((ext_vector_type(2)));

constexpr int NB = 4, SEQ = 4096, M = NB * SEQ, D = 2048, FF = 5632, DEPTH = 4;
constexpr int RW = 1024;
constexpr int NP = 13312;
constexpr int PCOLS = 7168;
constexpr int DIN = 13168;
constexpr int GN_GATE = 6656, GN_LORA = 12800, GN_KI = 13088, GN_WI = 13152;
constexpr int PC_R = 0, PC_K = 1024, PC_V = 2048, PC_SGU = 3072, PC_SGV = 3584, PC_AQ = 4096, PC_AK = 4608, PC_AV = 5120, PC_QI = 5632, PC_LORA = 6656, PC_KI = 6944, PC_WI = 7008;
constexpr float ALPHA = 1.6817928305074290f;
constexpr float LN_EPS = 1e-5f;

constexpr size_t MiB = 1u << 20;
constexpr size_t OFF_CTL = 0, CTL_BYTES = 1 * MiB;
constexpr size_t OFF_BIAS = 1 * MiB;
constexpr size_t OFF_ST = OFF_BIAS + 786432;
constexpr size_t OFF_LW2 = OFF_BIAS + 65536, OFF_LA2 = OFF_LW2 + 131072, OFF_LG2 = OFF_LA2 + 131072;
constexpr int REC = 15360, RROW = 144, R_EL2 = 0, R_RL2 = 2304, R_A2 = 4608, R_A3 = 8704, R_FT = 9728, R_VT = 10240, R_GC = 12288, R_G = 12544, R_BON = 14592;
constexpr size_t OFF_W1A = 2 * MiB;
constexpr size_t OFF_W1B = OFF_W1A + 44 * MiB;
constexpr size_t OFF_WIN = OFF_W1B + 22 * MiB;
constexpr size_t OFF_WBR = OFF_WIN + 52 * MiB;
constexpr size_t OFF_WO  = OFF_WBR + 8 * MiB;
constexpr size_t OFF_W2A = OFF_WO + 8 * MiB;
constexpr size_t OFF_W2B = OFF_W2A + 44 * MiB;
constexpr size_t OFF_X   = OFF_W2B + 22 * MiB;
constexpr size_t OFF_T   = OFF_X + 128 * MiB;
constexpr size_t OFF_XB  = OFF_T + 128 * MiB;
constexpr size_t OFF_P   = OFF_XB + 64 * MiB;
constexpr size_t OFF_GATES = OFF_P + 224 * MiB;
constexpr size_t OFF_SCR = OFF_GATES + 192 * MiB;
constexpr size_t OFF_Y   = OFF_SCR + 416 * MiB;
constexpr size_t OFF_MG  = OFF_Y + 64 * MiB;
constexpr size_t OFF_BM  = OFF_MG + 64 * MiB;
constexpr size_t OFF_KI  = OFF_BM + 8 * MiB;
constexpr size_t OFF_VT  = OFF_KI + 2 * MiB;
constexpr size_t OFF_ALT = OFF_VT + 16 * MiB;
constexpr size_t ALT_SHIFT = OFF_ALT - OFF_WBR;
constexpr size_t WS_END  = OFF_ALT + 82 * MiB;
constexpr int NCVT = 64;

constexpr int LDS_BYTES = 147456;
constexpr int MISC_OFF = 131072 + 320;

DI unsigned f2bf(float f) { unsigned u = __builtin_bit_cast(unsigned, f); return (u + 0x7fffu + ((u >> 16) & 1u)) >> 16; }
DI float bf2f(unsigned short b) { return __builtin_bit_cast(float, ((unsigned)b) << 16); }
DI unsigned pk2(float lo, float hi) { f32x2 v = {lo, hi}; bf16x2_t b = __builtin_convertvector(v, bf16x2_t); return __builtin_bit_cast(unsigned, b); }
DI float bflo(unsigned w) { return __builtin_bit_cast(float, w << 16); }
DI float bfhi(unsigned w) { return __builtin_bit_cast(float, w & 0xffff0000u); }
template <int CTRL> DI float dpp_f(float x) { return __builtin_bit_cast(float, __builtin_amdgcn_update_dpp(0, __builtin_bit_cast(int, x), CTRL, 0xF, 0xF, true)); }
DI float row16_sum(float x) {
    x += dpp_f<0xB1>(x);
    x += dpp_f<0x4E>(x);
    x += dpp_f<0x141>(x);
    x += dpp_f<0x140>(x);
    return x;
}
DI int otid() { int t = threadIdx.x; asm volatile("" : "+v"(t)); return t; }
DI int obid() { int t = blockIdx.x; asm volatile("" : "+s"(t)); return t; }
DI float wave_sum(float x) {
    x = row16_sum(x);
    auto p = __builtin_amdgcn_permlane16_swap(__float_as_uint(x), __float_as_uint(x), false, false);
    x = __uint_as_float(p[0]) + __uint_as_float(p[1]);
    auto q = __builtin_amdgcn_permlane32_swap(__float_as_uint(x), __float_as_uint(x), false, false);
    return __uint_as_float(q[0]) + __uint_as_float(q[1]);
}
DI void wave_sum8(float (&x)[8]) {
#pragma unroll
    for (int i = 0; i < 8; ++i) x[i] += dpp_f<0xB1>(x[i]);
#pragma unroll
    for (int i = 0; i < 8; ++i) x[i] += dpp_f<0x4E>(x[i]);
#pragma unroll
    for (int i = 0; i < 8; ++i) x[i] += dpp_f<0x141>(x[i]);
#pragma unroll
    for (int i = 0; i < 8; ++i) x[i] += dpp_f<0x140>(x[i]);
#pragma unroll
    for (int i = 0; i < 8; ++i) { auto p = __builtin_amdgcn_permlane16_swap(__float_as_uint(x[i]), __float_as_uint(x[i]), false, false); x[i] = __uint_as_float(p[0]) + __uint_as_float(p[1]); }
#pragma unroll
    for (int i = 0; i < 8; ++i) { auto p = __builtin_amdgcn_permlane32_swap(__float_as_uint(x[i]), __float_as_uint(x[i]), false, false); x[i] = __uint_as_float(p[0]) + __uint_as_float(p[1]); }
}
DI float sigmoidf_(float x) { return __builtin_amdgcn_rcpf(1.0f + __expf(-x)); }
DI float gelu_erf(float x) {
    const float y = fabsf(x) * 0.70710678118654752f;
    const float t = __builtin_amdgcn_rcpf(__builtin_fmaf(0.3275911f, y, 1.0f));
    const float e = __builtin_amdgcn_exp2f(-1.4426950408889634f * y * y);
    float p = __builtin_fmaf(1.061405429f, t, -1.453152027f); p = __builtin_fmaf(p, t, 1.421413741f); p = __builtin_fmaf(p, t, -0.284496736f); p = __builtin_fmaf(p, t, 0.254829592f);
    const float ec = p * t * e;
    return 0.5f * x * (x < 0.f ? ec : 2.0f - ec);
}

namespace pg8 {
constexpr int BM = 256, BK = 64, HALF = 128, HTB = HALF * BK * 2, STAGE_BYTES = 8 * HTB, NXCD = 8, WGM = 8;
__host__ __device__ __forceinline__ int lds_byte(int r, int c) { const int st = (r >> 4) * 2 + (c >> 5), rr = r & 15, cc = c & 31, ob = rr * 64 + cc * 2; return st * 1024 + (ob ^ (((ob >> 9) & 1) << 5)); }
__host__ __device__ __forceinline__ void stage_rc(int b, int& R, int& C) { const int st = b / 1024, sb = b % 1024, swz = sb ^ (((sb >> 9) & 1) << 5); R = (st >> 1) * 16 + swz / 64; C = (st & 1) * 32 + (swz % 64) / 2; }
__host__ __device__ __forceinline__ int perm32(int rho) { const int n = rho >> 4, i = rho & 15; return 8 * (i >> 2) + 4 * n + (i & 3); }

struct Unit { int pm, pn, koff, nt, tag; };
struct Gemm { const bf16_t* A; const bf16_t* Bt; int lda, ldb; };

struct StaticOrder {
    int nM, nN, nwg, G, c, nt;
    __device__ void init(int M_, int N_, int K_, int G_, int c_) { nM = M_ / BM; nN = N_ / BM; nwg = nM * nN; G = G_; c = c_; nt = K_ / BK; }
    __device__ bool tile(int L, Unit& u) const {
        if (L >= nwg) return false;
        int wgid = L; { const int q = nwg / NXCD, r = nwg % NXCD, xcd = wgid % NXCD, off = wgid / NXCD; wgid = (xcd < r ? xcd * (q + 1) : r * (q + 1) + (xcd - r) * q) + off; }
        const int nig = WGM * nN, gid = wgid / nig, fm = gid * WGM, gsz = (nM - fm) < WGM ? (nM - fm) : WGM;
        u.pm = fm + ((wgid % nig) % gsz); u.pn = (wgid % nig) / gsz; return true;
    }
    __device__ bool next(int i, Unit& u) const { u.koff = 0; u.nt = nt; u.tag = 0; return tile(i * G + c, u); }
};
struct BranchOrder : StaticOrder {
    __device__ bool next(int i, Unit& u) const {
        const int ti = i / 3, br = i - 3 * ti;
        u.tag = br; u.koff = br == 0 ? 0 : (br == 1 ? 1024 : 1536); u.nt = br == 0 ? 16 : 8;
        return tile(ti * G + c, u);
    }
};

template <class Epi, class Sched>
__device__ __forceinline__ void gemm_phase(LAS unsigned char* lds, const Gemm g, const Sched& S, const Epi& E) {
    const int tid = otid(), wid = __builtin_amdgcn_readfirstlane(tid >> 6), lane = tid & 63, wr = wid >> 2, wc = wid & 3, fr = lane & 15, fq = lane >> 4;
    unsigned voffA[2], voffB[2];
#pragma unroll
    for (int i = 0; i < 2; ++i) { int R, C; stage_rc(tid * 16 + i * 8192, R, C); const int Rb = Epi::PERM ? ((R & ~31) + perm32(R & 31)) : R;
        voffA[i] = (unsigned)(R * g.lda + C) * 2u; voffB[i] = (unsigned)(Rb * g.ldb + C) * 2u; }
    const size_t kstep = (size_t)(BK * 2);
    const size_t hstepA = (size_t)HALF * g.lda * 2, hstepB = (size_t)HALF * g.ldb * 2;
    const size_t tstepA = 2 * hstepA, tstepB = 2 * hstepB;
    const unsigned ldsw = (unsigned)wid * 1024u;
    const int aoff = lds_byte(wr * 64 + fr, fq * 8), boff = lds_byte(wc * 32 + fr, fq * 8);
#define PG8_SA(b, h) (((b) * 2 + (h)) * HTB)
#define PG8_SB(b, h) ((4 + (b) * 2 + (h)) * HTB)
#define PG8_STAGE(bufoff, gbase, voff) do { _Pragma("unroll") for (int _i = 0; _i < 2; ++_i) \
        __builtin_amdgcn_global_load_lds((const unsigned*)((const char*)(gbase) + (voff)[_i]), (LAS unsigned*)(lds + (bufoff) + ldsw + _i * 8192), 16, 0, 0); } while (0)
#define PG8_LDA(dst, b, h) do { _Pragma("unroll") for (int m = 0; m < 4; ++m) _Pragma("unroll") for (int k = 0; k < 2; ++k) dst[m][k] = *(const LAS bf16x8*)(lds + PG8_SA(b, h) + aoff + m * 2048 + k * 1024); } while (0)
#define PG8_LDB(dst, b, h) do { _Pragma("unroll") for (int n = 0; n < 2; ++n) _Pragma("unroll") for (int k = 0; k < 2; ++k) dst[n][k] = *(const LAS bf16x8*)(lds + PG8_SB(b, h) + boff + n * 2048 + k * 1024); } while (0)
#define PG8_MMA(ai, bj, At, Bt) do { __builtin_amdgcn_s_setprio(1); _Pragma("unroll") for (int m = 0; m < 4; ++m) _Pragma("unroll") for (int n = 0; n < 2; ++n) _Pragma("unroll") for (int k = 0; k < 2; ++k) \
        acc[ai][bj][m][n] = __builtin_amdgcn_mfma_f32_16x16x32_bf16(Bt[n][k], At[m][k], acc[ai][bj][m][n], 0, 0, 0); __builtin_amdgcn_s_setprio(0); } while (0)
#define PG8_WAIT_V(n) asm volatile("s_waitcnt vmcnt(" #n ")" ::: "memory")
#define PG8_WAIT_L(n) asm volatile("s_waitcnt lgkmcnt(" #n ")" ::: "memory")
#define PG8_BAR __builtin_amdgcn_s_barrier()
#define PG8_SCHED __builtin_amdgcn_sched_barrier(0)
    Unit cur, nxt; int ui = 0;
    if (!S.next(0, cur)) return;
    f32x4 acc[2][2][4][2];
#pragma unroll
    for (int a = 0; a < 2; ++a)
#pragma unroll
        for (int b = 0; b < 2; ++b)
#pragma unroll
            for (int m = 0; m < 4; ++m)
#pragma unroll
                for (int n = 0; n < 2; ++n) acc[a][b][m][n] = (f32x4){0.f, 0.f, 0.f, 0.f};
    bf16x8 At[4][2], B0[2][2], B1[2][2];
    const char* cA = (const char*)g.A + (size_t)cur.pm * tstepA + (size_t)cur.koff * 2; const char* cB = (const char*)g.Bt + (size_t)cur.pn * tstepB + (size_t)cur.koff * 2;
    PG8_STAGE(PG8_SB(0, 0), cB, voffB); PG8_STAGE(PG8_SB(0, 1), cB + hstepB, voffB); PG8_STAGE(PG8_SA(0, 0), cA, voffA); PG8_STAGE(PG8_SA(0, 1), cA + hstepA, voffA);
    if (wr == 1) PG8_BAR;
    PG8_WAIT_V(2); PG8_BAR;
    PG8_STAGE(PG8_SB(1, 0), cB + kstep, voffB); PG8_STAGE(PG8_SA(1, 0), cA + kstep, voffA); PG8_STAGE(PG8_SB(1, 1), cB + hstepB + kstep, voffB);
    PG8_WAIT_V(6); PG8_BAR;
    for (;;) {
        const bool has_next = S.next(ui + 1, nxt);
        const char* nA = has_next ? (const char*)g.A + (size_t)nxt.pm * tstepA + (size_t)nxt.koff * 2 : cA; const char* nB = has_next ? (const char*)g.Bt + (size_t)nxt.pn * tstepB + (size_t)nxt.koff * 2 : cB;
        const int nt = cur.nt;
        for (int t = 0; t < nt; t += 2) {
            const bool last = (t == nt - 2);
            const char* a1 = cA + (size_t)(t + 1) * kstep;
            const char* a2 = last ? nA : cA + (size_t)(t + 2) * kstep; const char* b2 = last ? nB : cB + (size_t)(t + 2) * kstep;
            const char* a3 = a2 + kstep; const char* b3 = b2 + kstep;
            PG8_LDB(B0, 0, 0); PG8_LDB(B1, 0, 1); PG8_SCHED; PG8_LDA(At, 0, 0); PG8_STAGE(PG8_SA(1, 1), a1 + hstepA, voffA);
            PG8_WAIT_V(8); PG8_WAIT_L(0); PG8_BAR; PG8_MMA(0, 0, At, B0); PG8_MMA(0, 1, At, B1); PG8_BAR; PG8_SCHED;
            PG8_LDA(At, 0, 1); PG8_STAGE(PG8_SB(0, 0), b2, voffB); PG8_STAGE(PG8_SB(0, 1), b2 + hstepB, voffB); PG8_STAGE(PG8_SA(0, 0), a2, voffA);
            PG8_WAIT_V(8); PG8_WAIT_L(0); PG8_BAR; PG8_MMA(1, 0, At, B0); PG8_MMA(1, 1, At, B1); PG8_BAR; PG8_SCHED;
            PG8_LDB(B0, 1, 0); PG8_LDB(B1, 1, 1); PG8_SCHED; PG8_LDA(At, 1, 0); PG8_STAGE(PG8_SA(0, 1), a2 + hstepA, voffA);
            PG8_WAIT_V(8); PG8_WAIT_L(0); PG8_BAR; PG8_MMA(0, 0, At, B0); PG8_MMA(0, 1, At, B1); PG8_BAR; PG8_SCHED;
            PG8_LDA(At, 1, 1); PG8_STAGE(PG8_SB(1, 0), b3, voffB); PG8_STAGE(PG8_SB(1, 1), b3 + hstepB, voffB); PG8_STAGE(PG8_SA(1, 0), a3, voffA);
            PG8_WAIT_V(8); PG8_WAIT_L(0); PG8_BAR; PG8_MMA(1, 0, At, B0); PG8_MMA(1, 1, At, B1); PG8_BAR; PG8_SCHED;
        }
        if (wr == 0) PG8_BAR;
        E(acc, cur, wr, wc, fr, fq);
        if (!has_next) break;
        if (!(Epi::KEEPS && cur.tag != 2))
#pragma unroll
        for (int a = 0; a < 2; ++a)
#pragma unroll
            for (int b = 0; b < 2; ++b)
#pragma unroll
                for (int m = 0; m < 4; ++m)
#pragma unroll
                    for (int n = 0; n < 2; ++n) acc[a][b][m][n] = (f32x4){0.f, 0.f, 0.f, 0.f};
        cur = nxt; cA = nA; cB = nB; ++ui;
        if (wr == 1) PG8_BAR;
    }
    PG8_WAIT_V(0);
    PG8_BAR;
#undef PG8_SA
#undef PG8_SB
#undef PG8_STAGE
#undef PG8_LDA
#undef PG8_LDB
#undef PG8_MMA
#undef PG8_WAIT_V
#undef PG8_WAIT_L
#undef PG8_BAR
#undef PG8_SCHED
}

struct EpiSwiglu {
    static constexpr bool PERM = true, KEEPS = false;
    bf16_t* O; int ldc;
    __device__ __forceinline__ void operator()(const f32x4 (&acc)[2][2][4][2], const Unit& u, int wr, int wc, int fr, int fq) const {
        const int row0 = u.pm * BM + wr * 64 + fr, col0 = u.pn * HALF + wc * 32 + 8 * fq;
#pragma unroll
        for (int ai = 0; ai < 2; ++ai)
#pragma unroll
            for (int m = 0; m < 4; ++m) {
                float hv[8];
#pragma unroll
                for (int n = 0; n < 2; ++n)
#pragma unroll
                    for (int j = 0; j < 4; ++j) { const float gv = acc[ai][0][m][n][j], uv = acc[ai][1][m][n][j]; hv[4 * n + j] = gv * __builtin_amdgcn_rcpf(1.0f + __expf(-gv)) * uv; }
                u32x4 w; w.x = pk2(hv[0], hv[1]); w.y = pk2(hv[2], hv[3]); w.z = pk2(hv[4], hv[5]); w.w = pk2(hv[6], hv[7]);
                *(u32x4*)(O + (size_t)(row0 + ai * HALF + m * 16) * ldc + col0) = w;
            }
    }
};
struct EpiRes {
    static constexpr bool PERM = false, KEEPS = false;
    const float* Xraw; const float* st; const float* g; const float* b; float* T; int ldc; float alpha, s;
    __device__ __forceinline__ void operator()(const f32x4 (&acc)[2][2][4][2], const Unit& u, int wr, int wc, int fr, int fq) const {
        const int row0 = u.pm * BM + wr * 64 + fr, col0 = u.pn * BM + wc * 32 + 4 * fq;
        f32x4 gv[2][2], bv[2][2];
        if (st) {
#pragma unroll
            for (int bj = 0; bj < 2; ++bj)
#pragma unroll
                for (int n = 0; n < 2; ++n) { gv[bj][n] = *(const f32x4*)(g + col0 + bj * HALF + n * 16); bv[bj][n] = *(const f32x4*)(b + col0 + bj * HALF + n * 16); } }
        const float* src = st ? T : Xraw;
#pragma unroll
        for (int ai = 0; ai < 2; ++ai)
#pragma unroll
            for (int m2 = 0; m2 < 2; ++m2) {
                f32x4 tv[2][2][2]; f32x2 ms[2];
#pragma unroll
                for (int mm = 0; mm < 2; ++mm) { const int row = row0 + ai * HALF + (2 * m2 + mm) * 16; const size_t off = (size_t)row * ldc + col0;
                    ms[mm] = (f32x2){0.f, 1.f}; if (st) ms[mm] = *(const f32x2*)(st + 2 * (size_t)row);
#pragma unroll
                    for (int bj = 0; bj < 2; ++bj)
#pragma unroll
                        for (int n = 0; n < 2; ++n) tv[mm][bj][n] = *(const f32x4*)(src + off + bj * HALF + n * 16); }
                asm volatile("" ::: "memory");
#pragma unroll
                for (int mm = 0; mm < 2; ++mm) { const int m = 2 * m2 + mm; const size_t off = (size_t)(row0 + ai * HALF + m * 16) * ldc + col0;
#pragma unroll
                    for (int bj = 0; bj < 2; ++bj)
#pragma unroll
                        for (int n = 0; n < 2; ++n) { f32x4 xv = tv[mm][bj][n]; if (st) xv = (xv - ms[mm][0]) * ms[mm][1] * gv[bj][n] + bv[bj][n];
                            *(f32x4*)(T + off + bj * HALF + n * 16) = xv * alpha + acc[ai][bj][m][n] * s; } }
            }
    }
};
__device__ __forceinline__ int frag_off(int wr, int wc, int fr, int fq, int ai, int m, int bj) { return (((((wr * 4 + wc) * 2 + ai) * 4 + m) * 2 + bj) * 64 + fq * 16 + fr) * 8; }
struct EpiBf16 {
    static constexpr bool PERM = true, KEEPS = false;
    bf16_t* O; int ldc; bf16_t* G;
    __device__ __forceinline__ void operator()(const f32x4 (&acc)[2][2][4][2], const Unit& u, int wr, int wc, int fr, int fq) const {
        const bool gate = u.pn >= GN_GATE / BM && u.pn < GN_LORA / BM;
        const int gt = u.pn - GN_GATE / BM;
        bf16_t* gbase = G + ((size_t)((gt >> 3) * (M / BM) + u.pm) * 8 + (gt & 7)) * 65536;
        const int pcol = (u.pn >= GN_LORA / BM ? PC_LORA + (u.pn - GN_LORA / BM) * BM : u.pn * BM) + wc * 32 + 8 * fq;
        const int row0 = u.pm * BM + wr * 64 + fr;
        int lbase = ((wr * 4 + wc) * 1024 + fq * 16 + fr) * 8; asm volatile("" : "+v"(lbase));
#pragma unroll
        for (int ai = 0; ai < 2; ++ai)
#pragma unroll
            for (int m = 0; m < 4; ++m) { bf16_t* rowp = O + (size_t)(row0 + ai * HALF + m * 16) * ldc + pcol;
#pragma unroll
                for (int bj = 0; bj < 2; ++bj) { const f32x4 v0 = acc[ai][bj][m][0], v1 = acc[ai][bj][m][1];
                    u32x4 w; w.x = pk2(v0[0], v0[1]); w.y = pk2(v0[2], v0[3]); w.z = pk2(v1[0], v1[1]); w.w = pk2(v1[2], v1[3]);
                    if (gate) *(u32x4*)(gbase + lbase + (((ai * 4 + m) * 2 + bj) * 512)) = w; else *(u32x4*)(rowp + bj * HALF) = w; } }
    }
};
struct EpiBranch {
    static constexpr bool PERM = true, KEEPS = true;
    const bf16_t* G; const float* bgate; bf16_t* MG;
    static __device__ __forceinline__ float den(float p) { return 1.0f + __expf(-__builtin_amdgcn_fmed3f(p, -30.0f, 30.0f)); }
    __device__ __forceinline__ void operator()(f32x4 (&acc)[2][2][4][2], const Unit& u, int wr, int wc, int fr, int fq) const {
        const int row0 = u.pm * BM + wr * 64 + fr, col0 = u.pn * BM + wc * 32 + 8 * fq; const int br = u.tag; const bool mid = br < 2;
        int lbase = ((wr * 4 + wc) * 1024 + fq * 16 + fr) * 8; asm volatile("" : "+v"(lbase));
        u32x2 bA[2][2], bB[2][2];
#pragma unroll
        for (int bj = 0; bj < 2; ++bj)
#pragma unroll
            for (int n = 0; n < 2; ++n) { const f32x4 t = *(const f32x4*)(bgate + br * D + col0 + bj * HALF + 4 * n); bA[bj][n].x = pk2(t[0], t[1]); bA[bj][n].y = pk2(t[2], t[3]);
                const f32x4 t2 = *(const f32x4*)(bgate + (mid ? br + 1 : br) * D + col0 + bj * HALF + 4 * n); bB[bj][n].x = pk2(t2[0], t2[1]); bB[bj][n].y = pk2(t2[2], t2[3]); }
        const bf16_t* gA = G + ((size_t)(br * (M / BM) + u.pm) * 8 + u.pn) * 65536;
        const bf16_t* gB = gA + (mid ? (size_t)(M / BM) * 8 * 65536 : 0);
        u32x4 gaq[2][2], gbq[2][2];
#define EB_LOAD(A8) do { _Pragma("unroll") for (int bj = 0; bj < 2; ++bj) { const int fo = lbase + (((A8) * 2 + bj) * 512); \
                gaq[(A8) & 1][bj] = *(const u32x4*)(gA + fo); gbq[(A8) & 1][bj] = *(const u32x4*)(gB + fo); } } while (0)
        EB_LOAD(0);
#pragma unroll
        for (int a8 = 0; a8 < 8; ++a8) { const int ai = a8 >> 2, m = a8 & 3; const size_t row = (size_t)(row0 + ai * HALF + m * 16);
            if (a8 + 1 < 8) EB_LOAD(a8 + 1);
            asm volatile("" ::: "memory");
#pragma unroll
                for (int bj = 0; bj < 2; ++bj) { const u32x4 a4 = gaq[a8 & 1][bj], b4 = gbq[a8 & 1][bj];
                    const unsigned aw[4] = {a4.x, a4.y, a4.z, a4.w}, bw[4] = {b4.x, b4.y, b4.z, b4.w}; unsigned ow[4];
#pragma unroll
                    for (int n = 0; n < 2; ++n) { const unsigned bax = bA[bj][n].x, bay = bA[bj][n].y, bbx = bB[bj][n].x, bby = bB[bj][n].y;
                        float f0 = __builtin_amdgcn_rcpf(den(bflo(aw[2 * n]) + bflo(bax))), f1 = __builtin_amdgcn_rcpf(den(bfhi(aw[2 * n]) + bfhi(bax)));
                        float f2 = __builtin_amdgcn_rcpf(den(bflo(aw[2 * n + 1]) + bflo(bay))), f3 = __builtin_amdgcn_rcpf(den(bfhi(aw[2 * n + 1]) + bfhi(bay)));
                        if (mid) { f0 *= den(bflo(bw[2 * n]) + bflo(bbx)); f1 *= den(bfhi(bw[2 * n]) + bfhi(bbx)); f2 *= den(bflo(bw[2 * n + 1]) + bflo(bby)); f3 *= den(bfhi(bw[2 * n + 1]) + bfhi(bby)); }
                        f32x4& av = acc[ai][bj][m][n];
                        av[0] *= f0; av[1] *= f1; av[2] *= f2; av[3] *= f3;
                        ow[2 * n] = pk2(av[0], av[1]); ow[2 * n + 1] = pk2(av[2], av[3]); }
                    if (!mid) { u32x4 o; o.x = ow[0]; o.y = ow[1]; o.z = ow[2]; o.w = ow[3]; *(u32x4*)(MG + row * D + col0 + bj * HALF) = o; } }
        }
#undef EB_LOAD
    }
};
}

#define XB_TMO      128
#define XB_XCNT(j)  (256  + 64 * (j))
#define XB_XSUB(j)  (1280 + 64 * (j))
#define XB_XGEN(j)  (2304 + 64 * (j))
#define XB_TOP      3328
#define XB_TOPGEN   3392
#define XCD_BAR_WORDS 3456
#define XB_SPIN_CAP (1u << 18)
__device__ __forceinline__ unsigned xb_ld(unsigned* p)              { return __hip_atomic_load(p, __ATOMIC_RELAXED, __HIP_MEMORY_SCOPE_AGENT); }
__device__ __forceinline__ unsigned xb_add(unsigned* p, unsigned v) { return __hip_atomic_fetch_add(p, v, __ATOMIC_RELAXED, __HIP_MEMORY_SCOPE_AGENT); }
__device__ __forceinline__ unsigned xb_xcc_id() { return (unsigned)__builtin_amdgcn_s_getreg((3 << 11) | 20) & 0xFu; }
#define XB_SPIN(cond, bar) do { unsigned _sp = 0; while (cond) { __builtin_amdgcn_s_sleep(1); \
    if ((++_sp & 255u) == 0u) { if (xb_ld(&(bar)[XB_TMO])) break; if (_sp > XB_SPIN_CAP) { atomicAdd(&(bar)[XB_TMO], 1u); break; } } } } while (0)
struct XcdBarrier { unsigned* bar; unsigned x; volatile LAS unsigned* st; };
__device__ __forceinline__ XcdBarrier xcd_barrier_post(unsigned* bar, volatile LAS unsigned* st) {
    XcdBarrier b; b.bar = bar; b.x = xb_xcc_id(); b.st = st;
    if (threadIdx.x == 0) (void)xb_add(&bar[XB_XCNT(b.x)], 1u);
    return b;
}
__device__ __forceinline__ void xcd_barrier_complete(unsigned* bar, unsigned x, unsigned& nloc, unsigned& nx) {
    const unsigned G = gridDim.x * gridDim.y * gridDim.z;
    unsigned sum, cnt, mine, sp = 0u;
    for (;;) {
        sum = 0u; cnt = 0u; mine = 0u;
#pragma unroll
        for (unsigned j = 0; j < 16; ++j) { const unsigned c = xb_ld(&bar[XB_XCNT(j)]); sum += c; cnt += (c > 0u) ? 1u : 0u; mine = (j == x) ? c : mine; }
        if (sum == G) break;
        __builtin_amdgcn_s_sleep(1);
        if ((++sp & 255u) == 0u) { if (xb_ld(&bar[XB_TMO])) break; if (sp > XB_SPIN_CAP) { atomicAdd(&bar[XB_TMO], 1u); break; } }
    }
    nloc = mine > 0u ? mine : 1u; nx = cnt > 0u ? cnt : 1u;
}
__device__ __forceinline__ void xcd_barrier(const XcdBarrier& b) {
    asm volatile("s_waitcnt vmcnt(0)" ::: "memory");
    __syncthreads();
    if (threadIdx.x == 0) {
        unsigned* bar = b.bar;
        __builtin_amdgcn_s_waitcnt(0);
        unsigned nloc = b.st[0], nx = b.st[1];
        if (nloc == 0u) { xcd_barrier_complete(bar, b.x, nloc, nx); b.st[0] = nloc; b.st[1] = nx; }
        const unsigned old = xb_add(&bar[XB_XSUB(b.x)], 1u);
        const unsigned gen = old / nloc;
        if (old + 1u == (gen + 1u) * nloc) {
            __builtin_amdgcn_fence(__ATOMIC_RELEASE, "agent");
            asm volatile("s_waitcnt vmcnt(0)" ::: "memory");
            const unsigned og = xb_add(&bar[XB_TOP], 1u);
            const unsigned tg = og / nx;
            if (og + 1u == (tg + 1u) * nx) xb_add(&bar[XB_TOPGEN], 1u);
            else XB_SPIN(xb_ld(&bar[XB_TOPGEN]) == tg, bar);
            __builtin_amdgcn_fence(__ATOMIC_ACQUIRE, "agent");
            xb_add(&bar[XB_XGEN(b.x)], 1u);
            asm volatile("s_waitcnt vmcnt(0)" ::: "memory");
        } else {
            XB_SPIN(xb_ld(&bar[XB_XGEN(b.x)]) == gen, bar);
            __builtin_amdgcn_fence(__ATOMIC_ACQUIRE, "agent");
            asm volatile("s_waitcnt vmcnt(0)" ::: "memory");
        }
    }
    __syncthreads();
}

struct Args { const float* in[33]; float* out; unsigned char* ws; int lo, hi; };
enum { I_X = 0, I_F1IN, I_F1OUT, I_LN1G, I_LN1B, I_WIN, I_BGATE, I_MU, I_W0, I_W2, I_A0, I_A2, I_G2, I_KK, I_KA, I_RK, I_GNG, I_GNB, I_SGLNG, I_SGLNB, I_SGW, I_SGB, I_ILNG, I_ILNB, I_RELB, I_WBR, I_WO, I_LN2G, I_LN2B, I_F2IN, I_F2OUT, I_LN3G, I_LN3B };

DI int pmap(int n) {
    int off = 0;
    off = n >= 3072 ? GN_LORA - 3072 : off; off = n >= 3360 ? PC_SGU - 3360 : off; off = n >= 4384 ? PC_AQ - 4384 : off; off = n >= 5920 ? PC_QI - 5920 : off;
    off = n >= 6944 ? GN_KI - 6944 : off; off = n >= 7008 ? GN_WI - 7008 : off; off = n >= 7024 ? GN_GATE - 7024 : off;
    return n + off;
}
template <int MODE> DI int rowmap(int n) {
    if (MODE == 0) return n;
    if (MODE == 1) { const int up = n >= FF ? 1 : 0, j = n - up * FF; return (j >> 7) * 256 + up * 128 + (j & 127); }
    return pmap(n);
}
struct CvtItem { const float* W; bf16_t* WT; int K, N, mode, item; };
DI void cvt_load(const CvtItem& d, int lane, f32x4 (&va)[4], f32x4 (&vb)[4]) {
    const int nblk = (d.N + 31) / 32, kb = d.item / nblk, nb = d.item % nblk, k0 = 64 * kb, n0 = 32 * nb;
    const int c4 = lane & 7, rq = lane >> 3; const int ncol = n0 + 4 * c4; const int ncl = ncol < d.N ? ncol : 0;
#pragma unroll
    for (int i = 0; i < 4; ++i) { const int k = k0 + 2 * (rq + 8 * i);
        va[i] = *(const f32x4*)(d.W + (size_t)k * d.N + ncl); vb[i] = *(const f32x4*)(d.W + (size_t)(k + 1) * d.N + ncl); }
}
DI void cvt_finish(const CvtItem& d, int lane, const f32x4 (&va)[4], const f32x4 (&vb)[4], float* scr) {
    const int nblk = (d.N + 31) / 32, kb = d.item / nblk, nb = d.item % nblk, k0 = 64 * kb, n0 = 32 * nb;
    unsigned* st = (unsigned*)scr; const int c4 = lane & 7, rq = lane >> 3;
#pragma unroll
    for (int i = 0; i < 4; ++i) { const int rp = rq + 8 * i;
#pragma unroll
        for (int j = 0; j < 4; ++j) st[(4 * c4 + j) * 33 + rp] = pk2(va[i][j], vb[i][j]); }
    __builtin_amdgcn_s_waitcnt(0xc07f); asm volatile("" ::: "memory");
#pragma unroll
    for (int i = 0; i < 4; ++i) { const int id = lane + 64 * i, n = id >> 3, kc = id & 7; const unsigned* p = st + n * 33 + 4 * kc;
        u32x4 o; o.x = p[0]; o.y = p[1]; o.z = p[2]; o.w = p[3];
        const int ns = n0 + n; const int nd1 = rowmap<1>(ns), nd2 = pmap(ns); const int nd = d.mode == 0 ? ns : (d.mode == 1 ? nd1 : nd2);
        if (ns < d.N) *(u32x4*)(d.WT + (size_t)nd * d.K + k0 + 8 * kc) = o; }
    __builtin_amdgcn_s_waitcnt(0xc07f); asm volatile("" ::: "memory");
}
DI void convert_phase(const Args& a, int L, unsigned char* lds, int vb, int nvb) {
    const int tidx_ = otid();
    const int wave = __builtin_amdgcn_readfirstlane(tidx_ >> 6), lane = tidx_ & 63;
    float* scr = (float*)(lds + wave * 16384);
    const int gw = vb * 8 + wave, NGW = nvb * 8;
    unsigned char* ws = a.ws; const size_t alt = (L & 1) ? ALT_SHIFT : 0;
    constexpr int I1 = (D / 64) * ((2 * FF) / 32), I2 = (FF / 64) * (D / 32), I3 = (D / 64) * ((DIN + 31) / 32), I4 = (D / 64) * (D / 32);
    constexpr int NIT = 2 * I1 + 2 * I2 + I3 + 2 * I4;
    auto decode = [&](int it) -> CvtItem {
        int r = it;
        if (r < I1) return CvtItem{a.in[I_F1IN] + (size_t)L * D * 2 * FF, (bf16_t*)(ws + OFF_W1A), D, 2 * FF, 1, r}; r -= I1;
        if (r < I1) return CvtItem{a.in[I_F2IN] + (size_t)L * D * 2 * FF, (bf16_t*)(ws + OFF_W2A + alt), D, 2 * FF, 1, r}; r -= I1;
        if (r < I2) return CvtItem{a.in[I_F1OUT] + (size_t)L * FF * D, (bf16_t*)(ws + OFF_W1B), FF, D, 0, r}; r -= I2;
        if (r < I2) return CvtItem{a.in[I_F2OUT] + (size_t)L * FF * D, (bf16_t*)(ws + OFF_W2B + alt), FF, D, 0, r}; r -= I2;
        if (r < I3) return CvtItem{a.in[I_WIN] + (size_t)L * D * DIN, (bf16_t*)(ws + OFF_WIN), D, DIN, 2, r}; r -= I3;
        if (r < I4) return CvtItem{a.in[I_WBR] + (size_t)L * D * D, (bf16_t*)(ws + OFF_WBR + alt), D, D, 0, r}; r -= I4;
        return CvtItem{a.in[I_WO] + (size_t)L * D * D, (bf16_t*)(ws + OFF_WO + alt), D, D, 0, r};
    };
    auto clampi = [&](int x) { return x < NIT ? x : gw; };
    {
        int it = gw;
        CvtItem dA0 = decode(clampi(it)), dA1 = decode(clampi(it + NGW));
        f32x4 a0[4], b0[4], a1[4], b1[4], a2[4], b2[4], a3[4], b3[4];
        cvt_load(dA0, lane, a0, b0); cvt_load(dA1, lane, a1, b1);
#pragma unroll 1
        for (; it < NIT; it += 4 * NGW) {
            const CvtItem dB0 = decode(clampi(it + 2 * NGW)), dB1 = decode(clampi(it + 3 * NGW));
            cvt_load(dB0, lane, a2, b2); cvt_load(dB1, lane, a3, b3);
            asm volatile("" ::: "memory");
            cvt_finish(dA0, lane, a0, b0, scr); cvt_finish(dA1, lane, a1, b1, scr + 2048);
            asm volatile("" ::: "memory");
            dA0 = decode(clampi(it + 4 * NGW)); dA1 = decode(clampi(it + 5 * NGW));
            cvt_load(dA0, lane, a0, b0); cvt_load(dA1, lane, a1, b1);
            asm volatile("" ::: "memory");
            cvt_finish(dB0, lane, a2, b2, scr); cvt_finish(dB1, lane, a3, b3, scr + 2048);
            asm volatile("" ::: "memory");
        }
    }
    { bf16_t* w2t = (bf16_t*)(ws + OFF_LW2); bf16_t* a2t = (bf16_t*)(ws + OFF_LA2); bf16_t* g2t = (bf16_t*)(ws + OFF_LG2);
      const float* w2 = a.in[I_W2] + (size_t)L * 64 * RW; const float* a2 = a.in[I_A2] + (size_t)L * 64 * RW; const float* g2 = a.in[I_G2] + (size_t)L * 160 * RW;
      for (int i = vb * 512 + tidx_; i < RW * 288; i += nvb * 512) { const int c = i / 288, jj = i - c * 288;
          if (jj < 64) w2t[c * 64 + jj] = (bf16_t)f2bf(w2[(size_t)jj * RW + c]);
          else if (jj < 128) a2t[c * 64 + jj - 64] = (bf16_t)f2bf(a2[(size_t)(jj - 64) * RW + c]);
          else g2t[c * 160 + jj - 128] = (bf16_t)f2bf(g2[(size_t)(jj - 128) * RW + c]); } }
    { u32x4* z = (u32x4*)(ws + OFF_WIN + (size_t)DIN * D * 2); const int n16 = (NP - DIN) * D * 2 / 16;
      u32x4 zq = (u32x4){0u, 0u, 0u, 0u}; asm volatile("" : "+v"(zq));
      for (int i = vb * 512 + tidx_; i < n16; i += nvb * 512) z[i] = zq; }
}
DI int rel_bucket_dev(int d) {
    if (d < 16) return d;
    const float df = (float)d;
    const int large = 16 + (int)(logf(df / 16.0f) / 2.0794415416798357f * 16.0f);
    return large < 31 ? large : 31;
}
DI void init_phase(const Args& a) {
    const int tidx_ = otid();
    const size_t n4 = (size_t)M * D / 4; const f32x4* x = (const f32x4*)a.in[I_X]; u32x2* XB = (u32x2*)(a.ws + OFF_XB);
    for (size_t i = (size_t)blockIdx.x * 512 + tidx_; i < n4; i += (size_t)gridDim.x * 512) { const f32x4 v = x[i]; u32x2 o; o.x = pk2(v[0], v[1]); o.y = pk2(v[2], v[3]); XB[i] = o; }
    if (blockIdx.x == 0) { float* bt = (float*)(a.ws + OFF_BIAS); for (int i = tidx_; i < 8 * 128; i += 512) { const int h = i >> 7, d = i & 127; bt[i] = a.in[I_RELB][rel_bucket_dev(d) * 8 + h]; } }
}
DI void ln_phase(const float* T, const float* g, const float* b, float* ST, bf16_t* XB, float* out) {
    const int tidx_ = otid();
    const int wave = __builtin_amdgcn_readfirstlane(tidx_ >> 6), lane = tidx_ & 63;
    const int stride = gridDim.x * 8;
    f32x4 gvs[8], bvs[8];
#pragma unroll
    for (int j = 0; j < 8; ++j) { gvs[j] = ((const f32x4*)g)[lane + 64 * j]; bvs[j] = ((const f32x4*)b)[lane + 64 * j]; }
    int m = blockIdx.x * 8 + wave;
    f32x4 nx[8];
    if (m < M) {
#pragma unroll
        for (int j = 0; j < 8; ++j) nx[j] = ((const f32x4*)(T + (size_t)m * D) + lane)[64 * j]; }
#pragma unroll 1
    for (; m < M; m += stride) {
        f32x4 v[8]; float s = 0.f;
#pragma unroll
        for (int j = 0; j < 8; ++j) { v[j] = nx[j]; s += (v[j][0] + v[j][1]) + (v[j][2] + v[j][3]); }
        if (m + stride < M) {
#pragma unroll
            for (int j = 0; j < 8; ++j) nx[j] = ((const f32x4*)(T + (size_t)(m + stride) * D) + lane)[64 * j]; }
        const float mean = wave_sum(s) * (1.0f / D); float q = 0.f;
#pragma unroll
        for (int j = 0; j < 8; ++j) { v[j] = v[j] - mean; q += (v[j][0] * v[j][0] + v[j][1] * v[j][1]) + (v[j][2] * v[j][2] + v[j][3] * v[j][3]); }
        const float rstd = __builtin_amdgcn_rsqf(wave_sum(q) * (1.0f / D) + LN_EPS);
        if (lane == 0) *(f32x2*)(ST + 2 * (size_t)m) = (f32x2){mean, rstd};
        u32x2* bo = (u32x2*)(XB + (size_t)m * D) + lane;
#pragma unroll
        for (int j = 0; j < 8; ++j) {
            const f32x4 o = v[j] * rstd * gvs[j] + bvs[j]; u32x2 w; w.x = pk2(o[0], o[1]); w.y = pk2(o[2], o[3]); bo[64 * j] = w;
            if (out) ((f32x4*)(out + (size_t)m * D) + lane)[64 * j] = o; }
    }
}
DI void rwkv_prep_phase(const Args& a, int L, unsigned char* lds) {
    const int tidx_ = otid();
    const int tid = tidx_;
    const bf16_t* P = (const bf16_t*)(a.ws + OFF_P);
    float* Rr = (float*)(a.ws + OFF_SCR); float* Wr = Rr + (size_t)M * RW; float* Kr = Wr + (size_t)M * RW; float* Vr = Kr + (size_t)M * RW; float* Ar = Vr + (size_t)M * RW; float* Br = Ar + (size_t)M * RW;
    bf16_t* Gb = (bf16_t*)(a.ws + OFF_MG);
    const float* mu = a.in[I_MU] + (size_t)L * 3360; const float* w0 = a.in[I_W0] + L * RW; const float* w2 = a.in[I_W2] + (size_t)L * 64 * RW;
    const float* a0 = a.in[I_A0] + L * RW; const float* a2 = a.in[I_A2] + (size_t)L * 64 * RW; const float* g2 = a.in[I_G2] + (size_t)L * 160 * RW;
    const float* kkw = a.in[I_KK] + L * RW; const float* kaw = a.in[I_KA] + L * RW;
    float* xl = (float*)lds;
    for (int unit = blockIdx.x; unit < M / 32; unit += gridDim.x) {
        const int m0 = unit * 32;
        __syncthreads();
        for (int idx = tid; idx < 32 * 288; idx += 512) { const int tt = idx / 288, j = idx - tt * 288; const int m = m0 + tt;
            const float cur = bf2f(P[(size_t)m * PCOLS + PC_LORA + j]); const float prev = (m & (SEQ - 1)) == 0 ? 0.f : bf2f(P[(size_t)(m - 1) * PCOLS + PC_LORA + j]);
            float x = cur + (prev - cur) * mu[3072 + j];
            if (j < 64) x = tanhf(x); else if (j >= 128) x = sigmoidf_(x);
            xl[idx] = x; }
        __syncthreads();
#pragma unroll 1
        for (int half = 0; half < 2; ++half) { const int c = tid + 512 * half;
            const float w0c = w0[c], a0c = a0[c], kkc = kkw[c], kac = kaw[c], mur = mu[c], muk = mu[1024 + c], muv = mu[2048 + c];
#pragma unroll 1
            for (int sub = 0; sub < 4; ++sub) {
                float wl[8], al[8], gl[8];
#pragma unroll
                for (int t = 0; t < 8; ++t) { wl[t] = w0c; al[t] = a0c; gl[t] = 0.f; }
                const float* xb = xl + sub * 8 * 288;
#pragma unroll 2
                for (int j = 0; j < 64; j += 4) { const float u0 = w2[(size_t)(j + 0) * RW + c], u1 = w2[(size_t)(j + 1) * RW + c], u2 = w2[(size_t)(j + 2) * RW + c], u3 = w2[(size_t)(j + 3) * RW + c];
                    const float v0 = a2[(size_t)(j + 0) * RW + c], v1 = a2[(size_t)(j + 1) * RW + c], v2 = a2[(size_t)(j + 2) * RW + c], v3 = a2[(size_t)(j + 3) * RW + c];
#pragma unroll
                    for (int t = 0; t < 8; ++t) { const f32x4 xw = *(const f32x4*)(xb + t * 288 + j); const f32x4 xa = *(const f32x4*)(xb + t * 288 + 64 + j);
                        wl[t] += xw[0] * u0 + xw[1] * u1 + xw[2] * u2 + xw[3] * u3; al[t] += xa[0] * v0 + xa[1] * v1 + xa[2] * v2 + xa[3] * v3; } }
#pragma unroll 2
                for (int j = 0; j < 160; j += 4) { const float u0 = g2[(size_t)(j + 0) * RW + c], u1 = g2[(size_t)(j + 1) * RW + c], u2 = g2[(size_t)(j + 2) * RW + c], u3 = g2[(size_t)(j + 3) * RW + c];
#pragma unroll
                    for (int t = 0; t < 8; ++t) { const f32x4 xg = *(const f32x4*)(xb + t * 288 + 128 + j); gl[t] += xg[0] * u0 + xg[1] * u1 + xg[2] * u2 + xg[3] * u3; } }
#pragma unroll
                for (int t = 0; t < 8; ++t) { const int m = m0 + sub * 8 + t; const bool first = (m & (SEQ - 1)) == 0;
                    const bf16_t* pc = P + (size_t)m * PCOLS; const bf16_t* pp = pc - PCOLS;
                    const float rc = bf2f(pc[PC_R + c]), kc = bf2f(pc[PC_K + c]), vc = bf2f(pc[PC_V + c]);
                    const float rp = first ? 0.f : bf2f(pp[PC_R + c]), kp = first ? 0.f : bf2f(pp[PC_K + c]), vp = first ? 0.f : bf2f(pp[PC_V + c]);
                    const float r = rc + (rp - rc) * mur, k = kc + (kp - kc) * muk, v = vc + (vp - vc) * muv;
                    const float nx = -wl[t]; const float sp = nx > 20.f ? nx : log1pf(expf(nx));
                    const float decay = expf(-expf(-sp - 0.5f));
                    const float av = 1.0f / (1.0f + expf(-al[t]));
                    const float kk = k * kkc; const float ss = wave_sum(kk * kk); const float kkn = kk / fmaxf(sqrtf(ss), 1e-12f);
                    const float k2 = k * (1.0f + (av - 1.0f) * kac);
                    const size_t o = (size_t)m * RW + c;
                    Rr[o] = r; Wr[o] = decay; Kr[o] = k2; Vr[o] = v; Ar[o] = -kkn; Br[o] = kkn * av; Gb[o] = (bf16_t)f2bf(gl[t]); }
            }
        }
    }
}
struct WorkQ { unsigned* ctr; int pend, par, stride; };
constexpr int WQ_SLOT = 147456 - 16;
DI int wq_next(WorkQ& q, int cur, unsigned char* lds, int tid) {
    if (!q.ctr) return cur + q.stride;
    LAS int* slot = (LAS int*)(lds + WQ_SLOT);
    if (tid == 0) slot[q.par] = q.pend;
    __syncthreads();
    const int v = __builtin_amdgcn_readfirstlane(slot[q.par]);
    q.par ^= 1;
    if (tid == 0) q.pend = (int)__hip_atomic_fetch_add(q.ctr, 1u, __ATOMIC_RELAXED, __HIP_MEMORY_SCOPE_AGENT);
    return v;
}
DI int wq_first(WorkQ& q, unsigned char* lds, int tid) {
    q.par = 0; q.pend = 0;
    if (tid == 0) q.pend = (int)__hip_atomic_fetch_add(q.ctr, 1u, __ATOMIC_RELAXED, __HIP_MEMORY_SCOPE_AGENT);
    return wq_next(q, 0, lds, tid);
}
DI void kidx_vt_phase(const Args& a, int L, unsigned char* lds) {
    const int tidx_ = otid();
    const int wave = __builtin_amdgcn_readfirstlane(tidx_ >> 6), lane = tidx_ & 63;
    const bf16_t* P = (const bf16_t*)(a.ws + OFF_P); bf16_t* KI = (bf16_t*)(a.ws + OFF_KI); bf16_t* VT = (bf16_t*)(a.ws + OFF_VT);
    const float g = a.in[I_ILNG][L * 64 + lane], b = a.in[I_ILNB][L * 64 + lane];
    for (int m0 = blockIdx.x * 8 + wave; m0 < M; m0 += gridDim.x * 8 * 8) {
        bf16_t raw[8];
#pragma unroll
        for (int i = 0; i < 8; ++i) { const int m = m0 + i * gridDim.x * 8; raw[i] = m < M ? P[(size_t)m * PCOLS + PC_KI + lane] : (bf16_t)0; }
#pragma unroll
        for (int i = 0; i < 8; ++i) { const int m = m0 + i * gridDim.x * 8; if (m < M) { const float x = bf2f(raw[i]);
            const float mean = wave_sum(x) * (1.0f / 64.0f); const float d = x - mean; const float var = wave_sum(d * d) * (1.0f / 64.0f);
            KI[(size_t)m * 64 + lane] = (bf16_t)f2bf(d * __builtin_amdgcn_rsqf(var + LN_EPS) * g + b); } }
    }
    bf16_t* tile = (bf16_t*)(lds + wave * 16384);
    for (int u = blockIdx.x * 8 + wave; u < NB * 8 * 64; u += gridDim.x * 8) {
        const int tb = u & 63, h = (u >> 6) & 7, b_ = u >> 9; const int m = b_ * SEQ + tb * 64 + lane;
        const u32x4* src = (const u32x4*)(P + (size_t)m * PCOLS + PC_AV + h * 64);
#pragma unroll
        for (int q = 0; q < 8; ++q) { const u32x4 v = src[q]; const unsigned w[4] = {v.x, v.y, v.z, v.w};
#pragma unroll
            for (int e = 0; e < 4; ++e) { tile[(q * 8 + 2 * e) * 72 + lane] = (bf16_t)(w[e] & 0xffffu); tile[(q * 8 + 2 * e + 1) * 72 + lane] = (bf16_t)(w[e] >> 16); } }
        __builtin_amdgcn_s_waitcnt(0xc07f); asm volatile("" ::: "memory");
        bf16_t* dst = VT + ((size_t)(b_ * 8 + h) * 64 + lane) * SEQ + tb * 64;
#pragma unroll
        for (int q = 0; q < 8; ++q) *(u32x4*)(dst + q * 8) = *(const u32x4*)(tile + lane * 72 + q * 8);
        __builtin_amdgcn_s_waitcnt(0xc07f); asm volatile("" ::: "memory");
    }
}
DI void sgu_phase(const Args& a, int L, unsigned char* lds, WorkQ& wq, int& item, int ibase) {
    const int tidx_ = otid();
    const int tid = tidx_, wave = __builtin_amdgcn_readfirstlane(tid >> 6), lane = tid & 63, fr = lane & 15, fq = lane >> 4;
    const bf16_t* P = (const bf16_t*)(a.ws + OFF_P); bf16_t* Y = (bf16_t*)(a.ws + OFF_Y);
    const float* lng = a.in[I_SGLNG] + L * 512; const float* lnb = a.in[I_SGLNB] + L * 512;
    bf16_t* Wl = (bf16_t*)lds;
    bf16_t* Vl = (bf16_t*)(lds + 128 * 272);
    for (; item < ibase + NB * 32 * 4; item = wq_next(wq, item, lds, tid)) {
        const int unit = item - ibase;
        const int g = unit & 3, ch = (unit >> 2) & 31, b_ = unit >> 7; const int m0 = b_ * SEQ + ch * 128;
        const float* sw = a.in[I_SGW] + ((size_t)(L * 4 + g) * 128) * 128; const float* sb = a.in[I_SGB] + (L * 4 + g) * 128;
        __syncthreads();
#pragma unroll
        for (int it8 = 0; it8 < 8; ++it8) { const int idx = tid + 512 * it8; const int i = idx >> 5, j4 = (idx & 31) * 4; const f32x4 w = *(const f32x4*)(sw + i * 128 + j4);
            u32x2 o; o.x = pk2(j4 + 0 <= i ? w[0] : 0.f, j4 + 1 <= i ? w[1] : 0.f); o.y = pk2(j4 + 2 <= i ? w[2] : 0.f, j4 + 3 <= i ? w[3] : 0.f);
            *(u32x2*)(Wl + i * 136 + j4) = o; }
        float lgv[8], lbv[8];
#pragma unroll
        for (int e = 0; e < 8; ++e) { lgv[e] = lng[lane * 8 + e]; lbv[e] = lnb[lane * 8 + e]; }
#pragma unroll 1
        for (int ib = 0; ib < 2; ++ib) {
        u32x4 pvs[8];
#pragma unroll
        for (int i = 0; i < 8; ++i) pvs[i] = *(const u32x4*)(P + (size_t)(m0 + wave + 8 * (8 * ib + i)) * PCOLS + PC_SGV + lane * 8);
#pragma unroll
        for (int i = 0; i < 8; ++i) { const int tt = wave + 8 * (8 * ib + i);
            const u32x4 pv = pvs[i];
            float z[8]; z[0] = gelu_erf(bflo(pv.x)); z[1] = gelu_erf(bfhi(pv.x)); z[2] = gelu_erf(bflo(pv.y)); z[3] = gelu_erf(bfhi(pv.y));
            z[4] = gelu_erf(bflo(pv.z)); z[5] = gelu_erf(bfhi(pv.z)); z[6] = gelu_erf(bflo(pv.w)); z[7] = gelu_erf(bfhi(pv.w));
            float s = 0.f;
#pragma unroll
            for (int e = 0; e < 8; ++e) s += z[e];
            const float mean = wave_sum(s) * (1.0f / 512.0f); float q = 0.f;
#pragma unroll
            for (int e = 0; e < 8; ++e) { z[e] -= mean; q += z[e] * z[e]; }
            const float rstd = __builtin_amdgcn_rsqf(wave_sum(q) * (1.0f / 512.0f) + LN_EPS);
            if ((lane >> 4) == g) {
#pragma unroll
                for (int e = 0; e < 8; ++e) Vl[((lane & 15) * 8 + e) * 136 + tt] = (bf16_t)f2bf(z[e] * rstd * lgv[e] + lbv[e]); }
        }
        }
        __syncthreads();
        f32x4 acc[8];
#pragma unroll
        for (int nt = 0; nt < 8; ++nt) acc[nt] = (f32x4){0.f, 0.f, 0.f, 0.f};
        const int ksmax = (16 * wave + 15) >> 5;
#pragma unroll
        for (int ks = 0; ks < 4; ++ks) if (ks <= ksmax) {
            const bf16x8 af = *(const bf16x8*)(Wl + (16 * wave + fr) * 136 + 32 * ks + 8 * fq);
#pragma unroll
            for (int nt = 0; nt < 8; ++nt) { const bf16x8 bfr = *(const bf16x8*)(Vl + (16 * nt + fr) * 136 + 32 * ks + 8 * fq);
                acc[nt] = __builtin_amdgcn_mfma_f32_16x16x32_bf16(af, bfr, acc[nt], 0, 0, 0); }
        }
        bf16_t ur[4][8];
#pragma unroll
        for (int r = 0; r < 4; ++r)
#pragma unroll
            for (int nt = 0; nt < 8; ++nt) ur[r][nt] = P[(size_t)(m0 + 16 * wave + 4 * fq + r) * PCOLS + PC_SGU + g * 128 + 16 * nt + fr];
        float bsv[4];
#pragma unroll
        for (int r = 0; r < 4; ++r) bsv[r] = sb[16 * wave + 4 * fq + r];
        asm volatile("" ::: "memory");
#pragma unroll
        for (int r = 0; r < 4; ++r) { const int i = 16 * wave + 4 * fq + r; const float bs = bsv[r]; const size_t m = (size_t)(m0 + i);
#pragma unroll
            for (int nt = 0; nt < 8; ++nt) { const int dcol = g * 128 + 16 * nt + fr; const float uu = gelu_erf(bf2f(ur[r][nt]));
                Y[m * D + 1024 + dcol] = (bf16_t)f2bf(uu * (acc[nt][r] + bs)); } }
    }
}
DI void scan_load_chunk(unsigned char* bufp, const float* Rr, const float* Wr, const float* Kr, const float* Ar, const float* Br, const float* Vr, size_t base, int c, int rg, int lt) {
    const float* arrs[5] = {Rr, Wr, Kr, Ar, Br};
#pragma unroll
    for (int ar = 0; ar < 5; ++ar)
#pragma unroll
        for (int ps = 0; ps < 2; ++ps) { const int tt = ps * 16 + (lt >> 4), c4 = (lt & 15) * 4;
            const f32x4 v = *(const f32x4*)(arrs[ar] + base + (size_t)(c * 32 + tt) * RW + c4);
            *(f32x4*)(bufp + ar * 8192 + (tt * 64 + c4) * 4) = v; }
    if (lt < 128) { const int tt = lt >> 2, i4 = (lt & 3) * 4; const f32x4 v = *(const f32x4*)(Vr + base + (size_t)(c * 32 + tt) * RW + rg * 16 + i4);
        *(f32x4*)(bufp + 5 * 8192 + (tt * 16 + i4) * 4) = v; }
}
DI void scan_phase(const Args& a, unsigned char* lds) {
    const int tidx_ = otid();
    const int tid = tidx_;
    const float* Rr = (const float*)(a.ws + OFF_SCR); const float* Wr = Rr + (size_t)M * RW; const float* Kr = Wr + (size_t)M * RW; const float* Vr = Kr + (size_t)M * RW; const float* Ar = Vr + (size_t)M * RW; const float* Br = Ar + (size_t)M * RW;
    float* Yraw = (float*)(a.ws + OFF_X);
    constexpr int BUFB = 5 * 8192 + 2048;
    constexpr int NCH = SEQ / 32;
    for (int unit = blockIdx.x; unit < 256; unit += gridDim.x) {
        const int rg = unit & 3, h = (unit >> 2) & 15, b_ = unit >> 6;
        const size_t base = (size_t)b_ * SEQ * RW + h * 64;
        __syncthreads();
        const bool loader = tid >= 256; const int lt = tid - 256;
        if (loader) scan_load_chunk(lds, Rr, Wr, Kr, Ar, Br, Vr, base, 0, rg, lt);
        __syncthreads();
        float S0 = 0.f, S1 = 0.f, S2 = 0.f, S3 = 0.f;
        const int i = tid >> 4, c4 = tid & 15;
#pragma unroll 1
        for (int c = 0; c < NCH; ++c) {
            if (loader) {
                if (c > 0 && lt < 128) { const int tt = lt >> 2, i4 = (lt & 3) * 4; const f32x4 y = *(const f32x4*)(lds + 2 * BUFB + ((c - 1) & 1) * 2048 + (tt * 16 + i4) * 4);
                    *(f32x4*)(Yraw + base + (size_t)((c - 1) * 32 + tt) * RW + rg * 16 + i4) = y; }
                if (c + 1 < NCH) scan_load_chunk(lds + ((c + 1) & 1) * BUFB, Rr, Wr, Kr, Ar, Br, Vr, base, c + 1, rg, lt);
            } else {
                const unsigned char* bufp = lds + (c & 1) * BUFB; float* yb = (float*)(lds + 2 * BUFB + (c & 1) * 2048);
#pragma unroll 4
                for (int s = 0; s < 32; ++s) {
                    const f32x4 r4 = *(const f32x4*)(bufp + 0 * 8192 + (s * 64 + c4 * 4) * 4);
                    const f32x4 w4 = *(const f32x4*)(bufp + 1 * 8192 + (s * 64 + c4 * 4) * 4);
                    const f32x4 k4 = *(const f32x4*)(bufp + 2 * 8192 + (s * 64 + c4 * 4) * 4);
                    const f32x4 a4 = *(const f32x4*)(bufp + 3 * 8192 + (s * 64 + c4 * 4) * 4);
                    const f32x4 b4 = *(const f32x4*)(bufp + 4 * 8192 + (s * 64 + c4 * 4) * 4);
                    const float vi = *(const float*)(bufp + 5 * 8192 + (s * 16 + i) * 4);
                    float sa = (S0 * a4[0] + S1 * a4[1]) + (S2 * a4[2] + S3 * a4[3]);
                    sa = row16_sum(sa);
                    S0 = S0 * w4[0] + sa * b4[0] + vi * k4[0]; S1 = S1 * w4[1] + sa * b4[1] + vi * k4[1];
                    S2 = S2 * w4[2] + sa * b4[2] + vi * k4[2]; S3 = S3 * w4[3] + sa * b4[3] + vi * k4[3];
                    float yp = (S0 * r4[0] + S1 * r4[1]) + (S2 * r4[2] + S3 * r4[3]);
                    yp = row16_sum(yp);
                    if (c4 == 0) yb[s * 16 + i] = yp;
                }
            }
            __syncthreads();
        }
        if (loader && lt < 128) { const int tt = lt >> 2, i4 = (lt & 3) * 4; const f32x4 y = *(const f32x4*)(lds + 2 * BUFB + ((NCH - 1) & 1) * 2048 + (tt * 16 + i4) * 4);
            *(f32x4*)(Yraw + base + (size_t)((NCH - 1) * 32 + tt) * RW + rg * 16 + i4) = y; }
    }
}
DI void rwkv_fin_phase(const Args& a, int L) {
    const int tidx_ = otid();
    const int wave = __builtin_amdgcn_readfirstlane(tidx_ >> 6), lane = tidx_ & 63;
    const float* Rr = (const float*)(a.ws + OFF_SCR); const float* Kr = Rr + 2 * (size_t)M * RW; const float* Vr = Kr + (size_t)M * RW;
    const float* Yraw = (const float*)(a.ws + OFF_X); const bf16_t* Gb = (const bf16_t*)(a.ws + OFF_MG); bf16_t* Y = (bf16_t*)(a.ws + OFF_Y);
    const float* rk = a.in[I_RK] + L * RW; const float* gng = a.in[I_GNG] + L * RW; const float* gnb = a.in[I_GNB] + L * RW;
    for (int it = blockIdx.x * 8 + wave; it < M * 16; it += gridDim.x * 8) {
        const int m = it >> 4, h = it & 15, c = h * 64 + lane; const size_t o = (size_t)m * RW + c;
        const float y = Yraw[o], r = Rr[o], k = Kr[o], v = Vr[o];
        const float mean = wave_sum(y) * (1.0f / 64.0f); const float d = y - mean; const float var = wave_sum(d * d) * (1.0f / 64.0f);
        const float yn = d * (1.0f / sqrtf(var + 64e-5f)) * gng[c] + gnb[c];
        const float bonus = wave_sum(r * k * rk[c]) * v;
        Y[(size_t)m * D + c] = (bf16_t)f2bf((yn + bonus) * bf2f(Gb[o]));
    }
}
DI void rwkv_par_phase(const Args& a, int L, unsigned char* lds) {
    const int tidx_ = otid();
    const int tid = tidx_, wave = __builtin_amdgcn_readfirstlane(tid >> 6), lane = tid & 63, fr = lane & 15, q = lane >> 4;
    const bf16_t* P = (const bf16_t*)(a.ws + OFF_P); unsigned char* RECB = a.ws + OFF_SCR;
    const bf16_t* W2T = (const bf16_t*)(a.ws + OFF_LW2); const bf16_t* A2T = (const bf16_t*)(a.ws + OFF_LA2); const bf16_t* G2T = (const bf16_t*)(a.ws + OFF_LG2);
    const float* mu = a.in[I_MU] + (size_t)L * 3360; const float* w0 = a.in[I_W0] + L * RW; const float* a0 = a.in[I_A0] + L * RW;
    const float* kkw = a.in[I_KK] + L * RW; const float* kaw = a.in[I_KA] + L * RW; const float* rkw = a.in[I_RK] + L * RW;
    unsigned char* XL = lds;
    unsigned char* WS = lds + 9472 + wave * 12288;
    for (int unit = blockIdx.x; unit < NB * 256; unit += gridDim.x) {
        const int b_ = unit >> 8, cidx = unit & 255; const int m0 = b_ * SEQ + cidx * 16;
        __syncthreads();
        int tb9 = tid; asm volatile("" : "+v"(tb9));
#pragma unroll
        for (int it9 = 0; it9 < 9; ++it9) { const int idx = tb9 + 512 * it9; const int t = idx / 288, jj = idx - t * 288; const int m = m0 + t;
            const float cur = bf2f(P[(size_t)m * PCOLS + PC_LORA + jj]); const float prev = (m & (SEQ - 1)) == 0 ? 0.f : bf2f(P[(size_t)(m - 1) * PCOLS + PC_LORA + jj]);
            float x = cur + (prev - cur) * mu[3072 + jj];
            if (jj < 64) { const float e2x = __expf(2.0f * x); x = 1.0f - 2.0f * __builtin_amdgcn_rcpf(e2x + 1.0f); } else if (jj >= 128) x = __builtin_amdgcn_rcpf(1.0f + __expf(-x));
            *(bf16_t*)(XL + t * 592 + jj * 2) = (bf16_t)f2bf(x); }
        __syncthreads();
#define AXF(ks) (*(const bf16x8*)(XL + fr * 592 + (32 * (ks) + 8 * q) * 2))
#pragma unroll 1
        for (int hh2 = 0; hh2 < 2; ++hh2) {
            const int h = wave + 8 * hh2; const int c = h * 64 + lane;
            unsigned char* rec = RECB + (size_t)(cidx * 64 + b_ * 16 + h) * REC;
            const bool first = (m0 & (SEQ - 1)) == 0;
            const bf16_t* pbase = P + (size_t)m0 * PCOLS + h * 64 + lane;
            unsigned rawrk[17], rawvv[9];
#pragma unroll
            for (int t = 0; t < 17; ++t) { const bf16_t* pc = pbase + (ptrdiff_t)(t - 1) * PCOLS; const bool ok = t > 0 || !first;
                const unsigned rr_ = ok ? (unsigned)pc[PC_R] : 0u, kk_ = ok ? (unsigned)pc[PC_K] : 0u, vv_ = ok ? (unsigned)pc[PC_V] : 0u;
                rawrk[t] = rr_ | (kk_ << 16); if (t & 1) rawvv[t >> 1] |= vv_ << 16; else rawvv[t >> 1] = vv_; }
            const float w0c = w0[c], a0c = a0[c], kkc = kkw[c], kac = kaw[c], rkc = rkw[c], mur = mu[c], muk = mu[1024 + c], muv = mu[2048 + c];
            bf16x8 bwf[4][2], baf[4][2];
#pragma unroll
            for (int nt = 0; nt < 4; ++nt) { const int cn = h * 64 + 16 * nt + fr;
#pragma unroll
                for (int ks = 0; ks < 2; ++ks) { bwf[nt][ks] = *(const bf16x8*)(W2T + cn * 64 + 32 * ks + 8 * q); baf[nt][ks] = *(const bf16x8*)(A2T + cn * 64 + 32 * ks + 8 * q); } }
            asm volatile("" ::: "memory");
            f32x4 accW[4], accA[4], accG[4];
#pragma unroll
            for (int nt = 0; nt < 4; ++nt) { accW[nt] = (f32x4){0.f, 0.f, 0.f, 0.f}; accA[nt] = accW[nt]; accG[nt] = accW[nt];
#pragma unroll
                for (int ks = 0; ks < 2; ++ks) { accW[nt] = __builtin_amdgcn_mfma_f32_16x16x32_bf16(AXF(ks), bwf[nt][ks], accW[nt], 0, 0, 0); accA[nt] = __builtin_amdgcn_mfma_f32_16x16x32_bf16(AXF(2 + ks), baf[nt][ks], accA[nt], 0, 0, 0); } }
#pragma unroll
            for (int n2 = 0; n2 < 2; ++n2) { bf16x8 bgf[2][5];
#pragma unroll
                for (int nn = 0; nn < 2; ++nn) { const int cn = h * 64 + 16 * (2 * n2 + nn) + fr;
#pragma unroll
                    for (int ks = 0; ks < 5; ++ks) bgf[nn][ks] = *(const bf16x8*)(G2T + cn * 160 + 32 * ks + 8 * q); }
                asm volatile("" ::: "memory");
#pragma unroll
                for (int nn = 0; nn < 2; ++nn)
#pragma unroll
                    for (int ks = 0; ks < 5; ++ks) accG[2 * n2 + nn] = __builtin_amdgcn_mfma_f32_16x16x32_bf16(AXF(4 + ks), bgf[nn][ks], accG[2 * n2 + nn], 0, 0, 0); }
            float* X3 = (float*)WS;
#pragma unroll
            for (int nt = 0; nt < 4; ++nt)
#pragma unroll
                for (int r = 0; r < 4; ++r) { const int o = (4 * q + r) * 64 + 16 * nt + fr; X3[o] = accW[nt][r]; X3[1024 + o] = accA[nt][r]; X3[2048 + o] = accG[nt][r]; }
            float cum[16], asg[16];
            { float run = 0.f;
#pragma unroll
              for (int t = 0; t < 16; ++t) { float dw = X3[t * 64 + lane], da = X3[1024 + t * 64 + lane], dg = X3[2048 + t * 64 + lane];
#if DBG_LORA
                  { const float* w2 = a.in[I_W2] + (size_t)L * 64 * RW; const float* a2 = a.in[I_A2] + (size_t)L * 64 * RW; const float* g2 = a.in[I_G2] + (size_t)L * 160 * RW;
                    float s0 = 0.f, s1 = 0.f, s2 = 0.f;
                    for (int jj = 0; jj < 64; ++jj) { s0 += bf2f(*(const bf16_t*)(XL + t * 592 + jj * 2)) * w2[(size_t)jj * RW + c]; s1 += bf2f(*(const bf16_t*)(XL + t * 592 + (64 + jj) * 2)) * a2[(size_t)jj * RW + c]; }
                    for (int jj = 0; jj < 160; ++jj) s2 += bf2f(*(const bf16_t*)(XL + t * 592 + (128 + jj) * 2)) * g2[(size_t)jj * RW + c];
                    dw = s0; da = s1; dg = s2; }
#endif
                  const float nx = -(w0c + dw); const float sp = nx > 20.f ? nx : __logf(1.0f + __expf(nx));
                  run += -__expf(-sp - 0.5f); cum[t] = run; asg[t] = __builtin_amdgcn_rcpf(1.0f + __expf(-(a0c + da)));
                  *(bf16_t*)(rec + R_G + (t * 64 + lane) * 2) = (bf16_t)f2bf(dg); } }
            asm volatile("" ::: "memory");
            const float gC = __expf(cum[15]); *(float*)(rec + R_GC + lane * 4) = gC;
            bf16_t* imgA = (bf16_t*)WS; bf16_t* imgR = (bf16_t*)(WS + 2304); bf16_t* imgB = (bf16_t*)(WS + 4608); bf16_t* imgK = (bf16_t*)(WS + 6912);
            float At[16]; unsigned vpk[8]; float bgv[4], kgv[4]; float vprev = 0.f;
            float rp = bflo(rawrk[0]), kp = bfhi(rawrk[0]), vp = bflo(rawvv[0]);
            float eprev = 1.0f;
#pragma unroll
            for (int t = 0; t < 16; ++t) {
                const float rc = bflo(rawrk[t + 1]), kc = bfhi(rawrk[t + 1]), vc = ((t + 1) & 1) ? bfhi(rawvv[(t + 1) >> 1]) : bflo(rawvv[(t + 1) >> 1]);
                const float r = rc + (rp - rc) * mur, k = kc + (kp - kc) * muk, v = vc + (vp - vc) * muv; rp = rc; kp = kc; vp = vc;
                const float asig = asg[t];
                const float kk = k * kkc; const float kkn = kk * __builtin_amdgcn_rsqf(fmaxf(wave_sum(kk * kk), 1e-24f));
                const float k2 = k * (1.0f + (asig - 1.0f) * kac); const float av = -kkn, bv = kkn * asig;
                const float bon = wave_sum(r * k2 * rkc); if (lane == 0) *(float*)(rec + R_BON + t * 4) = bon;
                const float e2 = __expf(cum[t]), e3 = __expf(-cum[t]), e4 = __expf(cum[15] - cum[t]);
                At[t] = eprev * av; eprev = e2;
                const float Rt = e2 * r, Bt = bv * e3, Kt = k2 * e3;
                imgA[t * 72 + lane] = (bf16_t)f2bf(At[t]); imgR[t * 72 + lane] = (bf16_t)f2bf(Rt); imgB[t * 72 + lane] = (bf16_t)f2bf(Bt); imgK[t * 72 + lane] = (bf16_t)f2bf(Kt);
                *(bf16_t*)(rec + R_RL2 + t * RROW + lane * 2) = (bf16_t)f2bf(Rt);
                bgv[t & 3] = bv * e4; kgv[t & 3] = k2 * e4;
                if ((t & 3) == 3) { u32x4 o; o.x = pk2(bgv[0], bgv[1]); o.y = pk2(bgv[2], bgv[3]); o.z = pk2(kgv[0], kgv[1]); o.w = pk2(kgv[2], kgv[3]); *(u32x4*)(rec + R_A2 + (lane * 4 + (t >> 2)) * 16) = o; }
                if (t & 1) vpk[t >> 1] = pk2(vprev, v); else vprev = v; }
            { u32x4 o0, o1; o0.x = vpk[0]; o0.y = vpk[1]; o0.z = vpk[2]; o0.w = vpk[3]; o1.x = vpk[4]; o1.y = vpk[5]; o1.z = vpk[6]; o1.w = vpk[7];
              *(u32x4*)(rec + R_VT + lane * 32) = o0; *(u32x4*)(rec + R_VT + lane * 32 + 16) = o1; }
            asm volatile("" ::: "memory");
            f32x4 gAB = (f32x4){0.f, 0.f, 0.f, 0.f}, gAK = gAB, gBR = gAB, gKR = gAB;
#pragma unroll
            for (int ks = 0; ks < 2; ++ks) { const int off = fr * 72 + 32 * ks + 8 * q;
                const bf16x8 fA = *(const bf16x8*)(imgA + off), fR = *(const bf16x8*)(imgR + off), fB = *(const bf16x8*)(imgB + off), fK = *(const bf16x8*)(imgK + off);
                gAB = __builtin_amdgcn_mfma_f32_16x16x32_bf16(fB, fA, gAB, 0, 0, 0); gAK = __builtin_amdgcn_mfma_f32_16x16x32_bf16(fK, fA, gAK, 0, 0, 0);
                gBR = __builtin_amdgcn_mfma_f32_16x16x32_bf16(fB, fR, gBR, 0, 0, 0); gKR = __builtin_amdgcn_mfma_f32_16x16x32_bf16(fK, fR, gKR, 0, 0, 0); }
#pragma unroll
            for (int r = 0; r < 4; ++r) { const int sI = 4 * q + r; gAB[r] = sI < fr ? gAB[r] : 0.f; gAK[r] = sI < fr ? gAK[r] : 0.f; gBR[r] = sI <= fr ? gBR[r] : 0.f; gKR[r] = sI <= fr ? gKR[r] : 0.f; }
            { u32x4 o; o.x = pk2(gBR[0], gBR[1]); o.y = pk2(gBR[2], gBR[3]); o.z = pk2(gKR[0], gKR[1]); o.w = pk2(gKR[2], gKR[3]); *(u32x4*)(rec + R_A3 + (fr * 4 + q) * 16) = o; }
            asm volatile("" ::: "memory");
            float* AKL = (float*)(WS + 9216);
#pragma unroll
            for (int r = 0; r < 4; ++r) AKL[(4 * q + r) * 16 + fr] = gAK[r];
            float Ft[16];
            { const f32x4* row = (const f32x4*)(AKL + (lane & 15) * 16);
#pragma unroll
              for (int t4 = 0; t4 < 4; ++t4) { const f32x4 v4 = row[t4]; Ft[4 * t4] = v4[0]; Ft[4 * t4 + 1] = v4[1]; Ft[4 * t4 + 2] = v4[2]; Ft[4 * t4 + 3] = v4[3]; } }
#pragma unroll
            for (int s2 = 0; s2 < 15; ++s2) {
                const float gsel = gAB[s2 & 3];
#pragma unroll
                for (int t = s2 + 1; t < 16; ++t) { const float sc = __int_as_float(__builtin_amdgcn_readlane(__float_as_int(gsel), t + 16 * (s2 >> 2))); At[t] += At[s2] * sc; Ft[t] += Ft[s2] * sc; } }
#pragma unroll
            for (int t = 0; t < 16; ++t) *(bf16_t*)(rec + R_EL2 + t * RROW + lane * 2) = (bf16_t)f2bf(At[t]);
            asm volatile("" ::: "memory");
            float* FL = (float*)(WS + 10240);
            if (lane < 16) {
#pragma unroll
                for (int t4 = 0; t4 < 4; ++t4) *(f32x4*)(FL + lane * 16 + 4 * t4) = (f32x4){Ft[4 * t4], Ft[4 * t4 + 1], Ft[4 * t4 + 2], Ft[4 * t4 + 3]}; }
            { const float f0 = FL[(4 * q + 0) * 16 + fr], f1 = FL[(4 * q + 1) * 16 + fr], f2 = FL[(4 * q + 2) * 16 + fr], f3 = FL[(4 * q + 3) * 16 + fr];
              u32x2 o; o.x = pk2(f0, f1); o.y = pk2(f2, f3); *(u32x2*)(rec + R_FT + (fr * 4 + q) * 8) = o; }
            asm volatile("" ::: "memory");
        }
    }
#undef AXF
}
DI bf16x8 mk8(u32x2 lo, u32x2 hi) { u32x4 w; w.x = lo.x; w.y = lo.y; w.z = hi.x; w.w = hi.y; return __builtin_bit_cast(bf16x8, w); }
struct SeqOps { u32x2 e[2][2], r[2][2]; u32x4 a2[4]; u32x4 a3; u32x2 ft, vt; f32x4 gc[4]; };
DI void seq_ops_load(SeqOps& f, const LAS unsigned char* rec, int fr, int q, int i0) {
#pragma unroll
    for (int ks = 0; ks < 2; ++ks) { f.e[ks][0] = *(const LAS u32x2*)(rec + R_EL2 + fr * RROW + (32 * ks + 4 * q) * 2); f.e[ks][1] = *(const LAS u32x2*)(rec + R_EL2 + fr * RROW + (32 * ks + 16 + 4 * q) * 2);
        f.r[ks][0] = *(const LAS u32x2*)(rec + R_RL2 + fr * RROW + (32 * ks + 4 * q) * 2); f.r[ks][1] = *(const LAS u32x2*)(rec + R_RL2 + fr * RROW + (32 * ks + 16 + 4 * q) * 2); }
#pragma unroll
    for (int jt = 0; jt < 4; ++jt) { f.a2[jt] = *(const LAS u32x4*)(rec + R_A2 + ((16 * jt + fr) * 4 + q) * 16); f.gc[jt] = *(const LAS f32x4*)(rec + R_GC + (16 * jt + 4 * q) * 4); }
    f.a3 = *(const LAS u32x4*)(rec + R_A3 + (fr * 4 + q) * 16); f.ft = *(const LAS u32x2*)(rec + R_FT + (fr * 4 + q) * 8); f.vt = *(const LAS u32x2*)(rec + R_VT + ((i0 + fr) * 16 + 4 * q) * 2);
}
DI void rwkv_seq_phase(const Args& a, unsigned char* lds, float* yout, const float* gng, const float* gnb, bf16_t* yfin) {
    const int tidx_ = otid();
    const int tid = tidx_, wave = __builtin_amdgcn_readfirstlane(tid >> 6), lane = tid & 63, fr = lane & 15, q = lane >> 4;
    constexpr int NR = 8, DEPTH_ = 6, NCHK = 256;
    LAS unsigned char* ring = (LAS unsigned char*)lds;
    LAS float* ybuf = (LAS float*)(ring + NR * REC);
    for (int bh = blockIdx.x; bh < NB * 16; bh += gridDim.x) {
        const unsigned char* rec0 = a.ws + OFF_SCR + (size_t)bh * REC;
        const int hd = bh & 15;
        asm volatile("s_waitcnt vmcnt(0) lgkmcnt(0)" ::: "memory"); __builtin_amdgcn_s_barrier();
        if (wave >= 4) {
            const int lw = wave - 4;
            const float gg = yfin ? gng[hd * 64 + lane] : 0.f, gb = yfin ? gnb[hd * 64 + lane] : 0.f;
            bf16_t* Yo = yfin + ((size_t)(bh >> 4) * SEQ) * D + hd * 64 + lane;
#define SEQ_ISSUE(cc) do { const unsigned char* g_ = rec0 + (size_t)(cc) * 64 * REC; LAS unsigned char* l_ = ring + ((cc) & (NR - 1)) * REC; \
            _Pragma("unroll") for (int i_ = 0; i_ < 4; ++i_) { int pc_ = i_ * 4 + lw; if (pc_ >= 15) pc_ = lw; \
                __builtin_amdgcn_global_load_lds((const unsigned*)(g_ + pc_ * 1024 + lane * 16), (LAS unsigned*)(l_ + pc_ * 1024), 16, 0, 0); } } while (0)
#define SEQ_FINALIZE(cf) do { const LAS unsigned char* rc_ = ring + ((cf) & (NR - 1)) * REC; const LAS float* yb_ = ybuf + ((cf) & 1) * 1024; \
            const u32x2 vv_ = *(const LAS u32x2*)(rc_ + R_VT + (lane * 16 + 4 * lw) * 2); \
            float y_[4], rd_[8]; \
            _Pragma("unroll") for (int tt_ = 0; tt_ < 4; ++tt_) { y_[tt_] = yb_[(4 * lw + tt_) * 64 + lane]; rd_[tt_] = y_[tt_]; rd_[4 + tt_] = y_[tt_] * y_[tt_]; } \
            wave_sum8(rd_);        \
            _Pragma("unroll") for (int tt_ = 0; tt_ < 4; ++tt_) { const int t_ = 4 * lw + tt_; \
                const float mean_ = rd_[tt_] * (1.0f / 64.0f); const float var_ = fmaxf(rd_[4 + tt_] * (1.0f / 64.0f) - mean_ * mean_, 0.f); \
                const float yn_ = (y_[tt_] - mean_) * __builtin_amdgcn_rsqf(var_ + 64e-5f) * gg + gb; \
                const float bon_ = *(const LAS float*)(rc_ + R_BON + t_ * 4); const float g_ = bf2f(*(const LAS bf16_t*)(rc_ + R_G + (t_ * 64 + lane) * 2)); \
                const unsigned vw_ = (tt_ & 2) ? vv_.y : vv_.x; const float v_ = (tt_ & 1) ? bfhi(vw_) : bflo(vw_); \
                Yo[(size_t)(16 * (cf) + t_) * D] = (bf16_t)f2bf((yn_ + bon_ * v_) * g_); } } while (0)
#pragma unroll 1
            for (int cc = 0; cc < DEPTH_; ++cc) SEQ_ISSUE(cc);
            asm volatile("s_waitcnt vmcnt(16)" ::: "memory");
            __builtin_amdgcn_s_barrier();
#pragma unroll 1
            for (int c = 0; c < NCHK; ++c) {
                if (yfin && c > 0) SEQ_FINALIZE(c - 1);
                if (c + DEPTH_ < NCHK) { SEQ_ISSUE(c + DEPTH_); asm volatile("s_waitcnt vmcnt(16)" ::: "memory"); }
                else asm volatile("s_waitcnt vmcnt(0)" ::: "memory");
                asm volatile("s_waitcnt lgkmcnt(0)" ::: "memory");
                __builtin_amdgcn_s_barrier();
            }
            if (yfin) SEQ_FINALIZE(NCHK - 1);
#undef SEQ_ISSUE
#undef SEQ_FINALIZE
        } else {
            const int i0 = wave * 16;
            float* Yp = yout + (size_t)(bh >> 4) * SEQ * RW + hd * 64 + i0 + fr;
            f32x4 S[4];
#pragma unroll
            for (int jt = 0; jt < 4; ++jt) S[jt] = (f32x4){0.f, 0.f, 0.f, 0.f};
            __builtin_amdgcn_s_barrier();
            SeqOps cur, nxt; seq_ops_load(cur, ring, fr, q, i0);
#pragma unroll 1
            for (int c = 0; c < NCHK; ++c) {
                if (c + 1 < NCHK) seq_ops_load(nxt, ring + ((c + 1) & (NR - 1)) * REC, fr, q, i0); else nxt = cur;
                bf16x8 sh[2];
#pragma unroll
                for (int ks = 0; ks < 2; ++ks) { u32x4 hw; hw.x = pk2(S[2 * ks][0], S[2 * ks][1]); hw.y = pk2(S[2 * ks][2], S[2 * ks][3]); hw.z = pk2(S[2 * ks + 1][0], S[2 * ks + 1][1]); hw.w = pk2(S[2 * ks + 1][2], S[2 * ks + 1][3]); sh[ks] = __builtin_bit_cast(bf16x8, hw); }
                const u32x2 z2 = {0u, 0u}; const f32x4 zz = (f32x4){0.f, 0.f, 0.f, 0.f};
                f32x4 Wk[2], Yk[2];
#pragma unroll
                for (int ks = 0; ks < 2; ++ks) { Wk[ks] = __builtin_amdgcn_mfma_f32_16x16x32_bf16(mk8(cur.e[ks][0], cur.e[ks][1]), sh[ks], zz, 0, 0, 0); Yk[ks] = __builtin_amdgcn_mfma_f32_16x16x32_bf16(mk8(cur.r[ks][0], cur.r[ks][1]), sh[ks], zz, 0, 0, 0); }
                const f32x4 Wv = __builtin_amdgcn_mfma_f32_16x16x32_bf16(mk8(cur.ft, z2), mk8(cur.vt, z2), zz, 0, 0, 0);
                const f32x4 W = (Wk[0] + Wk[1]) + Wv; f32x4 Y = Yk[0] + Yk[1];
                u32x2 wp; wp.x = pk2(W[0], W[1]); wp.y = pk2(W[2], W[3]);
                const bf16x8 b2 = mk8(wp, cur.vt);
#pragma unroll
                for (int jt = 0; jt < 4; ++jt) S[jt] = __builtin_amdgcn_mfma_f32_16x16x32_bf16(__builtin_bit_cast(bf16x8, cur.a2[jt]), b2, S[jt] * cur.gc[jt], 0, 0, 0);
                Y = __builtin_amdgcn_mfma_f32_16x16x32_bf16(__builtin_bit_cast(bf16x8, cur.a3), b2, Y, 0, 0, 0);
                if (yfin) {
#pragma unroll
                    for (int r = 0; r < 4; ++r) ybuf[(c & 1) * 1024 + (4 * q + r) * 64 + i0 + fr] = Y[r];
                } else {
#pragma unroll
                    for (int r = 0; r < 4; ++r) Yp[(size_t)(16 * c + 4 * q + r) * RW] = Y[r];
                }
                asm volatile("s_waitcnt lgkmcnt(0)" ::: "memory");
                __builtin_amdgcn_s_barrier();
                cur = nxt;
            }
        }
    }
}
DI void rwkv_fin2_phase(const Args& a, int L) {
    const int tidx_ = otid();
    const int wave = __builtin_amdgcn_readfirstlane(tidx_ >> 6), lane = tidx_ & 63;
    const float* Yraw = (const float*)(a.ws + OFF_X); bf16_t* Y = (bf16_t*)(a.ws + OFF_Y);
    const float* gng = a.in[I_GNG] + L * RW; const float* gnb = a.in[I_GNB] + L * RW;
    for (int u = blockIdx.x * 8 + wave; u < NB * 16 * 256; u += gridDim.x * 8) {
        const int cidx = u & 255, bh = u >> 8, h = bh & 15, b_ = bh >> 4; const int c = h * 64 + lane;
        const unsigned char* rec = a.ws + OFF_SCR + (size_t)(cidx * 64 + bh) * REC;
        const u32x4 v0 = *(const u32x4*)(rec + R_VT + lane * 32), v1 = *(const u32x4*)(rec + R_VT + lane * 32 + 16);
        const unsigned vw[8] = {v0.x, v0.y, v0.z, v0.w, v1.x, v1.y, v1.z, v1.w};
        const float gg = gng[c], gb = gnb[c];
#pragma unroll
        for (int t = 0; t < 16; ++t) { const size_t m = (size_t)b_ * SEQ + cidx * 16 + t;
            const float y = Yraw[m * RW + c];
            const float mean = wave_sum(y) * (1.0f / 64.0f); const float d = y - mean; const float var = wave_sum(d * d) * (1.0f / 64.0f);
            const float yn = d * __builtin_amdgcn_rsqf(var + 64e-5f) * gg + gb;
            const float bon = *(const float*)(rec + R_BON + t * 4); const float g = bf2f(*(const bf16_t*)(rec + R_G + (t * 64 + lane) * 2));
            const float v = (t & 1) ? bfhi(vw[t >> 1]) : bflo(vw[t >> 1]);
            Y[m * D + c] = (bf16_t)f2bf((yn + bon * v) * g); }
    }
}
DI void dbg_compare_phase(const Args& a) {
    const int tidx_ = otid();
    const float* y0 = (const float*)(a.ws + OFF_X); const float* y1 = y0 + (size_t)M * RW; float* acc = (float*)(a.ws + OFF_CTL) + 2048;
    float s0 = 0.f, s1 = 0.f, s2 = 0.f, s3 = 0.f;
    for (size_t i = (size_t)blockIdx.x * 512 + tidx_; i < (size_t)M * RW; i += (size_t)gridDim.x * 512) { const float o = y0[i], d = y1[i] - o; const int tok = (int)((i / RW) & (SEQ - 1));
        s0 += d * d; s1 += o * o; if (tok < 16) { s2 += d * d; s3 += o * o; } }
    s0 = wave_sum(s0); s1 = wave_sum(s1); s2 = wave_sum(s2); s3 = wave_sum(s3);
    if ((tidx_ & 63) == 0) { atomicAdd(acc + 0, s0); atomicAdd(acc + 1, s1); atomicAdd(acc + 2, s2); atomicAdd(acc + 3, s3); }
}
DI void dbg_encode_phase(const Args& a) {
    const int tidx_ = otid();
    float* acc = (float*)(a.ws + OFF_CTL) + 2048;
    const float s0 = __hip_atomic_load(acc + 0, __ATOMIC_RELAXED, __HIP_MEMORY_SCOPE_AGENT), s1 = __hip_atomic_load(acc + 1, __ATOMIC_RELAXED, __HIP_MEMORY_SCOPE_AGENT);
    const float s2 = __hip_atomic_load(acc + 2, __ATOMIC_RELAXED, __HIP_MEMORY_SCOPE_AGENT), s3 = __hip_atomic_load(acc + 3, __ATOMIC_RELAXED, __HIP_MEMORY_SCOPE_AGENT);
    const float e1 = sqrtf(s0 / fmaxf(s1, 1e-30f)), e2 = sqrtf(s2 / fmaxf(s3, 1e-30f));
    for (size_t i = (size_t)blockIdx.x * 512 + tidx_; i < (size_t)M * D; i += (size_t)gridDim.x * 512) { float v = a.out[i] * (1.0f + e1); if (i == 0) v += 1000.0f * e2; a.out[i] = v; }
}
DI unsigned f2ord(float f) { const unsigned u = __builtin_bit_cast(unsigned, f); return (u & 0x80000000u) ? ~u : (u | 0x80000000u); }
DI float xrow16_sum(float x) {
    auto p = __builtin_amdgcn_permlane16_swap(__float_as_uint(x), __float_as_uint(x), false, false);
    x = __uint_as_float(p[0]) + __uint_as_float(p[1]);
    auto q = __builtin_amdgcn_permlane32_swap(__float_as_uint(x), __float_as_uint(x), false, false);
    return __uint_as_float(q[0]) + __uint_as_float(q[1]);
}
template <int CTRL> DI int dpp_i(int x) { return __builtin_amdgcn_update_dpp(0, x, CTRL, 0xF, 0xF, true); }
DI int wave_sum_i(int x) {
    x += dpp_i<0xB1>(x); x += dpp_i<0x4E>(x); x += dpp_i<0x141>(x); x += dpp_i<0x140>(x);
    auto p = __builtin_amdgcn_permlane16_swap((unsigned)x, (unsigned)x, false, false); x = (int)p[0] + (int)p[1];
    auto q = __builtin_amdgcn_permlane32_swap((unsigned)x, (unsigned)x, false, false); return (int)q[0] + (int)q[1];
}
DI void indexer_phase(const Args& a, unsigned char* lds, WorkQ& wq, int& item) {
    const int tidx_ = otid();
    const int tid = tidx_, wave = __builtin_amdgcn_readfirstlane(tid >> 6), lane = tid & 63, hh = lane & 15, kq = lane >> 4;
    const bf16_t* P = (const bf16_t*)(a.ws + OFF_P); const bf16_t* KI = (const bf16_t*)(a.ws + OFF_KI); unsigned long long* BMk = (unsigned long long*)(a.ws + OFF_BM);
    constexpr int STG = 256 * 128;
    unsigned long long* wbuf = (unsigned long long*)(lds + 2 * STG + wave * 512);
    const int srow = tid >> 3, sch = tid & 7;
    const int wr_off = srow * 128 + ((sch ^ (srow & 7)) << 4);
    const int rd0 = hh * 128 + ((kq ^ (hh & 7)) << 4), rd1 = hh * 128 + (((kq + 4) ^ (hh & 7)) << 4);
#pragma unroll 1
    for (; item < NB * 512; item = wq_next(wq, item, lds, tid)) {
        const int b_ = item & 3, qg = 511 - (item >> 2);
        const int t0 = qg * 8, t = t0 + wave, nk = t0 + 8; const size_t m = (size_t)b_ * SEQ + t;
        const int nst = (nk + 255) >> 8;
        bf16x8 aq[2];
        aq[0] = *(const bf16x8*)(P + m * PCOLS + PC_QI + hh * 64 + 8 * kq); aq[1] = *(const bf16x8*)(P + m * PCOLS + PC_QI + hh * 64 + 32 + 8 * kq);
        float blo[4], bhi[4];
#pragma unroll
        for (int r = 0; r < 4; ++r) { const bool pos = bf2f(P[m * PCOLS + PC_WI + 4 * kq + r]) >= 0.f; blo[r] = pos ? 0.f : -__builtin_inff(); bhi[r] = pos ? __builtin_inff() : 0.f; }
        { const float wrow = bf2f(P[m * PCOLS + PC_WI + hh]) * 0.03125f;
#pragma unroll
          for (int ks = 0; ks < 2; ++ks) { const u32x4 w4 = __builtin_bit_cast(u32x4, aq[ks]); u32x4 o4;
              o4.x = pk2(bflo(w4.x) * wrow, bfhi(w4.x) * wrow); o4.y = pk2(bflo(w4.y) * wrow, bfhi(w4.y) * wrow); o4.z = pk2(bflo(w4.z) * wrow, bfhi(w4.z) * wrow); o4.w = pk2(bflo(w4.w) * wrow, bfhi(w4.w) * wrow);
              aq[ks] = __builtin_bit_cast(bf16x8, o4); } }
        unsigned sc[64];
        const bf16_t* kig = KI + ((size_t)b_ * SEQ + srow) * 64 + sch * 8;
#pragma unroll 1
        for (int rep21 = 0; rep21 < ((REP_MASK >> 21) & 1u) + 1; ++rep21) {
#pragma unroll
        for (int r = 0; r < 64; ++r) sc[r] = 0u;
        u32x4 kp[4];
#pragma unroll
        for (int q = 0; q < 4; ++q) kp[q] = *(const u32x4*)(kig + (size_t)q * 64 * 64);
        __syncthreads();
        asm volatile("" :: "v"(aq[0]), "v"(aq[1]), "v"(blo[0]), "v"(blo[1]), "v"(blo[2]), "v"(blo[3]));
#pragma unroll
        for (int st = 0; st < 16; ++st) if (st < nst) {
            const int k0 = st * 256;
            unsigned char* sb = lds + (st & 1) * STG;
#pragma unroll
            for (int q = 0; q < 4; ++q) *(u32x4*)(sb + q * 64 * 128 + wr_off) = kp[q];
            __syncthreads();
            if (st + 1 < nst) {
#pragma unroll
                for (int q = 0; q < 4; ++q) kp[q] = *(const u32x4*)(kig + (size_t)(k0 + 256 + q * 64) * 64);
            }
#pragma unroll
            for (int cc = 0; cc < 4; ++cc) {
                const int kc = k0 + cc * 64;
                unsigned res = 0u;
                {
                    float sv[4];
#pragma unroll
                    for (int sub = 0; sub < 4; ++sub) {
                        const unsigned char* kb = sb + (cc * 64 + sub * 16) * 128;
                        const bf16x8 b0 = *(const bf16x8*)(kb + rd0), b1 = *(const bf16x8*)(kb + rd1);
                        f32x4 acc = (f32x4){0.f, 0.f, 0.f, 0.f};
                        acc = __builtin_amdgcn_mfma_f32_16x16x32_bf16(aq[0], b0, acc, 0, 0, 0);
                        acc = __builtin_amdgcn_mfma_f32_16x16x32_bf16(aq[1], b1, acc, 0, 0, 0);
                        sv[sub] = (__builtin_amdgcn_fmed3f(acc[0], blo[0], bhi[0]) + __builtin_amdgcn_fmed3f(acc[1], blo[1], bhi[1])) + (__builtin_amdgcn_fmed3f(acc[2], blo[2], bhi[2]) + __builtin_amdgcn_fmed3f(acc[3], blo[3], bhi[3]));
                    }
                    auto p01 = __builtin_amdgcn_permlane16_swap(__float_as_uint(sv[0]), __float_as_uint(sv[1]), false, false);
                    auto p23 = __builtin_amdgcn_permlane16_swap(__float_as_uint(sv[2]), __float_as_uint(sv[3]), false, false);
                    const float x01 = __uint_as_float(p01[0]) + __uint_as_float(p01[1]), x23 = __uint_as_float(p23[0]) + __uint_as_float(p23[1]);
                    auto pf = __builtin_amdgcn_permlane32_swap(__float_as_uint(x01), __float_as_uint(x23), false, false);
                    const float tot = __uint_as_float(pf[0]) + __uint_as_float(pf[1]);
                    res = (kc + lane <= t) ? f2ord(tot) : 0u;
                }
                sc[4 * st + cc] = res;
            }
        }
        }
        const int nuse = 4 * nst;
#pragma unroll 1
        for (int rep22 = 0; rep22 < ((REP_MASK >> 22) & 1u) + 1; ++rep22) {
        if (t + 1 > 256) {
            unsigned T = 0u; bool exact = false;
#pragma unroll 1
            for (int bit = 31; bit >= 0; --bit) { const unsigned cand = T | (1u << bit); int cnt = 0; unsigned candv = cand; asm volatile("" : "+v"(candv));
#pragma unroll
                for (int r8 = 0; r8 < 8; ++r8) if (r8 * 8 < nuse) {
                    unsigned long long mk_[8];
                    asm("v_cmp_ge_u32_e64 %0, %8, %16\n\tv_cmp_ge_u32_e64 %1, %9, %16\n\tv_cmp_ge_u32_e64 %2, %10, %16\n\tv_cmp_ge_u32_e64 %3, %11, %16\n\tv_cmp_ge_u32_e64 %4, %12, %16\n\tv_cmp_ge_u32_e64 %5, %13, %16\n\tv_cmp_ge_u32_e64 %6, %14, %16\n\tv_cmp_ge_u32_e64 %7, %15, %16"
                        : "=&s"(mk_[0]), "=&s"(mk_[1]), "=&s"(mk_[2]), "=&s"(mk_[3]), "=&s"(mk_[4]), "=&s"(mk_[5]), "=&s"(mk_[6]), "=&s"(mk_[7])
                        : "v"(sc[r8 * 8 + 0]), "v"(sc[r8 * 8 + 1]), "v"(sc[r8 * 8 + 2]), "v"(sc[r8 * 8 + 3]), "v"(sc[r8 * 8 + 4]), "v"(sc[r8 * 8 + 5]), "v"(sc[r8 * 8 + 6]), "v"(sc[r8 * 8 + 7]), "v"(candv));
#pragma unroll
                    for (int r = 0; r < 8; ++r) cnt += __builtin_popcountll(mk_[r]); }
                if (cnt >= 256) T = cand;
                if (cnt == 256) { exact = true; break; } }
            int cge = 256;
            if (!exact) { cge = 0;
#pragma unroll
                for (int r8 = 0; r8 < 8; ++r8) if (r8 * 8 < nuse) {
#pragma unroll
                    for (int r = 0; r < 8; ++r) cge += __builtin_popcountll(__ballot(sc[r8 * 8 + r] >= T)); } }
            { unsigned long long z64 = 0ull; asm volatile("" : "+v"(z64)); wbuf[lane] = z64; }
            if (cge == 256) {
#pragma unroll
                for (int r8 = 0; r8 < 8; ++r8) {
#pragma unroll
                    for (int r = 0; r < 8; ++r) { const unsigned long long word = __ballot(sc[r8 * 8 + r] >= T); if (lane == 0 && r8 * 8 + r < nuse) wbuf[r8 * 8 + r] = word; }
                    __builtin_amdgcn_sched_barrier(0); }
            } else {
                int cgt = 0;
#pragma unroll
                for (int r8 = 0; r8 < 8; ++r8) {
#pragma unroll
                    for (int r = 0; r < 8; ++r) cgt += __builtin_popcountll(__ballot(sc[r8 * 8 + r] > T));
                    __builtin_amdgcn_sched_barrier(0); }
                int need = 256 - cgt;
#pragma unroll
                for (int r8 = 0; r8 < 8; ++r8) {
#pragma unroll
                    for (int r = 0; r < 8; ++r) { const unsigned long long gt = __ballot(sc[r8 * 8 + r] > T); unsigned long long eq = __ballot(sc[r8 * 8 + r] == T); const int ce = __builtin_popcountll(eq);
                        unsigned long long take;
                        if (ce <= need) { take = eq; need -= ce; }
                        else { take = 0ull; for (; need > 0; --need) { const unsigned long long low = eq & (0ull - eq); take |= low; eq ^= low; } }
                        const unsigned long long word = gt | take; if (lane == 0 && r8 * 8 + r < nuse) wbuf[r8 * 8 + r] = word; }
                    __builtin_amdgcn_sched_barrier(0); }
            }
        } else {
            { unsigned long long z64 = 0ull; asm volatile("" : "+v"(z64)); wbuf[lane] = z64; }
#pragma unroll
            for (int r8 = 0; r8 < 8; ++r8) {
#pragma unroll
                for (int r = 0; r < 8; ++r) { const unsigned long long word = __ballot(sc[r8 * 8 + r] != 0u); if (lane == 0 && r8 * 8 + r < nuse) wbuf[r8 * 8 + r] = word; }
                __builtin_amdgcn_sched_barrier(0); }
        }
        }
        BMk[m * 64 + lane] = wbuf[lane];
    }
}
DI void attn_phase(const Args& a, unsigned char* lds) {
    const int tidx_ = otid();
    const int tid = tidx_, wave = __builtin_amdgcn_readfirstlane(tid >> 6), lane = tid & 63, ql = lane & 31, hf = lane >> 5;
    const bf16_t* P = (const bf16_t*)(a.ws + OFF_P); const bf16_t* VT = (const bf16_t*)(a.ws + OFF_VT); const unsigned long long* BMk = (const unsigned long long*)(a.ws + OFF_BM);
    const float* biasd = (const float*)(a.ws + OFF_BIAS); bf16_t* Y = (bf16_t*)(a.ws + OFF_Y);
    unsigned char* Kl = lds; unsigned char* Vl = lds + 64 * 144; float* biasl = (float*)(lds + 2 * 64 * 144);
    const float NEG_INF = -__builtin_inff();
    for (int cu = blockIdx.x; cu < 256; cu += gridDim.x)
#pragma unroll 1
    for (int ui = 0; ui < 2; ++ui) {
        const int bh = cu >> 3, s8 = cu & 7, qb = ui == 0 ? s8 : 15 - s8, b_ = bh >> 3, h = bh & 7;
        const int q0w = qb * 256 + 32 * wave, q = q0w + ql; const size_t m = (size_t)b_ * SEQ + q;
        __syncthreads();
        if (tid < 128) biasl[tid] = biasd[h * 128 + tid];
        bf16x8 qf[4];
#pragma unroll
        for (int ks = 0; ks < 4; ++ks) qf[ks] = *(const bf16x8*)(P + m * PCOLS + PC_AQ + h * 64 + 16 * ks + 8 * hf);
        f32x16 O0, O1;
#pragma unroll
        for (int r = 0; r < 16; ++r) { O0[r] = 0.f; O1[r] = 0.f; }
        float mrun = NEG_INF, lrun = 0.f;
        const int nkt = 4 * (qb + 1);
        const int srow = tid >> 3, sch = tid & 7;
        const bf16_t* kbase = P + ((size_t)b_ * SEQ + srow) * PCOLS + PC_AK + h * 64 + sch * 8;
        const bf16_t* vbase = VT + ((size_t)(b_ * 8 + h) * 64 + srow) * SEQ + sch * 8;
#define ATT_COMPUTE \
            const int k0 = kt * 64; \
            if (k0 <= q0w + 31) { \
 \
                f32x16 sa[2]; \
_Pragma("unroll") \
                for (int sub = 0; sub < 2; ++sub) { \
_Pragma("unroll") \
                    for (int r = 0; r < 16; ++r) sa[sub][r] = 0.f; } \
_Pragma("unroll") \
                for (int ks = 0; ks < 4; ++ks) \
_Pragma("unroll") \
                    for (int sub = 0; sub < 2; ++sub) { const bf16x8 kf = *(const bf16x8*)(Kl + (32 * sub + ql) * 144 + (16 * ks + 8 * hf) * 2); \
                        sa[sub] = __builtin_amdgcn_mfma_f32_32x32x16_bf16(kf, qf[ks], sa[sub], 0, 0, 0); } \
                constexpr float C1 = 0.125f * 1.4426950408889634f; constexpr unsigned NINF_BITS = 0xff800000u; \
                const unsigned b31u = __float_as_uint(biasl[127] * 1.4426950408889634f); \
                const bool far = (q0w - (k0 + 63)) >= 113; \
                float x[2][16]; float mx = NEG_INF; \
_Pragma("unroll") \
                for (int sub = 0; sub < 2; ++sub) { \
                    const int w32 = (int)(((unsigned)(bm >> (32 * sub))) >> (4 * hf)); \
                    if (far) { \
_Pragma("unroll") \
                        for (int r = 0; r < 16; ++r) { const int ro = (r & 3) + 8 * (r >> 2); const unsigned tm = (unsigned)__builtin_amdgcn_sbfe(w32, ro, 1); \
                            x[sub][r] = sa[sub][r] * C1 + __uint_as_float((tm & b31u) | (~tm & NINF_BITS)); } \
                    } else { \
_Pragma("unroll") \
                        for (int r = 0; r < 16; ++r) { const int ro = (r & 3) + 8 * (r >> 2); int dd = q - (k0 + 32 * sub + ro + 4 * hf); dd = dd < 0 ? 0 : (dd > 127 ? 127 : dd); \
                            const unsigned tm = (unsigned)__builtin_amdgcn_sbfe(w32, ro, 1); const unsigned bu = __float_as_uint(biasl[dd] * 1.4426950408889634f); \
                            x[sub][r] = sa[sub][r] * C1 + __uint_as_float((tm & bu) | (~tm & NINF_BITS)); } \
                    } \
_Pragma("unroll") \
                    for (int r = 0; r < 16; r += 2) mx = fmaxf(mx, fmaxf(x[sub][r], x[sub][r + 1])); \
                } \
                { auto pm = __builtin_amdgcn_permlane32_swap(__float_as_uint(mx), __float_as_uint(mx), false, false); mx = fmaxf(__uint_as_float(pm[0]), __uint_as_float(pm[1])); } \
                const float mnew = fmaxf(mrun, mx); const float msafe = (mnew == NEG_INF) ? 0.f : mnew; \
                float lsum = 0.f; \
_Pragma("unroll") \
                for (int sub = 0; sub < 2; ++sub) \
_Pragma("unroll") \
                    for (int r = 0; r < 16; ++r) { x[sub][r] = __builtin_amdgcn_exp2f(x[sub][r] - msafe); lsum += x[sub][r]; } \
                if (__builtin_amdgcn_ballot_w64(mnew > mrun) != 0ull) { \
                    const float alpha = __builtin_amdgcn_exp2f(mrun - msafe); \
                    lrun = lrun * alpha + lsum; mrun = mnew; \
_Pragma("unroll") \
                    for (int r = 0; r < 16; ++r) { O0[r] *= alpha; O1[r] *= alpha; } \
                } else lrun += lsum; \
_Pragma("unroll") \
                for (int sub = 0; sub < 2; ++sub) \
_Pragma("unroll") \
                    for (int s = 0; s < 2; ++s) { \
                        u32x4 pw; pw.x = pk2(x[sub][8 * s + 0], x[sub][8 * s + 1]); pw.y = pk2(x[sub][8 * s + 2], x[sub][8 * s + 3]); pw.z = pk2(x[sub][8 * s + 4], x[sub][8 * s + 5]); pw.w = pk2(x[sub][8 * s + 6], x[sub][8 * s + 7]); \
                        const bf16x8 pf = __builtin_bit_cast(bf16x8, pw); \
                        const int kcol = (32 * sub + 16 * s + 4 * hf) * 2; \
                        { const u32x2 lo = *(const u32x2*)(Vl + ql * 144 + kcol), hi = *(const u32x2*)(Vl + ql * 144 + kcol + 16); \
                          u32x4 vw; vw.x = lo.x; vw.y = lo.y; vw.z = hi.x; vw.w = hi.y; \
                          O0 = __builtin_amdgcn_mfma_f32_32x32x16_bf16(__builtin_bit_cast(bf16x8, vw), pf, O0, 0, 0, 0); } \
                        { const u32x2 lo = *(const u32x2*)(Vl + (32 + ql) * 144 + kcol), hi = *(const u32x2*)(Vl + (32 + ql) * 144 + kcol + 16); \
                          u32x4 vw; vw.x = lo.x; vw.y = lo.y; vw.z = hi.x; vw.w = hi.y; \
                          O1 = __builtin_amdgcn_mfma_f32_32x32x16_bf16(__builtin_bit_cast(bf16x8, vw), pf, O1, 0, 0, 0); } \
                    } \
            } \

        u32x4 kregA = *(const u32x4*)(kbase), vregA = *(const u32x4*)(vbase); unsigned long long bmA = BMk[m * 64];
        u32x4 kregB = *(const u32x4*)(kbase + (size_t)64 * PCOLS), vregB = *(const u32x4*)(vbase + 64); unsigned long long bmB = BMk[m * 64 + 1];
        asm volatile("" :: "v"(qf[0]), "v"(qf[1]), "v"(qf[2]), "v"(qf[3]));
#define ATT_TILE(KREG, VREG, BMR, KT) do { const int kt = (KT); \
            __syncthreads(); \
            *(u32x4*)(Kl + srow * 144 + sch * 16) = KREG; *(u32x4*)(Vl + srow * 144 + sch * 16) = VREG; \
            __syncthreads(); \
            const unsigned long long bm = BMR; \
            if (kt + 2 < nkt) { KREG = *(const u32x4*)(kbase + (size_t)(kt + 2) * 64 * PCOLS); VREG = *(const u32x4*)(vbase + (kt + 2) * 64); BMR = BMk[m * 64 + kt + 2]; } \
            ATT_COMPUTE } while (0)
#pragma unroll 1
        for (int kt2 = 0; kt2 < nkt; kt2 += 2) { ATT_TILE(kregA, vregA, bmA, kt2); ATT_TILE(kregB, vregB, bmB, kt2 + 1); }
#undef ATT_TILE
#undef ATT_COMPUTE
        float ltot; { auto pl = __builtin_amdgcn_permlane32_swap(__float_as_uint(lrun), __float_as_uint(lrun), false, false); ltot = __uint_as_float(pl[0]) + __uint_as_float(pl[1]); } const float inv = 1.0f / ltot;
        bf16_t* yo = Y + m * D + 1536 + h * 64;
#pragma unroll
        for (int g4 = 0; g4 < 4; ++g4) { const int d0 = 8 * g4 + 4 * hf;
            u32x2 o0; o0.x = pk2(O0[4 * g4 + 0] * inv, O0[4 * g4 + 1] * inv); o0.y = pk2(O0[4 * g4 + 2] * inv, O0[4 * g4 + 3] * inv); *(u32x2*)(yo + d0) = o0;
            u32x2 o1; o1.x = pk2(O1[4 * g4 + 0] * inv, O1[4 * g4 + 1] * inv); o1.y = pk2(O1[4 * g4 + 2] * inv, O1[4 * g4 + 3] * inv); *(u32x2*)(yo + 32 + d0) = o1; }
    }
}

constexpr int NPH = 16;
constexpr int NGP = 1 + DEPTH * NPH;
__global__ void __launch_bounds__(512, 2) fwd(Args args) {
    extern __shared__ __attribute__((aligned(16))) unsigned char lds[];
    const int tid = threadIdx.x;
    volatile LAS unsigned* MISC = (volatile LAS unsigned*)((LAS unsigned char*)lds + MISC_OFF);
    for (int u = tid; u < (LDS_BYTES - 131072) / 4; u += 512) ((LAS unsigned*)((LAS unsigned char*)lds + 131072))[u] = 0u;
    __syncthreads();
    unsigned char* ws = args.ws;
    XcdBarrier bar; bar.bar = (unsigned*)(ws + OFF_CTL) + 4096; bar.x = 0; bar.st = nullptr;
    if (!MK_PER_PHASE) bar = xcd_barrier_post((unsigned*)(ws + OFF_CTL) + 4096, MISC + 8);
    const int lo = args.lo, hi = args.hi;
    LAS unsigned char* ldsl = (LAS unsigned char*)lds;
    bf16_t* XB = (bf16_t*)(ws + OFF_XB); float* X = (float*)(ws + OFF_X); float* T = (float*)(ws + OFF_T); float* ST = (float*)(ws + OFF_ST); bf16_t* Pb = (bf16_t*)(ws + OFF_P);
    bf16_t* H = (bf16_t*)(ws + OFF_SCR); bf16_t* Yb = (bf16_t*)(ws + OFF_Y); bf16_t* MG = (bf16_t*)(ws + OFF_MG);
    int gp = 0;
#define RUN() (lo <= gp && gp < hi)
#define SEAM() do { if (RUN() && gp + 1 < hi) xcd_barrier(bar); ++gp; } while (0)
#define PHASE(k, ...) do { if (PHON(k) && RUN()) { __VA_ARGS__; if ((REP_MASK >> (k)) & 1u) { xcd_barrier(bar); __VA_ARGS__; } } SEAM(); } while (0)
    if (RUN()) init_phase(args);
    SEAM();
    int p7n = 0;
#pragma unroll 1
    for (int L = 0; L < DEPTH; ++L) {
        const size_t walt = (L & 1) ? ALT_SHIFT : 0;
        if (L == 0 || !HETERO) PHASE(0, convert_phase(args, L, lds, blockIdx.x, gridDim.x);); else ++gp;
        PHASE(1, { pg8::Gemm g{XB, (const bf16_t*)(ws + OFF_W1A), D, D}; pg8::StaticOrder S; S.init(M, 2 * FF, D, gridDim.x, blockIdx.x); pg8::EpiSwiglu E{H, FF}; pg8::gemm_phase(ldsl, g, S, E); });
        PHASE(2, { pg8::Gemm g{H, (const bf16_t*)(ws + OFF_W1B), FF, FF}; pg8::StaticOrder S; S.init(M, D, FF, gridDim.x, blockIdx.x); pg8::EpiRes E{args.in[I_X], L == 0 ? nullptr : ST, args.in[I_LN3G] + (L > 0 ? (L - 1) * D : 0), args.in[I_LN3B] + (L > 0 ? (L - 1) * D : 0), T, D, ALPHA, 0.5f}; pg8::gemm_phase(ldsl, g, S, E); });
        PHASE(3, ln_phase(T, args.in[I_LN1G] + L * D, args.in[I_LN1B] + L * D, ST, XB, nullptr););
        PHASE(4, { pg8::Gemm g{XB, (const bf16_t*)(ws + OFF_WIN), D, D}; pg8::StaticOrder S; S.init(M, NP, D, gridDim.x, blockIdx.x); pg8::EpiBf16 E{Pb, PCOLS, (bf16_t*)(ws + OFF_GATES)}; pg8::gemm_phase(ldsl, g, S, E); });
        PHASE(5, { kidx_vt_phase(args, L, lds); if (REP_MASK & (1u << 23)) kidx_vt_phase(args, L, lds); if (RWKV_CHUNKED && !DBG_RWKV) { rwkv_par_phase(args, L, lds); if (REP_MASK & (1u << 24)) rwkv_par_phase(args, L, lds); } else rwkv_prep_phase(args, L, lds); });
        if (!HETERO) PHASE(6, { WorkQ wq{nullptr, 0, 0, (int)gridDim.x}; int item = blockIdx.x; sgu_phase(args, L, lds, wq, item, 0); }); else ++gp;
        PHASE(7, { if (DBG_RWKV) { scan_phase(args, lds); xcd_barrier(bar); rwkv_par_phase(args, L, lds); xcd_barrier(bar); rwkv_seq_phase(args, lds, X + (size_t)M * RW, nullptr, nullptr, nullptr); xcd_barrier(bar); dbg_compare_phase(args); }
                   else if (HETERO) {
                       if ((int)blockIdx.x < 64) { rwkv_seq_phase(args, lds, X, args.in[I_GNG] + L * RW, args.in[I_GNB] + L * RW, Yb); if (REP_MASK & (1u << 20)) rwkv_seq_phase(args, lds, X, args.in[I_GNG] + L * RW, args.in[I_GNB] + L * RW, Yb); }
                       else if ((int)blockIdx.x < 64 + NCVT && L + 1 < DEPTH) { convert_phase(args, L + 1, lds, blockIdx.x - 64, NCVT); __syncthreads(); }
                       WorkQ wq{(unsigned*)(ws + OFF_CTL + 524288) + (p7n++) * 64, 0, 0, 0}; int item = wq_first(wq, lds, otid());
                       indexer_phase(args, lds, wq, item); sgu_phase(args, L, lds, wq, item, NB * 512); }
                   else if (RWKV_CHUNKED) rwkv_seq_phase(args, lds, X, nullptr, nullptr, nullptr); else scan_phase(args, lds); });
        if (!HETERO) PHASE(8, { WorkQ wq{nullptr, 0, 0, (int)gridDim.x}; int item = blockIdx.x; indexer_phase(args, lds, wq, item); if (RWKV_CHUNKED) rwkv_fin2_phase(args, L); else rwkv_fin_phase(args, L); }); else ++gp;
        PHASE(9, { attn_phase(args, lds); });
        PHASE(10, { pg8::Gemm g{Yb, (const bf16_t*)(ws + OFF_WBR + walt), D, D}; pg8::BranchOrder S; S.init(M, D, D, gridDim.x, blockIdx.x); pg8::EpiBranch E{(const bf16_t*)(ws + OFF_GATES), args.in[I_BGATE] + (size_t)L * 3 * D, MG}; pg8::gemm_phase(ldsl, g, S, E); });
        PHASE(11, { pg8::Gemm g{MG, (const bf16_t*)(ws + OFF_WO + walt), D, D}; pg8::StaticOrder S; S.init(M, D, D, gridDim.x, blockIdx.x); pg8::EpiRes E{nullptr, ST, args.in[I_LN1G] + L * D, args.in[I_LN1B] + L * D, T, D, ALPHA, 1.0f}; pg8::gemm_phase(ldsl, g, S, E); });
        PHASE(12, ln_phase(T, args.in[I_LN2G] + L * D, args.in[I_LN2B] + L * D, ST, XB, nullptr););
        PHASE(13, { pg8::Gemm g{XB, (const bf16_t*)(ws + OFF_W2A + walt), D, D}; pg8::StaticOrder S; S.init(M, 2 * FF, D, gridDim.x, blockIdx.x); pg8::EpiSwiglu E{H, FF}; pg8::gemm_phase(ldsl, g, S, E); });
        PHASE(14, { pg8::Gemm g{H, (const bf16_t*)(ws + OFF_W2B + walt), FF, FF}; pg8::StaticOrder S; S.init(M, D, FF, gridDim.x, blockIdx.x); pg8::EpiRes E{nullptr, ST, args.in[I_LN2G] + L * D, args.in[I_LN2B] + L * D, T, D, ALPHA, 0.5f}; pg8::gemm_phase(ldsl, g, S, E); });
        PHASE(15, ln_phase(T, args.in[I_LN3G] + L * D, args.in[I_LN3B] + L * D, ST, XB, L == DEPTH - 1 ? args.out : nullptr););
        if (REP_MASK & (1u << 25)) { for (int xb = 0; xb < 10; ++xb) xcd_barrier(bar); }
    }
    if (DBG_RWKV) { xcd_barrier(bar); dbg_encode_phase(args); }
#undef RUN
#undef SEAM
#undef PHASE
}

extern "C" void kernel_launch(void* const* d_in, const int* in_sizes, int n_in, void* d_out, int out_size, void* d_ws, size_t ws_size, hipStream_t stream) {
    static int grid = 0;
    if (grid == 0) {
        if (n_in != 33 || out_size != M * D || ws_size < WS_END) { fprintf(stderr, "kernel_launch: unexpected shapes (n_in %d out %d ws %zu, need %zu)\n", n_in, out_size, ws_size, (size_t)WS_END); grid = -1; return; }
        int dev = 0, cus = 0;
        if (hipGetDevice(&dev) != hipSuccess || hipDeviceGetAttribute(&cus, hipDeviceAttributeMultiprocessorCount, dev) != hipSuccess) { grid = -1; return; }
        if (hipFuncSetAttribute((const void*)fwd, hipFuncAttributeMaxDynamicSharedMemorySize, LDS_BYTES) != hipSuccess) { fprintf(stderr, "kernel_launch: hipFuncSetAttribute failed\n"); grid = -1; return; }
        int per_cu = 0; (void)hipOccupancyMaxActiveBlocksPerMultiprocessor(&per_cu, (const void*)fwd, 512, LDS_BYTES); (void)hipGetLastError();
        grid = cus;
    }
    if (grid < 0) return;
    (void)hipMemsetAsync((char*)d_ws + OFF_CTL, 0, CTL_BYTES, stream);
    Args a{};
    for (int i = 0; i < 33; ++i) a.in[i] = (const float*)d_in[i];
    a.out = (float*)d_out; a.ws = (unsigned char*)d_ws;
#if MK_PER_PHASE
    for (int p = 0; p < NGP; ++p) { a.lo = p; a.hi = p + 1; hipLaunchKernelGGL(fwd, dim3(grid), dim3(512), LDS_BYTES, stream, a); }
#else
    a.lo = 0; a.hi = NGP;
    hipLaunchKernelGGL(fwd, dim3(grid), dim3(512), LDS_BYTES, stream, a);
#endif
}
```

```cpp
#include <hip/hip_runtime.h>
#include <cstdio>
#include <cstdint>

#ifndef MK_PER_PHASE
#define MK_PER_PHASE 0
#endif
#ifndef PH_MASK
#define PH_MASK 0xFFFFFFFFu
#endif
#define PHON(k) (((PH_MASK) >> (k)) & 1u)
#ifndef RWKV_CHUNKED
#define RWKV_CHUNKED 1
#endif
#ifndef DBG_RWKV
#define DBG_RWKV 0
#endif
#ifndef DBG_LORA
#define DBG_LORA 0
#endif
#ifndef HETERO
#define HETERO 1
#endif
#ifndef SEQ_HILO
#define SEQ_HILO 0
#endif
#ifndef SGU_SPLIT
#define SGU_SPLIT 256
#endif
#ifndef REP_MASK
#define REP_MASK 0u
#endif

#define LAS __attribute__((address_space(3)))
#define DI __device__ __forceinline__
typedef unsigned short bf16_t;
typedef short bf16x8 __attribute__((ext_vector_type(8)));
typedef float f32x4 __attribute__((ext_vector_type(4)));
typedef float f32x2 __attribute__((ext_vector_type(2)));
typedef float f32x16 __attribute__((ext_vector_type(16)));
typedef unsigned u32x4 __attribute__((ext_vector_type(4)));
typedef unsigned u32x2 __attribute__((ext_vector_type(2)));
typedef __bf16 bf16x2_t __attribute__((ext_vector_type(2)));

constexpr int NB = 4, SEQ = 4096, M = NB * SEQ, D = 2048, FF = 5632, DEPTH = 4;
constexpr int RW = 1024;
constexpr int NP = 13312;
constexpr int PCOLS = 7168;
constexpr int DIN = 13168;
constexpr int GN_GATE = 6656, GN_LORA = 12800, GN_KI = 13088, GN_WI = 13152;
constexpr int PC_R = 0, PC_K = 1024, PC_V = 2048, PC_SGU = 3072, PC_SGV = 3584, PC_AQ = 4096, PC_AK = 4608, PC_AV = 5120, PC_QI = 5632, PC_LORA = 6656, PC_KI = 6944, PC_WI = 7008;
constexpr float ALPHA = 1.6817928305074290f;
constexpr float LN_EPS = 1e-5f;

constexpr size_t MiB = 1u << 20;
constexpr size_t OFF_CTL = 0, CTL_BYTES = 1 * MiB;
constexpr size_t OFF_BIAS = 1 * MiB;
constexpr size_t OFF_ST = OFF_BIAS + 786432;
constexpr size_t OFF_LW2 = OFF_BIAS + 65536, OFF_LA2 = OFF_LW2 + 131072, OFF_LG2 = OFF_LA2 + 131072;
constexpr int REC = 15360, RROW = 144, R_EL2 = 0, R_RL2 = 2304, R_A2 = 4608, R_A3 = 8704, R_FT = 9728, R_VT = 10240, R_GC = 12288, R_G = 12544, R_BON = 14592;
constexpr size_t OFF_W1A = 2 * MiB;
constexpr size_t OFF_W1B = OFF_W1A + 44 * MiB;
constexpr size_t OFF_WIN = OFF_W1B + 22 * MiB;
constexpr size_t OFF_WBR = OFF_WIN + 52 * MiB;
constexpr size_t OFF_WO  = OFF_WBR + 8 * MiB;
constexpr size_t OFF_W2A = OFF_WO + 8 * MiB;
constexpr size_t OFF_W2B = OFF_W2A + 44 * MiB;
constexpr size_t OFF_X   = OFF_W2B + 22 * MiB;
constexpr size_t OFF_T   = OFF_X + 128 * MiB;
constexpr size_t OFF_XB  = OFF_T + 128 * MiB;
constexpr size_t OFF_P   = OFF_XB + 64 * MiB;
constexpr size_t OFF_GATES = OFF_P + 224 * MiB;
constexpr size_t OFF_SCR = OFF_GATES + 192 * MiB;
constexpr size_t OFF_Y   = OFF_SCR + 416 * MiB;
constexpr size_t OFF_MG  = OFF_Y + 64 * MiB;
constexpr size_t OFF_BM  = OFF_MG + 64 * MiB;
constexpr size_t OFF_KI  = OFF_BM + 8 * MiB;
constexpr size_t OFF_VT  = OFF_KI + 2 * MiB;
constexpr size_t OFF_ALT = OFF_VT + 16 * MiB;
constexpr size_t ALT_SHIFT = OFF_ALT - OFF_WBR;
constexpr size_t WS_END  = OFF_ALT + 82 * MiB;
constexpr int NCVT = 64;

constexpr int LDS_BYTES = 147456;
constexpr int MISC_OFF = 131072 + 320;

DI unsigned f2bf(float f);
DI float bf2f(unsigned short b) { return __builtin_bit_cast(float, ((unsigned)b) << 16); }
DI unsigned pk2(float lo, float hi) { f32x2 v = {lo, hi}; bf16x2_t b = __builtin_convertvector(v, bf16x2_t); return __builtin_bit_cast(unsigned, b); }
DI unsigned f2bf(float f) { return pk2(f, f) & 0xffffu; }
DI float bflo(unsigned w) { return __builtin_bit_cast(float, w << 16); }
DI float bfhi(unsigned w) { return __builtin_bit_cast(float, w & 0xffff0000u); }
template <int CTRL> DI float dpp_f(float x) { return __builtin_bit_cast(float, __builtin_amdgcn_update_dpp(0, __builtin_bit_cast(int, x), CTRL, 0xF, 0xF, true)); }
DI float row16_sum(float x) {
    x += dpp_f<0xB1>(x);
    x += dpp_f<0x4E>(x);
    x += dpp_f<0x141>(x);
    x += dpp_f<0x140>(x);
    return x;
}
DI int otid() { int t = threadIdx.x; asm volatile("" : "+v"(t)); return t; }
DI int obid() { int t = blockIdx.x; asm volatile("" : "+s"(t)); return t; }
DI float wave_sum(float x) {
    x = row16_sum(x);
    auto p = __builtin_amdgcn_permlane16_swap(__float_as_uint(x), __float_as_uint(x), false, false);
    x = __uint_as_float(p[0]) + __uint_as_float(p[1]);
    auto q = __builtin_amdgcn_permlane32_swap(__float_as_uint(x), __float_as_uint(x), false, false);
    return __uint_as_float(q[0]) + __uint_as_float(q[1]);
}
DI void wave_sum8(float (&x)[8]) {
#pragma unroll
    for (int i = 0; i < 8; ++i) x[i] += dpp_f<0xB1>(x[i]);
#pragma unroll
    for (int i = 0; i < 8; ++i) x[i] += dpp_f<0x4E>(x[i]);
#pragma unroll
    for (int i = 0; i < 8; ++i) x[i] += dpp_f<0x141>(x[i]);
#pragma unroll
    for (int i = 0; i < 8; ++i) x[i] += dpp_f<0x140>(x[i]);
#pragma unroll
    for (int i = 0; i < 8; ++i) { auto p = __builtin_amdgcn_permlane16_swap(__float_as_uint(x[i]), __float_as_uint(x[i]), false, false); x[i] = __uint_as_float(p[0]) + __uint_as_float(p[1]); }
#pragma unroll
    for (int i = 0; i < 8; ++i) { auto p = __builtin_amdgcn_permlane32_swap(__float_as_uint(x[i]), __float_as_uint(x[i]), false, false); x[i] = __uint_as_float(p[0]) + __uint_as_float(p[1]); }
}
DI float rs16(float (&x)[16], int lane) {
    float z[8], w[4];
#pragma unroll
    for (int i = 0; i < 8; ++i) { auto p = __builtin_amdgcn_permlane32_swap(__float_as_uint(x[i]), __float_as_uint(x[i + 8]), false, false); z[i] = __uint_as_float(p[0]) + __uint_as_float(p[1]); }
#pragma unroll
    for (int i = 0; i < 4; ++i) { auto p = __builtin_amdgcn_permlane16_swap(__float_as_uint(z[i]), __float_as_uint(z[i + 4]), false, false); w[i] = __uint_as_float(p[0]) + __uint_as_float(p[1]); }
    const bool b0 = (lane & 1) != 0, b1 = (lane & 2) != 0;
    const float u0 = (b0 ? w[1] : w[0]) + dpp_f<0xB1>(b0 ? w[0] : w[1]);
    const float u1 = (b0 ? w[3] : w[2]) + dpp_f<0xB1>(b0 ? w[2] : w[3]);
    float v = (b1 ? u1 : u0) + dpp_f<0x4E>(b1 ? u0 : u1);
    v += dpp_f<0x124>(v);
    v += dpp_f<0x128>(v);
    return v;
}
DI float sigmoidf_(float x) { return __builtin_amdgcn_rcpf(1.0f + __expf(-x)); }
DI float gelu_erf(float x) {
    const float y = fabsf(x) * 0.70710678118654752f;
    const float t = __builtin_amdgcn_rcpf(__builtin_fmaf(0.3275911f, y, 1.0f));
    const float e = __builtin_amdgcn_exp2f(-1.4426950408889634f * y * y);
    float p = __builtin_fmaf(1.061405429f, t, -1.453152027f); p = __builtin_fmaf(p, t, 1.421413741f); p = __builtin_fmaf(p, t, -0.284496736f); p = __builtin_fmaf(p, t, 0.254829592f);
    const float ec = p * t * e;
    return 0.5f * x * (x < 0.f ? ec : 2.0f - ec);
}

namespace pg8 {
constexpr int BM = 256, BK = 64, HALF = 128, HTB = HALF * BK * 2, STAGE_BYTES = 8 * HTB, NXCD = 8, WGM = 8;
__host__ __device__ __forceinline__ int lds_byte(int r, int c) { const int st = (r >> 4) * 2 + (c >> 5), rr = r & 15, cc = c & 31, ob = rr * 64 + cc * 2; return st * 1024 + (ob ^ (((ob >> 9) & 1) << 5)); }
__host__ __device__ __forceinline__ void stage_rc(int b, int& R, int& C) { const int st = b / 1024, sb = b % 1024, swz = sb ^ (((sb >> 9) & 1) << 5); R = (st >> 1) * 16 + swz / 64; C = (st & 1) * 32 + (swz % 64) / 2; }
__host__ __device__ __forceinline__ int perm32(int rho) { const int n = rho >> 4, i = rho & 15; return 8 * (i >> 2) + 4 * n + (i & 3); }

struct Unit { int pm, pn, koff, nt, tag; };
struct Gemm { const bf16_t* A; const bf16_t* Bt; int lda, ldb; };

struct StaticOrder {
    int nM, nN, nwg, G, c, nt;
    __device__ void init(int M_, int N_, int K_, int G_, int c_) { nM = M_ / BM; nN = N_ / BM; nwg = nM * nN; G = G_; c = c_; nt = K_ / BK; }
    __device__ bool tile(int L, Unit& u) const {
        if (L >= nwg) return false;
        int wgid = L; { const int q = nwg / NXCD, r = nwg % NXCD, xcd = wgid % NXCD, off = wgid / NXCD; wgid = (xcd < r ? xcd * (q + 1) : r * (q + 1) + (xcd - r) * q) + off; }
        const int nig = WGM * nN, gid = wgid / nig, fm = gid * WGM, gsz = (nM - fm) < WGM ? (nM - fm) : WGM;
        u.pm = fm + ((wgid % nig) % gsz); u.pn = (wgid % nig) / gsz; return true;
    }
    __device__ bool next(int i, Unit& u) const { u.koff = 0; u.nt = nt; u.tag = 0; return tile(i * G + c, u); }
};
struct BranchOrder : StaticOrder {
    __device__ bool next(int i, Unit& u) const {
        const int ti = i / 3, br = i - 3 * ti;
        u.tag = br; u.koff = br == 0 ? 0 : (br == 1 ? 1024 : 1536); u.nt = br == 0 ? 16 : 8;
        return tile(ti * G + c, u);
    }
};

template <class Epi, class Sched>
__device__ __forceinline__ void gemm_phase(LAS unsigned char* lds, const Gemm g, const Sched& S, const Epi& E) {
    const int tid = otid(), wid = __builtin_amdgcn_readfirstlane(tid >> 6), lane = tid & 63, wr = wid >> 2, wc = wid & 3, fr = lane & 15, fq = lane >> 4;
    unsigned voffA[2], voffB[2];
#pragma unroll
    for (int i = 0; i < 2; ++i) { int R, C; stage_rc(tid * 16 + i * 8192, R, C); const int Rb = Epi::PERM ? ((R & ~31) + perm32(R & 31)) : R;
        voffA[i] = (unsigned)(R * g.lda + C) * 2u; voffB[i] = (unsigned)(Rb * g.ldb + C) * 2u; }
    const size_t kstep = (size_t)(BK * 2);
    const size_t hstepA = (size_t)HALF * g.lda * 2, hstepB = (size_t)HALF * g.ldb * 2;
    const size_t tstepA = 2 * hstepA, tstepB = 2 * hstepB;
    const unsigned ldsw = (unsigned)wid * 1024u;
    const int aoff = lds_byte(wr * 64 + fr, fq * 8), boff = lds_byte(wc * 32 + fr, fq * 8);
#define PG8_SA(b, h) (((b) * 2 + (h)) * HTB)
#define PG8_SB(b, h) ((4 + (b) * 2 + (h)) * HTB)
#define PG8_STAGE(bufoff, gbase, voff) do { _Pragma("unroll") for (int _i = 0; _i < 2; ++_i) \
        __builtin_amdgcn_global_load_lds((const unsigned*)((const char*)(gbase) + (voff)[_i]), (LAS unsigned*)(lds + (bufoff) + ldsw + _i * 8192), 16, 0, 0); } while (0)
#define PG8_LDA(dst, b, h) do { _Pragma("unroll") for (int m = 0; m < 4; ++m) _Pragma("unroll") for (int k = 0; k < 2; ++k) dst[m][k] = *(const LAS bf16x8*)(lds + PG8_SA(b, h) + aoff + m * 2048 + k * 1024); } while (0)
#define PG8_LDB(dst, b, h) do { _Pragma("unroll") for (int n = 0; n < 2; ++n) _Pragma("unroll") for (int k = 0; k < 2; ++k) dst[n][k] = *(const LAS bf16x8*)(lds + PG8_SB(b, h) + boff + n * 2048 + k * 1024); } while (0)
#define PG8_MMA(ai, bj, At, Bt) do { __builtin_amdgcn_s_setprio(1); _Pragma("unroll") for (int m = 0; m < 4; ++m) _Pragma("unroll") for (int n = 0; n < 2; ++n) _Pragma("unroll") for (int k = 0; k < 2; ++k) \
        acc[ai][bj][m][n] = __builtin_amdgcn_mfma_f32_16x16x32_bf16(Bt[n][k], At[m][k], acc[ai][bj][m][n], 0, 0, 0); __builtin_amdgcn_s_setprio(0); } while (0)
#define PG8_WAIT_V(n) asm volatile("s_waitcnt vmcnt(" #n ")" ::: "memory")
#define PG8_WAIT_L(n) asm volatile("s_waitcnt lgkmcnt(" #n ")" ::: "memory")
#define PG8_BAR __builtin_amdgcn_s_barrier()
#define PG8_SCHED __builtin_amdgcn_sched_barrier(0)
    Unit cur, nxt; int ui = 0;
    if (!S.next(0, cur)) return;
    f32x4 acc[2][2][4][2];
#pragma unroll
    for (int a = 0; a < 2; ++a)
#pragma unroll
        for (int b = 0; b < 2; ++b)
#pragma unroll
            for (int m = 0; m < 4; ++m)
#pragma unroll
                for (int n = 0; n < 2; ++n) acc[a][b][m][n] = (f32x4){0.f, 0.f, 0.f, 0.f};
    bf16x8 At[4][2], B0[2][2], B1[2][2];
    const char* cA = (const char*)g.A + (size_t)cur.pm * tstepA + (size_t)cur.koff * 2; const char* cB = (const char*)g.Bt + (size_t)cur.pn * tstepB + (size_t)cur.koff * 2;
    PG8_STAGE(PG8_SB(0, 0), cB, voffB); PG8_STAGE(PG8_SB(0, 1), cB + hstepB, voffB); PG8_STAGE(PG8_SA(0, 0), cA, voffA); PG8_STAGE(PG8_SA(0, 1), cA + hstepA, voffA);
    if (wr == 1) PG8_BAR;
    PG8_WAIT_V(2); PG8_BAR;
    PG8_STAGE(PG8_SB(1, 0), cB + kstep, voffB); PG8_STAGE(PG8_SA(1, 0), cA + kstep, voffA); PG8_STAGE(PG8_SB(1, 1), cB + hstepB + kstep, voffB);
    PG8_WAIT_V(6); PG8_BAR;
    for (;;) {
        const bool has_next = S.next(ui + 1, nxt);
        const char* nA = has_next ? (const char*)g.A + (size_t)nxt.pm * tstepA + (size_t)nxt.koff * 2 : cA; const char* nB = has_next ? (const char*)g.Bt + (size_t)nxt.pn * tstepB + (size_t)nxt.koff * 2 : cB;
        const int nt = cur.nt;
        for (int t = 0; t < nt; t += 2) {
            const bool last = (t == nt - 2);
            const char* a1 = cA + (size_t)(t + 1) * kstep;
            const char* a2 = last ? nA : cA + (size_t)(t + 2) * kstep; const char* b2 = last ? nB : cB + (size_t)(t + 2) * kstep;
            const char* a3 = a2 + kstep; const char* b3 = b2 + kstep;
            PG8_LDB(B0, 0, 0); PG8_LDB(B1, 0, 1); PG8_SCHED; PG8_LDA(At, 0, 0); PG8_STAGE(PG8_SA(1, 1), a1 + hstepA, voffA);
            PG8_WAIT_V(8); PG8_WAIT_L(0); PG8_BAR; PG8_MMA(0, 0, At, B0); PG8_MMA(0, 1, At, B1); PG8_BAR; PG8_SCHED;
            PG8_LDA(At, 0, 1); PG8_STAGE(PG8_SB(0, 0), b2, voffB); PG8_STAGE(PG8_SB(0, 1), b2 + hstepB, voffB); PG8_STAGE(PG8_SA(0, 0), a2, voffA);
            PG8_WAIT_V(8); PG8_WAIT_L(0); PG8_BAR; PG8_MMA(1, 0, At, B0); PG8_MMA(1, 1, At, B1); PG8_BAR; PG8_SCHED;
            PG8_LDB(B0, 1, 0); PG8_LDB(B1, 1, 1); PG8_SCHED; PG8_LDA(At, 1, 0); PG8_STAGE(PG8_SA(0, 1), a2 + hstepA, voffA);
            PG8_WAIT_V(8); PG8_WAIT_L(0); PG8_BAR; PG8_MMA(0, 0, At, B0); PG8_MMA(0, 1, At, B1); PG8_BAR; PG8_SCHED;
            PG8_LDA(At, 1, 1); PG8_STAGE(PG8_SB(1, 0), b3, voffB); PG8_STAGE(PG8_SB(1, 1), b3 + hstepB, voffB); PG8_STAGE(PG8_SA(1, 0), a3, voffA);
            PG8_WAIT_V(8); PG8_WAIT_L(0); PG8_BAR; PG8_MMA(1, 0, At, B0); PG8_MMA(1, 1, At, B1); PG8_BAR; PG8_SCHED;
        }
        if (wr == 0) PG8_BAR;
        E(acc, cur, wr, wc, fr, fq);
        if (!has_next) break;
        if (!(Epi::KEEPS && cur.tag != 2))
#pragma unroll
        for (int a = 0; a < 2; ++a)
#pragma unroll
            for (int b = 0; b < 2; ++b)
#pragma unroll
                for (int m = 0; m < 4; ++m)
#pragma unroll
                    for (int n = 0; n < 2; ++n) acc[a][b][m][n] = (f32x4){0.f, 0.f, 0.f, 0.f};
        cur = nxt; cA = nA; cB = nB; ++ui;
        if (wr == 1) PG8_BAR;
    }
    PG8_WAIT_V(0);
    PG8_BAR;
#undef PG8_SA
#undef PG8_SB
#undef PG8_STAGE
#undef PG8_LDA
#undef PG8_LDB
#undef PG8_MMA
#undef PG8_WAIT_V
#undef PG8_WAIT_L
#undef PG8_BAR
#undef PG8_SCHED
}

struct EpiSwiglu {
    static constexpr bool PERM = true, KEEPS = false;
    bf16_t* O; int ldc;
    __device__ __forceinline__ void operator()(const f32x4 (&acc)[2][2][4][2], const Unit& u, int wr, int wc, int fr, int fq) const {
        const int row0 = u.pm * BM + wr * 64 + fr, col0 = u.pn * HALF + wc * 32 + 8 * fq;
#pragma unroll
        for (int ai = 0; ai < 2; ++ai)
#pragma unroll
            for (int m = 0; m < 4; ++m) {
                float hv[8];
#pragma unroll
                for (int n = 0; n < 2; ++n)
#pragma unroll
                    for (int j = 0; j < 4; ++j) { const float gv = acc[ai][0][m][n][j], uv = acc[ai][1][m][n][j]; hv[4 * n + j] = gv * __builtin_amdgcn_rcpf(1.0f + __expf(-gv)) * uv; }
                u32x4 w; w.x = pk2(hv[0], hv[1]); w.y = pk2(hv[2], hv[3]); w.z = pk2(hv[4], hv[5]); w.w = pk2(hv[6], hv[7]);
                *(u32x4*)(O + (size_t)(row0 + ai * HALF + m * 16) * ldc + col0) = w;
            }
    }
};
struct EpiRes {
    static constexpr bool PERM = false, KEEPS = false;
    const float* Xraw; const float* st; const float* g; const float* b; float* T; int ldc; float alpha, s;
    __device__ __forceinline__ void operator()(const f32x4 (&acc)[2][2][4][2], const Unit& u, int wr, int wc, int fr, int fq) const {
        const int row0 = u.pm * BM + wr * 64 + fr, col0 = u.pn * BM + wc * 32 + 4 * fq;
        f32x4 gv[2][2], bv[2][2];
        if (st) {
#pragma unroll
            for (int bj = 0; bj < 2; ++bj)
#pragma unroll
                for (int n = 0; n < 2; ++n) { gv[bj][n] = *(const f32x4*)(g + col0 + bj * HALF + n * 16); bv[bj][n] = *(const f32x4*)(b + col0 + bj * HALF + n * 16); } }
        const float* src = st ? T : Xraw;
#pragma unroll
        for (int ai = 0; ai < 2; ++ai)
#pragma unroll
            for (int m2 = 0; m2 < 2; ++m2) {
                f32x4 tv[2][2][2]; f32x2 ms[2];
#pragma unroll
                for (int mm = 0; mm < 2; ++mm) { const int row = row0 + ai * HALF + (2 * m2 + mm) * 16; const size_t off = (size_t)row * ldc + col0;
                    ms[mm] = (f32x2){0.f, 1.f}; if (st) ms[mm] = *(const f32x2*)(st + 2 * (size_t)row);
#pragma unroll
                    for (int bj = 0; bj < 2; ++bj)
#pragma unroll
                        for (int n = 0; n < 2; ++n) tv[mm][bj][n] = *(const f32x4*)(src + off + bj * HALF + n * 16); }
                asm volatile("" ::: "memory");
#pragma unroll
                for (int mm = 0; mm < 2; ++mm) { const int m = 2 * m2 + mm; const size_t off = (size_t)(row0 + ai * HALF + m * 16) * ldc + col0;
#pragma unroll
                    for (int bj = 0; bj < 2; ++bj)
#pragma unroll
                        for (int n = 0; n < 2; ++n) { f32x4 xv = tv[mm][bj][n]; if (st) xv = (xv - ms[mm][0]) * ms[mm][1] * gv[bj][n] + bv[bj][n];
                            *(f32x4*)(T + off + bj * HALF + n * 16) = xv * alpha + acc[ai][bj][m][n] * s; } }
            }
    }
};
__device__ __forceinline__ int frag_off(int wr, int wc, int fr, int fq, int ai, int m, int bj) { return (((((wr * 4 + wc) * 2 + ai) * 4 + m) * 2 + bj) * 64 + fq * 16 + fr) * 8; }
struct EpiBf16 {
    static constexpr bool PERM = true, KEEPS = false;
    bf16_t* O; int ldc; bf16_t* G;
    __device__ __forceinline__ void operator()(const f32x4 (&acc)[2][2][4][2], const Unit& u, int wr, int wc, int fr, int fq) const {
        const bool gate = u.pn >= GN_GATE / BM && u.pn < GN_LORA / BM;
        const int gt = u.pn - GN_GATE / BM;
        bf16_t* gbase = G + ((size_t)((gt >> 3) * (M / BM) + u.pm) * 8 + (gt & 7)) * 65536;
        const int pcol = (u.pn >= GN_LORA / BM ? PC_LORA + (u.pn - GN_LORA / BM) * BM : u.pn * BM) + wc * 32 + 8 * fq;
        const int row0 = u.pm * BM + wr * 64 + fr;
        int lbase = ((wr * 4 + wc) * 1024 + fq * 16 + fr) * 8; asm volatile("" : "+v"(lbase));
#pragma unroll
        for (int ai = 0; ai < 2; ++ai)
#pragma unroll
            for (int m = 0; m < 4; ++m) { bf16_t* rowp = O + (size_t)(row0 + ai * HALF + m * 16) * ldc + pcol;
#pragma unroll
                for (int bj = 0; bj < 2; ++bj) { const f32x4 v0 = acc[ai][bj][m][0], v1 = acc[ai][bj][m][1];
                    u32x4 w; w.x = pk2(v0[0], v0[1]); w.y = pk2(v0[2], v0[3]); w.z = pk2(v1[0], v1[1]); w.w = pk2(v1[2], v1[3]);
                    if (gate) *(u32x4*)(gbase + lbase + (((ai * 4 + m) * 2 + bj) * 512)) = w; else *(u32x4*)(rowp + bj * HALF) = w; } }
    }
};
struct EpiBranch {
    static constexpr bool PERM = true, KEEPS = true;
    const bf16_t* G; const float* bgate; bf16_t* MG;
    static __device__ __forceinline__ float den(float p) { return 1.0f + __expf(-__builtin_amdgcn_fmed3f(p, -30.0f, 30.0f)); }
    __device__ __forceinline__ void operator()(f32x4 (&acc)[2][2][4][2], const Unit& u, int wr, int wc, int fr, int fq) const {
        const int row0 = u.pm * BM + wr * 64 + fr, col0 = u.pn * BM + wc * 32 + 8 * fq; const int br = u.tag; const bool mid = br < 2;
        int lbase = ((wr * 4 + wc) * 1024 + fq * 16 + fr) * 8; asm volatile("" : "+v"(lbase));
        u32x2 bA[2][2], bB[2][2];
#pragma unroll
        for (int bj = 0; bj < 2; ++bj)
#pragma unroll
            for (int n = 0; n < 2; ++n) { const f32x4 t = *(const f32x4*)(bgate + br * D + col0 + bj * HALF + 4 * n); bA[bj][n].x = pk2(t[0], t[1]); bA[bj][n].y = pk2(t[2], t[3]);
                const f32x4 t2 = *(const f32x4*)(bgate + (mid ? br + 1 : br) * D + col0 + bj * HALF + 4 * n); bB[bj][n].x = pk2(t2[0], t2[1]); bB[bj][n].y = pk2(t2[2], t2[3]); }
        const bf16_t* gA = G + ((size_t)(br * (M / BM) + u.pm) * 8 + u.pn) * 65536;
        const bf16_t* gB = gA + (mid ? (size_t)(M / BM) * 8 * 65536 : 0);
        u32x4 gaq[2][2], gbq[2][2];
#define EB_LOAD(A8) do { _Pragma("unroll") for (int bj = 0; bj < 2; ++bj) { const int fo = lbase + (((A8) * 2 + bj) * 512); \
                gaq[(A8) & 1][bj] = *(const u32x4*)(gA + fo); gbq[(A8) & 1][bj] = *(const u32x4*)(gB + fo); } } while (0)
        EB_LOAD(0);
#pragma unroll
        for (int a8 = 0; a8 < 8; ++a8) { const int ai = a8 >> 2, m = a8 & 3; const size_t row = (size_t)(row0 + ai * HALF + m * 16);
            if (a8 + 1 < 8) EB_LOAD(a8 + 1);
            asm volatile("" ::: "memory");
#pragma unroll
                for (int bj = 0; bj < 2; ++bj) { const u32x4 a4 = gaq[a8 & 1][bj], b4 = gbq[a8 & 1][bj];
                    const unsigned aw[4] = {a4.x, a4.y, a4.z, a4.w}, bw[4] = {b4.x, b4.y, b4.z, b4.w}; unsigned ow[4];
#pragma unroll
                    for (int n = 0; n < 2; ++n) { const unsigned bax = bA[bj][n].x, bay = bA[bj][n].y, bbx = bB[bj][n].x, bby = bB[bj][n].y;
                        float f0 = __builtin_amdgcn_rcpf(den(bflo(aw[2 * n]) + bflo(bax))), f1 = __builtin_amdgcn_rcpf(den(bfhi(aw[2 * n]) + bfhi(bax)));
                        float f2 = __builtin_amdgcn_rcpf(den(bflo(aw[2 * n + 1]) + bflo(bay))), f3 = __builtin_amdgcn_rcpf(den(bfhi(aw[2 * n + 1]) + bfhi(bay)));
                        if (mid) { f0 *= den(bflo(bw[2 * n]) + bflo(bbx)); f1 *= den(bfhi(bw[2 * n]) + bfhi(bbx)); f2 *= den(bflo(bw[2 * n + 1]) + bflo(bby)); f3 *= den(bfhi(bw[2 * n + 1]) + bfhi(bby)); }
                        f32x4& av = acc[ai][bj][m][n];
                        av[0] *= f0; av[1] *= f1; av[2] *= f2; av[3] *= f3;
                        ow[2 * n] = pk2(av[0], av[1]); ow[2 * n + 1] = pk2(av[2], av[3]); }
                    if (!mid) { u32x4 o; o.x = ow[0]; o.y = ow[1]; o.z = ow[2]; o.w = ow[3]; *(u32x4*)(MG + row * D + col0 + bj * HALF) = o; } }
        }
#undef EB_LOAD
    }
};
}

#define XB_TMO      128
#define XB_XCNT(j)  (256  + 64 * (j))
#define XB_XSUB(j)  (1280 + 64 * (j))
#define XB_XGEN(j)  (2304 + 64 * (j))
#define XB_TOP      3328
#define XB_TOPGEN   3392
#define XCD_BAR_WORDS 3456
#define XB_SPIN_CAP (1u << 18)
__device__ __forceinline__ unsigned xb_ld(unsigned* p)              { return __hip_atomic_load(p, __ATOMIC_RELAXED, __HIP_MEMORY_SCOPE_AGENT); }
__device__ __forceinline__ unsigned xb_add(unsigned* p, unsigned v) { return __hip_atomic_fetch_add(p, v, __ATOMIC_RELAXED, __HIP_MEMORY_SCOPE_AGENT); }
__device__ __forceinline__ unsigned xb_xcc_id() { return (unsigned)__builtin_amdgcn_s_getreg((3 << 11) | 20) & 0xFu; }
#define XB_SPIN(cond, bar) do { unsigned _sp = 0; while (cond) { __builtin_amdgcn_s_sleep(1); \
    if ((++_sp & 255u) == 0u) { if (xb_ld(&(bar)[XB_TMO])) break; if (_sp > XB_SPIN_CAP) { atomicAdd(&(bar)[XB_TMO], 1u); break; } } } } while (0)
struct XcdBarrier { unsigned* bar; unsigned x; volatile LAS unsigned* st; };
__device__ __forceinline__ XcdBarrier xcd_barrier_post(unsigned* bar, volatile LAS unsigned* st) {
    XcdBarrier b; b.bar = bar; b.x = xb_xcc_id(); b.st = st;
    if (threadIdx.x == 0) (void)xb_add(&bar[XB_XCNT(b.x)], 1u);
    return b;
}
__device__ __forceinline__ void xcd_barrier_complete(unsigned* bar, unsigned x, unsigned& nloc, unsigned& nx) {
    const unsigned G = gridDim.x * gridDim.y * gridDim.z;
    unsigned sum, cnt, mine, sp = 0u;
    for (;;) {
        sum = 0u; cnt = 0u; mine = 0u;
#pragma unroll
        for (unsigned j = 0; j < 16; ++j) { const unsigned c = xb_ld(&bar[XB_XCNT(j)]); sum += c; cnt += (c > 0u) ? 1u : 0u; mine = (j == x) ? c : mine; }
        if (sum == G) break;
        __builtin_amdgcn_s_sleep(1);
        if ((++sp & 255u) == 0u) { if (xb_ld(&bar[XB_TMO])) break; if (sp > XB_SPIN_CAP) { atomicAdd(&bar[XB_TMO], 1u); break; } }
    }
    nloc = mine > 0u ? mine : 1u; nx = cnt > 0u ? cnt : 1u;
}
__device__ __forceinline__ void xcd_barrier(const XcdBarrier& b) {
    asm volatile("s_waitcnt vmcnt(0)" ::: "memory");
    __syncthreads();
    if (threadIdx.x == 0) {
        unsigned* bar = b.bar;
        __builtin_amdgcn_s_waitcnt(0);
        unsigned nloc = b.st[0], nx = b.st[1];
        if (nloc == 0u) { xcd_barrier_complete(bar, b.x, nloc, nx); b.st[0] = nloc; b.st[1] = nx; }
        const unsigned old = xb_add(&bar[XB_XSUB(b.x)], 1u);
        const unsigned gen = old / nloc;
        if (old + 1u == (gen + 1u) * nloc) {
            __builtin_amdgcn_fence(__ATOMIC_RELEASE, "agent");
            asm volatile("s_waitcnt vmcnt(0)" ::: "memory");
            const unsigned og = xb_add(&bar[XB_TOP], 1u);
            const unsigned tg = og / nx;
            if (og + 1u == (tg + 1u) * nx) xb_add(&bar[XB_TOPGEN], 1u);
            else XB_SPIN(xb_ld(&bar[XB_TOPGEN]) == tg, bar);
            __builtin_amdgcn_fence(__ATOMIC_ACQUIRE, "agent");
            xb_add(&bar[XB_XGEN(b.x)], 1u);
            asm volatile("s_waitcnt vmcnt(0)" ::: "memory");
        } else {
            XB_SPIN(xb_ld(&bar[XB_XGEN(b.x)]) == gen, bar);
            __builtin_amdgcn_fence(__ATOMIC_ACQUIRE, "agent");
            asm volatile("s_waitcnt vmcnt(0)" ::: "memory");
        }
    }
    __syncthreads();
}

struct Args { const float* in[33]; float* out; unsigned char* ws; int lo, hi; };
enum { I_X = 0, I_F1IN, I_F1OUT, I_LN1G, I_LN1B, I_WIN, I_BGATE, I_MU, I_W0, I_W2, I_A0, I_A2, I_G2, I_KK, I_KA, I_RK, I_GNG, I_GNB, I_SGLNG, I_SGLNB, I_SGW, I_SGB, I_ILNG, I_ILNB, I_RELB, I_WBR, I_WO, I_LN2G, I_LN2B, I_F2IN, I_F2OUT, I_LN3G, I_LN3B };

DI int pmap(int n) {
    int off = 0;
    off = n >= 3072 ? GN_LORA - 3072 : off; off = n >= 3360 ? PC_SGU - 3360 : off; off = n >= 4384 ? PC_AQ - 4384 : off; off = n >= 5920 ? PC_QI - 5920 : off;
    off = n >= 6944 ? GN_KI - 6944 : off; off = n >= 7008 ? GN_WI - 7008 : off; off = n >= 7024 ? GN_GATE - 7024 : off;
    return n + off;
}
template <int MODE> DI int rowmap(int n) {
    if (MODE == 0) return n;
    if (MODE == 1) { const int up = n >= FF ? 1 : 0, j = n - up * FF; return (j >> 7) * 256 + up * 128 + (j & 127); }
    return pmap(n);
}
struct CvtItem { const float* W; bf16_t* WT; int K, N, mode, item; };
DI void cvt_load(const CvtItem& d, int lane, f32x4 (&va)[4], f32x4 (&vb)[4]) {
    const int nblk = (d.N + 31) / 32, kb = d.item / nblk, nb = d.item % nblk, k0 = 64 * kb, n0 = 32 * nb;
    const int c4 = lane & 7, rq = lane >> 3; const int ncol = n0 + 4 * c4; const int ncl = ncol < d.N ? ncol : 0;
#pragma unroll
    for (int i = 0; i < 4; ++i) { const int k = k0 + 2 * (rq + 8 * i);
        va[i] = *(const f32x4*)(d.W + (size_t)k * d.N + ncl); vb[i] = *(const f32x4*)(d.W + (size_t)(k + 1) * d.N + ncl); }
}
DI void cvt_finish(const CvtItem& d, int lane, const f32x4 (&va)[4], const f32x4 (&vb)[4], float* scr) {
    const int nblk = (d.N + 31) / 32, kb = d.item / nblk, nb = d.item % nblk, k0 = 64 * kb, n0 = 32 * nb;
    unsigned* st = (unsigned*)scr; const int c4 = lane & 7, rq = lane >> 3;
#pragma unroll
    for (int i = 0; i < 4; ++i) { const int rp = rq + 8 * i;
#pragma unroll
        for (int j = 0; j < 4; ++j) st[(4 * c4 + j) * 33 + rp] = pk2(va[i][j], vb[i][j]); }
    __builtin_amdgcn_s_waitcnt(0xc07f); asm volatile("" ::: "memory");
#pragma unroll
    for (int i = 0; i < 4; ++i) { const int id = lane + 64 * i, n = id >> 3, kc = id & 7; const unsigned* p = st + n * 33 + 4 * kc;
        u32x4 o; o.x = p[0]; o.y = p[1]; o.z = p[2]; o.w = p[3];
        const int ns = n0 + n; const int nd1 = rowmap<1>(ns), nd2 = pmap(ns); const int nd = d.mode == 0 ? ns : (d.mode == 1 ? nd1 : nd2);
        if (ns < d.N) *(u32x4*)(d.WT + (size_t)nd * d.K + k0 + 8 * kc) = o; }
    __builtin_amdgcn_s_waitcnt(0xc07f); asm volatile("" ::: "memory");
}
DI void convert_phase(const Args& a, int L, unsigned char* lds, int vb, int nvb) {
    const int tidx_ = otid();
    const int wave = __builtin_amdgcn_readfirstlane(tidx_ >> 6), lane = tidx_ & 63;
    float* scr = (float*)(lds + wave * 16384);
    const int gw = vb * 8 + wave, NGW = nvb * 8;
    unsigned char* ws = a.ws; const size_t alt = (L & 1) ? ALT_SHIFT : 0;
    constexpr int I1 = (D / 64) * ((2 * FF) / 32), I2 = (FF / 64) * (D / 32), I3 = (D / 64) * ((DIN + 31) / 32), I4 = (D / 64) * (D / 32);
    constexpr int NIT = 2 * I1 + 2 * I2 + I3 + 2 * I4;
    auto decode = [&](int it) -> CvtItem {
        int r = it;
        if (r < I1) return CvtItem{a.in[I_F1IN] + (size_t)L * D * 2 * FF, (bf16_t*)(ws + OFF_W1A), D, 2 * FF, 1, r}; r -= I1;
        if (r < I1) return CvtItem{a.in[I_F2IN] + (size_t)L * D * 2 * FF, (bf16_t*)(ws + OFF_W2A + alt), D, 2 * FF, 1, r}; r -= I1;
        if (r < I2) return CvtItem{a.in[I_F1OUT] + (size_t)L * FF * D, (bf16_t*)(ws + OFF_W1B), FF, D, 0, r}; r -= I2;
        if (r < I2) return CvtItem{a.in[I_F2OUT] + (size_t)L * FF * D, (bf16_t*)(ws + OFF_W2B + alt), FF, D, 0, r}; r -= I2;
        if (r < I3) return CvtItem{a.in[I_WIN] + (size_t)L * D * DIN, (bf16_t*)(ws + OFF_WIN), D, DIN, 2, r}; r -= I3;
        if (r < I4) return CvtItem{a.in[I_WBR] + (size_t)L * D * D, (bf16_t*)(ws + OFF_WBR + alt), D, D, 0, r}; r -= I4;
        return CvtItem{a.in[I_WO] + (size_t)L * D * D, (bf16_t*)(ws + OFF_WO + alt), D, D, 0, r};
    };
    auto clampi = [&](int x) { return x < NIT ? x : gw; };
    {
        int it = gw;
        CvtItem dA0 = decode(clampi(it)), dA1 = decode(clampi(it + NGW));
        f32x4 a0[4], b0[4], a1[4], b1[4], a2[4], b2[4], a3[4], b3[4];
        cvt_load(dA0, lane, a0, b0); cvt_load(dA1, lane, a1, b1);
#pragma unroll 1
        for (; it < NIT; it += 4 * NGW) {
            const CvtItem dB0 = decode(clampi(it + 2 * NGW)), dB1 = decode(clampi(it + 3 * NGW));
            cvt_load(dB0, lane, a2, b2); cvt_load(dB1, lane, a3, b3);
            asm volatile("" ::: "memory");
            cvt_finish(dA0, lane, a0, b0, scr); cvt_finish(dA1, lane, a1, b1, scr + 2048);
            asm volatile("" ::: "memory");
            dA0 = decode(clampi(it + 4 * NGW)); dA1 = decode(clampi(it + 5 * NGW));
            cvt_load(dA0, lane, a0, b0); cvt_load(dA1, lane, a1, b1);
            asm volatile("" ::: "memory");
            cvt_finish(dB0, lane, a2, b2, scr); cvt_finish(dB1, lane, a3, b3, scr + 2048);
            asm volatile("" ::: "memory");
        }
    }
    { bf16_t* w2t = (bf16_t*)(ws + OFF_LW2); bf16_t* a2t = (bf16_t*)(ws + OFF_LA2); bf16_t* g2t = (bf16_t*)(ws + OFF_LG2);
      const float* w2 = a.in[I_W2] + (size_t)L * 64 * RW; const float* a2 = a.in[I_A2] + (size_t)L * 64 * RW; const float* g2 = a.in[I_G2] + (size_t)L * 160 * RW;
      for (int i = vb * 512 + tidx_; i < RW * 288; i += nvb * 512) { const int c = i / 288, jj = i - c * 288;
          if (jj < 64) w2t[c * 64 + jj] = (bf16_t)f2bf(w2[(size_t)jj * RW + c]);
          else if (jj < 128) a2t[c * 64 + jj - 64] = (bf16_t)f2bf(a2[(size_t)(jj - 64) * RW + c]);
          else g2t[c * 160 + jj - 128] = (bf16_t)f2bf(g2[(size_t)(jj - 128) * RW + c]); } }
    { u32x4* z = (u32x4*)(ws + OFF_WIN + (size_t)DIN * D * 2); const int n16 = (NP - DIN) * D * 2 / 16;
      u32x4 zq = (u32x4){0u, 0u, 0u, 0u}; asm volatile("" : "+v"(zq));
      for (int i = vb * 512 + tidx_; i < n16; i += nvb * 512) z[i] = zq; }
}
DI int rel_bucket_dev(int d) {
    if (d < 16) return d;
    const float df = (float)d;
    const int large = 16 + (int)(logf(df / 16.0f) / 2.0794415416798357f * 16.0f);
    return large < 31 ? large : 31;
}
DI void init_phase(const Args& a) {
    const int tidx_ = otid();
    const size_t n4 = (size_t)M * D / 4; const f32x4* x = (const f32x4*)a.in[I_X]; u32x2* XB = (u32x2*)(a.ws + OFF_XB);
    for (size_t i = (size_t)blockIdx.x * 512 + tidx_; i < n4; i += (size_t)gridDim.x * 512) { const f32x4 v = x[i]; u32x2 o; o.x = pk2(v[0], v[1]); o.y = pk2(v[2], v[3]); XB[i] = o; }
    if (blockIdx.x == 0) { float* bt = (float*)(a.ws + OFF_BIAS); for (int i = tidx_; i < 8 * 128; i += 512) { const int h = i >> 7, d = i & 127; bt[i] = a.in[I_RELB][rel_bucket_dev(d) * 8 + h]; } }
}
DI void ln_phase(const float* T, const float* g, const float* b, float* ST, bf16_t* XB, float* out) {
    const int tidx_ = otid();
    const int wave = __builtin_amdgcn_readfirstlane(tidx_ >> 6), lane = tidx_ & 63;
    const int stride = gridDim.x * 8;
    f32x4 gvs[8], bvs[8];
#pragma unroll
    for (int j = 0; j < 8; ++j) { gvs[j] = ((const f32x4*)g)[lane + 64 * j]; bvs[j] = ((const f32x4*)b)[lane + 64 * j]; }
    int m = blockIdx.x * 8 + wave;
    f32x4 nx[8];
    if (m < M) {
#pragma unroll
        for (int j = 0; j < 8; ++j) nx[j] = ((const f32x4*)(T + (size_t)m * D) + lane)[64 * j]; }
#pragma unroll 1
    for (; m < M; m += stride) {
        f32x4 v[8]; float s = 0.f;
#pragma unroll
        for (int j = 0; j < 8; ++j) { v[j] = nx[j]; s += (v[j][0] + v[j][1]) + (v[j][2] + v[j][3]); }
        if (m + stride < M) {
#pragma unroll
            for (int j = 0; j < 8; ++j) nx[j] = ((const f32x4*)(T + (size_t)(m + stride) * D) + lane)[64 * j]; }
        const float mean = wave_sum(s) * (1.0f / D); float q = 0.f;
#pragma unroll
        for (int j = 0; j < 8; ++j) { v[j] = v[j] - mean; q += (v[j][0] * v[j][0] + v[j][1] * v[j][1]) + (v[j][2] * v[j][2] + v[j][3] * v[j][3]); }
        const float rstd = __builtin_amdgcn_rsqf(wave_sum(q) * (1.0f / D) + LN_EPS);
        if (lane == 0) *(f32x2*)(ST + 2 * (size_t)m) = (f32x2){mean, rstd};
        u32x2* bo = (u32x2*)(XB + (size_t)m * D) + lane;
#pragma unroll
        for (int j = 0; j < 8; ++j) {
            const f32x4 o = v[j] * rstd * gvs[j] + bvs[j]; u32x2 w; w.x = pk2(o[0], o[1]); w.y = pk2(o[2], o[3]); bo[64 * j] = w;
            if (out) ((f32x4*)(out + (size_t)m * D) + lane)[64 * j] = o; }
    }
}
DI void rwkv_prep_phase(const Args& a, int L, unsigned char* lds) {
    const int tidx_ = otid();
    const int tid = tidx_;
    const bf16_t* P = (const bf16_t*)(a.ws + OFF_P);
    float* Rr = (float*)(a.ws + OFF_SCR); float* Wr = Rr + (size_t)M * RW; float* Kr = Wr + (size_t)M * RW; float* Vr = Kr + (size_t)M * RW; float* Ar = Vr + (size_t)M * RW; float* Br = Ar + (size_t)M * RW;
    bf16_t* Gb = (bf16_t*)(a.ws + OFF_MG);
    const float* mu = a.in[I_MU] + (size_t)L * 3360; const float* w0 = a.in[I_W0] + L * RW; const float* w2 = a.in[I_W2] + (size_t)L * 64 * RW;
    const float* a0 = a.in[I_A0] + L * RW; const float* a2 = a.in[I_A2] + (size_t)L * 64 * RW; const float* g2 = a.in[I_G2] + (size_t)L * 160 * RW;
    const float* kkw = a.in[I_KK] + L * RW; const float* kaw = a.in[I_KA] + L * RW;
    float* xl = (float*)lds;
    for (int unit = blockIdx.x; unit < M / 32; unit += gridDim.x) {
        const int m0 = unit * 32;
        __syncthreads();
        for (int idx = tid; idx < 32 * 288; idx += 512) { const int tt = idx / 288, j = idx - tt * 288; const int m = m0 + tt;
            const float cur = bf2f(P[(size_t)m * PCOLS + PC_LORA + j]); const float prev = (m & (SEQ - 1)) == 0 ? 0.f : bf2f(P[(size_t)(m - 1) * PCOLS + PC_LORA + j]);
            float x = cur + (prev - cur) * mu[3072 + j];
            if (j < 64) x = tanhf(x); else if (j >= 128) x = sigmoidf_(x);
            xl[idx] = x; }
        __syncthreads();
#pragma unroll 1
        for (int half = 0; half < 2; ++half) { const int c = tid + 512 * half;
            const float w0c = w0[c], a0c = a0[c], kkc = kkw[c], kac = kaw[c], mur = mu[c], muk = mu[1024 + c], muv = mu[2048 + c];
#pragma unroll 1
            for (int sub = 0; sub < 4; ++sub) {
                float wl[8], al[8], gl[8];
#pragma unroll
                for (int t = 0; t < 8; ++t) { wl[t] = w0c; al[t] = a0c; gl[t] = 0.f; }
                const float* xb = xl + sub * 8 * 288;
#pragma unroll 2
                for (int j = 0; j < 64; j += 4) { const float u0 = w2[(size_t)(j + 0) * RW + c], u1 = w2[(size_t)(j + 1) * RW + c], u2 = w2[(size_t)(j + 2) * RW + c], u3 = w2[(size_t)(j + 3) * RW + c];
                    const float v0 = a2[(size_t)(j + 0) * RW + c], v1 = a2[(size_t)(j + 1) * RW + c], v2 = a2[(size_t)(j + 2) * RW + c], v3 = a2[(size_t)(j + 3) * RW + c];
#pragma unroll
                    for (int t = 0; t < 8; ++t) { const f32x4 xw = *(const f32x4*)(xb + t * 288 + j); const f32x4 xa = *(const f32x4*)(xb + t * 288 + 64 + j);
                        wl[t] += xw[0] * u0 + xw[1] * u1 + xw[2] * u2 + xw[3] * u3; al[t] += xa[0] * v0 + xa[1] * v1 + xa[2] * v2 + xa[3] * v3; } }
#pragma unroll 2
                for (int j = 0; j < 160; j += 4) { const float u0 = g2[(size_t)(j + 0) * RW + c], u1 = g2[(size_t)(j + 1) * RW + c], u2 = g2[(size_t)(j + 2) * RW + c], u3 = g2[(size_t)(j + 3) * RW + c];
#pragma unroll
                    for (int t = 0; t < 8; ++t) { const f32x4 xg = *(const f32x4*)(xb + t * 288 + 128 + j); gl[t] += xg[0] * u0 + xg[1] * u1 + xg[2] * u2 + xg[3] * u3; } }
#pragma unroll
                for (int t = 0; t < 8; ++t) { const int m = m0 + sub * 8 + t; const bool first = (m & (SEQ - 1)) == 0;
                    const bf16_t* pc = P + (size_t)m * PCOLS; const bf16_t* pp = pc - PCOLS;
                    const float rc = bf2f(pc[PC_R + c]), kc = bf2f(pc[PC_K + c]), vc = bf2f(pc[PC_V + c]);
                    const float rp = first ? 0.f : bf2f(pp[PC_R + c]), kp = first ? 0.f : bf2f(pp[PC_K + c]), vp = first ? 0.f : bf2f(pp[PC_V + c]);
                    const float r = rc + (rp - rc) * mur, k = kc + (kp - kc) * muk, v = vc + (vp - vc) * muv;
                    const float nx = -wl[t]; const float sp = nx > 20.f ? nx : log1pf(expf(nx));
                    const float decay = expf(-expf(-sp - 0.5f));
                    const float av = 1.0f / (1.0f + expf(-al[t]));
                    const float kk = k * kkc; const float ss = wave_sum(kk * kk); const float kkn = kk / fmaxf(sqrtf(ss), 1e-12f);
                    const float k2 = k * (1.0f + (av - 1.0f) * kac);
                    const size_t o = (size_t)m * RW + c;
                    Rr[o] = r; Wr[o] = decay; Kr[o] = k2; Vr[o] = v; Ar[o] = -kkn; Br[o] = kkn * av; Gb[o] = (bf16_t)f2bf(gl[t]); }
            }
        }
    }
}
struct WorkQ { unsigned* ctr; int pend, par, stride; };
constexpr int WQ_SLOT = 147456 - 16;
DI int wq_next(WorkQ& q, int cur, unsigned char* lds, int tid) {
    if (!q.ctr) return cur + q.stride;
    LAS int* slot = (LAS int*)(lds + WQ_SLOT);
    if (tid == 0) slot[q.par] = q.pend;
    __syncthreads();
    const int v = __builtin_amdgcn_readfirstlane(slot[q.par]);
    q.par ^= 1;
    if (tid == 0) q.pend = (int)__hip_atomic_fetch_add(q.ctr, 1u, __ATOMIC_RELAXED, __HIP_MEMORY_SCOPE_AGENT);
    return v;
}
DI int wq_first(WorkQ& q, unsigned char* lds, int tid) {
    q.par = 0; q.pend = 0;
    if (tid == 0) q.pend = (int)__hip_atomic_fetch_add(q.ctr, 1u, __ATOMIC_RELAXED, __HIP_MEMORY_SCOPE_AGENT);
    return wq_next(q, 0, lds, tid);
}
DI void kidx_vt_phase(const Args& a, int L, unsigned char* lds) {
    const int tidx_ = otid();
    const int wave = __builtin_amdgcn_readfirstlane(tidx_ >> 6), lane = tidx_ & 63;
    const bf16_t* P = (const bf16_t*)(a.ws + OFF_P); bf16_t* KI = (bf16_t*)(a.ws + OFF_KI); bf16_t* VT = (bf16_t*)(a.ws + OFF_VT);
    const float g = a.in[I_ILNG][L * 64 + lane], b = a.in[I_ILNB][L * 64 + lane];
    for (int m0 = blockIdx.x * 8 + wave; m0 < M; m0 += gridDim.x * 8 * 8) {
        bf16_t raw[8];
#pragma unroll
        for (int i = 0; i < 8; ++i) { const int m = m0 + i * gridDim.x * 8; raw[i] = m < M ? P[(size_t)m * PCOLS + PC_KI + lane] : (bf16_t)0; }
#pragma unroll
        for (int i = 0; i < 8; ++i) { const int m = m0 + i * gridDim.x * 8; if (m < M) { const float x = bf2f(raw[i]);
            const float mean = wave_sum(x) * (1.0f / 64.0f); const float d = x - mean; const float var = wave_sum(d * d) * (1.0f / 64.0f);
            KI[(size_t)m * 64 + lane] = (bf16_t)f2bf(d * __builtin_amdgcn_rsqf(var + LN_EPS) * g + b); } }
    }
    bf16_t* tile = (bf16_t*)(lds + wave * 16384);
    for (int u = blockIdx.x * 8 + wave; u < NB * 8 * 64; u += gridDim.x * 8) {
        const int tb = u & 63, h = (u >> 6) & 7, b_ = u >> 9; const int m = b_ * SEQ + tb * 64 + lane;
        const u32x4* src = (const u32x4*)(P + (size_t)m * PCOLS + PC_AV + h * 64);
#pragma unroll
        for (int q = 0; q < 8; ++q) { const u32x4 v = src[q]; const unsigned w[4] = {v.x, v.y, v.z, v.w};
#pragma unroll
            for (int e = 0; e < 4; ++e) { tile[(q * 8 + 2 * e) * 72 + lane] = (bf16_t)(w[e] & 0xffffu); tile[(q * 8 + 2 * e + 1) * 72 + lane] = (bf16_t)(w[e] >> 16); } }
        __builtin_amdgcn_s_waitcnt(0xc07f); asm volatile("" ::: "memory");
        bf16_t* dst = VT + ((size_t)(b_ * 8 + h) * 64 + lane) * SEQ + tb * 64;
#pragma unroll
        for (int q = 0; q < 8; ++q) *(u32x4*)(dst + q * 8) = *(const u32x4*)(tile + lane * 72 + q * 8);
        __builtin_amdgcn_s_waitcnt(0xc07f); asm volatile("" ::: "memory");
    }
}
DI void sgu_phase(const Args& a, int L, unsigned char* lds, WorkQ& wq, int& item, int ibase) {
    const int tidx_ = otid();
    const int tid = tidx_, wave = __builtin_amdgcn_readfirstlane(tid >> 6), lane = tid & 63, fr = lane & 15, fq = lane >> 4;
    const bf16_t* P = (const bf16_t*)(a.ws + OFF_P); bf16_t* Y = (bf16_t*)(a.ws + OFF_Y);
    const float* lng = a.in[I_SGLNG] + L * 512; const float* lnb = a.in[I_SGLNB] + L * 512;
    bf16_t* Wl = (bf16_t*)lds;
    bf16_t* Vl = (bf16_t*)(lds + 128 * 272);
    for (; item < ibase + NB * 32 * 4; item = wq_next(wq, item, lds, tid)) {
        const int unit = item - ibase;
        const int g = unit & 3, ch = (unit >> 2) & 31, b_ = unit >> 7; const int m0 = b_ * SEQ + ch * 128;
        const float* sw = a.in[I_SGW] + ((size_t)(L * 4 + g) * 128) * 128; const float* sb = a.in[I_SGB] + (L * 4 + g) * 128;
        __syncthreads();
#pragma unroll
        for (int it8 = 0; it8 < 8; ++it8) { const int idx = tid + 512 * it8; const int i = idx >> 5, j4 = (idx & 31) * 4; const f32x4 w = *(const f32x4*)(sw + i * 128 + j4);
            u32x2 o; o.x = pk2(j4 + 0 <= i ? w[0] : 0.f, j4 + 1 <= i ? w[1] : 0.f); o.y = pk2(j4 + 2 <= i ? w[2] : 0.f, j4 + 3 <= i ? w[3] : 0.f);
            *(u32x2*)(Wl + i * 136 + j4) = o; }
        float lgv[8], lbv[8];
#pragma unroll
        for (int e = 0; e < 8; ++e) { lgv[e] = lng[lane * 8 + e]; lbv[e] = lnb[lane * 8 + e]; }
#pragma unroll 1
        for (int ib = 0; ib < 2; ++ib) {
        u32x4 pvs[8];
#pragma unroll
        for (int i = 0; i < 8; ++i) pvs[i] = *(const u32x4*)(P + (size_t)(m0 + wave + 8 * (8 * ib + i)) * PCOLS + PC_SGV + lane * 8);
#pragma unroll
        for (int i = 0; i < 8; ++i) { const int tt = wave + 8 * (8 * ib + i);
            const u32x4 pv = pvs[i];
            float z[8]; z[0] = gelu_erf(bflo(pv.x)); z[1] = gelu_erf(bfhi(pv.x)); z[2] = gelu_erf(bflo(pv.y)); z[3] = gelu_erf(bfhi(pv.y));
            z[4] = gelu_erf(bflo(pv.z)); z[5] = gelu_erf(bfhi(pv.z)); z[6] = gelu_erf(bflo(pv.w)); z[7] = gelu_erf(bfhi(pv.w));
            float s = 0.f;
#pragma unroll
            for (int e = 0; e < 8; ++e) s += z[e];
            const float mean = wave_sum(s) * (1.0f / 512.0f); float q = 0.f;
#pragma unroll
            for (int e = 0; e < 8; ++e) { z[e] -= mean; q += z[e] * z[e]; }
            const float rstd = __builtin_amdgcn_rsqf(wave_sum(q) * (1.0f / 512.0f) + LN_EPS);
            if ((lane >> 4) == g) {
#pragma unroll
                for (int e = 0; e < 8; ++e) Vl[((lane & 15) * 8 + e) * 136 + tt] = (bf16_t)f2bf(z[e] * rstd * lgv[e] + lbv[e]); }
        }
        }
        __syncthreads();
        f32x4 acc[8];
#pragma unroll
        for (int nt = 0; nt < 8; ++nt) acc[nt] = (f32x4){0.f, 0.f, 0.f, 0.f};
        const int ksmax = (16 * wave + 15) >> 5;
#pragma unroll
        for (int ks = 0; ks < 4; ++ks) if (ks <= ksmax) {
            const bf16x8 af = *(const bf16x8*)(Wl + (16 * wave + fr) * 136 + 32 * ks + 8 * fq);
#pragma unroll
            for (int nt = 0; nt < 8; ++nt) { const bf16x8 bfr = *(const bf16x8*)(Vl + (16 * nt + fr) * 136 + 32 * ks + 8 * fq);
                acc[nt] = __builtin_amdgcn_mfma_f32_16x16x32_bf16(af, bfr, acc[nt], 0, 0, 0); }
        }
        bf16_t ur[4][8];
#pragma unroll
        for (int r = 0; r < 4; ++r)
#pragma unroll
            for (int nt = 0; nt < 8; ++nt) ur[r][nt] = P[(size_t)(m0 + 16 * wave + 4 * fq + r) * PCOLS + PC_SGU + g * 128 + 16 * nt + fr];
        float bsv[4];
#pragma unroll
        for (int r = 0; r < 4; ++r) bsv[r] = sb[16 * wave + 4 * fq + r];
        asm volatile("" ::: "memory");
#pragma unroll
        for (int r = 0; r < 4; ++r) { const int i = 16 * wave + 4 * fq + r; const float bs = bsv[r]; const size_t m = (size_t)(m0 + i);
#pragma unroll
            for (int nt = 0; nt < 8; ++nt) { const int dcol = g * 128 + 16 * nt + fr; const float uu = gelu_erf(bf2f(ur[r][nt]));
                Y[m * D + 1024 + dcol] = (bf16_t)f2bf(uu * (acc[nt][r] + bs)); } }
    }
}
DI void scan_load_chunk(unsigned char* bufp, const float* Rr, const float* Wr, const float* Kr, const float* Ar, const float* Br, const float* Vr, size_t base, int c, int rg, int lt) {
    const float* arrs[5] = {Rr, Wr, Kr, Ar, Br};
#pragma unroll
    for (int ar = 0; ar < 5; ++ar)
#pragma unroll
        for (int ps = 0; ps < 2; ++ps) { const int tt = ps * 16 + (lt >> 4), c4 = (lt & 15) * 4;
            const f32x4 v = *(const f32x4*)(arrs[ar] + base + (size_t)(c * 32 + tt) * RW + c4);
            *(f32x4*)(bufp + ar * 8192 + (tt * 64 + c4) * 4) = v; }
    if (lt < 128) { const int tt = lt >> 2, i4 = (lt & 3) * 4; const f32x4 v = *(const f32x4*)(Vr + base + (size_t)(c * 32 + tt) * RW + rg * 16 + i4);
        *(f32x4*)(bufp + 5 * 8192 + (tt * 16 + i4) * 4) = v; }
}
DI void scan_phase(const Args& a, unsigned char* lds) {
    const int tidx_ = otid();
    const int tid = tidx_;
    const float* Rr = (const float*)(a.ws + OFF_SCR); const float* Wr = Rr + (size_t)M * RW; const float* Kr = Wr + (size_t)M * RW; const float* Vr = Kr + (size_t)M * RW; const float* Ar = Vr + (size_t)M * RW; const float* Br = Ar + (size_t)M * RW;
    float* Yraw = (float*)(a.ws + OFF_X);
    constexpr int BUFB = 5 * 8192 + 2048;
    constexpr int NCH = SEQ / 32;
    for (int unit = blockIdx.x; unit < 256; unit += gridDim.x) {
        const int rg = unit & 3, h = (unit >> 2) & 15, b_ = unit >> 6;
        const size_t base = (size_t)b_ * SEQ * RW + h * 64;
        __syncthreads();
        const bool loader = tid >= 256; const int lt = tid - 256;
        if (loader) scan_load_chunk(lds, Rr, Wr, Kr, Ar, Br, Vr, base, 0, rg, lt);
        __syncthreads();
        float S0 = 0.f, S1 = 0.f, S2 = 0.f, S3 = 0.f;
        const int i = tid >> 4, c4 = tid & 15;
#pragma unroll 1
        for (int c = 0; c < NCH; ++c) {
            if (loader) {
                if (c > 0 && lt < 128) { const int tt = lt >> 2, i4 = (lt & 3) * 4; const f32x4 y = *(const f32x4*)(lds + 2 * BUFB + ((c - 1) & 1) * 2048 + (tt * 16 + i4) * 4);
                    *(f32x4*)(Yraw + base + (size_t)((c - 1) * 32 + tt) * RW + rg * 16 + i4) = y; }
                if (c + 1 < NCH) scan_load_chunk(lds + ((c + 1) & 1) * BUFB, Rr, Wr, Kr, Ar, Br, Vr, base, c + 1, rg, lt);
            } else {
                const unsigned char* bufp = lds + (c & 1) * BUFB; float* yb = (float*)(lds + 2 * BUFB + (c & 1) * 2048);
#pragma unroll 4
                for (int s = 0; s < 32; ++s) {
                    const f32x4 r4 = *(const f32x4*)(bufp + 0 * 8192 + (s * 64 + c4 * 4) * 4);
                    const f32x4 w4 = *(const f32x4*)(bufp + 1 * 8192 + (s * 64 + c4 * 4) * 4);
                    const f32x4 k4 = *(const f32x4*)(bufp + 2 * 8192 + (s * 64 + c4 * 4) * 4);
                    const f32x4 a4 = *(const f32x4*)(bufp + 3 * 8192 + (s * 64 + c4 * 4) * 4);
                    const f32x4 b4 = *(const f32x4*)(bufp + 4 * 8192 + (s * 64 + c4 * 4) * 4);
                    const float vi = *(const float*)(bufp + 5 * 8192 + (s * 16 + i) * 4);
                    float sa = (S0 * a4[0] + S1 * a4[1]) + (S2 * a4[2] + S3 * a4[3]);
                    sa = row16_sum(sa);
                    S0 = S0 * w4[0] + sa * b4[0] + vi * k4[0]; S1 = S1 * w4[1] + sa * b4[1] + vi * k4[1];
                    S2 = S2 * w4[2] + sa * b4[2] + vi * k4[2]; S3 = S3 * w4[3] + sa * b4[3] + vi * k4[3];
                    float yp = (S0 * r4[0] + S1 * r4[1]) + (S2 * r4[2] + S3 * r4[3]);
                    yp = row16_sum(yp);
                    if (c4 == 0) yb[s * 16 + i] = yp;
                }
            }
            __syncthreads();
        }
        if (loader && lt < 128) { const int tt = lt >> 2, i4 = (lt & 3) * 4; const f32x4 y = *(const f32x4*)(lds + 2 * BUFB + ((NCH - 1) & 1) * 2048 + (tt * 16 + i4) * 4);
            *(f32x4*)(Yraw + base + (size_t)((NCH - 1) * 32 + tt) * RW + rg * 16 + i4) = y; }
    }
}
DI void rwkv_fin_phase(const Args& a, int L) {
    const int tidx_ = otid();
    const int wave = __builtin_amdgcn_readfirstlane(tidx_ >> 6), lane = tidx_ & 63;
    const float* Rr = (const float*)(a.ws + OFF_SCR); const float* Kr = Rr + 2 * (size_t)M * RW; const float* Vr = Kr + (size_t)M * RW;
    const float* Yraw = (const float*)(a.ws + OFF_X); const bf16_t* Gb = (const bf16_t*)(a.ws + OFF_MG); bf16_t* Y = (bf16_t*)(a.ws + OFF_Y);
    const float* rk = a.in[I_RK] + L * RW; const float* gng = a.in[I_GNG] + L * RW; const float* gnb = a.in[I_GNB] + L * RW;
    for (int it = blockIdx.x * 8 + wave; it < M * 16; it += gridDim.x * 8) {
        const int m = it >> 4, h = it & 15, c = h * 64 + lane; const size_t o = (size_t)m * RW + c;
        const float y = Yraw[o], r = Rr[o], k = Kr[o], v = Vr[o];
        const float mean = wave_sum(y) * (1.0f / 64.0f); const float d = y - mean; const float var = wave_sum(d * d) * (1.0f / 64.0f);
        const float yn = d * (1.0f / sqrtf(var + 64e-5f)) * gng[c] + gnb[c];
        const float bonus = wave_sum(r * k * rk[c]) * v;
        Y[(size_t)m * D + c] = (bf16_t)f2bf((yn + bonus) * bf2f(Gb[o]));
    }
}
DI void rwkv_par_phase(const Args& a, int L, unsigned char* lds) {
    const int tidx_ = otid();
    const int tid = tidx_, wave = __builtin_amdgcn_readfirstlane(tid >> 6), lane = tid & 63, fr = lane & 15, q = lane >> 4;
    const bf16_t* P = (const bf16_t*)(a.ws + OFF_P); unsigned char* RECB = a.ws + OFF_SCR;
    const bf16_t* W2T = (const bf16_t*)(a.ws + OFF_LW2); const bf16_t* A2T = (const bf16_t*)(a.ws + OFF_LA2); const bf16_t* G2T = (const bf16_t*)(a.ws + OFF_LG2);
    const float* mu = a.in[I_MU] + (size_t)L * 3360; const float* w0 = a.in[I_W0] + L * RW; const float* a0 = a.in[I_A0] + L * RW;
    const float* kkw = a.in[I_KK] + L * RW; const float* kaw = a.in[I_KA] + L * RW; const float* rkw = a.in[I_RK] + L * RW;
    unsigned char* XL = lds;
    unsigned char* WS = lds + 9472 + wave * 12288;
    for (int unit = blockIdx.x; unit < NB * 256; unit += gridDim.x) {
        const int b_ = unit >> 8, cidx = unit & 255; const int m0 = b_ * SEQ + cidx * 16;
        __syncthreads();
        { const int t0 = 2 * wave; const int mrow = m0 + t0; const bool frow = (mrow & (SEQ - 1)) == 0;
          const bf16_t* prow = P + (size_t)mrow * PCOLS + PC_LORA; const bf16_t* pprev = frow ? prow : prow - PCOLS;
          bf16_t xp[5], x0[5], x1[5]; float muv[5];
#pragma unroll
          for (int p = 0; p < 5; ++p) { const int col = lane + 64 * p, colc = col < 288 ? col : 0; xp[p] = pprev[colc]; x0[p] = prow[colc]; x1[p] = prow[PCOLS + colc]; muv[p] = mu[3072 + colc]; }
#pragma unroll
          for (int p = 0; p < 5; ++p) { const int col = lane + 64 * p; const float c0 = bf2f(x0[p]), c1 = bf2f(x1[p]), pv = frow ? 0.f : bf2f(xp[p]);
              float y0 = c0 + (pv - c0) * muv[p], y1 = c1 + (c0 - c1) * muv[p];
              if (p == 0) { y0 = 1.0f - 2.0f * __builtin_amdgcn_rcpf(__expf(2.0f * y0) + 1.0f); y1 = 1.0f - 2.0f * __builtin_amdgcn_rcpf(__expf(2.0f * y1) + 1.0f); }
              else if (p >= 2) { y0 = __builtin_amdgcn_rcpf(1.0f + __expf(-y0)); y1 = __builtin_amdgcn_rcpf(1.0f + __expf(-y1)); }
              if (col < 288) { *(bf16_t*)(XL + t0 * 592 + col * 2) = (bf16_t)f2bf(y0); *(bf16_t*)(XL + (t0 + 1) * 592 + col * 2) = (bf16_t)f2bf(y1); } } }
        __syncthreads();
#define AXF(ks) (*(const bf16x8*)(XL + fr * 592 + (32 * (ks) + 8 * q) * 2))
#pragma unroll 1
        for (int hh2 = 0; hh2 < 2; ++hh2) {
            const int h = wave + 8 * hh2; const int c = h * 64 + lane;
            unsigned char* rec = RECB + (size_t)(cidx * 64 + b_ * 16 + h) * REC;
            const bool first = (m0 & (SEQ - 1)) == 0;
            const bf16_t* pbase = P + (size_t)m0 * PCOLS + h * 64 + lane;
            const float w0c = w0[c], a0c = a0[c], kkc = kkw[c], kac = kaw[c], rkc = rkw[c], mur = mu[c], muk = mu[1024 + c], muv = mu[2048 + c];
            bf16x8 bwf[4][2], baf[4][2];
#pragma unroll
            for (int nt = 0; nt < 4; ++nt) { const int cn = h * 64 + 16 * nt + fr;
#pragma unroll
                for (int ks = 0; ks < 2; ++ks) { bwf[nt][ks] = *(const bf16x8*)(W2T + cn * 64 + 32 * ks + 8 * q); baf[nt][ks] = *(const bf16x8*)(A2T + cn * 64 + 32 * ks + 8 * q); } }
            asm volatile("" ::: "memory");
            f32x4 accW[4], accA[4], accG[4];
#pragma unroll
            for (int nt = 0; nt < 4; ++nt) { accW[nt] = (f32x4){0.f, 0.f, 0.f, 0.f}; accA[nt] = accW[nt]; accG[nt] = accW[nt];
#pragma unroll
                for (int ks = 0; ks < 2; ++ks) { accW[nt] = __builtin_amdgcn_mfma_f32_16x16x32_bf16(AXF(ks), bwf[nt][ks], accW[nt], 0, 0, 0); accA[nt] = __builtin_amdgcn_mfma_f32_16x16x32_bf16(AXF(2 + ks), baf[nt][ks], accA[nt], 0, 0, 0); } }
#pragma unroll
            for (int n2 = 0; n2 < 2; ++n2) { bf16x8 bgf[2][5];
#pragma unroll
                for (int nn = 0; nn < 2; ++nn) { const int cn = h * 64 + 16 * (2 * n2 + nn) + fr;
#pragma unroll
                    for (int ks = 0; ks < 5; ++ks) bgf[nn][ks] = *(const bf16x8*)(G2T + cn * 160 + 32 * ks + 8 * q); }
                asm volatile("" ::: "memory");
#pragma unroll
                for (int nn = 0; nn < 2; ++nn)
#pragma unroll
                    for (int ks = 0; ks < 5; ++ks) accG[2 * n2 + nn] = __builtin_amdgcn_mfma_f32_16x16x32_bf16(AXF(4 + ks), bgf[nn][ks], accG[2 * n2 + nn], 0, 0, 0); }
            unsigned rawrk[17], rawvv[9];
#pragma unroll
            for (int t = 0; t < 17; ++t) { const bf16_t* pc = pbase + (ptrdiff_t)(t - 1) * PCOLS; const bool ok = t > 0 || !first;
                const unsigned rr_ = ok ? (unsigned)pc[PC_R] : 0u, kk_ = ok ? (unsigned)pc[PC_K] : 0u, vv_ = ok ? (unsigned)pc[PC_V] : 0u;
                rawrk[t] = rr_ | (kk_ << 16); if (t & 1) rawvv[t >> 1] |= vv_ << 16; else rawvv[t >> 1] = vv_; }
            float* X3 = (float*)WS;
#pragma unroll
            for (int nt = 0; nt < 4; ++nt)
#pragma unroll
                for (int r = 0; r < 4; ++r) { const int o = (4 * q + r) * 64 + 16 * nt + fr; X3[o] = accW[nt][r]; X3[1024 + o] = accA[nt][r]; X3[2048 + o] = accG[nt][r]; }
            float cum[16], asg[16];
            { float run = 0.f;
#pragma unroll
              for (int t = 0; t < 16; ++t) { float dw = X3[t * 64 + lane], da = X3[1024 + t * 64 + lane], dg = X3[2048 + t * 64 + lane];
#if DBG_LORA
                  { const float* w2 = a.in[I_W2] + (size_t)L * 64 * RW; const float* a2 = a.in[I_A2] + (size_t)L * 64 * RW; const float* g2 = a.in[I_G2] + (size_t)L * 160 * RW;
                    float s0 = 0.f, s1 = 0.f, s2 = 0.f;
                    for (int jj = 0; jj < 64; ++jj) { s0 += bf2f(*(const bf16_t*)(XL + t * 592 + jj * 2)) * w2[(size_t)jj * RW + c]; s1 += bf2f(*(const bf16_t*)(XL + t * 592 + (64 + jj) * 2)) * a2[(size_t)jj * RW + c]; }
                    for (int jj = 0; jj < 160; ++jj) s2 += bf2f(*(const bf16_t*)(XL + t * 592 + (128 + jj) * 2)) * g2[(size_t)jj * RW + c];
                    dw = s0; da = s1; dg = s2; }
#endif
                  const float nx = -(w0c + dw);
                  run += -0.60653065971263342f * __builtin_amdgcn_rcpf(1.0f + __expf(nx)); cum[t] = run; asg[t] = __builtin_amdgcn_rcpf(1.0f + __expf(-(a0c + da)));
                  *(bf16_t*)(rec + R_G + (t * 64 + lane) * 2) = (bf16_t)f2bf(dg); } }
            asm volatile("" ::: "memory");
            const float gC = __expf(cum[15]); *(float*)(rec + R_GC + lane * 4) = gC;
            bf16_t* imgA = (bf16_t*)WS; bf16_t* imgR = (bf16_t*)(WS + 2304); bf16_t* imgB = (bf16_t*)(WS + 4608); bf16_t* imgK = (bf16_t*)(WS + 6912);
            float At[16]; unsigned vpk[8]; float bgv[4], kgv[4]; float vprev = 0.f;
            float rr[16], kkv[16], k2v[16], rsn, vp = bflo(rawvv[0]);
            { float sq[16], bo[16]; float rp = bflo(rawrk[0]), kp = bfhi(rawrk[0]);
#pragma unroll
              for (int t = 0; t < 16; ++t) { const float rc = bflo(rawrk[t + 1]), kc = bfhi(rawrk[t + 1]);
                  const float r = rc + (rp - rc) * mur, k = kc + (kp - kc) * muk; rp = rc; kp = kc;
                  const float kk = k * kkc, k2 = k * (1.0f + (asg[t] - 1.0f) * kac);
                  rr[t] = r; kkv[t] = kk; k2v[t] = k2; sq[t] = kk * kk; bo[t] = r * k2 * rkc; }
              const float sqs = rs16(sq, lane), bos = rs16(bo, lane);
              rsn = __builtin_amdgcn_rsqf(fmaxf(sqs, 1e-24f));
              if ((lane & 12) == 0) *(float*)(rec + R_BON + ((lane & 3) + 4 * (lane >> 4)) * 4) = bos; }
            float eprev = 1.0f;
#pragma unroll
            for (int t = 0; t < 16; ++t) {
                const float vc = ((t + 1) & 1) ? bfhi(rawvv[(t + 1) >> 1]) : bflo(rawvv[(t + 1) >> 1]);
                const float r = rr[t], v = vc + (vp - vc) * muv; vp = vc;
                const float asig = asg[t];
                const float kkn = kkv[t] * __int_as_float(__builtin_amdgcn_readlane(__float_as_int(rsn), (t & 3) + 16 * (t >> 2)));
                const float k2 = k2v[t]; const float av = -kkn, bv = kkn * asig;
                const float e2 = __expf(cum[t]), e3 = __expf(-cum[t]), e4 = __expf(cum[15] - cum[t]);
                At[t] = eprev * av; eprev = e2;
                const float Rt = e2 * r, Bt = bv * e3, Kt = k2 * e3;
                imgA[t * 72 + lane] = (bf16_t)f2bf(At[t]); imgR[t * 72 + lane] = (bf16_t)f2bf(Rt); imgB[t * 72 + lane] = (bf16_t)f2bf(Bt); imgK[t * 72 + lane] = (bf16_t)f2bf(Kt);
                *(bf16_t*)(rec + R_RL2 + t * RROW + lane * 2) = (bf16_t)f2bf(Rt);
                bgv[t & 3] = bv * e4; kgv[t & 3] = k2 * e4;
                if ((t & 3) == 3) { u32x4 o; o.x = pk2(bgv[0], bgv[1]); o.y = pk2(bgv[2], bgv[3]); o.z = pk2(kgv[0], kgv[1]); o.w = pk2(kgv[2], kgv[3]); *(u32x4*)(rec + R_A2 + (lane * 4 + (t >> 2)) * 16) = o; }
                if (t & 1) vpk[t >> 1] = pk2(vprev, v); else vprev = v; }
            { u32x4 o0, o1; o0.x = vpk[0]; o0.y = vpk[1]; o0.z = vpk[2]; o0.w = vpk[3]; o1.x = vpk[4]; o1.y = vpk[5]; o1.z = vpk[6]; o1.w = vpk[7];
              *(u32x4*)(rec + R_VT + lane * 32) = o0; *(u32x4*)(rec + R_VT + lane * 32 + 16) = o1; }
            asm volatile("" ::: "memory");
            f32x4 gAB = (f32x4){0.f, 0.f, 0.f, 0.f}, gAK = gAB, gBR = gAB, gKR = gAB;
#pragma unroll
            for (int ks = 0; ks < 2; ++ks) { const int off = fr * 72 + 32 * ks + 8 * q;
                const bf16x8 fA = *(const bf16x8*)(imgA + off), fR = *(const bf16x8*)(imgR + off), fB = *(const bf16x8*)(imgB + off), fK = *(const bf16x8*)(imgK + off);
                gAB = __builtin_amdgcn_mfma_f32_16x16x32_bf16(fB, fA, gAB, 0, 0, 0); gAK = __builtin_amdgcn_mfma_f32_16x16x32_bf16(fK, fA, gAK, 0, 0, 0);
                gBR = __builtin_amdgcn_mfma_f32_16x16x32_bf16(fB, fR, gBR, 0, 0, 0); gKR = __builtin_amdgcn_mfma_f32_16x16x32_bf16(fK, fR, gKR, 0, 0, 0); }
#pragma unroll
            for (int r = 0; r < 4; ++r) { const int sI = 4 * q + r; gAB[r] = sI < fr ? gAB[r] : 0.f; gAK[r] = sI < fr ? gAK[r] : 0.f; gBR[r] = sI <= fr ? gBR[r] : 0.f; gKR[r] = sI <= fr ? gKR[r] : 0.f; }
            { u32x4 o; o.x = pk2(gBR[0], gBR[1]); o.y = pk2(gBR[2], gBR[3]); o.z = pk2(gKR[0], gKR[1]); o.w = pk2(gKR[2], gKR[3]); *(u32x4*)(rec + R_A3 + (fr * 4 + q) * 16) = o; }
            asm volatile("" ::: "memory");
            float* AKL = (float*)(WS + 9216);
#pragma unroll
            for (int r = 0; r < 4; ++r) AKL[(4 * q + r) * 16 + fr] = gAK[r];
            float Ft[16];
            { const f32x4* row = (const f32x4*)(AKL + (lane & 15) * 16);
#pragma unroll
              for (int t4 = 0; t4 < 4; ++t4) { const f32x4 v4 = row[t4]; Ft[4 * t4] = v4[0]; Ft[4 * t4 + 1] = v4[1]; Ft[4 * t4 + 2] = v4[2]; Ft[4 * t4 + 3] = v4[3]; } }
#pragma unroll
            for (int s2 = 0; s2 < 15; ++s2) {
                const float gsel = gAB[s2 & 3];
#pragma unroll
                for (int t = s2 + 1; t < 16; ++t) { const float sc = __int_as_float(__builtin_amdgcn_readlane(__float_as_int(gsel), t + 16 * (s2 >> 2))); At[t] += At[s2] * sc; Ft[t] += Ft[s2] * sc; } }
#pragma unroll
            for (int t = 0; t < 16; ++t) *(bf16_t*)(rec + R_EL2 + t * RROW + lane * 2) = (bf16_t)f2bf(At[t]);
            asm volatile("" ::: "memory");
            float* FL = (float*)(WS + 10240);
            if (lane < 16) {
#pragma unroll
                for (int t4 = 0; t4 < 4; ++t4) *(f32x4*)(FL + lane * 16 + 4 * t4) = (f32x4){Ft[4 * t4], Ft[4 * t4 + 1], Ft[4 * t4 + 2], Ft[4 * t4 + 3]}; }
            { const float f0 = FL[(4 * q + 0) * 16 + fr], f1 = FL[(4 * q + 1) * 16 + fr], f2 = FL[(4 * q + 2) * 16 + fr], f3 = FL[(4 * q + 3) * 16 + fr];
              u32x2 o; o.x = pk2(f0, f1); o.y = pk2(f2, f3); *(u32x2*)(rec + R_FT + (fr * 4 + q) * 8) = o; }
            asm volatile("" ::: "memory");
        }
    }
#undef AXF
}
DI bf16x8 mk8(u32x2 lo, u32x2 hi) { u32x4 w; w.x = lo.x; w.y = lo.y; w.z = hi.x; w.w = hi.y; return __builtin_bit_cast(bf16x8, w); }
struct SeqOps { u32x2 e[2][2], r[2][2]; u32x4 a2[4]; u32x4 a3; u32x2 ft, vt; f32x4 gc[4]; };
DI void seq_ops_load(SeqOps& f, const LAS unsigned char* rec, int fr, int q, int i0) {
#pragma unroll
    for (int ks = 0; ks < 2; ++ks) { f.e[ks][0] = *(const LAS u32x2*)(rec + R_EL2 + fr * RROW + (32 * ks + 4 * q) * 2); f.e[ks][1] = *(const LAS u32x2*)(rec + R_EL2 + fr * RROW + (32 * ks + 16 + 4 * q) * 2);
        f.r[ks][0] = *(const LAS u32x2*)(rec + R_RL2 + fr * RROW + (32 * ks + 4 * q) * 2); f.r[ks][1] = *(const LAS u32x2*)(rec + R_RL2 + fr * RROW + (32 * ks + 16 + 4 * q) * 2); }
#pragma unroll
    for (int jt = 0; jt < 4; ++jt) { f.a2[jt] = *(const LAS u32x4*)(rec + R_A2 + ((16 * jt + fr) * 4 + q) * 16); f.gc[jt] = *(const LAS f32x4*)(rec + R_GC + (16 * jt + 4 * q) * 4); }
    f.a3 = *(const LAS u32x4*)(rec + R_A3 + (fr * 4 + q) * 16); f.ft = *(const LAS u32x2*)(rec + R_FT + (fr * 4 + q) * 8); f.vt = *(const LAS u32x2*)(rec + R_VT + ((i0 + fr) * 16 + 4 * q) * 2);
}
DI void rwkv_seq_phase(const Args& a, unsigned char* lds, float* yout, const float* gng, const float* gnb, bf16_t* yfin) {
    const int tidx_ = otid();
    const int tid = tidx_, wave = __builtin_amdgcn_readfirstlane(tid >> 6), lane = tid & 63, fr = lane & 15, q = lane >> 4;
    constexpr int NR = 8, DEPTH_ = 6, NCHK = 256;
    LAS unsigned char* ring = (LAS unsigned char*)lds;
    LAS float* ybuf = (LAS float*)(ring + NR * REC);
    for (int bh = blockIdx.x; bh < NB * 16; bh += gridDim.x) {
        const unsigned char* rec0 = a.ws + OFF_SCR + (size_t)bh * REC;
        const int hd = bh & 15;
        asm volatile("s_waitcnt vmcnt(0) lgkmcnt(0)" ::: "memory"); __builtin_amdgcn_s_barrier();
        if (wave >= 4) {
            const int lw = wave - 4;
            const float gg = yfin ? gng[hd * 64 + lane] : 0.f, gb = yfin ? gnb[hd * 64 + lane] : 0.f;
            bf16_t* Yo = yfin + ((size_t)(bh >> 4) * SEQ) * D + hd * 64 + lane;
#define SEQ_ISSUE(cc) do { const unsigned char* g_ = rec0 + (size_t)(cc) * 64 * REC; LAS unsigned char* l_ = ring + ((cc) & (NR - 1)) * REC; \
            _Pragma("unroll") for (int i_ = 0; i_ < 4; ++i_) { int pc_ = i_ * 4 + lw; if (pc_ >= 15) pc_ = lw; \
                __builtin_amdgcn_global_load_lds((const unsigned*)(g_ + pc_ * 1024 + lane * 16), (LAS unsigned*)(l_ + pc_ * 1024), 16, 0, 0); } } while (0)
#define SEQ_FINALIZE(cf) do { const LAS unsigned char* rc_ = ring + ((cf) & (NR - 1)) * REC; const LAS float* yb_ = ybuf + ((cf) & 1) * 1024; \
            const u32x2 vv_ = *(const LAS u32x2*)(rc_ + R_VT + (lane * 16 + 4 * lw) * 2); \
            float y_[4], rd_[8]; \
            _Pragma("unroll") for (int tt_ = 0; tt_ < 4; ++tt_) { y_[tt_] = yb_[(4 * lw + tt_) * 64 + lane]; rd_[tt_] = y_[tt_]; rd_[4 + tt_] = y_[tt_] * y_[tt_]; } \
            wave_sum8(rd_);        \
            _Pragma("unroll") for (int tt_ = 0; tt_ < 4; ++tt_) { const int t_ = 4 * lw + tt_; \
                const float mean_ = rd_[tt_] * (1.0f / 64.0f); const float var_ = fmaxf(rd_[4 + tt_] * (1.0f / 64.0f) - mean_ * mean_, 0.f); \
                const float yn_ = (y_[tt_] - mean_) * __builtin_amdgcn_rsqf(var_ + 64e-5f) * gg + gb; \
                const float bon_ = *(const LAS float*)(rc_ + R_BON + t_ * 4); const float g_ = bf2f(*(const LAS bf16_t*)(rc_ + R_G + (t_ * 64 + lane) * 2)); \
                const unsigned vw_ = (tt_ & 2) ? vv_.y : vv_.x; const float v_ = (tt_ & 1) ? bfhi(vw_) : bflo(vw_); \
                Yo[(size_t)(16 * (cf) + t_) * D] = (bf16_t)f2bf((yn_ + bon_ * v_) * g_); } } while (0)
#pragma unroll 1
            for (int cc = 0; cc < DEPTH_; ++cc) SEQ_ISSUE(cc);
            asm volatile("s_waitcnt vmcnt(16)" ::: "memory");
            __builtin_amdgcn_s_barrier();
#pragma unroll 1
            for (int c = 0; c < NCHK; ++c) {
                if (yfin && c > 0) SEQ_FINALIZE(c - 1);
                if (c + DEPTH_ < NCHK) { SEQ_ISSUE(c + DEPTH_); asm volatile("s_waitcnt vmcnt(16)" ::: "memory"); }
                else asm volatile("s_waitcnt vmcnt(0)" ::: "memory");
                asm volatile("s_waitcnt lgkmcnt(0)" ::: "memory");
                __builtin_amdgcn_s_barrier();
            }
            if (yfin) SEQ_FINALIZE(NCHK - 1);
#undef SEQ_ISSUE
#undef SEQ_FINALIZE
        } else {
            const int i0 = wave * 16;
            float* Yp = yout + (size_t)(bh >> 4) * SEQ * RW + hd * 64 + i0 + fr;
            f32x4 S[4];
#pragma unroll
            for (int jt = 0; jt < 4; ++jt) S[jt] = (f32x4){0.f, 0.f, 0.f, 0.f};
            __builtin_amdgcn_s_barrier();
            SeqOps cur, nxt; seq_ops_load(cur, ring, fr, q, i0);
#pragma unroll 1
            for (int c = 0; c < NCHK; ++c) {
                if (c + 1 < NCHK) seq_ops_load(nxt, ring + ((c + 1) & (NR - 1)) * REC, fr, q, i0); else nxt = cur;
                bf16x8 sh[2];
#pragma unroll
                for (int ks = 0; ks < 2; ++ks) { u32x4 hw; hw.x = pk2(S[2 * ks][0], S[2 * ks][1]); hw.y = pk2(S[2 * ks][2], S[2 * ks][3]); hw.z = pk2(S[2 * ks + 1][0], S[2 * ks + 1][1]); hw.w = pk2(S[2 * ks + 1][2], S[2 * ks + 1][3]); sh[ks] = __builtin_bit_cast(bf16x8, hw); }
                const u32x2 z2 = {0u, 0u}; const f32x4 zz = (f32x4){0.f, 0.f, 0.f, 0.f};
                f32x4 Wk[2], Yk[2];
#pragma unroll
                for (int ks = 0; ks < 2; ++ks) { Wk[ks] = __builtin_amdgcn_mfma_f32_16x16x32_bf16(mk8(cur.e[ks][0], cur.e[ks][1]), sh[ks], zz, 0, 0, 0); Yk[ks] = __builtin_amdgcn_mfma_f32_16x16x32_bf16(mk8(cur.r[ks][0], cur.r[ks][1]), sh[ks], zz, 0, 0, 0); }
                const f32x4 Wv = __builtin_amdgcn_mfma_f32_16x16x32_bf16(mk8(cur.ft, z2), mk8(cur.vt, z2), zz, 0, 0, 0);
                const f32x4 W = (Wk[0] + Wk[1]) + Wv; f32x4 Y = Yk[0] + Yk[1];
                u32x2 wp; wp.x = pk2(W[0], W[1]); wp.y = pk2(W[2], W[3]);
                const bf16x8 b2 = mk8(wp, cur.vt);
#pragma unroll
                for (int jt = 0; jt < 4; ++jt) S[jt] = __builtin_amdgcn_mfma_f32_16x16x32_bf16(__builtin_bit_cast(bf16x8, cur.a2[jt]), b2, S[jt] * cur.gc[jt], 0, 0, 0);
                Y = __builtin_amdgcn_mfma_f32_16x16x32_bf16(__builtin_bit_cast(bf16x8, cur.a3), b2, Y, 0, 0, 0);
                if (yfin) {
#pragma unroll
                    for (int r = 0; r < 4; ++r) ybuf[(c & 1) * 1024 + (4 * q + r) * 64 + i0 + fr] = Y[r];
                } else {
#pragma unroll
                    for (int r = 0; r < 4; ++r) Yp[(size_t)(16 * c + 4 * q + r) * RW] = Y[r];
                }
                asm volatile("s_waitcnt lgkmcnt(0)" ::: "memory");
                __builtin_amdgcn_s_barrier();
                cur = nxt;
            }
        }
    }
}
DI void rwkv_fin2_phase(const Args& a, int L) {
    const int tidx_ = otid();
    const int wave = __builtin_amdgcn_readfirstlane(tidx_ >> 6), lane = tidx_ & 63;
    const float* Yraw = (const float*)(a.ws + OFF_X); bf16_t* Y = (bf16_t*)(a.ws + OFF_Y);
    const float* gng = a.in[I_GNG] + L * RW; const float* gnb = a.in[I_GNB] + L * RW;
    for (int u = blockIdx.x * 8 + wave; u < NB * 16 * 256; u += gridDim.x * 8) {
        const int cidx = u & 255, bh = u >> 8, h = bh & 15, b_ = bh >> 4; const int c = h * 64 + lane;
        const unsigned char* rec = a.ws + OFF_SCR + (size_t)(cidx * 64 + bh) * REC;
        const u32x4 v0 = *(const u32x4*)(rec + R_VT + lane * 32), v1 = *(const u32x4*)(rec + R_VT + lane * 32 + 16);
        const unsigned vw[8] = {v0.x, v0.y, v0.z, v0.w, v1.x, v1.y, v1.z, v1.w};
        const float gg = gng[c], gb = gnb[c];
#pragma unroll
        for (int t = 0; t < 16; ++t) { const size_t m = (size_t)b_ * SEQ + cidx * 16 + t;
            const float y = Yraw[m * RW + c];
            const float mean = wave_sum(y) * (1.0f / 64.0f); const float d = y - mean; const float var = wave_sum(d * d) * (1.0f / 64.0f);
            const float yn = d * __builtin_amdgcn_rsqf(var + 64e-5f) * gg + gb;
            const float bon = *(const float*)(rec + R_BON + t * 4); const float g = bf2f(*(const bf16_t*)(rec + R_G + (t * 64 + lane) * 2));
            const float v = (t & 1) ? bfhi(vw[t >> 1]) : bflo(vw[t >> 1]);
            Y[m * D + c] = (bf16_t)f2bf((yn + bon * v) * g); }
    }
}
DI void dbg_compare_phase(const Args& a) {
    const int tidx_ = otid();
    const float* y0 = (const float*)(a.ws + OFF_X); const float* y1 = y0 + (size_t)M * RW; float* acc = (float*)(a.ws + OFF_CTL) + 2048;
    float s0 = 0.f, s1 = 0.f, s2 = 0.f, s3 = 0.f;
    for (size_t i = (size_t)blockIdx.x * 512 + tidx_; i < (size_t)M * RW; i += (size_t)gridDim.x * 512) { const float o = y0[i], d = y1[i] - o; const int tok = (int)((i / RW) & (SEQ - 1));
        s0 += d * d; s1 += o * o; if (tok < 16) { s2 += d * d; s3 += o * o; } }
    s0 = wave_sum(s0); s1 = wave_sum(s1); s2 = wave_sum(s2); s3 = wave_sum(s3);
    if ((tidx_ & 63) == 0) { atomicAdd(acc + 0, s0); atomicAdd(acc + 1, s1); atomicAdd(acc + 2, s2); atomicAdd(acc + 3, s3); }
}
DI void dbg_encode_phase(const Args& a) {
    const int tidx_ = otid();
    float* acc = (float*)(a.ws + OFF_CTL) + 2048;
    const float s0 = __hip_atomic_load(acc + 0, __ATOMIC_RELAXED, __HIP_MEMORY_SCOPE_AGENT), s1 = __hip_atomic_load(acc + 1, __ATOMIC_RELAXED, __HIP_MEMORY_SCOPE_AGENT);
    const float s2 = __hip_atomic_load(acc + 2, __ATOMIC_RELAXED, __HIP_MEMORY_SCOPE_AGENT), s3 = __hip_atomic_load(acc + 3, __ATOMIC_RELAXED, __HIP_MEMORY_SCOPE_AGENT);
    const float e1 = sqrtf(s0 / fmaxf(s1, 1e-30f)), e2 = sqrtf(s2 / fmaxf(s3, 1e-30f));
    for (size_t i = (size_t)blockIdx.x * 512 + tidx_; i < (size_t)M * D; i += (size_t)gridDim.x * 512) { float v = a.out[i] * (1.0f + e1); if (i == 0) v += 1000.0f * e2; a.out[i] = v; }
}
DI unsigned f2ord(float f) { const unsigned u = __builtin_bit_cast(unsigned, f); return u ^ ((unsigned)((int)u >> 31) | 0x80000000u); }
DI float xrow16_sum(float x) {
    auto p = __builtin_amdgcn_permlane16_swap(__float_as_uint(x), __float_as_uint(x), false, false);
    x = __uint_as_float(p[0]) + __uint_as_float(p[1]);
    auto q = __builtin_amdgcn_permlane32_swap(__float_as_uint(x), __float_as_uint(x), false, false);
    return __uint_as_float(q[0]) + __uint_as_float(q[1]);
}
template <int CTRL> DI int dpp_i(int x) { return __builtin_amdgcn_update_dpp(0, x, CTRL, 0xF, 0xF, true); }
DI int wave_sum_i(int x) {
    x += dpp_i<0xB1>(x); x += dpp_i<0x4E>(x); x += dpp_i<0x141>(x); x += dpp_i<0x140>(x);
    auto p = __builtin_amdgcn_permlane16_swap((unsigned)x, (unsigned)x, false, false); x = (int)p[0] + (int)p[1];
    auto q = __builtin_amdgcn_permlane32_swap((unsigned)x, (unsigned)x, false, false); return (int)q[0] + (int)q[1];
}
DI void indexer_phase(const Args& a, unsigned char* lds, WorkQ& wq, int& item) {
    const int tidx_ = otid();
    const int tid = tidx_, wave = __builtin_amdgcn_readfirstlane(tid >> 6), lane = tid & 63, hh = lane & 15, kq = lane >> 4;
    const bf16_t* P = (const bf16_t*)(a.ws + OFF_P); const bf16_t* KI = (const bf16_t*)(a.ws + OFF_KI); unsigned long long* BMk = (unsigned long long*)(a.ws + OFF_BM);
    constexpr int STG = 256 * 128;
    unsigned long long* wbuf = (unsigned long long*)(lds + 2 * STG + wave * 512);
    const int srow = tid >> 3, sch = tid & 7;
    const int wr_off = srow * 128 + ((sch ^ (srow & 7)) << 4);
    const int rd0 = hh * 128 + ((kq ^ (hh & 7)) << 4), rd1 = hh * 128 + (((kq + 4) ^ (hh & 7)) << 4);
#pragma unroll 1
    for (; item < NB * 512; item = wq_next(wq, item, lds, tid)) {
        const int b_ = item & 3, qg = 511 - (item >> 2);
        const int t0 = qg * 8, t = t0 + wave, nk = t0 + 8; const size_t m = (size_t)b_ * SEQ + t;
        const int nst = (nk + 255) >> 8;
        bf16x8 aq[2];
        aq[0] = *(const bf16x8*)(P + m * PCOLS + PC_QI + hh * 64 + 8 * kq); aq[1] = *(const bf16x8*)(P + m * PCOLS + PC_QI + hh * 64 + 32 + 8 * kq);
        float blo[4], bhi[4];
#pragma unroll
        for (int r = 0; r < 4; ++r) { const bool pos = bf2f(P[m * PCOLS + PC_WI + 4 * kq + r]) >= 0.f; blo[r] = pos ? 0.f : -__builtin_inff(); bhi[r] = pos ? __builtin_inff() : 0.f; }
        { const float wrow = bf2f(P[m * PCOLS + PC_WI + hh]) * 0.03125f;
#pragma unroll
          for (int ks = 0; ks < 2; ++ks) { const u32x4 w4 = __builtin_bit_cast(u32x4, aq[ks]); u32x4 o4;
              o4.x = pk2(bflo(w4.x) * wrow, bfhi(w4.x) * wrow); o4.y = pk2(bflo(w4.y) * wrow, bfhi(w4.y) * wrow); o4.z = pk2(bflo(w4.z) * wrow, bfhi(w4.z) * wrow); o4.w = pk2(bflo(w4.w) * wrow, bfhi(w4.w) * wrow);
              aq[ks] = __builtin_bit_cast(bf16x8, o4); } }
        unsigned sc[64];
        const bf16_t* kig = KI + ((size_t)b_ * SEQ + srow) * 64 + sch * 8;
#pragma unroll 1
        for (int rep21 = 0; rep21 < ((REP_MASK >> 21) & 1u) + 1; ++rep21) {
#pragma unroll
        for (int r = 0; r < 64; ++r) sc[r] = 0u;
        u32x4 kp[4];
#pragma unroll
        for (int q = 0; q < 4; ++q) kp[q] = *(const u32x4*)(kig + (size_t)q * 64 * 64);
        __syncthreads();
        asm volatile("" :: "v"(aq[0]), "v"(aq[1]), "v"(blo[0]), "v"(blo[1]), "v"(blo[2]), "v"(blo[3]));
#pragma unroll
        for (int st = 0; st < 16; ++st) if (st < nst) {
            const int k0 = st * 256;
            unsigned char* sb = lds + (st & 1) * STG;
#pragma unroll
            for (int q = 0; q < 4; ++q) *(u32x4*)(sb + q * 64 * 128 + wr_off) = kp[q];
            __syncthreads();
            if (st + 1 < nst) {
#pragma unroll
                for (int q = 0; q < 4; ++q) kp[q] = *(const u32x4*)(kig + (size_t)(k0 + 256 + q * 64) * 64);
            }
#pragma unroll
            for (int cc = 0; cc < 4; ++cc) {
                const int kc = k0 + cc * 64;
                unsigned res = 0u;
                {
                    float sv[4];
#pragma unroll
                    for (int sub = 0; sub < 4; ++sub) {
                        const unsigned char* kb = sb + (cc * 64 + sub * 16) * 128;
                        const bf16x8 b0 = *(const bf16x8*)(kb + rd0), b1 = *(const bf16x8*)(kb + rd1);
                        f32x4 acc = (f32x4){0.f, 0.f, 0.f, 0.f};
                        acc = __builtin_amdgcn_mfma_f32_16x16x32_bf16(aq[0], b0, acc, 0, 0, 0);
                        acc = __builtin_amdgcn_mfma_f32_16x16x32_bf16(aq[1], b1, acc, 0, 0, 0);
                        sv[sub] = (__builtin_amdgcn_fmed3f(acc[0], blo[0], bhi[0]) + __builtin_amdgcn_fmed3f(acc[1], blo[1], bhi[1])) + (__builtin_amdgcn_fmed3f(acc[2], blo[2], bhi[2]) + __builtin_amdgcn_fmed3f(acc[3], blo[3], bhi[3]));
                    }
                    auto p01 = __builtin_amdgcn_permlane16_swap(__float_as_uint(sv[0]), __float_as_uint(sv[1]), false, false);
                    auto p23 = __builtin_amdgcn_permlane16_swap(__float_as_uint(sv[2]), __float_as_uint(sv[3]), false, false);
                    const float x01 = __uint_as_float(p01[0]) + __uint_as_float(p01[1]), x23 = __uint_as_float(p23[0]) + __uint_as_float(p23[1]);
                    auto pf = __builtin_amdgcn_permlane32_swap(__float_as_uint(x01), __float_as_uint(x23), false, false);
                    const float tot = __uint_as_float(pf[0]) + __uint_as_float(pf[1]);
                    res = (kc + lane <= t) ? f2ord(tot) : 0u;
                }
                sc[4 * st + cc] = res;
            }
        }
        }
        const int nuse = 4 * nst;
#pragma unroll 1
        for (int rep22 = 0; rep22 < ((REP_MASK >> 22) & 1u) + 1; ++rep22) {
        if (t + 1 > 256) {
            unsigned T = 0u; bool exact = false;
#pragma unroll 1
            for (int bit = 31; bit >= 0; --bit) { const unsigned cand = T | (1u << bit); int cnt = 0; unsigned candv = cand; asm volatile("" : "+v"(candv));
#pragma unroll
                for (int r8 = 0; r8 < 8; ++r8) if (r8 * 8 < nuse) {
                    unsigned long long mk_[8];
                    asm("v_cmp_ge_u32_e64 %0, %8, %16\n\tv_cmp_ge_u32_e64 %1, %9, %16\n\tv_cmp_ge_u32_e64 %2, %10, %16\n\tv_cmp_ge_u32_e64 %3, %11, %16\n\tv_cmp_ge_u32_e64 %4, %12, %16\n\tv_cmp_ge_u32_e64 %5, %13, %16\n\tv_cmp_ge_u32_e64 %6, %14, %16\n\tv_cmp_ge_u32_e64 %7, %15, %16"
                        : "=&s"(mk_[0]), "=&s"(mk_[1]), "=&s"(mk_[2]), "=&s"(mk_[3]), "=&s"(mk_[4]), "=&s"(mk_[5]), "=&s"(mk_[6]), "=&s"(mk_[7])
                        : "v"(sc[r8 * 8 + 0]), "v"(sc[r8 * 8 + 1]), "v"(sc[r8 * 8 + 2]), "v"(sc[r8 * 8 + 3]), "v"(sc[r8 * 8 + 4]), "v"(sc[r8 * 8 + 5]), "v"(sc[r8 * 8 + 6]), "v"(sc[r8 * 8 + 7]), "v"(candv));
#pragma unroll
                    for (int r = 0; r < 8; ++r) cnt += __builtin_popcountll(mk_[r]); }
                if (cnt >= 256) T = cand;
                if (cnt == 256) { exact = true; break; } }
            int cge = 256;
            if (!exact) { cge = 0;
#pragma unroll
                for (int r8 = 0; r8 < 8; ++r8) if (r8 * 8 < nuse) {
#pragma unroll
                    for (int r = 0; r < 8; ++r) cge += __builtin_popcountll(__ballot(sc[r8 * 8 + r] >= T)); } }
            { unsigned long long z64 = 0ull; asm volatile("" : "+v"(z64)); wbuf[lane] = z64; }
            if (cge == 256) {
#pragma unroll
                for (int r8 = 0; r8 < 8; ++r8) {
#pragma unroll
                    for (int r = 0; r < 8; ++r) { const unsigned long long word = __ballot(sc[r8 * 8 + r] >= T); if (lane == 0 && r8 * 8 + r < nuse) wbuf[r8 * 8 + r] = word; }
                    __builtin_amdgcn_sched_barrier(0); }
            } else {
                int cgt = 0;
#pragma unroll
                for (int r8 = 0; r8 < 8; ++r8) {
#pragma unroll
                    for (int r = 0; r < 8; ++r) cgt += __builtin_popcountll(__ballot(sc[r8 * 8 + r] > T));
                    __builtin_amdgcn_sched_barrier(0); }
                int need = 256 - cgt;
#pragma unroll
                for (int r8 = 0; r8 < 8; ++r8) {
#pragma unroll
                    for (int r = 0; r < 8; ++r) { const unsigned long long gt = __ballot(sc[r8 * 8 + r] > T); unsigned long long eq = __ballot(sc[r8 * 8 + r] == T); const int ce = __builtin_popcountll(eq);
                        unsigned long long take;
                        if (ce <= need) { take = eq; need -= ce; }
                        else { take = 0ull; for (; need > 0; --need) { const unsigned long long low = eq & (0ull - eq); take |= low; eq ^= low; } }
                        const unsigned long long word = gt | take; if (lane == 0 && r8 * 8 + r < nuse) wbuf[r8 * 8 + r] = word; }
                    __builtin_amdgcn_sched_barrier(0); }
            }
        } else {
            { unsigned long long z64 = 0ull; asm volatile("" : "+v"(z64)); wbuf[lane] = z64; }
#pragma unroll
            for (int r8 = 0; r8 < 8; ++r8) {
#pragma unroll
                for (int r = 0; r < 8; ++r) { const unsigned long long word = __ballot(sc[r8 * 8 + r] != 0u); if (lane == 0 && r8 * 8 + r < nuse) wbuf[r8 * 8 + r] = word; }
                __builtin_amdgcn_sched_barrier(0); }
        }
        }
        BMk[m * 64 + lane] = wbuf[lane];
    }
}
DI void attn_phase(const Args& a, unsigned char* lds) {
    const int tidx_ = otid();
    const int tid = tidx_, wave = __builtin_amdgcn_readfirstlane(tid >> 6), lane = tid & 63, ql = lane & 31, hf = lane >> 5;
    const bf16_t* P = (const bf16_t*)(a.ws + OFF_P); const bf16_t* VT = (const bf16_t*)(a.ws + OFF_VT); const unsigned long long* BMk = (const unsigned long long*)(a.ws + OFF_BM);
    const float* biasd = (const float*)(a.ws + OFF_BIAS); bf16_t* Y = (bf16_t*)(a.ws + OFF_Y);
    unsigned char* Kl = lds; unsigned char* Vl = lds + 64 * 144; float* biasl = (float*)(lds + 2 * 64 * 144);
    const float NEG_INF = -__builtin_inff();
    for (int cu = blockIdx.x; cu < 256; cu += gridDim.x)
#pragma unroll 1
    for (int ui = 0; ui < 2; ++ui) {
        const int bh = cu >> 3, s8 = cu & 7, qb = ui == 0 ? s8 : 15 - s8, b_ = bh >> 3, h = bh & 7;
        const int q0w = qb * 256 + 32 * wave, q = q0w + ql; const size_t m = (size_t)b_ * SEQ + q;
        __syncthreads();
        if (tid < 128) biasl[tid] = biasd[h * 128 + tid];
        bf16x8 qf[4];
#pragma unroll
        for (int ks = 0; ks < 4; ++ks) qf[ks] = *(const bf16x8*)(P + m * PCOLS + PC_AQ + h * 64 + 16 * ks + 8 * hf);
        f32x16 O0, O1;
#pragma unroll
        for (int r = 0; r < 16; ++r) { O0[r] = 0.f; O1[r] = 0.f; }
        float mrun = NEG_INF, lrun = 0.f;
        const int nkt = 4 * (qb + 1);
        const int srow = tid >> 3, sch = tid & 7;
        const bf16_t* kbase = P + ((size_t)b_ * SEQ + srow) * PCOLS + PC_AK + h * 64 + sch * 8;
        const bf16_t* vbase = VT + ((size_t)(b_ * 8 + h) * 64 + srow) * SEQ + sch * 8;
#define ATT_COMPUTE \
            const int k0 = kt * 64; \
            if (k0 <= q0w + 31) { \
 \
                f32x16 sa[2]; \
_Pragma("unroll") \
                for (int sub = 0; sub < 2; ++sub) { \
_Pragma("unroll") \
                    for (int r = 0; r < 16; ++r) sa[sub][r] = 0.f; } \
_Pragma("unroll") \
                for (int ks = 0; ks < 4; ++ks) \
_Pragma("unroll") \
                    for (int sub = 0; sub < 2; ++sub) { const bf16x8 kf = *(const bf16x8*)(Kl + (32 * sub + ql) * 144 + (16 * ks + 8 * hf) * 2); \
                        sa[sub] = __builtin_amdgcn_mfma_f32_32x32x16_bf16(kf, qf[ks], sa[sub], 0, 0, 0); } \
                constexpr float C1 = 0.125f * 1.4426950408889634f; \
                  \
                const float b31f = biasl[127] * 1.4426950408889634f; \
                const bool far = (q0w - (k0 + 63)) >= 113; \
                float mx = NEG_INF;        \
                if (far) { \
_Pragma("unroll") \
                    for (int sub = 0; sub < 2; ++sub) \
_Pragma("unroll") \
                        for (int r = 0; r < 16; r += 2) mx = fmaxf(mx, fmaxf(sa[sub][r], sa[sub][r + 1])); \
                    mx = mx * C1 + b31f; \
                } else { \
_Pragma("unroll") \
                    for (int sub = 0; sub < 2; ++sub) { \
_Pragma("unroll") \
                        for (int r = 0; r < 16; ++r) { const int ro = (r & 3) + 8 * (r >> 2); int dd = q - (k0 + 32 * sub + ro + 4 * hf); dd = dd < 0 ? 0 : (dd > 127 ? 127 : dd); \
                            sa[sub][r] = sa[sub][r] * C1 + biasl[dd] * 1.4426950408889634f; } \
_Pragma("unroll") \
                        for (int r = 0; r < 16; r += 2) mx = fmaxf(mx, fmaxf(sa[sub][r], sa[sub][r + 1])); \
                    } \
                } \
                { auto pm = __builtin_amdgcn_permlane32_swap(__float_as_uint(mx), __float_as_uint(mx), false, false); mx = fmaxf(__uint_as_float(pm[0]), __uint_as_float(pm[1])); } \
                const float mnew = fmaxf(mrun, mx); const float msafe = mnew; \
                float lsum = 0.f; \
                const float cb = b31f - msafe; \
                if (far) { \
_Pragma("unroll") \
                    for (int sub = 0; sub < 2; ++sub) \
_Pragma("unroll") \
                        for (int r = 0; r < 16; ++r) sa[sub][r] = sa[sub][r] * C1 + cb; \
                } else { \
_Pragma("unroll") \
                    for (int sub = 0; sub < 2; ++sub) \
_Pragma("unroll") \
                        for (int r = 0; r < 16; ++r) sa[sub][r] -= msafe; \
                } \
_Pragma("unroll") \
                for (int sub = 0; sub < 2; ++sub) { \
                    const int w32 = (int)(((unsigned)(bm >> (32 * sub))) >> (4 * hf)); \
_Pragma("unroll") \
                    for (int r = 0; r < 16; ++r) { const int ro = (r & 3) + 8 * (r >> 2); const unsigned tm = (unsigned)__builtin_amdgcn_sbfe(w32, ro, 1); \
                        sa[sub][r] = __uint_as_float(__float_as_uint(__builtin_amdgcn_exp2f(sa[sub][r])) & tm); lsum += sa[sub][r]; } } \
                if (__builtin_amdgcn_ballot_w64(mnew > mrun) != 0ull) { \
                    const float alpha = __builtin_amdgcn_exp2f(mrun - msafe); \
                    lrun = lrun * alpha + lsum; mrun = mnew; \
_Pragma("unroll") \
                    for (int r = 0; r < 16; ++r) { O0[r] *= alpha; O1[r] *= alpha; } \
                } else lrun += lsum; \
_Pragma("unroll") \
                for (int sub = 0; sub < 2; ++sub) \
_Pragma("unroll") \
                    for (int s = 0; s < 2; ++s) { \
                        u32x4 pw; pw.x = pk2(sa[sub][8 * s + 0], sa[sub][8 * s + 1]); pw.y = pk2(sa[sub][8 * s + 2], sa[sub][8 * s + 3]); pw.z = pk2(sa[sub][8 * s + 4], sa[sub][8 * s + 5]); pw.w = pk2(sa[sub][8 * s + 6], sa[sub][8 * s + 7]); \
                        const bf16x8 pf = __builtin_bit_cast(bf16x8, pw); \
                        const int kcol = (32 * sub + 16 * s + 4 * hf) * 2; \
                        { const u32x2 lo = *(const u32x2*)(Vl + ql * 144 + kcol), hi = *(const u32x2*)(Vl + ql * 144 + kcol + 16); \
                          u32x4 vw; vw.x = lo.x; vw.y = lo.y; vw.z = hi.x; vw.w = hi.y; \
                          O0 = __builtin_amdgcn_mfma_f32_32x32x16_bf16(__builtin_bit_cast(bf16x8, vw), pf, O0, 0, 0, 0); } \
                        { const u32x2 lo = *(const u32x2*)(Vl + (32 + ql) * 144 + kcol), hi = *(const u32x2*)(Vl + (32 + ql) * 144 + kcol + 16); \
                          u32x4 vw; vw.x = lo.x; vw.y = lo.y; vw.z = hi.x; vw.w = hi.y; \
                          O1 = __builtin_amdgcn_mfma_f32_32x32x16_bf16(__builtin_bit_cast(bf16x8, vw), pf, O1, 0, 0, 0); } \
                    } \
            } \

        u32x4 kregA = *(const u32x4*)(kbase), vregA = *(const u32x4*)(vbase); unsigned long long bmA = BMk[m * 64];
        u32x4 kregB = *(const u32x4*)(kbase + (size_t)64 * PCOLS), vregB = *(const u32x4*)(vbase + 64); unsigned long long bmB = BMk[m * 64 + 1];
        asm volatile("" :: "v"(qf[0]), "v"(qf[1]), "v"(qf[2]), "v"(qf[3]));
#define ATT_TILE(KREG, VREG, BMR, KT) do { const int kt = (KT); \
            __syncthreads(); \
            *(u32x4*)(Kl + srow * 144 + sch * 16) = KREG; *(u32x4*)(Vl + srow * 144 + sch * 16) = VREG; \
            __syncthreads(); \
            const unsigned long long bm = BMR; \
            if (kt + 2 < nkt) { KREG = *(const u32x4*)(kbase + (size_t)(kt + 2) * 64 * PCOLS); VREG = *(const u32x4*)(vbase + (kt + 2) * 64); BMR = BMk[m * 64 + kt + 2]; } \
            ATT_COMPUTE } while (0)
#pragma unroll 1
        for (int kt2 = 0; kt2 < nkt; kt2 += 2) { ATT_TILE(kregA, vregA, bmA, kt2); ATT_TILE(kregB, vregB, bmB, kt2 + 1); }
#undef ATT_TILE
#undef ATT_COMPUTE
        float ltot; { auto pl = __builtin_amdgcn_permlane32_swap(__float_as_uint(lrun), __float_as_uint(lrun), false, false); ltot = __uint_as_float(pl[0]) + __uint_as_float(pl[1]); } const float inv = 1.0f / ltot;
        bf16_t* yo = Y + m * D + 1536 + h * 64;
#pragma unroll
        for (int g4 = 0; g4 < 4; ++g4) { const int d0 = 8 * g4 + 4 * hf;
            u32x2 o0; o0.x = pk2(O0[4 * g4 + 0] * inv, O0[4 * g4 + 1] * inv); o0.y = pk2(O0[4 * g4 + 2] * inv, O0[4 * g4 + 3] * inv); *(u32x2*)(yo + d0) = o0;
            u32x2 o1; o1.x = pk2(O1[4 * g4 + 0] * inv, O1[4 * g4 + 1] * inv); o1.y = pk2(O1[4 * g4 + 2] * inv, O1[4 * g4 + 3] * inv); *(u32x2*)(yo + 32 + d0) = o1; }
    }
}

constexpr int NPH = 16;
constexpr int NGP = 1 + DEPTH * NPH;
__global__ void __launch_bounds__(512, 2) fwd(Args args) {
    extern __shared__ __attribute__((aligned(16))) unsigned char lds[];
    const int tid = threadIdx.x;
    volatile LAS unsigned* MISC = (volatile LAS unsigned*)((LAS unsigned char*)lds + MISC_OFF);
    for (int u = tid; u < (LDS_BYTES - 131072) / 4; u += 512) ((LAS unsigned*)((LAS unsigned char*)lds + 131072))[u] = 0u;
    __syncthreads();
    unsigned char* ws = args.ws;
    XcdBarrier bar; bar.bar = (unsigned*)(ws + OFF_CTL) + 4096; bar.x = 0; bar.st = nullptr;
    if (!MK_PER_PHASE) bar = xcd_barrier_post((unsigned*)(ws + OFF_CTL) + 4096, MISC + 8);
    const int lo = args.lo, hi = args.hi;
    LAS unsigned char* ldsl = (LAS unsigned char*)lds;
    bf16_t* XB = (bf16_t*)(ws + OFF_XB); float* X = (float*)(ws + OFF_X); float* T = (float*)(ws + OFF_T); float* ST = (float*)(ws + OFF_ST); bf16_t* Pb = (bf16_t*)(ws + OFF_P);
    bf16_t* H = (bf16_t*)(ws + OFF_SCR); bf16_t* Yb = (bf16_t*)(ws + OFF_Y); bf16_t* MG = (bf16_t*)(ws + OFF_MG);
    int gp = 0;
#define RUN() (lo <= gp && gp < hi)
#define SEAM() do { if (RUN() && gp + 1 < hi) xcd_barrier(bar); ++gp; } while (0)
#define PHASE(k, ...) do { if (PHON(k) && RUN()) { __VA_ARGS__; if ((REP_MASK >> (k)) & 1u) { xcd_barrier(bar); __VA_ARGS__; } } SEAM(); } while (0)
    if (RUN()) init_phase(args);
    SEAM();
    int p7n = 0;
#pragma unroll 1
    for (int L = 0; L < DEPTH; ++L) {
        const size_t walt = (L & 1) ? ALT_SHIFT : 0;
        if (L == 0 || !HETERO) PHASE(0, convert_phase(args, L, lds, blockIdx.x, gridDim.x);); else ++gp;
        PHASE(1, { pg8::Gemm g{XB, (const bf16_t*)(ws + OFF_W1A), D, D}; pg8::StaticOrder S; S.init(M, 2 * FF, D, gridDim.x, blockIdx.x); pg8::EpiSwiglu E{H, FF}; pg8::gemm_phase(ldsl, g, S, E); });
        PHASE(2, { pg8::Gemm g{H, (const bf16_t*)(ws + OFF_W1B), FF, FF}; pg8::StaticOrder S; S.init(M, D, FF, gridDim.x, blockIdx.x); pg8::EpiRes E{args.in[I_X], L == 0 ? nullptr : ST, args.in[I_LN3G] + (L > 0 ? (L - 1) * D : 0), args.in[I_LN3B] + (L > 0 ? (L - 1) * D : 0), T, D, ALPHA, 0.5f}; pg8::gemm_phase(ldsl, g, S, E); });
        PHASE(3, ln_phase(T, args.in[I_LN1G] + L * D, args.in[I_LN1B] + L * D, ST, XB, nullptr););
        PHASE(4, { pg8::Gemm g{XB, (const bf16_t*)(ws + OFF_WIN), D, D}; pg8::StaticOrder S; S.init(M, NP, D, gridDim.x, blockIdx.x); pg8::EpiBf16 E{Pb, PCOLS, (bf16_t*)(ws + OFF_GATES)}; pg8::gemm_phase(ldsl, g, S, E); });
        PHASE(5, { kidx_vt_phase(args, L, lds); if (REP_MASK & (1u << 23)) kidx_vt_phase(args, L, lds); if (RWKV_CHUNKED && !DBG_RWKV) { rwkv_par_phase(args, L, lds); if (REP_MASK & (1u << 24)) rwkv_par_phase(args, L, lds); } else rwkv_prep_phase(args, L, lds); });
        if (!HETERO) PHASE(6, { WorkQ wq{nullptr, 0, 0, (int)gridDim.x}; int item = blockIdx.x; sgu_phase(args, L, lds, wq, item, 0); }); else ++gp;
        PHASE(7, { if (DBG_RWKV) { scan_phase(args, lds); xcd_barrier(bar); rwkv_par_phase(args, L, lds); xcd_barrier(bar); rwkv_seq_phase(args, lds, X + (size_t)M * RW, nullptr, nullptr, nullptr); xcd_barrier(bar); dbg_compare_phase(args); }
                   else if (HETERO) {
                       if ((int)blockIdx.x < 64) { rwkv_seq_phase(args, lds, X, args.in[I_GNG] + L * RW, args.in[I_GNB] + L * RW, Yb); if (REP_MASK & (1u << 20)) rwkv_seq_phase(args, lds, X, args.in[I_GNG] + L * RW, args.in[I_GNB] + L * RW, Yb); }
                       else if ((int)blockIdx.x < 64 + NCVT && L + 1 < DEPTH) { convert_phase(args, L + 1, lds, blockIdx.x - 64, NCVT); __syncthreads(); }
                       WorkQ wq{(unsigned*)(ws + OFF_CTL + 524288) + (p7n++) * 64, 0, 0, 0}; int item = wq_first(wq, lds, otid());
                       indexer_phase(args, lds, wq, item); sgu_phase(args, L, lds, wq, item, NB * 512); }
                   else if (RWKV_CHUNKED) rwkv_seq_phase(args, lds, X, nullptr, nullptr, nullptr); else scan_phase(args, lds); });
        if (!HETERO) PHASE(8, { WorkQ wq{nullptr, 0, 0, (int)gridDim.x}; int item = blockIdx.x; indexer_phase(args, lds, wq, item); if (RWKV_CHUNKED) rwkv_fin2_phase(args, L); else rwkv_fin_phase(args, L); }); else ++gp;
        PHASE(9, { attn_phase(args, lds); });
        PHASE(10, { pg8::Gemm g{Yb, (const bf16_t*)(ws + OFF_WBR + walt), D, D}; pg8::BranchOrder S; S.init(M, D, D, gridDim.x, blockIdx.x); pg8::EpiBranch E{(const bf16_t*)(ws + OFF_GATES), args.in[I_BGATE] + (size_t)L * 3 * D, MG}; pg8::gemm_phase(ldsl, g, S, E); });
        PHASE(11, { pg8::Gemm g{MG, (const bf16_t*)(ws + OFF_WO + walt), D, D}; pg8::StaticOrder S; S.init(M, D, D, gridDim.x, blockIdx.x); pg8::EpiRes E{nullptr, ST, args.in[I_LN1G] + L * D, args.in[I_LN1B] + L * D, T, D, ALPHA, 1.0f}; pg8::gemm_phase(ldsl, g, S, E); });
        PHASE(12, ln_phase(T, args.in[I_LN2G] + L * D, args.in[I_LN2B] + L * D, ST, XB, nullptr););
        PHASE(13, { pg8::Gemm g{XB, (const bf16_t*)(ws + OFF_W2A + walt), D, D}; pg8::StaticOrder S; S.init(M, 2 * FF, D, gridDim.x, blockIdx.x); pg8::EpiSwiglu E{H, FF}; pg8::gemm_phase(ldsl, g, S, E); });
        PHASE(14, { pg8::Gemm g{H, (const bf16_t*)(ws + OFF_W2B + walt), FF, FF}; pg8::StaticOrder S; S.init(M, D, FF, gridDim.x, blockIdx.x); pg8::EpiRes E{nullptr, ST, args.in[I_LN2G] + L * D, args.in[I_LN2B] + L * D, T, D, ALPHA, 0.5f}; pg8::gemm_phase(ldsl, g, S, E); });
        PHASE(15, ln_phase(T, args.in[I_LN3G] + L * D, args.in[I_LN3B] + L * D, ST, XB, L == DEPTH - 1 ? args.out : nullptr););
        if (REP_MASK & (1u << 25)) { for (int xb = 0; xb < 10; ++xb) xcd_barrier(bar); }
    }
    if (DBG_RWKV) { xcd_barrier(bar); dbg_encode_phase(args); }
#undef RUN
#undef SEAM
#undef PHASE
}

extern "C" void kernel_launch(void* const* d_in, const int* in_sizes, int n_in, void* d_out, int out_size, void* d_ws, size_t ws_size, hipStream_t stream) {
    static int grid = 0;
    if (grid == 0) {
        if (n_in != 33 || out_size != M * D || ws_size < WS_END) { fprintf(stderr, "kernel_launch: unexpected shapes (n_in %d out %d ws %zu, need %zu)\n", n_in, out_size, ws_size, (size_t)WS_END); grid = -1; return; }
        int dev = 0, cus = 0;
        if (hipGetDevice(&dev) != hipSuccess || hipDeviceGetAttribute(&cus, hipDeviceAttributeMultiprocessorCount, dev) != hipSuccess) { grid = -1; return; }
        if (hipFuncSetAttribute((const void*)fwd, hipFuncAttributeMaxDynamicSharedMemorySize, LDS_BYTES) != hipSuccess) { fprintf(stderr, "kernel_launch: hipFuncSetAttribute failed\n"); grid = -1; return; }
        int per_cu = 0; (void)hipOccupancyMaxActiveBlocksPerMultiprocessor(&per_cu, (const void*)fwd, 512, LDS_BYTES); (void)hipGetLastError();
        grid = cus;
    }
    if (grid < 0) return;
    (void)hipMemsetAsync((char*)d_ws + OFF_CTL, 0, CTL_BYTES, stream);
    Args a{};
    for (int i = 0; i < 33; ++i) a.in[i] = (const float*)d_in[i];
    a.out = (float*)d_out; a.ws = (unsigned char*)d_ws;
#if MK_PER_PHASE
    for (int p = 0; p < NGP; ++p) { a.lo = p; a.hi = p + 1; hipLaunchKernelGGL(fwd, dim3(grid), dim3(512), LDS_BYTES, stream, a); }
#else
    a.lo = 0; a.hi = NGP;
    hipLaunchKernelGGL(fwd, dim3(grid), dim3(512), LDS_BYTES, stream, a);
#endif
}
```

```cpp
#include <hip/hip_runtime.h>
#include <cstdio>
#include <cstdint>

#ifndef MK_PER_PHASE
#define MK_PER_PHASE 0
#endif
#ifndef PH_MASK
#define PH_MASK 0xFFFFFFFFu
#endif
#define PHON(k) (((PH_MASK) >> (k)) & 1u)
#ifndef RWKV_CHUNKED
#define RWKV_CHUNKED 1
#endif
#ifndef DBG_RWKV
#define DBG_RWKV 0
#endif
#ifndef DBG_LORA
#define DBG_LORA 0
#endif
#ifndef HETERO
#define HETERO 1
#endif
#ifndef SEQ_HILO
#define SEQ_HILO 0
#endif
#ifndef SGU_SPLIT
#define SGU_SPLIT 256
#endif
#ifndef REP_MASK
#define REP_MASK 0u
#endif

#define LAS __attribute__((address_space(3)))
#define DI __device__ __forceinline__
typedef unsigned short bf16_t;
typedef short bf16x8 __attribute__((ext_vector_type(8)));
typedef float f32x4 __attribute__((ext_vector_type(4)));
typedef float f32x2 __attribute__((ext_vector_type(2)));
typedef float f32x16 __attribute__((ext_vector_type(16)));
typedef unsigned u32x4 __attribute__((ext_vector_type(4)));
typedef unsigned u32x2 __attribute__((ext_vector_type(2)));
typedef __bf16 bf16x2_t __attribute__((ext_vector_type(2)));

constexpr int NB = 4, SEQ = 4096, M = NB * SEQ, D = 2048, FF = 5632, DEPTH = 4;
constexpr int RW = 1024;
constexpr int NP = 13312;
constexpr int PCOLS = 7168;
constexpr int DIN = 13168;
constexpr int GN_GATE = 6656, GN_LORA = 12800, GN_KI = 13088, GN_WI = 13152;
constexpr int PC_R = 0, PC_K = 1024, PC_V = 2048, PC_SGU = 3072, PC_SGV = 3584, PC_AQ = 4096, PC_AK = 4608, PC_AV = 5120, PC_QI = 5632, PC_LORA = 6656, PC_KI = 6944, PC_WI = 7008;
constexpr float ALPHA = 1.6817928305074290f;
constexpr float LN_EPS = 1e-5f;

constexpr size_t MiB = 1u << 20;
constexpr size_t OFF_CTL = 0, CTL_BYTES = 1 * MiB;
constexpr size_t OFF_BIAS = 1 * MiB;
constexpr size_t OFF_ST = OFF_BIAS + 786432;
constexpr size_t OFF_LW2 = OFF_BIAS + 65536, OFF_LA2 = OFF_LW2 + 131072, OFF_LG2 = OFF_LA2 + 131072;
constexpr int REC = 15360, RROW = 144, R_EL2 = 0, R_RL2 = 2304, R_A2 = 4608, R_A3 = 8704, R_FT = 9728, R_VT = 10240, R_GC = 12288, R_G = 12544, R_BON = 14592;
constexpr size_t OFF_W1A = 2 * MiB;
constexpr size_t OFF_W1B = OFF_W1A + 44 * MiB;
constexpr size_t OFF_WIN = OFF_W1B + 22 * MiB;
constexpr size_t OFF_WBR = OFF_WIN + 52 * MiB;
constexpr size_t OFF_WO  = OFF_WBR + 8 * MiB;
constexpr size_t OFF_W2A = OFF_WO + 8 * MiB;
constexpr size_t OFF_W2B = OFF_W2A + 44 * MiB;
constexpr size_t OFF_X   = OFF_W2B + 22 * MiB;
constexpr size_t OFF_T   = OFF_X + 128 * MiB;
constexpr size_t OFF_XB  = OFF_T + 128 * MiB;
constexpr size_t OFF_P   = OFF_XB + 64 * MiB;
constexpr size_t OFF_GATES = OFF_P + 224 * MiB;
constexpr size_t OFF_SCR = OFF_GATES + 192 * MiB;
constexpr size_t OFF_Y   = OFF_SCR + 416 * MiB;
constexpr size_t OFF_MG  = OFF_Y + 64 * MiB;
constexpr size_t OFF_BM  = OFF_MG + 64 * MiB;
constexpr size_t OFF_KI  = OFF_BM + 8 * MiB;
constexpr size_t OFF_VT  = OFF_KI + 2 * MiB;
constexpr size_t OFF_ALT = OFF_VT + 16 * MiB;
constexpr size_t ALT_SHIFT = OFF_ALT - OFF_WBR;
constexpr size_t WS_END  = OFF_ALT + 82 * MiB;
constexpr int NCVT = 64;

constexpr int LDS_BYTES = 147456;
constexpr int MISC_OFF = 131072 + 320;

DI unsigned f2bf(float f);
DI float bf2f(unsigned short b) { return __builtin_bit_cast(float, ((unsigned)b) << 16); }
DI unsigned pk2(float lo, float hi) { f32x2 v = {lo, hi}; bf16x2_t b = __builtin_convertvector(v, bf16x2_t); return __builtin_bit_cast(unsigned, b); }
DI unsigned f2bf(float f) { return pk2(f, f) & 0xffffu; }
DI float bflo(unsigned w) { return __builtin_bit_cast(float, w << 16); }
DI float bfhi(unsigned w) { return __builtin_bit_cast(float, w & 0xffff0000u); }
template <int CTRL> DI float dpp_f(float x) { return __builtin_bit_cast(float, __builtin_amdgcn_update_dpp(0, __builtin_bit_cast(int, x), CTRL, 0xF, 0xF, true)); }
DI float row16_sum(float x) {
    x += dpp_f<0xB1>(x);
    x += dpp_f<0x4E>(x);
    x += dpp_f<0x141>(x);
    x += dpp_f<0x140>(x);
    return x;
}
DI int otid() { int t = threadIdx.x; asm volatile("" : "+v"(t)); return t; }
DI int obid() { int t = blockIdx.x; asm volatile("" : "+s"(t)); return t; }
DI float wave_sum(float x) {
    x = row16_sum(x);
    auto p = __builtin_amdgcn_permlane16_swap(__float_as_uint(x), __float_as_uint(x), false, false);
    x = __uint_as_float(p[0]) + __uint_as_float(p[1]);
    auto q = __builtin_amdgcn_permlane32_swap(__float_as_uint(x), __float_as_uint(x), false, false);
    return __uint_as_float(q[0]) + __uint_as_float(q[1]);
}
DI void wave_sum8(float (&x)[8]) {
#pragma unroll
    for (int i = 0; i < 8; ++i) x[i] += dpp_f<0xB1>(x[i]);
#pragma unroll
    for (int i = 0; i < 8; ++i) x[i] += dpp_f<0x4E>(x[i]);
#pragma unroll
    for (int i = 0; i < 8; ++i) x[i] += dpp_f<0x141>(x[i]);
#pragma unroll
    for (int i = 0; i < 8; ++i) x[i] += dpp_f<0x140>(x[i]);
#pragma unroll
    for (int i = 0; i < 8; ++i) { auto p = __builtin_amdgcn_permlane16_swap(__float_as_uint(x[i]), __float_as_uint(x[i]), false, false); x[i] = __uint_as_float(p[0]) + __uint_as_float(p[1]); }
#pragma unroll
    for (int i = 0; i < 8; ++i) { auto p = __builtin_amdgcn_permlane32_swap(__float_as_uint(x[i]), __float_as_uint(x[i]), false, false); x[i] = __uint_as_float(p[0]) + __uint_as_float(p[1]); }
}
DI float rs16(float (&x)[16], int lane) {
    float z[8], w[4];
#pragma unroll
    for (int i = 0; i < 8; ++i) { auto p = __builtin_amdgcn_permlane32_swap(__float_as_uint(x[i]), __float_as_uint(x[i + 8]), false, false); z[i] = __uint_as_float(p[0]) + __uint_as_float(p[1]); }
#pragma unroll
    for (int i = 0; i < 4; ++i) { auto p = __builtin_amdgcn_permlane16_swap(__float_as_uint(z[i]), __float_as_uint(z[i + 4]), false, false); w[i] = __uint_as_float(p[0]) + __uint_as_float(p[1]); }
    const bool b0 = (lane & 1) != 0, b1 = (lane & 2) != 0;
    const float u0 = (b0 ? w[1] : w[0]) + dpp_f<0xB1>(b0 ? w[0] : w[1]);
    const float u1 = (b0 ? w[3] : w[2]) + dpp_f<0xB1>(b0 ? w[2] : w[3]);
    float v = (b1 ? u1 : u0) + dpp_f<0x4E>(b1 ? u0 : u1);
    v += dpp_f<0x124>(v);
    v += dpp_f<0x128>(v);
    return v;
}
DI float sigmoidf_(float x) { return __builtin_amdgcn_rcpf(1.0f + __expf(-x)); }
DI float gelu_erf(float x) {
    const float y = fabsf(x) * 0.70710678118654752f;
    const float t = __builtin_amdgcn_rcpf(__builtin_fmaf(0.3275911f, y, 1.0f));
    const float e = __builtin_amdgcn_exp2f(-1.4426950408889634f * y * y);
    float p = __builtin_fmaf(1.061405429f, t, -1.453152027f); p = __builtin_fmaf(p, t, 1.421413741f); p = __builtin_fmaf(p, t, -0.284496736f); p = __builtin_fmaf(p, t, 0.254829592f);
    const float ec = p * t * e;
    return 0.5f * x * (x < 0.f ? ec : 2.0f - ec);
}

namespace pg8 {
constexpr int BM = 256, BK = 64, HALF = 128, HTB = HALF * BK * 2, STAGE_BYTES = 8 * HTB, NXCD = 8, WGM = 8;
__host__ __device__ __forceinline__ int lds_byte(int r, int c) { const int st = (r >> 4) * 2 + (c >> 5), rr = r & 15, cc = c & 31, ob = rr * 64 + cc * 2; return st * 1024 + (ob ^ (((ob >> 9) & 1) << 5)); }
__host__ __device__ __forceinline__ void stage_rc(int b, int& R, int& C) { const int st = b / 1024, sb = b % 1024, swz = sb ^ (((sb >> 9) & 1) << 5); R = (st >> 1) * 16 + swz / 64; C = (st & 1) * 32 + (swz % 64) / 2; }
__host__ __device__ __forceinline__ int perm32(int rho) { const int n = rho >> 4, i = rho & 15; return 8 * (i >> 2) + 4 * n + (i & 3); }

struct Unit { int pm, pn, koff, nt, tag; };
struct Gemm { const bf16_t* A; const bf16_t* Bt; int lda, ldb; };

struct StaticOrder {
    int nM, nN, nwg, G, c, nt;
    __device__ void init(int M_, int N_, int K_, int G_, int c_) { nM = M_ / BM; nN = N_ / BM; nwg = nM * nN; G = G_; c = c_; nt = K_ / BK; }
    __device__ bool tile(int L, Unit& u) const {
        if (L >= nwg) return false;
        int wgid = L; { const int q = nwg / NXCD, r = nwg % NXCD, xcd = wgid % NXCD, off = wgid / NXCD; wgid = (xcd < r ? xcd * (q + 1) : r * (q + 1) + (xcd - r) * q) + off; }
        const int nig = WGM * nN, gid = wgid / nig, fm = gid * WGM, gsz = (nM - fm) < WGM ? (nM - fm) : WGM;
        u.pm = fm + ((wgid % nig) % gsz); u.pn = (wgid % nig) / gsz; return true;
    }
    __device__ bool next(int i, Unit& u) const { u.koff = 0; u.nt = nt; u.tag = 0; return tile(i * G + c, u); }
};
struct BranchOrder : StaticOrder {
    __device__ bool next(int i, Unit& u) const {
        const int ti = i / 3, br = i - 3 * ti;
        u.tag = br; u.koff = br == 0 ? 0 : (br == 1 ? 1024 : 1536); u.nt = br == 0 ? 16 : 8;
        return tile(ti * G + c, u);
    }
};

template <class Epi, class Sched>
__device__ __forceinline__ void gemm_phase(LAS unsigned char* lds, const Gemm g, const Sched& S, const Epi& E) {
    const int tid = otid(), wid = __builtin_amdgcn_readfirstlane(tid >> 6), lane = tid & 63, wr = wid >> 2, wc = wid & 3, fr = lane & 15, fq = lane >> 4;
    unsigned voffA[2], voffB[2];
#pragma unroll
    for (int i = 0; i < 2; ++i) { int R, C; stage_rc(tid * 16 + i * 8192, R, C); const int Rb = Epi::PERM ? ((R & ~31) + perm32(R & 31)) : R;
        voffA[i] = (unsigned)(R * g.lda + C) * 2u; voffB[i] = (unsigned)(Rb * g.ldb + C) * 2u; }
    const size_t kstep = (size_t)(BK * 2);
    const size_t hstepA = (size_t)HALF * g.lda * 2, hstepB = (size_t)HALF * g.ldb * 2;
    const size_t tstepA = 2 * hstepA, tstepB = 2 * hstepB;
    const unsigned ldsw = (unsigned)wid * 1024u;
    const int aoff = lds_byte(wr * 64 + fr, fq * 8), boff = lds_byte(wc * 32 + fr, fq * 8);
#define PG8_SA(b, h) (((b) * 2 + (h)) * HTB)
#define PG8_SB(b, h) ((4 + (b) * 2 + (h)) * HTB)
#define PG8_STAGE(bufoff, gbase, voff) do { _Pragma("unroll") for (int _i = 0; _i < 2; ++_i) \
        __builtin_amdgcn_global_load_lds((const unsigned*)((const char*)(gbase) + (voff)[_i]), (LAS unsigned*)(lds + (bufoff) + ldsw + _i * 8192), 16, 0, 0); } while (0)
#define PG8_LDA(dst, b, h) do { _Pragma("unroll") for (int m = 0; m < 4; ++m) _Pragma("unroll") for (int k = 0; k < 2; ++k) dst[m][k] = *(const LAS bf16x8*)(lds + PG8_SA(b, h) + aoff + m * 2048 + k * 1024); } while (0)
#define PG8_LDB(dst, b, h) do { _Pragma("unroll") for (int n = 0; n < 2; ++n) _Pragma("unroll") for (int k = 0; k < 2; ++k) dst[n][k] = *(const LAS bf16x8*)(lds + PG8_SB(b, h) + boff + n * 2048 + k * 1024); } while (0)
#define PG8_MMA(ai, bj, At, Bt) do { __builtin_amdgcn_s_setprio(1); _Pragma("unroll") for (int m = 0; m < 4; ++m) _Pragma("unroll") for (int n = 0; n < 2; ++n) _Pragma("unroll") for (int k = 0; k < 2; ++k) \
        acc[ai][bj][m][n] = __builtin_amdgcn_mfma_f32_16x16x32_bf16(Bt[n][k], At[m][k], acc[ai][bj][m][n], 0, 0, 0); __builtin_amdgcn_s_setprio(0); } while (0)
#define PG8_WAIT_V(n) asm volatile("s_waitcnt vmcnt(" #n ")" ::: "memory")
#define PG8_WAIT_L(n) asm volatile("s_waitcnt lgkmcnt(" #n ")" ::: "memory")
#define PG8_BAR __builtin_amdgcn_s_barrier()
#define PG8_SCHED __builtin_amdgcn_sched_barrier(0)
    Unit cur, nxt; int ui = 0;
    if (!S.next(0, cur)) return;
    f32x4 acc[2][2][4][2];
#pragma unroll
    for (int a = 0; a < 2; ++a)
#pragma unroll
        for (int b = 0; b < 2; ++b)
#pragma unroll
            for (int m = 0; m < 4; ++m)
#pragma unroll
                for (int n = 0; n < 2; ++n) acc[a][b][m][n] = (f32x4){0.f, 0.f, 0.f, 0.f};
    bf16x8 At[4][2], B0[2][2], B1[2][2];
    const char* cA = (const char*)g.A + (size_t)cur.pm * tstepA + (size_t)cur.koff * 2; const char* cB = (const char*)g.Bt + (size_t)cur.pn * tstepB + (size_t)cur.koff * 2;
    PG8_STAGE(PG8_SB(0, 0), cB, voffB); PG8_STAGE(PG8_SB(0, 1), cB + hstepB, voffB); PG8_STAGE(PG8_SA(0, 0), cA, voffA); PG8_STAGE(PG8_SA(0, 1), cA + hstepA, voffA);
    if (wr == 1) PG8_BAR;
    PG8_WAIT_V(2); PG8_BAR;
    PG8_STAGE(PG8_SB(1, 0), cB + kstep, voffB); PG8_STAGE(PG8_SA(1, 0), cA + kstep, voffA); PG8_STAGE(PG8_SB(1, 1), cB + hstepB + kstep, voffB);
    PG8_WAIT_V(6); PG8_BAR;
    for (;;) {
        const bool has_next = S.next(ui + 1, nxt);
        const char* nA = has_next ? (const char*)g.A + (size_t)nxt.pm * tstepA + (size_t)nxt.koff * 2 : cA; const char* nB = has_next ? (const char*)g.Bt + (size_t)nxt.pn * tstepB + (size_t)nxt.koff * 2 : cB;
        const int nt = cur.nt;
        for (int t = 0; t < nt; t += 2) {
            const bool last = (t == nt - 2);
            const char* a1 = cA + (size_t)(t + 1) * kstep;
            const char* a2 = last ? nA : cA + (size_t)(t + 2) * kstep; const char* b2 = last ? nB : cB + (size_t)(t + 2) * kstep;
            const char* a3 = a2 + kstep; const char* b3 = b2 + kstep;
            PG8_LDB(B0, 0, 0); PG8_LDB(B1, 0, 1); PG8_SCHED; PG8_LDA(At, 0, 0); PG8_STAGE(PG8_SA(1, 1), a1 + hstepA, voffA);
            PG8_WAIT_V(8); PG8_WAIT_L(0); PG8_BAR; PG8_MMA(0, 0, At, B0); PG8_MMA(0, 1, At, B1); PG8_BAR; PG8_SCHED;
            PG8_LDA(At, 0, 1); PG8_STAGE(PG8_SB(0, 0), b2, voffB); PG8_STAGE(PG8_SB(0, 1), b2 + hstepB, voffB); PG8_STAGE(PG8_SA(0, 0), a2, voffA);
            PG8_WAIT_V(8); PG8_WAIT_L(0); PG8_BAR; PG8_MMA(1, 0, At, B0); PG8_MMA(1, 1, At, B1); PG8_BAR; PG8_SCHED;
            PG8_LDB(B0, 1, 0); PG8_LDB(B1, 1, 1); PG8_SCHED; PG8_LDA(At, 1, 0); PG8_STAGE(PG8_SA(0, 1), a2 + hstepA, voffA);
            PG8_WAIT_V(8); PG8_WAIT_L(0); PG8_BAR; PG8_MMA(0, 0, At, B0); PG8_MMA(0, 1, At, B1); PG8_BAR; PG8_SCHED;
            PG8_LDA(At, 1, 1); PG8_STAGE(PG8_SB(1, 0), b3, voffB); PG8_STAGE(PG8_SB(1, 1), b3 + hstepB, voffB); PG8_STAGE(PG8_SA(1, 0), a3, voffA);
            PG8_WAIT_V(8); PG8_WAIT_L(0); PG8_BAR; PG8_MMA(1, 0, At, B0); PG8_MMA(1, 1, At, B1); PG8_BAR; PG8_SCHED;
        }
        if (wr == 0) PG8_BAR;
        E(acc, cur, wr, wc, fr, fq);
        if (!has_next) break;
        if (!(Epi::KEEPS && cur.tag != 2))
#pragma unroll
        for (int a = 0; a < 2; ++a)
#pragma unroll
            for (int b = 0; b < 2; ++b)
#pragma unroll
                for (int m = 0; m < 4; ++m)
#pragma unroll
                    for (int n = 0; n < 2; ++n) acc[a][b][m][n] = (f32x4){0.f, 0.f, 0.f, 0.f};
        cur = nxt; cA = nA; cB = nB; ++ui;
        if (wr == 1) PG8_BAR;
    }
    PG8_WAIT_V(0);
    PG8_BAR;
#undef PG8_SA
#undef PG8_SB
#undef PG8_STAGE
#undef PG8_LDA
#undef PG8_LDB
#undef PG8_MMA
#undef PG8_WAIT_V
#undef PG8_WAIT_L
#undef PG8_BAR
#undef PG8_SCHED
}

struct EpiSwiglu {
    static constexpr bool PERM = true, KEEPS = false;
    bf16_t* O; int ldc;
    __device__ __forceinline__ void operator()(const f32x4 (&acc)[2][2][4][2], const Unit& u, int wr, int wc, int fr, int fq) const {
        const int row0 = u.pm * BM + wr * 64 + fr, col0 = u.pn * HALF + wc * 32 + 8 * fq;
#pragma unroll
        for (int ai = 0; ai < 2; ++ai)
#pragma unroll
            for (int m = 0; m < 4; ++m) {
                float hv[8];
#pragma unroll
                for (int n = 0; n < 2; ++n)
#pragma unroll
                    for (int j = 0; j < 4; ++j) { const float gv = acc[ai][0][m][n][j], uv = acc[ai][1][m][n][j]; hv[4 * n + j] = gv * __builtin_amdgcn_rcpf(1.0f + __expf(-gv)) * uv; }
                u32x4 w; w.x = pk2(hv[0], hv[1]); w.y = pk2(hv[2], hv[3]); w.z = pk2(hv[4], hv[5]); w.w = pk2(hv[6], hv[7]);
                *(u32x4*)(O + (size_t)(row0 + ai * HALF + m * 16) * ldc + col0) = w;
            }
    }
};
struct EpiRes {
    static constexpr bool PERM = false, KEEPS = false;
    const float* Xraw; const float* st; const float* g; const float* b; float* T; int ldc; float alpha, s;
    __device__ __forceinline__ void operator()(const f32x4 (&acc)[2][2][4][2], const Unit& u, int wr, int wc, int fr, int fq) const {
        const int row0 = u.pm * BM + wr * 64 + fr, col0 = u.pn * BM + wc * 32 + 4 * fq;
        f32x4 gv[2][2], bv[2][2];
        if (st) {
#pragma unroll
            for (int bj = 0; bj < 2; ++bj)
#pragma unroll
                for (int n = 0; n < 2; ++n) { gv[bj][n] = *(const f32x4*)(g + col0 + bj * HALF + n * 16); bv[bj][n] = *(const f32x4*)(b + col0 + bj * HALF + n * 16); } }
        const float* src = st ? T : Xraw;
#pragma unroll
        for (int ai = 0; ai < 2; ++ai)
#pragma unroll
            for (int m2 = 0; m2 < 2; ++m2) {
                f32x4 tv[2][2][2]; f32x2 ms[2];
#pragma unroll
                for (int mm = 0; mm < 2; ++mm) { const int row = row0 + ai * HALF + (2 * m2 + mm) * 16; const size_t off = (size_t)row * ldc + col0;
                    ms[mm] = (f32x2){0.f, 1.f}; if (st) ms[mm] = *(const f32x2*)(st + 2 * (size_t)row);
#pragma unroll
                    for (int bj = 0; bj < 2; ++bj)
#pragma unroll
                        for (int n = 0; n < 2; ++n) tv[mm][bj][n] = *(const f32x4*)(src + off + bj * HALF + n * 16); }
                asm volatile("" ::: "memory");
#pragma unroll
                for (int mm = 0; mm < 2; ++mm) { const int m = 2 * m2 + mm; const size_t off = (size_t)(row0 + ai * HALF + m * 16) * ldc + col0;
#pragma unroll
                    for (int bj = 0; bj < 2; ++bj)
#pragma unroll
                        for (int n = 0; n < 2; ++n) { f32x4 xv = tv[mm][bj][n]; if (st) xv = (xv - ms[mm][0]) * ms[mm][1] * gv[bj][n] + bv[bj][n];
                            *(f32x4*)(T + off + bj * HALF + n * 16) = xv * alpha + acc[ai][bj][m][n] * s; } }
            }
    }
};
__device__ __forceinline__ int frag_off(int wr, int wc, int fr, int fq, int ai, int m, int bj) { return (((((wr * 4 + wc) * 2 + ai) * 4 + m) * 2 + bj) * 64 + fq * 16 + fr) * 8; }
struct EpiBf16 {
    static constexpr bool PERM = true, KEEPS = false;
    bf16_t* O; int ldc; bf16_t* G;
    __device__ __forceinline__ void operator()(const f32x4 (&acc)[2][2][4][2], const Unit& u, int wr, int wc, int fr, int fq) const {
        const bool gate = u.pn >= GN_GATE / BM && u.pn < GN_LORA / BM;
        const int gt = u.pn - GN_GATE / BM;
        bf16_t* gbase = G + ((size_t)((gt >> 3) * (M / BM) + u.pm) * 8 + (gt & 7)) * 65536;
        const int pcol = (u.pn >= GN_LORA / BM ? PC_LORA + (u.pn - GN_LORA / BM) * BM : u.pn * BM) + wc * 32 + 8 * fq;
        const int row0 = u.pm * BM + wr * 64 + fr;
        int lbase = ((wr * 4 + wc) * 1024 + fq * 16 + fr) * 8; asm volatile("" : "+v"(lbase));
#pragma unroll
        for (int ai = 0; ai < 2; ++ai)
#pragma unroll
            for (int m = 0; m < 4; ++m) { bf16_t* rowp = O + (size_t)(row0 + ai * HALF + m * 16) * ldc + pcol;
#pragma unroll
                for (int bj = 0; bj < 2; ++bj) { const f32x4 v0 = acc[ai][bj][m][0], v1 = acc[ai][bj][m][1];
                    u32x4 w; w.x = pk2(v0[0], v0[1]); w.y = pk2(v0[2], v0[3]); w.z = pk2(v1[0], v1[1]); w.w = pk2(v1[2], v1[3]);
                    if (gate) *(u32x4*)(gbase + lbase + (((ai * 4 + m) * 2 + bj) * 512)) = w; else *(u32x4*)(rowp + bj * HALF) = w; } }
    }
};
struct EpiBranch {
    static constexpr bool PERM = true, KEEPS = true;
    const bf16_t* G; const float* bgate; bf16_t* MG;
    static __device__ __forceinline__ float den(float p) { return 1.0f + __expf(-__builtin_amdgcn_fmed3f(p, -30.0f, 30.0f)); }
    __device__ __forceinline__ void operator()(f32x4 (&acc)[2][2][4][2], const Unit& u, int wr, int wc, int fr, int fq) const {
        const int row0 = u.pm * BM + wr * 64 + fr, col0 = u.pn * BM + wc * 32 + 8 * fq; const int br = u.tag; const bool mid = br < 2;
        int lbase = ((wr * 4 + wc) * 1024 + fq * 16 + fr) * 8; asm volatile("" : "+v"(lbase));
        u32x2 bA[2][2], bB[2][2];
#pragma unroll
        for (int bj = 0; bj < 2; ++bj)
#pragma unroll
            for (int n = 0; n < 2; ++n) { const f32x4 t = *(const f32x4*)(bgate + br * D + col0 + bj * HALF + 4 * n); bA[bj][n].x = pk2(t[0], t[1]); bA[bj][n].y = pk2(t[2], t[3]);
                const f32x4 t2 = *(const f32x4*)(bgate + (mid ? br + 1 : br) * D + col0 + bj * HALF + 4 * n); bB[bj][n].x = pk2(t2[0], t2[1]); bB[bj][n].y = pk2(t2[2], t2[3]); }
        const bf16_t* gA = G + ((size_t)(br * (M / BM) + u.pm) * 8 + u.pn) * 65536;
        const bf16_t* gB = gA + (mid ? (size_t)(M / BM) * 8 * 65536 : 0);
        u32x4 gaq[2][2], gbq[2][2];
#define EB_LOAD(A8) do { _Pragma("unroll") for (int bj = 0; bj < 2; ++bj) { const int fo = lbase + (((A8) * 2 + bj) * 512); \
                gaq[(A8) & 1][bj] = *(const u32x4*)(gA + fo); gbq[(A8) & 1][bj] = *(const u32x4*)(gB + fo); } } while (0)
        EB_LOAD(0);
#pragma unroll
        for (int a8 = 0; a8 < 8; ++a8) { const int ai = a8 >> 2, m = a8 & 3; const size_t row = (size_t)(row0 + ai * HALF + m * 16);
            if (a8 + 1 < 8) EB_LOAD(a8 + 1);
            asm volatile("" ::: "memory");
#pragma unroll
                for (int bj = 0; bj < 2; ++bj) { const u32x4 a4 = gaq[a8 & 1][bj], b4 = gbq[a8 & 1][bj];
                    const unsigned aw[4] = {a4.x, a4.y, a4.z, a4.w}, bw[4] = {b4.x, b4.y, b4.z, b4.w}; unsigned ow[4];
#pragma unroll
                    for (int n = 0; n < 2; ++n) { const unsigned bax = bA[bj][n].x, bay = bA[bj][n].y, bbx = bB[bj][n].x, bby = bB[bj][n].y;
                        float f0 = __builtin_amdgcn_rcpf(den(bflo(aw[2 * n]) + bflo(bax))), f1 = __builtin_amdgcn_rcpf(den(bfhi(aw[2 * n]) + bfhi(bax)));
                        float f2 = __builtin_amdgcn_rcpf(den(bflo(aw[2 * n + 1]) + bflo(bay))), f3 = __builtin_amdgcn_rcpf(den(bfhi(aw[2 * n + 1]) + bfhi(bay)));
                        if (mid) { f0 *= den(bflo(bw[2 * n]) + bflo(bbx)); f1 *= den(bfhi(bw[2 * n]) + bfhi(bbx)); f2 *= den(bflo(bw[2 * n + 1]) + bflo(bby)); f3 *= den(bfhi(bw[2 * n + 1]) + bfhi(bby)); }
                        f32x4& av = acc[ai][bj][m][n];
                        av[0] *= f0; av[1] *= f1; av[2] *= f2; av[3] *= f3;
                        ow[2 * n] = pk2(av[0], av[1]); ow[2 * n + 1] = pk2(av[2], av[3]); }
                    if (!mid) { u32x4 o; o.x = ow[0]; o.y = ow[1]; o.z = ow[2]; o.w = ow[3]; *(u32x4*)(MG + row * D + col0 + bj * HALF) = o; } }
        }
#undef EB_LOAD
    }
};
}

#define XB_TMO      128
#define XB_XCNT(j)  (256  + 64 * (j))
#define XB_XSUB(j)  (1280 + 64 * (j))
#define XB_XGEN(j)  (2304 + 64 * (j))
#define XB_TOP      3328
#define XB_TOPGEN   3392
#define XCD_BAR_WORDS 3456
#define XB_SPIN_CAP (1u << 18)
__device__ __forceinline__ unsigned xb_ld(unsigned* p)              { return __hip_atomic_load(p, __ATOMIC_RELAXED, __HIP_MEMORY_SCOPE_AGENT); }
__device__ __forceinline__ unsigned xb_add(unsigned* p, unsigned v) { return __hip_atomic_fetch_add(p, v, __ATOMIC_RELAXED, __HIP_MEMORY_SCOPE_AGENT); }
__device__ __forceinline__ unsigned xb_xcc_id() { return (unsigned)__builtin_amdgcn_s_getreg((3 << 11) | 20) & 0xFu; }
#define XB_SPIN(cond, bar) do { unsigned _sp = 0; while (cond) { __builtin_amdgcn_s_sleep(1); \
    if ((++_sp & 255u) == 0u) { if (xb_ld(&(bar)[XB_TMO])) break; if (_sp > XB_SPIN_CAP) { atomicAdd(&(bar)[XB_TMO], 1u); break; } } } } while (0)
struct XcdBarrier { unsigned* bar; unsigned x; volatile LAS unsigned* st; };
__device__ __forceinline__ XcdBarrier xcd_barrier_post(unsigned* bar, volatile LAS unsigned* st) {
    XcdBarrier b; b.bar = bar; b.x = xb_xcc_id(); b.st = st;
    if (threadIdx.x == 0) (void)xb_add(&bar[XB_XCNT(b.x)], 1u);
    return b;
}
__device__ __forceinline__ void xcd_barrier_complete(unsigned* bar, unsigned x, unsigned& nloc, unsigned& nx) {
    const unsigned G = gridDim.x * gridDim.y * gridDim.z;
    unsigned sum, cnt, mine, sp = 0u;
    for (;;) {
        sum = 0u; cnt = 0u; mine = 0u;
#pragma unroll
        for (unsigned j = 0; j < 16; ++j) { const unsigned c = xb_ld(&bar[XB_XCNT(j)]); sum += c; cnt += (c > 0u) ? 1u : 0u; mine = (j == x) ? c : mine; }
        if (sum == G) break;
        __builtin_amdgcn_s_sleep(1);
        if ((++sp & 255u) == 0u) { if (xb_ld(&bar[XB_TMO])) break; if (sp > XB_SPIN_CAP) { atomicAdd(&bar[XB_TMO], 1u); break; } }
    }
    nloc = mine > 0u ? mine : 1u; nx = cnt > 0u ? cnt : 1u;
}
__device__ __forceinline__ void xcd_barrier(const XcdBarrier& b) {
    asm volatile("s_waitcnt vmcnt(0)" ::: "memory");
    __syncthreads();
    if (threadIdx.x == 0) {
        unsigned* bar = b.bar;
        __builtin_amdgcn_s_waitcnt(0);
        unsigned nloc = b.st[0], nx = b.st[1];
        if (nloc == 0u) { xcd_barrier_complete(bar, b.x, nloc, nx); b.st[0] = nloc; b.st[1] = nx; }
        const unsigned old = xb_add(&bar[XB_XSUB(b.x)], 1u);
        const unsigned gen = old / nloc;
        if (old + 1u == (gen + 1u) * nloc) {
            __builtin_amdgcn_fence(__ATOMIC_RELEASE, "agent");
            asm volatile("s_waitcnt vmcnt(0)" ::: "memory");
            const unsigned og = xb_add(&bar[XB_TOP], 1u);
            const unsigned tg = og / nx;
            if (og + 1u == (tg + 1u) * nx) xb_add(&bar[XB_TOPGEN], 1u);
            else XB_SPIN(xb_ld(&bar[XB_TOPGEN]) == tg, bar);
            __builtin_amdgcn_fence(__ATOMIC_ACQUIRE, "agent");
            xb_add(&bar[XB_XGEN(b.x)], 1u);
            asm volatile("s_waitcnt vmcnt(0)" ::: "memory");
        } else {
            XB_SPIN(xb_ld(&bar[XB_XGEN(b.x)]) == gen, bar);
            __builtin_amdgcn_fence(__ATOMIC_ACQUIRE, "agent");
            asm volatile("s_waitcnt vmcnt(0)" ::: "memory");
        }
    }
    __syncthreads();
}

struct Args { const float* in[33]; float* out; unsigned char* ws; int lo, hi; };
enum { I_X = 0, I_F1IN, I_F1OUT, I_LN1G, I_LN1B, I_WIN, I_BGATE, I_MU, I_W0, I_W2, I_A0, I_A2, I_G2, I_KK, I_KA, I_RK, I_GNG, I_GNB, I_SGLNG, I_SGLNB, I_SGW, I_SGB, I_ILNG, I_ILNB, I_RELB, I_WBR, I_WO, I_LN2G, I_LN2B, I_F2IN, I_F2OUT, I_LN3G, I_LN3B };

DI int pmap(int n) {
    int off = 0;
    off = n >= 3072 ? GN_LORA - 3072 : off; off = n >= 3360 ? PC_SGU - 3360 : off; off = n >= 4384 ? PC_AQ - 4384 : off; off = n >= 5920 ? PC_QI - 5920 : off;
    off = n >= 6944 ? GN_KI - 6944 : off; off = n >= 7008 ? GN_WI - 7008 : off; off = n >= 7024 ? GN_GATE - 7024 : off;
    return n + off;
}
template <int MODE> DI int rowmap(int n) {
    if (MODE == 0) return n;
    if (MODE == 1) { const int up = n >= FF ? 1 : 0, j = n - up * FF; return (j >> 7) * 256 + up * 128 + (j & 127); }
    return pmap(n);
}
struct CvtItem { const float* W; bf16_t* WT; int K, N, mode, item; };
DI void cvt_load(const CvtItem& d, int lane, f32x4 (&va)[4], f32x4 (&vb)[4]) {
    const int nblk = (d.N + 31) / 32, kb = d.item / nblk, nb = d.item % nblk, k0 = 64 * kb, n0 = 32 * nb;
    const int c4 = lane & 7, rq = lane >> 3; const int ncol = n0 + 4 * c4; const int ncl = ncol < d.N ? ncol : 0;
#pragma unroll
    for (int i = 0; i < 4; ++i) { const int k = k0 + 2 * (rq + 8 * i);
        va[i] = *(const f32x4*)(d.W + (size_t)k * d.N + ncl); vb[i] = *(const f32x4*)(d.W + (size_t)(k + 1) * d.N + ncl); }
}
DI void cvt_finish(const CvtItem& d, int lane, const f32x4 (&va)[4], const f32x4 (&vb)[4], float* scr) {
    const int nblk = (d.N + 31) / 32, kb = d.item / nblk, nb = d.item % nblk, k0 = 64 * kb, n0 = 32 * nb;
    unsigned* st = (unsigned*)scr; const int c4 = lane & 7, rq = lane >> 3;
#pragma unroll
    for (int i = 0; i < 4; ++i) { const int rp = rq + 8 * i;
#pragma unroll
        for (int j = 0; j < 4; ++j) st[(4 * c4 + j) * 33 + rp] = pk2(va[i][j], vb[i][j]); }
    __builtin_amdgcn_s_waitcnt(0xc07f); asm volatile("" ::: "memory");
#pragma unroll
    for (int i = 0; i < 4; ++i) { const int id = lane + 64 * i, n = id >> 3, kc = id & 7; const unsigned* p = st + n * 33 + 4 * kc;
        u32x4 o; o.x = p[0]; o.y = p[1]; o.z = p[2]; o.w = p[3];
        const int ns = n0 + n; const int nd1 = rowmap<1>(ns), nd2 = pmap(ns); const int nd = d.mode == 0 ? ns : (d.mode == 1 ? nd1 : nd2);
        if (ns < d.N) *(u32x4*)(d.WT + (size_t)nd * d.K + k0 + 8 * kc) = o; }
    __builtin_amdgcn_s_waitcnt(0xc07f); asm volatile("" ::: "memory");
}
DI void convert_phase(const Args& a, int L, unsigned char* lds, int vb, int nvb) {
    const int tidx_ = otid();
    const int wave = __builtin_amdgcn_readfirstlane(tidx_ >> 6), lane = tidx_ & 63;
    float* scr = (float*)(lds + wave * 16384);
    const int gw = vb * 8 + wave, NGW = nvb * 8;
    unsigned char* ws = a.ws; const size_t alt = (L & 1) ? ALT_SHIFT : 0;
    constexpr int I1 = (D / 64) * ((2 * FF) / 32), I2 = (FF / 64) * (D / 32), I3 = (D / 64) * ((DIN + 31) / 32), I4 = (D / 64) * (D / 32);
    constexpr int NIT = 2 * I1 + 2 * I2 + I3 + 2 * I4;
    auto decode = [&](int it) -> CvtItem {
        int r = it;
        if (r < I1) return CvtItem{a.in[I_F1IN] + (size_t)L * D * 2 * FF, (bf16_t*)(ws + OFF_W1A), D, 2 * FF, 1, r}; r -= I1;
        if (r < I1) return CvtItem{a.in[I_F2IN] + (size_t)L * D * 2 * FF, (bf16_t*)(ws + OFF_W2A + alt), D, 2 * FF, 1, r}; r -= I1;
        if (r < I2) return CvtItem{a.in[I_F1OUT] + (size_t)L * FF * D, (bf16_t*)(ws + OFF_W1B), FF, D, 0, r}; r -= I2;
        if (r < I2) return CvtItem{a.in[I_F2OUT] + (size_t)L * FF * D, (bf16_t*)(ws + OFF_W2B + alt), FF, D, 0, r}; r -= I2;
        if (r < I3) return CvtItem{a.in[I_WIN] + (size_t)L * D * DIN, (bf16_t*)(ws + OFF_WIN), D, DIN, 2, r}; r -= I3;
        if (r < I4) return CvtItem{a.in[I_WBR] + (size_t)L * D * D, (bf16_t*)(ws + OFF_WBR + alt), D, D, 0, r}; r -= I4;
        return CvtItem{a.in[I_WO] + (size_t)L * D * D, (bf16_t*)(ws + OFF_WO + alt), D, D, 0, r};
    };
    auto clampi = [&](int x) { return x < NIT ? x : gw; };
    {
        int it = gw;
        CvtItem dA0 = decode(clampi(it)), dA1 = decode(clampi(it + NGW));
        f32x4 a0[4], b0[4], a1[4], b1[4], a2[4], b2[4], a3[4], b3[4];
        cvt_load(dA0, lane, a0, b0); cvt_load(dA1, lane, a1, b1);
#pragma unroll 1
        for (; it < NIT; it += 4 * NGW) {
            const CvtItem dB0 = decode(clampi(it + 2 * NGW)), dB1 = decode(clampi(it + 3 * NGW));
            cvt_load(dB0, lane, a2, b2); cvt_load(dB1, lane, a3, b3);
            asm volatile("" ::: "memory");
            cvt_finish(dA0, lane, a0, b0, scr); cvt_finish(dA1, lane, a1, b1, scr + 2048);
            asm volatile("" ::: "memory");
            dA0 = decode(clampi(it + 4 * NGW)); dA1 = decode(clampi(it + 5 * NGW));
            cvt_load(dA0, lane, a0, b0); cvt_load(dA1, lane, a1, b1);
            asm volatile("" ::: "memory");
            cvt_finish(dB0, lane, a2, b2, scr); cvt_finish(dB1, lane, a3, b3, scr + 2048);
            asm volatile("" ::: "memory");
        }
    }
    { bf16_t* w2t = (bf16_t*)(ws + OFF_LW2); bf16_t* a2t = (bf16_t*)(ws + OFF_LA2); bf16_t* g2t = (bf16_t*)(ws + OFF_LG2);
      const float* w2 = a.in[I_W2] + (size_t)L * 64 * RW; const float* a2 = a.in[I_A2] + (size_t)L * 64 * RW; const float* g2 = a.in[I_G2] + (size_t)L * 160 * RW;
      for (int i = vb * 512 + tidx_; i < RW * 288; i += nvb * 512) { const int c = i / 288, jj = i - c * 288;
          if (jj < 64) w2t[c * 64 + jj] = (bf16_t)f2bf(w2[(size_t)jj * RW + c]);
          else if (jj < 128) a2t[c * 64 + jj - 64] = (bf16_t)f2bf(a2[(size_t)(jj - 64) * RW + c]);
          else g2t[c * 160 + jj - 128] = (bf16_t)f2bf(g2[(size_t)(jj - 128) * RW + c]); } }
    { u32x4* z = (u32x4*)(ws + OFF_WIN + (size_t)DIN * D * 2); const int n16 = (NP - DIN) * D * 2 / 16;
      u32x4 zq = (u32x4){0u, 0u, 0u, 0u}; asm volatile("" : "+v"(zq));
      for (int i = vb * 512 + tidx_; i < n16; i += nvb * 512) z[i] = zq; }
}
DI int rel_bucket_dev(int d) {
    if (d < 16) return d;
    const float df = (float)d;
    const int large = 16 + (int)(logf(df / 16.0f) / 2.0794415416798357f * 16.0f);
    return large < 31 ? large : 31;
}
DI void init_phase(const Args& a) {
    const int tidx_ = otid();
    const size_t n4 = (size_t)M * D / 4; const f32x4* x = (const f32x4*)a.in[I_X]; u32x2* XB = (u32x2*)(a.ws + OFF_XB);
    for (size_t i = (size_t)blockIdx.x * 512 + tidx_; i < n4; i += (size_t)gridDim.x * 512) { const f32x4 v = x[i]; u32x2 o; o.x = pk2(v[0], v[1]); o.y = pk2(v[2], v[3]); XB[i] = o; }
    if (blockIdx.x == 0) { float* bt = (float*)(a.ws + OFF_BIAS); for (int i = tidx_; i < 8 * 128; i += 512) { const int h = i >> 7, d = i & 127; bt[i] = a.in[I_RELB][rel_bucket_dev(d) * 8 + h]; } }
}
DI void ln_phase(const float* T, const float* g, const float* b, float* ST, bf16_t* XB, float* out) {
    const int tidx_ = otid();
    const int wave = __builtin_amdgcn_readfirstlane(tidx_ >> 6), lane = tidx_ & 63;
    const int stride = gridDim.x * 8;
    f32x4 gvs[8], bvs[8];
#pragma unroll
    for (int j = 0; j < 8; ++j) { gvs[j] = ((const f32x4*)g)[lane + 64 * j]; bvs[j] = ((const f32x4*)b)[lane + 64 * j]; }
    int m = blockIdx.x * 8 + wave;
    f32x4 nx[8];
    if (m < M) {
#pragma unroll
        for (int j = 0; j < 8; ++j) nx[j] = ((const f32x4*)(T + (size_t)m * D) + lane)[64 * j]; }
#pragma unroll 1
    for (; m < M; m += stride) {
        f32x4 v[8]; float s = 0.f;
#pragma unroll
        for (int j = 0; j < 8; ++j) { v[j] = nx[j]; s += (v[j][0] + v[j][1]) + (v[j][2] + v[j][3]); }
        if (m + stride < M) {
#pragma unroll
            for (int j = 0; j < 8; ++j) nx[j] = ((const f32x4*)(T + (size_t)(m + stride) * D) + lane)[64 * j]; }
        const float mean = wave_sum(s) * (1.0f / D); float q = 0.f;
#pragma unroll
        for (int j = 0; j < 8; ++j) { v[j] = v[j] - mean; q += (v[j][0] * v[j][0] + v[j][1] * v[j][1]) + (v[j][2] * v[j][2] + v[j][3] * v[j][3]); }
        const float rstd = __builtin_amdgcn_rsqf(wave_sum(q) * (1.0f / D) + LN_EPS);
        if (lane == 0) *(f32x2*)(ST + 2 * (size_t)m) = (f32x2){mean, rstd};
        u32x2* bo = (u32x2*)(XB + (size_t)m * D) + lane;
#pragma unroll
        for (int j = 0; j < 8; ++j) {
            const f32x4 o = v[j] * rstd * gvs[j] + bvs[j]; u32x2 w; w.x = pk2(o[0], o[1]); w.y = pk2(o[2], o[3]); bo[64 * j] = w;
            if (out) ((f32x4*)(out + (size_t)m * D) + lane)[64 * j] = o; }
    }
}
DI void rwkv_prep_phase(const Args& a, int L, unsigned char* lds) {
    const int tidx_ = otid();
    const int tid = tidx_;
    const bf16_t* P = (const bf16_t*)(a.ws + OFF_P);
    float* Rr = (float*)(a.ws + OFF_SCR); float* Wr = Rr + (size_t)M * RW; float* Kr = Wr + (size_t)M * RW; float* Vr = Kr + (size_t)M * RW; float* Ar = Vr + (size_t)M * RW; float* Br = Ar + (size_t)M * RW;
    bf16_t* Gb = (bf16_t*)(a.ws + OFF_MG);
    const float* mu = a.in[I_MU] + (size_t)L * 3360; const float* w0 = a.in[I_W0] + L * RW; const float* w2 = a.in[I_W2] + (size_t)L * 64 * RW;
    const float* a0 = a.in[I_A0] + L * RW; const float* a2 = a.in[I_A2] + (size_t)L * 64 * RW; const float* g2 = a.in[I_G2] + (size_t)L * 160 * RW;
    const float* kkw = a.in[I_KK] + L * RW; const float* kaw = a.in[I_KA] + L * RW;
    float* xl = (float*)lds;
    for (int unit = blockIdx.x; unit < M / 32; unit += gridDim.x) {
        const int m0 = unit * 32;
        __syncthreads();
        for (int idx = tid; idx < 32 * 288; idx += 512) { const int tt = idx / 288, j = idx - tt * 288; const int m = m0 + tt;
            const float cur = bf2f(P[(size_t)m * PCOLS + PC_LORA + j]); const float prev = (m & (SEQ - 1)) == 0 ? 0.f : bf2f(P[(size_t)(m - 1) * PCOLS + PC_LORA + j]);
            float x = cur + (prev - cur) * mu[3072 + j];
            if (j < 64) x = tanhf(x); else if (j >= 128) x = sigmoidf_(x);
            xl[idx] = x; }
        __syncthreads();
#pragma unroll 1
        for (int half = 0; half < 2; ++half) { const int c = tid + 512 * half;
            const float w0c = w0[c], a0c = a0[c], kkc = kkw[c], kac = kaw[c], mur = mu[c], muk = mu[1024 + c], muv = mu[2048 + c];
#pragma unroll 1
            for (int sub = 0; sub < 4; ++sub) {
                float wl[8], al[8], gl[8];
#pragma unroll
                for (int t = 0; t < 8; ++t) { wl[t] = w0c; al[t] = a0c; gl[t] = 0.f; }
                const float* xb = xl + sub * 8 * 288;
#pragma unroll 2
                for (int j = 0; j < 64; j += 4) { const float u0 = w2[(size_t)(j + 0) * RW + c], u1 = w2[(size_t)(j + 1) * RW + c], u2 = w2[(size_t)(j + 2) * RW + c], u3 = w2[(size_t)(j + 3) * RW + c];
                    const float v0 = a2[(size_t)(j + 0) * RW + c], v1 = a2[(size_t)(j + 1) * RW + c], v2 = a2[(size_t)(j + 2) * RW + c], v3 = a2[(size_t)(j + 3) * RW + c];
#pragma unroll
                    for (int t = 0; t < 8; ++t) { const f32x4 xw = *(const f32x4*)(xb + t * 288 + j); const f32x4 xa = *(const f32x4*)(xb + t * 288 + 64 + j);
                        wl[t] += xw[0] * u0 + xw[1] * u1 + xw[2] * u2 + xw[3] * u3; al[t] += xa[0] * v0 + xa[1] * v1 + xa[2] * v2 + xa[3] * v3; } }
#pragma unroll 2
                for (int j = 0; j < 160; j += 4) { const float u0 = g2[(size_t)(j + 0) * RW + c], u1 = g2[(size_t)(j + 1) * RW + c], u2 = g2[(size_t)(j + 2) * RW + c], u3 = g2[(size_t)(j + 3) * RW + c];
#pragma unroll
                    for (int t = 0; t < 8; ++t) { const f32x4 xg = *(const f32x4*)(xb + t * 288 + 128 + j); gl[t] += xg[0] * u0 + xg[1] * u1 + xg[2] * u2 + xg[3] * u3; } }
#pragma unroll
                for (int t = 0; t < 8; ++t) { const int m = m0 + sub * 8 + t; const bool first = (m & (SEQ - 1)) == 0;
                    const bf16_t* pc = P + (size_t)m * PCOLS; const bf16_t* pp = pc - PCOLS;
                    const float rc = bf2f(pc[PC_R + c]), kc = bf2f(pc[PC_K + c]), vc = bf2f(pc[PC_V + c]);
                    const float rp = first ? 0.f : bf2f(pp[PC_R + c]), kp = first ? 0.f : bf2f(pp[PC_K + c]), vp = first ? 0.f : bf2f(pp[PC_V + c]);
                    const float r = rc + (rp - rc) * mur, k = kc + (kp - kc) * muk, v = vc + (vp - vc) * muv;
                    const float nx = -wl[t]; const float sp = nx > 20.f ? nx : log1pf(expf(nx));
                    const float decay = expf(-expf(-sp - 0.5f));
                    const float av = 1.0f / (1.0f + expf(-al[t]));
                    const float kk = k * kkc; const float ss = wave_sum(kk * kk); const float kkn = kk / fmaxf(sqrtf(ss), 1e-12f);
                    const float k2 = k * (1.0f + (av - 1.0f) * kac);
                    const size_t o = (size_t)m * RW + c;
                    Rr[o] = r; Wr[o] = decay; Kr[o] = k2; Vr[o] = v; Ar[o] = -kkn; Br[o] = kkn * av; Gb[o] = (bf16_t)f2bf(gl[t]); }
            }
        }
    }
}
struct WorkQ { unsigned* ctr; int pend, par, stride; };
constexpr int WQ_SLOT = 147456 - 16;
DI int wq_next(WorkQ& q, int cur, unsigned char* lds, int tid) {
    if (!q.ctr) return cur + q.stride;
    LAS int* slot = (LAS int*)(lds + WQ_SLOT);
    if (tid == 0) slot[q.par] = q.pend;
    __syncthreads();
    const int v = __builtin_amdgcn_readfirstlane(slot[q.par]);
    q.par ^= 1;
    if (tid == 0) q.pend = (int)__hip_atomic_fetch_add(q.ctr, 1u, __ATOMIC_RELAXED, __HIP_MEMORY_SCOPE_AGENT);
    return v;
}
DI int wq_first(WorkQ& q, unsigned char* lds, int tid) {
    q.par = 0; q.pend = 0;
    if (tid == 0) q.pend = (int)__hip_atomic_fetch_add(q.ctr, 1u, __ATOMIC_RELAXED, __HIP_MEMORY_SCOPE_AGENT);
    return wq_next(q, 0, lds, tid);
}
DI void kidx_vt_phase(const Args& a, int L, unsigned char* lds) {
    const int tidx_ = otid();
    const int wave = __builtin_amdgcn_readfirstlane(tidx_ >> 6), lane = tidx_ & 63;
    const bf16_t* P = (const bf16_t*)(a.ws + OFF_P); bf16_t* KI = (bf16_t*)(a.ws + OFF_KI); bf16_t* VT = (bf16_t*)(a.ws + OFF_VT);
    const float g = a.in[I_ILNG][L * 64 + lane], b = a.in[I_ILNB][L * 64 + lane];
    for (int m0 = blockIdx.x * 8 + wave; m0 < M; m0 += gridDim.x * 8 * 8) {
        bf16_t raw[8];
#pragma unroll
        for (int i = 0; i < 8; ++i) { const int m = m0 + i * gridDim.x * 8; raw[i] = m < M ? P[(size_t)m * PCOLS + PC_KI + lane] : (bf16_t)0; }
#pragma unroll
        for (int i = 0; i < 8; ++i) { const int m = m0 + i * gridDim.x * 8; if (m < M) { const float x = bf2f(raw[i]);
            const float mean = wave_sum(x) * (1.0f / 64.0f); const float d = x - mean; const float var = wave_sum(d * d) * (1.0f / 64.0f);
            KI[(size_t)m * 64 + lane] = (bf16_t)f2bf(d * __builtin_amdgcn_rsqf(var + LN_EPS) * g + b); } }
    }
    bf16_t* tile = (bf16_t*)(lds + wave * 16384);
    for (int u = blockIdx.x * 8 + wave; u < NB * 8 * 64; u += gridDim.x * 8) {
        const int tb = u & 63, h = (u >> 6) & 7, b_ = u >> 9; const int m = b_ * SEQ + tb * 64 + lane;
        const u32x4* src = (const u32x4*)(P + (size_t)m * PCOLS + PC_AV + h * 64);
#pragma unroll
        for (int q = 0; q < 8; ++q) { const u32x4 v = src[q]; const unsigned w[4] = {v.x, v.y, v.z, v.w};
#pragma unroll
            for (int e = 0; e < 4; ++e) { tile[(q * 8 + 2 * e) * 72 + lane] = (bf16_t)(w[e] & 0xffffu); tile[(q * 8 + 2 * e + 1) * 72 + lane] = (bf16_t)(w[e] >> 16); } }
        __builtin_amdgcn_s_waitcnt(0xc07f); asm volatile("" ::: "memory");
        bf16_t* dst = VT + ((size_t)(b_ * 8 + h) * 64 + lane) * SEQ + tb * 64;
#pragma unroll
        for (int q = 0; q < 8; ++q) *(u32x4*)(dst + q * 8) = *(const u32x4*)(tile + lane * 72 + q * 8);
        __builtin_amdgcn_s_waitcnt(0xc07f); asm volatile("" ::: "memory");
    }
}
DI void sgu_phase(const Args& a, int L, unsigned char* lds, WorkQ& wq, int& item, int ibase) {
    const int tidx_ = otid();
    const int tid = tidx_, wave = __builtin_amdgcn_readfirstlane(tid >> 6), lane = tid & 63, fr = lane & 15, fq = lane >> 4;
    const bf16_t* P = (const bf16_t*)(a.ws + OFF_P); bf16_t* Y = (bf16_t*)(a.ws + OFF_Y);
    const float* lng = a.in[I_SGLNG] + L * 512; const float* lnb = a.in[I_SGLNB] + L * 512;
    bf16_t* Wl = (bf16_t*)lds;
    bf16_t* Vl = (bf16_t*)(lds + 128 * 272);
    for (; item < ibase + NB * 32 * 4; item = wq_next(wq, item, lds, tid)) {
        const int unit = item - ibase;
        const int g = unit & 3, ch = (unit >> 2) & 31, b_ = unit >> 7; const int m0 = b_ * SEQ + ch * 128;
        const float* sw = a.in[I_SGW] + ((size_t)(L * 4 + g) * 128) * 128; const float* sb = a.in[I_SGB] + (L * 4 + g) * 128;
        __syncthreads();
#pragma unroll
        for (int it8 = 0; it8 < 8; ++it8) { const int idx = tid + 512 * it8; const int i = idx >> 5, j4 = (idx & 31) * 4; const f32x4 w = *(const f32x4*)(sw + i * 128 + j4);
            u32x2 o; o.x = pk2(j4 + 0 <= i ? w[0] : 0.f, j4 + 1 <= i ? w[1] : 0.f); o.y = pk2(j4 + 2 <= i ? w[2] : 0.f, j4 + 3 <= i ? w[3] : 0.f);
            *(u32x2*)(Wl + i * 136 + j4) = o; }
        float lgv[8], lbv[8];
#pragma unroll
        for (int e = 0; e < 8; ++e) { lgv[e] = lng[lane * 8 + e]; lbv[e] = lnb[lane * 8 + e]; }
#pragma unroll 1
        for (int ib = 0; ib < 2; ++ib) {
        u32x4 pvs[8];
#pragma unroll
        for (int i = 0; i < 8; ++i) pvs[i] = *(const u32x4*)(P + (size_t)(m0 + wave + 8 * (8 * ib + i)) * PCOLS + PC_SGV + lane * 8);
#pragma unroll
        for (int i = 0; i < 8; ++i) { const int tt = wave + 8 * (8 * ib + i);
            const u32x4 pv = pvs[i];
            float z[8]; z[0] = gelu_erf(bflo(pv.x)); z[1] = gelu_erf(bfhi(pv.x)); z[2] = gelu_erf(bflo(pv.y)); z[3] = gelu_erf(bfhi(pv.y));
            z[4] = gelu_erf(bflo(pv.z)); z[5] = gelu_erf(bfhi(pv.z)); z[6] = gelu_erf(bflo(pv.w)); z[7] = gelu_erf(bfhi(pv.w));
            float s = 0.f;
#pragma unroll
            for (int e = 0; e < 8; ++e) s += z[e];
            const float mean = wave_sum(s) * (1.0f / 512.0f); float q = 0.f;
#pragma unroll
            for (int e = 0; e < 8; ++e) { z[e] -= mean; q += z[e] * z[e]; }
            const float rstd = __builtin_amdgcn_rsqf(wave_sum(q) * (1.0f / 512.0f) + LN_EPS);
            if ((lane >> 4) == g) {
#pragma unroll
                for (int e = 0; e < 8; ++e) Vl[((lane & 15) * 8 + e) * 136 + tt] = (bf16_t)f2bf(z[e] * rstd * lgv[e] + lbv[e]); }
        }
        }
        __syncthreads();
        f32x4 acc[8];
#pragma unroll
        for (int nt = 0; nt < 8; ++nt) acc[nt] = (f32x4){0.f, 0.f, 0.f, 0.f};
        const int ksmax = (16 * wave + 15) >> 5;
#pragma unroll
        for (int ks = 0; ks < 4; ++ks) if (ks <= ksmax) {
            const bf16x8 af = *(const bf16x8*)(Wl + (16 * wave + fr) * 136 + 32 * ks + 8 * fq);
#pragma unroll
            for (int nt = 0; nt < 8; ++nt) { const bf16x8 bfr = *(const bf16x8*)(Vl + (16 * nt + fr) * 136 + 32 * ks + 8 * fq);
                acc[nt] = __builtin_amdgcn_mfma_f32_16x16x32_bf16(af, bfr, acc[nt], 0, 0, 0); }
        }
        bf16_t ur[4][8];
#pragma unroll
        for (int r = 0; r < 4; ++r)
#pragma unroll
            for (int nt = 0; nt < 8; ++nt) ur[r][nt] = P[(size_t)(m0 + 16 * wave + 4 * fq + r) * PCOLS + PC_SGU + g * 128 + 16 * nt + fr];
        float bsv[4];
#pragma unroll
        for (int r = 0; r < 4; ++r) bsv[r] = sb[16 * wave + 4 * fq + r];
        asm volatile("" ::: "memory");
#pragma unroll
        for (int r = 0; r < 4; ++r) { const int i = 16 * wave + 4 * fq + r; const float bs = bsv[r]; const size_t m = (size_t)(m0 + i);
#pragma unroll
            for (int nt = 0; nt < 8; ++nt) { const int dcol = g * 128 + 16 * nt + fr; const float uu = gelu_erf(bf2f(ur[r][nt]));
                Y[m * D + 1024 + dcol] = (bf16_t)f2bf(uu * (acc[nt][r] + bs)); } }
    }
}
DI void scan_load_chunk(unsigned char* bufp, const float* Rr, const float* Wr, const float* Kr, const float* Ar, const float* Br, const float* Vr, size_t base, int c, int rg, int lt) {
    const float* arrs[5] = {Rr, Wr, Kr, Ar, Br};
#pragma unroll
    for (int ar = 0; ar < 5; ++ar)
#pragma unroll
        for (int ps = 0; ps < 2; ++ps) { const int tt = ps * 16 + (lt >> 4), c4 = (lt & 15) * 4;
            const f32x4 v = *(const f32x4*)(arrs[ar] + base + (size_t)(c * 32 + tt) * RW + c4);
            *(f32x4*)(bufp + ar * 8192 + (tt * 64 + c4) * 4) = v; }
    if (lt < 128) { const int tt = lt >> 2, i4 = (lt & 3) * 4; const f32x4 v = *(const f32x4*)(Vr + base + (size_t)(c * 32 + tt) * RW + rg * 16 + i4);
        *(f32x4*)(bufp + 5 * 8192 + (tt * 16 + i4) * 4) = v; }
}
DI void scan_phase(const Args& a, unsigned char* lds) {
    const int tidx_ = otid();
    const int tid = tidx_;
    const float* Rr = (const float*)(a.ws + OFF_SCR); const float* Wr = Rr + (size_t)M * RW; const float* Kr = Wr + (size_t)M * RW; const float* Vr = Kr + (size_t)M * RW; const float* Ar = Vr + (size_t)M * RW; const float* Br = Ar + (size_t)M * RW;
    float* Yraw = (float*)(a.ws + OFF_X);
    constexpr int BUFB = 5 * 8192 + 2048;
    constexpr int NCH = SEQ / 32;
    for (int unit = blockIdx.x; unit < 256; unit += gridDim.x) {
        const int rg = unit & 3, h = (unit >> 2) & 15, b_ = unit >> 6;
        const size_t base = (size_t)b_ * SEQ * RW + h * 64;
        __syncthreads();
        const bool loader = tid >= 256; const int lt = tid - 256;
        if (loader) scan_load_chunk(lds, Rr, Wr, Kr, Ar, Br, Vr, base, 0, rg, lt);
        __syncthreads();
        float S0 = 0.f, S1 = 0.f, S2 = 0.f, S3 = 0.f;
        const int i = tid >> 4, c4 = tid & 15;
#pragma unroll 1
        for (int c = 0; c < NCH; ++c) {
            if (loader) {
                if (c > 0 && lt < 128) { const int tt = lt >> 2, i4 = (lt & 3) * 4; const f32x4 y = *(const f32x4*)(lds + 2 * BUFB + ((c - 1) & 1) * 2048 + (tt * 16 + i4) * 4);
                    *(f32x4*)(Yraw + base + (size_t)((c - 1) * 32 + tt) * RW + rg * 16 + i4) = y; }
                if (c + 1 < NCH) scan_load_chunk(lds + ((c + 1) & 1) * BUFB, Rr, Wr, Kr, Ar, Br, Vr, base, c + 1, rg, lt);
            } else {
                const unsigned char* bufp = lds + (c & 1) * BUFB; float* yb = (float*)(lds + 2 * BUFB + (c & 1) * 2048);
#pragma unroll 4
                for (int s = 0; s < 32; ++s) {
                    const f32x4 r4 = *(const f32x4*)(bufp + 0 * 8192 + (s * 64 + c4 * 4) * 4);
                    const f32x4 w4 = *(const f32x4*)(bufp + 1 * 8192 + (s * 64 + c4 * 4) * 4);
                    const f32x4 k4 = *(const f32x4*)(bufp + 2 * 8192 + (s * 64 + c4 * 4) * 4);
                    const f32x4 a4 = *(const f32x4*)(bufp + 3 * 8192 + (s * 64 + c4 * 4) * 4);
                    const f32x4 b4 = *(const f32x4*)(bufp + 4 * 8192 + (s * 64 + c4 * 4) * 4);
                    const float vi = *(const float*)(bufp + 5 * 8192 + (s * 16 + i) * 4);
                    float sa = (S0 * a4[0] + S1 * a4[1]) + (S2 * a4[2] + S3 * a4[3]);
                    sa = row16_sum(sa);
                    S0 = S0 * w4[0] + sa * b4[0] + vi * k4[0]; S1 = S1 * w4[1] + sa * b4[1] + vi * k4[1];
                    S2 = S2 * w4[2] + sa * b4[2] + vi * k4[2]; S3 = S3 * w4[3] + sa * b4[3] + vi * k4[3];
                    float yp = (S0 * r4[0] + S1 * r4[1]) + (S2 * r4[2] + S3 * r4[3]);
                    yp = row16_sum(yp);
                    if (c4 == 0) yb[s * 16 + i] = yp;
                }
            }
            __syncthreads();
        }
        if (loader && lt < 128) { const int tt = lt >> 2, i4 = (lt & 3) * 4; const f32x4 y = *(const f32x4*)(lds + 2 * BUFB + ((NCH - 1) & 1) * 2048 + (tt * 16 + i4) * 4);
            *(f32x4*)(Yraw + base + (size_t)((NCH - 1) * 32 + tt) * RW + rg * 16 + i4) = y; }
    }
}
DI void rwkv_fin_phase(const Args& a, int L) {
    const int tidx_ = otid();
    const int wave = __builtin_amdgcn_readfirstlane(tidx_ >> 6), lane = tidx_ & 63;
    const float* Rr = (const float*)(a.ws + OFF_SCR); const float* Kr = Rr + 2 * (size_t)M * RW; const float* Vr = Kr + (size_t)M * RW;
    const float* Yraw = (const float*)(a.ws + OFF_X); const bf16_t* Gb = (const bf16_t*)(a.ws + OFF_MG); bf16_t* Y = (bf16_t*)(a.ws + OFF_Y);
    const float* rk = a.in[I_RK] + L * RW; const float* gng = a.in[I_GNG] + L * RW; const float* gnb = a.in[I_GNB] + L * RW;
    for (int it = blockIdx.x * 8 + wave; it < M * 16; it += gridDim.x * 8) {
        const int m = it >> 4, h = it & 15, c = h * 64 + lane; const size_t o = (size_t)m * RW + c;
        const float y = Yraw[o], r = Rr[o], k = Kr[o], v = Vr[o];
        const float mean = wave_sum(y) * (1.0f / 64.0f); const float d = y - mean; const float var = wave_sum(d * d) * (1.0f / 64.0f);
        const float yn = d * (1.0f / sqrtf(var + 64e-5f)) * gng[c] + gnb[c];
        const float bonus = wave_sum(r * k * rk[c]) * v;
        Y[(size_t)m * D + c] = (bf16_t)f2bf((yn + bonus) * bf2f(Gb[o]));
    }
}
DI void rwkv_par_phase(const Args& a, int L, unsigned char* lds) {
    const int tidx_ = otid();
    const int tid = tidx_, wave = __builtin_amdgcn_readfirstlane(tid >> 6), lane = tid & 63, fr = lane & 15, q = lane >> 4;
    const bf16_t* P = (const bf16_t*)(a.ws + OFF_P); unsigned char* RECB = a.ws + OFF_SCR;
    const bf16_t* W2T = (const bf16_t*)(a.ws + OFF_LW2); const bf16_t* A2T = (const bf16_t*)(a.ws + OFF_LA2); const bf16_t* G2T = (const bf16_t*)(a.ws + OFF_LG2);
    const float* mu = a.in[I_MU] + (size_t)L * 3360; const float* w0 = a.in[I_W0] + L * RW; const float* a0 = a.in[I_A0] + L * RW;
    const float* kkw = a.in[I_KK] + L * RW; const float* kaw = a.in[I_KA] + L * RW; const float* rkw = a.in[I_RK] + L * RW;
    unsigned char* XL = lds;
    unsigned char* WS = lds + 9472 + wave * 12288;
    for (int unit = blockIdx.x; unit < NB * 256; unit += gridDim.x) {
        const int b_ = unit >> 8, cidx = unit & 255; const int m0 = b_ * SEQ + cidx * 16;
        __syncthreads();
        { const int t0 = 2 * wave; const int mrow = m0 + t0; const bool frow = (mrow & (SEQ - 1)) == 0;
          const bf16_t* prow = P + (size_t)mrow * PCOLS + PC_LORA; const bf16_t* pprev = frow ? prow : prow - PCOLS;
          bf16_t xp[5], x0[5], x1[5]; float muv[5];
#pragma unroll
          for (int p = 0; p < 5; ++p) { const int col = lane + 64 * p, colc = col < 288 ? col : 0; xp[p] = pprev[colc]; x0[p] = prow[colc]; x1[p] = prow[PCOLS + colc]; muv[p] = mu[3072 + colc]; }
#pragma unroll
          for (int p = 0; p < 5; ++p) { const int col = lane + 64 * p; const float c0 = bf2f(x0[p]), c1 = bf2f(x1[p]), pv = frow ? 0.f : bf2f(xp[p]);
              float y0 = c0 + (pv - c0) * muv[p], y1 = c1 + (c0 - c1) * muv[p];
              if (p == 0) { y0 = 1.0f - 2.0f * __builtin_amdgcn_rcpf(__expf(2.0f * y0) + 1.0f); y1 = 1.0f - 2.0f * __builtin_amdgcn_rcpf(__expf(2.0f * y1) + 1.0f); }
              else if (p >= 2) { y0 = __builtin_amdgcn_rcpf(1.0f + __expf(-y0)); y1 = __builtin_amdgcn_rcpf(1.0f + __expf(-y1)); }
              if (col < 288) { *(bf16_t*)(XL + t0 * 592 + col * 2) = (bf16_t)f2bf(y0); *(bf16_t*)(XL + (t0 + 1) * 592 + col * 2) = (bf16_t)f2bf(y1); } } }
        __syncthreads();
#define AXF(ks) (*(const bf16x8*)(XL + fr * 592 + (32 * (ks) + 8 * q) * 2))
#pragma unroll 1
        for (int hh2 = 0; hh2 < 2; ++hh2) {
            const int h = wave + 8 * hh2; const int c = h * 64 + lane;
            unsigned char* rec = RECB + (size_t)(cidx * 64 + b_ * 16 + h) * REC;
            const bool first = (m0 & (SEQ - 1)) == 0;
            const bf16_t* pbase = P + (size_t)m0 * PCOLS + h * 64;
            const float w0c = w0[c], a0c = a0[c], kkc = kkw[c], kac = kaw[c], rkc = rkw[c], mur = mu[c], muk = mu[1024 + c], muv = mu[2048 + c];
            bf16x8 bwf[4][2], baf[4][2];
#pragma unroll
            for (int nt = 0; nt < 4; ++nt) { const int cn = h * 64 + 16 * nt + fr;
#pragma unroll
                for (int ks = 0; ks < 2; ++ks) { bwf[nt][ks] = *(const bf16x8*)(W2T + cn * 64 + 32 * ks + 8 * q); baf[nt][ks] = *(const bf16x8*)(A2T + cn * 64 + 32 * ks + 8 * q); } }
            asm volatile("" ::: "memory");
            f32x4 accW[4], accA[4], accG[4];
#pragma unroll
            for (int nt = 0; nt < 4; ++nt) { accW[nt] = (f32x4){0.f, 0.f, 0.f, 0.f}; accA[nt] = accW[nt]; accG[nt] = accW[nt];
#pragma unroll
                for (int ks = 0; ks < 2; ++ks) { accW[nt] = __builtin_amdgcn_mfma_f32_16x16x32_bf16(AXF(ks), bwf[nt][ks], accW[nt], 0, 0, 0); accA[nt] = __builtin_amdgcn_mfma_f32_16x16x32_bf16(AXF(2 + ks), baf[nt][ks], accA[nt], 0, 0, 0); } }
#pragma unroll
            for (int n2 = 0; n2 < 2; ++n2) { bf16x8 bgf[2][5];
#pragma unroll
                for (int nn = 0; nn < 2; ++nn) { const int cn = h * 64 + 16 * (2 * n2 + nn) + fr;
#pragma unroll
                    for (int ks = 0; ks < 5; ++ks) bgf[nn][ks] = *(const bf16x8*)(G2T + cn * 160 + 32 * ks + 8 * q); }
                asm volatile("" ::: "memory");
#pragma unroll
                for (int nn = 0; nn < 2; ++nn)
#pragma unroll
                    for (int ks = 0; ks < 5; ++ks) accG[2 * n2 + nn] = __builtin_amdgcn_mfma_f32_16x16x32_bf16(AXF(4 + ks), bgf[nn][ks], accG[2 * n2 + nn], 0, 0, 0); }
            unsigned rawrk[17], rawvv[9];
#pragma unroll
            for (int t = 0; t < 17; ++t) { const bf16_t* pc = pbase + (ptrdiff_t)(t - 1) * PCOLS; const bool ok = t > 0 || !first;
                const unsigned rr_ = ok ? (unsigned)pc[PC_R + lane] : 0u, kk_ = ok ? (unsigned)pc[PC_K + lane] : 0u, vv_ = ok ? (unsigned)pc[PC_V + lane] : 0u;
                rawrk[t] = rr_ | (kk_ << 16); if (t & 1) rawvv[t >> 1] |= vv_ << 16; else rawvv[t >> 1] = vv_; }
            float* X3 = (float*)WS;
#pragma unroll
            for (int nt = 0; nt < 4; ++nt)
#pragma unroll
                for (int r = 0; r < 4; ++r) { const int o = (4 * q + r) * 64 + 16 * nt + fr; X3[o] = accW[nt][r]; X3[1024 + o] = accA[nt][r]; X3[2048 + o] = accG[nt][r]; }
            float cum[16], asg[16];
            { float run = 0.f;
#pragma unroll
              for (int t = 0; t < 16; ++t) { float dw = X3[t * 64 + lane], da = X3[1024 + t * 64 + lane], dg = X3[2048 + t * 64 + lane];
#if DBG_LORA
                  { const float* w2 = a.in[I_W2] + (size_t)L * 64 * RW; const float* a2 = a.in[I_A2] + (size_t)L * 64 * RW; const float* g2 = a.in[I_G2] + (size_t)L * 160 * RW;
                    float s0 = 0.f, s1 = 0.f, s2 = 0.f;
                    for (int jj = 0; jj < 64; ++jj) { s0 += bf2f(*(const bf16_t*)(XL + t * 592 + jj * 2)) * w2[(size_t)jj * RW + c]; s1 += bf2f(*(const bf16_t*)(XL + t * 592 + (64 + jj) * 2)) * a2[(size_t)jj * RW + c]; }
                    for (int jj = 0; jj < 160; ++jj) s2 += bf2f(*(const bf16_t*)(XL + t * 592 + (128 + jj) * 2)) * g2[(size_t)jj * RW + c];
                    dw = s0; da = s1; dg = s2; }
#endif
                  const float nx = -(w0c + dw);
                  run += -0.60653065971263342f * __builtin_amdgcn_rcpf(1.0f + __expf(nx)); cum[t] = run; asg[t] = __builtin_amdgcn_rcpf(1.0f + __expf(-(a0c + da)));
                  *(bf16_t*)(rec + R_G + (t * 64 + lane) * 2) = (bf16_t)f2bf(dg); } }
            asm volatile("" ::: "memory");
            const float gC = __expf(cum[15]); *(float*)(rec + R_GC + lane * 4) = gC;
            bf16_t* imgA = (bf16_t*)WS; bf16_t* imgR = (bf16_t*)(WS + 2304); bf16_t* imgB = (bf16_t*)(WS + 4608); bf16_t* imgK = (bf16_t*)(WS + 6912);
            float At[16]; unsigned vpk[8]; float bgv[4], kgv[4]; float vprev = 0.f;
            float rr[16], kkv[16], k2v[16], rsn, vp = bflo(rawvv[0]);
            { float sq[16], bo[16]; float rp = bflo(rawrk[0]), kp = bfhi(rawrk[0]);
#pragma unroll
              for (int t = 0; t < 16; ++t) { const float rc = bflo(rawrk[t + 1]), kc = bfhi(rawrk[t + 1]);
                  const float r = rc + (rp - rc) * mur, k = kc + (kp - kc) * muk; rp = rc; kp = kc;
                  const float kk = k * kkc, k2 = k * (1.0f + (asg[t] - 1.0f) * kac);
                  rr[t] = r; kkv[t] = kk; k2v[t] = k2; sq[t] = kk * kk; bo[t] = r * k2 * rkc; }
              const float sqs = rs16(sq, lane), bos = rs16(bo, lane);
              rsn = __builtin_amdgcn_rsqf(fmaxf(sqs, 1e-24f));
              if ((lane & 12) == 0) *(float*)(rec + R_BON + ((lane & 3) + 4 * (lane >> 4)) * 4) = bos; }
            float eprev = 1.0f;
#pragma unroll
            for (int t = 0; t < 16; ++t) {
                const float vc = ((t + 1) & 1) ? bfhi(rawvv[(t + 1) >> 1]) : bflo(rawvv[(t + 1) >> 1]);
                const float r = rr[t], v = vc + (vp - vc) * muv; vp = vc;
                const float asig = asg[t];
                const float kkn = kkv[t] * __int_as_float(__builtin_amdgcn_readlane(__float_as_int(rsn), (t & 3) + 16 * (t >> 2)));
                const float k2 = k2v[t]; const float av = -kkn, bv = kkn * asig;
                const float e2 = __expf(cum[t]), e3 = __expf(-cum[t]), e4 = gC * e3;
                At[t] = eprev * av; eprev = e2;
                const float Rt = e2 * r, Bt = bv * e3, Kt = k2 * e3;
                imgA[t * 72 + lane] = (bf16_t)f2bf(At[t]); imgR[t * 72 + lane] = (bf16_t)f2bf(Rt); imgB[t * 72 + lane] = (bf16_t)f2bf(Bt); imgK[t * 72 + lane] = (bf16_t)f2bf(Kt);
                *(bf16_t*)(rec + R_RL2 + t * RROW + lane * 2) = (bf16_t)f2bf(Rt);
                bgv[t & 3] = bv * e4; kgv[t & 3] = k2 * e4;
                if ((t & 3) == 3) { u32x4 o; o.x = pk2(bgv[0], bgv[1]); o.y = pk2(bgv[2], bgv[3]); o.z = pk2(kgv[0], kgv[1]); o.w = pk2(kgv[2], kgv[3]); *(u32x4*)(rec + R_A2 + (lane * 4 + (t >> 2)) * 16) = o; }
                if (t & 1) vpk[t >> 1] = pk2(vprev, v); else vprev = v; }
            { u32x4 o0, o1; o0.x = vpk[0]; o0.y = vpk[1]; o0.z = vpk[2]; o0.w = vpk[3]; o1.x = vpk[4]; o1.y = vpk[5]; o1.z = vpk[6]; o1.w = vpk[7];
              *(u32x4*)(rec + R_VT + lane * 32) = o0; *(u32x4*)(rec + R_VT + lane * 32 + 16) = o1; }
            asm volatile("" ::: "memory");
            f32x4 gAB = (f32x4){0.f, 0.f, 0.f, 0.f}, gAK = gAB, gBR = gAB, gKR = gAB;
#pragma unroll
            for (int ks = 0; ks < 2; ++ks) { const int off = fr * 72 + 32 * ks + 8 * q;
                const bf16x8 fA = *(const bf16x8*)(imgA + off), fR = *(const bf16x8*)(imgR + off), fB = *(const bf16x8*)(imgB + off), fK = *(const bf16x8*)(imgK + off);
                gAB = __builtin_amdgcn_mfma_f32_16x16x32_bf16(fB, fA, gAB, 0, 0, 0); gAK = __builtin_amdgcn_mfma_f32_16x16x32_bf16(fK, fA, gAK, 0, 0, 0);
                gBR = __builtin_amdgcn_mfma_f32_16x16x32_bf16(fB, fR, gBR, 0, 0, 0); gKR = __builtin_amdgcn_mfma_f32_16x16x32_bf16(fK, fR, gKR, 0, 0, 0); }
#pragma unroll
            for (int r = 0; r < 4; ++r) { const int sI = 4 * q + r; gAB[r] = sI < fr ? gAB[r] : 0.f; gAK[r] = sI < fr ? gAK[r] : 0.f; gBR[r] = sI <= fr ? gBR[r] : 0.f; gKR[r] = sI <= fr ? gKR[r] : 0.f; }
            { u32x4 o; o.x = pk2(gBR[0], gBR[1]); o.y = pk2(gBR[2], gBR[3]); o.z = pk2(gKR[0], gKR[1]); o.w = pk2(gKR[2], gKR[3]); *(u32x4*)(rec + R_A3 + (fr * 4 + q) * 16) = o; }
            asm volatile("" ::: "memory");
            float* AKL = (float*)(WS + 9216);
#pragma unroll
            for (int r = 0; r < 4; ++r) AKL[(4 * q + r) * 16 + fr] = gAK[r];
            float* ABL = (float*)(WS + 11264);
#pragma unroll
            for (int r = 0; r < 4; ++r) ABL[(4 * q + r) * 16 + fr] = gAB[r];
            float Ft[16];
            { const f32x4* row = (const f32x4*)(AKL + (lane & 15) * 16);
#pragma unroll
              for (int t4 = 0; t4 < 4; ++t4) { const f32x4 v4 = row[t4]; Ft[4 * t4] = v4[0]; Ft[4 * t4 + 1] = v4[1]; Ft[4 * t4 + 2] = v4[2]; Ft[4 * t4 + 3] = v4[3]; } }
#pragma unroll
            for (int s2 = 0; s2 < 15; ++s2) {
                const f32x2 src = {At[s2], Ft[s2]};
#pragma unroll
                for (int j = (s2 + 1) >> 2; j < 4; ++j) { const f32x4 sc4 = *(const f32x4*)(ABL + s2 * 16 + 4 * j);
#pragma unroll
                    for (int e = 0; e < 4; ++e) { const int t = 4 * j + e; if (t > s2) { const f32x2 scv = {sc4[e], sc4[e]}; f32x2 dst = {At[t], Ft[t]}; dst = __builtin_elementwise_fma(src, scv, dst); At[t] = dst[0]; Ft[t] = dst[1]; } } } }
#pragma unroll
            for (int t = 0; t < 16; ++t) *(bf16_t*)(rec + R_EL2 + t * RROW + lane * 2) = (bf16_t)f2bf(At[t]);
            asm volatile("" ::: "memory");
            float* FL = (float*)(WS + 10240);
            if (lane < 16) {
#pragma unroll
                for (int t4 = 0; t4 < 4; ++t4) *(f32x4*)(FL + lane * 16 + 4 * t4) = (f32x4){Ft[4 * t4], Ft[4 * t4 + 1], Ft[4 * t4 + 2], Ft[4 * t4 + 3]}; }
            { const float f0 = FL[(4 * q + 0) * 16 + fr], f1 = FL[(4 * q + 1) * 16 + fr], f2 = FL[(4 * q + 2) * 16 + fr], f3 = FL[(4 * q + 3) * 16 + fr];
              u32x2 o; o.x = pk2(f0, f1); o.y = pk2(f2, f3); *(u32x2*)(rec + R_FT + (fr * 4 + q) * 8) = o; }
            asm volatile("" ::: "memory");
        }
    }
#undef AXF
}
DI bf16x8 mk8(u32x2 lo, u32x2 hi) { u32x4 w; w.x = lo.x; w.y = lo.y; w.z = hi.x; w.w = hi.y; return __builtin_bit_cast(bf16x8, w); }
struct SeqOps { u32x2 e[2][2], r[2][2]; u32x4 a2[4]; u32x4 a3; u32x2 ft, vt; f32x4 gc[4]; };
DI void seq_ops_load(SeqOps& f, const LAS unsigned char* rec, int fr, int q, int i0) {
#pragma unroll
    for (int ks = 0; ks < 2; ++ks) { f.e[ks][0] = *(const LAS u32x2*)(rec + R_EL2 + fr * RROW + (32 * ks + 4 * q) * 2); f.e[ks][1] = *(const LAS u32x2*)(rec + R_EL2 + fr * RROW + (32 * ks + 16 + 4 * q) * 2);
        f.r[ks][0] = *(const LAS u32x2*)(rec + R_RL2 + fr * RROW + (32 * ks + 4 * q) * 2); f.r[ks][1] = *(const LAS u32x2*)(rec + R_RL2 + fr * RROW + (32 * ks + 16 + 4 * q) * 2); }
#pragma unroll
    for (int jt = 0; jt < 4; ++jt) { f.a2[jt] = *(const LAS u32x4*)(rec + R_A2 + ((16 * jt + fr) * 4 + q) * 16); f.gc[jt] = *(const LAS f32x4*)(rec + R_GC + (16 * jt + 4 * q) * 4); }
    f.a3 = *(const LAS u32x4*)(rec + R_A3 + (fr * 4 + q) * 16); f.ft = *(const LAS u32x2*)(rec + R_FT + (fr * 4 + q) * 8); f.vt = *(const LAS u32x2*)(rec + R_VT + ((i0 + fr) * 16 + 4 * q) * 2);
}
DI void rwkv_seq_phase(const Args& a, unsigned char* lds, float* yout, const float* gng, const float* gnb, bf16_t* yfin) {
    const int tidx_ = otid();
    const int tid = tidx_, wave = __builtin_amdgcn_readfirstlane(tid >> 6), lane = tid & 63, fr = lane & 15, q = lane >> 4;
    constexpr int NR = 8, DEPTH_ = 6, NCHK = 256;
    LAS unsigned char* ring = (LAS unsigned char*)lds;
    LAS float* ybuf = (LAS float*)(ring + NR * REC);
    for (int bh = blockIdx.x; bh < NB * 16; bh += gridDim.x) {
        const unsigned char* rec0 = a.ws + OFF_SCR + (size_t)bh * REC;
        const int hd = bh & 15;
        asm volatile("s_waitcnt vmcnt(0) lgkmcnt(0)" ::: "memory"); __builtin_amdgcn_s_barrier();
        if (wave >= 4) {
            const int lw = wave - 4;
            const float gg = yfin ? gng[hd * 64 + lane] : 0.f, gb = yfin ? gnb[hd * 64 + lane] : 0.f;
            bf16_t* Yo = yfin + ((size_t)(bh >> 4) * SEQ) * D + hd * 64 + lane;
#define SEQ_ISSUE(cc) do { const unsigned char* g_ = rec0 + (size_t)(cc) * 64 * REC; LAS unsigned char* l_ = ring + ((cc) & (NR - 1)) * REC; \
            _Pragma("unroll") for (int i_ = 0; i_ < 4; ++i_) { int pc_ = i_ * 4 + lw; if (pc_ >= 15) pc_ = lw; \
                __builtin_amdgcn_global_load_lds((const unsigned*)(g_ + pc_ * 1024 + lane * 16), (LAS unsigned*)(l_ + pc_ * 1024), 16, 0, 0); } } while (0)
#define SEQ_FINALIZE(cf) do { const LAS unsigned char* rc_ = ring + ((cf) & (NR - 1)) * REC; const LAS float* yb_ = ybuf + ((cf) & 1) * 1024; \
            const u32x2 vv_ = *(const LAS u32x2*)(rc_ + R_VT + (lane * 16 + 4 * lw) * 2); \
            float y_[4], rd_[8]; \
            _Pragma("unroll") for (int tt_ = 0; tt_ < 4; ++tt_) { y_[tt_] = yb_[(4 * lw + tt_) * 64 + lane]; rd_[tt_] = y_[tt_]; rd_[4 + tt_] = y_[tt_] * y_[tt_]; } \
              \
            float mean4_, rstd4_; \
            { float z_[4], w_[2]; \
              _Pragma("unroll") for (int i_ = 0; i_ < 4; ++i_) { auto p_ = __builtin_amdgcn_permlane32_swap(__float_as_uint(rd_[i_]), __float_as_uint(rd_[i_ + 4]), false, false); z_[i_] = __uint_as_float(p_[0]) + __uint_as_float(p_[1]); } \
              _Pragma("unroll") for (int i_ = 0; i_ < 2; ++i_) { auto p_ = __builtin_amdgcn_permlane16_swap(__float_as_uint(z_[i_]), __float_as_uint(z_[i_ + 2]), false, false); w_[i_] = __uint_as_float(p_[0]) + __uint_as_float(p_[1]); } \
              const bool b0_ = (lane & 1) != 0; float u_ = (b0_ ? w_[1] : w_[0]) + dpp_f<0xB1>(b0_ ? w_[0] : w_[1]); \
              u_ += dpp_f<0x122>(u_); u_ += dpp_f<0x124>(u_); u_ += dpp_f<0x128>(u_);        \
              auto q_ = __builtin_amdgcn_permlane32_swap(__float_as_uint(u_), __float_as_uint(u_), false, false);        \
              mean4_ = __uint_as_float(q_[0]) * (1.0f / 64.0f); rstd4_ = __builtin_amdgcn_rsqf(fmaxf(__uint_as_float(q_[1]) * (1.0f / 64.0f) - mean4_ * mean4_, 0.f) + 64e-5f); } \
            _Pragma("unroll") for (int tt_ = 0; tt_ < 4; ++tt_) { const int t_ = 4 * lw + tt_; \
                const float mean_ = __int_as_float(__builtin_amdgcn_readlane(__float_as_int(mean4_), (tt_ & 1) + 16 * (tt_ >> 1))), rs_ = __int_as_float(__builtin_amdgcn_readlane(__float_as_int(rstd4_), (tt_ & 1) + 16 * (tt_ >> 1))); \
                const float yn_ = (y_[tt_] - mean_) * rs_ * gg + gb; \
                const float bon_ = *(const LAS float*)(rc_ + R_BON + t_ * 4); const float g_ = bf2f(*(const LAS bf16_t*)(rc_ + R_G + (t_ * 64 + lane) * 2)); \
                const unsigned vw_ = (tt_ & 2) ? vv_.y : vv_.x; const float v_ = (tt_ & 1) ? bfhi(vw_) : bflo(vw_); \
                Yo[(size_t)(16 * (cf) + t_) * D] = (bf16_t)f2bf((yn_ + bon_ * v_) * g_); } } while (0)
#pragma unroll 1
            for (int cc = 0; cc < DEPTH_; ++cc) SEQ_ISSUE(cc);
            asm volatile("s_waitcnt vmcnt(16)" ::: "memory");
            __builtin_amdgcn_s_barrier();
#pragma unroll 1
            for (int c = 0; c < NCHK; ++c) {
                if (yfin && c > 0) SEQ_FINALIZE(c - 1);
                if (c + DEPTH_ < NCHK) { SEQ_ISSUE(c + DEPTH_); asm volatile("s_waitcnt vmcnt(16)" ::: "memory"); }
                else asm volatile("s_waitcnt vmcnt(0)" ::: "memory");
                asm volatile("s_waitcnt lgkmcnt(0)" ::: "memory");
                __builtin_amdgcn_s_barrier();
            }
            if (yfin) SEQ_FINALIZE(NCHK - 1);
#undef SEQ_ISSUE
#undef SEQ_FINALIZE
        } else {
            const int i0 = wave * 16;
            float* Yp = yout + (size_t)(bh >> 4) * SEQ * RW + hd * 64 + i0 + fr;
            f32x4 S[4];
#pragma unroll
            for (int jt = 0; jt < 4; ++jt) S[jt] = (f32x4){0.f, 0.f, 0.f, 0.f};
            __builtin_amdgcn_s_barrier();
#define SEQ_STEP(CUR, NXT, CC) do { const int c = (CC); \
                if (c + 1 < NCHK) seq_ops_load(NXT, ring + ((c + 1) & (NR - 1)) * REC, fr, q, i0); \
                bf16x8 sh[2]; \
_Pragma("unroll") \
                for (int ks = 0; ks < 2; ++ks) { u32x4 hw; hw.x = pk2(S[2 * ks][0], S[2 * ks][1]); hw.y = pk2(S[2 * ks][2], S[2 * ks][3]); hw.z = pk2(S[2 * ks + 1][0], S[2 * ks + 1][1]); hw.w = pk2(S[2 * ks + 1][2], S[2 * ks + 1][3]); sh[ks] = __builtin_bit_cast(bf16x8, hw); } \
                const u32x2 z2 = {0u, 0u}; const f32x4 zz = (f32x4){0.f, 0.f, 0.f, 0.f}; \
                f32x4 Wk[2], Yk[2]; \
_Pragma("unroll") \
                for (int ks = 0; ks < 2; ++ks) { Wk[ks] = __builtin_amdgcn_mfma_f32_16x16x32_bf16(mk8(CUR.e[ks][0], CUR.e[ks][1]), sh[ks], zz, 0, 0, 0); Yk[ks] = __builtin_amdgcn_mfma_f32_16x16x32_bf16(mk8(CUR.r[ks][0], CUR.r[ks][1]), sh[ks], zz, 0, 0, 0); } \
                const f32x4 Wv = __builtin_amdgcn_mfma_f32_16x16x32_bf16(mk8(CUR.ft, z2), mk8(CUR.vt, z2), zz, 0, 0, 0); \
                const f32x4 W = (Wk[0] + Wk[1]) + Wv; f32x4 Y = Yk[0] + Yk[1]; \
                u32x2 wp; wp.x = pk2(W[0], W[1]); wp.y = pk2(W[2], W[3]); \
                const bf16x8 b2 = mk8(wp, CUR.vt); \
_Pragma("unroll") \
                for (int jt = 0; jt < 4; ++jt) S[jt] = __builtin_amdgcn_mfma_f32_16x16x32_bf16(__builtin_bit_cast(bf16x8, CUR.a2[jt]), b2, S[jt] * CUR.gc[jt], 0, 0, 0); \
                Y = __builtin_amdgcn_mfma_f32_16x16x32_bf16(__builtin_bit_cast(bf16x8, CUR.a3), b2, Y, 0, 0, 0); \
                if (yfin) { \
_Pragma("unroll") \
                    for (int r = 0; r < 4; ++r) ybuf[(c & 1) * 1024 + (4 * q + r) * 64 + i0 + fr] = Y[r]; \
                } else { \
_Pragma("unroll") \
                    for (int r = 0; r < 4; ++r) Yp[(size_t)(16 * c + 4 * q + r) * RW] = Y[r]; \
                } \
                asm volatile("s_waitcnt lgkmcnt(0)" ::: "memory"); \
                __builtin_amdgcn_s_barrier(); \
            } while (0)
            SeqOps opA, opB; seq_ops_load(opA, ring, fr, q, i0);
#pragma unroll 1
            for (int c2 = 0; c2 < NCHK; c2 += 2) { SEQ_STEP(opA, opB, c2); SEQ_STEP(opB, opA, c2 + 1); }
#undef SEQ_STEP
        }
    }
}
DI void rwkv_fin2_phase(const Args& a, int L) {
    const int tidx_ = otid();
    const int wave = __builtin_amdgcn_readfirstlane(tidx_ >> 6), lane = tidx_ & 63;
    const float* Yraw = (const float*)(a.ws + OFF_X); bf16_t* Y = (bf16_t*)(a.ws + OFF_Y);
    const float* gng = a.in[I_GNG] + L * RW; const float* gnb = a.in[I_GNB] + L * RW;
    for (int u = blockIdx.x * 8 + wave; u < NB * 16 * 256; u += gridDim.x * 8) {
        const int cidx = u & 255, bh = u >> 8, h = bh & 15, b_ = bh >> 4; const int c = h * 64 + lane;
        const unsigned char* rec = a.ws + OFF_SCR + (size_t)(cidx * 64 + bh) * REC;
        const u32x4 v0 = *(const u32x4*)(rec + R_VT + lane * 32), v1 = *(const u32x4*)(rec + R_VT + lane * 32 + 16);
        const unsigned vw[8] = {v0.x, v0.y, v0.z, v0.w, v1.x, v1.y, v1.z, v1.w};
        const float gg = gng[c], gb = gnb[c];
#pragma unroll
        for (int t = 0; t < 16; ++t) { const size_t m = (size_t)b_ * SEQ + cidx * 16 + t;
            const float y = Yraw[m * RW + c];
            const float mean = wave_sum(y) * (1.0f / 64.0f); const float d = y - mean; const float var = wave_sum(d * d) * (1.0f / 64.0f);
            const float yn = d * __builtin_amdgcn_rsqf(var + 64e-5f) * gg + gb;
            const float bon = *(const float*)(rec + R_BON + t * 4); const float g = bf2f(*(const bf16_t*)(rec + R_G + (t * 64 + lane) * 2));
            const float v = (t & 1) ? bfhi(vw[t >> 1]) : bflo(vw[t >> 1]);
            Y[m * D + c] = (bf16_t)f2bf((yn + bon * v) * g); }
    }
}
DI void dbg_compare_phase(const Args& a) {
    const int tidx_ = otid();
    const float* y0 = (const float*)(a.ws + OFF_X); const float* y1 = y0 + (size_t)M * RW; float* acc = (float*)(a.ws + OFF_CTL) + 2048;
    float s0 = 0.f, s1 = 0.f, s2 = 0.f, s3 = 0.f;
    for (size_t i = (size_t)blockIdx.x * 512 + tidx_; i < (size_t)M * RW; i += (size_t)gridDim.x * 512) { const float o = y0[i], d = y1[i] - o; const int tok = (int)((i / RW) & (SEQ - 1));
        s0 += d * d; s1 += o * o; if (tok < 16) { s2 += d * d; s3 += o * o; } }
    s0 = wave_sum(s0); s1 = wave_sum(s1); s2 = wave_sum(s2); s3 = wave_sum(s3);
    if ((tidx_ & 63) == 0) { atomicAdd(acc + 0, s0); atomicAdd(acc + 1, s1); atomicAdd(acc + 2, s2); atomicAdd(acc + 3, s3); }
}
DI void dbg_encode_phase(const Args& a) {
    const int tidx_ = otid();
    float* acc = (float*)(a.ws + OFF_CTL) + 2048;
    const float s0 = __hip_atomic_load(acc + 0, __ATOMIC_RELAXED, __HIP_MEMORY_SCOPE_AGENT), s1 = __hip_atomic_load(acc + 1, __ATOMIC_RELAXED, __HIP_MEMORY_SCOPE_AGENT);
    const float s2 = __hip_atomic_load(acc + 2, __ATOMIC_RELAXED, __HIP_MEMORY_SCOPE_AGENT), s3 = __hip_atomic_load(acc + 3, __ATOMIC_RELAXED, __HIP_MEMORY_SCOPE_AGENT);
    const float e1 = sqrtf(s0 / fmaxf(s1, 1e-30f)), e2 = sqrtf(s2 / fmaxf(s3, 1e-30f));
    for (size_t i = (size_t)blockIdx.x * 512 + tidx_; i < (size_t)M * D; i += (size_t)gridDim.x * 512) { float v = a.out[i] * (1.0f + e1); if (i == 0) v += 1000.0f * e2; a.out[i] = v; }
}
DI unsigned f2ord(float f) { const unsigned u = __builtin_bit_cast(unsigned, f); return u ^ ((unsigned)((int)u >> 31) | 0x80000000u); }
DI float xrow16_sum(float x) {
    auto p = __builtin_amdgcn_permlane16_swap(__float_as_uint(x), __float_as_uint(x), false, false);
    x = __uint_as_float(p[0]) + __uint_as_float(p[1]);
    auto q = __builtin_amdgcn_permlane32_swap(__float_as_uint(x), __float_as_uint(x), false, false);
    return __uint_as_float(q[0]) + __uint_as_float(q[1]);
}
template <int CTRL> DI int dpp_i(int x) { return __builtin_amdgcn_update_dpp(0, x, CTRL, 0xF, 0xF, true); }
DI int wave_sum_i(int x) {
    x += dpp_i<0xB1>(x); x += dpp_i<0x4E>(x); x += dpp_i<0x141>(x); x += dpp_i<0x140>(x);
    auto p = __builtin_amdgcn_permlane16_swap((unsigned)x, (unsigned)x, false, false); x = (int)p[0] + (int)p[1];
    auto q = __builtin_amdgcn_permlane32_swap((unsigned)x, (unsigned)x, false, false); return (int)q[0] + (int)q[1];
}
DI void indexer_phase(const Args& a, unsigned char* lds, WorkQ& wq, int& item) {
    const int tidx_ = otid();
    const int tid = tidx_, wave = __builtin_amdgcn_readfirstlane(tid >> 6), lane = tid & 63, hh = lane & 15, kq = lane >> 4;
    const bf16_t* P = (const bf16_t*)(a.ws + OFF_P); const bf16_t* KI = (const bf16_t*)(a.ws + OFF_KI); unsigned long long* BMk = (unsigned long long*)(a.ws + OFF_BM);
    constexpr int STG = 256 * 128;
    unsigned long long* wbuf = (unsigned long long*)(lds + 2 * STG + wave * 512);
    const int srow = tid >> 3, sch = tid & 7;
    const int wr_off = srow * 128 + ((sch ^ (srow & 7)) << 4);
    const int rd0 = hh * 128 + ((kq ^ (hh & 7)) << 4), rd1 = hh * 128 + (((kq + 4) ^ (hh & 7)) << 4);
#pragma unroll 1
    for (; item < NB * 512; item = wq_next(wq, item, lds, tid)) {
        const int b_ = item & 3, qg = 511 - (item >> 2);
        const int t0 = qg * 8, t = t0 + wave, nk = t0 + 8; const size_t m = (size_t)b_ * SEQ + t;
        const int nst = (nk + 255) >> 8;
        bf16x8 aq[2];
        aq[0] = *(const bf16x8*)(P + m * PCOLS + PC_QI + hh * 64 + 8 * kq); aq[1] = *(const bf16x8*)(P + m * PCOLS + PC_QI + hh * 64 + 32 + 8 * kq);
        float blo[4], bhi[4];
#pragma unroll
        for (int r = 0; r < 4; ++r) { const bool pos = bf2f(P[m * PCOLS + PC_WI + 4 * kq + r]) >= 0.f; blo[r] = pos ? 0.f : -__builtin_inff(); bhi[r] = pos ? __builtin_inff() : 0.f; }
        { const float wrow = bf2f(P[m * PCOLS + PC_WI + hh]) * 0.03125f;
#pragma unroll
          for (int ks = 0; ks < 2; ++ks) { const u32x4 w4 = __builtin_bit_cast(u32x4, aq[ks]); u32x4 o4;
              o4.x = pk2(bflo(w4.x) * wrow, bfhi(w4.x) * wrow); o4.y = pk2(bflo(w4.y) * wrow, bfhi(w4.y) * wrow); o4.z = pk2(bflo(w4.z) * wrow, bfhi(w4.z) * wrow); o4.w = pk2(bflo(w4.w) * wrow, bfhi(w4.w) * wrow);
              aq[ks] = __builtin_bit_cast(bf16x8, o4); } }
        unsigned sc[64];
        const bf16_t* kig = KI + ((size_t)b_ * SEQ + srow) * 64 + sch * 8;
#pragma unroll 1
        for (int rep21 = 0; rep21 < ((REP_MASK >> 21) & 1u) + 1; ++rep21) {
#pragma unroll
        for (int r = 0; r < 64; ++r) sc[r] = 0u;
        u32x4 kp[4];
#pragma unroll
        for (int q = 0; q < 4; ++q) kp[q] = *(const u32x4*)(kig + (size_t)q * 64 * 64);
        __syncthreads();
        asm volatile("" :: "v"(aq[0]), "v"(aq[1]), "v"(blo[0]), "v"(blo[1]), "v"(blo[2]), "v"(blo[3]));
#pragma unroll
        for (int st = 0; st < 16; ++st) if (st < nst) {
            const int k0 = st * 256;
            unsigned char* sb = lds + (st & 1) * STG;
#pragma unroll
            for (int q = 0; q < 4; ++q) *(u32x4*)(sb + q * 64 * 128 + wr_off) = kp[q];
            __syncthreads();
            if (st + 1 < nst) {
#pragma unroll
                for (int q = 0; q < 4; ++q) kp[q] = *(const u32x4*)(kig + (size_t)(k0 + 256 + q * 64) * 64);
            }
#pragma unroll
            for (int cc = 0; cc < 4; ++cc) {
                const int kc = k0 + cc * 64;
                unsigned res = 0u;
                {
                    float sv[4];
#pragma unroll
                    for (int sub = 0; sub < 4; ++sub) {
                        const unsigned char* kb = sb + (cc * 64 + sub * 16) * 128;
                        const bf16x8 b0 = *(const bf16x8*)(kb + rd0), b1 = *(const bf16x8*)(kb + rd1);
                        f32x4 acc = (f32x4){0.f, 0.f, 0.f, 0.f};
                        acc = __builtin_amdgcn_mfma_f32_16x16x32_bf16(aq[0], b0, acc, 0, 0, 0);
                        acc = __builtin_amdgcn_mfma_f32_16x16x32_bf16(aq[1], b1, acc, 0, 0, 0);
                        sv[sub] = (__builtin_amdgcn_fmed3f(acc[0], blo[0], bhi[0]) + __builtin_amdgcn_fmed3f(acc[1], blo[1], bhi[1])) + (__builtin_amdgcn_fmed3f(acc[2], blo[2], bhi[2]) + __builtin_amdgcn_fmed3f(acc[3], blo[3], bhi[3]));
                    }
                    auto p01 = __builtin_amdgcn_permlane16_swap(__float_as_uint(sv[0]), __float_as_uint(sv[1]), false, false);
                    auto p23 = __builtin_amdgcn_permlane16_swap(__float_as_uint(sv[2]), __float_as_uint(sv[3]), false, false);
                    const float x01 = __uint_as_float(p01[0]) + __uint_as_float(p01[1]), x23 = __uint_as_float(p23[0]) + __uint_as_float(p23[1]);
                    auto pf = __builtin_amdgcn_permlane32_swap(__float_as_uint(x01), __float_as_uint(x23), false, false);
                    const float tot = __uint_as_float(pf[0]) + __uint_as_float(pf[1]);
                    res = f2ord(tot); if (st + 1 == nst) res = (kc + lane <= t) ? res : 0u;
                }
                sc[4 * st + cc] = res;
            }
        }
        }
        const int nuse = 4 * nst;
#pragma unroll 1
        for (int rep22 = 0; rep22 < ((REP_MASK >> 22) & 1u) + 1; ++rep22) {
        if (t + 1 > 256) {
            unsigned T = 0u; bool exact = false;
#pragma unroll 1
            for (int bit = 31; bit >= 0; --bit) { const unsigned cand = T | (1u << bit); int cnt = 0; unsigned candv = cand; asm volatile("" : "+v"(candv));
#pragma unroll
                for (int r8 = 0; r8 < 8; ++r8) if (r8 * 8 < nuse) {
                    unsigned long long mk_[8];
                    asm("v_cmp_ge_u32_e64 %0, %8, %16\n\tv_cmp_ge_u32_e64 %1, %9, %16\n\tv_cmp_ge_u32_e64 %2, %10, %16\n\tv_cmp_ge_u32_e64 %3, %11, %16\n\tv_cmp_ge_u32_e64 %4, %12, %16\n\tv_cmp_ge_u32_e64 %5, %13, %16\n\tv_cmp_ge_u32_e64 %6, %14, %16\n\tv_cmp_ge_u32_e64 %7, %15, %16"
                        : "=&s"(mk_[0]), "=&s"(mk_[1]), "=&s"(mk_[2]), "=&s"(mk_[3]), "=&s"(mk_[4]), "=&s"(mk_[5]), "=&s"(mk_[6]), "=&s"(mk_[7])
                        : "v"(sc[r8 * 8 + 0]), "v"(sc[r8 * 8 + 1]), "v"(sc[r8 * 8 + 2]), "v"(sc[r8 * 8 + 3]), "v"(sc[r8 * 8 + 4]), "v"(sc[r8 * 8 + 5]), "v"(sc[r8 * 8 + 6]), "v"(sc[r8 * 8 + 7]), "v"(candv));
#pragma unroll
                    for (int r = 0; r < 8; ++r) cnt += __builtin_popcountll(mk_[r]); }
                if (cnt >= 256) T = cand;
                if (cnt == 256) { exact = true; break; } }
            int cge = 256;
            if (!exact) { cge = 0;
#pragma unroll
                for (int r8 = 0; r8 < 8; ++r8) if (r8 * 8 < nuse) {
#pragma unroll
                    for (int r = 0; r < 8; ++r) cge += __builtin_popcountll(__ballot(sc[r8 * 8 + r] >= T)); } }
            { unsigned long long z64 = 0ull; asm volatile("" : "+v"(z64)); wbuf[lane] = z64; }
            if (cge == 256) {
#pragma unroll
                for (int r8 = 0; r8 < 8; ++r8) {
#pragma unroll
                    for (int r = 0; r < 8; ++r) { const unsigned long long word = __ballot(sc[r8 * 8 + r] >= T); if (lane == 0 && r8 * 8 + r < nuse) wbuf[r8 * 8 + r] = word; }
                    __builtin_amdgcn_sched_barrier(0); }
            } else {
                int cgt = 0;
#pragma unroll
                for (int r8 = 0; r8 < 8; ++r8) {
#pragma unroll
                    for (int r = 0; r < 8; ++r) cgt += __builtin_popcountll(__ballot(sc[r8 * 8 + r] > T));
                    __builtin_amdgcn_sched_barrier(0); }
                int need = 256 - cgt;
#pragma unroll
                for (int r8 = 0; r8 < 8; ++r8) {
#pragma unroll
                    for (int r = 0; r < 8; ++r) { const unsigned long long gt = __ballot(sc[r8 * 8 + r] > T); unsigned long long eq = __ballot(sc[r8 * 8 + r] == T); const int ce = __builtin_popcountll(eq);
                        unsigned long long take;
                        if (ce <= need) { take = eq; need -= ce; }
                        else { take = 0ull; for (; need > 0; --need) { const unsigned long long low = eq & (0ull - eq); take |= low; eq ^= low; } }
                        const unsigned long long word = gt | take; if (lane == 0 && r8 * 8 + r < nuse) wbuf[r8 * 8 + r] = word; }
                    __builtin_amdgcn_sched_barrier(0); }
            }
        } else {
            { unsigned long long z64 = 0ull; asm volatile("" : "+v"(z64)); wbuf[lane] = z64; }
#pragma unroll
            for (int r8 = 0; r8 < 8; ++r8) {
#pragma unroll
                for (int r = 0; r < 8; ++r) { const unsigned long long word = __ballot(sc[r8 * 8 + r] != 0u); if (lane == 0 && r8 * 8 + r < nuse) wbuf[r8 * 8 + r] = word; }
                __builtin_amdgcn_sched_barrier(0); }
        }
        }
        BMk[m * 64 + lane] = wbuf[lane];
    }
}
DI void attn_phase(const Args& a, unsigned char* lds) {
    const int tidx_ = otid();
    const int tid = tidx_, wave = __builtin_amdgcn_readfirstlane(tid >> 6), lane = tid & 63, ql = lane & 31, hf = lane >> 5;
    const bf16_t* P = (const bf16_t*)(a.ws + OFF_P); const bf16_t* VT = (const bf16_t*)(a.ws + OFF_VT); const unsigned long long* BMk = (const unsigned long long*)(a.ws + OFF_BM);
    const float* biasd = (const float*)(a.ws + OFF_BIAS); bf16_t* Y = (bf16_t*)(a.ws + OFF_Y);
    unsigned char* Kl = lds; unsigned char* Vl = lds + 64 * 144; float* biasl = (float*)(lds + 2 * 64 * 144);
    const float NEG_INF = -__builtin_inff();
    for (int cu = blockIdx.x; cu < 256; cu += gridDim.x)
#pragma unroll 1
    for (int ui = 0; ui < 2; ++ui) {
        const int bh = cu >> 3, s8 = cu & 7, qb = ui == 0 ? s8 : 15 - s8, b_ = bh >> 3, h = bh & 7;
        const int q0w = qb * 256 + 32 * wave, q = q0w + ql; const size_t m = (size_t)b_ * SEQ + q;
        __syncthreads();
        if (tid < 128) biasl[tid] = biasd[h * 128 + tid];
        bf16x8 qf[4];
#pragma unroll
        for (int ks = 0; ks < 4; ++ks) qf[ks] = *(const bf16x8*)(P + m * PCOLS + PC_AQ + h * 64 + 16 * ks + 8 * hf);
        f32x16 O0, O1;
#pragma unroll
        for (int r = 0; r < 16; ++r) { O0[r] = 0.f; O1[r] = 0.f; }
        float mrun = NEG_INF, lrun = 0.f;
        const int nkt = 4 * (qb + 1);
        const int srow = tid >> 3, sch = tid & 7;
        const bf16_t* kbase = P + ((size_t)b_ * SEQ + srow) * PCOLS + PC_AK + h * 64 + sch * 8;
        const bf16_t* vbase = VT + ((size_t)(b_ * 8 + h) * 64 + srow) * SEQ + sch * 8;
#define ATT_COMPUTE \
            const int k0 = kt * 64; \
            if (k0 <= q0w + 31) { \
 \
                f32x16 sa[2]; \
                const f32x16 zero16 = {0.f, 0.f, 0.f, 0.f, 0.f, 0.f, 0.f, 0.f, 0.f, 0.f, 0.f, 0.f, 0.f, 0.f, 0.f, 0.f};        \
_Pragma("unroll") \
                for (int ks = 0; ks < 4; ++ks) \
_Pragma("unroll") \
                    for (int sub = 0; sub < 2; ++sub) { const bf16x8 kf = *(const bf16x8*)(Kl + (32 * sub + ql) * 144 + (16 * ks + 8 * hf) * 2); \
                        sa[sub] = __builtin_amdgcn_mfma_f32_32x32x16_bf16(kf, qf[ks], ks == 0 ? zero16 : sa[sub], 0, 0, 0); } \
                constexpr float C1 = 0.125f * 1.4426950408889634f; \
                  \
                const float b31f = biasl[127] * 1.4426950408889634f; \
                const bool far = (q0w - (k0 + 63)) >= 113; \
                float mx = NEG_INF;        \
                if (far) { \
_Pragma("unroll") \
                    for (int sub = 0; sub < 2; ++sub) \
_Pragma("unroll") \
                        for (int r = 0; r < 16; r += 2) mx = fmaxf(mx, fmaxf(sa[sub][r], sa[sub][r + 1])); \
                    mx = mx * C1 + b31f; \
                } else { \
_Pragma("unroll") \
                    for (int sub = 0; sub < 2; ++sub) { \
_Pragma("unroll") \
                        for (int r = 0; r < 16; ++r) { const int ro = (r & 3) + 8 * (r >> 2); int dd = q - (k0 + 32 * sub + ro + 4 * hf); dd = dd < 0 ? 0 : (dd > 127 ? 127 : dd); \
                            sa[sub][r] = sa[sub][r] * C1 + biasl[dd] * 1.4426950408889634f; } \
_Pragma("unroll") \
                        for (int r = 0; r < 16; r += 2) mx = fmaxf(mx, fmaxf(sa[sub][r], sa[sub][r + 1])); \
                    } \
                } \
                { auto pm = __builtin_amdgcn_permlane32_swap(__float_as_uint(mx), __float_as_uint(mx), false, false); mx = fmaxf(__uint_as_float(pm[0]), __uint_as_float(pm[1])); } \
                const float mnew = fmaxf(mrun, mx); const float msafe = mnew; \
                float lsum = 0.f; \
                const float cb = b31f - msafe; \
                if (far) { \
_Pragma("unroll") \
                    for (int sub = 0; sub < 2; ++sub) \
_Pragma("unroll") \
                        for (int r = 0; r < 16; ++r) sa[sub][r] = sa[sub][r] * C1 + cb; \
                } else { \
_Pragma("unroll") \
                    for (int sub = 0; sub < 2; ++sub) \
_Pragma("unroll") \
                        for (int r = 0; r < 16; ++r) sa[sub][r] -= msafe; \
                } \
_Pragma("unroll") \
                for (int sub = 0; sub < 2; ++sub) { \
                    const int w32 = (int)(((unsigned)(bm >> (32 * sub))) >> (4 * hf)); \
_Pragma("unroll") \
                    for (int r = 0; r < 16; ++r) { const int ro = (r & 3) + 8 * (r >> 2); unsigned tm = (unsigned)__builtin_amdgcn_sbfe(w32, ro, 1); asm volatile("" : "+v"(tm));        \
                        sa[sub][r] = __uint_as_float(__float_as_uint(__builtin_amdgcn_exp2f(sa[sub][r])) & tm); lsum += sa[sub][r]; } } \
                if (__builtin_amdgcn_ballot_w64(mnew > mrun) != 0ull) { \
                    const float alpha = __builtin_amdgcn_exp2f(mrun - msafe); \
                    lrun = lrun * alpha + lsum; mrun = mnew; \
_Pragma("unroll") \
                    for (int r = 0; r < 16; ++r) { O0[r] *= alpha; O1[r] *= alpha; } \
                } else lrun += lsum; \
_Pragma("unroll") \
                for (int sub = 0; sub < 2; ++sub) \
_Pragma("unroll") \
                    for (int s = 0; s < 2; ++s) { \
                        u32x4 pw; pw.x = pk2(sa[sub][8 * s + 0], sa[sub][8 * s + 1]); pw.y = pk2(sa[sub][8 * s + 2], sa[sub][8 * s + 3]); pw.z = pk2(sa[sub][8 * s + 4], sa[sub][8 * s + 5]); pw.w = pk2(sa[sub][8 * s + 6], sa[sub][8 * s + 7]); \
                        const bf16x8 pf = __builtin_bit_cast(bf16x8, pw); \
                        const int kcol = (32 * sub + 16 * s + 4 * hf) * 2; \
                        { const u32x2 lo = *(const u32x2*)(Vl + ql * 144 + kcol), hi = *(const u32x2*)(Vl + ql * 144 + kcol + 16); \
                          u32x4 vw; vw.x = lo.x; vw.y = lo.y; vw.z = hi.x; vw.w = hi.y; \
                          O0 = __builtin_amdgcn_mfma_f32_32x32x16_bf16(__builtin_bit_cast(bf16x8, vw), pf, O0, 0, 0, 0); } \
                        { const u32x2 lo = *(const u32x2*)(Vl + (32 + ql) * 144 + kcol), hi = *(const u32x2*)(Vl + (32 + ql) * 144 + kcol + 16); \
                          u32x4 vw; vw.x = lo.x; vw.y = lo.y; vw.z = hi.x; vw.w = hi.y; \
                          O1 = __builtin_amdgcn_mfma_f32_32x32x16_bf16(__builtin_bit_cast(bf16x8, vw), pf, O1, 0, 0, 0); } \
                    } \
            } \

        u32x4 kregA = *(const u32x4*)(kbase), vregA = *(const u32x4*)(vbase); unsigned long long bmA = BMk[m * 64];
        u32x4 kregB = *(const u32x4*)(kbase + (size_t)64 * PCOLS), vregB = *(const u32x4*)(vbase + 64); unsigned long long bmB = BMk[m * 64 + 1];
        asm volatile("" :: "v"(qf[0]), "v"(qf[1]), "v"(qf[2]), "v"(qf[3]));
#define ATT_TILE(KREG, VREG, BMR, KT) do { const int kt = (KT); \
            __syncthreads(); \
            *(u32x4*)(Kl + srow * 144 + sch * 16) = KREG; *(u32x4*)(Vl + srow * 144 + sch * 16) = VREG; \
            __syncthreads(); \
            const unsigned long long bm = BMR; \
            if (kt + 2 < nkt) { KREG = *(const u32x4*)(kbase + (size_t)(kt + 2) * 64 * PCOLS); VREG = *(const u32x4*)(vbase + (kt + 2) * 64); BMR = BMk[m * 64 + kt + 2]; } \
            ATT_COMPUTE } while (0)
#pragma unroll 1
        for (int kt2 = 0; kt2 < nkt; kt2 += 2) { ATT_TILE(kregA, vregA, bmA, kt2); ATT_TILE(kregB, vregB, bmB, kt2 + 1); }
#undef ATT_TILE
#undef ATT_COMPUTE
        float ltot; { auto pl = __builtin_amdgcn_permlane32_swap(__float_as_uint(lrun), __float_as_uint(lrun), false, false); ltot = __uint_as_float(pl[0]) + __uint_as_float(pl[1]); } const float inv = 1.0f / ltot;
        bf16_t* yo = Y + m * D + 1536 + h * 64;
#pragma unroll
        for (int g4 = 0; g4 < 4; ++g4) { const int d0 = 8 * g4 + 4 * hf;
            u32x2 o0; o0.x = pk2(O0[4 * g4 + 0] * inv, O0[4 * g4 + 1] * inv); o0.y = pk2(O0[4 * g4 + 2] * inv, O0[4 * g4 + 3] * inv); *(u32x2*)(yo + d0) = o0;
            u32x2 o1; o1.x = pk2(O1[4 * g4 + 0] * inv, O1[4 * g4 + 1] * inv); o1.y = pk2(O1[4 * g4 + 2] * inv, O1[4 * g4 + 3] * inv); *(u32x2*)(yo + 32 + d0) = o1; }
    }
}

constexpr int NPH = 16;
constexpr int NGP = 1 + DEPTH * NPH;
__global__ void __launch_bounds__(512, 2) fwd(Args args) {
    extern __shared__ __attribute__((aligned(16))) unsigned char lds[];
    const int tid = threadIdx.x;
    volatile LAS unsigned* MISC = (volatile LAS unsigned*)((LAS unsigned char*)lds + MISC_OFF);
    for (int u = tid; u < (LDS_BYTES - 131072) / 4; u += 512) ((LAS unsigned*)((LAS unsigned char*)lds + 131072))[u] = 0u;
    __syncthreads();
    unsigned char* ws = args.ws;
    XcdBarrier bar; bar.bar = (unsigned*)(ws + OFF_CTL) + 4096; bar.x = 0; bar.st = nullptr;
    if (!MK_PER_PHASE) bar = xcd_barrier_post((unsigned*)(ws + OFF_CTL) + 4096, MISC + 8);
    const int lo = args.lo, hi = args.hi;
    LAS unsigned char* ldsl = (LAS unsigned char*)lds;
    bf16_t* XB = (bf16_t*)(ws + OFF_XB); float* X = (float*)(ws + OFF_X); float* T = (float*)(ws + OFF_T); float* ST = (float*)(ws + OFF_ST); bf16_t* Pb = (bf16_t*)(ws + OFF_P);
    bf16_t* H = (bf16_t*)(ws + OFF_SCR); bf16_t* Yb = (bf16_t*)(ws + OFF_Y); bf16_t* MG = (bf16_t*)(ws + OFF_MG);
    int gp = 0;
#define RUN() (lo <= gp && gp < hi)
#define SEAM() do { if (RUN() && gp + 1 < hi) xcd_barrier(bar); ++gp; } while (0)
#define PHASE(k, ...) do { if (PHON(k) && RUN()) { __VA_ARGS__; if ((REP_MASK >> (k)) & 1u) { xcd_barrier(bar); __VA_ARGS__; } } SEAM(); } while (0)
    if (RUN()) init_phase(args);
    SEAM();
    int p7n = 0;
#pragma unroll 1
    for (int L = 0; L < DEPTH; ++L) {
        const size_t walt = (L & 1) ? ALT_SHIFT : 0;
        if (L == 0 || !HETERO) PHASE(0, convert_phase(args, L, lds, blockIdx.x, gridDim.x);); else ++gp;
        PHASE(1, { pg8::Gemm g{XB, (const bf16_t*)(ws + OFF_W1A), D, D}; pg8::StaticOrder S; S.init(M, 2 * FF, D, gridDim.x, blockIdx.x); pg8::EpiSwiglu E{H, FF}; pg8::gemm_phase(ldsl, g, S, E); });
        PHASE(2, { pg8::Gemm g{H, (const bf16_t*)(ws + OFF_W1B), FF, FF}; pg8::StaticOrder S; S.init(M, D, FF, gridDim.x, blockIdx.x); pg8::EpiRes E{args.in[I_X], L == 0 ? nullptr : ST, args.in[I_LN3G] + (L > 0 ? (L - 1) * D : 0), args.in[I_LN3B] + (L > 0 ? (L - 1) * D : 0), T, D, ALPHA, 0.5f}; pg8::gemm_phase(ldsl, g, S, E); });
        PHASE(3, ln_phase(T, args.in[I_LN1G] + L * D, args.in[I_LN1B] + L * D, ST, XB, nullptr););
        PHASE(4, { pg8::Gemm g{XB, (const bf16_t*)(ws + OFF_WIN), D, D}; pg8::StaticOrder S; S.init(M, NP, D, gridDim.x, blockIdx.x); pg8::EpiBf16 E{Pb, PCOLS, (bf16_t*)(ws + OFF_GATES)}; pg8::gemm_phase(ldsl, g, S, E); });
        PHASE(5, { kidx_vt_phase(args, L, lds); if (REP_MASK & (1u << 23)) kidx_vt_phase(args, L, lds); if (RWKV_CHUNKED && !DBG_RWKV) { rwkv_par_phase(args, L, lds); if (REP_MASK & (1u << 24)) rwkv_par_phase(args, L, lds); } else rwkv_prep_phase(args, L, lds); });
        if (!HETERO) PHASE(6, { WorkQ wq{nullptr, 0, 0, (int)gridDim.x}; int item = blockIdx.x; sgu_phase(args, L, lds, wq, item, 0); }); else ++gp;
        PHASE(7, { if (DBG_RWKV) { scan_phase(args, lds); xcd_barrier(bar); rwkv_par_phase(args, L, lds); xcd_barrier(bar); rwkv_seq_phase(args, lds, X + (size_t)M * RW, nullptr, nullptr, nullptr); xcd_barrier(bar); dbg_compare_phase(args); }
                   else if (HETERO) {
                       if ((int)blockIdx.x < 64) { rwkv_seq_phase(args, lds, X, args.in[I_GNG] + L * RW, args.in[I_GNB] + L * RW, Yb); if (REP_MASK & (1u << 20)) rwkv_seq_phase(args, lds, X, args.in[I_GNG] + L * RW, args.in[I_GNB] + L * RW, Yb); }
                       else if ((int)blockIdx.x < 64 + NCVT && L + 1 < DEPTH) { convert_phase(args, L + 1, lds, blockIdx.x - 64, NCVT); __syncthreads(); }
                       WorkQ wq{(unsigned*)(ws + OFF_CTL + 524288) + (p7n++) * 64, 0, 0, 0}; int item = wq_first(wq, lds, otid());
                       indexer_phase(args, lds, wq, item); sgu_phase(args, L, lds, wq, item, NB * 512); }
                   else if (RWKV_CHUNKED) rwkv_seq_phase(args, lds, X, nullptr, nullptr, nullptr); else scan_phase(args, lds); });
        if (!HETERO) PHASE(8, { WorkQ wq{nullptr, 0, 0, (int)gridDim.x}; int item = blockIdx.x; indexer_phase(args, lds, wq, item); if (RWKV_CHUNKED) rwkv_fin2_phase(args, L); else rwkv_fin_phase(args, L); }); else ++gp;
        PHASE(9, { attn_phase(args, lds); });
        PHASE(10, { pg8::Gemm g{Yb, (const bf16_t*)(ws + OFF_WBR + walt), D, D}; pg8::BranchOrder S; S.init(M, D, D, gridDim.x, blockIdx.x); pg8::EpiBranch E{(const bf16_t*)(ws + OFF_GATES), args.in[I_BGATE] + (size_t)L * 3 * D, MG}; pg8::gemm_phase(ldsl, g, S, E); });
        PHASE(11, { pg8::Gemm g{MG, (const bf16_t*)(ws + OFF_WO + walt), D, D}; pg8::StaticOrder S; S.init(M, D, D, gridDim.x, blockIdx.x); pg8::EpiRes E{nullptr, ST, args.in[I_LN1G] + L * D, args.in[I_LN1B] + L * D, T, D, ALPHA, 1.0f}; pg8::gemm_phase(ldsl, g, S, E); });
        PHASE(12, ln_phase(T, args.in[I_LN2G] + L * D, args.in[I_LN2B] + L * D, ST, XB, nullptr););
        PHASE(13, { pg8::Gemm g{XB, (const bf16_t*)(ws + OFF_W2A + walt), D, D}; pg8::StaticOrder S; S.init(M, 2 * FF, D, gridDim.x, blockIdx.x); pg8::EpiSwiglu E{H, FF}; pg8::gemm_phase(ldsl, g, S, E); });
        PHASE(14, { pg8::Gemm g{H, (const bf16_t*)(ws + OFF_W2B + walt), FF, FF}; pg8::StaticOrder S; S.init(M, D, FF, gridDim.x, blockIdx.x); pg8::EpiRes E{nullptr, ST, args.in[I_LN2G] + L * D, args.in[I_LN2B] + L * D, T, D, ALPHA, 0.5f}; pg8::gemm_phase(ldsl, g, S, E); });
        PHASE(15, ln_phase(T, args.in[I_LN3G] + L * D, args.in[I_LN3B] + L * D, ST, XB, L == DEPTH - 1 ? args.out : nullptr););
        if (REP_MASK & (1u << 25)) { for (int xb = 0; xb < 10; ++xb) xcd_barrier(bar); }
    }
    if (DBG_RWKV) { xcd_barrier(bar); dbg_encode_phase(args); }
#undef RUN
#undef SEAM
#undef PHASE
}

extern "C" void kernel_launch(void* const* d_in, const int* in_sizes, int n_in, void* d_out, int out_size, void* d_ws, size_t ws_size, hipStream_t stream) {
    static int grid = 0;
    if (grid == 0) {
        if (n_in != 33 || out_size != M * D || ws_size < WS_END) { fprintf(stderr, "kernel_launch: unexpected shapes (n_in %d out %d ws %zu, need %zu)\n", n_in, out_size, ws_size, (size_t)WS_END); grid = -1; return; }
        int dev = 0, cus = 0;
        if (hipGetDevice(&dev) != hipSuccess || hipDeviceGetAttribute(&cus, hipDeviceAttributeMultiprocessorCount, dev) != hipSuccess) { grid = -1; return; }
        if (hipFuncSetAttribute((const void*)fwd, hipFuncAttributeMaxDynamicSharedMemorySize, LDS_BYTES) != hipSuccess) { fprintf(stderr, "kernel_launch: hipFuncSetAttribute failed\n"); grid = -1; return; }
        int per_cu = 0; (void)hipOccupancyMaxActiveBlocksPerMultiprocessor(&per_cu, (const void*)fwd, 512, LDS_BYTES); (void)hipGetLastError();
        grid = cus;
    }
    if (grid < 0) return;
    (void)hipMemsetAsync((char*)d_ws + OFF_CTL, 0, CTL_BYTES, stream);
    Args a{};
    for (int i = 0; i < 33; ++i) a.in[i] = (const float*)d_in[i];
    a.out = (float*)d_out; a.ws = (unsigned char*)d_ws;
#if MK_PER_PHASE
    for (int p = 0; p < NGP; ++p) { a.lo = p; a.hi = p + 1; hipLaunchKernelGGL(fwd, dim3(grid), dim3(512), LDS_BYTES, stream, a); }
#else
    a.lo = 0; a.hi = NGP;
    hipLaunchKernelGGL(fwd, dim3(grid), dim3(512), LDS_BYTES, stream, a);
#endif
}
```

```cpp
#include <hip/hip_runtime.h>
#include <cstdio>
#include <cstdint>

#ifndef MK_PER_PHASE
#define MK_PER_PHASE 0
#endif
#ifndef PH_MASK
#define PH_MASK 0xFFFFFFFFu
#endif
#define PHON(k) (((PH_MASK) >> (k)) & 1u)
#ifndef RWKV_CHUNKED
#define RWKV_CHUNKED 1
#endif
#ifndef DBG_RWKV
#define DBG_RWKV 0
#endif
#ifndef DBG_LORA
#define DBG_LORA 0
#endif
#ifndef HETERO
#define HETERO 1
#endif
#ifndef SEQ_HILO
#define SEQ_HILO 0
#endif
#ifndef SGU_SPLIT
#define SGU_SPLIT 256
#endif
#ifndef REP_MASK
#define REP_MASK 0u
#endif

#define LAS __attribute__((address_space(3)))
#define DI __device__ __forceinline__
typedef unsigned short bf16_t;
typedef short bf16x8 __attribute__((ext_vector_type(8)));
typedef float f32x4 __attribute__((ext_vector_type(4)));
typedef float f32x2 __attribute__((ext_vector_type(2)));
typedef float f32x16 __attribute__((ext_vector_type(16)));
typedef unsigned u32x4 __attribute__((ext_vector_type(4)));
typedef unsigned u32x2 __attribute__((ext_vector_type(2)));
typedef __bf16 bf16x2_t __attribute__((ext_vector_type(2)));

constexpr int NB = 4, SEQ = 4096, M = NB * SEQ, D = 2048, FF = 5632, DEPTH = 4;
constexpr int RW = 1024;
constexpr int NP = 13312;
constexpr int PCOLS = 7168;
constexpr int DIN = 13168;
constexpr int GN_GATE = 6656, GN_LORA = 12800, GN_KI = 13088, GN_WI = 13152;
constexpr int PC_R = 0, PC_K = 1024, PC_V = 2048, PC_SGU = 3072, PC_SGV = 3584, PC_AQ = 4096, PC_AK = 4608, PC_AV = 5120, PC_QI = 5632, PC_LORA = 6656, PC_KI = 6944, PC_WI = 7008;
constexpr float ALPHA = 1.6817928305074290f;
constexpr float LN_EPS = 1e-5f;

constexpr size_t MiB = 1u << 20;
constexpr size_t OFF_CTL = 0, CTL_BYTES = 1 * MiB;
constexpr size_t OFF_BIAS = 1 * MiB;
constexpr size_t OFF_ST = OFF_BIAS + 786432;
constexpr size_t OFF_LW2 = OFF_BIAS + 65536, OFF_LA2 = OFF_LW2 + 131072, OFF_LG2 = OFF_LA2 + 131072;
constexpr int REC = 15360, RROW = 144, R_EL2 = 0, R_RL2 = 2304, R_A2 = 4608, R_A3 = 8704, R_FT = 9728, R_VT = 10240, R_GC = 12288, R_G = 12544, R_BON = 14592;
constexpr size_t OFF_W1A = 2 * MiB;
constexpr size_t OFF_W1B = OFF_W1A + 44 * MiB;
constexpr size_t OFF_WIN = OFF_W1B + 22 * MiB;
constexpr size_t OFF_WBR = OFF_WIN + 52 * MiB;
constexpr size_t OFF_WO  = OFF_WBR + 8 * MiB;
constexpr size_t OFF_W2A = OFF_WO + 8 * MiB;
constexpr size_t OFF_W2B = OFF_W2A + 44 * MiB;
constexpr size_t OFF_X   = OFF_W2B + 22 * MiB;
constexpr size_t OFF_T   = OFF_X + 128 * MiB;
constexpr size_t OFF_XB  = OFF_T + 128 * MiB;
constexpr size_t OFF_P   = OFF_XB + 64 * MiB;
constexpr size_t OFF_GATES = OFF_P + 224 * MiB;
constexpr size_t OFF_SCR = OFF_GATES + 192 * MiB;
constexpr size_t OFF_Y   = OFF_SCR + 416 * MiB;
constexpr size_t OFF_MG  = OFF_Y + 64 * MiB;
constexpr size_t OFF_BM  = OFF_MG + 64 * MiB;
constexpr size_t OFF_KI  = OFF_BM + 8 * MiB;
constexpr size_t OFF_VT  = OFF_KI + 2 * MiB;
constexpr size_t OFF_ALT = OFF_VT + 16 * MiB;
constexpr size_t ALT_SHIFT = OFF_ALT - OFF_WBR;
constexpr size_t WS_END  = OFF_ALT + 82 * MiB;
constexpr int NCVT = 64;

constexpr int LDS_BYTES = 147456;
constexpr int MISC_OFF = 131072 + 320;

DI unsigned f2bf(float f);
DI float bf2f(unsigned short b) { return __builtin_bit_cast(float, ((unsigned)b) << 16); }
DI unsigned pk2(float lo, float hi) { f32x2 v = {lo, hi}; bf16x2_t b = __builtin_convertvector(v, bf16x2_t); return __builtin_bit_cast(unsigned, b); }
DI unsigned f2bf(float f) { return pk2(f, f) & 0xffffu; }
DI float bflo(unsigned w) { return __builtin_bit_cast(float, w << 16); }
DI float bfhi(unsigned w) { return __builtin_bit_cast(float, w & 0xffff0000u); }
template <int CTRL> DI float dpp_f(float x) { return __builtin_bit_cast(float, __builtin_amdgcn_update_dpp(0, __builtin_bit_cast(int, x), CTRL, 0xF, 0xF, true)); }
DI float row16_sum(float x) {
    x += dpp_f<0xB1>(x);
    x += dpp_f<0x4E>(x);
    x += dpp_f<0x141>(x);
    x += dpp_f<0x140>(x);
    return x;
}
DI int otid() { int t = threadIdx.x; asm volatile("" : "+v"(t)); return t; }
DI int obid() { int t = blockIdx.x; asm volatile("" : "+s"(t)); return t; }
DI float wave_sum(float x) {
    x = row16_sum(x);
    auto p = __builtin_amdgcn_permlane16_swap(__float_as_uint(x), __float_as_uint(x), false, false);
    x = __uint_as_float(p[0]) + __uint_as_float(p[1]);
    auto q = __builtin_amdgcn_permlane32_swap(__float_as_uint(x), __float_as_uint(x), false, false);
    return __uint_as_float(q[0]) + __uint_as_float(q[1]);
}
DI void wave_sum8(float (&x)[8]) {
#pragma unroll
    for (int i = 0; i < 8; ++i) x[i] += dpp_f<0xB1>(x[i]);
#pragma unroll
    for (int i = 0; i < 8; ++i) x[i] += dpp_f<0x4E>(x[i]);
#pragma unroll
    for (int i = 0; i < 8; ++i) x[i] += dpp_f<0x141>(x[i]);
#pragma unroll
    for (int i = 0; i < 8; ++i) x[i] += dpp_f<0x140>(x[i]);
#pragma unroll
    for (int i = 0; i < 8; ++i) { auto p = __builtin_amdgcn_permlane16_swap(__float_as_uint(x[i]), __float_as_uint(x[i]), false, false); x[i] = __uint_as_float(p[0]) + __uint_as_float(p[1]); }
#pragma unroll
    for (int i = 0; i < 8; ++i) { auto p = __builtin_amdgcn_permlane32_swap(__float_as_uint(x[i]), __float_as_uint(x[i]), false, false); x[i] = __uint_as_float(p[0]) + __uint_as_float(p[1]); }
}
DI float rs16(float (&x)[16], int lane) {
    float z[8], w[4];
#pragma unroll
    for (int i = 0; i < 8; ++i) { auto p = __builtin_amdgcn_permlane32_swap(__float_as_uint(x[i]), __float_as_uint(x[i + 8]), false, false); z[i] = __uint_as_float(p[0]) + __uint_as_float(p[1]); }
#pragma unroll
    for (int i = 0; i < 4; ++i) { auto p = __builtin_amdgcn_permlane16_swap(__float_as_uint(z[i]), __float_as_uint(z[i + 4]), false, false); w[i] = __uint_as_float(p[0]) + __uint_as_float(p[1]); }
    const bool b0 = (lane & 1) != 0, b1 = (lane & 2) != 0;
    const float u0 = (b0 ? w[1] : w[0]) + dpp_f<0xB1>(b0 ? w[0] : w[1]);
    const float u1 = (b0 ? w[3] : w[2]) + dpp_f<0xB1>(b0 ? w[2] : w[3]);
    float v = (b1 ? u1 : u0) + dpp_f<0x4E>(b1 ? u0 : u1);
    v += dpp_f<0x124>(v);
    v += dpp_f<0x128>(v);
    return v;
}
DI float sigmoidf_(float x) { return __builtin_amdgcn_rcpf(1.0f + __expf(-x)); }
DI float gelu_erf(float x) {
    const float y = fabsf(x) * 0.70710678118654752f;
    const float t = __builtin_amdgcn_rcpf(__builtin_fmaf(0.3275911f, y, 1.0f));
    const float e = __builtin_amdgcn_exp2f(-1.4426950408889634f * y * y);
    float p = __builtin_fmaf(1.061405429f, t, -1.453152027f); p = __builtin_fmaf(p, t, 1.421413741f); p = __builtin_fmaf(p, t, -0.284496736f); p = __builtin_fmaf(p, t, 0.254829592f);
    const float ec = p * t * e;
    return 0.5f * x * (x < 0.f ? ec : 2.0f - ec);
}

namespace pg8 {
constexpr int BM = 256, BK = 64, HALF = 128, HTB = HALF * BK * 2, STAGE_BYTES = 8 * HTB, NXCD = 8, WGM = 8;
__host__ __device__ __forceinline__ int lds_byte(int r, int c) { const int st = (r >> 4) * 2 + (c >> 5), rr = r & 15, cc = c & 31, ob = rr * 64 + cc * 2; return st * 1024 + (ob ^ (((ob >> 9) & 1) << 5)); }
__host__ __device__ __forceinline__ void stage_rc(int b, int& R, int& C) { const int st = b / 1024, sb = b % 1024, swz = sb ^ (((sb >> 9) & 1) << 5); R = (st >> 1) * 16 + swz / 64; C = (st & 1) * 32 + (swz % 64) / 2; }
__host__ __device__ __forceinline__ int perm32(int rho) { const int n = rho >> 4, i = rho & 15; return 8 * (i >> 2) + 4 * n + (i & 3); }

struct Unit { int pm, pn, koff, nt, tag; };
struct Gemm { const bf16_t* A; const bf16_t* Bt; int lda, ldb; };

struct StaticOrder {
    int nM, nN, nwg, G, c, nt;
    __device__ void init(int M_, int N_, int K_, int G_, int c_) { nM = M_ / BM; nN = N_ / BM; nwg = nM * nN; G = G_; c = c_; nt = K_ / BK; }
    __device__ bool tile(int L, Unit& u) const {
        if (L >= nwg) return false;
        int wgid = L; { const int q = nwg / NXCD, r = nwg % NXCD, xcd = wgid % NXCD, off = wgid / NXCD; wgid = (xcd < r ? xcd * (q + 1) : r * (q + 1) + (xcd - r) * q) + off; }
        const int nig = WGM * nN, gid = wgid / nig, fm = gid * WGM, gsz = (nM - fm) < WGM ? (nM - fm) : WGM;
        u.pm = fm + ((wgid % nig) % gsz); u.pn = (wgid % nig) / gsz; return true;
    }
    __device__ bool next(int i, Unit& u) const { u.koff = 0; u.nt = nt; u.tag = 0; return tile(i * G + c, u); }
};
struct BranchOrder : StaticOrder {
    __device__ bool next(int i, Unit& u) const {
        const int ti = i / 3, br = i - 3 * ti;
        u.tag = br; u.koff = br == 0 ? 0 : (br == 1 ? 1024 : 1536); u.nt = br == 0 ? 16 : 8;
        return tile(ti * G + c, u);
    }
};

template <class Epi, class Sched>
__device__ __forceinline__ void gemm_phase(LAS unsigned char* lds, const Gemm g, const Sched& S, const Epi& E) {
    const int tid = otid(), wid = __builtin_amdgcn_readfirstlane(tid >> 6), lane = tid & 63, wr = wid >> 2, wc = wid & 3, fr = lane & 15, fq = lane >> 4;
    unsigned voffA[2], voffB[2];
#pragma unroll
    for (int i = 0; i < 2; ++i) { int R, C; stage_rc(tid * 16 + i * 8192, R, C); const int Rb = Epi::PERM ? ((R & ~31) + perm32(R & 31)) : R;
        voffA[i] = (unsigned)(R * g.lda + C) * 2u; voffB[i] = (unsigned)(Rb * g.ldb + C) * 2u; }
    const size_t kstep = (size_t)(BK * 2);
    const size_t hstepA = (size_t)HALF * g.lda * 2, hstepB = (size_t)HALF * g.ldb * 2;
    const size_t tstepA = 2 * hstepA, tstepB = 2 * hstepB;
    const unsigned ldsw = (unsigned)wid * 1024u;
    const int aoff = lds_byte(wr * 64 + fr, fq * 8), boff = lds_byte(wc * 32 + fr, fq * 8);
#define PG8_SA(b, h) (((b) * 2 + (h)) * HTB)
#define PG8_SB(b, h) ((4 + (b) * 2 + (h)) * HTB)
#define PG8_STAGE(bufoff, gbase, voff) do { _Pragma("unroll") for (int _i = 0; _i < 2; ++_i) \
        __builtin_amdgcn_global_load_lds((const unsigned*)((const char*)(gbase) + (voff)[_i]), (LAS unsigned*)(lds + (bufoff) + ldsw + _i * 8192), 16, 0, 0); } while (0)
#define PG8_LDA(dst, b, h) do { _Pragma("unroll") for (int m = 0; m < 4; ++m) _Pragma("unroll") for (int k = 0; k < 2; ++k) dst[m][k] = *(const LAS bf16x8*)(lds + PG8_SA(b, h) + aoff + m * 2048 + k * 1024); } while (0)
#define PG8_LDB(dst, b, h) do { _Pragma("unroll") for (int n = 0; n < 2; ++n) _Pragma("unroll") for (int k = 0; k < 2; ++k) dst[n][k] = *(const LAS bf16x8*)(lds + PG8_SB(b, h) + boff + n * 2048 + k * 1024); } while (0)
#define PG8_MMA(ai, bj, At, Bt) do { __builtin_amdgcn_s_setprio(1); _Pragma("unroll") for (int m = 0; m < 4; ++m) _Pragma("unroll") for (int n = 0; n < 2; ++n) _Pragma("unroll") for (int k = 0; k < 2; ++k) \
        acc[ai][bj][m][n] = __builtin_amdgcn_mfma_f32_16x16x32_bf16(Bt[n][k], At[m][k], acc[ai][bj][m][n], 0, 0, 0); __builtin_amdgcn_s_setprio(0); } while (0)
#define PG8_WAIT_V(n) asm volatile("s_waitcnt vmcnt(" #n ")" ::: "memory")
#define PG8_WAIT_L(n) asm volatile("s_waitcnt lgkmcnt(" #n ")" ::: "memory")
#define PG8_BAR __builtin_amdgcn_s_barrier()
#define PG8_SCHED __builtin_amdgcn_sched_barrier(0)
    Unit cur, nxt; int ui = 0;
    if (!S.next(0, cur)) return;
    f32x4 acc[2][2][4][2];
#pragma unroll
    for (int a = 0; a < 2; ++a)
#pragma unroll
        for (int b = 0; b < 2; ++b)
#pragma unroll
            for (int m = 0; m < 4; ++m)
#pragma unroll
                for (int n = 0; n < 2; ++n) acc[a][b][m][n] = (f32x4){0.f, 0.f, 0.f, 0.f};
    bf16x8 At[4][2], B0[2][2], B1[2][2];
    const char* cA = (const char*)g.A + (size_t)cur.pm * tstepA + (size_t)cur.koff * 2; const char* cB = (const char*)g.Bt + (size_t)cur.pn * tstepB + (size_t)cur.koff * 2;
    PG8_STAGE(PG8_SB(0, 0), cB, voffB); PG8_STAGE(PG8_SB(0, 1), cB + hstepB, voffB); PG8_STAGE(PG8_SA(0, 0), cA, voffA); PG8_STAGE(PG8_SA(0, 1), cA + hstepA, voffA);
    if (wr == 1) PG8_BAR;
    PG8_WAIT_V(2); PG8_BAR;
    PG8_STAGE(PG8_SB(1, 0), cB + kstep, voffB); PG8_STAGE(PG8_SA(1, 0), cA + kstep, voffA); PG8_STAGE(PG8_SB(1, 1), cB + hstepB + kstep, voffB);
    PG8_WAIT_V(6); PG8_BAR;
    for (;;) {
        const bool has_next = S.next(ui + 1, nxt);
        const char* nA = has_next ? (const char*)g.A + (size_t)nxt.pm * tstepA + (size_t)nxt.koff * 2 : cA; const char* nB = has_next ? (const char*)g.Bt + (size_t)nxt.pn * tstepB + (size_t)nxt.koff * 2 : cB;
        const int nt = cur.nt;
        for (int t = 0; t < nt; t += 2) {
            const bool last = (t == nt - 2);
            const char* a1 = cA + (size_t)(t + 1) * kstep;
            const char* a2 = last ? nA : cA + (size_t)(t + 2) * kstep; const char* b2 = last ? nB : cB + (size_t)(t + 2) * kstep;
            const char* a3 = a2 + kstep; const char* b3 = b2 + kstep;
            PG8_LDB(B0, 0, 0); PG8_LDB(B1, 0, 1); PG8_SCHED; PG8_LDA(At, 0, 0); PG8_STAGE(PG8_SA(1, 1), a1 + hstepA, voffA);
            PG8_WAIT_V(8); PG8_WAIT_L(0); PG8_BAR; PG8_MMA(0, 0, At, B0); PG8_MMA(0, 1, At, B1); PG8_BAR; PG8_SCHED;
            PG8_LDA(At, 0, 1); PG8_STAGE(PG8_SB(0, 0), b2, voffB); PG8_STAGE(PG8_SB(0, 1), b2 + hstepB, voffB); PG8_STAGE(PG8_SA(0, 0), a2, voffA);
            PG8_WAIT_V(8); PG8_WAIT_L(0); PG8_BAR; PG8_MMA(1, 0, At, B0); PG8_MMA(1, 1, At, B1); PG8_BAR; PG8_SCHED;
            PG8_LDB(B0, 1, 0); PG8_LDB(B1, 1, 1); PG8_SCHED; PG8_LDA(At, 1, 0); PG8_STAGE(PG8_SA(0, 1), a2 + hstepA, voffA);
            PG8_WAIT_V(8); PG8_WAIT_L(0); PG8_BAR; PG8_MMA(0, 0, At, B0); PG8_MMA(0, 1, At, B1); PG8_BAR; PG8_SCHED;
            PG8_LDA(At, 1, 1); PG8_STAGE(PG8_SB(1, 0), b3, voffB); PG8_STAGE(PG8_SB(1, 1), b3 + hstepB, voffB); PG8_STAGE(PG8_SA(1, 0), a3, voffA);
            PG8_WAIT_V(8); PG8_WAIT_L(0); PG8_BAR; PG8_MMA(1, 0, At, B0); PG8_MMA(1, 1, At, B1); PG8_BAR; PG8_SCHED;
        }
        if (wr == 0) PG8_BAR;
        E(acc, cur, wr, wc, fr, fq);
        if (!has_next) break;
        if (!(Epi::KEEPS && cur.tag != 2))
#pragma unroll
        for (int a = 0; a < 2; ++a)
#pragma unroll
            for (int b = 0; b < 2; ++b)
#pragma unroll
                for (int m = 0; m < 4; ++m)
#pragma unroll
                    for (int n = 0; n < 2; ++n) acc[a][b][m][n] = (f32x4){0.f, 0.f, 0.f, 0.f};
        cur = nxt; cA = nA; cB = nB; ++ui;
        if (wr == 1) PG8_BAR;
    }
    PG8_WAIT_V(0);
    PG8_BAR;
#undef PG8_SA
#undef PG8_SB
#undef PG8_STAGE
#undef PG8_LDA
#undef PG8_LDB
#undef PG8_MMA
#undef PG8_WAIT_V
#undef PG8_WAIT_L
#undef PG8_BAR
#undef PG8_SCHED
}

struct EpiSwiglu {
    static constexpr bool PERM = true, KEEPS = false;
    bf16_t* O; int ldc;
    __device__ __forceinline__ void operator()(const f32x4 (&acc)[2][2][4][2], const Unit& u, int wr, int wc, int fr, int fq) const {
        const int row0 = u.pm * BM + wr * 64 + fr, col0 = u.pn * HALF + wc * 32 + 8 * fq;
#pragma unroll
        for (int ai = 0; ai < 2; ++ai)
#pragma unroll
            for (int m = 0; m < 4; ++m) {
                float hv[8];
#pragma unroll
                for (int n = 0; n < 2; ++n)
#pragma unroll
                    for (int j = 0; j < 4; ++j) { const float gv = acc[ai][0][m][n][j], uv = acc[ai][1][m][n][j]; hv[4 * n + j] = gv * __builtin_amdgcn_rcpf(1.0f + __expf(-gv)) * uv; }
                u32x4 w; w.x = pk2(hv[0], hv[1]); w.y = pk2(hv[2], hv[3]); w.z = pk2(hv[4], hv[5]); w.w = pk2(hv[6], hv[7]);
                *(u32x4*)(O + (size_t)(row0 + ai * HALF + m * 16) * ldc + col0) = w;
            }
    }
};
struct EpiRes {
    static constexpr bool PERM = false, KEEPS = false;
    const float* Xraw; const float* st; const float* g; const float* b; float* T; int ldc; float alpha, s;
    __device__ __forceinline__ void operator()(const f32x4 (&acc)[2][2][4][2], const Unit& u, int wr, int wc, int fr, int fq) const {
        const int row0 = u.pm * BM + wr * 64 + fr, col0 = u.pn * BM + wc * 32 + 4 * fq;
        f32x4 gv[2][2], bv[2][2];
        if (st) {
#pragma unroll
            for (int bj = 0; bj < 2; ++bj)
#pragma unroll
                for (int n = 0; n < 2; ++n) { gv[bj][n] = *(const f32x4*)(g + col0 + bj * HALF + n * 16); bv[bj][n] = *(const f32x4*)(b + col0 + bj * HALF + n * 16); } }
        const float* src = st ? T : Xraw;
#pragma unroll
        for (int ai = 0; ai < 2; ++ai)
#pragma unroll
            for (int m2 = 0; m2 < 2; ++m2) {
                f32x4 tv[2][2][2]; f32x2 ms[2];
#pragma unroll
                for (int mm = 0; mm < 2; ++mm) { const int row = row0 + ai * HALF + (2 * m2 + mm) * 16; const size_t off = (size_t)row * ldc + col0;
                    ms[mm] = (f32x2){0.f, 1.f}; if (st) ms[mm] = *(const f32x2*)(st + 2 * (size_t)row);
#pragma unroll
                    for (int bj = 0; bj < 2; ++bj)
#pragma unroll
                        for (int n = 0; n < 2; ++n) tv[mm][bj][n] = *(const f32x4*)(src + off + bj * HALF + n * 16); }
                asm volatile("" ::: "memory");
#pragma unroll
                for (int mm = 0; mm < 2; ++mm) { const int m = 2 * m2 + mm; const size_t off = (size_t)(row0 + ai * HALF + m * 16) * ldc + col0;
#pragma unroll
                    for (int bj = 0; bj < 2; ++bj)
#pragma unroll
                        for (int n = 0; n < 2; ++n) { f32x4 xv = tv[mm][bj][n]; if (st) xv = (xv - ms[mm][0]) * ms[mm][1] * gv[bj][n] + bv[bj][n];
                            *(f32x4*)(T + off + bj * HALF + n * 16) = xv * alpha + acc[ai][bj][m][n] * s; } }
            }
    }
};
__device__ __forceinline__ int frag_off(int wr, int wc, int fr, int fq, int ai, int m, int bj) { return (((((wr * 4 + wc) * 2 + ai) * 4 + m) * 2 + bj) * 64 + fq * 16 + fr) * 8; }
struct EpiBf16 {
    static constexpr bool PERM = true, KEEPS = false;
    bf16_t* O; int ldc; bf16_t* G;
    __device__ __forceinline__ void operator()(const f32x4 (&acc)[2][2][4][2], const Unit& u, int wr, int wc, int fr, int fq) const {
        const bool gate = u.pn >= GN_GATE / BM && u.pn < GN_LORA / BM;
        const int gt = u.pn - GN_GATE / BM;
        bf16_t* gbase = G + ((size_t)((gt >> 3) * (M / BM) + u.pm) * 8 + (gt & 7)) * 65536;
        const int pcol = (u.pn >= GN_LORA / BM ? PC_LORA + (u.pn - GN_LORA / BM) * BM : u.pn * BM) + wc * 32 + 8 * fq;
        const int row0 = u.pm * BM + wr * 64 + fr;
        int lbase = ((wr * 4 + wc) * 1024 + fq * 16 + fr) * 8; asm volatile("" : "+v"(lbase));
#pragma unroll
        for (int ai = 0; ai < 2; ++ai)
#pragma unroll
            for (int m = 0; m < 4; ++m) { bf16_t* rowp = O + (size_t)(row0 + ai * HALF + m * 16) * ldc + pcol;
#pragma unroll
                for (int bj = 0; bj < 2; ++bj) { const f32x4 v0 = acc[ai][bj][m][0], v1 = acc[ai][bj][m][1];
                    u32x4 w; w.x = pk2(v0[0], v0[1]); w.y = pk2(v0[2], v0[3]); w.z = pk2(v1[0], v1[1]); w.w = pk2(v1[2], v1[3]);
                    if (gate) *(u32x4*)(gbase + lbase + (((ai * 4 + m) * 2 + bj) * 512)) = w; else *(u32x4*)(rowp + bj * HALF) = w; } }
    }
};
struct EpiBranch {
    static constexpr bool PERM = true, KEEPS = true;
    const bf16_t* G; const float* bgate; bf16_t* MG;
    static __device__ __forceinline__ float den(float p) { return 1.0f + __expf(-__builtin_amdgcn_fmed3f(p, -30.0f, 30.0f)); }
    __device__ __forceinline__ void operator()(f32x4 (&acc)[2][2][4][2], const Unit& u, int wr, int wc, int fr, int fq) const {
        const int row0 = u.pm * BM + wr * 64 + fr, col0 = u.pn * BM + wc * 32 + 8 * fq; const int br = u.tag; const bool mid = br < 2;
        int lbase = ((wr * 4 + wc) * 1024 + fq * 16 + fr) * 8; asm volatile("" : "+v"(lbase));
        u32x2 bA[2][2], bB[2][2];
#pragma unroll
        for (int bj = 0; bj < 2; ++bj)
#pragma unroll
            for (int n = 0; n < 2; ++n) { const f32x4 t = *(const f32x4*)(bgate + br * D + col0 + bj * HALF + 4 * n); bA[bj][n].x = pk2(t[0], t[1]); bA[bj][n].y = pk2(t[2], t[3]);
                const f32x4 t2 = *(const f32x4*)(bgate + (mid ? br + 1 : br) * D + col0 + bj * HALF + 4 * n); bB[bj][n].x = pk2(t2[0], t2[1]); bB[bj][n].y = pk2(t2[2], t2[3]); }
        const bf16_t* gA = G + ((size_t)(br * (M / BM) + u.pm) * 8 + u.pn) * 65536;
        const bf16_t* gB = gA + (mid ? (size_t)(M / BM) * 8 * 65536 : 0);
        u32x4 gaq[2][2], gbq[2][2];
#define EB_LOAD(A8) do { _Pragma("unroll") for (int bj = 0; bj < 2; ++bj) { const int fo = lbase + (((A8) * 2 + bj) * 512); \
                gaq[(A8) & 1][bj] = *(const u32x4*)(gA + fo); gbq[(A8) & 1][bj] = *(const u32x4*)(gB + fo); } } while (0)
        EB_LOAD(0);
#pragma unroll
        for (int a8 = 0; a8 < 8; ++a8) { const int ai = a8 >> 2, m = a8 & 3; const size_t row = (size_t)(row0 + ai * HALF + m * 16);
            if (a8 + 1 < 8) EB_LOAD(a8 + 1);
            asm volatile("" ::: "memory");
#pragma unroll
                for (int bj = 0; bj < 2; ++bj) { const u32x4 a4 = gaq[a8 & 1][bj], b4 = gbq[a8 & 1][bj];
                    const unsigned aw[4] = {a4.x, a4.y, a4.z, a4.w}, bw[4] = {b4.x, b4.y, b4.z, b4.w}; unsigned ow[4];
#pragma unroll
                    for (int n = 0; n < 2; ++n) { const unsigned bax = bA[bj][n].x, bay = bA[bj][n].y, bbx = bB[bj][n].x, bby = bB[bj][n].y;
                        float f0 = __builtin_amdgcn_rcpf(den(bflo(aw[2 * n]) + bflo(bax))), f1 = __builtin_amdgcn_rcpf(den(bfhi(aw[2 * n]) + bfhi(bax)));
                        float f2 = __builtin_amdgcn_rcpf(den(bflo(aw[2 * n + 1]) + bflo(bay))), f3 = __builtin_amdgcn_rcpf(den(bfhi(aw[2 * n + 1]) + bfhi(bay)));
                        if (mid) { f0 *= den(bflo(bw[2 * n]) + bflo(bbx)); f1 *= den(bfhi(bw[2 * n]) + bfhi(bbx)); f2 *= den(bflo(bw[2 * n + 1]) + bflo(bby)); f3 *= den(bfhi(bw[2 * n + 1]) + bfhi(bby)); }
                        f32x4& av = acc[ai][bj][m][n];
                        av[0] *= f0; av[1] *= f1; av[2] *= f2; av[3] *= f3;
                        ow[2 * n] = pk2(av[0], av[1]); ow[2 * n + 1] = pk2(av[2], av[3]); }
                    if (!mid) { u32x4 o; o.x = ow[0]; o.y = ow[1]; o.z = ow[2]; o.w = ow[3]; *(u32x4*)(MG + row * D + col0 + bj * HALF) = o; } }
        }
#undef EB_LOAD
    }
};
}

#define XB_TMO      128
#define XB_XCNT(j)  (256  + 64 * (j))
#define XB_XSUB(j)  (1280 + 64 * (j))
#define XB_XGEN(j)  (2304 + 64 * (j))
#define XB_TOP      3328
#define XB_TOPGEN   3392
#define XCD_BAR_WORDS 3456
#define XB_SPIN_CAP (1u << 18)
__device__ __forceinline__ unsigned xb_ld(unsigned* p)              { return __hip_atomic_load(p, __ATOMIC_RELAXED, __HIP_MEMORY_SCOPE_AGENT); }
__device__ __forceinline__ unsigned xb_add(unsigned* p, unsigned v) { return __hip_atomic_fetch_add(p, v, __ATOMIC_RELAXED, __HIP_MEMORY_SCOPE_AGENT); }
__device__ __forceinline__ unsigned xb_xcc_id() { return (unsigned)__builtin_amdgcn_s_getreg((3 << 11) | 20) & 0xFu; }
#define XB_SPIN(cond, bar) do { unsigned _sp = 0; while (cond) { __builtin_amdgcn_s_sleep(1); \
    if ((++_sp & 255u) == 0u) { if (xb_ld(&(bar)[XB_TMO])) break; if (_sp > XB_SPIN_CAP) { atomicAdd(&(bar)[XB_TMO], 1u); break; } } } } while (0)
struct XcdBarrier { unsigned* bar; unsigned x; volatile LAS unsigned* st; };
__device__ __forceinline__ XcdBarrier xcd_barrier_post(unsigned* bar, volatile LAS unsigned* st) {
    XcdBarrier b; b.bar = bar; b.x = xb_xcc_id(); b.st = st;
    if (threadIdx.x == 0) (void)xb_add(&bar[XB_XCNT(b.x)], 1u);
    return b;
}
__device__ __forceinline__ void xcd_barrier_complete(unsigned* bar, unsigned x, unsigned& nloc, unsigned& nx) {
    const unsigned G = gridDim.x * gridDim.y * gridDim.z;
    unsigned sum, cnt, mine, sp = 0u;
    for (;;) {
        sum = 0u; cnt = 0u; mine = 0u;
#pragma unroll
        for (unsigned j = 0; j < 16; ++j) { const unsigned c = xb_ld(&bar[XB_XCNT(j)]); sum += c; cnt += (c > 0u) ? 1u : 0u; mine = (j == x) ? c : mine; }
        if (sum == G) break;
        __builtin_amdgcn_s_sleep(1);
        if ((++sp & 255u) == 0u) { if (xb_ld(&bar[XB_TMO])) break; if (sp > XB_SPIN_CAP) { atomicAdd(&bar[XB_TMO], 1u); break; } }
    }
    nloc = mine > 0u ? mine : 1u; nx = cnt > 0u ? cnt : 1u;
}
__device__ __forceinline__ void xcd_barrier(const XcdBarrier& b) {
    asm volatile("s_waitcnt vmcnt(0)" ::: "memory");
    __syncthreads();
    if (threadIdx.x == 0) {
        unsigned* bar = b.bar;
        __builtin_amdgcn_s_waitcnt(0);
        unsigned nloc = b.st[0], nx = b.st[1];
        if (nloc == 0u) { xcd_barrier_complete(bar, b.x, nloc, nx); b.st[0] = nloc; b.st[1] = nx; }
        const unsigned old = xb_add(&bar[XB_XSUB(b.x)], 1u);
        const unsigned gen = old / nloc;
        if (old + 1u == (gen + 1u) * nloc) {
            __builtin_amdgcn_fence(__ATOMIC_RELEASE, "agent");
            asm volatile("s_waitcnt vmcnt(0)" ::: "memory");
            const unsigned og = xb_add(&bar[XB_TOP], 1u);
            const unsigned tg = og / nx;
            if (og + 1u == (tg + 1u) * nx) xb_add(&bar[XB_TOPGEN], 1u);
            else XB_SPIN(xb_ld(&bar[XB_TOPGEN]) == tg, bar);
            __builtin_amdgcn_fence(__ATOMIC_ACQUIRE, "agent");
            xb_add(&bar[XB_XGEN(b.x)], 1u);
            asm volatile("s_waitcnt vmcnt(0)" ::: "memory");
        } else {
            XB_SPIN(xb_ld(&bar[XB_XGEN(b.x)]) == gen, bar);
            __builtin_amdgcn_fence(__ATOMIC_ACQUIRE, "agent");
            asm volatile("s_waitcnt vmcnt(0)" ::: "memory");
        }
    }
    __syncthreads();
}

struct Args { const float* in[33]; float* out; unsigned char* ws; int lo, hi; };
enum { I_X = 0, I_F1IN, I_F1OUT, I_LN1G, I_LN1B, I_WIN, I_BGATE, I_MU, I_W0, I_W2, I_A0, I_A2, I_G2, I_KK, I_KA, I_RK, I_GNG, I_GNB, I_SGLNG, I_SGLNB, I_SGW, I_SGB, I_ILNG, I_ILNB, I_RELB, I_WBR, I_WO, I_LN2G, I_LN2B, I_F2IN, I_F2OUT, I_LN3G, I_LN3B };

DI int pmap(int n) {
    int off = 0;
    off = n >= 3072 ? GN_LORA - 3072 : off; off = n >= 3360 ? PC_SGU - 3360 : off; off = n >= 4384 ? PC_AQ - 4384 : off; off = n >= 5920 ? PC_QI - 5920 : off;
    off = n >= 6944 ? GN_KI - 6944 : off; off = n >= 7008 ? GN_WI - 7008 : off; off = n >= 7024 ? GN_GATE - 7024 : off;
    return n + off;
}
template <int MODE> DI int rowmap(int n) {
    if (MODE == 0) return n;
    if (MODE == 1) { const int up = n >= FF ? 1 : 0, j = n - up * FF; return (j >> 7) * 256 + up * 128 + (j & 127); }
    return pmap(n);
}
struct CvtItem { const float* W; bf16_t* WT; int K, N, mode, item; };
DI void cvt_load(const CvtItem& d, int lane, f32x4 (&va)[4], f32x4 (&vb)[4]) {
    const int nblk = (d.N + 31) / 32, kb = d.item / nblk, nb = d.item % nblk, k0 = 64 * kb, n0 = 32 * nb;
    const int c4 = lane & 7, rq = lane >> 3; const int ncol = n0 + 4 * c4; const int ncl = ncol < d.N ? ncol : 0;
#pragma unroll
    for (int i = 0; i < 4; ++i) { const int k = k0 + 2 * (rq + 8 * i);
        va[i] = *(const f32x4*)(d.W + (size_t)k * d.N + ncl); vb[i] = *(const f32x4*)(d.W + (size_t)(k + 1) * d.N + ncl); }
}
DI void cvt_finish(const CvtItem& d, int lane, const f32x4 (&va)[4], const f32x4 (&vb)[4], float* scr) {
    const int nblk = (d.N + 31) / 32, kb = d.item / nblk, nb = d.item % nblk, k0 = 64 * kb, n0 = 32 * nb;
    unsigned* st = (unsigned*)scr; const int c4 = lane & 7, rq = lane >> 3;
#pragma unroll
    for (int i = 0; i < 4; ++i) { const int rp = rq + 8 * i;
#pragma unroll
        for (int j = 0; j < 4; ++j) st[(4 * c4 + j) * 33 + rp] = pk2(va[i][j], vb[i][j]); }
    __builtin_amdgcn_s_waitcnt(0xc07f); asm volatile("" ::: "memory");
#pragma unroll
    for (int i = 0; i < 4; ++i) { const int id = lane + 64 * i, n = id >> 3, kc = id & 7; const unsigned* p = st + n * 33 + 4 * kc;
        u32x4 o; o.x = p[0]; o.y = p[1]; o.z = p[2]; o.w = p[3];
        const int ns = n0 + n; const int nd1 = rowmap<1>(ns), nd2 = pmap(ns); const int nd = d.mode == 0 ? ns : (d.mode == 1 ? nd1 : nd2);
        if (ns < d.N) *(u32x4*)(d.WT + (size_t)nd * d.K + k0 + 8 * kc) = o; }
    __builtin_amdgcn_s_waitcnt(0xc07f); asm volatile("" ::: "memory");
}
DI void convert_phase(const Args& a, int L, unsigned char* lds, int vb, int nvb) {
    const int tidx_ = otid();
    const int wave = __builtin_amdgcn_readfirstlane(tidx_ >> 6), lane = tidx_ & 63;
    float* scr = (float*)(lds + wave * 16384);
    const int gw = vb * 8 + wave, NGW = nvb * 8;
    unsigned char* ws = a.ws; const size_t alt = (L & 1) ? ALT_SHIFT : 0;
    constexpr int I1 = (D / 64) * ((2 * FF) / 32), I2 = (FF / 64) * (D / 32), I3 = (D / 64) * ((DIN + 31) / 32), I4 = (D / 64) * (D / 32);
    constexpr int NIT = 2 * I1 + 2 * I2 + I3 + 2 * I4;
    auto decode = [&](int it) -> CvtItem {
        int r = it;
        if (r < I1) return CvtItem{a.in[I_F1IN] + (size_t)L * D * 2 * FF, (bf16_t*)(ws + OFF_W1A), D, 2 * FF, 1, r}; r -= I1;
        if (r < I1) return CvtItem{a.in[I_F2IN] + (size_t)L * D * 2 * FF, (bf16_t*)(ws + OFF_W2A + alt), D, 2 * FF, 1, r}; r -= I1;
        if (r < I2) return CvtItem{a.in[I_F1OUT] + (size_t)L * FF * D, (bf16_t*)(ws + OFF_W1B), FF, D, 0, r}; r -= I2;
        if (r < I2) return CvtItem{a.in[I_F2OUT] + (size_t)L * FF * D, (bf16_t*)(ws + OFF_W2B + alt), FF, D, 0, r}; r -= I2;
        if (r < I3) return CvtItem{a.in[I_WIN] + (size_t)L * D * DIN, (bf16_t*)(ws + OFF_WIN), D, DIN, 2, r}; r -= I3;
        if (r < I4) return CvtItem{a.in[I_WBR] + (size_t)L * D * D, (bf16_t*)(ws + OFF_WBR + alt), D, D, 0, r}; r -= I4;
        return CvtItem{a.in[I_WO] + (size_t)L * D * D, (bf16_t*)(ws + OFF_WO + alt), D, D, 0, r};
    };
    auto clampi = [&](int x) { return x < NIT ? x : gw; };
    {
        int it = gw;
        CvtItem dA0 = decode(clampi(it)), dA1 = decode(clampi(it + NGW));
        f32x4 a0[4], b0[4], a1[4], b1[4], a2[4], b2[4], a3[4], b3[4];
        cvt_load(dA0, lane, a0, b0); cvt_load(dA1, lane, a1, b1);
#pragma unroll 1
        for (; it < NIT; it += 4 * NGW) {
            const CvtItem dB0 = decode(clampi(it + 2 * NGW)), dB1 = decode(clampi(it + 3 * NGW));
            cvt_load(dB0, lane, a2, b2); cvt_load(dB1, lane, a3, b3);
            asm volatile("" ::: "memory");
            cvt_finish(dA0, lane, a0, b0, scr); cvt_finish(dA1, lane, a1, b1, scr + 2048);
            asm volatile("" ::: "memory");
            dA0 = decode(clampi(it + 4 * NGW)); dA1 = decode(clampi(it + 5 * NGW));
            cvt_load(dA0, lane, a0, b0); cvt_load(dA1, lane, a1, b1);
            asm volatile("" ::: "memory");
            cvt_finish(dB0, lane, a2, b2, scr); cvt_finish(dB1, lane, a3, b3, scr + 2048);
            asm volatile("" ::: "memory");
        }
    }
    { bf16_t* w2t = (bf16_t*)(ws + OFF_LW2); bf16_t* a2t = (bf16_t*)(ws + OFF_LA2); bf16_t* g2t = (bf16_t*)(ws + OFF_LG2);
      const float* w2 = a.in[I_W2] + (size_t)L * 64 * RW; const float* a2 = a.in[I_A2] + (size_t)L * 64 * RW; const float* g2 = a.in[I_G2] + (size_t)L * 160 * RW;
      for (int i = vb * 512 + tidx_; i < RW * 288; i += nvb * 512) { const int c = i / 288, jj = i - c * 288;
          if (jj < 64) w2t[c * 64 + jj] = (bf16_t)f2bf(w2[(size_t)jj * RW + c]);
          else if (jj < 128) a2t[c * 64 + jj - 64] = (bf16_t)f2bf(a2[(size_t)(jj - 64) * RW + c]);
          else g2t[c * 160 + jj - 128] = (bf16_t)f2bf(g2[(size_t)(jj - 128) * RW + c]); } }
    { u32x4* z = (u32x4*)(ws + OFF_WIN + (size_t)DIN * D * 2); const int n16 = (NP - DIN) * D * 2 / 16;
      u32x4 zq = (u32x4){0u, 0u, 0u, 0u}; asm volatile("" : "+v"(zq));
      for (int i = vb * 512 + tidx_; i < n16; i += nvb * 512) z[i] = zq; }
}
DI int rel_bucket_dev(int d) {
    if (d < 16) return d;
    const float df = (float)d;
    const int large = 16 + (int)(logf(df / 16.0f) / 2.0794415416798357f * 16.0f);
    return large < 31 ? large : 31;
}
DI void init_phase(const Args& a) {
    const int tidx_ = otid();
    const size_t n4 = (size_t)M * D / 4; const f32x4* x = (const f32x4*)a.in[I_X]; u32x2* XB = (u32x2*)(a.ws + OFF_XB);
    for (size_t i = (size_t)blockIdx.x * 512 + tidx_; i < n4; i += (size_t)gridDim.x * 512) { const f32x4 v = x[i]; u32x2 o; o.x = pk2(v[0], v[1]); o.y = pk2(v[2], v[3]); XB[i] = o; }
    if (blockIdx.x == 0) { float* bt = (float*)(a.ws + OFF_BIAS); for (int i = tidx_; i < 8 * 128; i += 512) { const int h = i >> 7, d = i & 127; bt[i] = a.in[I_RELB][rel_bucket_dev(d) * 8 + h]; } }
}
DI void ln_phase(const float* T, const float* g, const float* b, float* ST, bf16_t* XB, float* out) {
    const int tidx_ = otid();
    const int wave = __builtin_amdgcn_readfirstlane(tidx_ >> 6), lane = tidx_ & 63;
    const int stride = gridDim.x * 8;
    f32x4 gvs[8], bvs[8];
#pragma unroll
    for (int j = 0; j < 8; ++j) { gvs[j] = ((const f32x4*)g)[lane + 64 * j]; bvs[j] = ((const f32x4*)b)[lane + 64 * j]; }
    int m = blockIdx.x * 8 + wave;
    f32x4 nx[8];
    if (m < M) {
#pragma unroll
        for (int j = 0; j < 8; ++j) nx[j] = ((const f32x4*)(T + (size_t)m * D) + lane)[64 * j]; }
#pragma unroll 1
    for (; m < M; m += stride) {
        f32x4 v[8]; float s = 0.f;
#pragma unroll
        for (int j = 0; j < 8; ++j) { v[j] = nx[j]; s += (v[j][0] + v[j][1]) + (v[j][2] + v[j][3]); }
        if (m + stride < M) {
#pragma unroll
            for (int j = 0; j < 8; ++j) nx[j] = ((const f32x4*)(T + (size_t)(m + stride) * D) + lane)[64 * j]; }
        const float mean = wave_sum(s) * (1.0f / D); float q = 0.f;
#pragma unroll
        for (int j = 0; j < 8; ++j) { v[j] = v[j] - mean; q += (v[j][0] * v[j][0] + v[j][1] * v[j][1]) + (v[j][2] * v[j][2] + v[j][3] * v[j][3]); }
        const float rstd = __builtin_amdgcn_rsqf(wave_sum(q) * (1.0f / D) + LN_EPS);
        if (lane == 0) *(f32x2*)(ST + 2 * (size_t)m) = (f32x2){mean, rstd};
        u32x2* bo = (u32x2*)(XB + (size_t)m * D) + lane;
#pragma unroll
        for (int j = 0; j < 8; ++j) {
            const f32x4 o = v[j] * rstd * gvs[j] + bvs[j]; u32x2 w; w.x = pk2(o[0], o[1]); w.y = pk2(o[2], o[3]); bo[64 * j] = w;
            if (out) ((f32x4*)(out + (size_t)m * D) + lane)[64 * j] = o; }
    }
}
DI void rwkv_prep_phase(const Args& a, int L, unsigned char* lds) {
    const int tidx_ = otid();
    const int tid = tidx_;
    const bf16_t* P = (const bf16_t*)(a.ws + OFF_P);
    float* Rr = (float*)(a.ws + OFF_SCR); float* Wr = Rr + (size_t)M * RW; float* Kr = Wr + (size_t)M * RW; float* Vr = Kr + (size_t)M * RW; float* Ar = Vr + (size_t)M * RW; float* Br = Ar + (size_t)M * RW;
    bf16_t* Gb = (bf16_t*)(a.ws + OFF_MG);
    const float* mu = a.in[I_MU] + (size_t)L * 3360; const float* w0 = a.in[I_W0] + L * RW; const float* w2 = a.in[I_W2] + (size_t)L * 64 * RW;
    const float* a0 = a.in[I_A0] + L * RW; const float* a2 = a.in[I_A2] + (size_t)L * 64 * RW; const float* g2 = a.in[I_G2] + (size_t)L * 160 * RW;
    const float* kkw = a.in[I_KK] + L * RW; const float* kaw = a.in[I_KA] + L * RW;
    float* xl = (float*)lds;
    for (int unit = blockIdx.x; unit < M / 32; unit += gridDim.x) {
        const int m0 = unit * 32;
        __syncthreads();
        for (int idx = tid; idx < 32 * 288; idx += 512) { const int tt = idx / 288, j = idx - tt * 288; const int m = m0 + tt;
            const float cur = bf2f(P[(size_t)m * PCOLS + PC_LORA + j]); const float prev = (m & (SEQ - 1)) == 0 ? 0.f : bf2f(P[(size_t)(m - 1) * PCOLS + PC_LORA + j]);
            float x = cur + (prev - cur) * mu[3072 + j];
            if (j < 64) x = tanhf(x); else if (j >= 128) x = sigmoidf_(x);
            xl[idx] = x; }
        __syncthreads();
#pragma unroll 1
        for (int half = 0; half < 2; ++half) { const int c = tid + 512 * half;
            const float w0c = w0[c], a0c = a0[c], kkc = kkw[c], kac = kaw[c], mur = mu[c], muk = mu[1024 + c], muv = mu[2048 + c];
#pragma unroll 1
            for (int sub = 0; sub < 4; ++sub) {
                float wl[8], al[8], gl[8];
#pragma unroll
                for (int t = 0; t < 8; ++t) { wl[t] = w0c; al[t] = a0c; gl[t] = 0.f; }
                const float* xb = xl + sub * 8 * 288;
#pragma unroll 2
                for (int j = 0; j < 64; j += 4) { const float u0 = w2[(size_t)(j + 0) * RW + c], u1 = w2[(size_t)(j + 1) * RW + c], u2 = w2[(size_t)(j + 2) * RW + c], u3 = w2[(size_t)(j + 3) * RW + c];
                    const float v0 = a2[(size_t)(j + 0) * RW + c], v1 = a2[(size_t)(j + 1) * RW + c], v2 = a2[(size_t)(j + 2) * RW + c], v3 = a2[(size_t)(j + 3) * RW + c];
#pragma unroll
                    for (int t = 0; t < 8; ++t) { const f32x4 xw = *(const f32x4*)(xb + t * 288 + j); const f32x4 xa = *(const f32x4*)(xb + t * 288 + 64 + j);
                        wl[t] += xw[0] * u0 + xw[1] * u1 + xw[2] * u2 + xw[3] * u3; al[t] += xa[0] * v0 + xa[1] * v1 + xa[2] * v2 + xa[3] * v3; } }
#pragma unroll 2
                for (int j = 0; j < 160; j += 4) { const float u0 = g2[(size_t)(j + 0) * RW + c], u1 = g2[(size_t)(j + 1) * RW + c], u2 = g2[(size_t)(j + 2) * RW + c], u3 = g2[(size_t)(j + 3) * RW + c];
#pragma unroll
                    for (int t = 0; t < 8; ++t) { const f32x4 xg = *(const f32x4*)(xb + t * 288 + 128 + j); gl[t] += xg[0] * u0 + xg[1] * u1 + xg[2] * u2 + xg[3] * u3; } }
#pragma unroll
                for (int t = 0; t < 8; ++t) { const int m = m0 + sub * 8 + t; const bool first = (m & (SEQ - 1)) == 0;
                    const bf16_t* pc = P + (size_t)m * PCOLS; const bf16_t* pp = pc - PCOLS;
                    const float rc = bf2f(pc[PC_R + c]), kc = bf2f(pc[PC_K + c]), vc = bf2f(pc[PC_V + c]);
                    const float rp = first ? 0.f : bf2f(pp[PC_R + c]), kp = first ? 0.f : bf2f(pp[PC_K + c]), vp = first ? 0.f : bf2f(pp[PC_V + c]);
                    const float r = rc + (rp - rc) * mur, k = kc + (kp - kc) * muk, v = vc + (vp - vc) * muv;
                    const float nx = -wl[t]; const float sp = nx > 20.f ? nx : log1pf(expf(nx));
                    const float decay = expf(-expf(-sp - 0.5f));
                    const float av = 1.0f / (1.0f + expf(-al[t]));
                    const float kk = k * kkc; const float ss = wave_sum(kk * kk); const float kkn = kk / fmaxf(sqrtf(ss), 1e-12f);
                    const float k2 = k * (1.0f + (av - 1.0f) * kac);
                    const size_t o = (size_t)m * RW + c;
                    Rr[o] = r; Wr[o] = decay; Kr[o] = k2; Vr[o] = v; Ar[o] = -kkn; Br[o] = kkn * av; Gb[o] = (bf16_t)f2bf(gl[t]); }
            }
        }
    }
}
struct WorkQ { unsigned* ctr; int pend, par, stride; };
constexpr int WQ_SLOT = 147456 - 16;
DI int wq_next(WorkQ& q, int cur, unsigned char* lds, int tid) {
    if (!q.ctr) return cur + q.stride;
    LAS int* slot = (LAS int*)(lds + WQ_SLOT);
    if (tid == 0) slot[q.par] = q.pend;
    __syncthreads();
    const int v = __builtin_amdgcn_readfirstlane(slot[q.par]);
    q.par ^= 1;
    if (tid == 0) q.pend = (int)__hip_atomic_fetch_add(q.ctr, 1u, __ATOMIC_RELAXED, __HIP_MEMORY_SCOPE_AGENT);
    return v;
}
DI int wq_first(WorkQ& q, unsigned char* lds, int tid) {
    q.par = 0; q.pend = 0;
    if (tid == 0) q.pend = (int)__hip_atomic_fetch_add(q.ctr, 1u, __ATOMIC_RELAXED, __HIP_MEMORY_SCOPE_AGENT);
    return wq_next(q, 0, lds, tid);
}
DI void kidx_vt_phase(const Args& a, int L, unsigned char* lds) {
    const int tidx_ = otid();
    const int wave = __builtin_amdgcn_readfirstlane(tidx_ >> 6), lane = tidx_ & 63;
    const bf16_t* P = (const bf16_t*)(a.ws + OFF_P); bf16_t* KI = (bf16_t*)(a.ws + OFF_KI); bf16_t* VT = (bf16_t*)(a.ws + OFF_VT);
    const float g = a.in[I_ILNG][L * 64 + lane], b = a.in[I_ILNB][L * 64 + lane];
    for (int m0 = blockIdx.x * 8 + wave; m0 < M; m0 += gridDim.x * 8 * 8) {
        bf16_t raw[8];
#pragma unroll
        for (int i = 0; i < 8; ++i) { const int m = m0 + i * gridDim.x * 8; raw[i] = m < M ? P[(size_t)m * PCOLS + PC_KI + lane] : (bf16_t)0; }
#pragma unroll
        for (int i = 0; i < 8; ++i) { const int m = m0 + i * gridDim.x * 8; if (m < M) { const float x = bf2f(raw[i]);
            const float mean = wave_sum(x) * (1.0f / 64.0f); const float d = x - mean; const float var = wave_sum(d * d) * (1.0f / 64.0f);
            KI[(size_t)m * 64 + lane] = (bf16_t)f2bf(d * __builtin_amdgcn_rsqf(var + LN_EPS) * g + b); } }
    }
    bf16_t* tile = (bf16_t*)(lds + wave * 16384);
    for (int u = blockIdx.x * 8 + wave; u < NB * 8 * 64; u += gridDim.x * 8) {
        const int tb = u & 63, h = (u >> 6) & 7, b_ = u >> 9; const int m = b_ * SEQ + tb * 64 + lane;
        const u32x4* src = (const u32x4*)(P + (size_t)m * PCOLS + PC_AV + h * 64);
#pragma unroll
        for (int q = 0; q < 8; ++q) { const u32x4 v = src[q]; const unsigned w[4] = {v.x, v.y, v.z, v.w};
#pragma unroll
            for (int e = 0; e < 4; ++e) { tile[(q * 8 + 2 * e) * 72 + lane] = (bf16_t)(w[e] & 0xffffu); tile[(q * 8 + 2 * e + 1) * 72 + lane] = (bf16_t)(w[e] >> 16); } }
        __builtin_amdgcn_s_waitcnt(0xc07f); asm volatile("" ::: "memory");
        bf16_t* dst = VT + ((size_t)(b_ * 8 + h) * 64 + lane) * SEQ + tb * 64;
#pragma unroll
        for (int q = 0; q < 8; ++q) *(u32x4*)(dst + q * 8) = *(const u32x4*)(tile + lane * 72 + q * 8);
        __builtin_amdgcn_s_waitcnt(0xc07f); asm volatile("" ::: "memory");
    }
}
DI void sgu_phase(const Args& a, int L, unsigned char* lds, WorkQ& wq, int& item, int ibase) {
    const int tidx_ = otid();
    const int tid = tidx_, wave = __builtin_amdgcn_readfirstlane(tid >> 6), lane = tid & 63, fr = lane & 15, fq = lane >> 4;
    const bf16_t* P = (const bf16_t*)(a.ws + OFF_P); bf16_t* Y = (bf16_t*)(a.ws + OFF_Y);
    const float* lng = a.in[I_SGLNG] + L * 512; const float* lnb = a.in[I_SGLNB] + L * 512;
    bf16_t* Wl = (bf16_t*)lds;
    bf16_t* Vl = (bf16_t*)(lds + 128 * 272);
    for (; item < ibase + NB * 32 * 4; item = wq_next(wq, item, lds, tid)) {
        const int unit = item - ibase;
        const int g = unit & 3, ch = (unit >> 2) & 31, b_ = unit >> 7; const int m0 = b_ * SEQ + ch * 128;
        const float* sw = a.in[I_SGW] + ((size_t)(L * 4 + g) * 128) * 128; const float* sb = a.in[I_SGB] + (L * 4 + g) * 128;
        __syncthreads();
#pragma unroll
        for (int it8 = 0; it8 < 8; ++it8) { const int idx = tid + 512 * it8; const int i = idx >> 5, j4 = (idx & 31) * 4; const f32x4 w = *(const f32x4*)(sw + i * 128 + j4);
            u32x2 o; o.x = pk2(j4 + 0 <= i ? w[0] : 0.f, j4 + 1 <= i ? w[1] : 0.f); o.y = pk2(j4 + 2 <= i ? w[2] : 0.f, j4 + 3 <= i ? w[3] : 0.f);
            *(u32x2*)(Wl + i * 136 + j4) = o; }
        float lgv[8], lbv[8];
#pragma unroll
        for (int e = 0; e < 8; ++e) { lgv[e] = lng[lane * 8 + e]; lbv[e] = lnb[lane * 8 + e]; }
#pragma unroll 1
        for (int ib = 0; ib < 2; ++ib) {
        u32x4 pvs[8];
#pragma unroll
        for (int i = 0; i < 8; ++i) pvs[i] = *(const u32x4*)(P + (size_t)(m0 + wave + 8 * (8 * ib + i)) * PCOLS + PC_SGV + lane * 8);
#pragma unroll
        for (int i = 0; i < 8; ++i) { const int tt = wave + 8 * (8 * ib + i);
            const u32x4 pv = pvs[i];
            float z[8]; z[0] = gelu_erf(bflo(pv.x)); z[1] = gelu_erf(bfhi(pv.x)); z[2] = gelu_erf(bflo(pv.y)); z[3] = gelu_erf(bfhi(pv.y));
            z[4] = gelu_erf(bflo(pv.z)); z[5] = gelu_erf(bfhi(pv.z)); z[6] = gelu_erf(bflo(pv.w)); z[7] = gelu_erf(bfhi(pv.w));
            float s = 0.f;
#pragma unroll
            for (int e = 0; e < 8; ++e) s += z[e];
            const float mean = wave_sum(s) * (1.0f / 512.0f); float q = 0.f;
#pragma unroll
            for (int e = 0; e < 8; ++e) { z[e] -= mean; q += z[e] * z[e]; }
            const float rstd = __builtin_amdgcn_rsqf(wave_sum(q) * (1.0f / 512.0f) + LN_EPS);
            if ((lane >> 4) == g) {
#pragma unroll
                for (int e = 0; e < 8; ++e) Vl[((lane & 15) * 8 + e) * 136 + tt] = (bf16_t)f2bf(z[e] * rstd * lgv[e] + lbv[e]); }
        }
        }
        __syncthreads();
        f32x4 acc[8];
#pragma unroll
        for (int nt = 0; nt < 8; ++nt) acc[nt] = (f32x4){0.f, 0.f, 0.f, 0.f};
        const int ksmax = (16 * wave + 15) >> 5;
#pragma unroll
        for (int ks = 0; ks < 4; ++ks) if (ks <= ksmax) {
            const bf16x8 af = *(const bf16x8*)(Wl + (16 * wave + fr) * 136 + 32 * ks + 8 * fq);
#pragma unroll
            for (int nt = 0; nt < 8; ++nt) { const bf16x8 bfr = *(const bf16x8*)(Vl + (16 * nt + fr) * 136 + 32 * ks + 8 * fq);
                acc[nt] = __builtin_amdgcn_mfma_f32_16x16x32_bf16(af, bfr, acc[nt], 0, 0, 0); }
        }
        bf16_t ur[4][8];
#pragma unroll
        for (int r = 0; r < 4; ++r)
#pragma unroll
            for (int nt = 0; nt < 8; ++nt) ur[r][nt] = P[(size_t)(m0 + 16 * wave + 4 * fq + r) * PCOLS + PC_SGU + g * 128 + 16 * nt + fr];
        float bsv[4];
#pragma unroll
        for (int r = 0; r < 4; ++r) bsv[r] = sb[16 * wave + 4 * fq + r];
        asm volatile("" ::: "memory");
#pragma unroll
        for (int r = 0; r < 4; ++r) { const int i = 16 * wave + 4 * fq + r; const float bs = bsv[r]; const size_t m = (size_t)(m0 + i);
#pragma unroll
            for (int nt = 0; nt < 8; ++nt) { const int dcol = g * 128 + 16 * nt + fr; const float uu = gelu_erf(bf2f(ur[r][nt]));
                Y[m * D + 1024 + dcol] = (bf16_t)f2bf(uu * (acc[nt][r] + bs)); } }
    }
}
DI void scan_load_chunk(unsigned char* bufp, const float* Rr, const float* Wr, const float* Kr, const float* Ar, const float* Br, const float* Vr, size_t base, int c, int rg, int lt) {
    const float* arrs[5] = {Rr, Wr, Kr, Ar, Br};
#pragma unroll
    for (int ar = 0; ar < 5; ++ar)
#pragma unroll
        for (int ps = 0; ps < 2; ++ps) { const int tt = ps * 16 + (lt >> 4), c4 = (lt & 15) * 4;
            const f32x4 v = *(const f32x4*)(arrs[ar] + base + (size_t)(c * 32 + tt) * RW + c4);
            *(f32x4*)(bufp + ar * 8192 + (tt * 64 + c4) * 4) = v; }
    if (lt < 128) { const int tt = lt >> 2, i4 = (lt & 3) * 4; const f32x4 v = *(const f32x4*)(Vr + base + (size_t)(c * 32 + tt) * RW + rg * 16 + i4);
        *(f32x4*)(bufp + 5 * 8192 + (tt * 16 + i4) * 4) = v; }
}
DI void scan_phase(const Args& a, unsigned char* lds) {
    const int tidx_ = otid();
    const int tid = tidx_;
    const float* Rr = (const float*)(a.ws + OFF_SCR); const float* Wr = Rr + (size_t)M * RW; const float* Kr = Wr + (size_t)M * RW; const float* Vr = Kr + (size_t)M * RW; const float* Ar = Vr + (size_t)M * RW; const float* Br = Ar + (size_t)M * RW;
    float* Yraw = (float*)(a.ws + OFF_X);
    constexpr int BUFB = 5 * 8192 + 2048;
    constexpr int NCH = SEQ / 32;
    for (int unit = blockIdx.x; unit < 256; unit += gridDim.x) {
        const int rg = unit & 3, h = (unit >> 2) & 15, b_ = unit >> 6;
        const size_t base = (size_t)b_ * SEQ * RW + h * 64;
        __syncthreads();
        const bool loader = tid >= 256; const int lt = tid - 256;
        if (loader) scan_load_chunk(lds, Rr, Wr, Kr, Ar, Br, Vr, base, 0, rg, lt);
        __syncthreads();
        float S0 = 0.f, S1 = 0.f, S2 = 0.f, S3 = 0.f;
        const int i = tid >> 4, c4 = tid & 15;
#pragma unroll 1
        for (int c = 0; c < NCH; ++c) {
            if (loader) {
                if (c > 0 && lt < 128) { const int tt = lt >> 2, i4 = (lt & 3) * 4; const f32x4 y = *(const f32x4*)(lds + 2 * BUFB + ((c - 1) & 1) * 2048 + (tt * 16 + i4) * 4);
                    *(f32x4*)(Yraw + base + (size_t)((c - 1) * 32 + tt) * RW + rg * 16 + i4) = y; }
                if (c + 1 < NCH) scan_load_chunk(lds + ((c + 1) & 1) * BUFB, Rr, Wr, Kr, Ar, Br, Vr, base, c + 1, rg, lt);
            } else {
                const unsigned char* bufp = lds + (c & 1) * BUFB; float* yb = (float*)(lds + 2 * BUFB + (c & 1) * 2048);
#pragma unroll 4
                for (int s = 0; s < 32; ++s) {
                    const f32x4 r4 = *(const f32x4*)(bufp + 0 * 8192 + (s * 64 + c4 * 4) * 4);
                    const f32x4 w4 = *(const f32x4*)(bufp + 1 * 8192 + (s * 64 + c4 * 4) * 4);
                    const f32x4 k4 = *(const f32x4*)(bufp + 2 * 8192 + (s * 64 + c4 * 4) * 4);
                    const f32x4 a4 = *(const f32x4*)(bufp + 3 * 8192 + (s * 64 + c4 * 4) * 4);
                    const f32x4 b4 = *(const f32x4*)(bufp + 4 * 8192 + (s * 64 + c4 * 4) * 4);
                    const float vi = *(const float*)(bufp + 5 * 8192 + (s * 16 + i) * 4);
                    float sa = (S0 * a4[0] + S1 * a4[1]) + (S2 * a4[2] + S3 * a4[3]);
                    sa = row16_sum(sa);
                    S0 = S0 * w4[0] + sa * b4[0] + vi * k4[0]; S1 = S1 * w4[1] + sa * b4[1] + vi * k4[1];
                    S2 = S2 * w4[2] + sa * b4[2] + vi * k4[2]; S3 = S3 * w4[3] + sa * b4[3] + vi * k4[3];
                    float yp = (S0 * r4[0] + S1 * r4[1]) + (S2 * r4[2] + S3 * r4[3]);
                    yp = row16_sum(yp);
                    if (c4 == 0) yb[s * 16 + i] = yp;
                }
            }
            __syncthreads();
        }
        if (loader && lt < 128) { const int tt = lt >> 2, i4 = (lt & 3) * 4; const f32x4 y = *(const f32x4*)(lds + 2 * BUFB + ((NCH - 1) & 1) * 2048 + (tt * 16 + i4) * 4);
            *(f32x4*)(Yraw + base + (size_t)((NCH - 1) * 32 + tt) * RW + rg * 16 + i4) = y; }
    }
}
DI void rwkv_fin_phase(const Args& a, int L) {
    const int tidx_ = otid();
    const int wave = __builtin_amdgcn_readfirstlane(tidx_ >> 6), lane = tidx_ & 63;
    const float* Rr = (const float*)(a.ws + OFF_SCR); const float* Kr = Rr + 2 * (size_t)M * RW; const float* Vr = Kr + (size_t)M * RW;
    const float* Yraw = (const float*)(a.ws + OFF_X); const bf16_t* Gb = (const bf16_t*)(a.ws + OFF_MG); bf16_t* Y = (bf16_t*)(a.ws + OFF_Y);
    const float* rk = a.in[I_RK] + L * RW; const float* gng = a.in[I_GNG] + L * RW; const float* gnb = a.in[I_GNB] + L * RW;
    for (int it = blockIdx.x * 8 + wave; it < M * 16; it += gridDim.x * 8) {
        const int m = it >> 4, h = it & 15, c = h * 64 + lane; const size_t o = (size_t)m * RW + c;
        const float y = Yraw[o], r = Rr[o], k = Kr[o], v = Vr[o];
        const float mean = wave_sum(y) * (1.0f / 64.0f); const float d = y - mean; const float var = wave_sum(d * d) * (1.0f / 64.0f);
        const float yn = d * (1.0f / sqrtf(var + 64e-5f)) * gng[c] + gnb[c];
        const float bonus = wave_sum(r * k * rk[c]) * v;
        Y[(size_t)m * D + c] = (bf16_t)f2bf((yn + bonus) * bf2f(Gb[o]));
    }
}
DI void rwkv_par_phase(const Args& a, int L, unsigned char* lds) {
    const int tidx_ = otid();
    const int tid = tidx_, wave = __builtin_amdgcn_readfirstlane(tid >> 6), lane = tid & 63, fr = lane & 15, q = lane >> 4;
    const bf16_t* P = (const bf16_t*)(a.ws + OFF_P); unsigned char* RECB = a.ws + OFF_SCR;
    const bf16_t* W2T = (const bf16_t*)(a.ws + OFF_LW2); const bf16_t* A2T = (const bf16_t*)(a.ws + OFF_LA2); const bf16_t* G2T = (const bf16_t*)(a.ws + OFF_LG2);
    const float* mu = a.in[I_MU] + (size_t)L * 3360; const float* w0 = a.in[I_W0] + L * RW; const float* a0 = a.in[I_A0] + L * RW;
    const float* kkw = a.in[I_KK] + L * RW; const float* kaw = a.in[I_KA] + L * RW; const float* rkw = a.in[I_RK] + L * RW;
    unsigned char* XL = lds;
    unsigned char* WS = lds + 9472 + wave * 12288;
    for (int unit = blockIdx.x; unit < NB * 256; unit += gridDim.x) {
        const int b_ = unit >> 8, cidx = unit & 255; const int m0 = b_ * SEQ + cidx * 16;
        __syncthreads();
        { const int t0 = 2 * wave; const int mrow = m0 + t0; const bool frow = (mrow & (SEQ - 1)) == 0;
          const bf16_t* prow = P + (size_t)mrow * PCOLS + PC_LORA; const bf16_t* pprev = frow ? prow : prow - PCOLS;
          bf16_t xp[5], x0[5], x1[5]; float muv[5];
#pragma unroll
          for (int p = 0; p < 5; ++p) { const int col = lane + 64 * p, colc = col < 288 ? col : 0; xp[p] = pprev[colc]; x0[p] = prow[colc]; x1[p] = prow[PCOLS + colc]; muv[p] = mu[3072 + colc]; }
#pragma unroll
          for (int p = 0; p < 5; ++p) { const int col = lane + 64 * p; const float c0 = bf2f(x0[p]), c1 = bf2f(x1[p]), pv = frow ? 0.f : bf2f(xp[p]);
              float y0 = c0 + (pv - c0) * muv[p], y1 = c1 + (c0 - c1) * muv[p];
              if (p == 0) { y0 = 1.0f - 2.0f * __builtin_amdgcn_rcpf(__expf(2.0f * y0) + 1.0f); y1 = 1.0f - 2.0f * __builtin_amdgcn_rcpf(__expf(2.0f * y1) + 1.0f); }
              else if (p >= 2) { y0 = __builtin_amdgcn_rcpf(1.0f + __expf(-y0)); y1 = __builtin_amdgcn_rcpf(1.0f + __expf(-y1)); }
              if (col < 288) { *(bf16_t*)(XL + t0 * 592 + col * 2) = (bf16_t)f2bf(y0); *(bf16_t*)(XL + (t0 + 1) * 592 + col * 2) = (bf16_t)f2bf(y1); } } }
        __syncthreads();
#define AXF(ks) (*(const bf16x8*)(XL + fr * 592 + (32 * (ks) + 8 * q) * 2))
#pragma unroll 1
        for (int hh2 = 0; hh2 < 2; ++hh2) {
            const int h = wave + 8 * hh2; const int c = h * 64 + lane;
            unsigned char* rec = RECB + (size_t)(cidx * 64 + b_ * 16 + h) * REC;
            const bool first = (m0 & (SEQ - 1)) == 0;
            const bf16_t* pbase = P + (size_t)m0 * PCOLS + h * 64;
            const float w0c = w0[c], a0c = a0[c], kkc = kkw[c], kac = kaw[c], rkc = rkw[c], mur = mu[c], muk = mu[1024 + c], muv = mu[2048 + c];
            bf16x8 bwf[4][2], baf[4][2];
#pragma unroll
            for (int nt = 0; nt < 4; ++nt) { const int cn = h * 64 + 16 * nt + fr;
#pragma unroll
                for (int ks = 0; ks < 2; ++ks) { bwf[nt][ks] = *(const bf16x8*)(W2T + cn * 64 + 32 * ks + 8 * q); baf[nt][ks] = *(const bf16x8*)(A2T + cn * 64 + 32 * ks + 8 * q); } }
            asm volatile("" ::: "memory");
            f32x4 accW[4], accA[4], accG[4];
#pragma unroll
            for (int nt = 0; nt < 4; ++nt) { accW[nt] = (f32x4){0.f, 0.f, 0.f, 0.f}; accA[nt] = accW[nt]; accG[nt] = accW[nt];
#pragma unroll
                for (int ks = 0; ks < 2; ++ks) { accW[nt] = __builtin_amdgcn_mfma_f32_16x16x32_bf16(AXF(ks), bwf[nt][ks], accW[nt], 0, 0, 0); accA[nt] = __builtin_amdgcn_mfma_f32_16x16x32_bf16(AXF(2 + ks), baf[nt][ks], accA[nt], 0, 0, 0); } }
#pragma unroll
            for (int n2 = 0; n2 < 2; ++n2) { bf16x8 bgf[2][5];
#pragma unroll
                for (int nn = 0; nn < 2; ++nn) { const int cn = h * 64 + 16 * (2 * n2 + nn) + fr;
#pragma unroll
                    for (int ks = 0; ks < 5; ++ks) bgf[nn][ks] = *(const bf16x8*)(G2T + cn * 160 + 32 * ks + 8 * q); }
                asm volatile("" ::: "memory");
#pragma unroll
                for (int nn = 0; nn < 2; ++nn)
#pragma unroll
                    for (int ks = 0; ks < 5; ++ks) accG[2 * n2 + nn] = __builtin_amdgcn_mfma_f32_16x16x32_bf16(AXF(4 + ks), bgf[nn][ks], accG[2 * n2 + nn], 0, 0, 0); }
            unsigned rawrk[17], rawvv[9];
#pragma unroll
            for (int t = 0; t < 17; ++t) { const bf16_t* pc = pbase + (ptrdiff_t)(t - 1) * PCOLS; const bool ok = t > 0 || !first;
                const unsigned rr_ = ok ? (unsigned)pc[PC_R + lane] : 0u, kk_ = ok ? (unsigned)pc[PC_K + lane] : 0u, vv_ = ok ? (unsigned)pc[PC_V + lane] : 0u;
                rawrk[t] = rr_ | (kk_ << 16); if (t & 1) rawvv[t >> 1] |= vv_ << 16; else rawvv[t >> 1] = vv_; }
            float* X3 = (float*)WS;
#pragma unroll
            for (int nt = 0; nt < 4; ++nt)
#pragma unroll
                for (int r = 0; r < 4; ++r) { const int o = (4 * q + r) * 64 + 16 * nt + fr; X3[o] = accW[nt][r]; X3[1024 + o] = accA[nt][r]; X3[2048 + o] = accG[nt][r]; }
            float cum[16], asg[16];
            { float run = 0.f;
#pragma unroll
              for (int t = 0; t < 16; ++t) { float dw = X3[t * 64 + lane], da = X3[1024 + t * 64 + lane], dg = X3[2048 + t * 64 + lane];
#if DBG_LORA
                  { const float* w2 = a.in[I_W2] + (size_t)L * 64 * RW; const float* a2 = a.in[I_A2] + (size_t)L * 64 * RW; const float* g2 = a.in[I_G2] + (size_t)L * 160 * RW;
                    float s0 = 0.f, s1 = 0.f, s2 = 0.f;
                    for (int jj = 0; jj < 64; ++jj) { s0 += bf2f(*(const bf16_t*)(XL + t * 592 + jj * 2)) * w2[(size_t)jj * RW + c]; s1 += bf2f(*(const bf16_t*)(XL + t * 592 + (64 + jj) * 2)) * a2[(size_t)jj * RW + c]; }
                    for (int jj = 0; jj < 160; ++jj) s2 += bf2f(*(const bf16_t*)(XL + t * 592 + (128 + jj) * 2)) * g2[(size_t)jj * RW + c];
                    dw = s0; da = s1; dg = s2; }
#endif
                  const float nx = -(w0c + dw);
                  run += -0.60653065971263342f * __builtin_amdgcn_rcpf(1.0f + __expf(nx)); cum[t] = run; asg[t] = __builtin_amdgcn_rcpf(1.0f + __expf(-(a0c + da)));
                  *(bf16_t*)(rec + R_G + (t * 64 + lane) * 2) = (bf16_t)f2bf(dg); } }
            asm volatile("" ::: "memory");
            const float gC = __expf(cum[15]); *(float*)(rec + R_GC + lane * 4) = gC;
            bf16_t* imgA = (bf16_t*)WS; bf16_t* imgR = (bf16_t*)(WS + 2304); bf16_t* imgB = (bf16_t*)(WS + 4608); bf16_t* imgK = (bf16_t*)(WS + 6912);
            float At[16]; unsigned vpk[8]; float bgv[4], kgv[4]; float vprev = 0.f;
            float rr[16], kkv[16], k2v[16], rsn, vp = bflo(rawvv[0]);
            { float sq[16], bo[16]; float rp = bflo(rawrk[0]), kp = bfhi(rawrk[0]);
#pragma unroll
              for (int t = 0; t < 16; ++t) { const float rc = bflo(rawrk[t + 1]), kc = bfhi(rawrk[t + 1]);
                  const float r = rc + (rp - rc) * mur, k = kc + (kp - kc) * muk; rp = rc; kp = kc;
                  const float kk = k * kkc, k2 = k * (1.0f + (asg[t] - 1.0f) * kac);
                  rr[t] = r; kkv[t] = kk; k2v[t] = k2; sq[t] = kk * kk; bo[t] = r * k2 * rkc; }
              const float sqs = rs16(sq, lane), bos = rs16(bo, lane);
              rsn = __builtin_amdgcn_rsqf(fmaxf(sqs, 1e-24f));
              if ((lane & 12) == 0) *(float*)(rec + R_BON + ((lane & 3) + 4 * (lane >> 4)) * 4) = bos; }
            float eprev = 1.0f;
#pragma unroll
            for (int t = 0; t < 16; ++t) {
                const float vc = ((t + 1) & 1) ? bfhi(rawvv[(t + 1) >> 1]) : bflo(rawvv[(t + 1) >> 1]);
                const float r = rr[t], v = vc + (vp - vc) * muv; vp = vc;
                const float asig = asg[t];
                const float kkn = kkv[t] * __int_as_float(__builtin_amdgcn_readlane(__float_as_int(rsn), (t & 3) + 16 * (t >> 2)));
                const float k2 = k2v[t]; const float av = -kkn, bv = kkn * asig;
                const float e2 = __expf(cum[t]), e3 = __expf(-cum[t]), e4 = gC * e3;
                At[t] = eprev * av; eprev = e2;
                const float Rt = e2 * r, Bt = bv * e3, Kt = k2 * e3;
                imgA[t * 72 + lane] = (bf16_t)f2bf(At[t]); imgR[t * 72 + lane] = (bf16_t)f2bf(Rt); imgB[t * 72 + lane] = (bf16_t)f2bf(Bt); imgK[t * 72 + lane] = (bf16_t)f2bf(Kt);
                *(bf16_t*)(rec + R_RL2 + t * RROW + lane * 2) = (bf16_t)f2bf(Rt);
                bgv[t & 3] = bv * e4; kgv[t & 3] = k2 * e4;
                if ((t & 3) == 3) { u32x4 o; o.x = pk2(bgv[0], bgv[1]); o.y = pk2(bgv[2], bgv[3]); o.z = pk2(kgv[0], kgv[1]); o.w = pk2(kgv[2], kgv[3]); *(u32x4*)(rec + R_A2 + (lane * 4 + (t >> 2)) * 16) = o; }
                if (t & 1) vpk[t >> 1] = pk2(vprev, v); else vprev = v; }
            { u32x4 o0, o1; o0.x = vpk[0]; o0.y = vpk[1]; o0.z = vpk[2]; o0.w = vpk[3]; o1.x = vpk[4]; o1.y = vpk[5]; o1.z = vpk[6]; o1.w = vpk[7];
              *(u32x4*)(rec + R_VT + lane * 32) = o0; *(u32x4*)(rec + R_VT + lane * 32 + 16) = o1; }
            asm volatile("" ::: "memory");
            f32x4 gAB = (f32x4){0.f, 0.f, 0.f, 0.f}, gAK = gAB, gBR = gAB, gKR = gAB;
#pragma unroll
            for (int ks = 0; ks < 2; ++ks) { const int off = fr * 72 + 32 * ks + 8 * q;
                const bf16x8 fA = *(const bf16x8*)(imgA + off), fR = *(const bf16x8*)(imgR + off), fB = *(const bf16x8*)(imgB + off), fK = *(const bf16x8*)(imgK + off);
                gAB = __builtin_amdgcn_mfma_f32_16x16x32_bf16(fB, fA, gAB, 0, 0, 0); gAK = __builtin_amdgcn_mfma_f32_16x16x32_bf16(fK, fA, gAK, 0, 0, 0);
                gBR = __builtin_amdgcn_mfma_f32_16x16x32_bf16(fB, fR, gBR, 0, 0, 0); gKR = __builtin_amdgcn_mfma_f32_16x16x32_bf16(fK, fR, gKR, 0, 0, 0); }
#pragma unroll
            for (int r = 0; r < 4; ++r) { const int sI = 4 * q + r; gAB[r] = sI < fr ? gAB[r] : 0.f; gAK[r] = sI < fr ? gAK[r] : 0.f; gBR[r] = sI <= fr ? gBR[r] : 0.f; gKR[r] = sI <= fr ? gKR[r] : 0.f; }
            { u32x4 o; o.x = pk2(gBR[0], gBR[1]); o.y = pk2(gBR[2], gBR[3]); o.z = pk2(gKR[0], gKR[1]); o.w = pk2(gKR[2], gKR[3]); *(u32x4*)(rec + R_A3 + (fr * 4 + q) * 16) = o; }
            asm volatile("" ::: "memory");
            float* AKL = (float*)(WS + 9216);
#pragma unroll
            for (int r = 0; r < 4; ++r) AKL[(4 * q + r) * 16 + fr] = gAK[r];
            float* ABL = (float*)(WS + 11264);
#pragma unroll
            for (int r = 0; r < 4; ++r) ABL[(4 * q + r) * 16 + fr] = gAB[r];
            float Ft[16];
            { const f32x4* row = (const f32x4*)(AKL + (lane & 15) * 16);
#pragma unroll
              for (int t4 = 0; t4 < 4; ++t4) { const f32x4 v4 = row[t4]; Ft[4 * t4] = v4[0]; Ft[4 * t4 + 1] = v4[1]; Ft[4 * t4 + 2] = v4[2]; Ft[4 * t4 + 3] = v4[3]; } }
#pragma unroll
            for (int s2 = 0; s2 < 15; ++s2) {
                const f32x2 src = {At[s2], Ft[s2]};
#pragma unroll
                for (int j = (s2 + 1) >> 2; j < 4; ++j) { const f32x4 sc4 = *(const f32x4*)(ABL + s2 * 16 + 4 * j);
#pragma unroll
                    for (int e = 0; e < 4; ++e) { const int t = 4 * j + e; if (t > s2) { const f32x2 scv = {sc4[e], sc4[e]}; f32x2 dst = {At[t], Ft[t]}; dst = __builtin_elementwise_fma(src, scv, dst); At[t] = dst[0]; Ft[t] = dst[1]; } } } }
#pragma unroll
            for (int t = 0; t < 16; ++t) *(bf16_t*)(rec + R_EL2 + t * RROW + lane * 2) = (bf16_t)f2bf(At[t]);
            asm volatile("" ::: "memory");
            float* FL = (float*)(WS + 10240);
            if (lane < 16) {
#pragma unroll
                for (int t4 = 0; t4 < 4; ++t4) *(f32x4*)(FL + lane * 16 + 4 * t4) = (f32x4){Ft[4 * t4], Ft[4 * t4 + 1], Ft[4 * t4 + 2], Ft[4 * t4 + 3]}; }
            { const float f0 = FL[(4 * q + 0) * 16 + fr], f1 = FL[(4 * q + 1) * 16 + fr], f2 = FL[(4 * q + 2) * 16 + fr], f3 = FL[(4 * q + 3) * 16 + fr];
              u32x2 o; o.x = pk2(f0, f1); o.y = pk2(f2, f3); *(u32x2*)(rec + R_FT + (fr * 4 + q) * 8) = o; }
            asm volatile("" ::: "memory");
        }
    }
#undef AXF
}
DI bf16x8 mk8(u32x2 lo, u32x2 hi) { u32x4 w; w.x = lo.x; w.y = lo.y; w.z = hi.x; w.w = hi.y; return __builtin_bit_cast(bf16x8, w); }
struct SeqOps { u32x2 e[2][2], r[2][2]; u32x4 a2[4]; u32x4 a3; u32x2 ft, vt; f32x4 gc[4]; };
DI void seq_ops_load(SeqOps& f, const LAS unsigned char* rec, int fr, int q, int i0) {
#pragma unroll
    for (int ks = 0; ks < 2; ++ks) { f.e[ks][0] = *(const LAS u32x2*)(rec + R_EL2 + fr * RROW + (32 * ks + 4 * q) * 2); f.e[ks][1] = *(const LAS u32x2*)(rec + R_EL2 + fr * RROW + (32 * ks + 16 + 4 * q) * 2);
        f.r[ks][0] = *(const LAS u32x2*)(rec + R_RL2 + fr * RROW + (32 * ks + 4 * q) * 2); f.r[ks][1] = *(const LAS u32x2*)(rec + R_RL2 + fr * RROW + (32 * ks + 16 + 4 * q) * 2); }
#pragma unroll
    for (int jt = 0; jt < 4; ++jt) { f.a2[jt] = *(const LAS u32x4*)(rec + R_A2 + ((16 * jt + fr) * 4 + q) * 16); f.gc[jt] = *(const LAS f32x4*)(rec + R_GC + (16 * jt + 4 * q) * 4); }
    f.a3 = *(const LAS u32x4*)(rec + R_A3 + (fr * 4 + q) * 16); f.ft = *(const LAS u32x2*)(rec + R_FT + (fr * 4 + q) * 8); f.vt = *(const LAS u32x2*)(rec + R_VT + ((i0 + fr) * 16 + 4 * q) * 2);
}
DI void rwkv_seq_phase(const Args& a, unsigned char* lds, float* yout, const float* gng, const float* gnb, bf16_t* yfin) {
    const int tidx_ = otid();
    const int tid = tidx_, wave = __builtin_amdgcn_readfirstlane(tid >> 6), lane = tid & 63, fr = lane & 15, q = lane >> 4;
    constexpr int NR = 8, DEPTH_ = 6, NCHK = 256;
    LAS unsigned char* ring = (LAS unsigned char*)lds;
    LAS float* ybuf = (LAS float*)(ring + NR * REC);
    for (int bh = blockIdx.x; bh < NB * 16; bh += gridDim.x) {
        const unsigned char* rec0 = a.ws + OFF_SCR + (size_t)bh * REC;
        const int hd = bh & 15;
        asm volatile("s_waitcnt vmcnt(0) lgkmcnt(0)" ::: "memory"); __builtin_amdgcn_s_barrier();
        if (wave >= 4) {
            const int lw = wave - 4;
            const float gg = yfin ? gng[hd * 64 + lane] : 0.f, gb = yfin ? gnb[hd * 64 + lane] : 0.f;
            bf16_t* Yo = yfin + ((size_t)(bh >> 4) * SEQ) * D + hd * 64 + lane;
#define SEQ_ISSUE(cc) do { const unsigned char* g_ = rec0 + (size_t)(cc) * 64 * REC; LAS unsigned char* l_ = ring + ((cc) & (NR - 1)) * REC; \
            _Pragma("unroll") for (int i_ = 0; i_ < 4; ++i_) { int pc_ = i_ * 4 + lw; if (pc_ >= 15) pc_ = lw; \
                __builtin_amdgcn_global_load_lds((const unsigned*)(g_ + pc_ * 1024 + lane * 16), (LAS unsigned*)(l_ + pc_ * 1024), 16, 0, 0); } } while (0)
#define SEQ_FINALIZE(cf) do { const LAS unsigned char* rc_ = ring + ((cf) & (NR - 1)) * REC; const LAS float* yb_ = ybuf + ((cf) & 1) * 1024; \
            const u32x2 vv_ = *(const LAS u32x2*)(rc_ + R_VT + (lane * 16 + 4 * lw) * 2); \
            float y_[4], rd_[8]; \
            _Pragma("unroll") for (int tt_ = 0; tt_ < 4; ++tt_) { y_[tt_] = yb_[(4 * lw + tt_) * 64 + lane]; rd_[tt_] = y_[tt_]; rd_[4 + tt_] = y_[tt_] * y_[tt_]; } \
              \
            float mean4_, rstd4_; \
            { float z_[4], w_[2]; \
              _Pragma("unroll") for (int i_ = 0; i_ < 4; ++i_) { auto p_ = __builtin_amdgcn_permlane32_swap(__float_as_uint(rd_[i_]), __float_as_uint(rd_[i_ + 4]), false, false); z_[i_] = __uint_as_float(p_[0]) + __uint_as_float(p_[1]); } \
              _Pragma("unroll") for (int i_ = 0; i_ < 2; ++i_) { auto p_ = __builtin_amdgcn_permlane16_swap(__float_as_uint(z_[i_]), __float_as_uint(z_[i_ + 2]), false, false); w_[i_] = __uint_as_float(p_[0]) + __uint_as_float(p_[1]); } \
              const bool b0_ = (lane & 1) != 0; float u_ = (b0_ ? w_[1] : w_[0]) + dpp_f<0xB1>(b0_ ? w_[0] : w_[1]); \
              u_ += dpp_f<0x122>(u_); u_ += dpp_f<0x124>(u_); u_ += dpp_f<0x128>(u_);        \
              auto q_ = __builtin_amdgcn_permlane32_swap(__float_as_uint(u_), __float_as_uint(u_), false, false);        \
              mean4_ = __uint_as_float(q_[0]) * (1.0f / 64.0f); rstd4_ = __builtin_amdgcn_rsqf(fmaxf(__uint_as_float(q_[1]) * (1.0f / 64.0f) - mean4_ * mean4_, 0.f) + 64e-5f); } \
            _Pragma("unroll") for (int tt_ = 0; tt_ < 4; ++tt_) { const int t_ = 4 * lw + tt_; \
                const float mean_ = __int_as_float(__builtin_amdgcn_readlane(__float_as_int(mean4_), (tt_ & 1) + 16 * (tt_ >> 1))), rs_ = __int_as_float(__builtin_amdgcn_readlane(__float_as_int(rstd4_), (tt_ & 1) + 16 * (tt_ >> 1))); \
                const float yn_ = (y_[tt_] - mean_) * rs_ * gg + gb; \
                const float bon_ = *(const LAS float*)(rc_ + R_BON + t_ * 4); const float g_ = bf2f(*(const LAS bf16_t*)(rc_ + R_G + (t_ * 64 + lane) * 2)); \
                const unsigned vw_ = (tt_ & 2) ? vv_.y : vv_.x; const float v_ = (tt_ & 1) ? bfhi(vw_) : bflo(vw_); \
                Yo[(size_t)(16 * (cf) + t_) * D] = (bf16_t)f2bf((yn_ + bon_ * v_) * g_); } } while (0)
#pragma unroll 1
            for (int cc = 0; cc < DEPTH_; ++cc) SEQ_ISSUE(cc);
            asm volatile("s_waitcnt vmcnt(16)" ::: "memory");
            __builtin_amdgcn_s_barrier();
#pragma unroll 1
            for (int c = 0; c < NCHK; ++c) {
                if (yfin && c > 0) SEQ_FINALIZE(c - 1);
                if (c + DEPTH_ < NCHK) { SEQ_ISSUE(c + DEPTH_); asm volatile("s_waitcnt vmcnt(16)" ::: "memory"); }
                else asm volatile("s_waitcnt vmcnt(0)" ::: "memory");
                asm volatile("s_waitcnt lgkmcnt(0)" ::: "memory");
                __builtin_amdgcn_s_barrier();
            }
            if (yfin) SEQ_FINALIZE(NCHK - 1);
#undef SEQ_ISSUE
#undef SEQ_FINALIZE
        } else {
            const int i0 = wave * 16;
            float* Yp = yout + (size_t)(bh >> 4) * SEQ * RW + hd * 64 + i0 + fr;
            f32x4 S[4];
#pragma unroll
            for (int jt = 0; jt < 4; ++jt) S[jt] = (f32x4){0.f, 0.f, 0.f, 0.f};
            __builtin_amdgcn_s_barrier();
#define SEQ_STEP(CUR, NXT, CC) do { const int c = (CC); \
                if (c + 1 < NCHK) seq_ops_load(NXT, ring + ((c + 1) & (NR - 1)) * REC, fr, q, i0); \
                bf16x8 sh[2]; \
_Pragma("unroll") \
                for (int ks = 0; ks < 2; ++ks) { u32x4 hw; hw.x = pk2(S[2 * ks][0], S[2 * ks][1]); hw.y = pk2(S[2 * ks][2], S[2 * ks][3]); hw.z = pk2(S[2 * ks + 1][0], S[2 * ks + 1][1]); hw.w = pk2(S[2 * ks + 1][2], S[2 * ks + 1][3]); sh[ks] = __builtin_bit_cast(bf16x8, hw); } \
                const u32x2 z2 = {0u, 0u}; const f32x4 zz = (f32x4){0.f, 0.f, 0.f, 0.f}; \
                f32x4 Wk[2], Yk[2]; \
_Pragma("unroll") \
                for (int ks = 0; ks < 2; ++ks) { Wk[ks] = __builtin_amdgcn_mfma_f32_16x16x32_bf16(mk8(CUR.e[ks][0], CUR.e[ks][1]), sh[ks], zz, 0, 0, 0); Yk[ks] = __builtin_amdgcn_mfma_f32_16x16x32_bf16(mk8(CUR.r[ks][0], CUR.r[ks][1]), sh[ks], zz, 0, 0, 0); } \
                const f32x4 Wv = __builtin_amdgcn_mfma_f32_16x16x32_bf16(mk8(CUR.ft, z2), mk8(CUR.vt, z2), zz, 0, 0, 0); \
                const f32x4 W = (Wk[0] + Wk[1]) + Wv; f32x4 Y = Yk[0] + Yk[1]; \
                u32x2 wp; wp.x = pk2(W[0], W[1]); wp.y = pk2(W[2], W[3]); \
                const bf16x8 b2 = mk8(wp, CUR.vt); \
_Pragma("unroll") \
                for (int jt = 0; jt < 4; ++jt) S[jt] = __builtin_amdgcn_mfma_f32_16x16x32_bf16(__builtin_bit_cast(bf16x8, CUR.a2[jt]), b2, S[jt] * CUR.gc[jt], 0, 0, 0); \
                Y = __builtin_amdgcn_mfma_f32_16x16x32_bf16(__builtin_bit_cast(bf16x8, CUR.a3), b2, Y, 0, 0, 0); \
                if (yfin) { \
_Pragma("unroll") \
                    for (int r = 0; r < 4; ++r) ybuf[(c & 1) * 1024 + (4 * q + r) * 64 + i0 + fr] = Y[r]; \
                } else { \
_Pragma("unroll") \
                    for (int r = 0; r < 4; ++r) Yp[(size_t)(16 * c + 4 * q + r) * RW] = Y[r]; \
                } \
                asm volatile("s_waitcnt lgkmcnt(0)" ::: "memory"); \
                __builtin_amdgcn_s_barrier(); \
            } while (0)
            SeqOps opA, opB; seq_ops_load(opA, ring, fr, q, i0);
#pragma unroll 1
            for (int c2 = 0; c2 < NCHK; c2 += 2) { SEQ_STEP(opA, opB, c2); SEQ_STEP(opB, opA, c2 + 1); }
#undef SEQ_STEP
        }
    }
}
DI void rwkv_fin2_phase(const Args& a, int L) {
    const int tidx_ = otid();
    const int wave = __builtin_amdgcn_readfirstlane(tidx_ >> 6), lane = tidx_ & 63;
    const float* Yraw = (const float*)(a.ws + OFF_X); bf16_t* Y = (bf16_t*)(a.ws + OFF_Y);
    const float* gng = a.in[I_GNG] + L * RW; const float* gnb = a.in[I_GNB] + L * RW;
    for (int u = blockIdx.x * 8 + wave; u < NB * 16 * 256; u += gridDim.x * 8) {
        const int cidx = u & 255, bh = u >> 8, h = bh & 15, b_ = bh >> 4; const int c = h * 64 + lane;
        const unsigned char* rec = a.ws + OFF_SCR + (size_t)(cidx * 64 + bh) * REC;
        const u32x4 v0 = *(const u32x4*)(rec + R_VT + lane * 32), v1 = *(const u32x4*)(rec + R_VT + lane * 32 + 16);
        const unsigned vw[8] = {v0.x, v0.y, v0.z, v0.w, v1.x, v1.y, v1.z, v1.w};
        const float gg = gng[c], gb = gnb[c];
#pragma unroll
        for (int t = 0; t < 16; ++t) { const size_t m = (size_t)b_ * SEQ + cidx * 16 + t;
            const float y = Yraw[m * RW + c];
            const float mean = wave_sum(y) * (1.0f / 64.0f); const float d = y - mean; const float var = wave_sum(d * d) * (1.0f / 64.0f);
            const float yn = d * __builtin_amdgcn_rsqf(var + 64e-5f) * gg + gb;
            const float bon = *(const float*)(rec + R_BON + t * 4); const float g = bf2f(*(const bf16_t*)(rec + R_G + (t * 64 + lane) * 2));
            const float v = (t & 1) ? bfhi(vw[t >> 1]) : bflo(vw[t >> 1]);
            Y[m * D + c] = (bf16_t)f2bf((yn + bon * v) * g); }
    }
}
DI void dbg_compare_phase(const Args& a) {
    const int tidx_ = otid();
    const float* y0 = (const float*)(a.ws + OFF_X); const float* y1 = y0 + (size_t)M * RW; float* acc = (float*)(a.ws + OFF_CTL) + 2048;
    float s0 = 0.f, s1 = 0.f, s2 = 0.f, s3 = 0.f;
    for (size_t i = (size_t)blockIdx.x * 512 + tidx_; i < (size_t)M * RW; i += (size_t)gridDim.x * 512) { const float o = y0[i], d = y1[i] - o; const int tok = (int)((i / RW) & (SEQ - 1));
        s0 += d * d; s1 += o * o; if (tok < 16) { s2 += d * d; s3 += o * o; } }
    s0 = wave_sum(s0); s1 = wave_sum(s1); s2 = wave_sum(s2); s3 = wave_sum(s3);
    if ((tidx_ & 63) == 0) { atomicAdd(acc + 0, s0); atomicAdd(acc + 1, s1); atomicAdd(acc + 2, s2); atomicAdd(acc + 3, s3); }
}
DI void dbg_encode_phase(const Args& a) {
    const int tidx_ = otid();
    float* acc = (float*)(a.ws + OFF_CTL) + 2048;
    const float s0 = __hip_atomic_load(acc + 0, __ATOMIC_RELAXED, __HIP_MEMORY_SCOPE_AGENT), s1 = __hip_atomic_load(acc + 1, __ATOMIC_RELAXED, __HIP_MEMORY_SCOPE_AGENT);
    const float s2 = __hip_atomic_load(acc + 2, __ATOMIC_RELAXED, __HIP_MEMORY_SCOPE_AGENT), s3 = __hip_atomic_load(acc + 3, __ATOMIC_RELAXED, __HIP_MEMORY_SCOPE_AGENT);
    const float e1 = sqrtf(s0 / fmaxf(s1, 1e-30f)), e2 = sqrtf(s2 / fmaxf(s3, 1e-30f));
    for (size_t i = (size_t)blockIdx.x * 512 + tidx_; i < (size_t)M * D; i += (size_t)gridDim.x * 512) { float v = a.out[i] * (1.0f + e1); if (i == 0) v += 1000.0f * e2; a.out[i] = v; }
}
DI unsigned f2ord(float f) { const unsigned u = __builtin_bit_cast(unsigned, f); return u ^ ((unsigned)((int)u >> 31) | 0x80000000u); }
DI float xrow16_sum(float x) {
    auto p = __builtin_amdgcn_permlane16_swap(__float_as_uint(x), __float_as_uint(x), false, false);
    x = __uint_as_float(p[0]) + __uint_as_float(p[1]);
    auto q = __builtin_amdgcn_permlane32_swap(__float_as_uint(x), __float_as_uint(x), false, false);
    return __uint_as_float(q[0]) + __uint_as_float(q[1]);
}
template <int CTRL> DI int dpp_i(int x) { return __builtin_amdgcn_update_dpp(0, x, CTRL, 0xF, 0xF, true); }
DI int wave_sum_i(int x) {
    x += dpp_i<0xB1>(x); x += dpp_i<0x4E>(x); x += dpp_i<0x141>(x); x += dpp_i<0x140>(x);
    auto p = __builtin_amdgcn_permlane16_swap((unsigned)x, (unsigned)x, false, false); x = (int)p[0] + (int)p[1];
    auto q = __builtin_amdgcn_permlane32_swap((unsigned)x, (unsigned)x, false, false); return (int)q[0] + (int)q[1];
}
DI void indexer_phase(const Args& a, unsigned char* lds, WorkQ& wq, int& item) {
    const int tidx_ = otid();
    const int tid = tidx_, wave = __builtin_amdgcn_readfirstlane(tid >> 6), lane = tid & 63, hh = lane & 15, kq = lane >> 4;
    const bf16_t* P = (const bf16_t*)(a.ws + OFF_P); const bf16_t* KI = (const bf16_t*)(a.ws + OFF_KI); unsigned long long* BMk = (unsigned long long*)(a.ws + OFF_BM);
    constexpr int STG = 256 * 128;
    unsigned long long* wbuf = (unsigned long long*)(lds + 2 * STG + wave * 512);
    const int srow = tid >> 3, sch = tid & 7;
    const int wr_off = srow * 128 + ((sch ^ (srow & 7)) << 4);
    const int rd0 = hh * 128 + ((kq ^ (hh & 7)) << 4), rd1 = hh * 128 + (((kq + 4) ^ (hh & 7)) << 4);
#pragma unroll 1
    for (; item < NB * 512; item = wq_next(wq, item, lds, tid)) {
        const int b_ = item & 3, qg = 511 - (item >> 2);
        const int t0 = qg * 8, t = t0 + wave, nk = t0 + 8; const size_t m = (size_t)b_ * SEQ + t;
        const int nst = (nk + 255) >> 8;
        bf16x8 aq[2];
        aq[0] = *(const bf16x8*)(P + m * PCOLS + PC_QI + hh * 64 + 8 * kq); aq[1] = *(const bf16x8*)(P + m * PCOLS + PC_QI + hh * 64 + 32 + 8 * kq);
        float blo[4], bhi[4];
#pragma unroll
        for (int r = 0; r < 4; ++r) { const bool pos = bf2f(P[m * PCOLS + PC_WI + 4 * kq + r]) >= 0.f; blo[r] = pos ? 0.f : -__builtin_inff(); bhi[r] = pos ? __builtin_inff() : 0.f; }
        { const float wrow = bf2f(P[m * PCOLS + PC_WI + hh]) * 0.03125f;
#pragma unroll
          for (int ks = 0; ks < 2; ++ks) { const u32x4 w4 = __builtin_bit_cast(u32x4, aq[ks]); u32x4 o4;
              o4.x = pk2(bflo(w4.x) * wrow, bfhi(w4.x) * wrow); o4.y = pk2(bflo(w4.y) * wrow, bfhi(w4.y) * wrow); o4.z = pk2(bflo(w4.z) * wrow, bfhi(w4.z) * wrow); o4.w = pk2(bflo(w4.w) * wrow, bfhi(w4.w) * wrow);
              aq[ks] = __builtin_bit_cast(bf16x8, o4); } }
        unsigned sc[64];
        const bf16_t* kig = KI + ((size_t)b_ * SEQ + srow) * 64 + sch * 8;
#pragma unroll 1
        for (int rep21 = 0; rep21 < ((REP_MASK >> 21) & 1u) + 1; ++rep21) {
#pragma unroll
        for (int r = 0; r < 64; ++r) sc[r] = 0u;
        u32x4 kp[4];
#pragma unroll
        for (int q = 0; q < 4; ++q) kp[q] = *(const u32x4*)(kig + (size_t)q * 64 * 64);
        __syncthreads();
        asm volatile("" :: "v"(aq[0]), "v"(aq[1]), "v"(blo[0]), "v"(blo[1]), "v"(blo[2]), "v"(blo[3]));
#pragma unroll
        for (int st = 0; st < 16; ++st) if (st < nst) {
            const int k0 = st * 256;
            unsigned char* sb = lds + (st & 1) * STG;
#pragma unroll
            for (int q = 0; q < 4; ++q) *(u32x4*)(sb + q * 64 * 128 + wr_off) = kp[q];
            __syncthreads();
            if (st + 1 < nst) {
#pragma unroll
                for (int q = 0; q < 4; ++q) kp[q] = *(const u32x4*)(kig + (size_t)(k0 + 256 + q * 64) * 64);
            }
            bf16x8 kf[2][4][2];
#pragma unroll
            for (int sub = 0; sub < 4; ++sub) { const unsigned char* kb = sb + (sub * 16) * 128; kf[0][sub][0] = *(const bf16x8*)(kb + rd0); kf[0][sub][1] = *(const bf16x8*)(kb + rd1); }
#pragma unroll
            for (int cc = 0; cc < 4; ++cc) {
                const int kc = k0 + cc * 64;
                unsigned res = 0u;
                {
                    float sv[4]; f32x4 acc4[4];
#pragma unroll
                    for (int sub = 0; sub < 4; ++sub) { const f32x4 z4 = (f32x4){0.f, 0.f, 0.f, 0.f};
                        acc4[sub] = __builtin_amdgcn_mfma_f32_16x16x32_bf16(aq[0], kf[cc & 1][sub][0], z4, 0, 0, 0);
                        acc4[sub] = __builtin_amdgcn_mfma_f32_16x16x32_bf16(aq[1], kf[cc & 1][sub][1], acc4[sub], 0, 0, 0); }
                    if (cc < 3) {
#pragma unroll
                        for (int sub = 0; sub < 4; ++sub) { const unsigned char* kb = sb + ((cc + 1) * 64 + sub * 16) * 128; kf[(cc + 1) & 1][sub][0] = *(const bf16x8*)(kb + rd0); kf[(cc + 1) & 1][sub][1] = *(const bf16x8*)(kb + rd1); } }
                    __builtin_amdgcn_sched_barrier(0);
#pragma unroll
                    for (int sub = 0; sub < 4; ++sub) { const f32x4 acc = acc4[sub];
                        sv[sub] = (__builtin_amdgcn_fmed3f(acc[0], blo[0], bhi[0]) + __builtin_amdgcn_fmed3f(acc[1], blo[1], bhi[1])) + (__builtin_amdgcn_fmed3f(acc[2], blo[2], bhi[2]) + __builtin_amdgcn_fmed3f(acc[3], blo[3], bhi[3]));
                    }
                    auto p01 = __builtin_amdgcn_permlane16_swap(__float_as_uint(sv[0]), __float_as_uint(sv[1]), false, false);
                    auto p23 = __builtin_amdgcn_permlane16_swap(__float_as_uint(sv[2]), __float_as_uint(sv[3]), false, false);
                    const float x01 = __uint_as_float(p01[0]) + __uint_as_float(p01[1]), x23 = __uint_as_float(p23[0]) + __uint_as_float(p23[1]);
                    auto pf = __builtin_amdgcn_permlane32_swap(__float_as_uint(x01), __float_as_uint(x23), false, false);
                    const float tot = __uint_as_float(pf[0]) + __uint_as_float(pf[1]);
                    res = f2ord(tot); if (st + 1 == nst) res = (kc + lane <= t) ? res : 0u;
                }
                sc[4 * st + cc] = res;
            }
        }
        }
        const int nuse = 4 * nst;
#pragma unroll 1
        for (int rep22 = 0; rep22 < ((REP_MASK >> 22) & 1u) + 1; ++rep22) {
        if (t + 1 > 256) {
            unsigned T = 0u; bool exact = false;
#pragma unroll 1
            for (int bit = 31; bit >= 0; --bit) { const unsigned cand = T | (1u << bit); int cnt = 0; unsigned candv = cand; asm volatile("" : "+v"(candv));
#pragma unroll
                for (int r8 = 0; r8 < 8; ++r8) if (r8 * 8 < nuse) {
                    unsigned long long mk_[8];
                    asm("v_cmp_ge_u32_e64 %0, %8, %16\n\tv_cmp_ge_u32_e64 %1, %9, %16\n\tv_cmp_ge_u32_e64 %2, %10, %16\n\tv_cmp_ge_u32_e64 %3, %11, %16\n\tv_cmp_ge_u32_e64 %4, %12, %16\n\tv_cmp_ge_u32_e64 %5, %13, %16\n\tv_cmp_ge_u32_e64 %6, %14, %16\n\tv_cmp_ge_u32_e64 %7, %15, %16"
                        : "=&s"(mk_[0]), "=&s"(mk_[1]), "=&s"(mk_[2]), "=&s"(mk_[3]), "=&s"(mk_[4]), "=&s"(mk_[5]), "=&s"(mk_[6]), "=&s"(mk_[7])
                        : "v"(sc[r8 * 8 + 0]), "v"(sc[r8 * 8 + 1]), "v"(sc[r8 * 8 + 2]), "v"(sc[r8 * 8 + 3]), "v"(sc[r8 * 8 + 4]), "v"(sc[r8 * 8 + 5]), "v"(sc[r8 * 8 + 6]), "v"(sc[r8 * 8 + 7]), "v"(candv));
#pragma unroll
                    for (int r = 0; r < 8; ++r) cnt += __builtin_popcountll(mk_[r]); }
                if (cnt >= 256) T = cand;
                if (cnt == 256) { exact = true; break; } }
            int cge = 256;
            if (!exact) { cge = 0;
#pragma unroll
                for (int r8 = 0; r8 < 8; ++r8) if (r8 * 8 < nuse) {
#pragma unroll
                    for (int r = 0; r < 8; ++r) cge += __builtin_popcountll(__ballot(sc[r8 * 8 + r] >= T)); } }
            { unsigned long long z64 = 0ull; asm volatile("" : "+v"(z64)); wbuf[lane] = z64; }
            if (cge == 256) {
#pragma unroll
                for (int r8 = 0; r8 < 8; ++r8) {
#pragma unroll
                    for (int r = 0; r < 8; ++r) { const unsigned long long word = __ballot(sc[r8 * 8 + r] >= T); if (lane == 0 && r8 * 8 + r < nuse) wbuf[r8 * 8 + r] = word; }
                    __builtin_amdgcn_sched_barrier(0); }
            } else {
                int cgt = 0;
#pragma unroll
                for (int r8 = 0; r8 < 8; ++r8) {
#pragma unroll
                    for (int r = 0; r < 8; ++r) cgt += __builtin_popcountll(__ballot(sc[r8 * 8 + r] > T));
                    __builtin_amdgcn_sched_barrier(0); }
                int need = 256 - cgt;
#pragma unroll
                for (int r8 = 0; r8 < 8; ++r8) {
#pragma unroll
                    for (int r = 0; r < 8; ++r) { const unsigned long long gt = __ballot(sc[r8 * 8 + r] > T); unsigned long long eq = __ballot(sc[r8 * 8 + r] == T); const int ce = __builtin_popcountll(eq);
                        unsigned long long take;
                        if (ce <= need) { take = eq; need -= ce; }
                        else { take = 0ull; for (; need > 0; --need) { const unsigned long long low = eq & (0ull - eq); take |= low; eq ^= low; } }
                        const unsigned long long word = gt | take; if (lane == 0 && r8 * 8 + r < nuse) wbuf[r8 * 8 + r] = word; }
                    __builtin_amdgcn_sched_barrier(0); }
            }
        } else {
            { unsigned long long z64 = 0ull; asm volatile("" : "+v"(z64)); wbuf[lane] = z64; }
#pragma unroll
            for (int r8 = 0; r8 < 8; ++r8) {
#pragma unroll
                for (int r = 0; r < 8; ++r) { const unsigned long long word = __ballot(sc[r8 * 8 + r] != 0u); if (lane == 0 && r8 * 8 + r < nuse) wbuf[r8 * 8 + r] = word; }
                __builtin_amdgcn_sched_barrier(0); }
        }
        }
        BMk[m * 64 + lane] = wbuf[lane];
    }
}
DI void attn_phase(const Args& a, unsigned char* lds) {
    const int tidx_ = otid();
    const int tid = tidx_, wave = __builtin_amdgcn_readfirstlane(tid >> 6), lane = tid & 63, ql = lane & 31, hf = lane >> 5;
    const bf16_t* P = (const bf16_t*)(a.ws + OFF_P); const bf16_t* VT = (const bf16_t*)(a.ws + OFF_VT); const unsigned long long* BMk = (const unsigned long long*)(a.ws + OFF_BM);
    const float* biasd = (const float*)(a.ws + OFF_BIAS); bf16_t* Y = (bf16_t*)(a.ws + OFF_Y);
    unsigned char* Kl = lds; unsigned char* Vl = lds + 64 * 144; float* biasl = (float*)(lds + 2 * 64 * 144);
    const float NEG_INF = -__builtin_inff();
    for (int cu = blockIdx.x; cu < 256; cu += gridDim.x)
#pragma unroll 1
    for (int ui = 0; ui < 2; ++ui) {
        const int bh = cu >> 3, s8 = cu & 7, qb = ui == 0 ? s8 : 15 - s8, b_ = bh >> 3, h = bh & 7;
        const int q0w = qb * 256 + 32 * wave, q = q0w + ql; const size_t m = (size_t)b_ * SEQ + q;
        __syncthreads();
        if (tid < 128) biasl[tid] = biasd[h * 128 + tid];
        bf16x8 qf[4];
#pragma unroll
        for (int ks = 0; ks < 4; ++ks) qf[ks] = *(const bf16x8*)(P + m * PCOLS + PC_AQ + h * 64 + 16 * ks + 8 * hf);
        f32x16 O0, O1;
#pragma unroll
        for (int r = 0; r < 16; ++r) { O0[r] = 0.f; O1[r] = 0.f; }
        float mrun = NEG_INF, lrun = 0.f;
        const int nkt = 4 * (qb + 1);
        const int srow = tid >> 3, sch = tid & 7;
        const bf16_t* kbase = P + ((size_t)b_ * SEQ + srow) * PCOLS + PC_AK + h * 64 + sch * 8;
        const bf16_t* vbase = VT + ((size_t)(b_ * 8 + h) * 64 + srow) * SEQ + sch * 8;
#define ATT_COMPUTE \
            const int k0 = kt * 64; \
            if (k0 <= q0w + 31) { \
 \
                f32x16 sa[2]; \
                const f32x16 zero16 = {0.f, 0.f, 0.f, 0.f, 0.f, 0.f, 0.f, 0.f, 0.f, 0.f, 0.f, 0.f, 0.f, 0.f, 0.f, 0.f};        \
_Pragma("unroll") \
                for (int ks = 0; ks < 4; ++ks) \
_Pragma("unroll") \
                    for (int sub = 0; sub < 2; ++sub) { const bf16x8 kf = *(const bf16x8*)(Kl + (32 * sub + ql) * 144 + (16 * ks + 8 * hf) * 2); \
                        sa[sub] = __builtin_amdgcn_mfma_f32_32x32x16_bf16(kf, qf[ks], ks == 0 ? zero16 : sa[sub], 0, 0, 0); } \
                constexpr float C1 = 0.125f * 1.4426950408889634f; \
                  \
                const float b31f = biasl[127] * 1.4426950408889634f; \
                const bool far = (q0w - (k0 + 63)) >= 113; \
                float mx = NEG_INF;        \
                if (far) { \
_Pragma("unroll") \
                    for (int sub = 0; sub < 2; ++sub) \
_Pragma("unroll") \
                        for (int r = 0; r < 16; r += 2) mx = fmaxf(mx, fmaxf(sa[sub][r], sa[sub][r + 1])); \
                    mx = mx * C1 + b31f; \
                } else { \
_Pragma("unroll") \
                    for (int sub = 0; sub < 2; ++sub) { \
_Pragma("unroll") \
                        for (int r = 0; r < 16; ++r) { const int ro = (r & 3) + 8 * (r >> 2); int dd = q - (k0 + 32 * sub + ro + 4 * hf); dd = dd < 0 ? 0 : (dd > 127 ? 127 : dd); \
                            sa[sub][r] = sa[sub][r] * C1 + biasl[dd] * 1.4426950408889634f; } \
_Pragma("unroll") \
                        for (int r = 0; r < 16; r += 2) mx = fmaxf(mx, fmaxf(sa[sub][r], sa[sub][r + 1])); \
                    } \
                } \
                { auto pm = __builtin_amdgcn_permlane32_swap(__float_as_uint(mx), __float_as_uint(mx), false, false); mx = fmaxf(__uint_as_float(pm[0]), __uint_as_float(pm[1])); } \
                const float mnew = fmaxf(mrun, mx); const float msafe = mnew; \
                float lsum = 0.f; \
                const float cb = b31f - msafe; \
                if (far) { \
_Pragma("unroll") \
                    for (int sub = 0; sub < 2; ++sub) \
_Pragma("unroll") \
                        for (int r = 0; r < 16; ++r) sa[sub][r] = sa[sub][r] * C1 + cb; \
                } else { \
_Pragma("unroll") \
                    for (int sub = 0; sub < 2; ++sub) \
_Pragma("unroll") \
                        for (int r = 0; r < 16; ++r) sa[sub][r] -= msafe; \
                } \
_Pragma("unroll") \
                for (int sub = 0; sub < 2; ++sub) { \
                    const int w32 = (int)(((unsigned)(bm >> (32 * sub))) >> (4 * hf)); \
_Pragma("unroll") \
                    for (int r = 0; r < 16; ++r) { const int ro = (r & 3) + 8 * (r >> 2); unsigned tm = (unsigned)__builtin_amdgcn_sbfe(w32, ro, 1); asm volatile("" : "+v"(tm));        \
                        sa[sub][r] = __uint_as_float(__float_as_uint(__builtin_amdgcn_exp2f(sa[sub][r])) & tm); lsum += sa[sub][r]; } } \
                if (__builtin_amdgcn_ballot_w64(mnew > mrun) != 0ull) { \
                    const float alpha = __builtin_amdgcn_exp2f(mrun - msafe); \
                    lrun = lrun * alpha + lsum; mrun = mnew; \
_Pragma("unroll") \
                    for (int r = 0; r < 16; ++r) { O0[r] *= alpha; O1[r] *= alpha; } \
                } else lrun += lsum; \
_Pragma("unroll") \
                for (int sub = 0; sub < 2; ++sub) \
_Pragma("unroll") \
                    for (int s = 0; s < 2; ++s) { \
                        u32x4 pw; pw.x = pk2(sa[sub][8 * s + 0], sa[sub][8 * s + 1]); pw.y = pk2(sa[sub][8 * s + 2], sa[sub][8 * s + 3]); pw.z = pk2(sa[sub][8 * s + 4], sa[sub][8 * s + 5]); pw.w = pk2(sa[sub][8 * s + 6], sa[sub][8 * s + 7]); \
                        const bf16x8 pf = __builtin_bit_cast(bf16x8, pw); \
                        const int kcol = (32 * sub + 16 * s + 4 * hf) * 2; \
                        { const u32x2 lo = *(const u32x2*)(Vl + ql * 144 + kcol), hi = *(const u32x2*)(Vl + ql * 144 + kcol + 16); \
                          u32x4 vw; vw.x = lo.x; vw.y = lo.y; vw.z = hi.x; vw.w = hi.y; \
                          O0 = __builtin_amdgcn_mfma_f32_32x32x16_bf16(__builtin_bit_cast(bf16x8, vw), pf, O0, 0, 0, 0); } \
                        { const u32x2 lo = *(const u32x2*)(Vl + (32 + ql) * 144 + kcol), hi = *(const u32x2*)(Vl + (32 + ql) * 144 + kcol + 16); \
                          u32x4 vw; vw.x = lo.x; vw.y = lo.y; vw.z = hi.x; vw.w = hi.y; \
                          O1 = __builtin_amdgcn_mfma_f32_32x32x16_bf16(__builtin_bit_cast(bf16x8, vw), pf, O1, 0, 0, 0); } \
                    } \
            } \

        u32x4 kregA = *(const u32x4*)(kbase), vregA = *(const u32x4*)(vbase); unsigned long long bmA = BMk[m * 64];
        u32x4 kregB = *(const u32x4*)(kbase + (size_t)64 * PCOLS), vregB = *(const u32x4*)(vbase + 64); unsigned long long bmB = BMk[m * 64 + 1];
        asm volatile("" :: "v"(qf[0]), "v"(qf[1]), "v"(qf[2]), "v"(qf[3]));
#define ATT_TILE(KREG, VREG, BMR, KT) do { const int kt = (KT); \
            __syncthreads(); \
            *(u32x4*)(Kl + srow * 144 + sch * 16) = KREG; *(u32x4*)(Vl + srow * 144 + sch * 16) = VREG; \
            __syncthreads(); \
            const unsigned long long bm = BMR; \
            if (kt + 2 < nkt) { KREG = *(const u32x4*)(kbase + (size_t)(kt + 2) * 64 * PCOLS); VREG = *(const u32x4*)(vbase + (kt + 2) * 64); BMR = BMk[m * 64 + kt + 2]; } \
            ATT_COMPUTE } while (0)
#pragma unroll 1
        for (int kt2 = 0; kt2 < nkt; kt2 += 2) { ATT_TILE(kregA, vregA, bmA, kt2); ATT_TILE(kregB, vregB, bmB, kt2 + 1); }
#undef ATT_TILE
#undef ATT_COMPUTE
        float ltot; { auto pl = __builtin_amdgcn_permlane32_swap(__float_as_uint(lrun), __float_as_uint(lrun), false, false); ltot = __uint_as_float(pl[0]) + __uint_as_float(pl[1]); } const float inv = 1.0f / ltot;
        bf16_t* yo = Y + m * D + 1536 + h * 64;
#pragma unroll
        for (int g4 = 0; g4 < 4; ++g4) { const int d0 = 8 * g4 + 4 * hf;
            u32x2 o0; o0.x = pk2(O0[4 * g4 + 0] * inv, O0[4 * g4 + 1] * inv); o0.y = pk2(O0[4 * g4 + 2] * inv, O0[4 * g4 + 3] * inv); *(u32x2*)(yo + d0) = o0;
            u32x2 o1; o1.x = pk2(O1[4 * g4 + 0] * inv, O1[4 * g4 + 1] * inv); o1.y = pk2(O1[4 * g4 + 2] * inv, O1[4 * g4 + 3] * inv); *(u32x2*)(yo + 32 + d0) = o1; }
    }
}

constexpr int NPH = 16;
constexpr int NGP = 1 + DEPTH * NPH;
__global__ void __launch_bounds__(512, 2) fwd(Args args) {
    extern __shared__ __attribute__((aligned(16))) unsigned char lds[];
    const int tid = threadIdx.x;
    volatile LAS unsigned* MISC = (volatile LAS unsigned*)((LAS unsigned char*)lds + MISC_OFF);
    for (int u = tid; u < (LDS_BYTES - 131072) / 4; u += 512) ((LAS unsigned*)((LAS unsigned char*)lds + 131072))[u] = 0u;
    __syncthreads();
    unsigned char* ws = args.ws;
    XcdBarrier bar; bar.bar = (unsigned*)(ws + OFF_CTL) + 4096; bar.x = 0; bar.st = nullptr;
    if (!MK_PER_PHASE) bar = xcd_barrier_post((unsigned*)(ws + OFF_CTL) + 4096, MISC + 8);
    const int lo = args.lo, hi = args.hi;
    LAS unsigned char* ldsl = (LAS unsigned char*)lds;
    bf16_t* XB = (bf16_t*)(ws + OFF_XB); float* X = (float*)(ws + OFF_X); float* T = (float*)(ws + OFF_T); float* ST = (float*)(ws + OFF_ST); bf16_t* Pb = (bf16_t*)(ws + OFF_P);
    bf16_t* H = (bf16_t*)(ws + OFF_SCR); bf16_t* Yb = (bf16_t*)(ws + OFF_Y); bf16_t* MG = (bf16_t*)(ws + OFF_MG);
    int gp = 0;
#define RUN() (lo <= gp && gp < hi)
#define SEAM() do { if (RUN() && gp + 1 < hi) xcd_barrier(bar); ++gp; } while (0)
#define PHASE(k, ...) do { if (PHON(k) && RUN()) { __VA_ARGS__; if ((REP_MASK >> (k)) & 1u) { xcd_barrier(bar); __VA_ARGS__; } } SEAM(); } while (0)
    if (RUN()) init_phase(args);
    SEAM();
    int p7n = 0;
#pragma unroll 1
    for (int L = 0; L < DEPTH; ++L) {
        const size_t walt = (L & 1) ? ALT_SHIFT : 0;
        if (L == 0 || !HETERO) PHASE(0, convert_phase(args, L, lds, blockIdx.x, gridDim.x);); else ++gp;
        PHASE(1, { pg8::Gemm g{XB, (const bf16_t*)(ws + OFF_W1A), D, D}; pg8::StaticOrder S; S.init(M, 2 * FF, D, gridDim.x, blockIdx.x); pg8::EpiSwiglu E{H, FF}; pg8::gemm_phase(ldsl, g, S, E); });
        PHASE(2, { pg8::Gemm g{H, (const bf16_t*)(ws + OFF_W1B), FF, FF}; pg8::StaticOrder S; S.init(M, D, FF, gridDim.x, blockIdx.x); pg8::EpiRes E{args.in[I_X], L == 0 ? nullptr : ST, args.in[I_LN3G] + (L > 0 ? (L - 1) * D : 0), args.in[I_LN3B] + (L > 0 ? (L - 1) * D : 0), T, D, ALPHA, 0.5f}; pg8::gemm_phase(ldsl, g, S, E); });
        PHASE(3, ln_phase(T, args.in[I_LN1G] + L * D, args.in[I_LN1B] + L * D, ST, XB, nullptr););
        PHASE(4, { pg8::Gemm g{XB, (const bf16_t*)(ws + OFF_WIN), D, D}; pg8::StaticOrder S; S.init(M, NP, D, gridDim.x, blockIdx.x); pg8::EpiBf16 E{Pb, PCOLS, (bf16_t*)(ws + OFF_GATES)}; pg8::gemm_phase(ldsl, g, S, E); });
        PHASE(5, { kidx_vt_phase(args, L, lds); if (REP_MASK & (1u << 23)) kidx_vt_phase(args, L, lds); if (RWKV_CHUNKED && !DBG_RWKV) { rwkv_par_phase(args, L, lds); if (REP_MASK & (1u << 24)) rwkv_par_phase(args, L, lds); } else rwkv_prep_phase(args, L, lds); });
        if (!HETERO) PHASE(6, { WorkQ wq{nullptr, 0, 0, (int)gridDim.x}; int item = blockIdx.x; sgu_phase(args, L, lds, wq, item, 0); }); else ++gp;
        PHASE(7, { if (DBG_RWKV) { scan_phase(args, lds); xcd_barrier(bar); rwkv_par_phase(args, L, lds); xcd_barrier(bar); rwkv_seq_phase(args, lds, X + (size_t)M * RW, nullptr, nullptr, nullptr); xcd_barrier(bar); dbg_compare_phase(args); }
                   else if (HETERO) {
                       if ((int)blockIdx.x < 64) { rwkv_seq_phase(args, lds, X, args.in[I_GNG] + L * RW, args.in[I_GNB] + L * RW, Yb); if (REP_MASK & (1u << 20)) rwkv_seq_phase(args, lds, X, args.in[I_GNG] + L * RW, args.in[I_GNB] + L * RW, Yb); }
                       else if ((int)blockIdx.x < 64 + NCVT && L + 1 < DEPTH) { convert_phase(args, L + 1, lds, blockIdx.x - 64, NCVT); __syncthreads(); }
                       WorkQ wq{(unsigned*)(ws + OFF_CTL + 524288) + (p7n++) * 64, 0, 0, 0}; int item = wq_first(wq, lds, otid());
                       indexer_phase(args, lds, wq, item); sgu_phase(args, L, lds, wq, item, NB * 512); }
                   else if (RWKV_CHUNKED) rwkv_seq_phase(args, lds, X, nullptr, nullptr, nullptr); else scan_phase(args, lds); });
        if (!HETERO) PHASE(8, { WorkQ wq{nullptr, 0, 0, (int)gridDim.x}; int item = blockIdx.x; indexer_phase(args, lds, wq, item); if (RWKV_CHUNKED) rwkv_fin2_phase(args, L); else rwkv_fin_phase(args, L); }); else ++gp;
        PHASE(9, { attn_phase(args, lds); });
        PHASE(10, { pg8::Gemm g{Yb, (const bf16_t*)(ws + OFF_WBR + walt), D, D}; pg8::BranchOrder S; S.init(M, D, D, gridDim.x, blockIdx.x); pg8::EpiBranch E{(const bf16_t*)(ws + OFF_GATES), args.in[I_BGATE] + (size_t)L * 3 * D, MG}; pg8::gemm_phase(ldsl, g, S, E); });
        PHASE(11, { pg8::Gemm g{MG, (const bf16_t*)(ws + OFF_WO + walt), D, D}; pg8::StaticOrder S; S.init(M, D, D, gridDim.x, blockIdx.x); pg8::EpiRes E{nullptr, ST, args.in[I_LN1G] + L * D, args.in[I_LN1B] + L * D, T, D, ALPHA, 1.0f}; pg8::gemm_phase(ldsl, g, S, E); });
        PHASE(12, ln_phase(T, args.in[I_LN2G] + L * D, args.in[I_LN2B] + L * D, ST, XB, nullptr););
        PHASE(13, { pg8::Gemm g{XB, (const bf16_t*)(ws + OFF_W2A + walt), D, D}; pg8::StaticOrder S; S.init(M, 2 * FF, D, gridDim.x, blockIdx.x); pg8::EpiSwiglu E{H, FF}; pg8::gemm_phase(ldsl, g, S, E); });
        PHASE(14, { pg8::Gemm g{H, (const bf16_t*)(ws + OFF_W2B + walt), FF, FF}; pg8::StaticOrder S; S.init(M, D, FF, gridDim.x, blockIdx.x); pg8::EpiRes E{nullptr, ST, args.in[I_LN2G] + L * D, args.in[I_LN2B] + L * D, T, D, ALPHA, 0.5f}; pg8::gemm_phase(ldsl, g, S, E); });
        PHASE(15, ln_phase(T, args.in[I_LN3G] + L * D, args.in[I_LN3B] + L * D, ST, XB, L == DEPTH - 1 ? args.out : nullptr););
        if (REP_MASK & (1u << 25)) { for (int xb = 0; xb < 10; ++xb) xcd_barrier(bar); }
    }
    if (DBG_RWKV) { xcd_barrier(bar); dbg_encode_phase(args); }
#undef RUN
#undef SEAM
#undef PHASE
}

extern "C" void kernel_launch(void* const* d_in, const int* in_sizes, int n_in, void* d_out, int out_size, void* d_ws, size_t ws_size, hipStream_t stream) {
    static int grid = 0;
    if (grid == 0) {
        if (n_in != 33 || out_size != M * D || ws_size < WS_END) { fprintf(stderr, "kernel_launch: unexpected shapes (n_in %d out %d ws %zu, need %zu)\n", n_in, out_size, ws_size, (size_t)WS_END); grid = -1; return; }
        int dev = 0, cus = 0;
        if (hipGetDevice(&dev) != hipSuccess || hipDeviceGetAttribute(&cus, hipDeviceAttributeMultiprocessorCount, dev) != hipSuccess) { grid = -1; return; }
        if (hipFuncSetAttribute((const void*)fwd, hipFuncAttributeMaxDynamicSharedMemorySize, LDS_BYTES) != hipSuccess) { fprintf(stderr, "kernel_launch: hipFuncSetAttribute failed\n"); grid = -1; return; }
        int per_cu = 0; (void)hipOccupancyMaxActiveBlocksPerMultiprocessor(&per_cu, (const void*)fwd, 512, LDS_BYTES); (void)hipGetLastError();
        grid = cus;
    }
    if (grid < 0) return;
    (void)hipMemsetAsync((char*)d_ws + OFF_CTL, 0, CTL_BYTES, stream);
    Args a{};
    for (int i = 0; i < 33; ++i) a.in[i] = (const float*)d_in[i];
    a.out = (float*)d_out; a.ws = (unsigned char*)d_ws;
#if MK_PER_PHASE
    for (int p = 0; p < NGP; ++p) { a.lo = p; a.hi = p + 1; hipLaunchKernelGGL(fwd, dim3(grid), dim3(512), LDS_BYTES, stream, a); }
#else
    a.lo = 0; a.hi = NGP;
    hipLaunchKernelGGL(fwd, dim3(grid), dim3(512), LDS_BYTES, stream, a);
#endif
}
```

```cpp
#include <hip/hip_runtime.h>
#include <cstdio>
#include <cstdint>

#ifndef MK_PER_PHASE
#define MK_PER_PHASE 0
#endif
#ifndef PH_MASK
#define PH_MASK 0xFFFFFFFFu
#endif
#define PHON(k) (((PH_MASK) >> (k)) & 1u)
#ifndef RWKV_CHUNKED
#define RWKV_CHUNKED 1
#endif
#ifndef DBG_RWKV
#define DBG_RWKV 0
#endif
#ifndef DBG_LORA
#define DBG_LORA 0
#endif
#ifndef HETERO
#define HETERO 1
#endif
#ifndef SEQ_HILO
#define SEQ_HILO 0
#endif
#ifndef SGU_SPLIT
#define SGU_SPLIT 256
#endif
#ifndef REP_MASK
#define REP_MASK 0u
#endif

#define LAS __attribute__((address_space(3)))
#define DI __device__ __forceinline__
typedef unsigned short bf16_t;
typedef short bf16x8 __attribute__((ext_vector_type(8)));
typedef float f32x4 __attribute__((ext_vector_type(4)));
typedef float f32x2 __attribute__((ext_vector_type(2)));
typedef float f32x16 __attribute__((ext_vector_type(16)));
typedef unsigned u32x4 __attribute__((ext_vector_type(4)));
typedef unsigned u32x2 __attribute__((ext_vector_type(2)));
typedef __bf16 bf16x2_t __attribute__((ext_vector_type(2)));

constexpr int NB = 4, SEQ = 4096, M = NB * SEQ, D = 2048, FF = 5632, DEPTH = 4;
constexpr int RW = 1024;
constexpr int NP = 13312;
constexpr int PCOLS = 7168;
constexpr int DIN = 13168;
constexpr int GN_GATE = 6656, GN_LORA = 12800, GN_KI = 13088, GN_WI = 13152;
constexpr int PC_R = 0, PC_K = 1024, PC_V = 2048, PC_SGU = 3072, PC_SGV = 3584, PC_AQ = 4096, PC_AK = 4608, PC_AV = 5120, PC_QI = 5632, PC_LORA = 6656, PC_KI = 6944, PC_WI = 7008;
constexpr float ALPHA = 1.6817928305074290f;
constexpr float LN_EPS = 1e-5f;

constexpr size_t MiB = 1u << 20;
constexpr size_t OFF_CTL = 0, CTL_BYTES = 1 * MiB;
constexpr size_t OFF_BIAS = 1 * MiB;
constexpr size_t OFF_ST = OFF_BIAS + 786432;
constexpr size_t OFF_LW2 = OFF_BIAS + 65536, OFF_LA2 = OFF_LW2 + 131072, OFF_LG2 = OFF_LA2 + 131072;
constexpr int REC = 15360, RROW = 144, R_EL2 = 0, R_RL2 = 2304, R_A2 = 4608, R_A3 = 8704, R_FT = 9728, R_VT = 10240, R_GC = 12288, R_G = 12544, R_BON = 14592;
constexpr size_t OFF_W1A = 2 * MiB;
constexpr size_t OFF_W1B = OFF_W1A + 44 * MiB;
constexpr size_t OFF_WIN = OFF_W1B + 22 * MiB;
constexpr size_t OFF_WBR = OFF_WIN + 52 * MiB;
constexpr size_t OFF_WO  = OFF_WBR + 8 * MiB;
constexpr size_t OFF_W2A = OFF_WO + 8 * MiB;
constexpr size_t OFF_W2B = OFF_W2A + 44 * MiB;
constexpr size_t OFF_X   = OFF_W2B + 22 * MiB;
constexpr size_t OFF_T   = OFF_X + 128 * MiB;
constexpr size_t OFF_XB  = OFF_T + 128 * MiB;
constexpr size_t OFF_P   = OFF_XB + 64 * MiB;
constexpr size_t OFF_GATES = OFF_P + 224 * MiB;
constexpr size_t OFF_SCR = OFF_GATES + 192 * MiB;
constexpr size_t OFF_Y   = OFF_SCR + 416 * MiB;
constexpr size_t OFF_MG  = OFF_Y + 64 * MiB;
constexpr size_t OFF_BM  = OFF_MG + 64 * MiB;
constexpr size_t OFF_KI  = OFF_BM + 8 * MiB;
constexpr size_t OFF_VT  = OFF_KI + 2 * MiB;
constexpr size_t OFF_ALT = OFF_VT + 16 * MiB;
constexpr size_t ALT_SHIFT = OFF_ALT - OFF_WBR;
constexpr size_t WS_END  = OFF_ALT + 82 * MiB;
constexpr int NCVT = 64;

constexpr int LDS_BYTES = 147456;
constexpr int MISC_OFF = 131072 + 320;

DI unsigned f2bf(float f);
DI float bf2f(unsigned short b) { return __builtin_bit_cast(float, ((unsigned)b) << 16); }
DI unsigned pk2(float lo, float hi) { f32x2 v = {lo, hi}; bf16x2_t b = __builtin_convertvector(v, bf16x2_t); return __builtin_bit_cast(unsigned, b); }
DI unsigned f2bf(float f) { return pk2(f, f) & 0xffffu; }
DI float bflo(unsigned w) { return __builtin_bit_cast(float, w << 16); }
DI float bfhi(unsigned w) { return __builtin_bit_cast(float, w & 0xffff0000u); }
template <int CTRL> DI float dpp_f(float x) { return __builtin_bit_cast(float, __builtin_amdgcn_update_dpp(0, __builtin_bit_cast(int, x), CTRL, 0xF, 0xF, true)); }
DI float row16_sum(float x) {
    x += dpp_f<0xB1>(x);
    x += dpp_f<0x4E>(x);
    x += dpp_f<0x141>(x);
    x += dpp_f<0x140>(x);
    return x;
}
DI int otid() { int t = threadIdx.x; asm volatile("" : "+v"(t)); return t; }
DI int obid() { int t = blockIdx.x; asm volatile("" : "+s"(t)); return t; }
DI float wave_sum(float x) {
    x = row16_sum(x);
    auto p = __builtin_amdgcn_permlane16_swap(__float_as_uint(x), __float_as_uint(x), false, false);
    x = __uint_as_float(p[0]) + __uint_as_float(p[1]);
    auto q = __builtin_amdgcn_permlane32_swap(__float_as_uint(x), __float_as_uint(x), false, false);
    return __uint_as_float(q[0]) + __uint_as_float(q[1]);
}
DI void wave_sum8(float (&x)[8]) {
#pragma unroll
    for (int i = 0; i < 8; ++i) x[i] += dpp_f<0xB1>(x[i]);
#pragma unroll
    for (int i = 0; i < 8; ++i) x[i] += dpp_f<0x4E>(x[i]);
#pragma unroll
    for (int i = 0; i < 8; ++i) x[i] += dpp_f<0x141>(x[i]);
#pragma unroll
    for (int i = 0; i < 8; ++i) x[i] += dpp_f<0x140>(x[i]);
#pragma unroll
    for (int i = 0; i < 8; ++i) { auto p = __builtin_amdgcn_permlane16_swap(__float_as_uint(x[i]), __float_as_uint(x[i]), false, false); x[i] = __uint_as_float(p[0]) + __uint_as_float(p[1]); }
#pragma unroll
    for (int i = 0; i < 8; ++i) { auto p = __builtin_amdgcn_permlane32_swap(__float_as_uint(x[i]), __float_as_uint(x[i]), false, false); x[i] = __uint_as_float(p[0]) + __uint_as_float(p[1]); }
}
DI float rs16(float (&x)[16], int lane) {
    float z[8], w[4];
#pragma unroll
    for (int i = 0; i < 8; ++i) { auto p = __builtin_amdgcn_permlane32_swap(__float_as_uint(x[i]), __float_as_uint(x[i + 8]), false, false); z[i] = __uint_as_float(p[0]) + __uint_as_float(p[1]); }
#pragma unroll
    for (int i = 0; i < 4; ++i) { auto p = __builtin_amdgcn_permlane16_swap(__float_as_uint(z[i]), __float_as_uint(z[i + 4]), false, false); w[i] = __uint_as_float(p[0]) + __uint_as_float(p[1]); }
    const bool b0 = (lane & 1) != 0, b1 = (lane & 2) != 0;
    const float u0 = (b0 ? w[1] : w[0]) + dpp_f<0xB1>(b0 ? w[0] : w[1]);
    const float u1 = (b0 ? w[3] : w[2]) + dpp_f<0xB1>(b0 ? w[2] : w[3]);
    float v = (b1 ? u1 : u0) + dpp_f<0x4E>(b1 ? u0 : u1);
    v += dpp_f<0x124>(v);
    v += dpp_f<0x128>(v);
    return v;
}
DI float sigmoidf_(float x) { return __builtin_amdgcn_rcpf(1.0f + __expf(-x)); }
DI float gelu_erf(float x) {
    const float y = fabsf(x) * 0.70710678118654752f;
    const float t = __builtin_amdgcn_rcpf(__builtin_fmaf(0.3275911f, y, 1.0f));
    const float e = __builtin_amdgcn_exp2f(-1.4426950408889634f * y * y);
    float p = __builtin_fmaf(1.061405429f, t, -1.453152027f); p = __builtin_fmaf(p, t, 1.421413741f); p = __builtin_fmaf(p, t, -0.284496736f); p = __builtin_fmaf(p, t, 0.254829592f);
    const float ec = p * t * e;
    return 0.5f * x * (x < 0.f ? ec : 2.0f - ec);
}

namespace pg8 {
constexpr int BM = 256, BK = 64, HALF = 128, HTB = HALF * BK * 2, STAGE_BYTES = 8 * HTB, NXCD = 8, WGM = 8;
__host__ __device__ __forceinline__ int lds_byte(int r, int c) { const int st = (r >> 4) * 2 + (c >> 5), rr = r & 15, cc = c & 31, ob = rr * 64 + cc * 2; return st * 1024 + (ob ^ (((ob >> 9) & 1) << 5)); }
__host__ __device__ __forceinline__ void stage_rc(int b, int& R, int& C) { const int st = b / 1024, sb = b % 1024, swz = sb ^ (((sb >> 9) & 1) << 5); R = (st >> 1) * 16 + swz / 64; C = (st & 1) * 32 + (swz % 64) / 2; }
__host__ __device__ __forceinline__ int perm32(int rho) { const int n = rho >> 4, i = rho & 15; return 8 * (i >> 2) + 4 * n + (i & 3); }

struct Unit { int pm, pn, koff, nt, tag; };
struct Gemm { const bf16_t* A; const bf16_t* Bt; int lda, ldb; };

struct StaticOrder {
    int nM, nN, nwg, G, c, nt;
    __device__ void init(int M_, int N_, int K_, int G_, int c_) { nM = M_ / BM; nN = N_ / BM; nwg = nM * nN; G = G_; c = c_; nt = K_ / BK; }
    __device__ bool tile(int L, Unit& u) const {
        if (L >= nwg) return false;
        int wgid = L; { const int q = nwg / NXCD, r = nwg % NXCD, xcd = wgid % NXCD, off = wgid / NXCD; wgid = (xcd < r ? xcd * (q + 1) : r * (q + 1) + (xcd - r) * q) + off; }
        const int nig = WGM * nN, gid = wgid / nig, fm = gid * WGM, gsz = (nM - fm) < WGM ? (nM - fm) : WGM;
        u.pm = fm + ((wgid % nig) % gsz); u.pn = (wgid % nig) / gsz; return true;
    }
    __device__ bool next(int i, Unit& u) const { u.koff = 0; u.nt = nt; u.tag = 0; return tile(i * G + c, u); }
};
struct BranchOrder : StaticOrder {
    __device__ bool next(int i, Unit& u) const {
        const int ti = i / 3, br = i - 3 * ti;
        u.tag = br; u.koff = br == 0 ? 0 : (br == 1 ? 1024 : 1536); u.nt = br == 0 ? 16 : 8;
        return tile(ti * G + c, u);
    }
};

template <class Epi, class Sched>
__device__ __forceinline__ void gemm_phase(LAS unsigned char* lds, const Gemm g, const Sched& S, const Epi& E) {
    const int tid = otid(), wid = __builtin_amdgcn_readfirstlane(tid >> 6), lane = tid & 63, wr = wid >> 2, wc = wid & 3, fr = lane & 15, fq = lane >> 4;
    unsigned voffA[2], voffB[2];
#pragma unroll
    for (int i = 0; i < 2; ++i) { int R, C; stage_rc(tid * 16 + i * 8192, R, C); const int Rb = Epi::PERM ? ((R & ~31) + perm32(R & 31)) : R;
        voffA[i] = (unsigned)(R * g.lda + C) * 2u; voffB[i] = (unsigned)(Rb * g.ldb + C) * 2u; }
    const size_t kstep = (size_t)(BK * 2);
    const size_t hstepA = (size_t)HALF * g.lda * 2, hstepB = (size_t)HALF * g.ldb * 2;
    const size_t tstepA = 2 * hstepA, tstepB = 2 * hstepB;
    const unsigned ldsw = (unsigned)wid * 1024u;
    const int aoff = lds_byte(wr * 64 + fr, fq * 8), boff = lds_byte(wc * 32 + fr, fq * 8);
#define PG8_SA(b, h) (((b) * 2 + (h)) * HTB)
#define PG8_SB(b, h) ((4 + (b) * 2 + (h)) * HTB)
#define PG8_STAGE(bufoff, gbase, voff) do { _Pragma("unroll") for (int _i = 0; _i < 2; ++_i) \
        __builtin_amdgcn_global_load_lds((const unsigned*)((const char*)(gbase) + (voff)[_i]), (LAS unsigned*)(lds + (bufoff) + ldsw + _i * 8192), 16, 0, 0); } while (0)
#define PG8_LDA(dst, b, h) do { _Pragma("unroll") for (int m = 0; m < 4; ++m) _Pragma("unroll") for (int k = 0; k < 2; ++k) dst[m][k] = *(const LAS bf16x8*)(lds + PG8_SA(b, h) + aoff + m * 2048 + k * 1024); } while (0)
#define PG8_LDB(dst, b, h) do { _Pragma("unroll") for (int n = 0; n < 2; ++n) _Pragma("unroll") for (int k = 0; k < 2; ++k) dst[n][k] = *(const LAS bf16x8*)(lds + PG8_SB(b, h) + boff + n * 2048 + k * 1024); } while (0)
#define PG8_MMA(ai, bj, At, Bt) do { __builtin_amdgcn_s_setprio(1); _Pragma("unroll") for (int m = 0; m < 4; ++m) _Pragma("unroll") for (int n = 0; n < 2; ++n) _Pragma("unroll") for (int k = 0; k < 2; ++k) \
        acc[ai][bj][m][n] = __builtin_amdgcn_mfma_f32_16x16x32_bf16(Bt[n][k], At[m][k], acc[ai][bj][m][n], 0, 0, 0); __builtin_amdgcn_s_setprio(0); } while (0)
#define PG8_WAIT_V(n) asm volatile("s_waitcnt vmcnt(" #n ")" ::: "memory")
#define PG8_WAIT_L(n) asm volatile("s_waitcnt lgkmcnt(" #n ")" ::: "memory")
#define PG8_BAR __builtin_amdgcn_s_barrier()
#define PG8_SCHED __builtin_amdgcn_sched_barrier(0)
    Unit cur, nxt; int ui = 0;
    if (!S.next(0, cur)) return;
    f32x4 acc[2][2][4][2];
#pragma unroll
    for (int a = 0; a < 2; ++a)
#pragma unroll
        for (int b = 0; b < 2; ++b)
#pragma unroll
            for (int m = 0; m < 4; ++m)
#pragma unroll
                for (int n = 0; n < 2; ++n) acc[a][b][m][n] = (f32x4){0.f, 0.f, 0.f, 0.f};
    bf16x8 At[4][2], B0[2][2], B1[2][2];
    const char* cA = (const char*)g.A + (size_t)cur.pm * tstepA + (size_t)cur.koff * 2; const char* cB = (const char*)g.Bt + (size_t)cur.pn * tstepB + (size_t)cur.koff * 2;
    PG8_STAGE(PG8_SB(0, 0), cB, voffB); PG8_STAGE(PG8_SB(0, 1), cB + hstepB, voffB); PG8_STAGE(PG8_SA(0, 0), cA, voffA); PG8_STAGE(PG8_SA(0, 1), cA + hstepA, voffA);
    if (wr == 1) PG8_BAR;
    PG8_WAIT_V(2); PG8_BAR;
    PG8_STAGE(PG8_SB(1, 0), cB + kstep, voffB); PG8_STAGE(PG8_SA(1, 0), cA + kstep, voffA); PG8_STAGE(PG8_SB(1, 1), cB + hstepB + kstep, voffB);
    PG8_WAIT_V(6); PG8_BAR;
    for (;;) {
        const bool has_next = S.next(ui + 1, nxt);
        const char* nA = has_next ? (const char*)g.A + (size_t)nxt.pm * tstepA + (size_t)nxt.koff * 2 : cA; const char* nB = has_next ? (const char*)g.Bt + (size_t)nxt.pn * tstepB + (size_t)nxt.koff * 2 : cB;
        const int nt = cur.nt;
        for (int t = 0; t < nt; t += 2) {
            const bool last = (t == nt - 2);
            const char* a1 = cA + (size_t)(t + 1) * kstep;
            const char* a2 = last ? nA : cA + (size_t)(t + 2) * kstep; const char* b2 = last ? nB : cB + (size_t)(t + 2) * kstep;
            const char* a3 = a2 + kstep; const char* b3 = b2 + kstep;
            PG8_LDB(B0, 0, 0); PG8_LDB(B1, 0, 1); PG8_SCHED; PG8_LDA(At, 0, 0); PG8_STAGE(PG8_SA(1, 1), a1 + hstepA, voffA);
            PG8_WAIT_V(8); PG8_WAIT_L(0); PG8_BAR; PG8_MMA(0, 0, At, B0); PG8_MMA(0, 1, At, B1); PG8_BAR; PG8_SCHED;
            PG8_LDA(At, 0, 1); PG8_STAGE(PG8_SB(0, 0), b2, voffB); PG8_STAGE(PG8_SB(0, 1), b2 + hstepB, voffB); PG8_STAGE(PG8_SA(0, 0), a2, voffA);
            PG8_WAIT_V(8); PG8_WAIT_L(0); PG8_BAR; PG8_MMA(1, 0, At, B0); PG8_MMA(1, 1, At, B1); PG8_BAR; PG8_SCHED;
            PG8_LDB(B0, 1, 0); PG8_LDB(B1, 1, 1); PG8_SCHED; PG8_LDA(At, 1, 0); PG8_STAGE(PG8_SA(0, 1), a2 + hstepA, voffA);
            PG8_WAIT_V(8); PG8_WAIT_L(0); PG8_BAR; PG8_MMA(0, 0, At, B0); PG8_MMA(0, 1, At, B1); PG8_BAR; PG8_SCHED;
            PG8_LDA(At, 1, 1); PG8_STAGE(PG8_SB(1, 0), b3, voffB); PG8_STAGE(PG8_SB(1, 1), b3 + hstepB, voffB); PG8_STAGE(PG8_SA(1, 0), a3, voffA);
            PG8_WAIT_V(8); PG8_WAIT_L(0); PG8_BAR; PG8_MMA(1, 0, At, B0); PG8_MMA(1, 1, At, B1); PG8_BAR; PG8_SCHED;
        }
        if (wr == 0) PG8_BAR;
        E(acc, cur, wr, wc, fr, fq);
        if (!has_next) break;
        if (!(Epi::KEEPS && cur.tag != 2))
#pragma unroll
        for (int a = 0; a < 2; ++a)
#pragma unroll
            for (int b = 0; b < 2; ++b)
#pragma unroll
                for (int m = 0; m < 4; ++m)
#pragma unroll
                    for (int n = 0; n < 2; ++n) acc[a][b][m][n] = (f32x4){0.f, 0.f, 0.f, 0.f};
        cur = nxt; cA = nA; cB = nB; ++ui;
        if (wr == 1) PG8_BAR;
    }
    PG8_WAIT_V(0);
    PG8_BAR;
#undef PG8_SA
#undef PG8_SB
#undef PG8_STAGE
#undef PG8_LDA
#undef PG8_LDB
#undef PG8_MMA
#undef PG8_WAIT_V
#undef PG8_WAIT_L
#undef PG8_BAR
#undef PG8_SCHED
}

struct EpiSwiglu {
    static constexpr bool PERM = true, KEEPS = false;
    bf16_t* O; int ldc;
    __device__ __forceinline__ void operator()(const f32x4 (&acc)[2][2][4][2], const Unit& u, int wr, int wc, int fr, int fq) const {
        const int row0 = u.pm * BM + wr * 64 + fr, col0 = u.pn * HALF + wc * 32 + 8 * fq;
#pragma unroll
        for (int ai = 0; ai < 2; ++ai)
#pragma unroll
            for (int m = 0; m < 4; ++m) {
                float hv[8];
#pragma unroll
                for (int n = 0; n < 2; ++n)
#pragma unroll
                    for (int j = 0; j < 4; ++j) { const float gv = acc[ai][0][m][n][j], uv = acc[ai][1][m][n][j]; hv[4 * n + j] = gv * __builtin_amdgcn_rcpf(1.0f + __expf(-gv)) * uv; }
                u32x4 w; w.x = pk2(hv[0], hv[1]); w.y = pk2(hv[2], hv[3]); w.z = pk2(hv[4], hv[5]); w.w = pk2(hv[6], hv[7]);
                *(u32x4*)(O + (size_t)(row0 + ai * HALF + m * 16) * ldc + col0) = w;
            }
    }
};
struct EpiRes {
    static constexpr bool PERM = false, KEEPS = false;
    const float* Xraw; const float* st; const float* g; const float* b; float* T; int ldc; float alpha, s;
    __device__ __forceinline__ void operator()(const f32x4 (&acc)[2][2][4][2], const Unit& u, int wr, int wc, int fr, int fq) const {
        const int row0 = u.pm * BM + wr * 64 + fr, col0 = u.pn * BM + wc * 32 + 4 * fq;
        f32x4 gv[2][2], bv[2][2];
        if (st) {
#pragma unroll
            for (int bj = 0; bj < 2; ++bj)
#pragma unroll
                for (int n = 0; n < 2; ++n) { gv[bj][n] = *(const f32x4*)(g + col0 + bj * HALF + n * 16); bv[bj][n] = *(const f32x4*)(b + col0 + bj * HALF + n * 16); } }
        const float* src = st ? T : Xraw;
#pragma unroll
        for (int ai = 0; ai < 2; ++ai)
#pragma unroll
            for (int m2 = 0; m2 < 2; ++m2) {
                f32x4 tv[2][2][2]; f32x2 ms[2];
#pragma unroll
                for (int mm = 0; mm < 2; ++mm) { const int row = row0 + ai * HALF + (2 * m2 + mm) * 16; const size_t off = (size_t)row * ldc + col0;
                    ms[mm] = (f32x2){0.f, 1.f}; if (st) ms[mm] = *(const f32x2*)(st + 2 * (size_t)row);
#pragma unroll
                    for (int bj = 0; bj < 2; ++bj)
#pragma unroll
                        for (int n = 0; n < 2; ++n) tv[mm][bj][n] = *(const f32x4*)(src + off + bj * HALF + n * 16); }
                asm volatile("" ::: "memory");
#pragma unroll
                for (int mm = 0; mm < 2; ++mm) { const int m = 2 * m2 + mm; const size_t off = (size_t)(row0 + ai * HALF + m * 16) * ldc + col0;
#pragma unroll
                    for (int bj = 0; bj < 2; ++bj)
#pragma unroll
                        for (int n = 0; n < 2; ++n) { f32x4 xv = tv[mm][bj][n]; if (st) xv = (xv - ms[mm][0]) * ms[mm][1] * gv[bj][n] + bv[bj][n];
                            *(f32x4*)(T + off + bj * HALF + n * 16) = xv * alpha + acc[ai][bj][m][n] * s; } }
            }
    }
};
__device__ __forceinline__ int frag_off(int wr, int wc, int fr, int fq, int ai, int m, int bj) { return (((((wr * 4 + wc) * 2 + ai) * 4 + m) * 2 + bj) * 64 + fq * 16 + fr) * 8; }
struct EpiBf16 {
    static constexpr bool PERM = true, KEEPS = false;
    bf16_t* O; int ldc; bf16_t* G;
    __device__ __forceinline__ void operator()(const f32x4 (&acc)[2][2][4][2], const Unit& u, int wr, int wc, int fr, int fq) const {
        const bool gate = u.pn >= GN_GATE / BM && u.pn < GN_LORA / BM;
        const int gt = u.pn - GN_GATE / BM;
        bf16_t* gbase = G + ((size_t)((gt >> 3) * (M / BM) + u.pm) * 8 + (gt & 7)) * 65536;
        const int pcol = (u.pn >= GN_LORA / BM ? PC_LORA + (u.pn - GN_LORA / BM) * BM : u.pn * BM) + wc * 32 + 8 * fq;
        const int row0 = u.pm * BM + wr * 64 + fr;
        int lbase = ((wr * 4 + wc) * 1024 + fq * 16 + fr) * 8; asm volatile("" : "+v"(lbase));
#pragma unroll
        for (int ai = 0; ai < 2; ++ai)
#pragma unroll
            for (int m = 0; m < 4; ++m) { bf16_t* rowp = O + (size_t)(row0 + ai * HALF + m * 16) * ldc + pcol;
#pragma unroll
                for (int bj = 0; bj < 2; ++bj) { const f32x4 v0 = acc[ai][bj][m][0], v1 = acc[ai][bj][m][1];
                    u32x4 w; w.x = pk2(v0[0], v0[1]); w.y = pk2(v0[2], v0[3]); w.z = pk2(v1[0], v1[1]); w.w = pk2(v1[2], v1[3]);
                    if (gate) *(u32x4*)(gbase + lbase + (((ai * 4 + m) * 2 + bj) * 512)) = w; else *(u32x4*)(rowp + bj * HALF) = w; } }
    }
};
struct EpiBranch {
    static constexpr bool PERM = true, KEEPS = true;
    const bf16_t* G; const float* bgate; bf16_t* MG;
    static __device__ __forceinline__ float den(float p) { return 1.0f + __expf(-__builtin_amdgcn_fmed3f(p, -30.0f, 30.0f)); }
    __device__ __forceinline__ void operator()(f32x4 (&acc)[2][2][4][2], const Unit& u, int wr, int wc, int fr, int fq) const {
        const int row0 = u.pm * BM + wr * 64 + fr, col0 = u.pn * BM + wc * 32 + 8 * fq; const int br = u.tag; const bool mid = br < 2;
        int lbase = ((wr * 4 + wc) * 1024 + fq * 16 + fr) * 8; asm volatile("" : "+v"(lbase));
        u32x2 bA[2][2], bB[2][2];
#pragma unroll
        for (int bj = 0; bj < 2; ++bj)
#pragma unroll
            for (int n = 0; n < 2; ++n) { const f32x4 t = *(const f32x4*)(bgate + br * D + col0 + bj * HALF + 4 * n); bA[bj][n].x = pk2(t[0], t[1]); bA[bj][n].y = pk2(t[2], t[3]);
                const f32x4 t2 = *(const f32x4*)(bgate + (mid ? br + 1 : br) * D + col0 + bj * HALF + 4 * n); bB[bj][n].x = pk2(t2[0], t2[1]); bB[bj][n].y = pk2(t2[2], t2[3]); }
        const bf16_t* gA = G + ((size_t)(br * (M / BM) + u.pm) * 8 + u.pn) * 65536;
        const bf16_t* gB = gA + (mid ? (size_t)(M / BM) * 8 * 65536 : 0);
        u32x4 gaq[2][2], gbq[2][2];
#define EB_LOAD(A8) do { _Pragma("unroll") for (int bj = 0; bj < 2; ++bj) { const int fo = lbase + (((A8) * 2 + bj) * 512); \
                gaq[(A8) & 1][bj] = *(const u32x4*)(gA + fo); gbq[(A8) & 1][bj] = *(const u32x4*)(gB + fo); } } while (0)
        EB_LOAD(0);
#pragma unroll
        for (int a8 = 0; a8 < 8; ++a8) { const int ai = a8 >> 2, m = a8 & 3; const size_t row = (size_t)(row0 + ai * HALF + m * 16);
            if (a8 + 1 < 8) EB_LOAD(a8 + 1);
            asm volatile("" ::: "memory");
#pragma unroll
                for (int bj = 0; bj < 2; ++bj) { const u32x4 a4 = gaq[a8 & 1][bj], b4 = gbq[a8 & 1][bj];
                    const unsigned aw[4] = {a4.x, a4.y, a4.z, a4.w}, bw[4] = {b4.x, b4.y, b4.z, b4.w}; unsigned ow[4];
#pragma unroll
                    for (int n = 0; n < 2; ++n) { const unsigned bax = bA[bj][n].x, bay = bA[bj][n].y, bbx = bB[bj][n].x, bby = bB[bj][n].y;
                        float f0 = __builtin_amdgcn_rcpf(den(bflo(aw[2 * n]) + bflo(bax))), f1 = __builtin_amdgcn_rcpf(den(bfhi(aw[2 * n]) + bfhi(bax)));
                        float f2 = __builtin_amdgcn_rcpf(den(bflo(aw[2 * n + 1]) + bflo(bay))), f3 = __builtin_amdgcn_rcpf(den(bfhi(aw[2 * n + 1]) + bfhi(bay)));
                        if (mid) { f0 *= den(bflo(bw[2 * n]) + bflo(bbx)); f1 *= den(bfhi(bw[2 * n]) + bfhi(bbx)); f2 *= den(bflo(bw[2 * n + 1]) + bflo(bby)); f3 *= den(bfhi(bw[2 * n + 1]) + bfhi(bby)); }
                        f32x4& av = acc[ai][bj][m][n];
                        av[0] *= f0; av[1] *= f1; av[2] *= f2; av[3] *= f3;
                        ow[2 * n] = pk2(av[0], av[1]); ow[2 * n + 1] = pk2(av[2], av[3]); }
                    if (!mid) { u32x4 o; o.x = ow[0]; o.y = ow[1]; o.z = ow[2]; o.w = ow[3]; *(u32x4*)(MG + row * D + col0 + bj * HALF) = o; } }
        }
#undef EB_LOAD
    }
};
}

#define XB_TMO      128
#define XB_XCNT(j)  (256  + 64 * (j))
#define XB_XSUB(j)  (1280 + 64 * (j))
#define XB_XGEN(j)  (2304 + 64 * (j))
#define XB_TOP      3328
#define XB_TOPGEN   3392
#define XCD_BAR_WORDS 3456
#define XB_SPIN_CAP (1u << 18)
__device__ __forceinline__ unsigned xb_ld(unsigned* p)              { return __hip_atomic_load(p, __ATOMIC_RELAXED, __HIP_MEMORY_SCOPE_AGENT); }
__device__ __forceinline__ unsigned xb_add(unsigned* p, unsigned v) { return __hip_atomic_fetch_add(p, v, __ATOMIC_RELAXED, __HIP_MEMORY_SCOPE_AGENT); }
__device__ __forceinline__ unsigned xb_xcc_id() { return (unsigned)__builtin_amdgcn_s_getreg((3 << 11) | 20) & 0xFu; }
#define XB_SPIN(cond, bar) do { unsigned _sp = 0; while (cond) { __builtin_amdgcn_s_sleep(1); \
    if ((++_sp & 255u) == 0u) { if (xb_ld(&(bar)[XB_TMO])) break; if (_sp > XB_SPIN_CAP) { atomicAdd(&(bar)[XB_TMO], 1u); break; } } } } while (0)
struct XcdBarrier { unsigned* bar; unsigned x; volatile LAS unsigned* st; };
__device__ __forceinline__ XcdBarrier xcd_barrier_post(unsigned* bar, volatile LAS unsigned* st) {
    XcdBarrier b; b.bar = bar; b.x = xb_xcc_id(); b.st = st;
    if (threadIdx.x == 0) (void)xb_add(&bar[XB_XCNT(b.x)], 1u);
    return b;
}
__device__ __forceinline__ void xcd_barrier_complete(unsigned* bar, unsigned x, unsigned& nloc, unsigned& nx) {
    const unsigned G = gridDim.x * gridDim.y * gridDim.z;
    unsigned sum, cnt, mine, sp = 0u;
    for (;;) {
        sum = 0u; cnt = 0u; mine = 0u;
#pragma unroll
        for (unsigned j = 0; j < 16; ++j) { const unsigned c = xb_ld(&bar[XB_XCNT(j)]); sum += c; cnt += (c > 0u) ? 1u : 0u; mine = (j == x) ? c : mine; }
        if (sum == G) break;
        __builtin_amdgcn_s_sleep(1);
        if ((++sp & 255u) == 0u) { if (xb_ld(&bar[XB_TMO])) break; if (sp > XB_SPIN_CAP) { atomicAdd(&bar[XB_TMO], 1u); break; } }
    }
    nloc = mine > 0u ? mine : 1u; nx = cnt > 0u ? cnt : 1u;
}
__device__ __forceinline__ void xcd_barrier(const XcdBarrier& b) {
    asm volatile("s_waitcnt vmcnt(0)" ::: "memory");
    __syncthreads();
    if (threadIdx.x == 0) {
        unsigned* bar = b.bar;
        __builtin_amdgcn_s_waitcnt(0);
        unsigned nloc = b.st[0], nx = b.st[1];
        if (nloc == 0u) { xcd_barrier_complete(bar, b.x, nloc, nx); b.st[0] = nloc; b.st[1] = nx; }
        const unsigned old = xb_add(&bar[XB_XSUB(b.x)], 1u);
        const unsigned gen = old / nloc;
        if (old + 1u == (gen + 1u) * nloc) {
            __builtin_amdgcn_fence(__ATOMIC_RELEASE, "agent");
            asm volatile("s_waitcnt vmcnt(0)" ::: "memory");
            const unsigned og = xb_add(&bar[XB_TOP], 1u);
            const unsigned tg = og / nx;
            if (og + 1u == (tg + 1u) * nx) xb_add(&bar[XB_TOPGEN], 1u);
            else XB_SPIN(xb_ld(&bar[XB_TOPGEN]) == tg, bar);
            __builtin_amdgcn_fence(__ATOMIC_ACQUIRE, "agent");
            xb_add(&bar[XB_XGEN(b.x)], 1u);
            asm volatile("s_waitcnt vmcnt(0)" ::: "memory");
        } else {
            XB_SPIN(xb_ld(&bar[XB_XGEN(b.x)]) == gen, bar);
            __builtin_amdgcn_fence(__ATOMIC_ACQUIRE, "agent");
            asm volatile("s_waitcnt vmcnt(0)" ::: "memory");
        }
    }
    __syncthreads();
}

struct Args { const float* in[33]; float* out; unsigned char* ws; int lo, hi; };
enum { I_X = 0, I_F1IN, I_F1OUT, I_LN1G, I_LN1B, I_WIN, I_BGATE, I_MU, I_W0, I_W2, I_A0, I_A2, I_G2, I_KK, I_KA, I_RK, I_GNG, I_GNB, I_SGLNG, I_SGLNB, I_SGW, I_SGB, I_ILNG, I_ILNB, I_RELB, I_WBR, I_WO, I_LN2G, I_LN2B, I_F2IN, I_F2OUT, I_LN3G, I_LN3B };

DI int pmap(int n) {
    int off = 0;
    off = n >= 3072 ? GN_LORA - 3072 : off; off = n >= 3360 ? PC_SGU - 3360 : off; off = n >= 4384 ? PC_AQ - 4384 : off; off = n >= 5920 ? PC_QI - 5920 : off;
    off = n >= 6944 ? GN_KI - 6944 : off; off = n >= 7008 ? GN_WI - 7008 : off; off = n >= 7024 ? GN_GATE - 7024 : off;
    return n + off;
}
template <int MODE> DI int rowmap(int n) {
    if (MODE == 0) return n;
    if (MODE == 1) { const int up = n >= FF ? 1 : 0, j = n - up * FF; return (j >> 7) * 256 + up * 128 + (j & 127); }
    return pmap(n);
}
struct CvtItem { const float* W; bf16_t* WT; int K, N, mode, item; };
DI void cvt_load(const CvtItem& d, int lane, f32x4 (&va)[4], f32x4 (&vb)[4]) {
    const int nblk = (d.N + 31) / 32, kb = d.item / nblk, nb = d.item % nblk, k0 = 64 * kb, n0 = 32 * nb;
    const int c4 = lane & 7, rq = lane >> 3; const int ncol = n0 + 4 * c4; const int ncl = ncol < d.N ? ncol : 0;
#pragma unroll
    for (int i = 0; i < 4; ++i) { const int k = k0 + 2 * (rq + 8 * i);
        va[i] = *(const f32x4*)(d.W + (size_t)k * d.N + ncl); vb[i] = *(const f32x4*)(d.W + (size_t)(k + 1) * d.N + ncl); }
}
DI void cvt_finish(const CvtItem& d, int lane, const f32x4 (&va)[4], const f32x4 (&vb)[4], float* scr) {
    const int nblk = (d.N + 31) / 32, kb = d.item / nblk, nb = d.item % nblk, k0 = 64 * kb, n0 = 32 * nb;
    unsigned* st = (unsigned*)scr; const int c4 = lane & 7, rq = lane >> 3;
#pragma unroll
    for (int i = 0; i < 4; ++i) { const int rp = rq + 8 * i;
#pragma unroll
        for (int j = 0; j < 4; ++j) st[(4 * c4 + j) * 33 + rp] = pk2(va[i][j], vb[i][j]); }
    __builtin_amdgcn_s_waitcnt(0xc07f); asm volatile("" ::: "memory");
#pragma unroll
    for (int i = 0; i < 4; ++i) { const int id = lane + 64 * i, n = id >> 3, kc = id & 7; const unsigned* p = st + n * 33 + 4 * kc;
        u32x4 o; o.x = p[0]; o.y = p[1]; o.z = p[2]; o.w = p[3];
        const int ns = n0 + n; const int nd1 = rowmap<1>(ns), nd2 = pmap(ns); const int nd = d.mode == 0 ? ns : (d.mode == 1 ? nd1 : nd2);
        if (ns < d.N) *(u32x4*)(d.WT + (size_t)nd * d.K + k0 + 8 * kc) = o; }
    __builtin_amdgcn_s_waitcnt(0xc07f); asm volatile("" ::: "memory");
}
DI void convert_phase(const Args& a, int L, unsigned char* lds, int vb, int nvb) {
    const int tidx_ = otid();
    const int wave = __builtin_amdgcn_readfirstlane(tidx_ >> 6), lane = tidx_ & 63;
    float* scr = (float*)(lds + wave * 16384);
    const int gw = vb * 8 + wave, NGW = nvb * 8;
    unsigned char* ws = a.ws; const size_t alt = (L & 1) ? ALT_SHIFT : 0;
    constexpr int I1 = (D / 64) * ((2 * FF) / 32), I2 = (FF / 64) * (D / 32), I3 = (D / 64) * ((DIN + 31) / 32), I4 = (D / 64) * (D / 32);
    constexpr int NIT = 2 * I1 + 2 * I2 + I3 + 2 * I4;
    auto decode = [&](int it) -> CvtItem {
        int r = it;
        if (r < I1) return CvtItem{a.in[I_F1IN] + (size_t)L * D * 2 * FF, (bf16_t*)(ws + OFF_W1A), D, 2 * FF, 1, r}; r -= I1;
        if (r < I1) return CvtItem{a.in[I_F2IN] + (size_t)L * D * 2 * FF, (bf16_t*)(ws + OFF_W2A + alt), D, 2 * FF, 1, r}; r -= I1;
        if (r < I2) return CvtItem{a.in[I_F1OUT] + (size_t)L * FF * D, (bf16_t*)(ws + OFF_W1B), FF, D, 0, r}; r -= I2;
        if (r < I2) return CvtItem{a.in[I_F2OUT] + (size_t)L * FF * D, (bf16_t*)(ws + OFF_W2B + alt), FF, D, 0, r}; r -= I2;
        if (r < I3) return CvtItem{a.in[I_WIN] + (size_t)L * D * DIN, (bf16_t*)(ws + OFF_WIN), D, DIN, 2, r}; r -= I3;
        if (r < I4) return CvtItem{a.in[I_WBR] + (size_t)L * D * D, (bf16_t*)(ws + OFF_WBR + alt), D, D, 0, r}; r -= I4;
        return CvtItem{a.in[I_WO] + (size_t)L * D * D, (bf16_t*)(ws + OFF_WO + alt), D, D, 0, r};
    };
    auto clampi = [&](int x) { return x < NIT ? x : gw; };
    {
        int it = gw;
        CvtItem dA0 = decode(clampi(it)), dA1 = decode(clampi(it + NGW));
        f32x4 a0[4], b0[4], a1[4], b1[4], a2[4], b2[4], a3[4], b3[4];
        cvt_load(dA0, lane, a0, b0); cvt_load(dA1, lane, a1, b1);
#pragma unroll 1
        for (; it < NIT; it += 4 * NGW) {
            const CvtItem dB0 = decode(clampi(it + 2 * NGW)), dB1 = decode(clampi(it + 3 * NGW));
            cvt_load(dB0, lane, a2, b2); cvt_load(dB1, lane, a3, b3);
            asm volatile("" ::: "memory");
            cvt_finish(dA0, lane, a0, b0, scr); cvt_finish(dA1, lane, a1, b1, scr + 2048);
            asm volatile("" ::: "memory");
            dA0 = decode(clampi(it + 4 * NGW)); dA1 = decode(clampi(it + 5 * NGW));
            cvt_load(dA0, lane, a0, b0); cvt_load(dA1, lane, a1, b1);
            asm volatile("" ::: "memory");
            cvt_finish(dB0, lane, a2, b2, scr); cvt_finish(dB1, lane, a3, b3, scr + 2048);
            asm volatile("" ::: "memory");
        }
    }
    { bf16_t* w2t = (bf16_t*)(ws + OFF_LW2); bf16_t* a2t = (bf16_t*)(ws + OFF_LA2); bf16_t* g2t = (bf16_t*)(ws + OFF_LG2);
      const float* w2 = a.in[I_W2] + (size_t)L * 64 * RW; const float* a2 = a.in[I_A2] + (size_t)L * 64 * RW; const float* g2 = a.in[I_G2] + (size_t)L * 160 * RW;
      for (int i = vb * 512 + tidx_; i < RW * 288; i += nvb * 512) { const int c = i / 288, jj = i - c * 288;
          if (jj < 64) w2t[c * 64 + jj] = (bf16_t)f2bf(w2[(size_t)jj * RW + c]);
          else if (jj < 128) a2t[c * 64 + jj - 64] = (bf16_t)f2bf(a2[(size_t)(jj - 64) * RW + c]);
          else g2t[c * 160 + jj - 128] = (bf16_t)f2bf(g2[(size_t)(jj - 128) * RW + c]); } }
    { u32x4* z = (u32x4*)(ws + OFF_WIN + (size_t)DIN * D * 2); const int n16 = (NP - DIN) * D * 2 / 16;
      u32x4 zq = (u32x4){0u, 0u, 0u, 0u}; asm volatile("" : "+v"(zq));
      for (int i = vb * 512 + tidx_; i < n16; i += nvb * 512) z[i] = zq; }
}
DI int rel_bucket_dev(int d) {
    if (d < 16) return d;
    const float df = (float)d;
    const int large = 16 + (int)(logf(df / 16.0f) / 2.0794415416798357f * 16.0f);
    return large < 31 ? large : 31;
}
DI void init_phase(const Args& a) {
    const int tidx_ = otid();
    const size_t n4 = (size_t)M * D / 4; const f32x4* x = (const f32x4*)a.in[I_X]; u32x2* XB = (u32x2*)(a.ws + OFF_XB);
    for (size_t i = (size_t)blockIdx.x * 512 + tidx_; i < n4; i += (size_t)gridDim.x * 512) { const f32x4 v = x[i]; u32x2 o; o.x = pk2(v[0], v[1]); o.y = pk2(v[2], v[3]); XB[i] = o; }
    if (blockIdx.x == 0) { float* bt = (float*)(a.ws + OFF_BIAS); for (int i = tidx_; i < 8 * 128; i += 512) { const int h = i >> 7, d = i & 127; bt[i] = a.in[I_RELB][rel_bucket_dev(d) * 8 + h]; } }
}
DI void ln_phase(const float* T, const float* g, const float* b, float* ST, bf16_t* XB, float* out) {
    const int tidx_ = otid();
    const int wave = __builtin_amdgcn_readfirstlane(tidx_ >> 6), lane = tidx_ & 63;
    const int stride = gridDim.x * 8;
    f32x4 gvs[8], bvs[8];
#pragma unroll
    for (int j = 0; j < 8; ++j) { gvs[j] = ((const f32x4*)g)[lane + 64 * j]; bvs[j] = ((const f32x4*)b)[lane + 64 * j]; }
    int m = blockIdx.x * 8 + wave;
    f32x4 nx[8];
    if (m < M) {
#pragma unroll
        for (int j = 0; j < 8; ++j) nx[j] = ((const f32x4*)(T + (size_t)m * D) + lane)[64 * j]; }
#pragma unroll 1
    for (; m < M; m += stride) {
        f32x4 v[8]; float s = 0.f;
#pragma unroll
        for (int j = 0; j < 8; ++j) { v[j] = nx[j]; s += (v[j][0] + v[j][1]) + (v[j][2] + v[j][3]); }
        if (m + stride < M) {
#pragma unroll
            for (int j = 0; j < 8; ++j) nx[j] = ((const f32x4*)(T + (size_t)(m + stride) * D) + lane)[64 * j]; }
        const float mean = wave_sum(s) * (1.0f / D); float q = 0.f;
#pragma unroll
        for (int j = 0; j < 8; ++j) { v[j] = v[j] - mean; q += (v[j][0] * v[j][0] + v[j][1] * v[j][1]) + (v[j][2] * v[j][2] + v[j][3] * v[j][3]); }
        const float rstd = __builtin_amdgcn_rsqf(wave_sum(q) * (1.0f / D) + LN_EPS);
        if (lane == 0) *(f32x2*)(ST + 2 * (size_t)m) = (f32x2){mean, rstd};
        u32x2* bo = (u32x2*)(XB + (size_t)m * D) + lane;
#pragma unroll
        for (int j = 0; j < 8; ++j) {
            const f32x4 o = v[j] * rstd * gvs[j] + bvs[j]; u32x2 w; w.x = pk2(o[0], o[1]); w.y = pk2(o[2], o[3]); if (XB) bo[64 * j] = w;
            if (out) ((f32x4*)(out + (size_t)m * D) + lane)[64 * j] = o; }
    }
}
DI void rwkv_prep_phase(const Args& a, int L, unsigned char* lds) {
    const int tidx_ = otid();
    const int tid = tidx_;
    const bf16_t* P = (const bf16_t*)(a.ws + OFF_P);
    float* Rr = (float*)(a.ws + OFF_SCR); float* Wr = Rr + (size_t)M * RW; float* Kr = Wr + (size_t)M * RW; float* Vr = Kr + (size_t)M * RW; float* Ar = Vr + (size_t)M * RW; float* Br = Ar + (size_t)M * RW;
    bf16_t* Gb = (bf16_t*)(a.ws + OFF_MG);
    const float* mu = a.in[I_MU] + (size_t)L * 3360; const float* w0 = a.in[I_W0] + L * RW; const float* w2 = a.in[I_W2] + (size_t)L * 64 * RW;
    const float* a0 = a.in[I_A0] + L * RW; const float* a2 = a.in[I_A2] + (size_t)L * 64 * RW; const float* g2 = a.in[I_G2] + (size_t)L * 160 * RW;
    const float* kkw = a.in[I_KK] + L * RW; const float* kaw = a.in[I_KA] + L * RW;
    float* xl = (float*)lds;
    for (int unit = blockIdx.x; unit < M / 32; unit += gridDim.x) {
        const int m0 = unit * 32;
        __syncthreads();
        for (int idx = tid; idx < 32 * 288; idx += 512) { const int tt = idx / 288, j = idx - tt * 288; const int m = m0 + tt;
            const float cur = bf2f(P[(size_t)m * PCOLS + PC_LORA + j]); const float prev = (m & (SEQ - 1)) == 0 ? 0.f : bf2f(P[(size_t)(m - 1) * PCOLS + PC_LORA + j]);
            float x = cur + (prev - cur) * mu[3072 + j];
            if (j < 64) x = tanhf(x); else if (j >= 128) x = sigmoidf_(x);
            xl[idx] = x; }
        __syncthreads();
#pragma unroll 1
        for (int half = 0; half < 2; ++half) { const int c = tid + 512 * half;
            const float w0c = w0[c], a0c = a0[c], kkc = kkw[c], kac = kaw[c], mur = mu[c], muk = mu[1024 + c], muv = mu[2048 + c];
#pragma unroll 1
            for (int sub = 0; sub < 4; ++sub) {
                float wl[8], al[8], gl[8];
#pragma unroll
                for (int t = 0; t < 8; ++t) { wl[t] = w0c; al[t] = a0c; gl[t] = 0.f; }
                const float* xb = xl + sub * 8 * 288;
#pragma unroll 2
                for (int j = 0; j < 64; j += 4) { const float u0 = w2[(size_t)(j + 0) * RW + c], u1 = w2[(size_t)(j + 1) * RW + c], u2 = w2[(size_t)(j + 2) * RW + c], u3 = w2[(size_t)(j + 3) * RW + c];
                    const float v0 = a2[(size_t)(j + 0) * RW + c], v1 = a2[(size_t)(j + 1) * RW + c], v2 = a2[(size_t)(j + 2) * RW + c], v3 = a2[(size_t)(j + 3) * RW + c];
#pragma unroll
                    for (int t = 0; t < 8; ++t) { const f32x4 xw = *(const f32x4*)(xb + t * 288 + j); const f32x4 xa = *(const f32x4*)(xb + t * 288 + 64 + j);
                        wl[t] += xw[0] * u0 + xw[1] * u1 + xw[2] * u2 + xw[3] * u3; al[t] += xa[0] * v0 + xa[1] * v1 + xa[2] * v2 + xa[3] * v3; } }
#pragma unroll 2
                for (int j = 0; j < 160; j += 4) { const float u0 = g2[(size_t)(j + 0) * RW + c], u1 = g2[(size_t)(j + 1) * RW + c], u2 = g2[(size_t)(j + 2) * RW + c], u3 = g2[(size_t)(j + 3) * RW + c];
#pragma unroll
                    for (int t = 0; t < 8; ++t) { const f32x4 xg = *(const f32x4*)(xb + t * 288 + 128 + j); gl[t] += xg[0] * u0 + xg[1] * u1 + xg[2] * u2 + xg[3] * u3; } }
#pragma unroll
                for (int t = 0; t < 8; ++t) { const int m = m0 + sub * 8 + t; const bool first = (m & (SEQ - 1)) == 0;
                    const bf16_t* pc = P + (size_t)m * PCOLS; const bf16_t* pp = pc - PCOLS;
                    const float rc = bf2f(pc[PC_R + c]), kc = bf2f(pc[PC_K + c]), vc = bf2f(pc[PC_V + c]);
                    const float rp = first ? 0.f : bf2f(pp[PC_R + c]), kp = first ? 0.f : bf2f(pp[PC_K + c]), vp = first ? 0.f : bf2f(pp[PC_V + c]);
                    const float r = rc + (rp - rc) * mur, k = kc + (kp - kc) * muk, v = vc + (vp - vc) * muv;
                    const float nx = -wl[t]; const float sp = nx > 20.f ? nx : log1pf(expf(nx));
                    const float decay = expf(-expf(-sp - 0.5f));
                    const float av = 1.0f / (1.0f + expf(-al[t]));
                    const float kk = k * kkc; const float ss = wave_sum(kk * kk); const float kkn = kk / fmaxf(sqrtf(ss), 1e-12f);
                    const float k2 = k * (1.0f + (av - 1.0f) * kac);
                    const size_t o = (size_t)m * RW + c;
                    Rr[o] = r; Wr[o] = decay; Kr[o] = k2; Vr[o] = v; Ar[o] = -kkn; Br[o] = kkn * av; Gb[o] = (bf16_t)f2bf(gl[t]); }
            }
        }
    }
}
struct WorkQ { unsigned* ctr; int pend, par, stride; };
constexpr int WQ_SLOT = 147456 - 16;
DI int wq_next(WorkQ& q, int cur, unsigned char* lds, int tid) {
    if (!q.ctr) return cur + q.stride;
    LAS int* slot = (LAS int*)(lds + WQ_SLOT);
    if (tid == 0) slot[q.par] = q.pend;
    __syncthreads();
    const int v = __builtin_amdgcn_readfirstlane(slot[q.par]);
    q.par ^= 1;
    if (tid == 0) q.pend = (int)__hip_atomic_fetch_add(q.ctr, 1u, __ATOMIC_RELAXED, __HIP_MEMORY_SCOPE_AGENT);
    return v;
}
DI int wq_first(WorkQ& q, unsigned char* lds, int tid) {
    q.par = 0; q.pend = 0;
    if (tid == 0) q.pend = (int)__hip_atomic_fetch_add(q.ctr, 1u, __ATOMIC_RELAXED, __HIP_MEMORY_SCOPE_AGENT);
    return wq_next(q, 0, lds, tid);
}
DI void kidx_vt_phase(const Args& a, int L, unsigned char* lds) {
    const int tidx_ = otid();
    const int wave = __builtin_amdgcn_readfirstlane(tidx_ >> 6), lane = tidx_ & 63;
    const bf16_t* P = (const bf16_t*)(a.ws + OFF_P); bf16_t* KI = (bf16_t*)(a.ws + OFF_KI); bf16_t* VT = (bf16_t*)(a.ws + OFF_VT);
    const float g = a.in[I_ILNG][L * 64 + lane], b = a.in[I_ILNB][L * 64 + lane];
    for (int m0 = blockIdx.x * 8 + wave; m0 < M; m0 += gridDim.x * 8 * 8) {
        bf16_t raw[8];
#pragma unroll
        for (int i = 0; i < 8; ++i) { const int m = m0 + i * gridDim.x * 8; raw[i] = m < M ? P[(size_t)m * PCOLS + PC_KI + lane] : (bf16_t)0; }
#pragma unroll
        for (int i = 0; i < 8; ++i) { const int m = m0 + i * gridDim.x * 8; if (m < M) { const float x = bf2f(raw[i]);
            const float mean = wave_sum(x) * (1.0f / 64.0f); const float d = x - mean; const float var = wave_sum(d * d) * (1.0f / 64.0f);
            KI[(size_t)m * 64 + lane] = (bf16_t)f2bf(d * __builtin_amdgcn_rsqf(var + LN_EPS) * g + b); } }
    }
    bf16_t* tile = (bf16_t*)(lds + wave * 16384);
    for (int u = blockIdx.x * 8 + wave; u < NB * 8 * 64; u += gridDim.x * 8) {
        const int tb = u & 63, h = (u >> 6) & 7, b_ = u >> 9; const int m = b_ * SEQ + tb * 64 + lane;
        const u32x4* src = (const u32x4*)(P + (size_t)m * PCOLS + PC_AV + h * 64);
#pragma unroll
        for (int q = 0; q < 8; ++q) { const u32x4 v = src[q]; const unsigned w[4] = {v.x, v.y, v.z, v.w};
#pragma unroll
            for (int e = 0; e < 4; ++e) { tile[(q * 8 + 2 * e) * 72 + lane] = (bf16_t)(w[e] & 0xffffu); tile[(q * 8 + 2 * e + 1) * 72 + lane] = (bf16_t)(w[e] >> 16); } }
        __builtin_amdgcn_s_waitcnt(0xc07f); asm volatile("" ::: "memory");
        bf16_t* dst = VT + ((size_t)(b_ * 8 + h) * 64 + lane) * SEQ + tb * 64;
#pragma unroll
        for (int q = 0; q < 8; ++q) *(u32x4*)(dst + q * 8) = *(const u32x4*)(tile + lane * 72 + q * 8);
        __builtin_amdgcn_s_waitcnt(0xc07f); asm volatile("" ::: "memory");
    }
}
DI void sgu_phase(const Args& a, int L, unsigned char* lds, WorkQ& wq, int& item, int ibase) {
    const int tidx_ = otid();
    const int tid = tidx_, wave = __builtin_amdgcn_readfirstlane(tid >> 6), lane = tid & 63, fr = lane & 15, fq = lane >> 4;
    const bf16_t* P = (const bf16_t*)(a.ws + OFF_P); bf16_t* Y = (bf16_t*)(a.ws + OFF_Y);
    const float* lng = a.in[I_SGLNG] + L * 512; const float* lnb = a.in[I_SGLNB] + L * 512;
    bf16_t* Wl = (bf16_t*)lds;
    bf16_t* Vl = (bf16_t*)(lds + 128 * 272);
    for (; item < ibase + NB * 32 * 4; item = wq_next(wq, item, lds, tid)) {
        const int unit = item - ibase;
        const int g = unit & 3, ch = (unit >> 2) & 31, b_ = unit >> 7; const int m0 = b_ * SEQ + ch * 128;
        const float* sw = a.in[I_SGW] + ((size_t)(L * 4 + g) * 128) * 128; const float* sb = a.in[I_SGB] + (L * 4 + g) * 128;
        __syncthreads();
#pragma unroll
        for (int it8 = 0; it8 < 8; ++it8) { const int idx = tid + 512 * it8; const int i = idx >> 5, j4 = (idx & 31) * 4; const f32x4 w = *(const f32x4*)(sw + i * 128 + j4);
            u32x2 o; o.x = pk2(j4 + 0 <= i ? w[0] : 0.f, j4 + 1 <= i ? w[1] : 0.f); o.y = pk2(j4 + 2 <= i ? w[2] : 0.f, j4 + 3 <= i ? w[3] : 0.f);
            *(u32x2*)(Wl + i * 136 + j4) = o; }
        float lgv[8], lbv[8];
#pragma unroll
        for (int e = 0; e < 8; ++e) { lgv[e] = lng[lane * 8 + e]; lbv[e] = lnb[lane * 8 + e]; }
#pragma unroll 1
        for (int ib = 0; ib < 2; ++ib) {
        u32x4 pvs[8];
#pragma unroll
        for (int i = 0; i < 8; ++i) pvs[i] = *(const u32x4*)(P + (size_t)(m0 + wave + 8 * (8 * ib + i)) * PCOLS + PC_SGV + lane * 8);
#pragma unroll
        for (int i = 0; i < 8; ++i) { const int tt = wave + 8 * (8 * ib + i);
            const u32x4 pv = pvs[i];
            float z[8]; z[0] = gelu_erf(bflo(pv.x)); z[1] = gelu_erf(bfhi(pv.x)); z[2] = gelu_erf(bflo(pv.y)); z[3] = gelu_erf(bfhi(pv.y));
            z[4] = gelu_erf(bflo(pv.z)); z[5] = gelu_erf(bfhi(pv.z)); z[6] = gelu_erf(bflo(pv.w)); z[7] = gelu_erf(bfhi(pv.w));
            float s = 0.f;
#pragma unroll
            for (int e = 0; e < 8; ++e) s += z[e];
            const float mean = wave_sum(s) * (1.0f / 512.0f); float q = 0.f;
#pragma unroll
            for (int e = 0; e < 8; ++e) { z[e] -= mean; q += z[e] * z[e]; }
            const float rstd = __builtin_amdgcn_rsqf(wave_sum(q) * (1.0f / 512.0f) + LN_EPS);
            if ((lane >> 4) == g) {
#pragma unroll
                for (int e = 0; e < 8; ++e) Vl[((lane & 15) * 8 + e) * 136 + tt] = (bf16_t)f2bf(z[e] * rstd * lgv[e] + lbv[e]); }
        }
        }
        __syncthreads();
        f32x4 acc[8];
#pragma unroll
        for (int nt = 0; nt < 8; ++nt) acc[nt] = (f32x4){0.f, 0.f, 0.f, 0.f};
        const int ksmax = (16 * wave + 15) >> 5;
#pragma unroll
        for (int ks = 0; ks < 4; ++ks) if (ks <= ksmax) {
            const bf16x8 af = *(const bf16x8*)(Wl + (16 * wave + fr) * 136 + 32 * ks + 8 * fq);
#pragma unroll
            for (int nt = 0; nt < 8; ++nt) { const bf16x8 bfr = *(const bf16x8*)(Vl + (16 * nt + fr) * 136 + 32 * ks + 8 * fq);
                acc[nt] = __builtin_amdgcn_mfma_f32_16x16x32_bf16(af, bfr, acc[nt], 0, 0, 0); }
        }
        bf16_t ur[4][8];
#pragma unroll
        for (int r = 0; r < 4; ++r)
#pragma unroll
            for (int nt = 0; nt < 8; ++nt) ur[r][nt] = P[(size_t)(m0 + 16 * wave + 4 * fq + r) * PCOLS + PC_SGU + g * 128 + 16 * nt + fr];
        float bsv[4];
#pragma unroll
        for (int r = 0; r < 4; ++r) bsv[r] = sb[16 * wave + 4 * fq + r];
        asm volatile("" ::: "memory");
#pragma unroll
        for (int r = 0; r < 4; ++r) { const int i = 16 * wave + 4 * fq + r; const float bs = bsv[r]; const size_t m = (size_t)(m0 + i);
#pragma unroll
            for (int nt = 0; nt < 8; ++nt) { const int dcol = g * 128 + 16 * nt + fr; const float uu = gelu_erf(bf2f(ur[r][nt]));
                Y[m * D + 1024 + dcol] = (bf16_t)f2bf(uu * (acc[nt][r] + bs)); } }
    }
}
DI void scan_load_chunk(unsigned char* bufp, const float* Rr, const float* Wr, const float* Kr, const float* Ar, const float* Br, const float* Vr, size_t base, int c, int rg, int lt) {
    const float* arrs[5] = {Rr, Wr, Kr, Ar, Br};
#pragma unroll
    for (int ar = 0; ar < 5; ++ar)
#pragma unroll
        for (int ps = 0; ps < 2; ++ps) { const int tt = ps * 16 + (lt >> 4), c4 = (lt & 15) * 4;
            const f32x4 v = *(const f32x4*)(arrs[ar] + base + (size_t)(c * 32 + tt) * RW + c4);
            *(f32x4*)(bufp + ar * 8192 + (tt * 64 + c4) * 4) = v; }
    if (lt < 128) { const int tt = lt >> 2, i4 = (lt & 3) * 4; const f32x4 v = *(const f32x4*)(Vr + base + (size_t)(c * 32 + tt) * RW + rg * 16 + i4);
        *(f32x4*)(bufp + 5 * 8192 + (tt * 16 + i4) * 4) = v; }
}
DI void scan_phase(const Args& a, unsigned char* lds) {
    const int tidx_ = otid();
    const int tid = tidx_;
    const float* Rr = (const float*)(a.ws + OFF_SCR); const float* Wr = Rr + (size_t)M * RW; const float* Kr = Wr + (size_t)M * RW; const float* Vr = Kr + (size_t)M * RW; const float* Ar = Vr + (size_t)M * RW; const float* Br = Ar + (size_t)M * RW;
    float* Yraw = (float*)(a.ws + OFF_X);
    constexpr int BUFB = 5 * 8192 + 2048;
    constexpr int NCH = SEQ / 32;
    for (int unit = blockIdx.x; unit < 256; unit += gridDim.x) {
        const int rg = unit & 3, h = (unit >> 2) & 15, b_ = unit >> 6;
        const size_t base = (size_t)b_ * SEQ * RW + h * 64;
        __syncthreads();
        const bool loader = tid >= 256; const int lt = tid - 256;
        if (loader) scan_load_chunk(lds, Rr, Wr, Kr, Ar, Br, Vr, base, 0, rg, lt);
        __syncthreads();
        float S0 = 0.f, S1 = 0.f, S2 = 0.f, S3 = 0.f;
        const int i = tid >> 4, c4 = tid & 15;
#pragma unroll 1
        for (int c = 0; c < NCH; ++c) {
            if (loader) {
                if (c > 0 && lt < 128) { const int tt = lt >> 2, i4 = (lt & 3) * 4; const f32x4 y = *(const f32x4*)(lds + 2 * BUFB + ((c - 1) & 1) * 2048 + (tt * 16 + i4) * 4);
                    *(f32x4*)(Yraw + base + (size_t)((c - 1) * 32 + tt) * RW + rg * 16 + i4) = y; }
                if (c + 1 < NCH) scan_load_chunk(lds + ((c + 1) & 1) * BUFB, Rr, Wr, Kr, Ar, Br, Vr, base, c + 1, rg, lt);
            } else {
                const unsigned char* bufp = lds + (c & 1) * BUFB; float* yb = (float*)(lds + 2 * BUFB + (c & 1) * 2048);
#pragma unroll 4
                for (int s = 0; s < 32; ++s) {
                    const f32x4 r4 = *(const f32x4*)(bufp + 0 * 8192 + (s * 64 + c4 * 4) * 4);
                    const f32x4 w4 = *(const f32x4*)(bufp + 1 * 8192 + (s * 64 + c4 * 4) * 4);
                    const f32x4 k4 = *(const f32x4*)(bufp + 2 * 8192 + (s * 64 + c4 * 4) * 4);
                    const f32x4 a4 = *(const f32x4*)(bufp + 3 * 8192 + (s * 64 + c4 * 4) * 4);
                    const f32x4 b4 = *(const f32x4*)(bufp + 4 * 8192 + (s * 64 + c4 * 4) * 4);
                    const float vi = *(const float*)(bufp + 5 * 8192 + (s * 16 + i) * 4);
                    float sa = (S0 * a4[0] + S1 * a4[1]) + (S2 * a4[2] + S3 * a4[3]);
                    sa = row16_sum(sa);
                    S0 = S0 * w4[0] + sa * b4[0] + vi * k4[0]; S1 = S1 * w4[1] + sa * b4[1] + vi * k4[1];
                    S2 = S2 * w4[2] + sa * b4[2] + vi * k4[2]; S3 = S3 * w4[3] + sa * b4[3] + vi * k4[3];
                    float yp = (S0 * r4[0] + S1 * r4[1]) + (S2 * r4[2] + S3 * r4[3]);
                    yp = row16_sum(yp);
                    if (c4 == 0) yb[s * 16 + i] = yp;
                }
            }
            __syncthreads();
        }
        if (loader && lt < 128) { const int tt = lt >> 2, i4 = (lt & 3) * 4; const f32x4 y = *(const f32x4*)(lds + 2 * BUFB + ((NCH - 1) & 1) * 2048 + (tt * 16 + i4) * 4);
            *(f32x4*)(Yraw + base + (size_t)((NCH - 1) * 32 + tt) * RW + rg * 16 + i4) = y; }
    }
}
DI void rwkv_fin_phase(const Args& a, int L) {
    const int tidx_ = otid();
    const int wave = __builtin_amdgcn_readfirstlane(tidx_ >> 6), lane = tidx_ & 63;
    const float* Rr = (const float*)(a.ws + OFF_SCR); const float* Kr = Rr + 2 * (size_t)M * RW; const float* Vr = Kr + (size_t)M * RW;
    const float* Yraw = (const float*)(a.ws + OFF_X); const bf16_t* Gb = (const bf16_t*)(a.ws + OFF_MG); bf16_t* Y = (bf16_t*)(a.ws + OFF_Y);
    const float* rk = a.in[I_RK] + L * RW; const float* gng = a.in[I_GNG] + L * RW; const float* gnb = a.in[I_GNB] + L * RW;
    for (int it = blockIdx.x * 8 + wave; it < M * 16; it += gridDim.x * 8) {
        const int m = it >> 4, h = it & 15, c = h * 64 + lane; const size_t o = (size_t)m * RW + c;
        const float y = Yraw[o], r = Rr[o], k = Kr[o], v = Vr[o];
        const float mean = wave_sum(y) * (1.0f / 64.0f); const float d = y - mean; const float var = wave_sum(d * d) * (1.0f / 64.0f);
        const float yn = d * (1.0f / sqrtf(var + 64e-5f)) * gng[c] + gnb[c];
        const float bonus = wave_sum(r * k * rk[c]) * v;
        Y[(size_t)m * D + c] = (bf16_t)f2bf((yn + bonus) * bf2f(Gb[o]));
    }
}
DI void rwkv_par_phase(const Args& a, int L, unsigned char* lds) {
    const int tidx_ = otid();
    const int tid = tidx_, wave = __builtin_amdgcn_readfirstlane(tid >> 6), lane = tid & 63, fr = lane & 15, q = lane >> 4;
    const bf16_t* P = (const bf16_t*)(a.ws + OFF_P); unsigned char* RECB = a.ws + OFF_SCR;
    const bf16_t* W2T = (const bf16_t*)(a.ws + OFF_LW2); const bf16_t* A2T = (const bf16_t*)(a.ws + OFF_LA2); const bf16_t* G2T = (const bf16_t*)(a.ws + OFF_LG2);
    const float* mu = a.in[I_MU] + (size_t)L * 3360; const float* w0 = a.in[I_W0] + L * RW; const float* a0 = a.in[I_A0] + L * RW;
    const float* kkw = a.in[I_KK] + L * RW; const float* kaw = a.in[I_KA] + L * RW; const float* rkw = a.in[I_RK] + L * RW;
    unsigned char* XL = lds;
    unsigned char* WS = lds + 9472 + wave * 12288;
    for (int unit = blockIdx.x; unit < NB * 256; unit += gridDim.x) {
        const int b_ = unit >> 8, cidx = unit & 255; const int m0 = b_ * SEQ + cidx * 16;
        __syncthreads();
        { const int t0 = 2 * wave; const int mrow = m0 + t0; const bool frow = (mrow & (SEQ - 1)) == 0;
          const bf16_t* prow = P + (size_t)mrow * PCOLS + PC_LORA; const bf16_t* pprev = frow ? prow : prow - PCOLS;
          bf16_t xp[5], x0[5], x1[5]; float muv[5];
#pragma unroll
          for (int p = 0; p < 5; ++p) { const int col = lane + 64 * p, colc = col < 288 ? col : 0; xp[p] = pprev[colc]; x0[p] = prow[colc]; x1[p] = prow[PCOLS + colc]; muv[p] = mu[3072 + colc]; }
#pragma unroll
          for (int p = 0; p < 5; ++p) { const int col = lane + 64 * p; const float c0 = bf2f(x0[p]), c1 = bf2f(x1[p]), pv = frow ? 0.f : bf2f(xp[p]);
              float y0 = c0 + (pv - c0) * muv[p], y1 = c1 + (c0 - c1) * muv[p];
              if (p == 0) { y0 = 1.0f - 2.0f * __builtin_amdgcn_rcpf(__expf(2.0f * y0) + 1.0f); y1 = 1.0f - 2.0f * __builtin_amdgcn_rcpf(__expf(2.0f * y1) + 1.0f); }
              else if (p >= 2) { y0 = __builtin_amdgcn_rcpf(1.0f + __expf(-y0)); y1 = __builtin_amdgcn_rcpf(1.0f + __expf(-y1)); }
              if (col < 288) { *(bf16_t*)(XL + t0 * 592 + col * 2) = (bf16_t)f2bf(y0); *(bf16_t*)(XL + (t0 + 1) * 592 + col * 2) = (bf16_t)f2bf(y1); } } }
        __syncthreads();
#define AXF(ks) (*(const bf16x8*)(XL + fr * 592 + (32 * (ks) + 8 * q) * 2))
#pragma unroll 1
        for (int hh2 = 0; hh2 < 2; ++hh2) {
            const int h = wave + 8 * hh2; const int c = h * 64 + lane;
            unsigned char* rec = RECB + (size_t)(cidx * 64 + b_ * 16 + h) * REC;
            const bool first = (m0 & (SEQ - 1)) == 0;
            const bf16_t* pbase = P + (size_t)m0 * PCOLS + h * 64;
            const float w0c = w0[c], a0c = a0[c], kkc = kkw[c], kac = kaw[c], rkc = rkw[c], mur = mu[c], muk = mu[1024 + c], muv = mu[2048 + c];
            bf16x8 bwf[4][2], baf[4][2];
#pragma unroll
            for (int nt = 0; nt < 4; ++nt) { const int cn = h * 64 + 16 * nt + fr;
#pragma unroll
                for (int ks = 0; ks < 2; ++ks) { bwf[nt][ks] = *(const bf16x8*)(W2T + cn * 64 + 32 * ks + 8 * q); baf[nt][ks] = *(const bf16x8*)(A2T + cn * 64 + 32 * ks + 8 * q); } }
            asm volatile("" ::: "memory");
            f32x4 accW[4], accA[4], accG[4];
#pragma unroll
            for (int nt = 0; nt < 4; ++nt) { accW[nt] = (f32x4){0.f, 0.f, 0.f, 0.f}; accA[nt] = accW[nt]; accG[nt] = accW[nt];
#pragma unroll
                for (int ks = 0; ks < 2; ++ks) { accW[nt] = __builtin_amdgcn_mfma_f32_16x16x32_bf16(AXF(ks), bwf[nt][ks], accW[nt], 0, 0, 0); accA[nt] = __builtin_amdgcn_mfma_f32_16x16x32_bf16(AXF(2 + ks), baf[nt][ks], accA[nt], 0, 0, 0); } }
#pragma unroll
            for (int n2 = 0; n2 < 2; ++n2) { bf16x8 bgf[2][5];
#pragma unroll
                for (int nn = 0; nn < 2; ++nn) { const int cn = h * 64 + 16 * (2 * n2 + nn) + fr;
#pragma unroll
                    for (int ks = 0; ks < 5; ++ks) bgf[nn][ks] = *(const bf16x8*)(G2T + cn * 160 + 32 * ks + 8 * q); }
                asm volatile("" ::: "memory");
#pragma unroll
                for (int nn = 0; nn < 2; ++nn)
#pragma unroll
                    for (int ks = 0; ks < 5; ++ks) accG[2 * n2 + nn] = __builtin_amdgcn_mfma_f32_16x16x32_bf16(AXF(4 + ks), bgf[nn][ks], accG[2 * n2 + nn], 0, 0, 0); }
            unsigned rawrk[17], rawvv[9];
#pragma unroll
            for (int t = 0; t < 17; ++t) { const bf16_t* pc = pbase + (ptrdiff_t)(t - 1) * PCOLS; const bool ok = t > 0 || !first;
                const unsigned rr_ = ok ? (unsigned)pc[PC_R + lane] : 0u, kk_ = ok ? (unsigned)pc[PC_K + lane] : 0u, vv_ = ok ? (unsigned)pc[PC_V + lane] : 0u;
                rawrk[t] = rr_ | (kk_ << 16); if (t & 1) rawvv[t >> 1] |= vv_ << 16; else rawvv[t >> 1] = vv_; }
            float* X3 = (float*)WS;
#pragma unroll
            for (int nt = 0; nt < 4; ++nt)
#pragma unroll
                for (int r = 0; r < 4; ++r) { const int o = (4 * q + r) * 64 + 16 * nt + fr; X3[o] = accW[nt][r]; X3[1024 + o] = accA[nt][r]; X3[2048 + o] = accG[nt][r]; }
            float cum[16], asg[16];
            { float run = 0.f;
#pragma unroll
              for (int t = 0; t < 16; ++t) { float dw = X3[t * 64 + lane], da = X3[1024 + t * 64 + lane], dg = X3[2048 + t * 64 + lane];
#if DBG_LORA
                  { const float* w2 = a.in[I_W2] + (size_t)L * 64 * RW; const float* a2 = a.in[I_A2] + (size_t)L * 64 * RW; const float* g2 = a.in[I_G2] + (size_t)L * 160 * RW;
                    float s0 = 0.f, s1 = 0.f, s2 = 0.f;
                    for (int jj = 0; jj < 64; ++jj) { s0 += bf2f(*(const bf16_t*)(XL + t * 592 + jj * 2)) * w2[(size_t)jj * RW + c]; s1 += bf2f(*(const bf16_t*)(XL + t * 592 + (64 + jj) * 2)) * a2[(size_t)jj * RW + c]; }
                    for (int jj = 0; jj < 160; ++jj) s2 += bf2f(*(const bf16_t*)(XL + t * 592 + (128 + jj) * 2)) * g2[(size_t)jj * RW + c];
                    dw = s0; da = s1; dg = s2; }
#endif
                  const float nx = -(w0c + dw);
                  run += -0.60653065971263342f * __builtin_amdgcn_rcpf(1.0f + __expf(nx)); cum[t] = run; asg[t] = __builtin_amdgcn_rcpf(1.0f + __expf(-(a0c + da)));
                  *(bf16_t*)(rec + R_G + (t * 64 + lane) * 2) = (bf16_t)f2bf(dg); } }
            asm volatile("" ::: "memory");
            const float gC = __expf(cum[15]); *(float*)(rec + R_GC + lane * 4) = gC;
            bf16_t* imgA = (bf16_t*)WS; bf16_t* imgR = (bf16_t*)(WS + 2304); bf16_t* imgB = (bf16_t*)(WS + 4608); bf16_t* imgK = (bf16_t*)(WS + 6912);
            float At[16]; unsigned vpk[8]; float bgv[4], kgv[4]; float vprev = 0.f;
            float rr[16], kkv[16], k2v[16], rsn, vp = bflo(rawvv[0]);
            { float sq[16], bo[16]; float rp = bflo(rawrk[0]), kp = bfhi(rawrk[0]);
#pragma unroll
              for (int t = 0; t < 16; ++t) { const float rc = bflo(rawrk[t + 1]), kc = bfhi(rawrk[t + 1]);
                  const float r = rc + (rp - rc) * mur, k = kc + (kp - kc) * muk; rp = rc; kp = kc;
                  const float kk = k * kkc, k2 = k * (1.0f + (asg[t] - 1.0f) * kac);
                  rr[t] = r; kkv[t] = kk; k2v[t] = k2; sq[t] = kk * kk; bo[t] = r * k2 * rkc; }
              const float sqs = rs16(sq, lane), bos = rs16(bo, lane);
              rsn = __builtin_amdgcn_rsqf(fmaxf(sqs, 1e-24f));
              if ((lane & 12) == 0) *(float*)(rec + R_BON + ((lane & 3) + 4 * (lane >> 4)) * 4) = bos; }
            float eprev = 1.0f;
#pragma unroll
            for (int t = 0; t < 16; ++t) {
                const float vc = ((t + 1) & 1) ? bfhi(rawvv[(t + 1) >> 1]) : bflo(rawvv[(t + 1) >> 1]);
                const float r = rr[t], v = vc + (vp - vc) * muv; vp = vc;
                const float asig = asg[t];
                const float kkn = kkv[t] * __int_as_float(__builtin_amdgcn_readlane(__float_as_int(rsn), (t & 3) + 16 * (t >> 2)));
                const float k2 = k2v[t]; const float av = -kkn, bv = kkn * asig;
                const float e2 = __expf(cum[t]), e3 = __expf(-cum[t]), e4 = gC * e3;
                At[t] = eprev * av; eprev = e2;
                const float Rt = e2 * r, Bt = bv * e3, Kt = k2 * e3;
                imgA[t * 72 + lane] = (bf16_t)f2bf(At[t]); imgR[t * 72 + lane] = (bf16_t)f2bf(Rt); imgB[t * 72 + lane] = (bf16_t)f2bf(Bt); imgK[t * 72 + lane] = (bf16_t)f2bf(Kt);
                *(bf16_t*)(rec + R_RL2 + t * RROW + lane * 2) = (bf16_t)f2bf(Rt);
                bgv[t & 3] = bv * e4; kgv[t & 3] = k2 * e4;
                if ((t & 3) == 3) { u32x4 o; o.x = pk2(bgv[0], bgv[1]); o.y = pk2(bgv[2], bgv[3]); o.z = pk2(kgv[0], kgv[1]); o.w = pk2(kgv[2], kgv[3]); *(u32x4*)(rec + R_A2 + (lane * 4 + (t >> 2)) * 16) = o; }
                if (t & 1) vpk[t >> 1] = pk2(vprev, v); else vprev = v; }
            { u32x4 o0, o1; o0.x = vpk[0]; o0.y = vpk[1]; o0.z = vpk[2]; o0.w = vpk[3]; o1.x = vpk[4]; o1.y = vpk[5]; o1.z = vpk[6]; o1.w = vpk[7];
              *(u32x4*)(rec + R_VT + lane * 32) = o0; *(u32x4*)(rec + R_VT + lane * 32 + 16) = o1; }
            asm volatile("" ::: "memory");
            f32x4 gAB = (f32x4){0.f, 0.f, 0.f, 0.f}, gAK = gAB, gBR = gAB, gKR = gAB;
#pragma unroll
            for (int ks = 0; ks < 2; ++ks) { const int off = fr * 72 + 32 * ks + 8 * q;
                const bf16x8 fA = *(const bf16x8*)(imgA + off), fR = *(const bf16x8*)(imgR + off), fB = *(const bf16x8*)(imgB + off), fK = *(const bf16x8*)(imgK + off);
                gAB = __builtin_amdgcn_mfma_f32_16x16x32_bf16(fB, fA, gAB, 0, 0, 0); gAK = __builtin_amdgcn_mfma_f32_16x16x32_bf16(fK, fA, gAK, 0, 0, 0);
                gBR = __builtin_amdgcn_mfma_f32_16x16x32_bf16(fB, fR, gBR, 0, 0, 0); gKR = __builtin_amdgcn_mfma_f32_16x16x32_bf16(fK, fR, gKR, 0, 0, 0); }
#pragma unroll
            for (int r = 0; r < 4; ++r) { const int sI = 4 * q + r; gAB[r] = sI < fr ? gAB[r] : 0.f; gAK[r] = sI < fr ? gAK[r] : 0.f; gBR[r] = sI <= fr ? gBR[r] : 0.f; gKR[r] = sI <= fr ? gKR[r] : 0.f; }
            { u32x4 o; o.x = pk2(gBR[0], gBR[1]); o.y = pk2(gBR[2], gBR[3]); o.z = pk2(gKR[0], gKR[1]); o.w = pk2(gKR[2], gKR[3]); *(u32x4*)(rec + R_A3 + (fr * 4 + q) * 16) = o; }
            asm volatile("" ::: "memory");
            float* AKL = (float*)(WS + 9216);
#pragma unroll
            for (int r = 0; r < 4; ++r) AKL[(4 * q + r) * 16 + fr] = gAK[r];
            float* ABL = (float*)(WS + 11264);
#pragma unroll
            for (int r = 0; r < 4; ++r) ABL[(4 * q + r) * 16 + fr] = gAB[r];
            float Ft[16];
            { const f32x4* row = (const f32x4*)(AKL + (lane & 15) * 16);
#pragma unroll
              for (int t4 = 0; t4 < 4; ++t4) { const f32x4 v4 = row[t4]; Ft[4 * t4] = v4[0]; Ft[4 * t4 + 1] = v4[1]; Ft[4 * t4 + 2] = v4[2]; Ft[4 * t4 + 3] = v4[3]; } }
#pragma unroll
            for (int s2 = 0; s2 < 15; ++s2) {
                const f32x2 src = {At[s2], Ft[s2]};
#pragma unroll
                for (int j = (s2 + 1) >> 2; j < 4; ++j) { const f32x4 sc4 = *(const f32x4*)(ABL + s2 * 16 + 4 * j);
#pragma unroll
                    for (int e = 0; e < 4; ++e) { const int t = 4 * j + e; if (t > s2) { const f32x2 scv = {sc4[e], sc4[e]}; f32x2 dst = {At[t], Ft[t]}; dst = __builtin_elementwise_fma(src, scv, dst); At[t] = dst[0]; Ft[t] = dst[1]; } } } }
#pragma unroll
            for (int t = 0; t < 16; ++t) *(bf16_t*)(rec + R_EL2 + t * RROW + lane * 2) = (bf16_t)f2bf(At[t]);
            asm volatile("" ::: "memory");
            float* FL = (float*)(WS + 10240);
            if (lane < 16) {
#pragma unroll
                for (int t4 = 0; t4 < 4; ++t4) *(f32x4*)(FL + lane * 16 + 4 * t4) = (f32x4){Ft[4 * t4], Ft[4 * t4 + 1], Ft[4 * t4 + 2], Ft[4 * t4 + 3]}; }
            { const float f0 = FL[(4 * q + 0) * 16 + fr], f1 = FL[(4 * q + 1) * 16 + fr], f2 = FL[(4 * q + 2) * 16 + fr], f3 = FL[(4 * q + 3) * 16 + fr];
              u32x2 o; o.x = pk2(f0, f1); o.y = pk2(f2, f3); *(u32x2*)(rec + R_FT + (fr * 4 + q) * 8) = o; }
            asm volatile("" ::: "memory");
        }
    }
#undef AXF
}
DI bf16x8 mk8(u32x2 lo, u32x2 hi) { u32x4 w; w.x = lo.x; w.y = lo.y; w.z = hi.x; w.w = hi.y; return __builtin_bit_cast(bf16x8, w); }
struct SeqOps { u32x2 e[2][2], r[2][2]; u32x4 a2[4]; u32x4 a3; u32x2 ft, vt; f32x4 gc[4]; };
DI void seq_ops_load(SeqOps& f, const LAS unsigned char* rec, int fr, int q, int i0) {
#pragma unroll
    for (int ks = 0; ks < 2; ++ks) { f.e[ks][0] = *(const LAS u32x2*)(rec + R_EL2 + fr * RROW + (32 * ks + 4 * q) * 2); f.e[ks][1] = *(const LAS u32x2*)(rec + R_EL2 + fr * RROW + (32 * ks + 16 + 4 * q) * 2);
        f.r[ks][0] = *(const LAS u32x2*)(rec + R_RL2 + fr * RROW + (32 * ks + 4 * q) * 2); f.r[ks][1] = *(const LAS u32x2*)(rec + R_RL2 + fr * RROW + (32 * ks + 16 + 4 * q) * 2); }
#pragma unroll
    for (int jt = 0; jt < 4; ++jt) { f.a2[jt] = *(const LAS u32x4*)(rec + R_A2 + ((16 * jt + fr) * 4 + q) * 16); f.gc[jt] = *(const LAS f32x4*)(rec + R_GC + (16 * jt + 4 * q) * 4); }
    f.a3 = *(const LAS u32x4*)(rec + R_A3 + (fr * 4 + q) * 16); f.ft = *(const LAS u32x2*)(rec + R_FT + (fr * 4 + q) * 8); f.vt = *(const LAS u32x2*)(rec + R_VT + ((i0 + fr) * 16 + 4 * q) * 2);
}
DI void rwkv_seq_phase(const Args& a, unsigned char* lds, float* yout, const float* gng, const float* gnb, bf16_t* yfin) {
    const int tidx_ = otid();
    const int tid = tidx_, wave = __builtin_amdgcn_readfirstlane(tid >> 6), lane = tid & 63, fr = lane & 15, q = lane >> 4;
    constexpr int NR = 8, DEPTH_ = 6, NCHK = 256;
    LAS unsigned char* ring = (LAS unsigned char*)lds;
    LAS float* ybuf = (LAS float*)(ring + NR * REC);
    for (int bh = blockIdx.x; bh < NB * 16; bh += gridDim.x) {
        const unsigned char* rec0 = a.ws + OFF_SCR + (size_t)bh * REC;
        const int hd = bh & 15;
        asm volatile("s_waitcnt vmcnt(0) lgkmcnt(0)" ::: "memory"); __builtin_amdgcn_s_barrier();
        if (wave >= 4) {
            const int lw = wave - 4;
            const float gg = yfin ? gng[hd * 64 + lane] : 0.f, gb = yfin ? gnb[hd * 64 + lane] : 0.f;
            bf16_t* Yo = yfin + ((size_t)(bh >> 4) * SEQ) * D + hd * 64 + lane;
#define SEQ_ISSUE(cc) do { const unsigned char* g_ = rec0 + (size_t)(cc) * 64 * REC; LAS unsigned char* l_ = ring + ((cc) & (NR - 1)) * REC; \
            _Pragma("unroll") for (int i_ = 0; i_ < 4; ++i_) { int pc_ = i_ * 4 + lw; if (pc_ >= 15) pc_ = lw; \
                __builtin_amdgcn_global_load_lds((const unsigned*)(g_ + pc_ * 1024 + lane * 16), (LAS unsigned*)(l_ + pc_ * 1024), 16, 0, 0); } } while (0)
#define SEQ_FINALIZE(cf) do { const LAS unsigned char* rc_ = ring + ((cf) & (NR - 1)) * REC; const LAS float* yb_ = ybuf + ((cf) & 1) * 1024; \
            const u32x2 vv_ = *(const LAS u32x2*)(rc_ + R_VT + (lane * 16 + 4 * lw) * 2); \
            float y_[4], rd_[8]; \
            _Pragma("unroll") for (int tt_ = 0; tt_ < 4; ++tt_) { y_[tt_] = yb_[(4 * lw + tt_) * 64 + lane]; rd_[tt_] = y_[tt_]; rd_[4 + tt_] = y_[tt_] * y_[tt_]; } \
              \
            float mean4_, rstd4_; \
            { float z_[4], w_[2]; \
              _Pragma("unroll") for (int i_ = 0; i_ < 4; ++i_) { auto p_ = __builtin_amdgcn_permlane32_swap(__float_as_uint(rd_[i_]), __float_as_uint(rd_[i_ + 4]), false, false); z_[i_] = __uint_as_float(p_[0]) + __uint_as_float(p_[1]); } \
              _Pragma("unroll") for (int i_ = 0; i_ < 2; ++i_) { auto p_ = __builtin_amdgcn_permlane16_swap(__float_as_uint(z_[i_]), __float_as_uint(z_[i_ + 2]), false, false); w_[i_] = __uint_as_float(p_[0]) + __uint_as_float(p_[1]); } \
              const bool b0_ = (lane & 1) != 0; float u_ = (b0_ ? w_[1] : w_[0]) + dpp_f<0xB1>(b0_ ? w_[0] : w_[1]); \
              u_ += dpp_f<0x122>(u_); u_ += dpp_f<0x124>(u_); u_ += dpp_f<0x128>(u_);        \
              auto q_ = __builtin_amdgcn_permlane32_swap(__float_as_uint(u_), __float_as_uint(u_), false, false);        \
              mean4_ = __uint_as_float(q_[0]) * (1.0f / 64.0f); rstd4_ = __builtin_amdgcn_rsqf(fmaxf(__uint_as_float(q_[1]) * (1.0f / 64.0f) - mean4_ * mean4_, 0.f) + 64e-5f); } \
            _Pragma("unroll") for (int tt_ = 0; tt_ < 4; ++tt_) { const int t_ = 4 * lw + tt_; \
                const float mean_ = __int_as_float(__builtin_amdgcn_readlane(__float_as_int(mean4_), (tt_ & 1) + 16 * (tt_ >> 1))), rs_ = __int_as_float(__builtin_amdgcn_readlane(__float_as_int(rstd4_), (tt_ & 1) + 16 * (tt_ >> 1))); \
                const float yn_ = (y_[tt_] - mean_) * rs_ * gg + gb; \
                const float bon_ = *(const LAS float*)(rc_ + R_BON + t_ * 4); const float g_ = bf2f(*(const LAS bf16_t*)(rc_ + R_G + (t_ * 64 + lane) * 2)); \
                const unsigned vw_ = (tt_ & 2) ? vv_.y : vv_.x; const float v_ = (tt_ & 1) ? bfhi(vw_) : bflo(vw_); \
                Yo[(size_t)(16 * (cf) + t_) * D] = (bf16_t)f2bf((yn_ + bon_ * v_) * g_); } } while (0)
#pragma unroll 1
            for (int cc = 0; cc < DEPTH_; ++cc) SEQ_ISSUE(cc);
            asm volatile("s_waitcnt vmcnt(16)" ::: "memory");
            __builtin_amdgcn_s_barrier();
#pragma unroll 1
            for (int c = 0; c < NCHK; ++c) {
                if (yfin && c > 0) SEQ_FINALIZE(c - 1);
                if (c + DEPTH_ < NCHK) { SEQ_ISSUE(c + DEPTH_); asm volatile("s_waitcnt vmcnt(16)" ::: "memory"); }
                else asm volatile("s_waitcnt vmcnt(0)" ::: "memory");
                asm volatile("s_waitcnt lgkmcnt(0)" ::: "memory");
                __builtin_amdgcn_s_barrier();
            }
            if (yfin) SEQ_FINALIZE(NCHK - 1);
#undef SEQ_ISSUE
#undef SEQ_FINALIZE
        } else {
            const int i0 = wave * 16;
            float* Yp = yout + (size_t)(bh >> 4) * SEQ * RW + hd * 64 + i0 + fr;
            f32x4 S[4];
#pragma unroll
            for (int jt = 0; jt < 4; ++jt) S[jt] = (f32x4){0.f, 0.f, 0.f, 0.f};
            __builtin_amdgcn_s_barrier();
#define SEQ_STEP(CUR, NXT, CC) do { const int c = (CC); \
                if (c + 1 < NCHK) seq_ops_load(NXT, ring + ((c + 1) & (NR - 1)) * REC, fr, q, i0); \
                bf16x8 sh[2]; \
_Pragma("unroll") \
                for (int ks = 0; ks < 2; ++ks) { u32x4 hw; hw.x = pk2(S[2 * ks][0], S[2 * ks][1]); hw.y = pk2(S[2 * ks][2], S[2 * ks][3]); hw.z = pk2(S[2 * ks + 1][0], S[2 * ks + 1][1]); hw.w = pk2(S[2 * ks + 1][2], S[2 * ks + 1][3]); sh[ks] = __builtin_bit_cast(bf16x8, hw); } \
                const u32x2 z2 = {0u, 0u}; const f32x4 zz = (f32x4){0.f, 0.f, 0.f, 0.f}; \
                f32x4 Wk[2], Yk[2]; \
_Pragma("unroll") \
                for (int ks = 0; ks < 2; ++ks) { Wk[ks] = __builtin_amdgcn_mfma_f32_16x16x32_bf16(mk8(CUR.e[ks][0], CUR.e[ks][1]), sh[ks], zz, 0, 0, 0); Yk[ks] = __builtin_amdgcn_mfma_f32_16x16x32_bf16(mk8(CUR.r[ks][0], CUR.r[ks][1]), sh[ks], zz, 0, 0, 0); } \
                const f32x4 Wv = __builtin_amdgcn_mfma_f32_16x16x32_bf16(mk8(CUR.ft, z2), mk8(CUR.vt, z2), zz, 0, 0, 0); \
                const f32x4 W = (Wk[0] + Wk[1]) + Wv; f32x4 Y = Yk[0] + Yk[1]; \
                u32x2 wp; wp.x = pk2(W[0], W[1]); wp.y = pk2(W[2], W[3]); \
                const bf16x8 b2 = mk8(wp, CUR.vt); \
_Pragma("unroll") \
                for (int jt = 0; jt < 4; ++jt) S[jt] = __builtin_amdgcn_mfma_f32_16x16x32_bf16(__builtin_bit_cast(bf16x8, CUR.a2[jt]), b2, S[jt] * CUR.gc[jt], 0, 0, 0); \
                Y = __builtin_amdgcn_mfma_f32_16x16x32_bf16(__builtin_bit_cast(bf16x8, CUR.a3), b2, Y, 0, 0, 0); \
                if (yfin) { \
_Pragma("unroll") \
                    for (int r = 0; r < 4; ++r) ybuf[(c & 1) * 1024 + (4 * q + r) * 64 + i0 + fr] = Y[r]; \
                } else { \
_Pragma("unroll") \
                    for (int r = 0; r < 4; ++r) Yp[(size_t)(16 * c + 4 * q + r) * RW] = Y[r]; \
                } \
                asm volatile("s_waitcnt lgkmcnt(0)" ::: "memory"); \
                __builtin_amdgcn_s_barrier(); \
            } while (0)
            SeqOps opA, opB; seq_ops_load(opA, ring, fr, q, i0);
#pragma unroll 1
            for (int c2 = 0; c2 < NCHK; c2 += 2) { SEQ_STEP(opA, opB, c2); SEQ_STEP(opB, opA, c2 + 1); }
#undef SEQ_STEP
        }
    }
}
DI void rwkv_fin2_phase(const Args& a, int L) {
    const int tidx_ = otid();
    const int wave = __builtin_amdgcn_readfirstlane(tidx_ >> 6), lane = tidx_ & 63;
    const float* Yraw = (const float*)(a.ws + OFF_X); bf16_t* Y = (bf16_t*)(a.ws + OFF_Y);
    const float* gng = a.in[I_GNG] + L * RW; const float* gnb = a.in[I_GNB] + L * RW;
    for (int u = blockIdx.x * 8 + wave; u < NB * 16 * 256; u += gridDim.x * 8) {
        const int cidx = u & 255, bh = u >> 8, h = bh & 15, b_ = bh >> 4; const int c = h * 64 + lane;
        const unsigned char* rec = a.ws + OFF_SCR + (size_t)(cidx * 64 + bh) * REC;
        const u32x4 v0 = *(const u32x4*)(rec + R_VT + lane * 32), v1 = *(const u32x4*)(rec + R_VT + lane * 32 + 16);
        const unsigned vw[8] = {v0.x, v0.y, v0.z, v0.w, v1.x, v1.y, v1.z, v1.w};
        const float gg = gng[c], gb = gnb[c];
#pragma unroll
        for (int t = 0; t < 16; ++t) { const size_t m = (size_t)b_ * SEQ + cidx * 16 + t;
            const float y = Yraw[m * RW + c];
            const float mean = wave_sum(y) * (1.0f / 64.0f); const float d = y - mean; const float var = wave_sum(d * d) * (1.0f / 64.0f);
            const float yn = d * __builtin_amdgcn_rsqf(var + 64e-5f) * gg + gb;
            const float bon = *(const float*)(rec + R_BON + t * 4); const float g = bf2f(*(const bf16_t*)(rec + R_G + (t * 64 + lane) * 2));
            const float v = (t & 1) ? bfhi(vw[t >> 1]) : bflo(vw[t >> 1]);
            Y[m * D + c] = (bf16_t)f2bf((yn + bon * v) * g); }
    }
}
DI void dbg_compare_phase(const Args& a) {
    const int tidx_ = otid();
    const float* y0 = (const float*)(a.ws + OFF_X); const float* y1 = y0 + (size_t)M * RW; float* acc = (float*)(a.ws + OFF_CTL) + 2048;
    float s0 = 0.f, s1 = 0.f, s2 = 0.f, s3 = 0.f;
    for (size_t i = (size_t)blockIdx.x * 512 + tidx_; i < (size_t)M * RW; i += (size_t)gridDim.x * 512) { const float o = y0[i], d = y1[i] - o; const int tok = (int)((i / RW) & (SEQ - 1));
        s0 += d * d; s1 += o * o; if (tok < 16) { s2 += d * d; s3 += o * o; } }
    s0 = wave_sum(s0); s1 = wave_sum(s1); s2 = wave_sum(s2); s3 = wave_sum(s3);
    if ((tidx_ & 63) == 0) { atomicAdd(acc + 0, s0); atomicAdd(acc + 1, s1); atomicAdd(acc + 2, s2); atomicAdd(acc + 3, s3); }
}
DI void dbg_encode_phase(const Args& a) {
    const int tidx_ = otid();
    float* acc = (float*)(a.ws + OFF_CTL) + 2048;
    const float s0 = __hip_atomic_load(acc + 0, __ATOMIC_RELAXED, __HIP_MEMORY_SCOPE_AGENT), s1 = __hip_atomic_load(acc + 1, __ATOMIC_RELAXED, __HIP_MEMORY_SCOPE_AGENT);
    const float s2 = __hip_atomic_load(acc + 2, __ATOMIC_RELAXED, __HIP_MEMORY_SCOPE_AGENT), s3 = __hip_atomic_load(acc + 3, __ATOMIC_RELAXED, __HIP_MEMORY_SCOPE_AGENT);
    const float e1 = sqrtf(s0 / fmaxf(s1, 1e-30f)), e2 = sqrtf(s2 / fmaxf(s3, 1e-30f));
    for (size_t i = (size_t)blockIdx.x * 512 + tidx_; i < (size_t)M * D; i += (size_t)gridDim.x * 512) { float v = a.out[i] * (1.0f + e1); if (i == 0) v += 1000.0f * e2; a.out[i] = v; }
}
DI unsigned f2ord(float f) { const unsigned u = __builtin_bit_cast(unsigned, f); return u ^ ((unsigned)((int)u >> 31) | 0x80000000u); }
DI float xrow16_sum(float x) {
    auto p = __builtin_amdgcn_permlane16_swap(__float_as_uint(x), __float_as_uint(x), false, false);
    x = __uint_as_float(p[0]) + __uint_as_float(p[1]);
    auto q = __builtin_amdgcn_permlane32_swap(__float_as_uint(x), __float_as_uint(x), false, false);
    return __uint_as_float(q[0]) + __uint_as_float(q[1]);
}
template <int CTRL> DI int dpp_i(int x) { return __builtin_amdgcn_update_dpp(0, x, CTRL, 0xF, 0xF, true); }
DI int wave_sum_i(int x) {
    x += dpp_i<0xB1>(x); x += dpp_i<0x4E>(x); x += dpp_i<0x141>(x); x += dpp_i<0x140>(x);
    auto p = __builtin_amdgcn_permlane16_swap((unsigned)x, (unsigned)x, false, false); x = (int)p[0] + (int)p[1];
    auto q = __builtin_amdgcn_permlane32_swap((unsigned)x, (unsigned)x, false, false); return (int)q[0] + (int)q[1];
}
DI unsigned wave_max_u(unsigned x) {
    x = max(x, (unsigned)dpp_i<0xB1>((int)x)); x = max(x, (unsigned)dpp_i<0x4E>((int)x)); x = max(x, (unsigned)dpp_i<0x141>((int)x)); x = max(x, (unsigned)dpp_i<0x140>((int)x));
    auto p = __builtin_amdgcn_permlane16_swap(x, x, false, false); x = max(p[0], p[1]);
    auto q = __builtin_amdgcn_permlane32_swap(x, x, false, false); return max(q[0], q[1]);
}
DI void indexer_phase(const Args& a, unsigned char* lds, WorkQ& wq, int& item) {
    const int tidx_ = otid();
    const int tid = tidx_, wave = __builtin_amdgcn_readfirstlane(tid >> 6), lane = tid & 63, hh = lane & 15, kq = lane >> 4;
    const bf16_t* P = (const bf16_t*)(a.ws + OFF_P); const bf16_t* KI = (const bf16_t*)(a.ws + OFF_KI); unsigned long long* BMk = (unsigned long long*)(a.ws + OFF_BM);
    constexpr int STG = 256 * 128;
    unsigned long long* wbuf = (unsigned long long*)(lds + 2 * STG + wave * 512);
    const int srow = tid >> 3, sch = tid & 7;
    const int wr_off = srow * 128 + ((sch ^ (srow & 7)) << 4);
    const int rd0 = hh * 128 + ((kq ^ (hh & 7)) << 4), rd1 = hh * 128 + (((kq + 4) ^ (hh & 7)) << 4);
#pragma unroll 1
    for (; item < NB * 512; item = wq_next(wq, item, lds, tid)) {
        const int b_ = item & 3, qg = 511 - (item >> 2);
        const int t0 = qg * 8, t = t0 + wave, nk = t0 + 8; const size_t m = (size_t)b_ * SEQ + t;
        const int nst = (nk + 255) >> 8;
        bf16x8 aq[2];
        aq[0] = *(const bf16x8*)(P + m * PCOLS + PC_QI + hh * 64 + 8 * kq); aq[1] = *(const bf16x8*)(P + m * PCOLS + PC_QI + hh * 64 + 32 + 8 * kq);
        float blo[4], bhi[4];
#pragma unroll
        for (int r = 0; r < 4; ++r) { const bool pos = bf2f(P[m * PCOLS + PC_WI + 4 * kq + r]) >= 0.f; blo[r] = pos ? 0.f : -__builtin_inff(); bhi[r] = pos ? __builtin_inff() : 0.f; }
        { const float wrow = bf2f(P[m * PCOLS + PC_WI + hh]) * 0.03125f;
#pragma unroll
          for (int ks = 0; ks < 2; ++ks) { const u32x4 w4 = __builtin_bit_cast(u32x4, aq[ks]); u32x4 o4;
              o4.x = pk2(bflo(w4.x) * wrow, bfhi(w4.x) * wrow); o4.y = pk2(bflo(w4.y) * wrow, bfhi(w4.y) * wrow); o4.z = pk2(bflo(w4.z) * wrow, bfhi(w4.z) * wrow); o4.w = pk2(bflo(w4.w) * wrow, bfhi(w4.w) * wrow);
              aq[ks] = __builtin_bit_cast(bf16x8, o4); } }
        unsigned sc[64];
        const bf16_t* kig = KI + ((size_t)b_ * SEQ + srow) * 64 + sch * 8;
#pragma unroll 1
        for (int rep21 = 0; rep21 < ((REP_MASK >> 21) & 1u) + 1; ++rep21) {
#pragma unroll
        for (int r = 0; r < 64; ++r) sc[r] = 0u;
        u32x4 kp[4];
#pragma unroll
        for (int q = 0; q < 4; ++q) kp[q] = *(const u32x4*)(kig + (size_t)q * 64 * 64);
        __syncthreads();
        asm volatile("" :: "v"(aq[0]), "v"(aq[1]), "v"(blo[0]), "v"(blo[1]), "v"(blo[2]), "v"(blo[3]));
#pragma unroll
        for (int st = 0; st < 16; ++st) if (st < nst) {
            const int k0 = st * 256;
            unsigned char* sb = lds + (st & 1) * STG;
#pragma unroll
            for (int q = 0; q < 4; ++q) *(u32x4*)(sb + q * 64 * 128 + wr_off) = kp[q];
            __syncthreads();
            if (st + 1 < nst) {
#pragma unroll
                for (int q = 0; q < 4; ++q) kp[q] = *(const u32x4*)(kig + (size_t)(k0 + 256 + q * 64) * 64);
            }
            bf16x8 kf[2][4][2];
#pragma unroll
            for (int sub = 0; sub < 4; ++sub) { const unsigned char* kb = sb + (sub * 16) * 128; kf[0][sub][0] = *(const bf16x8*)(kb + rd0); kf[0][sub][1] = *(const bf16x8*)(kb + rd1); }
#pragma unroll
            for (int cc = 0; cc < 4; ++cc) {
                const int kc = k0 + cc * 64;
                unsigned res = 0u;
                {
                    float sv[4]; f32x4 acc4[4];
#pragma unroll
                    for (int sub = 0; sub < 4; ++sub) { const f32x4 z4 = (f32x4){0.f, 0.f, 0.f, 0.f};
                        acc4[sub] = __builtin_amdgcn_mfma_f32_16x16x32_bf16(aq[0], kf[cc & 1][sub][0], z4, 0, 0, 0);
                        acc4[sub] = __builtin_amdgcn_mfma_f32_16x16x32_bf16(aq[1], kf[cc & 1][sub][1], acc4[sub], 0, 0, 0); }
                    if (cc < 3) {
#pragma unroll
                        for (int sub = 0; sub < 4; ++sub) { const unsigned char* kb = sb + ((cc + 1) * 64 + sub * 16) * 128; kf[(cc + 1) & 1][sub][0] = *(const bf16x8*)(kb + rd0); kf[(cc + 1) & 1][sub][1] = *(const bf16x8*)(kb + rd1); } }
                    __builtin_amdgcn_sched_barrier(0);
#pragma unroll
                    for (int sub = 0; sub < 4; ++sub) { const f32x4 acc = acc4[sub];
                        sv[sub] = (__builtin_amdgcn_fmed3f(acc[0], blo[0], bhi[0]) + __builtin_amdgcn_fmed3f(acc[1], blo[1], bhi[1])) + (__builtin_amdgcn_fmed3f(acc[2], blo[2], bhi[2]) + __builtin_amdgcn_fmed3f(acc[3], blo[3], bhi[3]));
                    }
                    auto p01 = __builtin_amdgcn_permlane16_swap(__float_as_uint(sv[0]), __float_as_uint(sv[1]), false, false);
                    auto p23 = __builtin_amdgcn_permlane16_swap(__float_as_uint(sv[2]), __float_as_uint(sv[3]), false, false);
                    const float x01 = __uint_as_float(p01[0]) + __uint_as_float(p01[1]), x23 = __uint_as_float(p23[0]) + __uint_as_float(p23[1]);
                    auto pf = __builtin_amdgcn_permlane32_swap(__float_as_uint(x01), __float_as_uint(x23), false, false);
                    const float tot = __uint_as_float(pf[0]) + __uint_as_float(pf[1]);
                    res = f2ord(tot); if (st + 1 == nst) res = (kc + lane <= t) ? res : 0u;
                }
                sc[4 * st + cc] = res;
            }
        }
        }
        const int nuse = 4 * nst;
#pragma unroll 1
        for (int rep22 = 0; rep22 < ((REP_MASK >> 22) & 1u) + 1; ++rep22) {
        if (t + 1 > 256) {
            unsigned T = 0u; bool exact = false;
            unsigned kmax = 0u;
#pragma unroll
            for (int r8 = 0; r8 < 8; ++r8) if (r8 * 8 < nuse) {
#pragma unroll
                for (int r = 0; r < 8; ++r) kmax = max(kmax, sc[r8 * 8 + r]); }
            kmax = (unsigned)__builtin_amdgcn_readfirstlane((int)wave_max_u(kmax));
#pragma unroll 1
            for (int bit = 31; bit >= 0; --bit) { const unsigned cand = T | (1u << bit); if (cand > kmax) continue; int cnt = 0; unsigned candv = cand; asm volatile("" : "+v"(candv));
#pragma unroll
                for (int r8 = 0; r8 < 8; ++r8) if (r8 * 8 < nuse) {
                    unsigned long long mk_[8];
                    asm("v_cmp_ge_u32_e64 %0, %8, %16\n\tv_cmp_ge_u32_e64 %1, %9, %16\n\tv_cmp_ge_u32_e64 %2, %10, %16\n\tv_cmp_ge_u32_e64 %3, %11, %16\n\tv_cmp_ge_u32_e64 %4, %12, %16\n\tv_cmp_ge_u32_e64 %5, %13, %16\n\tv_cmp_ge_u32_e64 %6, %14, %16\n\tv_cmp_ge_u32_e64 %7, %15, %16"
                        : "=&s"(mk_[0]), "=&s"(mk_[1]), "=&s"(mk_[2]), "=&s"(mk_[3]), "=&s"(mk_[4]), "=&s"(mk_[5]), "=&s"(mk_[6]), "=&s"(mk_[7])
                        : "v"(sc[r8 * 8 + 0]), "v"(sc[r8 * 8 + 1]), "v"(sc[r8 * 8 + 2]), "v"(sc[r8 * 8 + 3]), "v"(sc[r8 * 8 + 4]), "v"(sc[r8 * 8 + 5]), "v"(sc[r8 * 8 + 6]), "v"(sc[r8 * 8 + 7]), "v"(candv));
#pragma unroll
                    for (int r = 0; r < 8; ++r) cnt += __builtin_popcountll(mk_[r]); }
                if (cnt >= 256) T = cand;
                if (cnt == 256) { exact = true; break; } }
            int cge = 256;
            if (!exact) { cge = 0;
#pragma unroll
                for (int r8 = 0; r8 < 8; ++r8) if (r8 * 8 < nuse) {
#pragma unroll
                    for (int r = 0; r < 8; ++r) cge += __builtin_popcountll(__ballot(sc[r8 * 8 + r] >= T)); } }
            { unsigned long long z64 = 0ull; asm volatile("" : "+v"(z64)); wbuf[lane] = z64; }
            if (cge == 256) {
                unsigned wlo = 0u, whi = 0u;
#pragma unroll
                for (int r8 = 0; r8 < 8; ++r8) if (r8 * 8 < nuse) {
#pragma unroll
                    for (int r = 0; r < 8; ++r) { const unsigned long long word = __ballot(sc[r8 * 8 + r] >= T); const unsigned lo_ = (unsigned)word, hi_ = (unsigned)(word >> 32);
                        asm("s_nop 1\n\tv_writelane_b32 %0, %2, %4\n\tv_writelane_b32 %1, %3, %4" : "+v"(wlo), "+v"(whi) : "s"(lo_), "s"(hi_), "n"(r8 * 8 + r)); } }
                wbuf[lane] = ((unsigned long long)whi << 32) | wlo;
            } else {
                int cgt = 0;
#pragma unroll
                for (int r8 = 0; r8 < 8; ++r8) {
#pragma unroll
                    for (int r = 0; r < 8; ++r) cgt += __builtin_popcountll(__ballot(sc[r8 * 8 + r] > T));
                    __builtin_amdgcn_sched_barrier(0); }
                int need = 256 - cgt;
#pragma unroll
                for (int r8 = 0; r8 < 8; ++r8) {
#pragma unroll
                    for (int r = 0; r < 8; ++r) { const unsigned long long gt = __ballot(sc[r8 * 8 + r] > T); unsigned long long eq = __ballot(sc[r8 * 8 + r] == T); const int ce = __builtin_popcountll(eq);
                        unsigned long long take;
                        if (ce <= need) { take = eq; need -= ce; }
                        else { take = 0ull; for (; need > 0; --need) { const unsigned long long low = eq & (0ull - eq); take |= low; eq ^= low; } }
                        const unsigned long long word = gt | take; if (lane == 0 && r8 * 8 + r < nuse) wbuf[r8 * 8 + r] = word; }
                    __builtin_amdgcn_sched_barrier(0); }
            }
        } else {
            { unsigned long long z64 = 0ull; asm volatile("" : "+v"(z64)); wbuf[lane] = z64; }
#pragma unroll
            for (int r8 = 0; r8 < 8; ++r8) {
#pragma unroll
                for (int r = 0; r < 8; ++r) { const unsigned long long word = __ballot(sc[r8 * 8 + r] != 0u); if (lane == 0 && r8 * 8 + r < nuse) wbuf[r8 * 8 + r] = word; }
                __builtin_amdgcn_sched_barrier(0); }
        }
        }
        BMk[m * 64 + lane] = wbuf[lane];
    }
}
DI void attn_phase(const Args& a, unsigned char* lds) {
    const int tidx_ = otid();
    const int tid = tidx_, wave = __builtin_amdgcn_readfirstlane(tid >> 6), lane = tid & 63, ql = lane & 31, hf = lane >> 5;
    const bf16_t* P = (const bf16_t*)(a.ws + OFF_P); const bf16_t* VT = (const bf16_t*)(a.ws + OFF_VT); const unsigned long long* BMk = (const unsigned long long*)(a.ws + OFF_BM);
    const float* biasd = (const float*)(a.ws + OFF_BIAS); bf16_t* Y = (bf16_t*)(a.ws + OFF_Y);
    unsigned char* Kl = lds; unsigned char* Vl = lds + 64 * 144; float* biasl = (float*)(lds + 2 * 64 * 144);
    const float NEG_INF = -__builtin_inff();
    for (int cu = blockIdx.x; cu < 256; cu += gridDim.x)
#pragma unroll 1
    for (int ui = 0; ui < 2; ++ui) {
        const int bh = cu >> 3, s8 = cu & 7, qb = ui == 0 ? s8 : 15 - s8, b_ = bh >> 3, h = bh & 7;
        const int q0w = qb * 256 + 32 * wave, q = q0w + ql; const size_t m = (size_t)b_ * SEQ + q;
        __syncthreads();
        if (tid < 128) biasl[tid] = biasd[h * 128 + tid];
        bf16x8 qf[4];
#pragma unroll
        for (int ks = 0; ks < 4; ++ks) qf[ks] = *(const bf16x8*)(P + m * PCOLS + PC_AQ + h * 64 + 16 * ks + 8 * hf);
        f32x16 O0, O1;
#pragma unroll
        for (int r = 0; r < 16; ++r) { O0[r] = 0.f; O1[r] = 0.f; }
        float mrun = NEG_INF, lrun = 0.f;
        const int nkt = 4 * (qb + 1);
        const int srow = tid >> 3, sch = tid & 7;
        const bf16_t* kbase = P + ((size_t)b_ * SEQ + srow) * PCOLS + PC_AK + h * 64 + sch * 8;
        const bf16_t* vbase = VT + ((size_t)(b_ * 8 + h) * 64 + srow) * SEQ + sch * 8;
#define ATT_COMPUTE \
            const int k0 = kt * 64; \
            if (k0 <= q0w + 31) { \
 \
                f32x16 sa[2]; \
                const f32x16 zero16 = {0.f, 0.f, 0.f, 0.f, 0.f, 0.f, 0.f, 0.f, 0.f, 0.f, 0.f, 0.f, 0.f, 0.f, 0.f, 0.f};        \
_Pragma("unroll") \
                for (int ks = 0; ks < 4; ++ks) \
_Pragma("unroll") \
                    for (int sub = 0; sub < 2; ++sub) { const bf16x8 kf = *(const bf16x8*)(Kl + (32 * sub + ql) * 144 + (16 * ks + 8 * hf) * 2); \
                        sa[sub] = __builtin_amdgcn_mfma_f32_32x32x16_bf16(kf, qf[ks], ks == 0 ? zero16 : sa[sub], 0, 0, 0); } \
                constexpr float C1 = 0.125f * 1.4426950408889634f; \
                  \
                const float b31f = biasl[127] * 1.4426950408889634f; \
                const bool far = (q0w - (k0 + 63)) >= 113; \
                float mx = NEG_INF;        \
                if (far) { \
_Pragma("unroll") \
                    for (int sub = 0; sub < 2; ++sub) \
_Pragma("unroll") \
                        for (int r = 0; r < 16; r += 2) mx = fmaxf(mx, fmaxf(sa[sub][r], sa[sub][r + 1])); \
                    mx = mx * C1 + b31f; \
                } else { \
_Pragma("unroll") \
                    for (int sub = 0; sub < 2; ++sub) { \
_Pragma("unroll") \
                        for (int r = 0; r < 16; ++r) { const int ro = (r & 3) + 8 * (r >> 2); int dd = q - (k0 + 32 * sub + ro + 4 * hf); dd = dd < 0 ? 0 : (dd > 127 ? 127 : dd); \
                            sa[sub][r] = sa[sub][r] * C1 + biasl[dd] * 1.4426950408889634f; } \
_Pragma("unroll") \
                        for (int r = 0; r < 16; r += 2) mx = fmaxf(mx, fmaxf(sa[sub][r], sa[sub][r + 1])); \
                    } \
                } \
                { auto pm = __builtin_amdgcn_permlane32_swap(__float_as_uint(mx), __float_as_uint(mx), false, false); mx = fmaxf(__uint_as_float(pm[0]), __uint_as_float(pm[1])); } \
                const float mnew = fmaxf(mrun, mx); const float msafe = mnew; \
                float lsum = 0.f; \
                const float cb = b31f - msafe; \
                if (far) { \
_Pragma("unroll") \
                    for (int sub = 0; sub < 2; ++sub) \
_Pragma("unroll") \
                        for (int r = 0; r < 16; ++r) sa[sub][r] = sa[sub][r] * C1 + cb; \
                } else { \
_Pragma("unroll") \
                    for (int sub = 0; sub < 2; ++sub) \
_Pragma("unroll") \
                        for (int r = 0; r < 16; ++r) sa[sub][r] -= msafe; \
                } \
_Pragma("unroll") \
                for (int sub = 0; sub < 2; ++sub) { \
                    const int w32 = (int)(((unsigned)(bm >> (32 * sub))) >> (4 * hf)); \
_Pragma("unroll") \
                    for (int r = 0; r < 16; ++r) { const int ro = (r & 3) + 8 * (r >> 2); unsigned tm = (unsigned)__builtin_amdgcn_sbfe(w32, ro, 1); asm volatile("" : "+v"(tm));        \
                        sa[sub][r] = __uint_as_float(__float_as_uint(__builtin_amdgcn_exp2f(sa[sub][r])) & tm); lsum += sa[sub][r]; } } \
                if (__builtin_amdgcn_ballot_w64(mnew > mrun) != 0ull) { \
                    const float alpha = __builtin_amdgcn_exp2f(mrun - msafe); \
                    lrun = lrun * alpha + lsum; mrun = mnew; \
_Pragma("unroll") \
                    for (int r = 0; r < 16; ++r) { O0[r] *= alpha; O1[r] *= alpha; } \
                } else lrun += lsum; \
_Pragma("unroll") \
                for (int sub = 0; sub < 2; ++sub) \
_Pragma("unroll") \
                    for (int s = 0; s < 2; ++s) { \
                        u32x4 pw; pw.x = pk2(sa[sub][8 * s + 0], sa[sub][8 * s + 1]); pw.y = pk2(sa[sub][8 * s + 2], sa[sub][8 * s + 3]); pw.z = pk2(sa[sub][8 * s + 4], sa[sub][8 * s + 5]); pw.w = pk2(sa[sub][8 * s + 6], sa[sub][8 * s + 7]); \
                        const bf16x8 pf = __builtin_bit_cast(bf16x8, pw); \
                        const int kcol = (32 * sub + 16 * s + 4 * hf) * 2; \
                        { const u32x2 lo = *(const u32x2*)(Vl + ql * 144 + kcol), hi = *(const u32x2*)(Vl + ql * 144 + kcol + 16); \
                          u32x4 vw; vw.x = lo.x; vw.y = lo.y; vw.z = hi.x; vw.w = hi.y; \
                          O0 = __builtin_amdgcn_mfma_f32_32x32x16_bf16(__builtin_bit_cast(bf16x8, vw), pf, O0, 0, 0, 0); } \
                        { const u32x2 lo = *(const u32x2*)(Vl + (32 + ql) * 144 + kcol), hi = *(const u32x2*)(Vl + (32 + ql) * 144 + kcol + 16); \
                          u32x4 vw; vw.x = lo.x; vw.y = lo.y; vw.z = hi.x; vw.w = hi.y; \
                          O1 = __builtin_amdgcn_mfma_f32_32x32x16_bf16(__builtin_bit_cast(bf16x8, vw), pf, O1, 0, 0, 0); } \
                    } \
            } \

        u32x4 kregA = *(const u32x4*)(kbase), vregA = *(const u32x4*)(vbase); unsigned long long bmA = BMk[m * 64];
        u32x4 kregB = *(const u32x4*)(kbase + (size_t)64 * PCOLS), vregB = *(const u32x4*)(vbase + 64); unsigned long long bmB = BMk[m * 64 + 1];
        asm volatile("" :: "v"(qf[0]), "v"(qf[1]), "v"(qf[2]), "v"(qf[3]));
#define ATT_TILE(KREG, VREG, BMR, KT) do { const int kt = (KT); \
            __syncthreads(); \
            *(u32x4*)(Kl + srow * 144 + sch * 16) = KREG; *(u32x4*)(Vl + srow * 144 + sch * 16) = VREG; \
            __syncthreads(); \
            const unsigned long long bm = BMR; \
            if (kt + 2 < nkt) { KREG = *(const u32x4*)(kbase + (size_t)(kt + 2) * 64 * PCOLS); VREG = *(const u32x4*)(vbase + (kt + 2) * 64); BMR = BMk[m * 64 + kt + 2]; } \
            ATT_COMPUTE } while (0)
#pragma unroll 1
        for (int kt2 = 0; kt2 < nkt; kt2 += 2) { ATT_TILE(kregA, vregA, bmA, kt2); ATT_TILE(kregB, vregB, bmB, kt2 + 1); }
#undef ATT_TILE
#undef ATT_COMPUTE
        float ltot; { auto pl = __builtin_amdgcn_permlane32_swap(__float_as_uint(lrun), __float_as_uint(lrun), false, false); ltot = __uint_as_float(pl[0]) + __uint_as_float(pl[1]); } const float inv = 1.0f / ltot;
        bf16_t* yo = Y + m * D + 1536 + h * 64;
#pragma unroll
        for (int g4 = 0; g4 < 4; ++g4) { const int d0 = 8 * g4 + 4 * hf;
            u32x2 o0; o0.x = pk2(O0[4 * g4 + 0] * inv, O0[4 * g4 + 1] * inv); o0.y = pk2(O0[4 * g4 + 2] * inv, O0[4 * g4 + 3] * inv); *(u32x2*)(yo + d0) = o0;
            u32x2 o1; o1.x = pk2(O1[4 * g4 + 0] * inv, O1[4 * g4 + 1] * inv); o1.y = pk2(O1[4 * g4 + 2] * inv, O1[4 * g4 + 3] * inv); *(u32x2*)(yo + 32 + d0) = o1; }
    }
}

constexpr int NPH = 16;
constexpr int NGP = 1 + DEPTH * NPH;
__global__ void __launch_bounds__(512, 2) fwd(Args args) {
    extern __shared__ __attribute__((aligned(16))) unsigned char lds[];
    const int tid = threadIdx.x;
    volatile LAS unsigned* MISC = (volatile LAS unsigned*)((LAS unsigned char*)lds + MISC_OFF);
    for (int u = tid; u < (LDS_BYTES - 131072) / 4; u += 512) ((LAS unsigned*)((LAS unsigned char*)lds + 131072))[u] = 0u;
    __syncthreads();
    unsigned char* ws = args.ws;
    XcdBarrier bar; bar.bar = (unsigned*)(ws + OFF_CTL) + 4096; bar.x = 0; bar.st = nullptr;
    if (!MK_PER_PHASE) bar = xcd_barrier_post((unsigned*)(ws + OFF_CTL) + 4096, MISC + 8);
    const int lo = args.lo, hi = args.hi;
    LAS unsigned char* ldsl = (LAS unsigned char*)lds;
    bf16_t* XB = (bf16_t*)(ws + OFF_XB); float* X = (float*)(ws + OFF_X); float* T = (float*)(ws + OFF_T); float* ST = (float*)(ws + OFF_ST); bf16_t* Pb = (bf16_t*)(ws + OFF_P);
    bf16_t* H = (bf16_t*)(ws + OFF_SCR); bf16_t* Yb = (bf16_t*)(ws + OFF_Y); bf16_t* MG = (bf16_t*)(ws + OFF_MG);
    int gp = 0;
#define RUN() (lo <= gp && gp < hi)
#define SEAM() do { if (RUN() && gp + 1 < hi) xcd_barrier(bar); ++gp; } while (0)
#define PHASE(k, ...) do { if (PHON(k) && RUN()) { __VA_ARGS__; if ((REP_MASK >> (k)) & 1u) { xcd_barrier(bar); __VA_ARGS__; } } SEAM(); } while (0)
    if (RUN()) init_phase(args);
    SEAM();
    int p7n = 0;
#pragma unroll 1
    for (int L = 0; L < DEPTH; ++L) {
        const size_t walt = (L & 1) ? ALT_SHIFT : 0;
        if (L == 0 || !HETERO) PHASE(0, convert_phase(args, L, lds, blockIdx.x, gridDim.x);); else ++gp;
        PHASE(1, { pg8::Gemm g{XB, (const bf16_t*)(ws + OFF_W1A), D, D}; pg8::StaticOrder S; S.init(M, 2 * FF, D, gridDim.x, blockIdx.x); pg8::EpiSwiglu E{H, FF}; pg8::gemm_phase(ldsl, g, S, E); });
        PHASE(2, { pg8::Gemm g{H, (const bf16_t*)(ws + OFF_W1B), FF, FF}; pg8::StaticOrder S; S.init(M, D, FF, gridDim.x, blockIdx.x); pg8::EpiRes E{args.in[I_X], L == 0 ? nullptr : ST, args.in[I_LN3G] + (L > 0 ? (L - 1) * D : 0), args.in[I_LN3B] + (L > 0 ? (L - 1) * D : 0), T, D, ALPHA, 0.5f}; pg8::gemm_phase(ldsl, g, S, E); });
        PHASE(3, ln_phase(T, args.in[I_LN1G] + L * D, args.in[I_LN1B] + L * D, ST, XB, nullptr););
        PHASE(4, { pg8::Gemm g{XB, (const bf16_t*)(ws + OFF_WIN), D, D}; pg8::StaticOrder S; S.init(M, NP, D, gridDim.x, blockIdx.x); pg8::EpiBf16 E{Pb, PCOLS, (bf16_t*)(ws + OFF_GATES)}; pg8::gemm_phase(ldsl, g, S, E); });
        PHASE(5, { kidx_vt_phase(args, L, lds); if (REP_MASK & (1u << 23)) kidx_vt_phase(args, L, lds); if (RWKV_CHUNKED && !DBG_RWKV) { rwkv_par_phase(args, L, lds); if (REP_MASK & (1u << 24)) rwkv_par_phase(args, L, lds); } else rwkv_prep_phase(args, L, lds); });
        if (!HETERO) PHASE(6, { WorkQ wq{nullptr, 0, 0, (int)gridDim.x}; int item = blockIdx.x; sgu_phase(args, L, lds, wq, item, 0); }); else ++gp;
        PHASE(7, { if (DBG_RWKV) { scan_phase(args, lds); xcd_barrier(bar); rwkv_par_phase(args, L, lds); xcd_barrier(bar); rwkv_seq_phase(args, lds, X + (size_t)M * RW, nullptr, nullptr, nullptr); xcd_barrier(bar); dbg_compare_phase(args); }
                   else if (HETERO) {
                       if ((int)blockIdx.x < 64) { rwkv_seq_phase(args, lds, X, args.in[I_GNG] + L * RW, args.in[I_GNB] + L * RW, Yb); if (REP_MASK & (1u << 20)) rwkv_seq_phase(args, lds, X, args.in[I_GNG] + L * RW, args.in[I_GNB] + L * RW, Yb); }
                       else if ((int)blockIdx.x < 64 + NCVT && L + 1 < DEPTH) { convert_phase(args, L + 1, lds, blockIdx.x - 64, NCVT); __syncthreads(); }
                       WorkQ wq{(unsigned*)(ws + OFF_CTL + 524288) + (p7n++) * 64, 0, 0, 0}; int item = wq_first(wq, lds, otid());
                       indexer_phase(args, lds, wq, item); sgu_phase(args, L, lds, wq, item, NB * 512); }
                   else if (RWKV_CHUNKED) rwkv_seq_phase(args, lds, X, nullptr, nullptr, nullptr); else scan_phase(args, lds); });
        if (!HETERO) PHASE(8, { WorkQ wq{nullptr, 0, 0, (int)gridDim.x}; int item = blockIdx.x; indexer_phase(args, lds, wq, item); if (RWKV_CHUNKED) rwkv_fin2_phase(args, L); else rwkv_fin_phase(args, L); }); else ++gp;
        PHASE(9, { attn_phase(args, lds); });
        PHASE(10, { pg8::Gemm g{Yb, (const bf16_t*)(ws + OFF_WBR + walt), D, D}; pg8::BranchOrder S; S.init(M, D, D, gridDim.x, blockIdx.x); pg8::EpiBranch E{(const bf16_t*)(ws + OFF_GATES), args.in[I_BGATE] + (size_t)L * 3 * D, MG}; pg8::gemm_phase(ldsl, g, S, E); });
        PHASE(11, { pg8::Gemm g{MG, (const bf16_t*)(ws + OFF_WO + walt), D, D}; pg8::StaticOrder S; S.init(M, D, D, gridDim.x, blockIdx.x); pg8::EpiRes E{nullptr, ST, args.in[I_LN1G] + L * D, args.in[I_LN1B] + L * D, T, D, ALPHA, 1.0f}; pg8::gemm_phase(ldsl, g, S, E); });
        PHASE(12, ln_phase(T, args.in[I_LN2G] + L * D, args.in[I_LN2B] + L * D, ST, XB, nullptr););
        PHASE(13, { pg8::Gemm g{XB, (const bf16_t*)(ws + OFF_W2A + walt), D, D}; pg8::StaticOrder S; S.init(M, 2 * FF, D, gridDim.x, blockIdx.x); pg8::EpiSwiglu E{H, FF}; pg8::gemm_phase(ldsl, g, S, E); });
        PHASE(14, { pg8::Gemm g{H, (const bf16_t*)(ws + OFF_W2B + walt), FF, FF}; pg8::StaticOrder S; S.init(M, D, FF, gridDim.x, blockIdx.x); pg8::EpiRes E{nullptr, ST, args.in[I_LN2G] + L * D, args.in[I_LN2B] + L * D, T, D, ALPHA, 0.5f}; pg8::gemm_phase(ldsl, g, S, E); });
        PHASE(15, ln_phase(T, args.in[I_LN3G] + L * D, args.in[I_LN3B] + L * D, ST, L == DEPTH - 1 ? nullptr : XB, L == DEPTH - 1 ? args.out : nullptr););
        if (REP_MASK & (1u << 25)) { for (int xb = 0; xb < 10; ++xb) xcd_barrier(bar); }
    }
    if (DBG_RWKV) { xcd_barrier(bar); dbg_encode_phase(args); }
#undef RUN
#undef SEAM
#undef PHASE
}

extern "C" void kernel_launch(void* const* d_in, const int* in_sizes, int n_in, void* d_out, int out_size, void* d_ws, size_t ws_size, hipStream_t stream) {
    static int grid = 0;
    if (grid == 0) {
        if (n_in != 33 || out_size != M * D || ws_size < WS_END) { fprintf(stderr, "kernel_launch: unexpected shapes (n_in %d out %d ws %zu, need %zu)\n", n_in, out_size, ws_size, (size_t)WS_END); grid = -1; return; }
        int dev = 0, cus = 0;
        if (hipGetDevice(&dev) != hipSuccess || hipDeviceGetAttribute(&cus, hipDeviceAttributeMultiprocessorCount, dev) != hipSuccess) { grid = -1; return; }
        if (hipFuncSetAttribute((const void*)fwd, hipFuncAttributeMaxDynamicSharedMemorySize, LDS_BYTES) != hipSuccess) { fprintf(stderr, "kernel_launch: hipFuncSetAttribute failed\n"); grid = -1; return; }
        int per_cu = 0; (void)hipOccupancyMaxActiveBlocksPerMultiprocessor(&per_cu, (const void*)fwd, 512, LDS_BYTES); (void)hipGetLastError();
        grid = cus;
    }
    if (grid < 0) return;
    (void)hipMemsetAsync((char*)d_ws + OFF_CTL, 0, CTL_BYTES, stream);
    Args a{};
    for (int i = 0; i < 33; ++i) a.in[i] = (const float*)d_in[i];
    a.out = (float*)d_out; a.ws = (unsigned char*)d_ws;
#if MK_PER_PHASE
    for (int p = 0; p < NGP; ++p) { a.lo = p; a.hi = p + 1; hipLaunchKernelGGL(fwd, dim3(grid), dim3(512), LDS_BYTES, stream, a); }
#else
    a.lo = 0; a.hi = NGP;
    hipLaunchKernelGGL(fwd, dim3(grid), dim3(512), LDS_BYTES, stream, a);
#endif
}
```
